# Optimizing an MI355X kernel written in HIP

```python
import math
import jax, jax.numpy as jnp
from jax import lax
import numpy as np

D_MODEL = 1024
BATCH = 2
SEQ = 16384
DEPTH = 2

D_MIX = D_MODEL
HEAD_DIM = 64
D_ATT = 3 * D_MIX // 4
N_HEADS = D_ATT // HEAD_DIM
N_KV = 3
GQA = N_HEADS // N_KV
D_SSM = D_MIX - D_ATT
SSM_CH = 16
N_SSM_GROUPS = D_SSM // SSM_CH
SSM_STATE = 64
L_CMP = 32
STRIDE_CMP = 16
CMP_HID = 256
L_SEL = 64
TOP_K = 16
WINDOW = 512
Q_BLK = 128
BIG = 1e9
TINY = 1e-30
D_FF = -(-8 * D_MODEL // (3 * 256)) * 256

P_KV = N_KV * HEAD_DIM
P_GATE = 3 * N_HEADS
P_SIZES = [D_ATT] + [P_KV] * 6 + [P_GATE, D_SSM]
P_TOTAL = D_ATT + 6 * P_KV + P_GATE + D_SSM

kernel_name = 'hymba_nsa_s5_hybrid_trunk'


def rmsnorm(x, g, eps=1e-6):
    xf = x.astype(jnp.float32)
    y = xf * lax.rsqrt(jnp.mean(xf * xf, axis=-1, keepdims=True) + eps)
    return (y * g.astype(jnp.float32)).astype(x.dtype)


def masked_softmax(s, mask):
    s = jnp.where(mask, s.astype(jnp.float32), -jnp.inf)
    m = jnp.max(s, axis=-1, keepdims=True)
    m = jnp.where(jnp.isfinite(m), m, 0.0)
    p = jnp.exp(s - m)
    return p / jnp.maximum(jnp.sum(p, axis=-1, keepdims=True), TINY)


def split_q_heads(t):
    b, s, _ = t.shape
    return t.reshape(b, s, N_KV, GQA, HEAD_DIM).transpose(0, 2, 3, 1, 4)


def split_kv_heads(t):
    b, s, _ = t.shape
    return t.reshape(b, s, N_KV, HEAD_DIM).transpose(0, 2, 1, 3)


def compress(k, pe, w1, b1, w2, b2):
    b, h, s, dh = k.shape
    n_chunk = s // STRIDE_CMP
    r = L_CMP // STRIDE_CMP
    n_cmp = n_chunk - r + 1
    ch = k.reshape(b, h, n_chunk, STRIDE_CMP, dh)
    blocks = jnp.concatenate([ch[:, :, j:j + n_cmp] for j in range(r)], axis=3)
    blocks = (blocks + pe).reshape(b, h, n_cmp, L_CMP * dh)
    hid = jax.nn.gelu(blocks @ w1 + b1)
    return hid @ w2 + b2


def nsa_attention(q, k_c, v_c, k_s, v_s, k_w, v_w, gates):
    b, h, g, s, dh = q.shape
    n_cmp = k_c.shape[2]
    n_sel = s // L_SEL
    k_top = min(TOP_K, n_sel)
    cmp_start = jnp.arange(n_cmp) * STRIDE_CMP
    cmp_end = cmp_start + L_CMP - 1
    sel_start = jnp.arange(n_sel) * L_SEL
    overlap = ((cmp_start[:, None] < sel_start[None, :] + L_SEL)
               & (cmp_start[:, None] + L_CMP > sel_start[None, :])).astype(jnp.float32)
    ks_blk = k_s.reshape(b, h, n_sel, L_SEL, dh)
    vs_blk = v_s.reshape(b, h, n_sel, L_SEL, dh)
    kw_pad = jnp.pad(k_w, ((0, 0), (0, 0), (WINDOW, 0), (0, 0)))
    vw_pad = jnp.pad(v_w, ((0, 0), (0, 0), (WINDOW, 0), (0, 0)))
    b_ix = jnp.arange(b)[:, None, None, None]
    h_ix = jnp.arange(h)[None, :, None, None]
    blk_ids = jnp.arange(n_sel)

    def block(i):
        q0 = i * Q_BLK
        qb = lax.dynamic_slice_in_dim(q, q0, Q_BLK, axis=3)
        gb = lax.dynamic_slice_in_dim(gates, q0, Q_BLK, axis=3)
        t = q0 + jnp.arange(Q_BLK)
        s_c = jnp.einsum('bhgqd,bhnd->bhgqn', qb, k_c)
        p_c = masked_softmax(s_c, cmp_end[None, :] <= t[:, None])
        o_c = jnp.einsum('bhgqn,bhnd->bhgqd', p_c.astype(v_c.dtype), v_c)
        imp = jnp.einsum('bhgqn,ns->bhqs', p_c, overlap)
        cur = t // L_SEL
        forced = ((blk_ids[None, :] == 0) | (blk_ids[None, :] == cur[:, None])
                  | (blk_ids[None, :] == cur[:, None] - 1))
        valid = blk_ids[None, :] <= cur[:, None]
        imp = jnp.where(forced, BIG, jnp.where(valid, imp, -BIG))
        _, idx = lax.top_k(imp, k_top)
        ksel = ks_blk[b_ix, h_ix, idx].reshape(b, h, Q_BLK, k_top * L_SEL, dh)
        vsel = vs_blk[b_ix, h_ix, idx].reshape(b, h, Q_BLK, k_top * L_SEL, dh)
        pos = (idx[..., None] * L_SEL + jnp.arange(L_SEL)).reshape(b, h, Q_BLK, k_top * L_SEL)
        s_s = jnp.einsum('bhgqd,bhqkd->bhgqk', qb, ksel)
        p_s = masked_softmax(s_s, (pos <= t[:, None])[:, :, None])
        o_s = jnp.einsum('bhgqk,bhqkd->bhgqd', p_s.astype(vsel.dtype), vsel)
        kwb = lax.dynamic_slice_in_dim(kw_pad, q0, Q_BLK + WINDOW, axis=2)
        vwb = lax.dynamic_slice_in_dim(vw_pad, q0, Q_BLK + WINDOW, axis=2)
        s_pos = q0 - WINDOW + jnp.arange(Q_BLK + WINDOW)
        wmask = ((s_pos[None, :] <= t[:, None]) & (s_pos[None, :] > t[:, None] - WINDOW)
                 & (s_pos[None, :] >= 0))
        s_w = jnp.einsum('bhgqd,bhkd->bhgqk', qb, kwb)
        p_w = masked_softmax(s_w, wmask)
        o_w = jnp.einsum('bhgqk,bhkd->bhgqd', p_w.astype(vwb.dtype), vwb)
        return gb[..., 0:1] * o_c + gb[..., 1:2] * o_s + gb[..., 2:3] * o_w

    out = lax.map(block, jnp.arange(s // Q_BLK))
    return out.transpose(1, 0, 4, 2, 3, 5).reshape(b, s, h * g * dh)


def _ssm_combine(e1, e2):
    ar1, ai1, br1, bi1 = e1
    ar2, ai2, br2, bi2 = e2
    return (ar2 * ar1 - ai2 * ai1,
            ar2 * ai1 + ai2 * ar1,
            ar2 * br1 - ai2 * bi1 + br2,
            ar2 * bi1 + ai2 * br1 + bi2)


def s5_mixer(u, log_dt, a_re, a_im, b_re, b_im, c_re, c_im, d_skip, w_glu, b_glu):
    f32 = jnp.float32
    bsz, s, _ = u.shape
    uf = u.astype(f32).reshape(bsz, s, N_SSM_GROUPS, SSM_CH)
    a_re = a_re.astype(f32)
    a_im = a_im.astype(f32)
    dt = jnp.exp(log_dt.astype(f32))[:, None]
    mag = jnp.exp(dt * a_re)
    abar_re = mag * jnp.cos(dt * a_im)
    abar_im = mag * jnp.sin(dt * a_im)
    den = a_re * a_re + a_im * a_im
    nr = abar_re - 1.0
    f_re = (nr * a_re + abar_im * a_im) / den
    f_im = (abar_im * a_re - nr * a_im) / den
    b_re = b_re.astype(f32)
    b_im = b_im.astype(f32)
    bbar_re = f_re[..., None] * b_re - f_im[..., None] * b_im
    bbar_im = f_re[..., None] * b_im + f_im[..., None] * b_re
    bu_re = jnp.einsum('bsgc,gnc->bsgn', uf, bbar_re)
    bu_im = jnp.einsum('bsgc,gnc->bsgn', uf, bbar_im)
    elems = (jnp.broadcast_to(abar_re, bu_re.shape), jnp.broadcast_to(abar_im, bu_re.shape), bu_re, bu_im)
    _, _, h_re, h_im = lax.associative_scan(_ssm_combine, elems, axis=1)
    y = (jnp.einsum('gcn,bsgn->bsgc', c_re.astype(f32), h_re)
         - jnp.einsum('gcn,bsgn->bsgc', c_im.astype(f32), h_im))
    y = y.reshape(bsz, s, D_SSM) + d_skip.astype(f32) * uf.reshape(bsz, s, D_SSM)
    y = jax.nn.gelu(y)
    z = y @ w_glu.astype(f32) + b_glu.astype(f32)
    val, gate = jnp.split(z, 2, axis=-1)
    return (val * jax.nn.sigmoid(gate)).astype(u.dtype)


def setup_inputs(seed: int = 0) -> dict:
    key = jax.random.key(seed)
    ks = jax.random.split(key, 32)
    f32 = jnp.float32
    L, D, G, N, C = DEPTH, D_MODEL, N_SSM_GROUPS, SSM_STATE, SSM_CH

    def nrm(k, shape, scale):
        return scale * jax.random.normal(k, shape, f32)

    return {
        'x': nrm(ks[0], (BATCH, SEQ, D), 1.0),
        'attn_norm_g': 1.0 + nrm(ks[1], (L, D), 0.02),
        'w_in': nrm(ks[2], (L, D, P_TOTAL), D ** -0.5),
        'cmp_pe': nrm(ks[3], (L, 2, L_CMP, HEAD_DIM), 0.02),
        'cmp_w1': nrm(ks[4], (L, 2, L_CMP * HEAD_DIM, CMP_HID), (L_CMP * HEAD_DIM) ** -0.5),
        'cmp_b1': nrm(ks[5], (L, 2, CMP_HID), 0.01),
        'cmp_w2': nrm(ks[6], (L, 2, CMP_HID, HEAD_DIM), CMP_HID ** -0.5),
        'cmp_b2': nrm(ks[7], (L, 2, HEAD_DIM), 0.01),
        'log_dt': jax.random.uniform(ks[8], (L, G), f32, math.log(1e-3), math.log(1e-1)),
        'a_re': -0.5 + nrm(ks[9], (L, G, N), 0.01),
        'a_im': math.pi * jnp.arange(N, dtype=f32) + nrm(ks[10], (L, G, N), 0.01),
        'b_re': nrm(ks[11], (L, G, N, C), (2 * C) ** -0.5),
        'b_im': nrm(ks[12], (L, G, N, C), (2 * C) ** -0.5),
        'c_re': nrm(ks[13], (L, G, C, N), N ** -0.5),
        'c_im': nrm(ks[14], (L, G, C, N), N ** -0.5),
        'd_skip': nrm(ks[15], (L, D_SSM), 1.0),
        'w_glu': nrm(ks[16], (L, D_SSM, 2 * D_SSM), D_SSM ** -0.5),
        'b_glu': nrm(ks[17], (L, 2 * D_SSM), 0.01),
        'mix_norm_att': 1.0 + nrm(ks[18], (L, D_ATT), 0.02),
        'mix_norm_ssm': 1.0 + nrm(ks[19], (L, D_SSM), 0.02),
        'w_out': nrm(ks[20], (L, D_MIX, D), D_MIX ** -0.5),
        'ffn_norm_g': 1.0 + nrm(ks[21], (L, D), 0.02),
        'w_gate': nrm(ks[22], (L, D, D_FF), D ** -0.5),
        'w_up': nrm(ks[23], (L, D, D_FF), D ** -0.5),
        'w_down': nrm(ks[24], (L, D_FF, D), D_FF ** -0.5),
        'final_norm_g': 1.0 + nrm(ks[25], (D,), 0.02),
    }


def reference(x, attn_norm_g, w_in, cmp_pe, cmp_w1, cmp_b1, cmp_w2, cmp_b2, log_dt, a_re, a_im,
              b_re, b_im, c_re, c_im, d_skip, w_glu, b_glu, mix_norm_att, mix_norm_ssm, w_out,
              ffn_norm_g, w_gate, w_up, w_down, final_norm_g):
    bsz, s, _ = x.shape
    split_at = np.cumsum(P_SIZES)[:-1].tolist()
    for l in range(DEPTH):
        h = rmsnorm(x, attn_norm_g[l])
        proj = h @ w_in[l]
        q, kc, vc, ksl, vsl, kwn, vwn, g, u = jnp.split(proj, split_at, axis=-1)
        q = split_q_heads(q) * (HEAD_DIM ** -0.5)
        k_c = compress(split_kv_heads(kc), cmp_pe[l, 0], cmp_w1[l, 0], cmp_b1[l, 0], cmp_w2[l, 0], cmp_b2[l, 0])
        v_c = compress(split_kv_heads(vc), cmp_pe[l, 1], cmp_w1[l, 1], cmp_b1[l, 1], cmp_w2[l, 1], cmp_b2[l, 1])
        gates = jax.nn.sigmoid(g.astype(jnp.float32)).astype(x.dtype)
        gates = gates.reshape(bsz, s, N_KV, GQA, 3).transpose(0, 2, 3, 1, 4)
        o_att = nsa_attention(q, k_c, v_c, split_kv_heads(ksl), split_kv_heads(vsl),
                              split_kv_heads(kwn), split_kv_heads(vwn), gates)
        o_ssm = s5_mixer(u, log_dt[l], a_re[l], a_im[l], b_re[l], b_im[l], c_re[l], c_im[l],
                         d_skip[l], w_glu[l], b_glu[l])
        mixed = jnp.concatenate([rmsnorm(o_att, mix_norm_att[l]), rmsnorm(o_ssm, mix_norm_ssm[l])], axis=-1)
        x = x + mixed @ w_out[l]
        h = rmsnorm(x, ffn_norm_g[l])
        x = x + (jax.nn.silu(h @ w_gate[l]) * (h @ w_up[l])) @ w_down[l]
    return rmsnorm(x, final_norm_g)
```

```cpp
#include <hip/hip_runtime.h>
#include <hip/hip_cooperative_groups.h>
#include <cstdio>
#include <cstdint>
namespace cg = cooperative_groups;

#ifndef STAGE
#define STAGE 99
#endif

#define DI __device__ __forceinline__
#define LAS __attribute__((address_space(3)))
typedef unsigned short bf16_t;
typedef short bf16x8 __attribute__((ext_vector_type(8)));
typedef short s16x4 __attribute__((ext_vector_type(4)));
typedef float f32x4 __attribute__((ext_vector_type(4)));
typedef float f32x2 __attribute__((ext_vector_type(2)));
typedef float f32x16 __attribute__((ext_vector_type(16)));
typedef unsigned u32x4 __attribute__((ext_vector_type(4)));
typedef unsigned u32x2 __attribute__((ext_vector_type(2)));
typedef __bf16 bf2_t __attribute__((ext_vector_type(2)));

DI unsigned pk2(float lo, float hi) { f32x2 v = {lo, hi}; return __builtin_bit_cast(unsigned, __builtin_convertvector(v, bf2_t)); }
DI bf16_t f2bf(float f) { return (bf16_t)(pk2(f, 0.f) & 0xffffu); }
DI float bf2f(bf16_t u) { return __uint_as_float((unsigned)u << 16); }
DI float bflo(unsigned w) { return __uint_as_float(w << 16); }
DI float bfhi(unsigned w) { return __uint_as_float(w & 0xffff0000u); }
DI float fexp2(float x) { return __builtin_amdgcn_exp2f(x); }
DI float sigmoidf_(float x) { return 1.0f / (1.0f + __expf(-x)); }
DI float gelu_tanh(float x) { const float y = 0.7978845608028654f * (x + 0.044715f * x * x * x); return x / (1.0f + __expf(-2.0f * y)); }
DI float wave_sum(float v) {
#pragma unroll
    for (int o = 1; o < 64; o <<= 1) v += __shfl_xor(v, o);
    return v;
}
DI float wave_max(float v) {
#pragma unroll
    for (int o = 1; o < 64; o <<= 1) v = fmaxf(v, __shfl_xor(v, o));
    return v;
}

constexpr int NB = 2, SEQ = 16384, DM = 1024, NT = NB * SEQ, NL = 2;
constexpr int PW = 2304;
constexpr int C_Q = 0, C_KC = 768, C_VC = 960, C_KS = 1152, C_VS = 1344, C_KW = 1536, C_VW = 1728, C_U = 1920, C_G = 2176;
constexpr int DFF = 2816;
constexpr float L2E = 1.4426950408889634f;

constexpr size_t MiB = 1u << 20;
constexpr size_t WS_CTL = 0;
constexpr size_t WS_W = 1 * MiB;
constexpr size_t WL_STRIDE = 32 * MiB;
constexpr size_t WO_WIN = 0;
constexpr size_t WO_WOUT = 5 * MiB;
constexpr size_t WO_WGU = 7 * MiB;
constexpr size_t WO_WD = 18 * MiB;
constexpr size_t WO_W1 = 24 * MiB;
constexpr size_t WO_SS1 = 26 * MiB;
constexpr size_t WO_SS2 = 30 * MiB;
constexpr size_t CT_L = 256 * 1024;
constexpr size_t CT_BASE = 64 * 1024;
constexpr size_t CT_AB16 = 0;
constexpr size_t CT_AB1K = 8 * 1024;
constexpr size_t CT_CB1 = 16 * 1024;
constexpr size_t CT_W2T = 20 * 1024;
constexpr size_t CT_WGLU = 84 * 1024;
constexpr size_t WS_ACT = WS_W + 2 * WL_STRIDE;
constexpr size_t WS_PROJ = WS_ACT + 64 * MiB;
constexpr size_t WS_OATT = WS_PROJ + 176 * MiB;
constexpr size_t WS_OSSM = WS_OATT + 48 * MiB;
constexpr size_t WS_YS2 = WS_OSSM + 16 * MiB;
constexpr size_t WS_YI = WS_YS2 + 16 * MiB;
constexpr size_t WS_HL = WS_YI + 32 * MiB;
constexpr size_t WS_HIN = WS_HL + 16 * MiB;
constexpr size_t WS_VTS = WS_HIN + 16 * MiB;
constexpr size_t WS_VTW = WS_VTS + 12 * MiB;
constexpr size_t WS_KC = WS_VTW + 12 * MiB;
constexpr size_t WS_VCT = WS_KC + 1 * MiB;
constexpr size_t WS_HIDC = WS_VCT + 1 * MiB;
constexpr size_t WS_MISC = WS_HIDC + 6 * MiB;
constexpr size_t WS_END = WS_MISC + 4 * MiB;
constexpr size_t MS_L = 2 * MiB;
constexpr size_t MS_MTAB = 0;
constexpr size_t MS_CBP = 256 * 1024;
constexpr size_t MS_WGLU = 512 * 1024;
constexpr size_t MS_BBAR = 1024 * 1024;
constexpr size_t MS_FTAB = 1024 * 1024 + 128 * 1024;

constexpr int LDS_BYTES = 143360;

struct Params { const float* in[26]; float* out; unsigned char* ws; };

namespace pg8 {
constexpr int BM = 256, BK = 64, HALF = 128, HTB = HALF * BK * 2, STAGE_BYTES = 8 * HTB, NXCD = 8, WGM = 8;
__host__ __device__ __forceinline__ int lds_byte(int r, int c) { const int st = (r >> 4) * 2 + (c >> 5), rr = r & 15, cc = c & 31, ob = rr * 64 + cc * 2; return st * 1024 + (ob ^ (((ob >> 9) & 1) << 5)); }
__host__ __device__ __forceinline__ void stage_rc(int b, int& R, int& C) { const int st = b / 1024, sb = b % 1024, swz = sb ^ (((sb >> 9) & 1) << 5); R = (st >> 1) * 16 + swz / 64; C = (st & 1) * 32 + (swz % 64) / 2; }
__host__ __device__ __forceinline__ int perm32(int rho) { const int n = rho >> 4, i = rho & 15; return 8 * (i >> 2) + 4 * n + (i & 3); }
struct Unit { int pm, pn; };
struct StaticOrder {
    int nM, nN, nwg, G, c;
    __device__ void init(int nM_, int nN_, int G_, int c_) { nM = nM_; nN = nN_; nwg = nM * nN; G = G_; c = c_; }
    __device__ bool next(int i, Unit& u) const {
        const long L = (long)i * G + c; if (L >= nwg) return false;
        int wgid = (int)L; { const int q = nwg / NXCD, r = nwg % NXCD, xcd = wgid % NXCD, off = wgid / NXCD; wgid = (xcd < r ? xcd * (q + 1) : r * (q + 1) + (xcd - r) * q) + off; }
        const int nig = WGM * nN, gid = wgid / nig, fm = gid * WGM, gsz = (nM - fm) < WGM ? (nM - fm) : WGM;
        u.pm = fm + ((wgid % nig) % gsz); u.pn = (wgid % nig) / gsz; return true;
    }
};

template <class Epi, class Addr, bool ALIGN_EPI>
__device__ __forceinline__ void gemm_phase(LAS unsigned char* lds, const Addr& g, const StaticOrder& S, const Epi& E, int tid) {
    asm volatile("" : "+v"(tid));
    const int wid = __builtin_amdgcn_readfirstlane(tid >> 6), lane = tid & 63, wr = wid >> 2, wc = wid & 3, fr = lane & 15, fq = lane >> 4;
    const int K = g.K(), nt = K / BK;
    unsigned voffA[2], voffB[2];
#pragma unroll
    for (int i = 0; i < 2; ++i) { int R, C; stage_rc(tid * 16 + i * 8192, R, C); const int Rb = Epi::PERM ? ((R & ~31) + perm32(R & 31)) : R;
        voffA[i] = (unsigned)R * g.a_row_bytes() + g.a_col_off(C); voffB[i] = (unsigned)(Rb * K + C) * 2u; }
    const size_t kstepA = g.a_kstep(), kstepB = (size_t)(BK * 2);
    const size_t hstepA = (size_t)HALF * g.a_row_bytes(), hstepB = (size_t)HALF * K * 2;
    const unsigned ldsw = (unsigned)wid * 1024u;
    const int aoff = lds_byte(wr * 64 + fr, fq * 8), boff = lds_byte(wc * 32 + fr, fq * 8);
#define PG8_SA(b, h) (((b) * 2 + (h)) * HTB)
#define PG8_SB(b, h) ((4 + (b) * 2 + (h)) * HTB)
#define PG8_STAGE(bufoff, gbase, voff) do { _Pragma("unroll") for (int _i = 0; _i < 2; ++_i) \
        __builtin_amdgcn_global_load_lds((const unsigned*)((const char*)(gbase) + (voff)[_i]), (LAS unsigned*)(lds + (bufoff) + ldsw + _i * 8192), 16, 0, 0); } while (0)
#define PG8_LDA(dst, b, h) do { _Pragma("unroll") for (int m = 0; m < 4; ++m) _Pragma("unroll") for (int k = 0; k < 2; ++k) dst[m][k] = *(const LAS bf16x8*)(lds + PG8_SA(b, h) + aoff + m * 2048 + k * 1024); } while (0)
#define PG8_LDB(dst, b, h) do { _Pragma("unroll") for (int n = 0; n < 2; ++n) _Pragma("unroll") for (int k = 0; k < 2; ++k) dst[n][k] = *(const LAS bf16x8*)(lds + PG8_SB(b, h) + boff + n * 2048 + k * 1024); } while (0)
#define PG8_MMA(ai, bj, At, Bt) do { __builtin_amdgcn_s_setprio(1); _Pragma("unroll") for (int m = 0; m < 4; ++m) _Pragma("unroll") for (int n = 0; n < 2; ++n) _Pragma("unroll") for (int k = 0; k < 2; ++k) \
        acc[ai][bj][m][n] = __builtin_amdgcn_mfma_f32_16x16x32_bf16(Bt[n][k], At[m][k], acc[ai][bj][m][n], 0, 0, 0); __builtin_amdgcn_s_setprio(0); } while (0)
#define PG8_WAIT_V(n) asm volatile("s_waitcnt vmcnt(" #n ")" ::: "memory")
#define PG8_WAIT_L(n) asm volatile("s_waitcnt lgkmcnt(" #n ")" ::: "memory")
#define PG8_BAR __builtin_amdgcn_s_barrier()
#define PG8_SCHED __builtin_amdgcn_sched_barrier(0)
    Unit cur, nxt; int ui = 0;
    if (!S.next(0, cur)) return;
    f32x4 acc[2][2][4][2];
#pragma unroll
    for (int a = 0; a < 2; ++a)
#pragma unroll
        for (int b = 0; b < 2; ++b)
#pragma unroll
            for (int m = 0; m < 4; ++m)
#pragma unroll
                for (int n = 0; n < 2; ++n) acc[a][b][m][n] = (f32x4){0.f, 0.f, 0.f, 0.f};
    bf16x8 At[4][2], B0[2][2], B1[2][2];
    const char* cA = g.a_base(cur); const char* cB = g.b_base(cur);
    PG8_STAGE(PG8_SB(0, 0), cB, voffB); PG8_STAGE(PG8_SB(0, 1), cB + hstepB, voffB); PG8_STAGE(PG8_SA(0, 0), cA, voffA); PG8_STAGE(PG8_SA(0, 1), cA + hstepA, voffA);
    if (wr == 1) PG8_BAR;
    PG8_WAIT_V(2); PG8_BAR;
    PG8_STAGE(PG8_SB(1, 0), cB + kstepB, voffB); PG8_STAGE(PG8_SA(1, 0), cA + kstepA, voffA); PG8_STAGE(PG8_SB(1, 1), cB + hstepB + kstepB, voffB);
    PG8_WAIT_V(6); PG8_BAR;
    for (;;) {
        const bool has_next = S.next(ui + 1, nxt);
        const char* nA = has_next ? g.a_base(nxt) : cA; const char* nB = has_next ? g.b_base(nxt) : cB;
        for (int t = 0; t < nt; t += 2) {
            const bool last = (t == nt - 2);
            const char* a1 = cA + (size_t)(t + 1) * kstepA;
            const char* a2 = last ? nA : cA + (size_t)(t + 2) * kstepA; const char* b2 = last ? nB : cB + (size_t)(t + 2) * kstepB;
            const char* a3 = a2 + kstepA; const char* b3 = b2 + kstepB;
            PG8_LDB(B0, 0, 0); PG8_LDB(B1, 0, 1); PG8_SCHED; PG8_LDA(At, 0, 0); PG8_STAGE(PG8_SA(1, 1), a1 + hstepA, voffA);
            PG8_WAIT_V(8); PG8_WAIT_L(0); PG8_BAR; PG8_MMA(0, 0, At, B0); PG8_MMA(0, 1, At, B1); PG8_BAR; PG8_SCHED;
            PG8_LDA(At, 0, 1); PG8_STAGE(PG8_SB(0, 0), b2, voffB); PG8_STAGE(PG8_SB(0, 1), b2 + hstepB, voffB); PG8_STAGE(PG8_SA(0, 0), a2, voffA);
            PG8_WAIT_V(8); PG8_WAIT_L(0); PG8_BAR; PG8_MMA(1, 0, At, B0); PG8_MMA(1, 1, At, B1); PG8_BAR; PG8_SCHED;
            PG8_LDB(B0, 1, 0); PG8_LDB(B1, 1, 1); PG8_SCHED; PG8_LDA(At, 1, 0); PG8_STAGE(PG8_SA(0, 1), a2 + hstepA, voffA);
            PG8_WAIT_V(8); PG8_WAIT_L(0); PG8_BAR; PG8_MMA(0, 0, At, B0); PG8_MMA(0, 1, At, B1); PG8_BAR; PG8_SCHED;
            PG8_LDA(At, 1, 1); PG8_STAGE(PG8_SB(1, 0), b3, voffB); PG8_STAGE(PG8_SB(1, 1), b3 + hstepB, voffB); PG8_STAGE(PG8_SA(1, 0), a3, voffA);
            PG8_WAIT_V(8); PG8_WAIT_L(0); PG8_BAR; PG8_MMA(1, 0, At, B0); PG8_MMA(1, 1, At, B1); PG8_BAR; PG8_SCHED;
        }
        if constexpr (ALIGN_EPI) { if (wr == 0) PG8_BAR; }
        E(acc, cur, wr, wc, fr, fq);
        if (!has_next) break;
#pragma unroll
        for (int a = 0; a < 2; ++a)
#pragma unroll
            for (int b = 0; b < 2; ++b)
#pragma unroll
                for (int m = 0; m < 4; ++m)
#pragma unroll
                    for (int n = 0; n < 2; ++n) acc[a][b][m][n] = (f32x4){0.f, 0.f, 0.f, 0.f};
        cur = nxt; cA = nA; cB = nB; ++ui;
        if constexpr (ALIGN_EPI) { if (wr == 1) PG8_BAR; }
    }
    PG8_WAIT_V(0);
    if constexpr (!ALIGN_EPI) { if (wr == 0) PG8_BAR; }
    PG8_BAR;
#undef PG8_SA
#undef PG8_SB
#undef PG8_STAGE
#undef PG8_LDA
#undef PG8_LDB
#undef PG8_MMA
#undef PG8_WAIT_V
#undef PG8_WAIT_L
#undef PG8_BAR
#undef PG8_SCHED
}

struct APlain {
    const char* A; const char* Bt; int k;
    DI int K() const { return k; }
    DI unsigned a_row_bytes() const { return (unsigned)k * 2u; }
    DI unsigned a_kstep() const { return 128u; }
    DI unsigned a_col_off(int C) const { return (unsigned)C * 2u; }
    DI const char* a_base(const Unit& u) const { return A + (size_t)u.pm * 256 * k * 2; }
    DI const char* b_base(const Unit& u) const { return Bt + (size_t)u.pn * 256 * k * 2; }
};
struct ACompress {
    const char* proj; const char* w1t;
    DI int K() const { return 2048; }
    DI unsigned a_row_bytes() const { return 16u * PW * 2u; }
    DI unsigned a_kstep() const { return (unsigned)PW * 2u; }
    DI unsigned a_col_off(int C) const { return (unsigned)C * 2u; }
    DI const char* a_base(const Unit& u) const { const int kv = u.pm / 24, r = u.pm % 24, bh = r >> 2, qt = r & 3, b = bh / 3, h = bh % 3;
        return proj + ((size_t)(b * SEQ + 4096 * qt) * PW + (kv ? C_VC : C_KC) + h * 64) * 2; }
    DI const char* b_base(const Unit& u) const { return w1t + (size_t)(u.pm / 24) * 256 * 2048 * 2; }
};
struct ASsm1 {
    const char* proj; const char* ss1;
    DI int K() const { return 256; }
    DI unsigned a_row_bytes() const { return 16u * PW * 2u; }
    DI unsigned a_kstep() const { return 4u * PW * 2u; }
    DI unsigned a_col_off(int C) const { return (unsigned)(C >> 4) * (PW * 2u) + (unsigned)(C & 15) * 2u; }
    DI const char* a_base(const Unit& u) const { const int bg = u.pm >> 2, qt = u.pm & 3, b = bg >> 4, gi = bg & 15;
        return proj + ((size_t)(b * SEQ + 4096 * qt) * PW + C_U + gi * 16) * 2; }
    DI const char* b_base(const Unit& u) const { const int gi = (u.pm >> 2) & 15; return ss1 + ((size_t)gi * 512 + (size_t)u.pn * 256) * 256 * 2; }
};
struct ASsm2 {
    const char* hin; const char* ss2;
    DI int K() const { return 256; }
    DI unsigned a_row_bytes() const { return 512u; }
    DI unsigned a_kstep() const { return 128u; }
    DI unsigned a_col_off(int C) const { return (unsigned)C * 2u; }
    DI const char* a_base(const Unit& u) const { return hin + (size_t)u.pm * 256 * 512; }
    DI const char* b_base(const Unit& u) const { const int gi = (u.pm >> 2) & 15; return ss2 + (size_t)gi * 256 * 256 * 2; }
};

struct EpiBf16 {
    static constexpr bool PERM = true;
    bf16_t* O; int ldc;
    DI void operator()(const f32x4 (&acc)[2][2][4][2], const Unit& u, int wr, int wc, int fr, int fq) const {
        const int row0 = u.pm * BM + wr * 64 + fr, col0 = u.pn * BM + wc * 32 + 8 * fq;
#pragma unroll
        for (int ai = 0; ai < 2; ++ai)
#pragma unroll
            for (int m = 0; m < 4; ++m) { bf16_t* rowp = O + (size_t)(row0 + ai * HALF + m * 16) * ldc + col0;
#pragma unroll
                for (int bj = 0; bj < 2; ++bj) { const f32x4 v0 = acc[ai][bj][m][0], v1 = acc[ai][bj][m][1];
                    u32x4 w; w.x = pk2(v0[0], v0[1]); w.y = pk2(v0[2], v0[3]); w.z = pk2(v1[0], v1[1]); w.w = pk2(v1[2], v1[3]);
                    *(u32x4*)(rowp + bj * HALF) = w; } }
    }
};
struct EpiCmpHid {
    static constexpr bool PERM = true;
    bf16_t* O; const float* cb1;
    DI void operator()(const f32x4 (&acc)[2][2][4][2], const Unit& u, int wr, int wc, int fr, int fq) const {
        const int row0 = u.pm * BM + wr * 64 + fr, col0 = wc * 32 + 8 * fq; const float* bb = cb1 + (u.pm / 24) * 256;
        f32x4 bv[2][2];
#pragma unroll
        for (int bj = 0; bj < 2; ++bj)
#pragma unroll
            for (int n = 0; n < 2; ++n) bv[bj][n] = *(const f32x4*)(bb + col0 + bj * HALF + 4 * n);
#pragma unroll
        for (int ai = 0; ai < 2; ++ai)
#pragma unroll
            for (int m = 0; m < 4; ++m) { bf16_t* rowp = O + (size_t)(row0 + ai * HALF + m * 16) * 256 + col0;
#pragma unroll
                for (int bj = 0; bj < 2; ++bj) { f32x4 v0 = acc[ai][bj][m][0] + bv[bj][0], v1 = acc[ai][bj][m][1] + bv[bj][1];
#pragma unroll
                    for (int e = 0; e < 4; ++e) { v0[e] = gelu_tanh(v0[e]); v1[e] = gelu_tanh(v1[e]); }
                    u32x4 w; w.x = pk2(v0[0], v0[1]); w.y = pk2(v0[2], v0[3]); w.z = pk2(v1[0], v1[1]); w.w = pk2(v1[2], v1[3]);
                    *(u32x4*)(rowp + bj * HALF) = w; } }
    }
};
struct EpiSsm1 {
    static constexpr bool PERM = false;
    float* YI; float* HL;
    DI void operator()(const f32x4 (&acc)[2][2][4][2], const Unit& u, int wr, int wc, int fr, int fq) const {
        const int row0 = u.pm * BM + wr * 64 + fr, col0 = wc * 32 + 4 * fq;
#pragma unroll
        for (int ai = 0; ai < 2; ++ai)
#pragma unroll
            for (int m = 0; m < 4; ++m) { const size_t row = (size_t)(row0 + ai * HALF + m * 16);
                if (u.pn == 0) {
#pragma unroll
                    for (int bj = 0; bj < 2; ++bj)
#pragma unroll
                        for (int n = 0; n < 2; ++n) *(f32x4*)(YI + row * 256 + col0 + bj * HALF + n * 16) = acc[ai][bj][m][n];
                } else {
#pragma unroll
                    for (int n = 0; n < 2; ++n) *(f32x4*)(HL + row * 128 + col0 + n * 16) = acc[ai][0][m][n];
                } }
    }
};
struct EpiSsm2 {
    static constexpr bool PERM = false;
    const float* YI; const bf16_t* proj; const float* dskip; bf16_t* YS2;
    DI void operator()(const f32x4 (&acc)[2][2][4][2], const Unit& u, int wr, int wc, int fr, int fq) const {
        const int row0 = u.pm * BM + wr * 64 + fr, col0 = wc * 32 + 4 * fq;
        const int bg = u.pm >> 2, b = bg >> 4, gi = bg & 15;
        const f32x4 dsk = *(const f32x4*)(dskip + gi * 16 + 4 * fq);
#pragma unroll
        for (int ai = 0; ai < 2; ++ai)
#pragma unroll
            for (int m = 0; m < 4; ++m) { const int row = row0 + ai * HALF + m * 16; const int chunk = row & 1023;
#pragma unroll
                for (int bj = 0; bj < 2; ++bj)
#pragma unroll
                    for (int n = 0; n < 2; ++n) { const int col = col0 + bj * HALF + n * 16, tau = col >> 4;
                        const size_t tok = (size_t)b * SEQ + chunk * 16 + tau;
                        const f32x4 yi = *(const f32x4*)(YI + (size_t)row * 256 + col);
                        const u32x2 uw = *(const u32x2*)(proj + tok * PW + C_U + gi * 16 + 4 * fq);
                        f32x4 y = acc[ai][bj][m][n] + yi;
                        y[0] += dsk[0] * bflo(uw.x); y[1] += dsk[1] * bfhi(uw.x); y[2] += dsk[2] * bflo(uw.y); y[3] += dsk[3] * bfhi(uw.y);
                        u32x2 w; w.x = pk2(gelu_tanh(y[0]), gelu_tanh(y[1])); w.y = pk2(gelu_tanh(y[2]), gelu_tanh(y[3]));
                        *(u32x2*)(YS2 + tok * 256 + gi * 16 + 4 * fq) = w; } }
    }
};
struct EpiGlu {
    static constexpr bool PERM = true;
    bf16_t* O; const float* bglu;
    DI void operator()(const f32x4 (&acc)[2][2][4][2], const Unit& u, int wr, int wc, int fr, int fq) const {
        const int row0 = u.pm * BM + wr * 64 + fr, col0 = u.pn * HALF + wc * 32 + 8 * fq;
        f32x4 bvv[2], bgg[2];
#pragma unroll
        for (int n = 0; n < 2; ++n) { bvv[n] = *(const f32x4*)(bglu + col0 + 4 * n); bgg[n] = *(const f32x4*)(bglu + 256 + col0 + 4 * n); }
#pragma unroll
        for (int ai = 0; ai < 2; ++ai)
#pragma unroll
            for (int m = 0; m < 4; ++m) { bf16_t* rowp = O + (size_t)(row0 + ai * HALF + m * 16) * 256 + col0;
                f32x4 o[2];
#pragma unroll
                for (int n = 0; n < 2; ++n) { const f32x4 v = acc[ai][0][m][n] + bvv[n], gt = acc[ai][1][m][n] + bgg[n];
#pragma unroll
                    for (int e = 0; e < 4; ++e) o[n][e] = v[e] * sigmoidf_(gt[e]); }
                u32x4 w; w.x = pk2(o[0][0], o[0][1]); w.y = pk2(o[0][2], o[0][3]); w.z = pk2(o[1][0], o[1][1]); w.w = pk2(o[1][2], o[1][3]);
                *(u32x4*)rowp = w; }
    }
};
struct EpiSwiglu {
    static constexpr bool PERM = true;
    bf16_t* O;
    DI void operator()(const f32x4 (&acc)[2][2][4][2], const Unit& u, int wr, int wc, int fr, int fq) const {
        const int row0 = u.pm * BM + wr * 64 + fr, col0 = u.pn * HALF + wc * 32 + 8 * fq;
#pragma unroll
        for (int ai = 0; ai < 2; ++ai)
#pragma unroll
            for (int m = 0; m < 4; ++m) { bf16_t* rowp = O + (size_t)(row0 + ai * HALF + m * 16) * DFF + col0;
                f32x4 o[2];
#pragma unroll
                for (int n = 0; n < 2; ++n) { const f32x4 gt = acc[ai][0][m][n], up = acc[ai][1][m][n];
#pragma unroll
                    for (int e = 0; e < 4; ++e) o[n][e] = gt[e] * sigmoidf_(gt[e]) * up[e]; }
                u32x4 w; w.x = pk2(o[0][0], o[0][1]); w.y = pk2(o[0][2], o[0][3]); w.z = pk2(o[1][0], o[1][1]); w.w = pk2(o[1][2], o[1][3]);
                *(u32x4*)rowp = w; }
    }
};
struct EpiResF32 {
    static constexpr bool PERM = false;
    const float* base; float* out;
    DI void operator()(const f32x4 (&acc)[2][2][4][2], const Unit& u, int wr, int wc, int fr, int fq) const {
        const int row0 = u.pm * BM + wr * 64 + fr, col0 = u.pn * BM + wc * 32 + 4 * fq;
#pragma unroll
        for (int ai = 0; ai < 2; ++ai)
#pragma unroll
            for (int m = 0; m < 4; ++m) { const size_t off = (size_t)(row0 + ai * HALF + m * 16) * DM + col0;
#pragma unroll
                for (int bj = 0; bj < 2; ++bj)
#pragma unroll
                    for (int n = 0; n < 2; ++n) { const f32x4 bs = *(const f32x4*)(base + off + bj * HALF + n * 16);
                        *(f32x4*)(out + off + bj * HALF + n * 16) = bs + acc[ai][bj][m][n]; } }
    }
};
}

struct Frame {
    LAS unsigned char* lds;
    LAS const unsigned long long* pt;
    int tid, lane, wave, G, gw, ngw, bid;
    DI const float* in(int i) const { const unsigned long long v = pt[i]; const unsigned lo = __builtin_amdgcn_readfirstlane((unsigned)v), hi = __builtin_amdgcn_readfirstlane((unsigned)(v >> 32));
        return (const float*)(((unsigned long long)hi << 32) | lo); }
    DI float* out() const { return (float*)in(26); }
    DI unsigned char* wsp() const { return (unsigned char*)in(27); }
};
constexpr int LDS_PT = LDS_BYTES - 256;

DI void transpose_item(const float* W, int K, int ldw, int nvalid, bf16_t* WT, int drow0, LAS float* scr, int k0, int n0, float scale, int lane) {
    const int nn = n0 + (lane & 31); const bool ok = nn < nvalid;
#pragma unroll 8
    for (int i = 0; i < 32; ++i) { const int kk = 2 * i + (lane >> 5); scr[kk * 33 + (lane & 31)] = ok ? W[(size_t)(k0 + kk) * ldw + nn] * scale : 0.f; }
    asm volatile("s_waitcnt lgkmcnt(0)" ::: "memory");
    const int c = lane & 7;
#pragma unroll
    for (int j = 0; j < 4; ++j) { const int n = (lane >> 3) + 8 * j; const LAS float* s = scr + (8 * c) * 33 + n;
        u32x4 o; o.x = pk2(s[0 * 33], s[1 * 33]); o.y = pk2(s[2 * 33], s[3 * 33]); o.z = pk2(s[4 * 33], s[5 * 33]); o.w = pk2(s[6 * 33], s[7 * 33]);
        *(u32x4*)(WT + (size_t)(drow0 + n) * K + k0 + 8 * c) = o; }
    asm volatile("s_waitcnt lgkmcnt(0)" ::: "memory");
}

DI int win_dest_row(int n) {
    if (n < 1920) return n;
    if (n < 1956) return C_G + (n - 1920);
    return C_U + (n - 1956);
}

DI void prologue_a(Frame& F) {
    LAS float* scr = (LAS float*)(F.lds + F.wave * 8704);
    constexpr int I_WIN = 16 * 72, I_WOUT = 16 * 32, I_WG = 16 * 88, I_WD = 44 * 32, I_W1 = 2 * 32 * 8, I_WGLU = 4 * 16, I_W2 = 2 * 4 * 2, I_CB = 64, I_M = 1024, I_TAB = 16;
    constexpr int PER_L = I_WIN + I_WOUT + 2 * I_WG + I_WD + I_W1 + I_WGLU + I_W2 + I_CB + I_M + I_TAB;
    const int lane = F.lane;
    for (int it = F.gw; it < NL * PER_L; it += F.ngw) {
        const int l = it / PER_L; int r = it % PER_L;
        unsigned char* wl = F.wsp() + WS_W + (size_t)l * WL_STRIDE;
        unsigned char* ms = F.wsp() + WS_MISC + (size_t)l * MS_L;
        unsigned char* ct = F.wsp() + WS_CTL + CT_BASE + (size_t)l * CT_L;
        if (r < I_WIN) {
            const int kb = r / 72, nb = r % 72, k0 = 64 * kb, n0 = 32 * nb;
            const float* W = F.in(2) + (size_t)l * 1024 * 2212;
            bf16_t* WT = (bf16_t*)(wl + WO_WIN);
            if (n0 + 32 <= 1920) { transpose_item(W, 1024, 2212, 2212, WT, n0, scr, k0, n0, n0 < 768 ? 0.125f : 1.0f, lane); }
            else {
                const int d = n0 + (lane & 31);
                int srcn = -1;
                if (d < 1920) srcn = d; else if (d >= C_U && d < C_U + 256) srcn = 1956 + (d - C_U); else if (d >= C_G && d < C_G + 36) srcn = 1920 + (d - C_G);
#pragma unroll 8
                for (int i = 0; i < 32; ++i) { const int kk = 2 * i + (lane >> 5); scr[kk * 33 + (lane & 31)] = srcn >= 0 ? W[(size_t)(k0 + kk) * 2212 + srcn] : 0.f; }
                asm volatile("s_waitcnt lgkmcnt(0)" ::: "memory");
                const int c = lane & 7;
#pragma unroll
                for (int j = 0; j < 4; ++j) { const int n = (lane >> 3) + 8 * j; const LAS float* s = scr + (8 * c) * 33 + n;
                    u32x4 o; o.x = pk2(s[0 * 33], s[1 * 33]); o.y = pk2(s[2 * 33], s[3 * 33]); o.z = pk2(s[4 * 33], s[5 * 33]); o.w = pk2(s[6 * 33], s[7 * 33]);
                    *(u32x4*)(WT + (size_t)(n0 + n) * 1024 + k0 + 8 * c) = o; }
                asm volatile("s_waitcnt lgkmcnt(0)" ::: "memory");
            }
            continue; }
        r -= I_WIN;
        if (r < I_WOUT) { const int kb = r / 32, nb = r % 32; transpose_item(F.in(20) + (size_t)l * 1024 * 1024, 1024, 1024, 1024, (bf16_t*)(wl + WO_WOUT), 32 * nb, scr, 64 * kb, 32 * nb, 1.f, lane); continue; }
        r -= I_WOUT;
        if (r < 2 * I_WG) { const int up = r / I_WG; const int rr = r % I_WG; const int kb = rr / 88, nb = rr % 88, n0 = 32 * nb;
            const int drow = (n0 / 128) * 256 + up * 128 + (n0 % 128);
            transpose_item(F.in(up ? 23 : 22) + (size_t)l * 1024 * DFF, 1024, DFF, DFF, (bf16_t*)(wl + WO_WGU), drow, scr, 64 * kb, n0, 1.f, lane); continue; }
        r -= 2 * I_WG;
        if (r < I_WD) { const int kb = r / 32, nb = r % 32; transpose_item(F.in(24) + (size_t)l * DFF * 1024, DFF, 1024, 1024, (bf16_t*)(wl + WO_WD), 32 * nb, scr, 64 * kb, 32 * nb, 1.f, lane); continue; }
        r -= I_WD;
        if (r < I_W1) { const int kv = r / 256; const int rr = r % 256; const int kb = rr / 8, nb = rr % 8;
            transpose_item(F.in(4) + ((size_t)l * 2 + kv) * 2048 * 256, 2048, 256, 256, (bf16_t*)(wl + WO_W1) + (size_t)kv * 256 * 2048, 32 * nb, scr, 64 * kb, 32 * nb, 1.f, lane); continue; }
        r -= I_W1;
        if (r < I_WGLU) { const int kb = r / 16, nb = r % 16, n0 = 32 * nb; const int gate = n0 >= 256, nn = n0 & 255;
            const int drow = (nn / 128) * 256 + gate * 128 + (nn % 128);
            transpose_item(F.in(16) + (size_t)l * 256 * 512, 256, 512, 512, (bf16_t*)(ms + MS_WGLU), drow, scr, 64 * kb, n0, 1.f, lane); continue; }
        r -= I_WGLU;
        if (r < I_W2) { const int kv = r / 8; const int rr = r % 8; const int kb = rr / 2, nb = rr % 2;
            transpose_item(F.in(6) + ((size_t)l * 2 + kv) * 256 * 64, 256, 64, 64, (bf16_t*)(ct + CT_W2T) + (size_t)kv * 64 * 256, 32 * nb, scr, 64 * kb, 32 * nb, 1.f, lane); continue; }
        r -= I_W2;
        if (r < I_CB) {
            const int kv = r / 32, ch = r % 32; const float* pe = F.in(3) + ((size_t)l * 2 + kv) * 2048; const float* w1 = F.in(4) + ((size_t)l * 2 + kv) * 2048 * 256;
            f32x4 s = {0.f, 0.f, 0.f, 0.f};
#pragma unroll 8
            for (int i = 0; i < 64; ++i) { const int k = 64 * ch + i; const float pv = pe[k]; const f32x4 w = *(const f32x4*)(w1 + (size_t)k * 256 + 4 * lane); s += w * pv; }
            *(f32x4*)((float*)(ms + MS_CBP) + ((size_t)kv * 32 + ch) * 256 + 4 * lane) = s; continue; }
        r -= I_CB;
        if (r < I_M) {
            const int e = r * 64 + lane; const int gi = e >> 12, dl = (e >> 8) & 15, cp = (e >> 4) & 15, c = e & 15;
            const float dt = __expf(F.in(8)[l * 16 + gi]);
            const float* are = F.in(9) + ((size_t)l * 16 + gi) * 64; const float* aim = F.in(10) + ((size_t)l * 16 + gi) * 64;
            const float* bre = F.in(11) + ((size_t)l * 16 + gi) * 64 * 16; const float* bim = F.in(12) + ((size_t)l * 16 + gi) * 64 * 16;
            const float* cre = F.in(13) + ((size_t)l * 16 + gi) * 16 * 64; const float* cim = F.in(14) + ((size_t)l * 16 + gi) * 16 * 64;
            float acc = 0.f;
            for (int n = 0; n < 64; ++n) {
                const float ar = are[n], ai = aim[n];
                const float x = dt * ar, y = dt * ai; float sy, cy; sincosf(y, &sy, &cy); float sh = sinf(0.5f * y);
                const float em1 = expm1f(x); const float nr = em1 * cy - 2.f * sh * sh; const float abi = (em1 + 1.f) * sy;
                const float den = ar * ar + ai * ai;
                const float fr_ = (nr * ar + abi * ai) / den, fi_ = (abi * ar - nr * ai) / den;
                const float br = bre[n * 16 + c], bi = bim[n * 16 + c];
                const float bbr = fr_ * br - fi_ * bi, bbi = fr_ * bi + fi_ * br;
                float sp, cpw; sincosf((float)dl * y, &sp, &cpw); const float mg = __expf((float)dl * x);
                const float pr = mg * cpw, pi = mg * sp;
                const float zr = pr * bbr - pi * bbi, zi = pr * bbi + pi * bbr;
                acc += cre[cp * 64 + n] * zr - cim[cp * 64 + n] * zi;
            }
            ((float*)(ms + MS_MTAB))[e] = acc; continue; }
        r -= I_M;
        {
            const int e = r * 64 + lane; const int gi = e >> 6, n = e & 63;
            const float dt = __expf(F.in(8)[l * 16 + gi]);
            const float ar = F.in(9)[((size_t)l * 16 + gi) * 64 + n], ai = F.in(10)[((size_t)l * 16 + gi) * 64 + n];
            const float x = dt * ar, y = dt * ai; float sy, cy; sincosf(y, &sy, &cy); const float sh = sinf(0.5f * y);
            const float em1 = expm1f(x); const float nr = em1 * cy - 2.f * sh * sh; const float abi = (em1 + 1.f) * sy;
            const float den = ar * ar + ai * ai;
            const float fr_ = (nr * ar + abi * ai) / den, fi_ = (abi * ar - nr * ai) / den;
            float s16, c16; sincosf(16.f * y, &s16, &c16); const float m16 = __expf(16.f * x);
            ((f32x2*)(ct + CT_AB16))[e] = (f32x2){m16 * c16, m16 * s16};
            float s1k, c1k; sincosf(1024.f * y, &s1k, &c1k); const float m1k = __expf(1024.f * x);
            ((f32x2*)(ct + CT_AB1K))[e] = (f32x2){m1k * c1k, m1k * s1k};
            const float* bre = F.in(11) + (((size_t)l * 16 + gi) * 64 + n) * 16; const float* bim = F.in(12) + (((size_t)l * 16 + gi) * 64 + n) * 16;
            f32x2* bb = (f32x2*)(ms + MS_BBAR) + (size_t)e * 16;
#pragma unroll
            for (int c = 0; c < 16; ++c) { const float br = bre[c], bi = bim[c]; bb[c] = (f32x2){fr_ * br - fi_ * bi, fr_ * bi + fi_ * br}; }
        }
    }
}

DI void prologue_b(Frame& F) {
    const int gt = F.gw * 64 + F.lane, ngt = F.ngw * 64;
    for (int l = 0; l < NL; ++l) {
        unsigned char* wl = F.wsp() + WS_W + (size_t)l * WL_STRIDE;
        unsigned char* ms = F.wsp() + WS_MISC + (size_t)l * MS_L;
        unsigned char* ct = F.wsp() + WS_CTL + CT_BASE + (size_t)l * CT_L;
        const float* MT = (const float*)(ms + MS_MTAB);
        const f32x2* BB = (const f32x2*)(ms + MS_BBAR);
        const float dtl_base = 0.f; (void)dtl_base;
        for (int e = gt; e < 16 * 512 * 256; e += ngt) {
            const int gi = e >> 17, n = (e >> 8) & 511, k = e & 255; float v = 0.f;
            if (n < 256) { const int tp = n >> 4, cp = n & 15, ta = k >> 4, c = k & 15; if (tp >= ta) v = MT[((gi * 16 + (tp - ta)) * 16 + cp) * 16 + c]; }
            else if (n < 384) { const int s = (n - 256) & 63, part = (n - 256) >> 6, ta = k >> 4, c = k & 15;
                const float dt = __expf(F.in(8)[l * 16 + gi]);
                const float ar = F.in(9)[((size_t)l * 16 + gi) * 64 + s], ai = F.in(10)[((size_t)l * 16 + gi) * 64 + s];
                const float pw = (float)(15 - ta); float sp, cpw; sincosf(pw * dt * ai, &sp, &cpw); const float mg = __expf(pw * dt * ar);
                const float pr = mg * cpw, pi = mg * sp; const f32x2 b = BB[((size_t)gi * 64 + s) * 16 + c];
                v = part ? (pr * b.y + pi * b.x) : (pr * b.x - pi * b.y); }
            ((bf16_t*)(wl + WO_SS1))[e] = f2bf(v);
        }
        for (int e = gt; e < 16 * 256 * 256; e += ngt) {
            const int gi = e >> 16, n = (e >> 8) & 255, k = e & 255; float v = 0.f;
            if (k < 128) { const int s = k & 63, part = k >> 6, ta = n >> 4, c = n & 15;
                const float dt = __expf(F.in(8)[l * 16 + gi]);
                const float ar = F.in(9)[((size_t)l * 16 + gi) * 64 + s], ai = F.in(10)[((size_t)l * 16 + gi) * 64 + s];
                const float pw = (float)(ta + 1); float sp, cpw; sincosf(pw * dt * ai, &sp, &cpw); const float mg = __expf(pw * dt * ar);
                const float pr = mg * cpw, pi = mg * sp;
                const float cr = F.in(13)[(((size_t)l * 16 + gi) * 16 + c) * 64 + s], ci = F.in(14)[(((size_t)l * 16 + gi) * 16 + c) * 64 + s];
                v = part ? -(cr * pi + ci * pr) : (cr * pr - ci * pi); }
            ((bf16_t*)(wl + WO_SS2))[e] = f2bf(v);
        }
        for (int e = gt; e < 512; e += ngt) { const int kv = e >> 8, n = e & 255; float s = F.in(5)[((size_t)l * 2 + kv) * 256 + n];
            const float* pp = (const float*)(ms + MS_CBP) + (size_t)kv * 32 * 256 + n;
            for (int ch = 0; ch < 32; ++ch) s += pp[ch * 256];
            ((float*)(ct + CT_CB1))[e] = s; }
    }
}

DI void rmsnorm_rows_bf16(Frame& F, const float* x, const float* g, bf16_t* o) {
    const f32x4* gp = (const f32x4*)g + F.lane; f32x4 gv[4];
#pragma unroll
    for (int j = 0; j < 4; ++j) gv[j] = gp[64 * j];
    for (int m = F.gw; m < NT; m += F.ngw) {
        const f32x4* xr = (const f32x4*)(x + (size_t)m * DM) + F.lane; f32x4 v[4]; float s = 0.f;
#pragma unroll
        for (int j = 0; j < 4; ++j) { v[j] = xr[64 * j]; s += (v[j].x * v[j].x + v[j].y * v[j].y) + (v[j].z * v[j].z + v[j].w * v[j].w); }
        const float rstd = rsqrtf(wave_sum(s) * (1.f / DM) + 1e-6f);
        u32x2* o8 = (u32x2*)(o + (size_t)m * DM) + F.lane;
#pragma unroll
        for (int j = 0; j < 4; ++j) { u32x2 w; w.x = pk2(v[j].x * rstd * gv[j].x, v[j].y * rstd * gv[j].y); w.y = pk2(v[j].z * rstd * gv[j].z, v[j].w * rstd * gv[j].w); o8[64 * j] = w; }
    }
}
DI void rmsnorm_rows_f32_inplace(Frame& F, float* x, const float* g) {
    const f32x4* gp = (const f32x4*)g + F.lane; f32x4 gv[4];
#pragma unroll
    for (int j = 0; j < 4; ++j) gv[j] = gp[64 * j];
    for (int m = F.gw; m < NT; m += F.ngw) {
        f32x4* xr = (f32x4*)(x + (size_t)m * DM) + F.lane; f32x4 v[4]; float s = 0.f;
#pragma unroll
        for (int j = 0; j < 4; ++j) { v[j] = xr[64 * j]; s += (v[j].x * v[j].x + v[j].y * v[j].y) + (v[j].z * v[j].z + v[j].w * v[j].w); }
        const float rstd = rsqrtf(wave_sum(s) * (1.f / DM) + 1e-6f);
#pragma unroll
        for (int j = 0; j < 4; ++j) xr[64 * j] = v[j] * rstd * gv[j];
    }
}
DI void mix_norm_rows(Frame& F, const bf16_t* oatt, const bf16_t* ossm, const float* gatt, const float* gssm, bf16_t* mixed) {
    for (int m = F.gw; m < NT; m += F.ngw) {
        const u32x2* ar = (const u32x2*)(oatt + (size_t)m * 768) + F.lane;
        float a[12]; float s = 0.f;
#pragma unroll
        for (int j = 0; j < 3; ++j) { const u32x2 w = ar[64 * j]; a[4 * j] = bflo(w.x); a[4 * j + 1] = bfhi(w.x); a[4 * j + 2] = bflo(w.y); a[4 * j + 3] = bfhi(w.y); }
#pragma unroll
        for (int j = 0; j < 12; ++j) s += a[j] * a[j];
        const float ra = rsqrtf(wave_sum(s) * (1.f / 768.f) + 1e-6f);
        const u32x2 sw = ((const u32x2*)(ossm + (size_t)m * 256))[F.lane];
        float b[4] = {bflo(sw.x), bfhi(sw.x), bflo(sw.y), bfhi(sw.y)};
        const float rs = rsqrtf(wave_sum(b[0] * b[0] + b[1] * b[1] + b[2] * b[2] + b[3] * b[3]) * (1.f / 256.f) + 1e-6f);
        u32x2* o8 = (u32x2*)(mixed + (size_t)m * DM);
#pragma unroll
        for (int j = 0; j < 3; ++j) { const f32x4 gv = ((const f32x4*)gatt)[64 * j + F.lane];
            u32x2 w; w.x = pk2(a[4 * j] * ra * gv.x, a[4 * j + 1] * ra * gv.y); w.y = pk2(a[4 * j + 2] * ra * gv.z, a[4 * j + 3] * ra * gv.w); o8[64 * j + F.lane] = w; }
        { const f32x4 gv = ((const f32x4*)gssm)[F.lane]; u32x2 w; w.x = pk2(b[0] * rs * gv.x, b[1] * rs * gv.y); w.y = pk2(b[2] * rs * gv.z, b[3] * rs * gv.w); o8[192 + F.lane] = w; }
    }
}

DI void vtranspose_phase(Frame& F, const bf16_t* proj, bf16_t* vts, bf16_t* vtw) {
    LAS bf16_t* scr = (LAS bf16_t*)(F.lds + F.wave * 8704);
    for (int it = F.gw; it < 2 * 6 * 256; it += F.ngw) {
        const int which = it / 1536, r = it % 1536, bh = r >> 8, tt = r & 255, b = bh / 3, h = bh % 3;
        const bf16_t* src = proj + ((size_t)(b * SEQ + 64 * tt)) * PW + (which ? C_VW : C_VS) + h * 64;
        bf16_t* dst = (which ? vtw : vts) + (size_t)bh * 64 * SEQ + 64 * tt;
#pragma unroll
        for (int i = 0; i < 8; ++i) { const int tk = i * 8 + (F.lane >> 3), d8 = F.lane & 7; const u32x4 w = *(const u32x4*)(src + (size_t)tk * PW + 8 * d8);
            LAS bf16_t* sp = scr + tk * 66 + 8 * d8; ((LAS unsigned*)sp)[0] = w.x; ((LAS unsigned*)sp)[1] = w.y; ((LAS unsigned*)sp)[2] = w.z; ((LAS unsigned*)sp)[3] = w.w; }
        asm volatile("s_waitcnt lgkmcnt(0)" ::: "memory");
#pragma unroll
        for (int i = 0; i < 8; ++i) { const int d = i * 8 + (F.lane >> 3), t8 = F.lane & 7; unsigned short e[8];
#pragma unroll
            for (int j = 0; j < 8; ++j) e[j] = scr[(8 * t8 + j) * 66 + d];
            u32x4 w; w.x = e[0] | ((unsigned)e[1] << 16); w.y = e[2] | ((unsigned)e[3] << 16); w.z = e[4] | ((unsigned)e[5] << 16); w.w = e[6] | ((unsigned)e[7] << 16);
            *(u32x4*)(dst + (size_t)d * SEQ + 8 * t8) = w; }
        asm volatile("s_waitcnt lgkmcnt(0)" ::: "memory");
    }
}

#define MFMA32(a, b, c) __builtin_amdgcn_mfma_f32_32x32x16_bf16((a), (b), (c), 0, 0, 0)
#define MFMA16(a, b, c) __builtin_amdgcn_mfma_f32_16x16x32_bf16((a), (b), (c), 0, 0, 0)

DI void compress2_phase(Frame& F, const bf16_t* hidc, const bf16_t* w2t, const float* b2  , bf16_t* kc, bf16_t* vct) {
    const int r = F.lane & 31, h = F.lane >> 5;
    for (int it = F.gw; it < 2 * 192; it += F.ngw) {
        const int kv = it / 192, rb = it % 192; const int R0 = kv * 6144 + rb * 32;
        f32x16 acc0, acc1;
#pragma unroll
        for (int i = 0; i < 16; ++i) { acc0[i] = 0.f; acc1[i] = 0.f; }
        const bf16_t* ap = hidc + (size_t)(R0 + r) * 256 + 8 * h; const bf16_t* bp = w2t + (size_t)kv * 64 * 256 + (size_t)r * 256 + 8 * h;
#pragma unroll 4
        for (int ks = 0; ks < 16; ++ks) { const bf16x8 a = *(const bf16x8*)(ap + 16 * ks); const bf16x8 b0 = *(const bf16x8*)(bp + 16 * ks), b1 = *(const bf16x8*)(bp + 32 * 256 + 16 * ks);
            acc0 = MFMA32(a, b0, acc0); acc1 = MFMA32(a, b1, acc1); }
        const int bh = rb >> 5, i0 = (rb & 31) * 32;
        const float bb0 = b2[kv * 64 + r], bb1 = b2[kv * 64 + 32 + r];
        if (kv == 0) {
#pragma unroll
            for (int i = 0; i < 16; ++i) { const int row = i0 + (i & 3) + 8 * (i >> 2) + 4 * h; bf16_t* o = kc + ((size_t)bh * 1024 + row) * 64;
                o[r] = f2bf(acc0[i] + bb0); o[32 + r] = f2bf(acc1[i] + bb1); }
        } else {
#pragma unroll
            for (int g4 = 0; g4 < 4; ++g4) { const int row = i0 + 8 * g4 + 4 * h;
                u32x2 w0, w1; w0.x = pk2(acc0[4 * g4] + bb0, acc0[4 * g4 + 1] + bb0); w0.y = pk2(acc0[4 * g4 + 2] + bb0, acc0[4 * g4 + 3] + bb0);
                w1.x = pk2(acc1[4 * g4] + bb1, acc1[4 * g4 + 1] + bb1); w1.y = pk2(acc1[4 * g4 + 2] + bb1, acc1[4 * g4 + 3] + bb1);
                *(u32x2*)(vct + ((size_t)bh * 64 + r) * 1024 + row) = w0; *(u32x2*)(vct + ((size_t)bh * 64 + 32 + r) * 1024 + row) = w1; }
        }
    }
}

DI void ssm_carry_phase(Frame& F, const float* hl, const f32x2* ab16, const f32x2* ab1k, bf16_t* hin) {
    LAS f32x2* E = (LAS f32x2*)F.lds;
    const int s = F.lane;
    for (int bg = F.bid; bg < 32; bg += F.G) {
        const int gi = bg & 15; const f32x2 a16 = ab16[gi * 64 + s], a1k = ab1k[gi * 64 + s];
        const float* hp = hl + (size_t)bg * 1024 * 128;
#pragma unroll 1
        for (int sg = 0; sg < 2; ++sg) { const int seg = 2 * F.wave + sg; float hr = 0.f, hi = 0.f;
#pragma unroll 8
            for (int c = 0; c < 64; ++c) { const float* q = hp + (size_t)(seg * 64 + c) * 128; const float lr = q[s], li = q[64 + s];
                const float nr = a16.x * hr - a16.y * hi + lr, ni = a16.x * hi + a16.y * hr + li; hr = nr; hi = ni; }
            E[seg * 64 + s] = (f32x2){hr, hi}; }
        __syncthreads();
#pragma unroll 1
        for (int sg = 0; sg < 2; ++sg) { const int seg = 2 * F.wave + sg; float hr = 0.f, hi = 0.f;
            for (int k = 0; k < seg; ++k) { const f32x2 e = E[k * 64 + s]; const float nr = a1k.x * hr - a1k.y * hi + e.x, ni = a1k.x * hi + a1k.y * hr + e.y; hr = nr; hi = ni; }
#pragma unroll 8
            for (int c = 0; c < 64; ++c) { const size_t row = (size_t)bg * 1024 + seg * 64 + c; const float* q = hp + (size_t)(seg * 64 + c) * 128; const float lr = q[s], li = q[64 + s];
                bf16_t* o = hin + row * 256; o[s] = f2bf(hr); o[64 + s] = f2bf(hi); ((unsigned*)(o + 128))[s] = 0u;
                const float nr = a16.x * hr - a16.y * hi + lr, ni = a16.x * hi + a16.y * hr + li; hr = nr; hi = ni; } }
        __syncthreads();
    }
}

constexpr int IMP_STRIDE = 257;
constexpr int LDS_IMP = 0, LDS_ACC = 64 * IMP_STRIDE * 4, LDS_SEL = 2 * 64 * IMP_STRIDE * 4, LDS_NSEL = LDS_SEL + 64 * 16 * 4;

DI void attn_unit(Frame& F, const bf16_t* proj, const bf16_t* kcb, const bf16_t* vctb, const bf16_t* vts, const bf16_t* vtw, bf16_t* oatt, int bh, int qb) {
    LAS float* IMP = (LAS float*)(F.lds + LDS_IMP); LAS float* ACC = (LAS float*)(F.lds + LDS_ACC); LAS int* SEL = (LAS int*)(F.lds + LDS_SEL);
    const int b = bh / 3, hkv = bh % 3, lane = F.lane, w = F.wave;
    const float NEG = -__builtin_inff();
    for (int i = F.tid; i < 64 * IMP_STRIDE; i += 512) IMP[i] = 0.f;
    __syncthreads();
    const int r32 = lane & 31, h = lane >> 5, gq = w & 3, qh = w >> 2;
    const int ql = 32 * qh + r32, t = 64 * qb + ql;
    const size_t trow = (size_t)(b * SEQ + t);
    const bf16_t* qrow = proj + trow * PW + C_Q + (hkv * 4 + gq) * 64;
    bf16x8 qf[4];
#pragma unroll
    for (int s = 0; s < 4; ++s) qf[s] = *(const bf16x8*)(qrow + 16 * s + 8 * h);
    const bf16_t* grow = proj + trow * PW + C_G + hkv * 12 + gq * 3;
    const float g0 = sigmoidf_(bf2f(grow[0])), g2 = sigmoidf_(bf2f(grow[2]));
    {
        const bf16_t* Kc = kcb + (size_t)bh * 1024 * 64; const bf16_t* VcT = vctb + (size_t)bh * 64 * 1024;
        const int ntile = (4 * qb + 3 + 31) >> 5;
        const int vis = (t - 31) >> 4;
        float m = NEG, lsum = 0.f;
        for (int kt = 0; kt < ntile; ++kt) {
            f32x16 sc;
#pragma unroll
            for (int i = 0; i < 16; ++i) sc[i] = 0.f;
            const bf16_t* kp = Kc + (size_t)(32 * kt + r32) * 64 + 8 * h;
#pragma unroll
            for (int s = 0; s < 4; ++s) { const bf16x8 a = *(const bf16x8*)(kp + 16 * s); sc = MFMA32(a, qf[s], sc); }
            float tm = NEG;
#pragma unroll
            for (int i = 0; i < 16; ++i) { const int ki = 32 * kt + (i & 3) + 8 * (i >> 2) + 4 * h; sc[i] = (ki <= vis) ? sc[i] : NEG; tm = fmaxf(tm, sc[i]); }
            const float mn = fmaxf(m, tm);
            if (mn > NEG) { float ps = 0.f;
#pragma unroll
                for (int i = 0; i < 16; ++i) ps += fexp2((sc[i] - mn) * L2E);
                lsum = lsum * fexp2((m - mn) * L2E) + ps; m = mn; }
        }
        const float m2 = __shfl_xor(m, 32), l2 = __shfl_xor(lsum, 32);
        float M = fmaxf(m, m2), Lt = 0.f;
        if (M > NEG) Lt = lsum * fexp2((m - M) * L2E) + l2 * fexp2((m2 - M) * L2E); else M = 0.f;
        const float inv = 1.0f / fmaxf(Lt, 1e-30f);
        f32x16 oc0, oc1;
#pragma unroll
        for (int i = 0; i < 16; ++i) { oc0[i] = 0.f; oc1[i] = 0.f; }
        for (int kt = 0; kt < ntile; ++kt) {
            f32x16 sc;
#pragma unroll
            for (int i = 0; i < 16; ++i) sc[i] = 0.f;
            const bf16_t* kp = Kc + (size_t)(32 * kt + r32) * 64 + 8 * h;
#pragma unroll
            for (int s = 0; s < 4; ++s) { const bf16x8 a = *(const bf16x8*)(kp + 16 * s); sc = MFMA32(a, qf[s], sc); }
#pragma unroll
            for (int i = 0; i < 16; ++i) { const int ki = 32 * kt + (i & 3) + 8 * (i >> 2) + 4 * h; sc[i] = (ki <= vis) ? fexp2((sc[i] - M) * L2E) * inv : 0.f; }
#pragma unroll
            for (int a = 0; a < 4; ++a) { const float G = (sc[4 * a] + sc[4 * a + 1]) + (sc[4 * a + 2] + sc[4 * a + 3]); const int j = 8 * kt + 2 * a + h;
                atomicAdd((float*)(IMP + ql * IMP_STRIDE + j), G); atomicAdd((float*)(IMP + ql * IMP_STRIDE + j + 1), sc[4 * a + 3]); }
#pragma unroll
            for (int s2 = 0; s2 < 2; ++s2) {
                u32x4 pw; pw.x = pk2(sc[8 * s2], sc[8 * s2 + 1]); pw.y = pk2(sc[8 * s2 + 2], sc[8 * s2 + 3]); pw.z = pk2(sc[8 * s2 + 4], sc[8 * s2 + 5]); pw.w = pk2(sc[8 * s2 + 6], sc[8 * s2 + 7]);
                const bf16x8 pb = __builtin_bit_cast(bf16x8, pw);
                const bf16_t* vp = VcT + (size_t)r32 * 1024 + 32 * kt + 16 * s2 + 4 * h;
                { const s16x4 lo = *(const s16x4*)vp, hi = *(const s16x4*)(vp + 8); const bf16x8 a = __builtin_shufflevector(lo, hi, 0, 1, 2, 3, 4, 5, 6, 7); oc0 = MFMA32(a, pb, oc0); }
                { const s16x4 lo = *(const s16x4*)(vp + 32 * 1024), hi = *(const s16x4*)(vp + 32 * 1024 + 8); const bf16x8 a = __builtin_shufflevector(lo, hi, 0, 1, 2, 3, 4, 5, 6, 7); oc1 = MFMA32(a, pb, oc1); }
            }
        }
        LAS float* ap = ACC + ql * IMP_STRIDE + gq * 64;
#pragma unroll
        for (int i = 0; i < 16; ++i) { const int d = (i & 3) + 8 * (i >> 2) + 4 * h; ap[d] = g0 * oc0[i]; ap[32 + d] = g0 * oc1[i]; }
    }
    __syncthreads();
    {
        const int cur = qb; const int c16 = lane & 15, kq = lane >> 4, hd = c16 & 3;
        for (int qi = 0; qi < 8; ++qi) {
            const int q = 8 * w + qi; const int tq = 64 * qb + q; int nsel;
            LAS int* sl = SEL + q * 16;
            if (cur + 1 <= 16) { nsel = cur + 1; if (lane < nsel) sl[lane] = lane; }
            else {
                nsel = 16; float v[4];
#pragma unroll
                for (int i = 0; i < 4; ++i) { const int j = 4 * lane + i; const float x = IMP[q * IMP_STRIDE + j]; v[i] = (j >= 1 && j <= cur - 2) ? x : -1.0f; }
                if (lane == 0) { sl[0] = 0; sl[1] = cur - 1; sl[2] = cur; }
                for (int k = 0; k < 13; ++k) {
                    const float lm = fmaxf(fmaxf(v[0], v[1]), fmaxf(v[2], v[3])); const float Mx = wave_max(lm);
                    const unsigned long long bal = __ballot(lm == Mx); const int L = __ffsll((long long)bal) - 1;
                    if (lane == L) { int ii = (v[0] == Mx) ? 0 : (v[1] == Mx) ? 1 : (v[2] == Mx) ? 2 : 3; sl[3 + k] = 4 * lane + ii;
                        v[0] = (ii == 0) ? -2.f : v[0]; v[1] = (ii == 1) ? -2.f : v[1]; v[2] = (ii == 2) ? -2.f : v[2]; v[3] = (ii == 3) ? -2.f : v[3]; }
                }
            }
            asm volatile("s_waitcnt lgkmcnt(0)" ::: "memory");
            const size_t qtrow = (size_t)(b * SEQ + tq);
            const bf16_t* qr = proj + qtrow * PW + C_Q + (hkv * 4 + hd) * 64 + 8 * kq;
            const bf16x8 qb0 = *(const bf16x8*)qr, qb1 = *(const bf16x8*)(qr + 32);
            float m = NEG, lsum = 0.f; f32x4 o[4];
#pragma unroll
            for (int i = 0; i < 4; ++i) o[i] = (f32x4){0.f, 0.f, 0.f, 0.f};
            for (int si = 0; si < nsel; ++si) {
                const int j = __builtin_amdgcn_readfirstlane(sl[si]);
                const bf16_t* kb = proj + ((size_t)(b * SEQ + 64 * j) + c16) * PW + C_KS + hkv * 64 + 8 * kq;
                f32x4 st[4];
#pragma unroll
                for (int rt = 0; rt < 4; ++rt) { st[rt] = (f32x4){0.f, 0.f, 0.f, 0.f}; const bf16_t* kr = kb + (size_t)(16 * rt) * PW;
                    const bf16x8 a0 = *(const bf16x8*)kr, a1 = *(const bf16x8*)(kr + 32); st[rt] = MFMA16(a0, qb0, st[rt]); st[rt] = MFMA16(a1, qb1, st[rt]); }
                float bm = NEG;
                if (j == cur) {
#pragma unroll
                    for (int rt = 0; rt < 4; ++rt)
#pragma unroll
                        for (int e = 0; e < 4; ++e) { const int pos = 64 * j + 16 * rt + 4 * kq + e; st[rt][e] = (pos <= tq) ? st[rt][e] : NEG; }
                }
#pragma unroll
                for (int rt = 0; rt < 4; ++rt)
#pragma unroll
                    for (int e = 0; e < 4; ++e) bm = fmaxf(bm, st[rt][e]);
                bm = fmaxf(bm, __shfl_xor(bm, 16)); bm = fmaxf(bm, __shfl_xor(bm, 32));
                const float mn = fmaxf(m, bm); const float ms = (mn > NEG) ? mn : 0.f;
                const float alpha = fexp2((m - ms) * L2E); float ps = 0.f;
#pragma unroll
                for (int rt = 0; rt < 4; ++rt)
#pragma unroll
                    for (int e = 0; e < 4; ++e) { st[rt][e] = fexp2((st[rt][e] - ms) * L2E); ps += st[rt][e]; }
                lsum = lsum * alpha + ps; m = mn;
#pragma unroll
                for (int i = 0; i < 4; ++i) o[i] *= alpha;
                const bf16_t* vb = vts + ((size_t)bh * 64 + c16) * SEQ + 64 * j + 4 * kq;
#pragma unroll
                for (int sp = 0; sp < 2; ++sp) {
                    u32x4 pw; pw.x = pk2(st[2 * sp][0], st[2 * sp][1]); pw.y = pk2(st[2 * sp][2], st[2 * sp][3]); pw.z = pk2(st[2 * sp + 1][0], st[2 * sp + 1][1]); pw.w = pk2(st[2 * sp + 1][2], st[2 * sp + 1][3]);
                    const bf16x8 pb = __builtin_bit_cast(bf16x8, pw);
#pragma unroll
                    for (int dt = 0; dt < 4; ++dt) { const bf16_t* vp = vb + (size_t)(16 * dt) * SEQ + 32 * sp;
                        const s16x4 lo = *(const s16x4*)vp, hi = *(const s16x4*)(vp + 16); const bf16x8 a = __builtin_shufflevector(lo, hi, 0, 1, 2, 3, 4, 5, 6, 7);
                        o[dt] = MFMA16(a, pb, o[dt]); }
                }
            }
            float Ls = lsum + __shfl_xor(lsum, 16); Ls += __shfl_xor(Ls, 32);
            const float invs = 1.0f / fmaxf(Ls, 1e-30f);
            if (c16 < 4) { const float g1 = sigmoidf_(bf2f(proj[qtrow * PW + C_G + hkv * 12 + c16 * 3 + 1])) * invs;
                LAS float* ap = ACC + q * IMP_STRIDE + c16 * 64 + 4 * kq;
#pragma unroll
                for (int dt = 0; dt < 4; ++dt)
#pragma unroll
                    for (int e = 0; e < 4; ++e) ap[16 * dt + e] += g1 * o[dt][e]; }
        }
    }
    __syncthreads();
    {
        const int t0w = 64 * qb + 32 * qh; const int kt_hi = t0w >> 5; const int kt_lo = (kt_hi - 16) > 0 ? (kt_hi - 16) : 0;
        const bf16_t* Kw = proj + (size_t)(b * SEQ) * PW + C_KW + hkv * 64; const bf16_t* Vt = vtw + (size_t)bh * 64 * SEQ;
        float m = NEG, lsum = 0.f; f32x16 o0, o1;
#pragma unroll
        for (int i = 0; i < 16; ++i) { o0[i] = 0.f; o1[i] = 0.f; }
        for (int kt = kt_lo; kt <= kt_hi; ++kt) {
            f32x16 sc;
#pragma unroll
            for (int i = 0; i < 16; ++i) sc[i] = 0.f;
            const bf16_t* kp = Kw + (size_t)(32 * kt + r32) * PW + 8 * h;
#pragma unroll
            for (int s = 0; s < 4; ++s) { const bf16x8 a = *(const bf16x8*)(kp + 16 * s); sc = MFMA32(a, qf[s], sc); }
            float tm = NEG;
#pragma unroll
            for (int i = 0; i < 16; ++i) { const int key = 32 * kt + (i & 3) + 8 * (i >> 2) + 4 * h; sc[i] = (key <= t && key > t - 512) ? sc[i] : NEG; tm = fmaxf(tm, sc[i]); }
            tm = fmaxf(tm, __shfl_xor(tm, 32));
            const float mn = fmaxf(m, tm); const float ms = (mn > NEG) ? mn : 0.f;
            const float alpha = fexp2((m - ms) * L2E); float ps = 0.f;
#pragma unroll
            for (int i = 0; i < 16; ++i) { sc[i] = fexp2((sc[i] - ms) * L2E); ps += sc[i]; }
            lsum = lsum * alpha + ps; m = mn;
#pragma unroll
            for (int i = 0; i < 16; ++i) { o0[i] *= alpha; o1[i] *= alpha; }
#pragma unroll
            for (int s2 = 0; s2 < 2; ++s2) {
                u32x4 pw; pw.x = pk2(sc[8 * s2], sc[8 * s2 + 1]); pw.y = pk2(sc[8 * s2 + 2], sc[8 * s2 + 3]); pw.z = pk2(sc[8 * s2 + 4], sc[8 * s2 + 5]); pw.w = pk2(sc[8 * s2 + 6], sc[8 * s2 + 7]);
                const bf16x8 pb = __builtin_bit_cast(bf16x8, pw);
                const bf16_t* vp = Vt + (size_t)r32 * SEQ + 32 * kt + 16 * s2 + 4 * h;
                { const s16x4 lo = *(const s16x4*)vp, hi = *(const s16x4*)(vp + 8); const bf16x8 a = __builtin_shufflevector(lo, hi, 0, 1, 2, 3, 4, 5, 6, 7); o0 = MFMA32(a, pb, o0); }
                { const s16x4 lo = *(const s16x4*)(vp + (size_t)32 * SEQ), hi = *(const s16x4*)(vp + (size_t)32 * SEQ + 8); const bf16x8 a = __builtin_shufflevector(lo, hi, 0, 1, 2, 3, 4, 5, 6, 7); o1 = MFMA32(a, pb, o1); }
            }
        }
        const float Lw = lsum + __shfl_xor(lsum, 32); const float gw = g2 / fmaxf(Lw, 1e-30f);
        const LAS float* ap = ACC + ql * IMP_STRIDE + gq * 64;
        bf16_t* op = oatt + trow * 768 + (hkv * 4 + gq) * 64;
#pragma unroll
        for (int g4 = 0; g4 < 4; ++g4) { const int d = 8 * g4 + 4 * h;
            u32x2 w0, w1;
            w0.x = pk2(ap[d] + gw * o0[4 * g4], ap[d + 1] + gw * o0[4 * g4 + 1]); w0.y = pk2(ap[d + 2] + gw * o0[4 * g4 + 2], ap[d + 3] + gw * o0[4 * g4 + 3]);
            w1.x = pk2(ap[32 + d] + gw * o1[4 * g4], ap[32 + d + 1] + gw * o1[4 * g4 + 1]); w1.y = pk2(ap[32 + d + 2] + gw * o1[4 * g4 + 2], ap[32 + d + 3] + gw * o1[4 * g4 + 3]);
            *(u32x2*)(op + d) = w0; *(u32x2*)(op + 32 + d) = w1; }
    }
}

DI void attn_phase(Frame& F, const bf16_t* proj, const bf16_t* kcb, const bf16_t* vctb, const bf16_t* vts, const bf16_t* vtw, bf16_t* oatt) {
    const int c = F.bid;
    for (int k = 0; k * F.G < 1536; ++k) {
        const int idx = k * F.G + ((k & 1) ? (F.G - 1 - c) : c);
        if (idx >= 1536) continue;
        const int qb = 255 - idx / 6, bh = idx % 6;
        attn_unit(F, proj, kcb, vctb, vts, vtw, oatt, bh, qb);
    }
    __syncthreads();
}

#define REFRESH() do { int w_ = wave0, b_ = blockIdx.x, g_ = gridDim.x; asm volatile("" : "+s"(w_), "+s"(b_), "+s"(g_)); \
    int l_; asm volatile("v_mbcnt_lo_u32_b32 %0, -1, 0\n\tv_mbcnt_hi_u32_b32 %0, -1, %0" : "=v"(l_)); \
    F.lane = l_; F.wave = w_; F.tid = w_ * 64 + l_; F.bid = b_; F.G = g_; F.gw = b_ * 8 + w_; F.ngw = g_ * 8; } while (0)
#define GSYNC() do { grid.sync(); REFRESH(); } while (0)
#define WSP(off) (F.wsp() + (off))
#define WL(off) (F.wsp() + WS_W + (size_t)l * WL_STRIDE + (off))
#define MSL(off) (F.wsp() + WS_MISC + (size_t)l * MS_L + (off))
#define CTL(off) (F.wsp() + WS_CTL + CT_BASE + (size_t)l * CT_L + (off))
__global__ void __launch_bounds__(512, 2) mk_fwd(Params p) {
    extern __shared__ __attribute__((aligned(16))) unsigned char lds_raw[];
    cg::grid_group grid = cg::this_grid();
    Frame F;
    F.lds = (LAS unsigned char*)lds_raw; F.pt = (LAS const unsigned long long*)(F.lds + LDS_PT);
    const int wave0 = __builtin_amdgcn_readfirstlane((int)threadIdx.x >> 6);
    REFRESH();
    {
        LAS unsigned long long* ptw = (LAS unsigned long long*)(F.lds + LDS_PT);
        if (F.tid < 26) ptw[F.tid] = (unsigned long long)p.in[F.tid];
        if (F.tid == 26) ptw[26] = (unsigned long long)p.out;
        if (F.tid == 27) ptw[27] = (unsigned long long)p.ws;
    }
    __syncthreads();

    prologue_a(F);
    GSYNC();
    prologue_b(F);
    rmsnorm_rows_bf16(F, F.in(0), F.in(1), (bf16_t*)WSP(WS_ACT));
    GSYNC();

#if STAGE >= 2
#pragma unroll 1
    for (int l = 0; l < NL; ++l) {
        if (l > 0) { rmsnorm_rows_bf16(F, F.out(), F.in(1) + (size_t)l * DM, (bf16_t*)WSP(WS_ACT)); GSYNC(); }
        REFRESH();
        { pg8::APlain g{(const char*)WSP(WS_ACT), (const char*)WL(WO_WIN), 1024}; pg8::StaticOrder S; S.init(NT / 256, PW / 256, F.G, F.bid);
          pg8::EpiBf16 E{(bf16_t*)WSP(WS_PROJ), PW}; pg8::gemm_phase<pg8::EpiBf16, pg8::APlain, true>(F.lds, g, S, E, F.tid); }
        GSYNC();
        vtranspose_phase(F, (const bf16_t*)WSP(WS_PROJ), (bf16_t*)WSP(WS_VTS), (bf16_t*)WSP(WS_VTW));
        __syncthreads(); REFRESH();
        REFRESH();
        { pg8::ACompress g{(const char*)WSP(WS_PROJ), (const char*)WL(WO_W1)}; pg8::StaticOrder S; S.init(48, 1, F.G, F.bid);
          pg8::EpiCmpHid E{(bf16_t*)WSP(WS_HIDC), (const float*)CTL(CT_CB1)}; pg8::gemm_phase<pg8::EpiCmpHid, pg8::ACompress, true>(F.lds, g, S, E, F.tid); }
        REFRESH();
        { pg8::ASsm1 g{(const char*)WSP(WS_PROJ), (const char*)WL(WO_SS1)}; pg8::StaticOrder S; S.init(128, 2, F.G, (F.bid + 64) % F.G);
          pg8::EpiSsm1 E{(float*)WSP(WS_YI), (float*)WSP(WS_HL)}; pg8::gemm_phase<pg8::EpiSsm1, pg8::ASsm1, true>(F.lds, g, S, E, F.tid); }
        GSYNC();
        compress2_phase(F, (const bf16_t*)WSP(WS_HIDC), (const bf16_t*)CTL(CT_W2T), F.in(7) + (size_t)l * 2 * 64, (bf16_t*)WSP(WS_KC), (bf16_t*)WSP(WS_VCT));
        __syncthreads(); REFRESH();
        ssm_carry_phase(F, (const float*)WSP(WS_HL), (const f32x2*)CTL(CT_AB16), (const f32x2*)CTL(CT_AB1K), (bf16_t*)WSP(WS_HIN));
        GSYNC();
        REFRESH();
        { pg8::ASsm2 g{(const char*)WSP(WS_HIN), (const char*)WL(WO_SS2)}; pg8::StaticOrder S; S.init(128, 1, F.G, F.bid);
          pg8::EpiSsm2 E{(const float*)WSP(WS_YI), (const bf16_t*)WSP(WS_PROJ), F.in(15) + (size_t)l * 256, (bf16_t*)WSP(WS_YS2)}; pg8::gemm_phase<pg8::EpiSsm2, pg8::ASsm2, true>(F.lds, g, S, E, F.tid); }
#if STAGE >= 3
        REFRESH();
        attn_phase(F, (const bf16_t*)WSP(WS_PROJ), (const bf16_t*)WSP(WS_KC), (const bf16_t*)WSP(WS_VCT), (const bf16_t*)WSP(WS_VTS), (const bf16_t*)WSP(WS_VTW), (bf16_t*)WSP(WS_OATT));
#else
        { unsigned* oz = (unsigned*)WSP(WS_OATT); for (size_t i = (size_t)F.bid * 512 + F.tid; i < (size_t)NT * 768 / 2; i += (size_t)F.G * 512) oz[i] = 0u; }
#endif
        GSYNC();
        REFRESH();
        { pg8::APlain g{(const char*)WSP(WS_YS2), (const char*)MSL(MS_WGLU), 256}; pg8::StaticOrder S; S.init(NT / 256, 2, F.G, F.bid);
          pg8::EpiGlu E{(bf16_t*)WSP(WS_OSSM), F.in(17) + (size_t)l * 512}; pg8::gemm_phase<pg8::EpiGlu, pg8::APlain, true>(F.lds, g, S, E, F.tid); }
        GSYNC();
        mix_norm_rows(F, (const bf16_t*)WSP(WS_OATT), (const bf16_t*)WSP(WS_OSSM), F.in(18) + (size_t)l * 768, F.in(19) + (size_t)l * 256, (bf16_t*)WSP(WS_ACT));
        GSYNC();
        REFRESH();
        { pg8::APlain g{(const char*)WSP(WS_ACT), (const char*)WL(WO_WOUT), 1024}; pg8::StaticOrder S; S.init(NT / 256, 4, F.G, F.bid);
          pg8::EpiResF32 E{(l == 0) ? F.in(0) : (const float*)F.out(), F.out()}; pg8::gemm_phase<pg8::EpiResF32, pg8::APlain, true>(F.lds, g, S, E, F.tid); }
        GSYNC();
#if STAGE >= 4
        rmsnorm_rows_bf16(F, F.out(), F.in(21) + (size_t)l * DM, (bf16_t*)WSP(WS_ACT));
        GSYNC();
        REFRESH();
        { pg8::APlain g{(const char*)WSP(WS_ACT), (const char*)WL(WO_WGU), 1024}; pg8::StaticOrder S; S.init(NT / 256, 22, F.G, F.bid);
          pg8::EpiSwiglu E{(bf16_t*)WSP(WS_PROJ)}; pg8::gemm_phase<pg8::EpiSwiglu, pg8::APlain, true>(F.lds, g, S, E, F.tid); }
        GSYNC();
        REFRESH();
        { pg8::APlain g{(const char*)WSP(WS_PROJ), (const char*)WL(WO_WD), DFF}; pg8::StaticOrder S; S.init(NT / 256, 4, F.G, F.bid);
          pg8::EpiResF32 E{(const float*)F.out(), F.out()}; pg8::gemm_phase<pg8::EpiResF32, pg8::APlain, true>(F.lds, g, S, E, F.tid); }
        GSYNC();
#endif
#if STAGE < 5
        break;
#endif
    }
    rmsnorm_rows_f32_inplace(F, F.out(), F.in(25));
#else
    {
        const float* x0 = F.in(0); const float* fg = F.in(25); float* X = F.out();
        for (int m = F.gw; m < NT; m += F.ngw) {
            const f32x4* xr = (const f32x4*)(x0 + (size_t)m * DM) + F.lane; f32x4 v[4]; float s = 0.f;
#pragma unroll
            for (int j = 0; j < 4; ++j) { v[j] = xr[64 * j]; s += (v[j].x * v[j].x + v[j].y * v[j].y) + (v[j].z * v[j].z + v[j].w * v[j].w); }
            const float rstd = rsqrtf(wave_sum(s) * (1.f / DM) + 1e-6f);
            f32x4* o = (f32x4*)(X + (size_t)m * DM) + F.lane;
#pragma unroll
            for (int j = 0; j < 4; ++j) o[64 * j] = v[j] * rstd * ((const f32x4*)fg)[64 * j + F.lane];
        }
    }
#endif
}

extern "C" void kernel_launch(void* const* d_in, const int* in_sizes, int n_in, void* d_out, int out_size, void* d_ws, size_t ws_size, hipStream_t stream) {
    static int grid_blocks = 0;
    if (grid_blocks == 0) {
        if (n_in != 26 || ws_size < WS_END) { fprintf(stderr, "kernel_launch: unexpected n_in %d or ws_size %zu (< %zu)\n", n_in, ws_size, (size_t)WS_END); grid_blocks = -1; return; }
        int dev = 0, cus = 0, per_cu = 0;
        hipGetDevice(&dev);
        hipDeviceGetAttribute(&cus, hipDeviceAttributeMultiprocessorCount, dev);
        hipFuncSetAttribute((const void*)mk_fwd, hipFuncAttributeMaxDynamicSharedMemorySize, LDS_BYTES);
        hipOccupancyMaxActiveBlocksPerMultiprocessor(&per_cu, (const void*)mk_fwd, 512, LDS_BYTES);
        if (per_cu < 1) { fprintf(stderr, "kernel_launch: occupancy query says %d blocks per CU\n", per_cu); per_cu = 1; }
        grid_blocks = cus;
        (void)hipGetLastError();
    }
    if (grid_blocks < 0) return;
    Params p{};
    for (int i = 0; i < 26; ++i) p.in[i] = (const float*)d_in[i];
    p.out = (float*)d_out; p.ws = (unsigned char*)d_ws;
    void* args[] = {&p};
    hipError_t e = hipLaunchCooperativeKernel((const void*)mk_fwd, dim3(grid_blocks), dim3(512), args, LDS_BYTES, stream);
    if (e != hipSuccess) fprintf(stderr, "cooperative launch failed: %s (grid %d)\n", hipGetErrorString(e), grid_blocks);
}
```

```cpp
#include <hip/hip_runtime.h>
#include <hip/hip_cooperative_groups.h>
#include <cstdio>
#include <cstdint>
namespace cg = cooperative_groups;

#ifndef STAGE
#define STAGE 99
#endif
#ifndef REP_ATTN
#define REP_ATTN 1
#endif
#ifndef REP_GU
#define REP_GU 1
#endif
#ifndef REP_INPROJ
#define REP_INPROJ 1
#endif
#ifndef REP_SYNC
#define REP_SYNC 1
#endif

#define DI __device__ __forceinline__
#define LAS __attribute__((address_space(3)))
typedef unsigned short bf16_t;
typedef short bf16x8 __attribute__((ext_vector_type(8)));
typedef short s16x4 __attribute__((ext_vector_type(4)));
typedef float f32x4 __attribute__((ext_vector_type(4)));
typedef float f32x2 __attribute__((ext_vector_type(2)));
typedef float f32x16 __attribute__((ext_vector_type(16)));
typedef unsigned u32x4 __attribute__((ext_vector_type(4)));
typedef unsigned u32x2 __attribute__((ext_vector_type(2)));
typedef __bf16 bf2_t __attribute__((ext_vector_type(2)));

DI unsigned pk2(float lo, float hi) { f32x2 v = {lo, hi}; return __builtin_bit_cast(unsigned, __builtin_convertvector(v, bf2_t)); }
DI bf16_t f2bf(float f) { return (bf16_t)(pk2(f, 0.f) & 0xffffu); }
DI float bf2f(bf16_t u) { return __uint_as_float((unsigned)u << 16); }
DI float bflo(unsigned w) { return __uint_as_float(w << 16); }
DI float bfhi(unsigned w) { return __uint_as_float(w & 0xffff0000u); }
DI float fexp2(float x) { return __builtin_amdgcn_exp2f(x); }
DI float sigmoidf_(float x) { return 1.0f / (1.0f + __expf(-x)); }
DI float gelu_tanh(float x) { const float y = 0.7978845608028654f * (x + 0.044715f * x * x * x); return x / (1.0f + __expf(-2.0f * y)); }
DI float wave_sum(float v) {
#pragma unroll
    for (int o = 1; o < 64; o <<= 1) v += __shfl_xor(v, o);
    return v;
}
DI float wave_max(float v) {
#pragma unroll
    for (int o = 1; o < 64; o <<= 1) v = fmaxf(v, __shfl_xor(v, o));
    return v;
}

constexpr int NB = 2, SEQ = 16384, DM = 1024, NT = NB * SEQ, NL = 2;
constexpr int PW = 2304;
constexpr int C_Q = 0, C_KC = 768, C_VC = 960, C_KS = 1152, C_VS = 1344, C_KW = 1536, C_VW = 1728, C_U = 1920, C_G = 2176;
constexpr int DFF = 2816;
constexpr float L2E = 1.4426950408889634f;

constexpr size_t MiB = 1u << 20;
constexpr size_t WS_CTL = 0;
constexpr size_t WS_W = 1 * MiB;
constexpr size_t WL_STRIDE = 32 * MiB;
constexpr size_t WO_WIN = 0;
constexpr size_t WO_WOUT = 5 * MiB;
constexpr size_t WO_WGU = 7 * MiB;
constexpr size_t WO_WD = 18 * MiB;
constexpr size_t WO_W1 = 24 * MiB;
constexpr size_t WO_SS1 = 26 * MiB;
constexpr size_t WO_SS2 = 30 * MiB;
constexpr size_t CT_L = 256 * 1024;
constexpr size_t CT_BASE = 64 * 1024;
constexpr size_t CT_AB16 = 0;
constexpr size_t CT_AB1K = 8 * 1024;
constexpr size_t CT_CB1 = 16 * 1024;
constexpr size_t CT_W2T = 20 * 1024;
constexpr size_t CT_WGLU = 84 * 1024;
constexpr size_t WS_ACT = WS_W + 2 * WL_STRIDE;
constexpr size_t WS_PROJ = WS_ACT + 64 * MiB;
constexpr size_t WS_OATT = WS_PROJ + 176 * MiB;
constexpr size_t WS_OSSM = WS_OATT + 48 * MiB;
constexpr size_t WS_YS2 = WS_OSSM + 16 * MiB;
constexpr size_t WS_YI = WS_YS2 + 16 * MiB;
constexpr size_t WS_HL = WS_YI + 32 * MiB;
constexpr size_t WS_HIN = WS_HL + 16 * MiB;
constexpr size_t WS_VTS = WS_HIN + 16 * MiB;
constexpr size_t WS_VTW = WS_VTS + 12 * MiB;
constexpr size_t WS_KC = WS_VTW + 12 * MiB;
constexpr size_t WS_VCT = WS_KC + 1 * MiB;
constexpr size_t WS_HIDC = WS_VCT + 1 * MiB;
constexpr size_t WS_MISC = WS_HIDC + 6 * MiB;
constexpr size_t WS_END = WS_MISC + 4 * MiB;
constexpr size_t MS_L = 2 * MiB;
constexpr size_t MS_MTAB = 0;
constexpr size_t MS_CBP = 256 * 1024;
constexpr size_t MS_WGLU = 512 * 1024;
constexpr size_t MS_BBAR = 1024 * 1024;
constexpr size_t MS_FTAB = 1024 * 1024 + 128 * 1024;

constexpr int LDS_BYTES = 143360;

struct Params { const float* in[26]; float* out; unsigned char* ws; };

namespace pg8 {
constexpr int BM = 256, BK = 64, HALF = 128, HTB = HALF * BK * 2, STAGE_BYTES = 8 * HTB, NXCD = 8, WGM = 8;
__host__ __device__ __forceinline__ int lds_byte(int r, int c) { const int st = (r >> 4) * 2 + (c >> 5), rr = r & 15, cc = c & 31, ob = rr * 64 + cc * 2; return st * 1024 + (ob ^ (((ob >> 9) & 1) << 5)); }
__host__ __device__ __forceinline__ void stage_rc(int b, int& R, int& C) { const int st = b / 1024, sb = b % 1024, swz = sb ^ (((sb >> 9) & 1) << 5); R = (st >> 1) * 16 + swz / 64; C = (st & 1) * 32 + (swz % 64) / 2; }
__host__ __device__ __forceinline__ int perm32(int rho) { const int n = rho >> 4, i = rho & 15; return 8 * (i >> 2) + 4 * n + (i & 3); }
struct Unit { int pm, pn; };
struct StaticOrder {
    int nM, nN, nwg, G, c;
    __device__ void init(int nM_, int nN_, int G_, int c_) { nM = nM_; nN = nN_; nwg = nM * nN; G = G_; c = c_; }
    __device__ bool next(int i, Unit& u) const {
        const long L = (long)i * G + c; if (L >= nwg) return false;
        int wgid = (int)L; { const int q = nwg / NXCD, r = nwg % NXCD, xcd = wgid % NXCD, off = wgid / NXCD; wgid = (xcd < r ? xcd * (q + 1) : r * (q + 1) + (xcd - r) * q) + off; }
        const int nig = WGM * nN, gid = wgid / nig, fm = gid * WGM, gsz = (nM - fm) < WGM ? (nM - fm) : WGM;
        u.pm = fm + ((wgid % nig) % gsz); u.pn = (wgid % nig) / gsz; return true;
    }
};

template <class Epi, class Addr, bool ALIGN_EPI>
__device__ __forceinline__ void gemm_phase(LAS unsigned char* lds, const Addr& g, const StaticOrder& S, const Epi& E, int tid) {
    asm volatile("" : "+v"(tid));
    const int wid = __builtin_amdgcn_readfirstlane(tid >> 6), lane = tid & 63, wr = wid >> 2, wc = wid & 3, fr = lane & 15, fq = lane >> 4;
    const int K = g.K(), nt = K / BK;
    unsigned voffA[2], voffB[2];
#pragma unroll
    for (int i = 0; i < 2; ++i) { int R, C; stage_rc(tid * 16 + i * 8192, R, C); const int Rb = Epi::PERM ? ((R & ~31) + perm32(R & 31)) : R;
        voffA[i] = (unsigned)R * g.a_row_bytes() + g.a_col_off(C); voffB[i] = (unsigned)(Rb * K + C) * 2u; }
    const size_t kstepA = g.a_kstep(), kstepB = (size_t)(BK * 2);
    const size_t hstepA = (size_t)HALF * g.a_row_bytes(), hstepB = (size_t)HALF * K * 2;
    const unsigned ldsw = (unsigned)wid * 1024u;
    const int aoff = lds_byte(wr * 64 + fr, fq * 8), boff = lds_byte(wc * 32 + fr, fq * 8);
#define PG8_SA(b, h) (((b) * 2 + (h)) * HTB)
#define PG8_SB(b, h) ((4 + (b) * 2 + (h)) * HTB)
#define PG8_STAGE(bufoff, gbase, voff) do { _Pragma("unroll") for (int _i = 0; _i < 2; ++_i) \
        __builtin_amdgcn_global_load_lds((const unsigned*)((const char*)(gbase) + (voff)[_i]), (LAS unsigned*)(lds + (bufoff) + ldsw + _i * 8192), 16, 0, 0); } while (0)
#define PG8_LDA(dst, b, h) do { _Pragma("unroll") for (int m = 0; m < 4; ++m) _Pragma("unroll") for (int k = 0; k < 2; ++k) dst[m][k] = *(const LAS bf16x8*)(lds + PG8_SA(b, h) + aoff + m * 2048 + k * 1024); } while (0)
#define PG8_LDB(dst, b, h) do { _Pragma("unroll") for (int n = 0; n < 2; ++n) _Pragma("unroll") for (int k = 0; k < 2; ++k) dst[n][k] = *(const LAS bf16x8*)(lds + PG8_SB(b, h) + boff + n * 2048 + k * 1024); } while (0)
#define PG8_MMA(ai, bj, At, Bt) do { __builtin_amdgcn_s_setprio(1); _Pragma("unroll") for (int m = 0; m < 4; ++m) _Pragma("unroll") for (int n = 0; n < 2; ++n) _Pragma("unroll") for (int k = 0; k < 2; ++k) \
        acc[ai][bj][m][n] = __builtin_amdgcn_mfma_f32_16x16x32_bf16(Bt[n][k], At[m][k], acc[ai][bj][m][n], 0, 0, 0); __builtin_amdgcn_s_setprio(0); } while (0)
#define PG8_WAIT_V(n) asm volatile("s_waitcnt vmcnt(" #n ")" ::: "memory")
#define PG8_WAIT_L(n) asm volatile("s_waitcnt lgkmcnt(" #n ")" ::: "memory")
#define PG8_BAR __builtin_amdgcn_s_barrier()
#define PG8_SCHED __builtin_amdgcn_sched_barrier(0)
    Unit cur, nxt; int ui = 0;
    if (!S.next(0, cur)) return;
    f32x4 acc[2][2][4][2];
#pragma unroll
    for (int a = 0; a < 2; ++a)
#pragma unroll
        for (int b = 0; b < 2; ++b)
#pragma unroll
            for (int m = 0; m < 4; ++m)
#pragma unroll
                for (int n = 0; n < 2; ++n) acc[a][b][m][n] = (f32x4){0.f, 0.f, 0.f, 0.f};
    bf16x8 At[4][2], B0[2][2], B1[2][2];
    const char* cA = g.a_base(cur); const char* cB = g.b_base(cur);
    PG8_STAGE(PG8_SB(0, 0), cB, voffB); PG8_STAGE(PG8_SB(0, 1), cB + hstepB, voffB); PG8_STAGE(PG8_SA(0, 0), cA, voffA); PG8_STAGE(PG8_SA(0, 1), cA + hstepA, voffA);
    if (wr == 1) PG8_BAR;
    PG8_WAIT_V(2); PG8_BAR;
    PG8_STAGE(PG8_SB(1, 0), cB + kstepB, voffB); PG8_STAGE(PG8_SA(1, 0), cA + kstepA, voffA); PG8_STAGE(PG8_SB(1, 1), cB + hstepB + kstepB, voffB);
    PG8_WAIT_V(6); PG8_BAR;
    for (;;) {
        const bool has_next = S.next(ui + 1, nxt);
        const char* nA = has_next ? g.a_base(nxt) : cA; const char* nB = has_next ? g.b_base(nxt) : cB;
        for (int t = 0; t < nt; t += 2) {
            const bool last = (t == nt - 2);
            const char* a1 = cA + (size_t)(t + 1) * kstepA;
            const char* a2 = last ? nA : cA + (size_t)(t + 2) * kstepA; const char* b2 = last ? nB : cB + (size_t)(t + 2) * kstepB;
            const char* a3 = a2 + kstepA; const char* b3 = b2 + kstepB;
            PG8_LDB(B0, 0, 0); PG8_LDB(B1, 0, 1); PG8_SCHED; PG8_LDA(At, 0, 0); PG8_STAGE(PG8_SA(1, 1), a1 + hstepA, voffA);
            PG8_WAIT_V(8); PG8_WAIT_L(0); PG8_BAR; PG8_MMA(0, 0, At, B0); PG8_MMA(0, 1, At, B1); PG8_BAR; PG8_SCHED;
            PG8_LDA(At, 0, 1); PG8_STAGE(PG8_SB(0, 0), b2, voffB); PG8_STAGE(PG8_SB(0, 1), b2 + hstepB, voffB); PG8_STAGE(PG8_SA(0, 0), a2, voffA);
            PG8_WAIT_V(8); PG8_WAIT_L(0); PG8_BAR; PG8_MMA(1, 0, At, B0); PG8_MMA(1, 1, At, B1); PG8_BAR; PG8_SCHED;
            PG8_LDB(B0, 1, 0); PG8_LDB(B1, 1, 1); PG8_SCHED; PG8_LDA(At, 1, 0); PG8_STAGE(PG8_SA(0, 1), a2 + hstepA, voffA);
            PG8_WAIT_V(8); PG8_WAIT_L(0); PG8_BAR; PG8_MMA(0, 0, At, B0); PG8_MMA(0, 1, At, B1); PG8_BAR; PG8_SCHED;
            PG8_LDA(At, 1, 1); PG8_STAGE(PG8_SB(1, 0), b3, voffB); PG8_STAGE(PG8_SB(1, 1), b3 + hstepB, voffB); PG8_STAGE(PG8_SA(1, 0), a3, voffA);
            PG8_WAIT_V(8); PG8_WAIT_L(0); PG8_BAR; PG8_MMA(1, 0, At, B0); PG8_MMA(1, 1, At, B1); PG8_BAR; PG8_SCHED;
        }
        if constexpr (ALIGN_EPI) { if (wr == 0) PG8_BAR; }
        E(acc, cur, wr, wc, fr, fq);
        if (!has_next) break;
#pragma unroll
        for (int a = 0; a < 2; ++a)
#pragma unroll
            for (int b = 0; b < 2; ++b)
#pragma unroll
                for (int m = 0; m < 4; ++m)
#pragma unroll
                    for (int n = 0; n < 2; ++n) acc[a][b][m][n] = (f32x4){0.f, 0.f, 0.f, 0.f};
        cur = nxt; cA = nA; cB = nB; ++ui;
        if constexpr (ALIGN_EPI) { if (wr == 1) PG8_BAR; }
    }
    PG8_WAIT_V(0);
    if constexpr (!ALIGN_EPI) { if (wr == 0) PG8_BAR; }
    PG8_BAR;
#undef PG8_SA
#undef PG8_SB
#undef PG8_STAGE
#undef PG8_LDA
#undef PG8_LDB
#undef PG8_MMA
#undef PG8_WAIT_V
#undef PG8_WAIT_L
#undef PG8_BAR
#undef PG8_SCHED
}

struct APlain {
    const char* A; const char* Bt; int k;
    DI int K() const { return k; }
    DI unsigned a_row_bytes() const { return (unsigned)k * 2u; }
    DI unsigned a_kstep() const { return 128u; }
    DI unsigned a_col_off(int C) const { return (unsigned)C * 2u; }
    DI const char* a_base(const Unit& u) const { return A + (size_t)u.pm * 256 * k * 2; }
    DI const char* b_base(const Unit& u) const { return Bt + (size_t)u.pn * 256 * k * 2; }
};
struct ACompress {
    const char* proj; const char* w1t;
    DI int K() const { return 2048; }
    DI unsigned a_row_bytes() const { return 16u * PW * 2u; }
    DI unsigned a_kstep() const { return (unsigned)PW * 2u; }
    DI unsigned a_col_off(int C) const { return (unsigned)C * 2u; }
    DI const char* a_base(const Unit& u) const { const int kv = u.pm / 24, r = u.pm % 24, bh = r >> 2, qt = r & 3, b = bh / 3, h = bh % 3;
        return proj + ((size_t)(b * SEQ + 4096 * qt) * PW + (kv ? C_VC : C_KC) + h * 64) * 2; }
    DI const char* b_base(const Unit& u) const { return w1t + (size_t)(u.pm / 24) * 256 * 2048 * 2; }
};
struct ASsm1 {
    const char* proj; const char* ss1;
    DI int K() const { return 256; }
    DI unsigned a_row_bytes() const { return 16u * PW * 2u; }
    DI unsigned a_kstep() const { return 4u * PW * 2u; }
    DI unsigned a_col_off(int C) const { return (unsigned)(C >> 4) * (PW * 2u) + (unsigned)(C & 15) * 2u; }
    DI const char* a_base(const Unit& u) const { const int bg = u.pm >> 2, qt = u.pm & 3, b = bg >> 4, gi = bg & 15;
        return proj + ((size_t)(b * SEQ + 4096 * qt) * PW + C_U + gi * 16) * 2; }
    DI const char* b_base(const Unit& u) const { const int gi = (u.pm >> 2) & 15; return ss1 + ((size_t)gi * 512 + (size_t)u.pn * 256) * 256 * 2; }
};
struct ASsm2 {
    const char* hin; const char* ss2;
    DI int K() const { return 256; }
    DI unsigned a_row_bytes() const { return 512u; }
    DI unsigned a_kstep() const { return 128u; }
    DI unsigned a_col_off(int C) const { return (unsigned)C * 2u; }
    DI const char* a_base(const Unit& u) const { return hin + (size_t)u.pm * 256 * 512; }
    DI const char* b_base(const Unit& u) const { const int gi = (u.pm >> 2) & 15; return ss2 + (size_t)gi * 256 * 256 * 2; }
};

struct EpiBf16 {
    static constexpr bool PERM = true;
    bf16_t* O; int ldc;
    DI void operator()(const f32x4 (&acc)[2][2][4][2], const Unit& u, int wr, int wc, int fr, int fq) const {
        const int row0 = u.pm * BM + wr * 64 + fr, col0 = u.pn * BM + wc * 32 + 8 * fq;
#pragma unroll
        for (int ai = 0; ai < 2; ++ai)
#pragma unroll
            for (int m = 0; m < 4; ++m) { bf16_t* rowp = O + (size_t)(row0 + ai * HALF + m * 16) * ldc + col0;
#pragma unroll
                for (int bj = 0; bj < 2; ++bj) { const f32x4 v0 = acc[ai][bj][m][0], v1 = acc[ai][bj][m][1];
                    u32x4 w; w.x = pk2(v0[0], v0[1]); w.y = pk2(v0[2], v0[3]); w.z = pk2(v1[0], v1[1]); w.w = pk2(v1[2], v1[3]);
                    *(u32x4*)(rowp + bj * HALF) = w; } }
    }
};
struct EpiCmpHid {
    static constexpr bool PERM = true;
    bf16_t* O; const float* cb1;
    DI void operator()(const f32x4 (&acc)[2][2][4][2], const Unit& u, int wr, int wc, int fr, int fq) const {
        const int row0 = u.pm * BM + wr * 64 + fr, col0 = wc * 32 + 8 * fq; const float* bb = cb1 + (u.pm / 24) * 256;
        f32x4 bv[2][2];
#pragma unroll
        for (int bj = 0; bj < 2; ++bj)
#pragma unroll
            for (int n = 0; n < 2; ++n) bv[bj][n] = *(const f32x4*)(bb + col0 + bj * HALF + 4 * n);
#pragma unroll
        for (int ai = 0; ai < 2; ++ai)
#pragma unroll
            for (int m = 0; m < 4; ++m) { bf16_t* rowp = O + (size_t)(row0 + ai * HALF + m * 16) * 256 + col0;
#pragma unroll
                for (int bj = 0; bj < 2; ++bj) { f32x4 v0 = acc[ai][bj][m][0] + bv[bj][0], v1 = acc[ai][bj][m][1] + bv[bj][1];
#pragma unroll
                    for (int e = 0; e < 4; ++e) { v0[e] = gelu_tanh(v0[e]); v1[e] = gelu_tanh(v1[e]); }
                    u32x4 w; w.x = pk2(v0[0], v0[1]); w.y = pk2(v0[2], v0[3]); w.z = pk2(v1[0], v1[1]); w.w = pk2(v1[2], v1[3]);
                    *(u32x4*)(rowp + bj * HALF) = w; } }
    }
};
struct EpiSsm1 {
    static constexpr bool PERM = false;
    float* YI; float* HL;
    DI void operator()(const f32x4 (&acc)[2][2][4][2], const Unit& u, int wr, int wc, int fr, int fq) const {
        const int row0 = u.pm * BM + wr * 64 + fr, col0 = wc * 32 + 4 * fq;
#pragma unroll
        for (int ai = 0; ai < 2; ++ai)
#pragma unroll
            for (int m = 0; m < 4; ++m) { const size_t row = (size_t)(row0 + ai * HALF + m * 16);
                if (u.pn == 0) {
#pragma unroll
                    for (int bj = 0; bj < 2; ++bj)
#pragma unroll
                        for (int n = 0; n < 2; ++n) *(f32x4*)(YI + row * 256 + col0 + bj * HALF + n * 16) = acc[ai][bj][m][n];
                } else {
#pragma unroll
                    for (int n = 0; n < 2; ++n) *(f32x4*)(HL + row * 128 + col0 + n * 16) = acc[ai][0][m][n];
                } }
    }
};
struct EpiSsm2 {
    static constexpr bool PERM = false;
    const float* YI; const bf16_t* proj; const float* dskip; bf16_t* YS2;
    DI void operator()(const f32x4 (&acc)[2][2][4][2], const Unit& u, int wr, int wc, int fr, int fq) const {
        const int row0 = u.pm * BM + wr * 64 + fr, col0 = wc * 32 + 4 * fq;
        const int bg = u.pm >> 2, b = bg >> 4, gi = bg & 15;
        const f32x4 dsk = *(const f32x4*)(dskip + gi * 16 + 4 * fq);
#pragma unroll
        for (int ai = 0; ai < 2; ++ai)
#pragma unroll
            for (int m = 0; m < 4; ++m) { const int row = row0 + ai * HALF + m * 16; const int chunk = row & 1023;
#pragma unroll
                for (int bj = 0; bj < 2; ++bj)
#pragma unroll
                    for (int n = 0; n < 2; ++n) { const int col = col0 + bj * HALF + n * 16, tau = col >> 4;
                        const size_t tok = (size_t)b * SEQ + chunk * 16 + tau;
                        const f32x4 yi = *(const f32x4*)(YI + (size_t)row * 256 + col);
                        const u32x2 uw = *(const u32x2*)(proj + tok * PW + C_U + gi * 16 + 4 * fq);
                        f32x4 y = acc[ai][bj][m][n] + yi;
                        y[0] += dsk[0] * bflo(uw.x); y[1] += dsk[1] * bfhi(uw.x); y[2] += dsk[2] * bflo(uw.y); y[3] += dsk[3] * bfhi(uw.y);
                        u32x2 w; w.x = pk2(gelu_tanh(y[0]), gelu_tanh(y[1])); w.y = pk2(gelu_tanh(y[2]), gelu_tanh(y[3]));
                        *(u32x2*)(YS2 + tok * 256 + gi * 16 + 4 * fq) = w; } }
    }
};
struct EpiGlu {
    static constexpr bool PERM = true;
    bf16_t* O; const float* bglu;
    DI void operator()(const f32x4 (&acc)[2][2][4][2], const Unit& u, int wr, int wc, int fr, int fq) const {
        const int row0 = u.pm * BM + wr * 64 + fr, col0 = u.pn * HALF + wc * 32 + 8 * fq;
        f32x4 bvv[2], bgg[2];
#pragma unroll
        for (int n = 0; n < 2; ++n) { bvv[n] = *(const f32x4*)(bglu + col0 + 4 * n); bgg[n] = *(const f32x4*)(bglu + 256 + col0 + 4 * n); }
#pragma unroll
        for (int ai = 0; ai < 2; ++ai)
#pragma unroll
            for (int m = 0; m < 4; ++m) { bf16_t* rowp = O + (size_t)(row0 + ai * HALF + m * 16) * 256 + col0;
                f32x4 o[2];
#pragma unroll
                for (int n = 0; n < 2; ++n) { const f32x4 v = acc[ai][0][m][n] + bvv[n], gt = acc[ai][1][m][n] + bgg[n];
#pragma unroll
                    for (int e = 0; e < 4; ++e) o[n][e] = v[e] * sigmoidf_(gt[e]); }
                u32x4 w; w.x = pk2(o[0][0], o[0][1]); w.y = pk2(o[0][2], o[0][3]); w.z = pk2(o[1][0], o[1][1]); w.w = pk2(o[1][2], o[1][3]);
                *(u32x4*)rowp = w; }
    }
};
struct EpiSwiglu {
    static constexpr bool PERM = true;
    bf16_t* O;
    DI void operator()(const f32x4 (&acc)[2][2][4][2], const Unit& u, int wr, int wc, int fr, int fq) const {
        const int row0 = u.pm * BM + wr * 64 + fr, col0 = u.pn * HALF + wc * 32 + 8 * fq;
#pragma unroll
        for (int ai = 0; ai < 2; ++ai)
#pragma unroll
            for (int m = 0; m < 4; ++m) { bf16_t* rowp = O + (size_t)(row0 + ai * HALF + m * 16) * DFF + col0;
                f32x4 o[2];
#pragma unroll
                for (int n = 0; n < 2; ++n) { const f32x4 gt = acc[ai][0][m][n], up = acc[ai][1][m][n];
#pragma unroll
                    for (int e = 0; e < 4; ++e) o[n][e] = gt[e] * sigmoidf_(gt[e]) * up[e]; }
                u32x4 w; w.x = pk2(o[0][0], o[0][1]); w.y = pk2(o[0][2], o[0][3]); w.z = pk2(o[1][0], o[1][1]); w.w = pk2(o[1][2], o[1][3]);
                *(u32x4*)rowp = w; }
    }
};
struct EpiResF32 {
    static constexpr bool PERM = false;
    const float* base; float* out;
    DI void operator()(const f32x4 (&acc)[2][2][4][2], const Unit& u, int wr, int wc, int fr, int fq) const {
        const int row0 = u.pm * BM + wr * 64 + fr, col0 = u.pn * BM + wc * 32 + 4 * fq;
#pragma unroll
        for (int ai = 0; ai < 2; ++ai)
#pragma unroll
            for (int m = 0; m < 4; ++m) { const size_t off = (size_t)(row0 + ai * HALF + m * 16) * DM + col0;
#pragma unroll
                for (int bj = 0; bj < 2; ++bj)
#pragma unroll
                    for (int n = 0; n < 2; ++n) { const f32x4 bs = *(const f32x4*)(base + off + bj * HALF + n * 16);
                        *(f32x4*)(out + off + bj * HALF + n * 16) = bs + acc[ai][bj][m][n]; } }
    }
};
}

struct Frame {
    LAS unsigned char* lds;
    LAS const unsigned long long* pt;
    int tid, lane, wave, G, gw, ngw, bid;
    DI const float* in(int i) const { const unsigned long long v = pt[i]; const unsigned lo = __builtin_amdgcn_readfirstlane((unsigned)v), hi = __builtin_amdgcn_readfirstlane((unsigned)(v >> 32));
        return (const float*)(((unsigned long long)hi << 32) | lo); }
    DI float* out() const { return (float*)in(26); }
    DI unsigned char* wsp() const { return (unsigned char*)in(27); }
};
constexpr int LDS_PT = LDS_BYTES - 256;

DI void transpose_item(const float* W, int K, int ldw, int nvalid, bf16_t* WT, int drow0, LAS float* scr, int k0, int n0, float scale, int lane) {
    const int nn = n0 + (lane & 31); const bool ok = nn < nvalid;
#pragma unroll 8
    for (int i = 0; i < 32; ++i) { const int kk = 2 * i + (lane >> 5); scr[kk * 33 + (lane & 31)] = ok ? W[(size_t)(k0 + kk) * ldw + nn] * scale : 0.f; }
    asm volatile("s_waitcnt lgkmcnt(0)" ::: "memory");
    const int c = lane & 7;
#pragma unroll
    for (int j = 0; j < 4; ++j) { const int n = (lane >> 3) + 8 * j; const LAS float* s = scr + (8 * c) * 33 + n;
        u32x4 o; o.x = pk2(s[0 * 33], s[1 * 33]); o.y = pk2(s[2 * 33], s[3 * 33]); o.z = pk2(s[4 * 33], s[5 * 33]); o.w = pk2(s[6 * 33], s[7 * 33]);
        *(u32x4*)(WT + (size_t)(drow0 + n) * K + k0 + 8 * c) = o; }
    asm volatile("s_waitcnt lgkmcnt(0)" ::: "memory");
}

DI int win_dest_row(int n) {
    if (n < 1920) return n;
    if (n < 1956) return C_G + (n - 1920);
    return C_U + (n - 1956);
}

DI void prologue_a(Frame& F) {
    LAS float* scr = (LAS float*)(F.lds + F.wave * 8704);
    constexpr int I_WIN = 16 * 72, I_WOUT = 16 * 32, I_WG = 16 * 88, I_WD = 44 * 32, I_W1 = 2 * 32 * 8, I_WGLU = 4 * 16, I_W2 = 2 * 4 * 2, I_CB = 64, I_M = 1024, I_TAB = 16;
    constexpr int PER_L = I_WIN + I_WOUT + 2 * I_WG + I_WD + I_W1 + I_WGLU + I_W2 + I_CB + I_M + I_TAB;
    const int lane = F.lane;
    for (int it = F.gw; it < NL * PER_L; it += F.ngw) {
        const int l = it / PER_L; int r = it % PER_L;
        unsigned char* wl = F.wsp() + WS_W + (size_t)l * WL_STRIDE;
        unsigned char* ms = F.wsp() + WS_MISC + (size_t)l * MS_L;
        unsigned char* ct = F.wsp() + WS_CTL + CT_BASE + (size_t)l * CT_L;
        if (r < I_WIN) {
            const int kb = r / 72, nb = r % 72, k0 = 64 * kb, n0 = 32 * nb;
            const float* W = F.in(2) + (size_t)l * 1024 * 2212;
            bf16_t* WT = (bf16_t*)(wl + WO_WIN);
            if (n0 + 32 <= 1920) { transpose_item(W, 1024, 2212, 2212, WT, n0, scr, k0, n0, n0 < 768 ? 0.125f : 1.0f, lane); }
            else {
                const int d = n0 + (lane & 31);
                int srcn = -1;
                if (d < 1920) srcn = d; else if (d >= C_U && d < C_U + 256) srcn = 1956 + (d - C_U); else if (d >= C_G && d < C_G + 36) srcn = 1920 + (d - C_G);
#pragma unroll 8
                for (int i = 0; i < 32; ++i) { const int kk = 2 * i + (lane >> 5); scr[kk * 33 + (lane & 31)] = srcn >= 0 ? W[(size_t)(k0 + kk) * 2212 + srcn] : 0.f; }
                asm volatile("s_waitcnt lgkmcnt(0)" ::: "memory");
                const int c = lane & 7;
#pragma unroll
                for (int j = 0; j < 4; ++j) { const int n = (lane >> 3) + 8 * j; const LAS float* s = scr + (8 * c) * 33 + n;
                    u32x4 o; o.x = pk2(s[0 * 33], s[1 * 33]); o.y = pk2(s[2 * 33], s[3 * 33]); o.z = pk2(s[4 * 33], s[5 * 33]); o.w = pk2(s[6 * 33], s[7 * 33]);
                    *(u32x4*)(WT + (size_t)(n0 + n) * 1024 + k0 + 8 * c) = o; }
                asm volatile("s_waitcnt lgkmcnt(0)" ::: "memory");
            }
            continue; }
        r -= I_WIN;
        if (r < I_WOUT) { const int kb = r / 32, nb = r % 32; transpose_item(F.in(20) + (size_t)l * 1024 * 1024, 1024, 1024, 1024, (bf16_t*)(wl + WO_WOUT), 32 * nb, scr, 64 * kb, 32 * nb, 1.f, lane); continue; }
        r -= I_WOUT;
        if (r < 2 * I_WG) { const int up = r / I_WG; const int rr = r % I_WG; const int kb = rr / 88, nb = rr % 88, n0 = 32 * nb;
            const int drow = (n0 / 128) * 256 + up * 128 + (n0 % 128);
            transpose_item(F.in(up ? 23 : 22) + (size_t)l * 1024 * DFF, 1024, DFF, DFF, (bf16_t*)(wl + WO_WGU), drow, scr, 64 * kb, n0, 1.f, lane); continue; }
        r -= 2 * I_WG;
        if (r < I_WD) { const int kb = r / 32, nb = r % 32; transpose_item(F.in(24) + (size_t)l * DFF * 1024, DFF, 1024, 1024, (bf16_t*)(wl + WO_WD), 32 * nb, scr, 64 * kb, 32 * nb, 1.f, lane); continue; }
        r -= I_WD;
        if (r < I_W1) { const int kv = r / 256; const int rr = r % 256; const int kb = rr / 8, nb = rr % 8;
            transpose_item(F.in(4) + ((size_t)l * 2 + kv) * 2048 * 256, 2048, 256, 256, (bf16_t*)(wl + WO_W1) + (size_t)kv * 256 * 2048, 32 * nb, scr, 64 * kb, 32 * nb, 1.f, lane); continue; }
        r -= I_W1;
        if (r < I_WGLU) { const int kb = r / 16, nb = r % 16, n0 = 32 * nb; const int gate = n0 >= 256, nn = n0 & 255;
            const int drow = (nn / 128) * 256 + gate * 128 + (nn % 128);
            transpose_item(F.in(16) + (size_t)l * 256 * 512, 256, 512, 512, (bf16_t*)(ms + MS_WGLU), drow, scr, 64 * kb, n0, 1.f, lane); continue; }
        r -= I_WGLU;
        if (r < I_W2) { const int kv = r / 8; const int rr = r % 8; const int kb = rr / 2, nb = rr % 2;
            transpose_item(F.in(6) + ((size_t)l * 2 + kv) * 256 * 64, 256, 64, 64, (bf16_t*)(ct + CT_W2T) + (size_t)kv * 64 * 256, 32 * nb, scr, 64 * kb, 32 * nb, 1.f, lane); continue; }
        r -= I_W2;
        if (r < I_CB) {
            const int kv = r / 32, ch = r % 32; const float* pe = F.in(3) + ((size_t)l * 2 + kv) * 2048; const float* w1 = F.in(4) + ((size_t)l * 2 + kv) * 2048 * 256;
            f32x4 s = {0.f, 0.f, 0.f, 0.f};
#pragma unroll 8
            for (int i = 0; i < 64; ++i) { const int k = 64 * ch + i; const float pv = pe[k]; const f32x4 w = *(const f32x4*)(w1 + (size_t)k * 256 + 4 * lane); s += w * pv; }
            *(f32x4*)((float*)(ms + MS_CBP) + ((size_t)kv * 32 + ch) * 256 + 4 * lane) = s; continue; }
        r -= I_CB;
        if (r < I_M) {
            const int e = r * 64 + lane; const int gi = e >> 12, dl = (e >> 8) & 15, cp = (e >> 4) & 15, c = e & 15;
            const float dt = __expf(F.in(8)[l * 16 + gi]);
            const float* are = F.in(9) + ((size_t)l * 16 + gi) * 64; const float* aim = F.in(10) + ((size_t)l * 16 + gi) * 64;
            const float* bre = F.in(11) + ((size_t)l * 16 + gi) * 64 * 16; const float* bim = F.in(12) + ((size_t)l * 16 + gi) * 64 * 16;
            const float* cre = F.in(13) + ((size_t)l * 16 + gi) * 16 * 64; const float* cim = F.in(14) + ((size_t)l * 16 + gi) * 16 * 64;
            float acc = 0.f;
            for (int n = 0; n < 64; ++n) {
                const float ar = are[n], ai = aim[n];
                const float x = dt * ar, y = dt * ai; float sy, cy; sincosf(y, &sy, &cy); float sh = sinf(0.5f * y);
                const float em1 = expm1f(x); const float nr = em1 * cy - 2.f * sh * sh; const float abi = (em1 + 1.f) * sy;
                const float den = ar * ar + ai * ai;
                const float fr_ = (nr * ar + abi * ai) / den, fi_ = (abi * ar - nr * ai) / den;
                const float br = bre[n * 16 + c], bi = bim[n * 16 + c];
                const float bbr = fr_ * br - fi_ * bi, bbi = fr_ * bi + fi_ * br;
                float sp, cpw; sincosf((float)dl * y, &sp, &cpw); const float mg = __expf((float)dl * x);
                const float pr = mg * cpw, pi = mg * sp;
                const float zr = pr * bbr - pi * bbi, zi = pr * bbi + pi * bbr;
                acc += cre[cp * 64 + n] * zr - cim[cp * 64 + n] * zi;
            }
            ((float*)(ms + MS_MTAB))[e] = acc; continue; }
        r -= I_M;
        {
            const int e = r * 64 + lane; const int gi = e >> 6, n = e & 63;
            const float dt = __expf(F.in(8)[l * 16 + gi]);
            const float ar = F.in(9)[((size_t)l * 16 + gi) * 64 + n], ai = F.in(10)[((size_t)l * 16 + gi) * 64 + n];
            const float x = dt * ar, y = dt * ai; float sy, cy; sincosf(y, &sy, &cy); const float sh = sinf(0.5f * y);
            const float em1 = expm1f(x); const float nr = em1 * cy - 2.f * sh * sh; const float abi = (em1 + 1.f) * sy;
            const float den = ar * ar + ai * ai;
            const float fr_ = (nr * ar + abi * ai) / den, fi_ = (abi * ar - nr * ai) / den;
            float s16, c16; sincosf(16.f * y, &s16, &c16); const float m16 = __expf(16.f * x);
            ((f32x2*)(ct + CT_AB16))[e] = (f32x2){m16 * c16, m16 * s16};
            float s1k, c1k; sincosf(1024.f * y, &s1k, &c1k); const float m1k = __expf(1024.f * x);
            ((f32x2*)(ct + CT_AB1K))[e] = (f32x2){m1k * c1k, m1k * s1k};
            const float* bre = F.in(11) + (((size_t)l * 16 + gi) * 64 + n) * 16; const float* bim = F.in(12) + (((size_t)l * 16 + gi) * 64 + n) * 16;
            f32x2* bb = (f32x2*)(ms + MS_BBAR) + (size_t)e * 16;
#pragma unroll
            for (int c = 0; c < 16; ++c) { const float br = bre[c], bi = bim[c]; bb[c] = (f32x2){fr_ * br - fi_ * bi, fr_ * bi + fi_ * br}; }
        }
    }
}

DI void prologue_b(Frame& F) {
    const int gt = F.gw * 64 + F.lane, ngt = F.ngw * 64;
    for (int l = 0; l < NL; ++l) {
        unsigned char* wl = F.wsp() + WS_W + (size_t)l * WL_STRIDE;
        unsigned char* ms = F.wsp() + WS_MISC + (size_t)l * MS_L;
        unsigned char* ct = F.wsp() + WS_CTL + CT_BASE + (size_t)l * CT_L;
        const float* MT = (const float*)(ms + MS_MTAB);
        const f32x2* BB = (const f32x2*)(ms + MS_BBAR);
        const float dtl_base = 0.f; (void)dtl_base;
        for (int e = gt; e < 16 * 512 * 256; e += ngt) {
            const int gi = e >> 17, n = (e >> 8) & 511, k = e & 255; float v = 0.f;
            if (n < 256) { const int tp = n >> 4, cp = n & 15, ta = k >> 4, c = k & 15; if (tp >= ta) v = MT[((gi * 16 + (tp - ta)) * 16 + cp) * 16 + c]; }
            else if (n < 384) { const int s = (n - 256) & 63, part = (n - 256) >> 6, ta = k >> 4, c = k & 15;
                const float dt = __expf(F.in(8)[l * 16 + gi]);
                const float ar = F.in(9)[((size_t)l * 16 + gi) * 64 + s], ai = F.in(10)[((size_t)l * 16 + gi) * 64 + s];
                const float pw = (float)(15 - ta); float sp, cpw; sincosf(pw * dt * ai, &sp, &cpw); const float mg = __expf(pw * dt * ar);
                const float pr = mg * cpw, pi = mg * sp; const f32x2 b = BB[((size_t)gi * 64 + s) * 16 + c];
                v = part ? (pr * b.y + pi * b.x) : (pr * b.x - pi * b.y); }
            ((bf16_t*)(wl + WO_SS1))[e] = f2bf(v);
        }
        for (int e = gt; e < 16 * 256 * 256; e += ngt) {
            const int gi = e >> 16, n = (e >> 8) & 255, k = e & 255; float v = 0.f;
            if (k < 128) { const int s = k & 63, part = k >> 6, ta = n >> 4, c = n & 15;
                const float dt = __expf(F.in(8)[l * 16 + gi]);
                const float ar = F.in(9)[((size_t)l * 16 + gi) * 64 + s], ai = F.in(10)[((size_t)l * 16 + gi) * 64 + s];
                const float pw = (float)(ta + 1); float sp, cpw; sincosf(pw * dt * ai, &sp, &cpw); const float mg = __expf(pw * dt * ar);
                const float pr = mg * cpw, pi = mg * sp;
                const float cr = F.in(13)[(((size_t)l * 16 + gi) * 16 + c) * 64 + s], ci = F.in(14)[(((size_t)l * 16 + gi) * 16 + c) * 64 + s];
                v = part ? -(cr * pi + ci * pr) : (cr * pr - ci * pi); }
            ((bf16_t*)(wl + WO_SS2))[e] = f2bf(v);
        }
        for (int e = gt; e < 512; e += ngt) { const int kv = e >> 8, n = e & 255; float s = F.in(5)[((size_t)l * 2 + kv) * 256 + n];
            const float* pp = (const float*)(ms + MS_CBP) + (size_t)kv * 32 * 256 + n;
            for (int ch = 0; ch < 32; ++ch) s += pp[ch * 256];
            ((float*)(ct + CT_CB1))[e] = s; }
    }
}

DI void rmsnorm_rows_bf16(Frame& F, const float* x, const float* g, bf16_t* o) {
    const f32x4* gp = (const f32x4*)g + F.lane; f32x4 gv[4];
#pragma unroll
    for (int j = 0; j < 4; ++j) gv[j] = gp[64 * j];
    for (int m = F.gw; m < NT; m += F.ngw) {
        const f32x4* xr = (const f32x4*)(x + (size_t)m * DM) + F.lane; f32x4 v[4]; float s = 0.f;
#pragma unroll
        for (int j = 0; j < 4; ++j) { v[j] = xr[64 * j]; s += (v[j].x * v[j].x + v[j].y * v[j].y) + (v[j].z * v[j].z + v[j].w * v[j].w); }
        const float rstd = rsqrtf(wave_sum(s) * (1.f / DM) + 1e-6f);
        u32x2* o8 = (u32x2*)(o + (size_t)m * DM) + F.lane;
#pragma unroll
        for (int j = 0; j < 4; ++j) { u32x2 w; w.x = pk2(v[j].x * rstd * gv[j].x, v[j].y * rstd * gv[j].y); w.y = pk2(v[j].z * rstd * gv[j].z, v[j].w * rstd * gv[j].w); o8[64 * j] = w; }
    }
}
DI void rmsnorm_rows_f32_inplace(Frame& F, float* x, const float* g) {
    const f32x4* gp = (const f32x4*)g + F.lane; f32x4 gv[4];
#pragma unroll
    for (int j = 0; j < 4; ++j) gv[j] = gp[64 * j];
    for (int m = F.gw; m < NT; m += F.ngw) {
        f32x4* xr = (f32x4*)(x + (size_t)m * DM) + F.lane; f32x4 v[4]; float s = 0.f;
#pragma unroll
        for (int j = 0; j < 4; ++j) { v[j] = xr[64 * j]; s += (v[j].x * v[j].x + v[j].y * v[j].y) + (v[j].z * v[j].z + v[j].w * v[j].w); }
        const float rstd = rsqrtf(wave_sum(s) * (1.f / DM) + 1e-6f);
#pragma unroll
        for (int j = 0; j < 4; ++j) xr[64 * j] = v[j] * rstd * gv[j];
    }
}
DI void mix_norm_rows(Frame& F, const bf16_t* oatt, const bf16_t* ossm, const float* gatt, const float* gssm, bf16_t* mixed) {
    for (int m = F.gw; m < NT; m += F.ngw) {
        const u32x2* ar = (const u32x2*)(oatt + (size_t)m * 768) + F.lane;
        float a[12]; float s = 0.f;
#pragma unroll
        for (int j = 0; j < 3; ++j) { const u32x2 w = ar[64 * j]; a[4 * j] = bflo(w.x); a[4 * j + 1] = bfhi(w.x); a[4 * j + 2] = bflo(w.y); a[4 * j + 3] = bfhi(w.y); }
#pragma unroll
        for (int j = 0; j < 12; ++j) s += a[j] * a[j];
        const float ra = rsqrtf(wave_sum(s) * (1.f / 768.f) + 1e-6f);
        const u32x2 sw = ((const u32x2*)(ossm + (size_t)m * 256))[F.lane];
        float b[4] = {bflo(sw.x), bfhi(sw.x), bflo(sw.y), bfhi(sw.y)};
        const float rs = rsqrtf(wave_sum(b[0] * b[0] + b[1] * b[1] + b[2] * b[2] + b[3] * b[3]) * (1.f / 256.f) + 1e-6f);
        u32x2* o8 = (u32x2*)(mixed + (size_t)m * DM);
#pragma unroll
        for (int j = 0; j < 3; ++j) { const f32x4 gv = ((const f32x4*)gatt)[64 * j + F.lane];
            u32x2 w; w.x = pk2(a[4 * j] * ra * gv.x, a[4 * j + 1] * ra * gv.y); w.y = pk2(a[4 * j + 2] * ra * gv.z, a[4 * j + 3] * ra * gv.w); o8[64 * j + F.lane] = w; }
        { const f32x4 gv = ((const f32x4*)gssm)[F.lane]; u32x2 w; w.x = pk2(b[0] * rs * gv.x, b[1] * rs * gv.y); w.y = pk2(b[2] * rs * gv.z, b[3] * rs * gv.w); o8[192 + F.lane] = w; }
    }
}

DI void vtranspose_phase(Frame& F, const bf16_t* proj, bf16_t* vts, bf16_t* vtw) {
    LAS bf16_t* scr = (LAS bf16_t*)(F.lds + F.wave * 8704);
    for (int it = F.gw; it < 2 * 6 * 256; it += F.ngw) {
        const int which = it / 1536, r = it % 1536, bh = r >> 8, tt = r & 255, b = bh / 3, h = bh % 3;
        const bf16_t* src = proj + ((size_t)(b * SEQ + 64 * tt)) * PW + (which ? C_VW : C_VS) + h * 64;
        bf16_t* dst = (which ? vtw : vts) + (size_t)bh * 64 * SEQ + 64 * tt;
#pragma unroll
        for (int i = 0; i < 8; ++i) { const int tk = i * 8 + (F.lane >> 3), d8 = F.lane & 7; const u32x4 w = *(const u32x4*)(src + (size_t)tk * PW + 8 * d8);
            LAS bf16_t* sp = scr + tk * 66 + 8 * d8; ((LAS unsigned*)sp)[0] = w.x; ((LAS unsigned*)sp)[1] = w.y; ((LAS unsigned*)sp)[2] = w.z; ((LAS unsigned*)sp)[3] = w.w; }
        asm volatile("s_waitcnt lgkmcnt(0)" ::: "memory");
#pragma unroll
        for (int i = 0; i < 8; ++i) { const int d = i * 8 + (F.lane >> 3), t8 = F.lane & 7; unsigned short e[8];
#pragma unroll
            for (int j = 0; j < 8; ++j) e[j] = scr[(8 * t8 + j) * 66 + d];
            u32x4 w; w.x = e[0] | ((unsigned)e[1] << 16); w.y = e[2] | ((unsigned)e[3] << 16); w.z = e[4] | ((unsigned)e[5] << 16); w.w = e[6] | ((unsigned)e[7] << 16);
            *(u32x4*)(dst + (size_t)d * SEQ + 8 * t8) = w; }
        asm volatile("s_waitcnt lgkmcnt(0)" ::: "memory");
    }
}

#define MFMA32(a, b, c) __builtin_amdgcn_mfma_f32_32x32x16_bf16((a), (b), (c), 0, 0, 0)
#define MFMA16(a, b, c) __builtin_amdgcn_mfma_f32_16x16x32_bf16((a), (b), (c), 0, 0, 0)

DI void compress2_phase(Frame& F, const bf16_t* hidc, const bf16_t* w2t, const float* b2  , bf16_t* kc, bf16_t* vct) {
    const int r = F.lane & 31, h = F.lane >> 5;
    for (int it = F.gw; it < 2 * 192; it += F.ngw) {
        const int kv = it / 192, rb = it % 192; const int R0 = kv * 6144 + rb * 32;
        f32x16 acc0, acc1;
#pragma unroll
        for (int i = 0; i < 16; ++i) { acc0[i] = 0.f; acc1[i] = 0.f; }
        const bf16_t* ap = hidc + (size_t)(R0 + r) * 256 + 8 * h; const bf16_t* bp = w2t + (size_t)kv * 64 * 256 + (size_t)r * 256 + 8 * h;
#pragma unroll 4
        for (int ks = 0; ks < 16; ++ks) { const bf16x8 a = *(const bf16x8*)(ap + 16 * ks); const bf16x8 b0 = *(const bf16x8*)(bp + 16 * ks), b1 = *(const bf16x8*)(bp + 32 * 256 + 16 * ks);
            acc0 = MFMA32(a, b0, acc0); acc1 = MFMA32(a, b1, acc1); }
        const int bh = rb >> 5, i0 = (rb & 31) * 32;
        const float bb0 = b2[kv * 64 + r], bb1 = b2[kv * 64 + 32 + r];
        if (kv == 0) {
#pragma unroll
            for (int i = 0; i < 16; ++i) { const int row = i0 + (i & 3) + 8 * (i >> 2) + 4 * h; bf16_t* o = kc + ((size_t)bh * 1024 + row) * 64;
                o[r] = f2bf(acc0[i] + bb0); o[32 + r] = f2bf(acc1[i] + bb1); }
        } else {
#pragma unroll
            for (int g4 = 0; g4 < 4; ++g4) { const int row = i0 + 8 * g4 + 4 * h;
                u32x2 w0, w1; w0.x = pk2(acc0[4 * g4] + bb0, acc0[4 * g4 + 1] + bb0); w0.y = pk2(acc0[4 * g4 + 2] + bb0, acc0[4 * g4 + 3] + bb0);
                w1.x = pk2(acc1[4 * g4] + bb1, acc1[4 * g4 + 1] + bb1); w1.y = pk2(acc1[4 * g4 + 2] + bb1, acc1[4 * g4 + 3] + bb1);
                *(u32x2*)(vct + ((size_t)bh * 64 + r) * 1024 + row) = w0; *(u32x2*)(vct + ((size_t)bh * 64 + 32 + r) * 1024 + row) = w1; }
        }
    }
}

DI void ssm_carry_phase(Frame& F, const float* hl, const f32x2* ab16, const f32x2* ab1k, bf16_t* hin) {
    LAS f32x2* E = (LAS f32x2*)F.lds;
    const int s = F.lane;
    for (int bg = F.bid; bg < 32; bg += F.G) {
        const int gi = bg & 15; const f32x2 a16 = ab16[gi * 64 + s], a1k = ab1k[gi * 64 + s];
        const float* hp = hl + (size_t)bg * 1024 * 128;
#pragma unroll 1
        for (int sg = 0; sg < 2; ++sg) { const int seg = 2 * F.wave + sg; float hr = 0.f, hi = 0.f;
#pragma unroll 8
            for (int c = 0; c < 64; ++c) { const float* q = hp + (size_t)(seg * 64 + c) * 128; const float lr = q[s], li = q[64 + s];
                const float nr = a16.x * hr - a16.y * hi + lr, ni = a16.x * hi + a16.y * hr + li; hr = nr; hi = ni; }
            E[seg * 64 + s] = (f32x2){hr, hi}; }
        __syncthreads();
#pragma unroll 1
        for (int sg = 0; sg < 2; ++sg) { const int seg = 2 * F.wave + sg; float hr = 0.f, hi = 0.f;
            for (int k = 0; k < seg; ++k) { const f32x2 e = E[k * 64 + s]; const float nr = a1k.x * hr - a1k.y * hi + e.x, ni = a1k.x * hi + a1k.y * hr + e.y; hr = nr; hi = ni; }
#pragma unroll 8
            for (int c = 0; c < 64; ++c) { const size_t row = (size_t)bg * 1024 + seg * 64 + c; const float* q = hp + (size_t)(seg * 64 + c) * 128; const float lr = q[s], li = q[64 + s];
                bf16_t* o = hin + row * 256; o[s] = f2bf(hr); o[64 + s] = f2bf(hi); ((unsigned*)(o + 128))[s] = 0u;
                const float nr = a16.x * hr - a16.y * hi + lr, ni = a16.x * hi + a16.y * hr + li; hr = nr; hi = ni; } }
        __syncthreads();
    }
}

constexpr int IMP_STRIDE = 257;
constexpr int LDS_RA = 0, LDS_RB = 64 * IMP_STRIDE * 4, LDS_WM = 2 * 64 * IMP_STRIDE * 4;
constexpr int TROW = 144, TILE_V = 64 * TROW, TILE_BYTES = 2 * 64 * TROW;

struct TileSrc { const bf16_t* k; long kstep, kstride; const bf16_t* v; long vstep, vstride; };

template <bool WITH_V, class Compute>
DI void kv_pipeline(Frame& F, LAS unsigned char* sb, const TileSrc& ts, int n, Compute&& compute) {
    if (n <= 0) return;
    const int row = F.tid >> 3, ch = F.tid & 7;
    const bf16_t* kp = ts.k + (long)row * ts.kstride + ch * 8; const bf16_t* vp = ts.v + (long)row * ts.vstride + ch * 8;
    LAS unsigned char* wk = sb + row * TROW + ch * 16;
    u32x4 kr, vr = {0u, 0u, 0u, 0u};
    kr = *(const u32x4*)kp; if (WITH_V) vr = *(const u32x4*)vp;
    *(LAS u32x4*)wk = kr; if (WITH_V) *(LAS u32x4*)(wk + TILE_V) = vr;
    if (n > 1) { kr = *(const u32x4*)(kp + ts.kstep); if (WITH_V) vr = *(const u32x4*)(vp + ts.vstep); }
    __syncthreads();
    for (int i = 0; i < n; ++i) {
        if (i + 1 < n) { LAS unsigned char* w1 = wk + ((i + 1) & 1) * TILE_BYTES; *(LAS u32x4*)w1 = kr; if (WITH_V) *(LAS u32x4*)(w1 + TILE_V) = vr; }
        if (i + 2 < n) { kr = *(const u32x4*)(kp + (long)(i + 2) * ts.kstep); if (WITH_V) vr = *(const u32x4*)(vp + (long)(i + 2) * ts.vstep); }
        compute(i, sb + (i & 1) * TILE_BYTES);
        __syncthreads();
    }
}

DI f32x16 qk32(const LAS unsigned char* tb, int kh, int r32, int h, const bf16x8 (&qf)[4]) {
    f32x16 sc;
#pragma unroll
    for (int i = 0; i < 16; ++i) sc[i] = 0.f;
    const LAS unsigned char* kp = tb + (32 * kh + r32) * TROW + 16 * h;
#pragma unroll
    for (int s = 0; s < 4; ++s) { const bf16x8 a = *(const LAS bf16x8*)(kp + 32 * s); sc = MFMA32(a, qf[s], sc); }
    return sc;
}
DI void pv32(const LAS unsigned char* tb, int kh, int r32, int h, const f32x16& p, f32x16& o0, f32x16& o1) {
#pragma unroll
    for (int s2 = 0; s2 < 2; ++s2) {
        u32x4 pw; pw.x = pk2(p[8 * s2], p[8 * s2 + 1]); pw.y = pk2(p[8 * s2 + 2], p[8 * s2 + 3]); pw.z = pk2(p[8 * s2 + 4], p[8 * s2 + 5]); pw.w = pk2(p[8 * s2 + 6], p[8 * s2 + 7]);
        const bf16x8 pb = __builtin_bit_cast(bf16x8, pw);
        const LAS unsigned char* vp = tb + TILE_V + r32 * TROW + (32 * kh + 16 * s2 + 4 * h) * 2;
        { const s16x4 lo = *(const LAS s16x4*)vp, hi = *(const LAS s16x4*)(vp + 16); const bf16x8 a = __builtin_shufflevector(lo, hi, 0, 1, 2, 3, 4, 5, 6, 7); o0 = MFMA32(a, pb, o0); }
        { const s16x4 lo = *(const LAS s16x4*)(vp + 32 * TROW), hi = *(const LAS s16x4*)(vp + 32 * TROW + 16); const bf16x8 a = __builtin_shufflevector(lo, hi, 0, 1, 2, 3, 4, 5, 6, 7); o1 = MFMA32(a, pb, o1); }
    }
}

DI void attn_unit(Frame& F, const bf16_t* proj, const bf16_t* kcb, const bf16_t* vctb, const bf16_t* vts, const bf16_t* vtw, bf16_t* oatt, int bh, int qb) {
    LAS float* IMP = (LAS float*)(F.lds + LDS_RA); LAS float* ACC = (LAS float*)(F.lds + LDS_RB); LAS unsigned char* WM = F.lds + LDS_WM;
    const int b = bh / 3, hkv = bh % 3, lane = F.lane, w = F.wave;
    const float NEG = -__builtin_inff();
    for (int i = F.tid; i < 64 * IMP_STRIDE; i += 512) IMP[i] = 0.f;
    for (int i = F.tid; i < 512; i += 512) ((LAS unsigned*)WM)[i] = 0u;
    const int r32 = lane & 31, h = lane >> 5, gq = w & 3, qh = w >> 2;
    const int ql = 32 * qh + r32, t = 64 * qb + ql;
    const size_t trow = (size_t)(b * SEQ + t);
    const bf16_t* qrow = proj + trow * PW + C_Q + (hkv * 4 + gq) * 64;
    bf16x8 qf[4];
#pragma unroll
    for (int s = 0; s < 4; ++s) qf[s] = *(const bf16x8*)(qrow + 16 * s + 8 * h);
    const bf16_t* grow = proj + trow * PW + C_G + hkv * 12 + gq * 3;
    const float g0 = sigmoidf_(bf2f(grow[0])), g2 = sigmoidf_(bf2f(grow[2]));
    f32x16 oc0, oc1;
#pragma unroll
    for (int i = 0; i < 16; ++i) { oc0[i] = 0.f; oc1[i] = 0.f; }
    {
        const int ntile = (4 * qb + 3 + 63) >> 6;
        const int vis = (t - 31) >> 4;
        const int vis_w = (64 * qb + 32 * qh + 31 - 31) >> 4;
        TileSrc ts{kcb + (size_t)bh * 1024 * 64, 64 * 64, 64, vctb + (size_t)bh * 64 * 1024, 64, 1024};
        float m = NEG, lsum = 0.f;
        kv_pipeline<false>(F, F.lds + LDS_RB, ts, ntile, [&](int i, const LAS unsigned char* tb) {
#pragma unroll
            for (int kh = 0; kh < 2; ++kh) {
                if (64 * i + 32 * kh > vis_w) continue;
                f32x16 sc = qk32(tb, kh, r32, h, qf);
                float tm = NEG;
#pragma unroll
                for (int e = 0; e < 16; ++e) { const int ki = 64 * i + 32 * kh + (e & 3) + 8 * (e >> 2) + 4 * h; sc[e] = (ki <= vis) ? sc[e] : NEG; tm = fmaxf(tm, sc[e]); }
                const float mn = fmaxf(m, tm);
                if (mn > NEG) { float ps = 0.f;
#pragma unroll
                    for (int e = 0; e < 16; ++e) ps += fexp2((sc[e] - mn) * L2E);
                    lsum = lsum * fexp2((m - mn) * L2E) + ps; m = mn; }
            }
        });
        const float m2 = __shfl_xor(m, 32), l2 = __shfl_xor(lsum, 32);
        float M = fmaxf(m, m2), Lt = 0.f;
        if (M > NEG) Lt = lsum * fexp2((m - M) * L2E) + l2 * fexp2((m2 - M) * L2E); else M = 0.f;
        const float inv = 1.0f / fmaxf(Lt, 1e-30f);
        kv_pipeline<true>(F, F.lds + LDS_RB, ts, ntile, [&](int i, const LAS unsigned char* tb) {
#pragma unroll
            for (int kh = 0; kh < 2; ++kh) {
                if (64 * i + 32 * kh > vis_w) continue;
                f32x16 sc = qk32(tb, kh, r32, h, qf);
#pragma unroll
                for (int e = 0; e < 16; ++e) { const int ki = 64 * i + 32 * kh + (e & 3) + 8 * (e >> 2) + 4 * h; sc[e] = (ki <= vis) ? fexp2((sc[e] - M) * L2E) * inv : 0.f; }
#pragma unroll
                for (int a = 0; a < 4; ++a) { const float G = (sc[4 * a] + sc[4 * a + 1]) + (sc[4 * a + 2] + sc[4 * a + 3]); const int j = 16 * i + 8 * kh + 2 * a + h;
                    __hip_atomic_fetch_add(IMP + ql * IMP_STRIDE + j, G, __ATOMIC_RELAXED, __HIP_MEMORY_SCOPE_WORKGROUP);
                    __hip_atomic_fetch_add(IMP + ql * IMP_STRIDE + j + 1, sc[4 * a + 3], __ATOMIC_RELAXED, __HIP_MEMORY_SCOPE_WORKGROUP); }
                pv32(tb, kh, r32, h, sc, oc0, oc1);
            }
        });
    }
    {
        const int cur = qb; LAS unsigned char* wm = WM + w * 256;
        if (cur + 1 <= 16) { if (lane <= cur) wm[lane] = 0xff; }
        else {
            unsigned mybits[4] = {0u, 0u, 0u, 0u};
            for (int qi = 0; qi < 8; ++qi) {
                const int q = 8 * w + qi; float v[4];
#pragma unroll
                for (int i = 0; i < 4; ++i) { const int j = 4 * lane + i; const float x = IMP[q * IMP_STRIDE + j]; v[i] = (j >= 1 && j <= cur - 2) ? x : -1.0f; }
                for (int k = 0; k < 13; ++k) {
                    const float lm = fmaxf(fmaxf(v[0], v[1]), fmaxf(v[2], v[3])); const float Mx = wave_max(lm);
                    const unsigned long long bal = __ballot(lm == Mx); const int L = __ffsll((long long)bal) - 1;
                    if (lane == L) { const int ii = (v[0] == Mx) ? 0 : (v[1] == Mx) ? 1 : (v[2] == Mx) ? 2 : 3;
#pragma unroll
                        for (int i = 0; i < 4; ++i) if (i == ii) { v[i] = -2.f; mybits[i] |= 1u << qi; } }
                }
            }
#pragma unroll
            for (int i = 0; i < 4; ++i) { const int j = 4 * lane + i; unsigned bits = mybits[i]; if (j == 0 || j == cur - 1 || j == cur) bits = 0xffu; wm[j] = (unsigned char)bits; }
        }
    }
    __syncthreads();
    {
        const int kt_lo = (qb - 8) > 0 ? (qb - 8) : 0; const int ntile = qb - kt_lo + 1;
        const int t0w = 64 * qb + 32 * qh;
        TileSrc ts{proj + ((size_t)(b * SEQ) + 64 * kt_lo) * PW + C_KW + hkv * 64, 64 * PW, PW, vtw + (size_t)bh * 64 * SEQ + 64 * kt_lo, 64, SEQ};
        float m = NEG, lsum = 0.f; f32x16 o0, o1;
#pragma unroll
        for (int i = 0; i < 16; ++i) { o0[i] = 0.f; o1[i] = 0.f; }
        kv_pipeline<true>(F, F.lds + LDS_RA, ts, ntile, [&](int i, const LAS unsigned char* tb) {
#pragma unroll
            for (int kh = 0; kh < 2; ++kh) {
                const int k0 = 64 * (kt_lo + i) + 32 * kh;
                if (k0 > t0w + 31 || k0 + 31 <= t0w - 512) continue;
                f32x16 sc = qk32(tb, kh, r32, h, qf);
                float tm = NEG;
#pragma unroll
                for (int e = 0; e < 16; ++e) { const int key = k0 + (e & 3) + 8 * (e >> 2) + 4 * h; sc[e] = (key <= t && key > t - 512) ? sc[e] : NEG; tm = fmaxf(tm, sc[e]); }
                tm = fmaxf(tm, __shfl_xor(tm, 32));
                const float mn = fmaxf(m, tm); const float ms = (mn > NEG) ? mn : 0.f;
                const float alpha = fexp2((m - ms) * L2E); float ps = 0.f;
#pragma unroll
                for (int e = 0; e < 16; ++e) { sc[e] = fexp2((sc[e] - ms) * L2E); ps += sc[e]; }
                lsum = lsum * alpha + ps; m = mn;
#pragma unroll
                for (int e = 0; e < 16; ++e) { o0[e] *= alpha; o1[e] *= alpha; }
                pv32(tb, kh, r32, h, sc, o0, o1);
            }
        });
        const float Lw = lsum + __shfl_xor(lsum, 32); const float gw = g2 / fmaxf(Lw, 1e-30f);
        LAS float* ap = ACC + ql * IMP_STRIDE + gq * 64;
#pragma unroll
        for (int e = 0; e < 16; ++e) { const int d = (e & 3) + 8 * (e >> 2) + 4 * h; ap[d] = g0 * oc0[e] + gw * o0[e]; ap[32 + d] = g0 * oc1[e] + gw * o1[e]; }
    }
    __syncthreads();
    {
        const int cur = qb; const int c16 = lane & 15, kq = lane >> 4, hd = c16 & 3, qs = c16 >> 2;
        const LAS unsigned char* wm = WM + w * 256;
        bf16x8 qa[2][2]; int tq[2];
#pragma unroll
        for (int x = 0; x < 2; ++x) { tq[x] = 64 * qb + 8 * w + 4 * x + qs; const bf16_t* qr = proj + (size_t)(b * SEQ + tq[x]) * PW + C_Q + (hkv * 4 + hd) * 64 + 8 * kq;
            qa[x][0] = *(const bf16x8*)qr; qa[x][1] = *(const bf16x8*)(qr + 32); }
        float m[2] = {NEG, NEG}, lsum[2] = {0.f, 0.f}; f32x4 o[2][4];
#pragma unroll
        for (int x = 0; x < 2; ++x)
#pragma unroll
            for (int i = 0; i < 4; ++i) o[x][i] = (f32x4){0.f, 0.f, 0.f, 0.f};
        TileSrc ts{proj + (size_t)(b * SEQ) * PW + C_KS + hkv * 64, 64 * PW, PW, vts + (size_t)bh * 64 * SEQ, 64, SEQ};
        kv_pipeline<true>(F, F.lds + LDS_RA, ts, cur + 1, [&](int j, const LAS unsigned char* tb) {
            const unsigned sel = wm[j];
            const unsigned selu = __builtin_amdgcn_readfirstlane(sel);
#pragma unroll
            for (int x = 0; x < 2; ++x) {
                if (((selu >> (4 * x)) & 15u) == 0u) continue;
                const bool colsel = (selu >> (4 * x + qs)) & 1u;
                f32x4 st[4];
                const LAS unsigned char* kp = tb + c16 * TROW + 16 * kq;
#pragma unroll
                for (int rt = 0; rt < 4; ++rt) { st[rt] = (f32x4){0.f, 0.f, 0.f, 0.f};
                    const bf16x8 a0 = *(const LAS bf16x8*)(kp + 16 * rt * TROW), a1 = *(const LAS bf16x8*)(kp + 16 * rt * TROW + 64);
                    st[rt] = MFMA16(a0, qa[x][0], st[rt]); st[rt] = MFMA16(a1, qa[x][1], st[rt]); }
                float bm = NEG;
#pragma unroll
                for (int rt = 0; rt < 4; ++rt)
#pragma unroll
                    for (int e = 0; e < 4; ++e) { const int pos = 64 * j + 16 * rt + 4 * kq + e; st[rt][e] = (colsel && pos <= tq[x]) ? st[rt][e] : NEG; bm = fmaxf(bm, st[rt][e]); }
                bm = fmaxf(bm, __shfl_xor(bm, 16)); bm = fmaxf(bm, __shfl_xor(bm, 32));
                const float mn = fmaxf(m[x], bm); const float ms = (mn > NEG) ? mn : 0.f;
                const float alpha = fexp2((m[x] - ms) * L2E); float ps = 0.f;
#pragma unroll
                for (int rt = 0; rt < 4; ++rt)
#pragma unroll
                    for (int e = 0; e < 4; ++e) { st[rt][e] = fexp2((st[rt][e] - ms) * L2E); ps += st[rt][e]; }
                lsum[x] = lsum[x] * alpha + ps; m[x] = mn;
#pragma unroll
                for (int i = 0; i < 4; ++i) o[x][i] *= alpha;
                const LAS unsigned char* vb = tb + TILE_V + c16 * TROW + 8 * kq;
#pragma unroll
                for (int sp = 0; sp < 2; ++sp) {
                    u32x4 pw; pw.x = pk2(st[2 * sp][0], st[2 * sp][1]); pw.y = pk2(st[2 * sp][2], st[2 * sp][3]); pw.z = pk2(st[2 * sp + 1][0], st[2 * sp + 1][1]); pw.w = pk2(st[2 * sp + 1][2], st[2 * sp + 1][3]);
                    const bf16x8 pb = __builtin_bit_cast(bf16x8, pw);
#pragma unroll
                    for (int dt = 0; dt < 4; ++dt) { const LAS unsigned char* vp = vb + 16 * dt * TROW + 64 * sp;
                        const s16x4 lo = *(const LAS s16x4*)vp, hi = *(const LAS s16x4*)(vp + 32); const bf16x8 a = __builtin_shufflevector(lo, hi, 0, 1, 2, 3, 4, 5, 6, 7);
                        o[x][dt] = MFMA16(a, pb, o[x][dt]); }
                }
            }
        });
#pragma unroll
        for (int x = 0; x < 2; ++x) {
            float Ls = lsum[x] + __shfl_xor(lsum[x], 16); Ls += __shfl_xor(Ls, 32);
            const int q = 8 * w + 4 * x + qs; const size_t qtrow = (size_t)(b * SEQ + tq[x]);
            const float g1 = sigmoidf_(bf2f(proj[qtrow * PW + C_G + hkv * 12 + hd * 3 + 1])) / fmaxf(Ls, 1e-30f);
            const LAS float* ap = ACC + q * IMP_STRIDE + hd * 64 + 4 * kq;
            bf16_t* op = oatt + qtrow * 768 + (hkv * 4 + hd) * 64 + 4 * kq;
#pragma unroll
            for (int dt = 0; dt < 4; ++dt) { u32x2 wv; wv.x = pk2(ap[16 * dt] + g1 * o[x][dt][0], ap[16 * dt + 1] + g1 * o[x][dt][1]); wv.y = pk2(ap[16 * dt + 2] + g1 * o[x][dt][2], ap[16 * dt + 3] + g1 * o[x][dt][3]);
                *(u32x2*)(op + 16 * dt) = wv; }
        }
    }
    __syncthreads();
}

DI void attn_phase(Frame& F, const bf16_t* proj, const bf16_t* kcb, const bf16_t* vctb, const bf16_t* vts, const bf16_t* vtw, bf16_t* oatt) {
    const int c = F.bid;
    for (int k = 0; k * F.G < 1536; ++k) {
        const int idx = k * F.G + ((k & 1) ? (F.G - 1 - c) : c);
        if (idx >= 1536) continue;
        const int qb = 255 - idx / 6, bh = idx % 6;
        attn_unit(F, proj, kcb, vctb, vts, vtw, oatt, bh, qb);
    }
    __syncthreads();
}

#define REFRESH() do { int w_ = wave0, b_ = blockIdx.x, g_ = gridDim.x; asm volatile("" : "+s"(w_), "+s"(b_), "+s"(g_)); \
    int l_; asm volatile("v_mbcnt_lo_u32_b32 %0, -1, 0\n\tv_mbcnt_hi_u32_b32 %0, -1, %0" : "=v"(l_)); \
    F.lane = l_; F.wave = w_; F.tid = w_ * 64 + l_; F.bid = b_; F.G = g_; F.gw = b_ * 8 + w_; F.ngw = g_ * 8; } while (0)
#define GSYNC() do { grid.sync(); REFRESH(); } while (0)
#define WSP(off) (F.wsp() + (off))
#define WL(off) (F.wsp() + WS_W + (size_t)l * WL_STRIDE + (off))
#define MSL(off) (F.wsp() + WS_MISC + (size_t)l * MS_L + (off))
#define CTL(off) (F.wsp() + WS_CTL + CT_BASE + (size_t)l * CT_L + (off))
__global__ void __launch_bounds__(512, 2) mk_fwd(Params p) {
    extern __shared__ __attribute__((aligned(16))) unsigned char lds_raw[];
    cg::grid_group grid = cg::this_grid();
    Frame F;
    F.lds = (LAS unsigned char*)lds_raw; F.pt = (LAS const unsigned long long*)(F.lds + LDS_PT);
    const int wave0 = __builtin_amdgcn_readfirstlane((int)threadIdx.x >> 6);
    REFRESH();
    {
        LAS unsigned long long* ptw = (LAS unsigned long long*)(F.lds + LDS_PT);
        if (F.tid < 26) ptw[F.tid] = (unsigned long long)p.in[F.tid];
        if (F.tid == 26) ptw[26] = (unsigned long long)p.out;
        if (F.tid == 27) ptw[27] = (unsigned long long)p.ws;
    }
    __syncthreads();

    prologue_a(F);
    GSYNC();
    prologue_b(F);
    rmsnorm_rows_bf16(F, F.in(0), F.in(1), (bf16_t*)WSP(WS_ACT));
    GSYNC();

#if STAGE >= 2
#pragma unroll 1
    for (int l = 0; l < NL; ++l) {
        if (l > 0) { rmsnorm_rows_bf16(F, F.out(), F.in(1) + (size_t)l * DM, (bf16_t*)WSP(WS_ACT)); GSYNC(); }
        REFRESH();
        { pg8::APlain g{(const char*)WSP(WS_ACT), (const char*)WL(WO_WIN), 1024}; pg8::StaticOrder S; S.init(NT / 256, PW / 256, F.G, F.bid);
          pg8::EpiBf16 E{(bf16_t*)WSP(WS_PROJ), PW}; pg8::gemm_phase<pg8::EpiBf16, pg8::APlain, true>(F.lds, g, S, E, F.tid); }
        GSYNC();
        vtranspose_phase(F, (const bf16_t*)WSP(WS_PROJ), (bf16_t*)WSP(WS_VTS), (bf16_t*)WSP(WS_VTW));
        __syncthreads(); REFRESH();
        REFRESH();
        { pg8::ACompress g{(const char*)WSP(WS_PROJ), (const char*)WL(WO_W1)}; pg8::StaticOrder S; S.init(48, 1, F.G, F.bid);
          pg8::EpiCmpHid E{(bf16_t*)WSP(WS_HIDC), (const float*)CTL(CT_CB1)}; pg8::gemm_phase<pg8::EpiCmpHid, pg8::ACompress, true>(F.lds, g, S, E, F.tid); }
        REFRESH();
        { pg8::ASsm1 g{(const char*)WSP(WS_PROJ), (const char*)WL(WO_SS1)}; pg8::StaticOrder S; S.init(128, 2, F.G, (F.bid + 64) % F.G);
          pg8::EpiSsm1 E{(float*)WSP(WS_YI), (float*)WSP(WS_HL)}; pg8::gemm_phase<pg8::EpiSsm1, pg8::ASsm1, true>(F.lds, g, S, E, F.tid); }
        GSYNC();
        compress2_phase(F, (const bf16_t*)WSP(WS_HIDC), (const bf16_t*)CTL(CT_W2T), F.in(7) + (size_t)l * 2 * 64, (bf16_t*)WSP(WS_KC), (bf16_t*)WSP(WS_VCT));
        __syncthreads(); REFRESH();
        ssm_carry_phase(F, (const float*)WSP(WS_HL), (const f32x2*)CTL(CT_AB16), (const f32x2*)CTL(CT_AB1K), (bf16_t*)WSP(WS_HIN));
        GSYNC();
        REFRESH();
        { pg8::ASsm2 g{(const char*)WSP(WS_HIN), (const char*)WL(WO_SS2)}; pg8::StaticOrder S; S.init(128, 1, F.G, F.bid);
          pg8::EpiSsm2 E{(const float*)WSP(WS_YI), (const bf16_t*)WSP(WS_PROJ), F.in(15) + (size_t)l * 256, (bf16_t*)WSP(WS_YS2)}; pg8::gemm_phase<pg8::EpiSsm2, pg8::ASsm2, true>(F.lds, g, S, E, F.tid); }
#if STAGE >= 3
        REFRESH();
        attn_phase(F, (const bf16_t*)WSP(WS_PROJ), (const bf16_t*)WSP(WS_KC), (const bf16_t*)WSP(WS_VCT), (const bf16_t*)WSP(WS_VTS), (const bf16_t*)WSP(WS_VTW), (bf16_t*)WSP(WS_OATT));
#if REP_ATTN > 1
        REFRESH();
        attn_phase(F, (const bf16_t*)WSP(WS_PROJ), (const bf16_t*)WSP(WS_KC), (const bf16_t*)WSP(WS_VCT), (const bf16_t*)WSP(WS_VTS), (const bf16_t*)WSP(WS_VTW), (bf16_t*)WSP(WS_OATT));
#endif
#else
        { unsigned* oz = (unsigned*)WSP(WS_OATT); for (size_t i = (size_t)F.bid * 512 + F.tid; i < (size_t)NT * 768 / 2; i += (size_t)F.G * 512) oz[i] = 0u; }
#endif
        GSYNC();
        REFRESH();
        { pg8::APlain g{(const char*)WSP(WS_YS2), (const char*)MSL(MS_WGLU), 256}; pg8::StaticOrder S; S.init(NT / 256, 2, F.G, F.bid);
          pg8::EpiGlu E{(bf16_t*)WSP(WS_OSSM), F.in(17) + (size_t)l * 512}; pg8::gemm_phase<pg8::EpiGlu, pg8::APlain, true>(F.lds, g, S, E, F.tid); }
        GSYNC();
        mix_norm_rows(F, (const bf16_t*)WSP(WS_OATT), (const bf16_t*)WSP(WS_OSSM), F.in(18) + (size_t)l * 768, F.in(19) + (size_t)l * 256, (bf16_t*)WSP(WS_ACT));
        GSYNC();
        REFRESH();
        { pg8::APlain g{(const char*)WSP(WS_ACT), (const char*)WL(WO_WOUT), 1024}; pg8::StaticOrder S; S.init(NT / 256, 4, F.G, F.bid);
          pg8::EpiResF32 E{(l == 0) ? F.in(0) : (const float*)F.out(), F.out()}; pg8::gemm_phase<pg8::EpiResF32, pg8::APlain, true>(F.lds, g, S, E, F.tid); }
        GSYNC();
#if STAGE >= 4
        rmsnorm_rows_bf16(F, F.out(), F.in(21) + (size_t)l * DM, (bf16_t*)WSP(WS_ACT));
        GSYNC();
        REFRESH();
        { pg8::APlain g{(const char*)WSP(WS_ACT), (const char*)WL(WO_WGU), 1024}; pg8::StaticOrder S; S.init(NT / 256, 22, F.G, F.bid);
          pg8::EpiSwiglu E{(bf16_t*)WSP(WS_PROJ)}; pg8::gemm_phase<pg8::EpiSwiglu, pg8::APlain, true>(F.lds, g, S, E, F.tid); }
        GSYNC();
        REFRESH();
        { pg8::APlain g{(const char*)WSP(WS_PROJ), (const char*)WL(WO_WD), DFF}; pg8::StaticOrder S; S.init(NT / 256, 4, F.G, F.bid);
          pg8::EpiResF32 E{(const float*)F.out(), F.out()}; pg8::gemm_phase<pg8::EpiResF32, pg8::APlain, true>(F.lds, g, S, E, F.tid); }
        GSYNC();
#endif
#if STAGE < 5
        break;
#endif
    }
    rmsnorm_rows_f32_inplace(F, F.out(), F.in(25));
#else
    {
        const float* x0 = F.in(0); const float* fg = F.in(25); float* X = F.out();
        for (int m = F.gw; m < NT; m += F.ngw) {
            const f32x4* xr = (const f32x4*)(x0 + (size_t)m * DM) + F.lane; f32x4 v[4]; float s = 0.f;
#pragma unroll
            for (int j = 0; j < 4; ++j) { v[j] = xr[64 * j]; s += (v[j].x * v[j].x + v[j].y * v[j].y) + (v[j].z * v[j].z + v[j].w * v[j].w); }
            const float rstd = rsqrtf(wave_sum(s) * (1.f / DM) + 1e-6f);
            f32x4* o = (f32x4*)(X + (size_t)m * DM) + F.lane;
#pragma unroll
            for (int j = 0; j < 4; ++j) o[64 * j] = v[j] * rstd * ((const f32x4*)fg)[64 * j + F.lane];
        }
    }
#endif
}

extern "C" void kernel_launch(void* const* d_in, const int* in_sizes, int n_in, void* d_out, int out_size, void* d_ws, size_t ws_size, hipStream_t stream) {
    static int grid_blocks = 0;
    if (grid_blocks == 0) {
        if (n_in != 26 || ws_size < WS_END) { fprintf(stderr, "kernel_launch: unexpected n_in %d or ws_size %zu (< %zu)\n", n_in, ws_size, (size_t)WS_END); grid_blocks = -1; return; }
        int dev = 0, cus = 0, per_cu = 0;
        hipGetDevice(&dev);
        hipDeviceGetAttribute(&cus, hipDeviceAttributeMultiprocessorCount, dev);
        hipFuncSetAttribute((const void*)mk_fwd, hipFuncAttributeMaxDynamicSharedMemorySize, LDS_BYTES);
        hipOccupancyMaxActiveBlocksPerMultiprocessor(&per_cu, (const void*)mk_fwd, 512, LDS_BYTES);
        if (per_cu < 1) { fprintf(stderr, "kernel_launch: occupancy query says %d blocks per CU\n", per_cu); per_cu = 1; }
        grid_blocks = cus;
        (void)hipGetLastError();
    }
    if (grid_blocks < 0) return;
    Params p{};
    for (int i = 0; i < 26; ++i) p.in[i] = (const float*)d_in[i];
    p.out = (float*)d_out; p.ws = (unsigned char*)d_ws;
    void* args[] = {&p};
    hipError_t e = hipLaunchCooperativeKernel((const void*)mk_fwd, dim3(grid_blocks), dim3(512), args, LDS_BYTES, stream);
    if (e != hipSuccess) fprintf(stderr, "cooperative launch failed: %s (grid %d)\n", hipGetErrorString(e), grid_blocks);
}
```

```cpp
#include <hip/hip_runtime.h>
#include <hip/hip_cooperative_groups.h>
#include <cstdio>
#include <cstdint>
namespace cg = cooperative_groups;

#ifndef STAGE
#define STAGE 99
#endif
#ifndef REP_ATTN
#define REP_ATTN 1
#endif
#ifndef REP_B1
#define REP_B1 1
#endif
#ifndef REP_B2
#define REP_B2 1
#endif
#ifndef REP_B3
#define REP_B3 1
#endif
#ifndef REP_TK
#define REP_TK 1
#endif
#ifndef FP8FIX
#define FP8FIX 1.0f
#endif
#ifndef PROBE_DUP
#define PROBE_DUP 0
#endif
#define PH(bit, ...) do { __VA_ARGS__ if (PROBE_DUP & (1 << (bit))) { __VA_ARGS__ } } while (0)
#ifndef REP_GU
#define REP_GU 1
#endif
#ifndef REP_INPROJ
#define REP_INPROJ 1
#endif
#ifndef REP_SYNC
#define REP_SYNC 1
#endif

#define DI __device__ __forceinline__
#define LAS __attribute__((address_space(3)))
typedef unsigned short bf16_t;
typedef short bf16x8 __attribute__((ext_vector_type(8)));
typedef short s16x4 __attribute__((ext_vector_type(4)));
typedef float f32x4 __attribute__((ext_vector_type(4)));
typedef float f32x2 __attribute__((ext_vector_type(2)));
typedef float f32x16 __attribute__((ext_vector_type(16)));
typedef unsigned u32x4 __attribute__((ext_vector_type(4)));
typedef unsigned u32x2 __attribute__((ext_vector_type(2)));
typedef __bf16 bf2_t __attribute__((ext_vector_type(2)));
typedef int i32x8 __attribute__((ext_vector_type(8)));
typedef int i32x4 __attribute__((ext_vector_type(4)));

DI float clamp8(float v) { return fminf(fmaxf(v, -440.f), 440.f); }
DI unsigned pk4_fp8(float a, float b, float c, float d) { int w = 0; w = __builtin_amdgcn_cvt_pk_fp8_f32(clamp8(a), clamp8(b), w, false); w = __builtin_amdgcn_cvt_pk_fp8_f32(clamp8(c), clamp8(d), w, true); return (unsigned)w; }
DI unsigned pk2(float lo, float hi) { f32x2 v = {lo, hi}; return __builtin_bit_cast(unsigned, __builtin_convertvector(v, bf2_t)); }
DI bf16_t f2bf(float f) { return (bf16_t)(pk2(f, 0.f) & 0xffffu); }
DI float bf2f(bf16_t u) { return __uint_as_float((unsigned)u << 16); }
DI float bflo(unsigned w) { return __uint_as_float(w << 16); }
DI float bfhi(unsigned w) { return __uint_as_float(w & 0xffff0000u); }
DI float fexp2(float x) { return __builtin_amdgcn_exp2f(x); }
DI float sigmoidf_(float x) { return __builtin_amdgcn_rcpf(1.0f + __builtin_amdgcn_exp2f(-1.4426950408889634f * x)); }
DI float gelu_tanh(float x) { const float y = 0.7978845608028654f * (x + 0.044715f * x * x * x); return x * __builtin_amdgcn_rcpf(1.0f + __builtin_amdgcn_exp2f(-2.8853900817779268f * y)); }
template <int CTRL> DI float dppf(float v) { return __builtin_bit_cast(float, __builtin_amdgcn_update_dpp(0, __builtin_bit_cast(int, v), CTRL, 0xF, 0xF, false)); }
struct F2 { float lo, hi; };
DI F2 halves32(float v) { const auto r = __builtin_amdgcn_permlane32_swap(__float_as_uint(v), __float_as_uint(v), false, false); return {__uint_as_float(r[0]), __uint_as_float(r[1])}; }
DI F2 rows16(float v) { const auto r = __builtin_amdgcn_permlane16_swap(__float_as_uint(v), __float_as_uint(v), false, false); return {__uint_as_float(r[0]), __uint_as_float(r[1])}; }
DI float xor32_sum(float v) { const F2 p = halves32(v); return p.lo + p.hi; }
DI float xor32_max(float v) { const F2 p = halves32(v); return fmaxf(p.lo, p.hi); }
DI float xor16_sum(float v) { const F2 p = rows16(v); return p.lo + p.hi; }
DI float xor16_max(float v) { const F2 p = rows16(v); return fmaxf(p.lo, p.hi); }
DI float wave_sum(float v) {
    v += dppf<0xB1>(v); v += dppf<0x4E>(v); v += dppf<0x141>(v); v += dppf<0x140>(v);
    return xor32_sum(xor16_sum(v));
}

DI unsigned wave_max_u32(unsigned v) {
    v = max(v, (unsigned)__builtin_amdgcn_update_dpp(0, (int)v, 0xB1, 0xF, 0xF, false));
    v = max(v, (unsigned)__builtin_amdgcn_update_dpp(0, (int)v, 0x4E, 0xF, 0xF, false));
    v = max(v, (unsigned)__builtin_amdgcn_update_dpp(0, (int)v, 0x141, 0xF, 0xF, false));
    v = max(v, (unsigned)__builtin_amdgcn_update_dpp(0, (int)v, 0x140, 0xF, 0xF, false));
    const unsigned a = __builtin_amdgcn_readlane(v, 0), b = __builtin_amdgcn_readlane(v, 16), c = __builtin_amdgcn_readlane(v, 32), d = __builtin_amdgcn_readlane(v, 48);
    return max(max(a, b), max(c, d));
}

constexpr int NB = 2, SEQ = 16384, DM = 1024, NT = NB * SEQ, NL = 2;
constexpr int PW = 2304;
constexpr int C_Q = 0, C_KC = 768, C_VC = 960, C_KS = 1152, C_VS = 1344, C_KW = 1536, C_VW = 1728, C_U = 1920, C_G = 2176;
constexpr int DFF = 2816;
constexpr float L2E = 1.4426950408889634f;

constexpr size_t MiB = 1u << 20;
constexpr size_t WS_CTL = 0;
constexpr size_t WS_W = 1 * MiB;
constexpr size_t WL_STRIDE = 32 * MiB;
constexpr size_t WO_WIN = 0;
constexpr size_t WO_WOUT = 5 * MiB;
constexpr size_t WO_WGU = 7 * MiB;
constexpr size_t WO_WD = 18 * MiB;
constexpr size_t WO_W1 = 24 * MiB;
constexpr size_t WO_SS1 = 26 * MiB;
constexpr size_t WO_SS2 = 30 * MiB;
constexpr size_t CT_L = 256 * 1024;
constexpr size_t CT_BASE = 64 * 1024;
constexpr size_t CT_AB16 = 0;
constexpr size_t CT_AB1K = 8 * 1024;
constexpr size_t CT_CB1 = 16 * 1024;
constexpr size_t CT_W2T = 20 * 1024;
constexpr size_t CT_WGLU = 84 * 1024;
constexpr size_t WS_ACT = WS_W + 2 * WL_STRIDE;
constexpr size_t WS_PROJ = WS_ACT + 64 * MiB;
constexpr size_t WS_OATT = WS_PROJ + 176 * MiB;
constexpr size_t WS_OSSM = WS_OATT + 48 * MiB;
constexpr size_t WS_YS2 = WS_OSSM + 16 * MiB;
constexpr size_t WS_YI = WS_ACT;
constexpr size_t WS_HL = WS_YS2 + 16 * MiB;
constexpr size_t WS_HIN = WS_HL + 16 * MiB;
constexpr size_t WS_VTS = WS_HIN + 16 * MiB;
constexpr size_t WS_VTW = WS_VTS + 12 * MiB;
constexpr size_t WS_KC = WS_VTW + 12 * MiB;
constexpr size_t WS_VCT = WS_KC + 1 * MiB;
constexpr size_t WS_HIDC = WS_VCT + 1 * MiB;
constexpr size_t WS_MISC = WS_HIDC + 6 * MiB;
constexpr size_t WS_PARK = WS_MISC + 4 * MiB;
constexpr size_t WS_KFS = WS_PARK + 16 * MiB;
constexpr size_t WS_SST = WS_KFS + 12 * MiB;
constexpr size_t WS_SSX = WS_SST + 1 * MiB;
constexpr size_t WS_UC = WS_SSX + 1 * MiB;
constexpr size_t WS_END = WS_UC + 16 * MiB;
constexpr size_t WS_XLAST = WS_PROJ + 96 * MiB;
constexpr size_t MS_L = 2 * MiB;
constexpr size_t MS_MTAB = 0;
constexpr size_t MS_CBP = 256 * 1024;
constexpr size_t MS_WGLU = 512 * 1024;
constexpr size_t MS_BBAR = 1024 * 1024;
constexpr size_t MS_FTAB = 1024 * 1024 + 128 * 1024;

constexpr int LDS_BYTES = 143360;

struct Params { const float* in[26]; float* out; unsigned char* ws; };

namespace pg8 {
constexpr int BM = 256, BK = 64, HALF = 128, HTB = HALF * BK * 2, STAGE_BYTES = 8 * HTB, NXCD = 8, WGM = 8;
__host__ __device__ __forceinline__ int lds_byte(int r, int c) { const int st = (r >> 4) * 2 + (c >> 5), rr = r & 15, cc = c & 31, ob = rr * 64 + cc * 2; return st * 1024 + (ob ^ (((ob >> 9) & 1) << 5)); }
__host__ __device__ __forceinline__ void stage_rc(int b, int& R, int& C) { const int st = b / 1024, sb = b % 1024, swz = sb ^ (((sb >> 9) & 1) << 5); R = (st >> 1) * 16 + swz / 64; C = (st & 1) * 32 + (swz % 64) / 2; }
__host__ __device__ __forceinline__ int perm32(int rho) { const int n = rho >> 4, i = rho & 15; return 8 * (i >> 2) + 4 * n + (i & 3); }
struct Unit { int pm, pn, part; };
constexpr int ROWTAB_OFF = STAGE_BYTES;
struct StaticOrder {
    int nM, nN, nwg, G, c, lmode = 0, lbase = 0, lpn = 0, lcount = 0;
    __device__ void init(int nM_, int nN_, int G_, int c_) { nM = nM_; nN = nN_; nwg = nM * nN; G = G_; c = c_; lmode = 0; }
    __device__ void init_run(int base, int pn, int count) { lmode = 1; lbase = base; lpn = pn; lcount = count; nM = 0; nN = 0; nwg = 0; G = 1; c = 0; }
    __device__ bool next(int i, Unit& u) const {
        if (lmode == 1) { if (i >= lcount) return false; u.pm = lbase + i; u.pn = lpn; return true; }
        const long L = (long)i * G + c; if (L >= nwg) return false;
        int wgid = (int)L; { const int q = nwg / NXCD, r = nwg % NXCD, xcd = wgid % NXCD, off = wgid / NXCD; wgid = (xcd < r ? xcd * (q + 1) : r * (q + 1) + (xcd - r) * q) + off; }
        const int nig = WGM * nN, gid = wgid / nig, fm = gid * WGM, gsz = (nM - fm) < WGM ? (nM - fm) : WGM;
        u.pm = fm + ((wgid % nig) % gsz); u.pn = (wgid % nig) / gsz; return true;
    }
};

template <class Epi, class Addr, bool ALIGN_EPI, bool FP8 = false>
__device__ __forceinline__ void gemm_phase(LAS unsigned char* lds, const Addr& g, const StaticOrder& S, const Epi& E, int tid) {
    asm volatile("" : "+v"(tid));
    const int wid = __builtin_amdgcn_readfirstlane(tid >> 6), lane = tid & 63, wr = wid >> 2, wc = wid & 3, fr = lane & 15, fq = lane >> 4;
    const int K = g.K(), nt0 = K / BK;
    unsigned voffA[2], voffB[2];
#pragma unroll
    for (int i = 0; i < 2; ++i) { int R, C; stage_rc(tid * 16 + i * 8192, R, C); const int Rb = Epi::PERM ? ((R & ~31) + perm32(R & 31)) : R;
        voffA[i] = (unsigned)R * g.a_row_bytes() + g.a_col_off(C); voffB[i] = (unsigned)(Rb * K + C) * 2u; }
    const size_t kstepA = g.a_kstep(), kstepB = (size_t)(BK * 2);
    const size_t hstepA = (size_t)HALF * g.a_row_bytes(), hstepB = (size_t)HALF * K * 2;
    const unsigned ldsw = (unsigned)wid * 1024u;
    const int aoff = lds_byte(wr * 64 + fr, fq * 8), boff = lds_byte(wc * 32 + fr, fq * 8);
#define PG8_SA(b, h) (((b) * 2 + (h)) * HTB)
#define PG8_SB(b, h) ((4 + (b) * 2 + (h)) * HTB)
#define PG8_STAGE(bufoff, gbase, voff) do { _Pragma("unroll") for (int _i = 0; _i < 2; ++_i) \
        __builtin_amdgcn_global_load_lds((const unsigned*)((const char*)(gbase) + (voff)[_i]), (LAS unsigned*)(lds + (bufoff) + ldsw + _i * 8192), 16, 0, 0); } while (0)
#define PG8_LDA(dst, b, h) do { _Pragma("unroll") for (int m = 0; m < 4; ++m) _Pragma("unroll") for (int k = 0; k < 2; ++k) dst[m][k] = *(const LAS bf16x8*)(lds + PG8_SA(b, h) + aoff + m * 2048 + k * 1024); } while (0)
#define PG8_LDB(dst, b, h) do { _Pragma("unroll") for (int n = 0; n < 2; ++n) _Pragma("unroll") for (int k = 0; k < 2; ++k) dst[n][k] = *(const LAS bf16x8*)(lds + PG8_SB(b, h) + boff + n * 2048 + k * 1024); } while (0)
#define PG8_CAT(x, y) __builtin_bit_cast(i32x8, __builtin_shufflevector((x), (y), 0, 1, 2, 3, 4, 5, 6, 7, 8, 9, 10, 11, 12, 13, 14, 15))
#define PG8_MMA(ai, bj, At, Bt) do { __builtin_amdgcn_s_setprio(1); _Pragma("unroll") for (int m = 0; m < 4; ++m) _Pragma("unroll") for (int n = 0; n < 2; ++n) { \
        if constexpr (FP8) { const i32x8 bw_ = PG8_CAT(Bt[n][0], Bt[n][1]), aw_ = PG8_CAT(At[m][0], At[m][1]); \
            asm volatile("v_mfma_f32_16x16x128_f8f6f4 %0, %1, %2, %0" : "+v"(acc[ai][bj][m][n]) : "v"(bw_), "v"(aw_));   } \
        else { _Pragma("unroll") for (int k = 0; k < 2; ++k) acc[ai][bj][m][n] = __builtin_amdgcn_mfma_f32_16x16x32_bf16(Bt[n][k], At[m][k], acc[ai][bj][m][n], 0, 0, 0); } } \
        __builtin_amdgcn_s_setprio(0); } while (0)
#define PG8_WAIT_V(n) asm volatile("s_waitcnt vmcnt(" #n ")" ::: "memory")
#define PG8_WAIT_L(n) asm volatile("s_waitcnt lgkmcnt(" #n ")" ::: "memory")
#define PG8_BAR __builtin_amdgcn_s_barrier()
#define PG8_SCHED __builtin_amdgcn_sched_barrier(0)
    Unit cur, nxt; int ui = 0;
    constexpr bool SPLIT = Epi::MID_T > 0;
    auto get_unit = [&](int i, Unit& u) -> bool { if constexpr (SPLIT) { const bool ok = S.next(i >> 1, u); u.part = i & 1; return ok; } else { const bool ok = S.next(i, u); u.part = 0; return ok; } };
    auto part_off = [&](const Unit& u) -> size_t { if constexpr (SPLIT) return (size_t)u.part * (Epi::MID_T * BK * 2); else return 0; };
    if (!get_unit(0, cur)) return;
    f32x4 acc[2][2][4][2];
#pragma unroll
    for (int a = 0; a < 2; ++a)
#pragma unroll
        for (int b = 0; b < 2; ++b)
#pragma unroll
            for (int m = 0; m < 4; ++m)
#pragma unroll
                for (int n = 0; n < 2; ++n) acc[a][b][m][n] = (f32x4){0.f, 0.f, 0.f, 0.f};
    bf16x8 At[4][2], B0[2][2], B1[2][2];
    const char* cA = g.a_base(cur) + part_off(cur); const char* cB = g.b_base(cur) + part_off(cur);
    PG8_STAGE(PG8_SB(0, 0), cB, voffB); PG8_STAGE(PG8_SB(0, 1), cB + hstepB, voffB); PG8_STAGE(PG8_SA(0, 0), cA, voffA); PG8_STAGE(PG8_SA(0, 1), cA + hstepA, voffA);
    if (wr == 1) PG8_BAR;
    PG8_WAIT_V(2); PG8_BAR;
    PG8_STAGE(PG8_SB(1, 0), cB + kstepB, voffB); PG8_STAGE(PG8_SA(1, 0), cA + kstepA, voffA); PG8_STAGE(PG8_SB(1, 1), cB + hstepB + kstepB, voffB);
    PG8_WAIT_V(6); PG8_BAR;
    for (;;) {
        const bool has_next = get_unit(ui + 1, nxt);
        const char* nA = has_next ? g.a_base(nxt) + part_off(nxt) : cA; const char* nB = has_next ? g.b_base(nxt) + part_off(nxt) : cB;
        int nt = nt0; if constexpr (SPLIT) nt = cur.part ? nt0 - Epi::MID_T : Epi::MID_T;
        for (int t = 0; t < nt; t += 2) {
            const bool last = (t == nt - 2);
            if constexpr (Epi::ROWTAB) {
                if (t == 0 && wid < 4 && cur.part == 0) {
                    int l_; asm volatile("v_mbcnt_lo_u32_b32 %0, -1, 0\n\tv_mbcnt_hi_u32_b32 %0, -1, %0" : "=v"(l_));
                    __builtin_amdgcn_global_load_lds((const unsigned*)(E.rowtab + ((size_t)cur.pm * BM + wid * 64 + l_) * 2), (LAS unsigned*)(lds + ROWTAB_OFF + ((SPLIT ? (ui >> 1) : ui) & 1) * 4096 + wid * 1024), 16, 0, 0); } }
            const char* a1 = cA + (size_t)(t + 1) * kstepA;
            const char* a2 = last ? nA : cA + (size_t)(t + 2) * kstepA; const char* b2 = last ? nB : cB + (size_t)(t + 2) * kstepB;
            const char* a3 = a2 + kstepA; const char* b3 = b2 + kstepB;
            PG8_LDB(B0, 0, 0); PG8_LDB(B1, 0, 1); PG8_SCHED; PG8_LDA(At, 0, 0); PG8_STAGE(PG8_SA(1, 1), a1 + hstepA, voffA);
            PG8_WAIT_V(8); PG8_WAIT_L(0); PG8_BAR; PG8_MMA(0, 0, At, B0); PG8_MMA(0, 1, At, B1); PG8_BAR; PG8_SCHED;
            PG8_LDA(At, 0, 1); PG8_STAGE(PG8_SB(0, 0), b2, voffB); PG8_STAGE(PG8_SB(0, 1), b2 + hstepB, voffB); PG8_STAGE(PG8_SA(0, 0), a2, voffA);
            PG8_WAIT_V(8); PG8_WAIT_L(0); PG8_BAR; PG8_MMA(1, 0, At, B0); PG8_MMA(1, 1, At, B1); PG8_BAR; PG8_SCHED;
            PG8_LDB(B0, 1, 0); PG8_LDB(B1, 1, 1); PG8_SCHED; PG8_LDA(At, 1, 0); PG8_STAGE(PG8_SA(0, 1), a2 + hstepA, voffA);
            PG8_WAIT_V(8); PG8_WAIT_L(0); PG8_BAR; PG8_MMA(0, 0, At, B0); PG8_MMA(0, 1, At, B1); PG8_BAR; PG8_SCHED;
            PG8_LDA(At, 1, 1); PG8_STAGE(PG8_SB(1, 0), b3, voffB); PG8_STAGE(PG8_SB(1, 1), b3 + hstepB, voffB); PG8_STAGE(PG8_SA(1, 0), a3, voffA);
            PG8_WAIT_V(8); PG8_WAIT_L(0); PG8_BAR; PG8_MMA(1, 0, At, B0); PG8_MMA(1, 1, At, B1); PG8_BAR; PG8_SCHED;
        }
        if constexpr (ALIGN_EPI) { if (wr == 0) PG8_BAR; }
        if constexpr (FP8) asm volatile("s_nop 15\n\ts_nop 15" ::: "memory");
        { int le_; asm volatile("v_mbcnt_lo_u32_b32 %0, -1, 0\n\tv_mbcnt_hi_u32_b32 %0, -1, %0" : "=v"(le_)); const int fr_e = le_ & 15, fq_e = le_ >> 4;
          if constexpr (Epi::ROWTAB) {
              const LAS unsigned long long* tab = (const LAS unsigned long long*)(lds + ROWTAB_OFF + ((SPLIT ? (ui >> 1) : ui) & 1) * 4096);
              if (SPLIT && cur.part == 0) {
                  const LAS unsigned long long* tb = tab + (wr * 64 + fr_e) * 2;
#pragma unroll
                  for (int a = 0; a < 2; ++a)
#pragma unroll
                      for (int m = 0; m < 4; ++m) { const float ratio = Epi::row_ratio(tb[(a * HALF + m * 16) * 2], tb[(a * HALF + m * 16) * 2 + 1]);
#pragma unroll
                          for (int b = 0; b < 2; ++b)
#pragma unroll
                              for (int n = 0; n < 2; ++n) acc[a][b][m][n] = acc[a][b][m][n] * ratio; }
              } else E(acc, cur, wr, wc, fr_e, fq_e, tab);
          } else E(acc, cur, wr, wc, fr_e, fq_e); }
        if (!has_next) break;
        if (!SPLIT || cur.part != 0) {
#pragma unroll
        for (int a = 0; a < 2; ++a)
#pragma unroll
            for (int b = 0; b < 2; ++b)
#pragma unroll
                for (int m = 0; m < 4; ++m)
#pragma unroll
                    for (int n = 0; n < 2; ++n) acc[a][b][m][n] = (f32x4){0.f, 0.f, 0.f, 0.f};
        }
        cur = nxt; cA = nA; cB = nB; ++ui;
        if constexpr (ALIGN_EPI) { if (wr == 1) PG8_BAR; }
    }
    PG8_WAIT_V(0);
    if constexpr (!ALIGN_EPI) { if (wr == 0) PG8_BAR; }
    PG8_BAR;
#undef PG8_SA
#undef PG8_SB
#undef PG8_STAGE
#undef PG8_LDA
#undef PG8_LDB
#undef PG8_MMA
#undef PG8_CAT
#undef PG8_WAIT_V
#undef PG8_WAIT_L
#undef PG8_BAR
#undef PG8_SCHED
}

struct APlain {
    const char* A; const char* Bt; int k; int sw = 0x7f7f7f7f, sa = 0x7f7f7f7f;
    DI int scale_w() const { return sw; } DI int scale_a() const { return sa; }
    DI int K() const { return k; }
    DI unsigned a_row_bytes() const { return (unsigned)k * 2u; }
    DI unsigned a_kstep() const { return 128u; }
    DI unsigned a_col_off(int C) const { return (unsigned)C * 2u; }
    DI const char* a_base(const Unit& u) const { return A + (size_t)u.pm * 256 * k * 2; }
    DI const char* b_base(const Unit& u) const { return Bt + (size_t)u.pn * 256 * k * 2; }
};
struct ACompress {
    const char* proj; const char* w1t;
    DI int scale_w() const { return 0x7f7f7f7f; } DI int scale_a() const { return 0x7f7f7f7f; }
    DI int K() const { return 2048; }
    DI unsigned a_row_bytes() const { return 16u * PW * 2u; }
    DI unsigned a_kstep() const { return (unsigned)PW * 2u; }
    DI unsigned a_col_off(int C) const { return (unsigned)C * 2u; }
    DI const char* a_base(const Unit& u) const { const int kv = u.pm / 24, r = u.pm % 24, bh = r >> 2, qt = r & 3, b = bh / 3, h = bh % 3;
        return proj + ((size_t)(b * SEQ + 4096 * qt) * PW + (kv ? C_VC : C_KC) + h * 64) * 2; }
    DI const char* b_base(const Unit& u) const { return w1t + (size_t)(u.pm / 24) * 256 * 2048 * 2; }
};
struct ASsm1 {
    const char* uc; const char* ss1;
    DI int scale_w() const { return 0x7f7f7f7f; } DI int scale_a() const { return 0x7f7f7f7f; }
    DI int K() const { return 256; }
    DI unsigned a_row_bytes() const { return 512u; }
    DI unsigned a_kstep() const { return 128u; }
    DI unsigned a_col_off(int C) const { return (unsigned)C * 2u; }
    DI const char* a_base(const Unit& u) const { const int bg = u.pm >> 2, qt = u.pm & 3; return uc + ((size_t)bg * SEQ + 4096 * qt) * 32; }
    DI const char* b_base(const Unit& u) const { const int gi = (u.pm >> 2) & 15; return ss1 + ((size_t)gi * 512 + (size_t)u.pn * 256) * 256 * 2; }
};
struct ASsm2 {
    const char* hin; const char* ss2;
    DI int scale_w() const { return 0x7f7f7f7f; } DI int scale_a() const { return 0x7f7f7f7f; }
    DI int K() const { return 256; }
    DI unsigned a_row_bytes() const { return 512u; }
    DI unsigned a_kstep() const { return 128u; }
    DI unsigned a_col_off(int C) const { return (unsigned)C * 2u; }
    DI const char* a_base(const Unit& u) const { return hin + (size_t)u.pm * 256 * 512; }
    DI const char* b_base(const Unit& u) const { const int gi = (u.pm >> 2) & 15; return ss2 + (size_t)gi * 256 * 256 * 2; }
};

struct EpiBf16 {
    static constexpr bool PERM = true; static constexpr bool ROWTAB = true; static constexpr int MID_T = -1;
    bf16_t* O; int ldc; const unsigned long long* rowtab;
    static DI float row_ratio(unsigned long long, unsigned long long) { return 1.f; }
    DI void operator()(const f32x4 (&acc)[2][2][4][2], const Unit& u, int wr, int wc, int fr, int fq, const LAS unsigned long long* tab) const {
        const int row0 = u.pm * BM + wr * 64 + fr, col0 = u.pn * BM + wc * 32 + 8 * fq;
        const int ubj = (u.pn == C_U / 256) ? 1 : ((u.pn == C_U / 256 + 1) ? 0 : -1);
#pragma unroll
        for (int ai = 0; ai < 2; ++ai)
#pragma unroll
            for (int m = 0; m < 4; ++m) { bf16_t* rowp = O + (size_t)(row0 + ai * HALF + m * 16) * ldc + col0;
                const float sc = rsqrtf((float)tab[(wr * 64 + fr + ai * HALF + m * 16) * 2] * (1.f / (1048576.f * DM)) + 1e-6f);
#pragma unroll
                for (int bj = 0; bj < 2; ++bj) { const f32x4 v0 = acc[ai][bj][m][0] * sc, v1 = acc[ai][bj][m][1] * sc;
                    u32x4 w; w.x = pk2(v0[0], v0[1]); w.y = pk2(v0[2], v0[3]); w.z = pk2(v1[0], v1[1]); w.w = pk2(v1[2], v1[3]);
                    *(u32x4*)(rowp + bj * HALF) = w;
                    if (bj == ubj) { const int row = row0 + ai * HALF + m * 16, ucol = col0 + bj * HALF - C_U;
                        bf16_t* uc = (bf16_t*)((unsigned char*)O + (WS_UC - WS_PROJ));
                        *(u32x4*)(uc + (((size_t)((row >> 14) * 16 + (ucol >> 4)) * SEQ + (row & (SEQ - 1))) * 16 + (ucol & 15))) = w; } } }
    }
};
struct EpiCmpHid {
    static constexpr bool PERM = true; static constexpr bool ROWTAB = false; static constexpr int MID_T = -1;
    bf16_t* O; const float* cb1;
    DI void operator()(const f32x4 (&acc)[2][2][4][2], const Unit& u, int wr, int wc, int fr, int fq) const {
        const int row0 = u.pm * BM + wr * 64 + fr, col0 = wc * 32 + 8 * fq; const float* bb = cb1 + (u.pm / 24) * 256;
        f32x4 bv[2][2];
#pragma unroll
        for (int bj = 0; bj < 2; ++bj)
#pragma unroll
            for (int n = 0; n < 2; ++n) bv[bj][n] = *(const f32x4*)(bb + col0 + bj * HALF + 4 * n);
#pragma unroll
        for (int ai = 0; ai < 2; ++ai)
#pragma unroll
            for (int m = 0; m < 4; ++m) { bf16_t* rowp = O + (size_t)(row0 + ai * HALF + m * 16) * 256 + col0;
#pragma unroll
                for (int bj = 0; bj < 2; ++bj) { f32x4 v0 = acc[ai][bj][m][0] + bv[bj][0], v1 = acc[ai][bj][m][1] + bv[bj][1];
#pragma unroll
                    for (int e = 0; e < 4; ++e) { v0[e] = gelu_tanh(v0[e]); v1[e] = gelu_tanh(v1[e]); }
                    u32x4 w; w.x = pk2(v0[0], v0[1]); w.y = pk2(v0[2], v0[3]); w.z = pk2(v1[0], v1[1]); w.w = pk2(v1[2], v1[3]);
                    *(u32x4*)(rowp + bj * HALF) = w; } }
    }
};
struct EpiSsm1 {
    static constexpr bool PERM = false; static constexpr bool ROWTAB = false; static constexpr int MID_T = -1;
    float* YI; float* HL;
    DI void operator()(const f32x4 (&acc)[2][2][4][2], const Unit& u, int wr, int wc, int fr, int fq) const {
        const int row0 = u.pm * BM + wr * 64 + fr, col0 = wc * 32 + 4 * fq;
#pragma unroll
        for (int ai = 0; ai < 2; ++ai)
#pragma unroll
            for (int m = 0; m < 4; ++m) { const size_t row = (size_t)(row0 + ai * HALF + m * 16);
                if (u.pn == 0) {
#pragma unroll
                    for (int bj = 0; bj < 2; ++bj)
#pragma unroll
                        for (int n = 0; n < 2; ++n) *(f32x4*)(YI + row * 256 + col0 + bj * HALF + n * 16) = acc[ai][bj][m][n];
                } else {
#pragma unroll
                    for (int n = 0; n < 2; ++n) *(f32x4*)(HL + row * 128 + col0 + n * 16) = acc[ai][0][m][n];
                } }
    }
};
struct EpiSsm2 {
    static constexpr bool PERM = false; static constexpr bool ROWTAB = false; static constexpr int MID_T = -1;
    const float* YI; const bf16_t* proj; const float* dskip; bf16_t* YS2;
    DI void operator()(const f32x4 (&acc)[2][2][4][2], const Unit& u, int wr, int wc, int fr, int fq) const {
        const int row0 = u.pm * BM + wr * 64 + fr, col0 = wc * 32 + 4 * fq;
        const int bg = u.pm >> 2, b = bg >> 4, gi = bg & 15;
        const f32x4 dsk = *(const f32x4*)(dskip + gi * 16 + 4 * fq);
#pragma unroll
        for (int ai = 0; ai < 2; ++ai)
#pragma unroll
            for (int m = 0; m < 4; ++m) { const int row = row0 + ai * HALF + m * 16; const int chunk = row & 1023;
#pragma unroll
                for (int bj = 0; bj < 2; ++bj)
#pragma unroll
                    for (int n = 0; n < 2; ++n) { const int col = col0 + bj * HALF + n * 16, tau = col >> 4;
                        const size_t tok = (size_t)b * SEQ + chunk * 16 + tau;
                        const f32x4 yi = *(const f32x4*)(YI + (size_t)row * 256 + col);
                        const u32x2 uw = *(const u32x2*)(proj + tok * PW + C_U + gi * 16 + 4 * fq);
                        f32x4 y = acc[ai][bj][m][n] + yi;
                        y[0] += dsk[0] * bflo(uw.x); y[1] += dsk[1] * bfhi(uw.x); y[2] += dsk[2] * bflo(uw.y); y[3] += dsk[3] * bfhi(uw.y);
                        u32x2 w; w.x = pk2(gelu_tanh(y[0]), gelu_tanh(y[1])); w.y = pk2(gelu_tanh(y[2]), gelu_tanh(y[3]));
                        *(u32x2*)(YS2 + tok * 256 + gi * 16 + 4 * fq) = w; } }
    }
};
struct EpiGlu {
    static constexpr bool PERM = true; static constexpr bool ROWTAB = false; static constexpr int MID_T = -1;
    bf16_t* O; const float* bglu; unsigned long long* sst;
    DI void operator()(const f32x4 (&acc)[2][2][4][2], const Unit& u, int wr, int wc, int fr, int fq) const {
        const int row0 = u.pm * BM + wr * 64 + fr, col0 = u.pn * HALF + wc * 32 + 8 * fq;
        f32x4 bvv[2], bgg[2];
#pragma unroll
        for (int n = 0; n < 2; ++n) { bvv[n] = *(const f32x4*)(bglu + col0 + 4 * n); bgg[n] = *(const f32x4*)(bglu + 256 + col0 + 4 * n); }
#pragma unroll
        for (int ai = 0; ai < 2; ++ai)
#pragma unroll
            for (int m = 0; m < 4; ++m) { const int row = row0 + ai * HALF + m * 16; bf16_t* rowp = O + (size_t)row * 1024 + 768 + col0;
                f32x4 o[2];
#pragma unroll
                for (int n = 0; n < 2; ++n) { const f32x4 v = acc[ai][0][m][n] + bvv[n], gt = acc[ai][1][m][n] + bgg[n];
#pragma unroll
                    for (int e = 0; e < 4; ++e) o[n][e] = v[e] * sigmoidf_(gt[e]); }
                u32x4 w; w.x = pk2(o[0][0], o[0][1]); w.y = pk2(o[0][2], o[0][3]); w.z = pk2(o[1][0], o[1][1]); w.w = pk2(o[1][2], o[1][3]);
                *(u32x4*)rowp = w;
                const f32x4 q = o[0] * o[0] + o[1] * o[1]; const float t = xor32_sum(xor16_sum((q[0] + q[1]) + (q[2] + q[3])));
                if (fq == 0) (void)__hip_atomic_fetch_add(sst + (size_t)row * 2 + 1, (unsigned long long)(t * 16777216.f), __ATOMIC_RELAXED, __HIP_MEMORY_SCOPE_AGENT); }
    }
};
struct EpiSwiglu8 {
    static constexpr bool PERM = true; static constexpr bool ROWTAB = false; static constexpr int MID_T = -1;
    unsigned char* O; float asc;
    DI void operator()(const f32x4 (&acc)[2][2][4][2], const Unit& u, int wr, int wc, int fr, int fq) const {
        const int row0 = u.pm * BM + wr * 64 + fr, col0 = u.pn * HALF + wc * 32 + 8 * fq;
#pragma unroll
        for (int ai = 0; ai < 2; ++ai)
#pragma unroll
            for (int m = 0; m < 4; ++m) { unsigned char* rowp = O + (size_t)(row0 + ai * HALF + m * 16) * DFF + col0;
                f32x4 o[2];
#pragma unroll
                for (int n = 0; n < 2; ++n) { const f32x4 gt = acc[ai][0][m][n] * asc, up = acc[ai][1][m][n] * asc;
#pragma unroll
                    for (int e = 0; e < 4; ++e) o[n][e] = 4.0f * gt[e] * sigmoidf_(gt[e]) * up[e]; }
                u32x2 w; w.x = pk4_fp8(o[0][0], o[0][1], o[0][2], o[0][3]); w.y = pk4_fp8(o[1][0], o[1][1], o[1][2], o[1][3]);
                *(u32x2*)rowp = w; }
    }
};
struct EpiSwiglu {
    static constexpr bool PERM = true; static constexpr bool ROWTAB = false; static constexpr int MID_T = -1;
    bf16_t* O;
    DI void operator()(const f32x4 (&acc)[2][2][4][2], const Unit& u, int wr, int wc, int fr, int fq) const {
        const int row0 = u.pm * BM + wr * 64 + fr, col0 = u.pn * HALF + wc * 32 + 8 * fq;
#pragma unroll
        for (int ai = 0; ai < 2; ++ai)
#pragma unroll
            for (int m = 0; m < 4; ++m) { bf16_t* rowp = O + (size_t)(row0 + ai * HALF + m * 16) * DFF + col0;
                f32x4 o[2];
#pragma unroll
                for (int n = 0; n < 2; ++n) { const f32x4 gt = acc[ai][0][m][n], up = acc[ai][1][m][n];
#pragma unroll
                    for (int e = 0; e < 4; ++e) o[n][e] = gt[e] * sigmoidf_(gt[e]) * up[e]; }
                u32x4 w; w.x = pk2(o[0][0], o[0][1]); w.y = pk2(o[0][2], o[0][3]); w.z = pk2(o[1][0], o[1][1]); w.w = pk2(o[1][2], o[1][3]);
                *(u32x4*)rowp = w; }
    }
};
struct EpiResF32 {
    static constexpr bool PERM = false; static constexpr bool ROWTAB = false; static constexpr int MID_T = -1;
    const float* base; float* out; float asc = 1.0f;
    DI void operator()(const f32x4 (&acc)[2][2][4][2], const Unit& u, int wr, int wc, int fr, int fq) const {
        const int row0 = u.pm * BM + wr * 64 + fr, col0 = u.pn * BM + wc * 32 + 4 * fq;
#pragma unroll
        for (int ai = 0; ai < 2; ++ai)
#pragma unroll
            for (int m = 0; m < 4; ++m) { const size_t off = (size_t)(row0 + ai * HALF + m * 16) * DM + col0;
#pragma unroll
                for (int bj = 0; bj < 2; ++bj)
#pragma unroll
                    for (int n = 0; n < 2; ++n) { const f32x4 bs = *(const f32x4*)(base + off + bj * HALF + n * 16);
                        *(f32x4*)(out + off + bj * HALF + n * 16) = bs + acc[ai][bj][m][n] * asc; } }
    }
};
template <bool MID, int ASC_EXP>
struct EpiResB {
    static constexpr bool PERM = true; static constexpr bool ROWTAB = MID; static constexpr int MID_T = MID ? 12 : -1;
    static constexpr float asc = 1.0f / (float)(1 << ASC_EXP);
    const float* basef; const bf16_t* baseb; bf16_t* out; const unsigned long long* rowtab; unsigned long long* ssx;
    static DI float rstd_a(unsigned long long v) { return rsqrtf((float)v * (1.f / (16777216.f * 768.f)) + 1e-6f); }
    static DI float rstd_s(unsigned long long v) { return rsqrtf((float)v * (1.f / (16777216.f * 256.f)) + 1e-6f); }
    static DI float row_ratio(unsigned long long a, unsigned long long s_) { return rstd_a(a) / rstd_s(s_); }
    template <bool F32B>
    DI void run(const f32x4 (&acc)[2][2][4][2], const Unit& u, int wr, int wc, int fr, int fq, const LAS unsigned long long* tab) const {
        const int row0 = u.pm * BM + wr * 64 + fr, col0 = u.pn * BM + wc * 32 + 8 * fq;
#pragma unroll
        for (int ai = 0; ai < 2; ++ai)
#pragma unroll
            for (int m = 0; m < 4; ++m) { const int row = row0 + ai * HALF + m * 16; const size_t off = (size_t)row * DM + col0; float sq = 0.f;
                float sc = asc; if constexpr (MID) sc = asc * rstd_s(tab[(wr * 64 + fr + ai * HALF + m * 16) * 2 + 1]);
#pragma unroll
                for (int bj = 0; bj < 2; ++bj) { f32x4 b0, b1;
                    if constexpr (F32B) { b0 = *(const f32x4*)(basef + off + bj * HALF); b1 = *(const f32x4*)(basef + off + bj * HALF + 4); }
                    else { const u32x4 b = *(const u32x4*)(baseb + off + bj * HALF); b0 = f32x4{bflo(b.x), bfhi(b.x), bflo(b.y), bfhi(b.y)}; b1 = f32x4{bflo(b.z), bfhi(b.z), bflo(b.w), bfhi(b.w)}; }
                    const f32x4 v0 = b0 + acc[ai][bj][m][0] * sc, v1 = b1 + acc[ai][bj][m][1] * sc;
                    u32x4 w; w.x = pk2(v0[0], v0[1]); w.y = pk2(v0[2], v0[3]); w.z = pk2(v1[0], v1[1]); w.w = pk2(v1[2], v1[3]);
                    *(u32x4*)(out + off + bj * HALF) = w;
                    if constexpr (!MID) { const f32x4 q = v0 * v0 + v1 * v1; sq += (q[0] + q[1]) + (q[2] + q[3]); } }
                if constexpr (!MID) { if (ssx != nullptr) { const float t = xor32_sum(xor16_sum(sq));
                    if (fq == 0) (void)__hip_atomic_fetch_add(ssx + (size_t)row * 2, (unsigned long long)(t * 1048576.f), __ATOMIC_RELAXED, __HIP_MEMORY_SCOPE_AGENT); } } }
    }
    DI void operator()(const f32x4 (&acc)[2][2][4][2], const Unit& u, int wr, int wc, int fr, int fq, const LAS unsigned long long* tab = nullptr) const {
        if (basef != nullptr) run<true>(acc, u, wr, wc, fr, fq, tab); else run<false>(acc, u, wr, wc, fr, fq, tab);
    }
};
}

struct Frame {
    LAS unsigned char* lds;
    LAS const unsigned long long* pt;
    int tid, lane, wave, G, gw, ngw, bid;
    DI const float* in(int i) const { const unsigned long long v = pt[i]; const unsigned lo = __builtin_amdgcn_readfirstlane((unsigned)v), hi = __builtin_amdgcn_readfirstlane((unsigned)(v >> 32));
        return (const float*)(const __attribute__((address_space(1))) float*)(((unsigned long long)hi << 32) | lo); }
    DI float* out() const { return (float*)in(26); }
    DI unsigned char* wsp() const { return (unsigned char*)in(27); }
};
constexpr int LDS_PT = LDS_BYTES - 256;

DI void transpose_item(const float* W, int K, int ldw, int nvalid, bf16_t* WT, int drow0, LAS float* scr, int k0, int n0, float scale, int lane, const float* gam64 = nullptr) {
    if (n0 + 32 <= nvalid) {
        const int n4 = (lane & 7) * 4; f32x4 v[8];
#pragma unroll
        for (int i = 0; i < 8; ++i) v[i] = *(const f32x4*)(W + (size_t)(k0 + 8 * i + (lane >> 3)) * ldw + n0 + n4);
        if (gam64 != nullptr) {
#pragma unroll
            for (int i = 0; i < 8; ++i) v[i] = v[i] * gam64[8 * i + (lane >> 3)];
        }
#pragma unroll
        for (int i = 0; i < 8; ++i) { LAS float* s = scr + (8 * i + (lane >> 3)) * 33 + n4; s[0] = v[i].x * scale; s[1] = v[i].y * scale; s[2] = v[i].z * scale; s[3] = v[i].w * scale; }
    } else {
    const int nn = n0 + (lane & 31); const bool ok = nn < nvalid;
#pragma unroll 8
    for (int i = 0; i < 32; ++i) { const int kk = 2 * i + (lane >> 5); scr[kk * 33 + (lane & 31)] = ok ? W[(size_t)(k0 + kk) * ldw + nn] * scale : 0.f; }
    }
    asm volatile("s_waitcnt lgkmcnt(0)" ::: "memory");
    const int c = lane & 7;
#pragma unroll
    for (int j = 0; j < 4; ++j) { const int n = (lane >> 3) + 8 * j; const LAS float* s = scr + (8 * c) * 33 + n;
        u32x4 o; o.x = pk2(s[0 * 33], s[1 * 33]); o.y = pk2(s[2 * 33], s[3 * 33]); o.z = pk2(s[4 * 33], s[5 * 33]); o.w = pk2(s[6 * 33], s[7 * 33]);
        *(u32x4*)(WT + (size_t)(drow0 + n) * K + k0 + 8 * c) = o; }
    asm volatile("s_waitcnt lgkmcnt(0)" ::: "memory");
}

DI void transpose_item_fp8(const float* W, int K, int ldw, unsigned char* WT, int drow0, LAS float* scr, int k0, int n0, float scale, int lane) {
    const int n4 = (lane & 7) * 4; f32x4 v[8];
#pragma unroll
    for (int i = 0; i < 8; ++i) v[i] = *(const f32x4*)(W + (size_t)(k0 + 8 * i + (lane >> 3)) * ldw + n0 + n4);
#pragma unroll
    for (int i = 0; i < 8; ++i) { LAS float* s = scr + (8 * i + (lane >> 3)) * 33 + n4; s[0] = v[i].x * scale; s[1] = v[i].y * scale; s[2] = v[i].z * scale; s[3] = v[i].w * scale; }
    asm volatile("s_waitcnt lgkmcnt(0)" ::: "memory");
    const int c = lane & 7;
#pragma unroll
    for (int j = 0; j < 4; ++j) { const int n = (lane >> 3) + 8 * j; const LAS float* s = scr + (8 * c) * 33 + n;
        u32x2 o; o.x = pk4_fp8(s[0 * 33], s[1 * 33], s[2 * 33], s[3 * 33]); o.y = pk4_fp8(s[4 * 33], s[5 * 33], s[6 * 33], s[7 * 33]);
        *(u32x2*)(WT + (size_t)(drow0 + n) * K + k0 + 8 * c) = o; }
    asm volatile("s_waitcnt lgkmcnt(0)" ::: "memory");
}

DI int win_dest_row(int n) {
    if (n < 1920) return n;
    if (n < 1956) return C_G + (n - 1920);
    return C_U + (n - 1956);
}

DI void prologue_a(Frame& F, int mode, int gw0, int ngw0) {
    LAS float* scr = (LAS float*)(F.lds + F.wave * 16640);
    constexpr int I_WIN = 16 * 72, I_WOUT = 16 * 32, I_WG = 16 * 88, I_WD = 44 * 32, I_W1 = 2 * 32 * 8, I_WGLU = 4 * 16, I_W2 = 2 * 4 * 2, I_CB = 64, I_M = 1024, I_TAB = 16;
    constexpr int PER_L = I_WIN + I_WOUT + 2 * I_WG + I_WD + I_W1 + I_WGLU + I_W2 + I_CB + I_M + I_TAB;
    const int lane = F.lane;
    constexpr int A1 = I_WIN, A3E = I_WIN + I_WOUT + 2 * I_WG + I_WD, A4E = A3E + I_W1, A5E = A4E + I_WGLU;
    for (int it = gw0; it < NL * PER_L; it += ngw0) {
        const int l = it / PER_L; int r = it % PER_L;
        { const bool late = (r >= A1 && r < A3E) || (r >= A4E && r < A5E) || (l > 0 && (r < A1 || (r >= A3E && r < A4E)));
          if (late != (mode == 1)) continue; }
        unsigned char* wl = F.wsp() + WS_W + (size_t)l * WL_STRIDE;
        unsigned char* ms = F.wsp() + WS_MISC + (size_t)l * MS_L;
        unsigned char* ct = F.wsp() + WS_CTL + CT_BASE + (size_t)l * CT_L;
        if (r < I_WIN) {
            const int kb = r / 72, nb = r % 72, k0 = 64 * kb, n0 = 32 * nb;
            const float* W = F.in(2) + (size_t)l * 1024 * 2212;
            bf16_t* WT = (bf16_t*)(wl + WO_WIN);
            const float* gam = F.in(1) + (size_t)l * DM + k0;
            if (n0 + 32 <= 1920) { transpose_item(W, 1024, 2212, 2212, WT, n0, scr, k0, n0, n0 < 768 ? 0.125f * L2E : 1.0f, lane, gam); }
            else {
                const int d = n0 + (lane & 31);
                int srcn = -1;
                if (d < 1920) srcn = d; else if (d >= C_U && d < C_U + 256) srcn = 1956 + (d - C_U); else if (d >= C_G && d < C_G + 36) srcn = 1920 + (d - C_G);
#pragma unroll 8
                for (int i = 0; i < 32; ++i) { const int kk = 2 * i + (lane >> 5); scr[kk * 33 + (lane & 31)] = srcn >= 0 ? W[(size_t)(k0 + kk) * 2212 + srcn] * gam[kk] : 0.f; }
                asm volatile("s_waitcnt lgkmcnt(0)" ::: "memory");
                const int c = lane & 7;
#pragma unroll
                for (int j = 0; j < 4; ++j) { const int n = (lane >> 3) + 8 * j; const LAS float* s = scr + (8 * c) * 33 + n;
                    u32x4 o; o.x = pk2(s[0 * 33], s[1 * 33]); o.y = pk2(s[2 * 33], s[3 * 33]); o.z = pk2(s[4 * 33], s[5 * 33]); o.w = pk2(s[6 * 33], s[7 * 33]);
                    *(u32x4*)(WT + (size_t)(n0 + n) * 1024 + k0 + 8 * c) = o; }
                asm volatile("s_waitcnt lgkmcnt(0)" ::: "memory");
            }
            continue; }
        r -= I_WIN;
        if (r < I_WOUT) { const int kb = r / 32, nb = r % 32;
            transpose_item(F.in(20) + (size_t)l * 1024 * 1024, 1024, 1024, 1024, (bf16_t*)(wl + WO_WOUT), 32 * nb, scr, 64 * kb, 32 * nb, 1.f, lane, kb < 12 ? F.in(18) + (size_t)l * 768 + 64 * kb : F.in(19) + (size_t)l * 256 + 64 * (kb - 12)); continue; }
        r -= I_WOUT;
        if (r < 2 * I_WG) { const int up = r / I_WG; const int rr = r % I_WG; const int kb = rr / 88, nb = rr % 88, n0 = 32 * nb;
            const int drow = (n0 / 128) * 256 + up * 128 + (n0 % 128);
            transpose_item_fp8(F.in(up ? 23 : 22) + (size_t)l * 1024 * DFF, 1024, DFF, (unsigned char*)(wl + WO_WGU), drow, scr, 64 * kb, n0, 64.f, lane); continue; }
        r -= 2 * I_WG;
        if (r < I_WD) { const int kb = r / 32, nb = r % 32; transpose_item_fp8(F.in(24) + (size_t)l * DFF * 1024, DFF, 1024, (unsigned char*)(wl + WO_WD), 32 * nb, scr, 64 * kb, 32 * nb, 64.f, lane); continue; }
        r -= I_WD;
        if (r < I_W1) { const int kv = r / 256; const int rr = r % 256; const int kb = rr / 8, nb = rr % 8;
            transpose_item(F.in(4) + ((size_t)l * 2 + kv) * 2048 * 256, 2048, 256, 256, (bf16_t*)(wl + WO_W1) + (size_t)kv * 256 * 2048, 32 * nb, scr, 64 * kb, 32 * nb, 1.f, lane); continue; }
        r -= I_W1;
        if (r < I_WGLU) { const int kb = r / 16, nb = r % 16, n0 = 32 * nb; const int gate = n0 >= 256, nn = n0 & 255;
            const int drow = (nn / 128) * 256 + gate * 128 + (nn % 128);
            transpose_item(F.in(16) + (size_t)l * 256 * 512, 256, 512, 512, (bf16_t*)(ms + MS_WGLU), drow, scr, 64 * kb, n0, 1.f, lane); continue; }
        r -= I_WGLU;
        if (r < I_W2) { const int kv = r / 8; const int rr = r % 8; const int kb = rr / 2, nb = rr % 2;
            transpose_item(F.in(6) + ((size_t)l * 2 + kv) * 256 * 64, 256, 64, 64, (bf16_t*)(ct + CT_W2T) + (size_t)kv * 64 * 256, 32 * nb, scr, 64 * kb, 32 * nb, 1.f, lane); continue; }
        r -= I_W2;
        if (r < I_CB) {
            const int kv = r / 32, ch = r % 32; const float* pe = F.in(3) + ((size_t)l * 2 + kv) * 2048; const float* w1 = F.in(4) + ((size_t)l * 2 + kv) * 2048 * 256;
            f32x4 s = {0.f, 0.f, 0.f, 0.f};
#pragma unroll 8
            for (int i = 0; i < 64; ++i) { const int k = 64 * ch + i; const float pv = pe[k]; const f32x4 w = *(const f32x4*)(w1 + (size_t)k * 256 + 4 * lane); s += w * pv; }
            *(f32x4*)((float*)(ms + MS_CBP) + ((size_t)kv * 32 + ch) * 256 + 4 * lane) = s; continue; }
        r -= I_CB;
        if (r < I_M) {
            const int e0 = r * 64; const int gi = e0 >> 12, dl = (e0 >> 8) & 15, cp0 = (e0 >> 4) & 15, n = lane;
            const float dt = __expf(F.in(8)[l * 16 + gi]);
            const float ar = F.in(9)[((size_t)l * 16 + gi) * 64 + n], ai = F.in(10)[((size_t)l * 16 + gi) * 64 + n];
            const float x = dt * ar, y = dt * ai; const float sy = __sinf(y), cy = __cosf(y), sh = __sinf(0.5f * y);
            const float em1 = (fabsf(x) < 0.25f) ? x * (1.f + x * (0.5f + x * (0.16666667f + x * (0.041666668f + x * 0.0083333338f)))) : expm1f(x);
            const float nr = em1 * cy - 2.f * sh * sh; const float abi = (em1 + 1.f) * sy;
            const float den = ar * ar + ai * ai;
            const float fr_ = (nr * ar + abi * ai) / den, fi_ = (abi * ar - nr * ai) / den;
            const float mg = __expf((float)dl * x); const float pr = mg * __cosf((float)dl * y), pi = mg * __sinf((float)dl * y);
            const f32x4* bre = (const f32x4*)(F.in(11) + (((size_t)l * 16 + gi) * 64 + n) * 16); const f32x4* bim = (const f32x4*)(F.in(12) + (((size_t)l * 16 + gi) * 64 + n) * 16);
            float zr[16], zi[16];
#pragma unroll
            for (int q4 = 0; q4 < 4; ++q4) { const f32x4 br = bre[q4], bi = bim[q4];
#pragma unroll
                for (int j = 0; j < 4; ++j) { const float bbr = fr_ * br[j] - fi_ * bi[j], bbi = fr_ * bi[j] + fi_ * br[j]; zr[4 * q4 + j] = pr * bbr - pi * bbi; zi[4 * q4 + j] = pr * bbi + pi * bbr; } }
#pragma unroll
            for (int cc = 0; cc < 4; ++cc) { const int cp = cp0 + cc;
                const float cr = F.in(13)[(((size_t)l * 16 + gi) * 16 + cp) * 64 + n], ci = F.in(14)[(((size_t)l * 16 + gi) * 16 + cp) * 64 + n];
#pragma unroll
                for (int c = 0; c < 16; ++c) scr[n * 65 + cc * 16 + c] = cr * zr[c] - ci * zi[c]; }
            asm volatile("s_waitcnt lgkmcnt(0)" ::: "memory");
            float mine = 0.f;
#pragma unroll 8
            for (int nn = 0; nn < 64; ++nn) mine += scr[nn * 65 + lane];
            ((float*)(ms + MS_MTAB))[e0 + lane] = mine;
            asm volatile("s_waitcnt lgkmcnt(0)" ::: "memory"); continue; }
        r -= I_M;
        {
            const int e = r * 64 + lane; const int gi = e >> 6, n = e & 63;
            const float dt = __expf(F.in(8)[l * 16 + gi]);
            const float ar = F.in(9)[((size_t)l * 16 + gi) * 64 + n], ai = F.in(10)[((size_t)l * 16 + gi) * 64 + n];
            const float x = dt * ar, y = dt * ai; float sy, cy; sy = __sinf(y); cy = __cosf(y); const float sh = __sinf(0.5f * y);
            const float em1 = (fabsf(x) < 0.25f) ? x * (1.f + x * (0.5f + x * (0.16666667f + x * (0.041666668f + x * 0.0083333338f)))) : expm1f(x); const float nr = em1 * cy - 2.f * sh * sh; const float abi = (em1 + 1.f) * sy;
            const float den = ar * ar + ai * ai;
            const float fr_ = (nr * ar + abi * ai) / den, fi_ = (abi * ar - nr * ai) / den;
            float s16, c16; s16 = __sinf(16.f * y); c16 = __cosf(16.f * y); const float m16 = __expf(16.f * x);
            ((f32x2*)(ct + CT_AB16))[e] = (f32x2){m16 * c16, m16 * s16};
            float s1k, c1k; s1k = __sinf(512.f * y); c1k = __cosf(512.f * y); const float m1k = __expf(512.f * x);
            ((f32x2*)(ct + CT_AB1K))[e] = (f32x2){m1k * c1k, m1k * s1k};
            const float* bre = F.in(11) + (((size_t)l * 16 + gi) * 64 + n) * 16; const float* bim = F.in(12) + (((size_t)l * 16 + gi) * 64 + n) * 16;
            f32x2* bb = (f32x2*)(ms + MS_BBAR) + (size_t)e * 16;
#pragma unroll
            for (int c = 0; c < 16; ++c) { const float br = bre[c], bi = bim[c]; bb[c] = (f32x2){fr_ * br - fi_ * bi, fr_ * bi + fi_ * br}; }
        }
    }
}

DI void prologue_b(Frame& F) {
    const int gt = F.gw * 64 + F.lane, ngt = F.ngw * 64;
    for (int l = 0; l < NL; ++l) {
        unsigned char* wl = F.wsp() + WS_W + (size_t)l * WL_STRIDE;
        unsigned char* ms = F.wsp() + WS_MISC + (size_t)l * MS_L;
        unsigned char* ct = F.wsp() + WS_CTL + CT_BASE + (size_t)l * CT_L;
        const float* MT = (const float*)(ms + MS_MTAB);
        const f32x2* BB = (const f32x2*)(ms + MS_BBAR);
        const float dtl_base = 0.f; (void)dtl_base;
        for (int e = gt; e < 16 * 512 * 256; e += ngt) {
            const int gi = e >> 17, n = (e >> 8) & 511, k = e & 255; float v = 0.f;
            if (n < 256) { const int tp = n >> 4, cp = n & 15, ta = k >> 4, c = k & 15; if (tp >= ta) v = MT[((gi * 16 + (tp - ta)) * 16 + cp) * 16 + c]; }
            else if (n < 384) { const int s = (n - 256) & 63, part = (n - 256) >> 6, ta = k >> 4, c = k & 15;
                const float dt = __expf(F.in(8)[l * 16 + gi]);
                const float ar = F.in(9)[((size_t)l * 16 + gi) * 64 + s], ai = F.in(10)[((size_t)l * 16 + gi) * 64 + s];
                const float pw = (float)(15 - ta); float sp, cpw; sp = __sinf(pw * dt * ai); cpw = __cosf(pw * dt * ai); const float mg = __expf(pw * dt * ar);
                const float pr = mg * cpw, pi = mg * sp; const f32x2 b = BB[((size_t)gi * 64 + s) * 16 + c];
                v = part ? (pr * b.y + pi * b.x) : (pr * b.x - pi * b.y); }
            ((bf16_t*)(wl + WO_SS1))[e] = f2bf(v);
        }
        for (int e = gt; e < 16 * 256 * 256; e += ngt) {
            const int gi = e >> 16, n = (e >> 8) & 255, k = e & 255; float v = 0.f;
            if (k < 128) { const int s = k & 63, part = k >> 6, ta = n >> 4, c = n & 15;
                const float dt = __expf(F.in(8)[l * 16 + gi]);
                const float ar = F.in(9)[((size_t)l * 16 + gi) * 64 + s], ai = F.in(10)[((size_t)l * 16 + gi) * 64 + s];
                const float pw = (float)(ta + 1); float sp, cpw; sp = __sinf(pw * dt * ai); cpw = __cosf(pw * dt * ai); const float mg = __expf(pw * dt * ar);
                const float pr = mg * cpw, pi = mg * sp;
                const float cr = F.in(13)[(((size_t)l * 16 + gi) * 16 + c) * 64 + s], ci = F.in(14)[(((size_t)l * 16 + gi) * 16 + c) * 64 + s];
                v = part ? -(cr * pi + ci * pr) : (cr * pr - ci * pi); }
            ((bf16_t*)(wl + WO_SS2))[e] = f2bf(v);
        }
        for (int e = gt; e < 512; e += ngt) { const int kv = e >> 8, n = e & 255; float s = F.in(5)[((size_t)l * 2 + kv) * 256 + n];
            const float* pp = (const float*)(ms + MS_CBP) + (size_t)kv * 32 * 256 + n;
            for (int ch = 0; ch < 32; ++ch) s += pp[ch * 256];
            ((float*)(ct + CT_CB1))[e] = s; }
    }
}

DI void convert_rows_stats(Frame& F, const float* x, bf16_t* o, unsigned long long* ssx) {
    for (int m = F.gw; m < NT; m += F.ngw) {
        const f32x4* xr = (const f32x4*)(x + (size_t)m * DM) + F.lane; f32x4 v[4]; float s = 0.f;
#pragma unroll
        for (int j = 0; j < 4; ++j) { v[j] = xr[64 * j]; s += (v[j].x * v[j].x + v[j].y * v[j].y) + (v[j].z * v[j].z + v[j].w * v[j].w); }
        u32x2* o8 = (u32x2*)(o + (size_t)m * DM) + F.lane;
#pragma unroll
        for (int j = 0; j < 4; ++j) { u32x2 w; w.x = pk2(v[j].x, v[j].y); w.y = pk2(v[j].z, v[j].w); o8[64 * j] = w; }
        s = wave_sum(s);
        if (F.lane == 0) ssx[(size_t)m * 2] = (unsigned long long)(s * 1048576.f);
    }
}
DI void rmsnorm_rows_bf16(Frame& F, const float* x, const float* g, bf16_t* o) {
    const f32x4* gp = (const f32x4*)g + F.lane; f32x4 gv[4];
#pragma unroll
    for (int j = 0; j < 4; ++j) gv[j] = gp[64 * j];
    for (int m = F.gw; m < NT; m += F.ngw) {
        const f32x4* xr = (const f32x4*)(x + (size_t)m * DM) + F.lane; f32x4 v[4]; float s = 0.f;
#pragma unroll
        for (int j = 0; j < 4; ++j) { v[j] = xr[64 * j]; s += (v[j].x * v[j].x + v[j].y * v[j].y) + (v[j].z * v[j].z + v[j].w * v[j].w); }
        const float rstd = rsqrtf(wave_sum(s) * (1.f / DM) + 1e-6f);
        u32x2* o8 = (u32x2*)(o + (size_t)m * DM) + F.lane;
#pragma unroll
        for (int j = 0; j < 4; ++j) { u32x2 w; w.x = pk2(v[j].x * rstd * gv[j].x, v[j].y * rstd * gv[j].y); w.y = pk2(v[j].z * rstd * gv[j].z, v[j].w * rstd * gv[j].w); o8[64 * j] = w; }
    }
}
DI void rmsnorm_rows_fp8(Frame& F, const float* x, const float* g, unsigned char* o) {
    const f32x4* gp = (const f32x4*)g + F.lane; f32x4 gv[4];
#pragma unroll
    for (int j = 0; j < 4; ++j) gv[j] = gp[64 * j];
    for (int m = F.gw; m < NT; m += F.ngw) {
        const f32x4* xr = (const f32x4*)(x + (size_t)m * DM) + F.lane; f32x4 v[4]; float s = 0.f;
#pragma unroll
        for (int j = 0; j < 4; ++j) { v[j] = xr[64 * j]; s += (v[j].x * v[j].x + v[j].y * v[j].y) + (v[j].z * v[j].z + v[j].w * v[j].w); }
        const float rstd = rsqrtf(wave_sum(s) * (1.f / DM) + 1e-6f);
        unsigned* o4 = (unsigned*)(o + (size_t)m * DM) + F.lane;
#pragma unroll
        for (int j = 0; j < 4; ++j) o4[64 * j] = pk4_fp8(v[j].x * rstd * gv[j].x, v[j].y * rstd * gv[j].y, v[j].z * rstd * gv[j].z, v[j].w * rstd * gv[j].w);
    }
}
DI void rmsnorm_rows_f32_inplace(Frame& F, float* x, const float* g) {
    const f32x4* gp = (const f32x4*)g + F.lane; f32x4 gv[4];
#pragma unroll
    for (int j = 0; j < 4; ++j) gv[j] = gp[64 * j];
    for (int m = F.gw; m < NT; m += F.ngw) {
        f32x4* xr = (f32x4*)(x + (size_t)m * DM) + F.lane; f32x4 v[4]; float s = 0.f;
#pragma unroll
        for (int j = 0; j < 4; ++j) { v[j] = xr[64 * j]; s += (v[j].x * v[j].x + v[j].y * v[j].y) + (v[j].z * v[j].z + v[j].w * v[j].w); }
        const float rstd = rsqrtf(wave_sum(s) * (1.f / DM) + 1e-6f);
#pragma unroll
        for (int j = 0; j < 4; ++j) xr[64 * j] = v[j] * rstd * gv[j];
    }
}
template <int OUT>
DI void rmsnorm_rows_xb(Frame& F, const bf16_t* x, const float* g, void* o) {
    const f32x4* gp = (const f32x4*)g + 2 * F.lane; f32x4 gv[2][2];
#pragma unroll
    for (int j = 0; j < 2; ++j) { gv[j][0] = gp[128 * j]; gv[j][1] = gp[128 * j + 1]; }
    for (int m = 2 * F.gw; m < NT; m += 2 * F.ngw) {
        u32x4 w[2][2];
#pragma unroll
        for (int r = 0; r < 2; ++r)
#pragma unroll
            for (int j = 0; j < 2; ++j) w[r][j] = ((const u32x4*)(x + (size_t)(m + r) * DM) + F.lane)[64 * j];
#pragma unroll
        for (int r = 0; r < 2; ++r) {
            f32x4 v[2][2]; float s = 0.f;
#pragma unroll
            for (int j = 0; j < 2; ++j) { const u32x4 q = w[r][j];
                v[j][0] = f32x4{bflo(q.x), bfhi(q.x), bflo(q.y), bfhi(q.y)}; v[j][1] = f32x4{bflo(q.z), bfhi(q.z), bflo(q.w), bfhi(q.w)};
                const f32x4 a = v[j][0] * v[j][0] + v[j][1] * v[j][1]; s += (a.x + a.y) + (a.z + a.w); }
            const float rstd = rsqrtf(wave_sum(s) * (1.f / DM) + 1e-6f);
#pragma unroll
            for (int j = 0; j < 2; ++j) { const f32x4 y0 = v[j][0] * rstd * gv[j][0], y1 = v[j][1] * rstd * gv[j][1];
                if constexpr (OUT == 0) { u32x4 t; t.x = pk2(y0.x, y0.y); t.y = pk2(y0.z, y0.w); t.z = pk2(y1.x, y1.y); t.w = pk2(y1.z, y1.w);
                    ((u32x4*)((bf16_t*)o + (size_t)(m + r) * DM) + F.lane)[64 * j] = t; }
                else if constexpr (OUT == 1) { u32x2 t; t.x = pk4_fp8(y0.x, y0.y, y0.z, y0.w); t.y = pk4_fp8(y1.x, y1.y, y1.z, y1.w);
                    ((u32x2*)((unsigned char*)o + (size_t)(m + r) * DM) + F.lane)[64 * j] = t; }
                else { f32x4* op = (f32x4*)((float*)o + (size_t)(m + r) * DM) + 2 * F.lane + 128 * j; op[0] = y0; op[1] = y1; } }
        }
    }
}
DI void mix_norm_rows(Frame& F, const bf16_t* oatt, const bf16_t* ossm, const float* gatt, const float* gssm, bf16_t* mixed) {
    for (int m = F.gw; m < NT; m += F.ngw) {
        const u32x2* ar = (const u32x2*)(oatt + (size_t)m * 768) + F.lane;
        float a[12]; float s = 0.f;
#pragma unroll
        for (int j = 0; j < 3; ++j) { const u32x2 w = ar[64 * j]; a[4 * j] = bflo(w.x); a[4 * j + 1] = bfhi(w.x); a[4 * j + 2] = bflo(w.y); a[4 * j + 3] = bfhi(w.y); }
#pragma unroll
        for (int j = 0; j < 12; ++j) s += a[j] * a[j];
        const float ra = rsqrtf(wave_sum(s) * (1.f / 768.f) + 1e-6f);
        const u32x2 sw = ((const u32x2*)(ossm + (size_t)m * 256))[F.lane];
        float b[4] = {bflo(sw.x), bfhi(sw.x), bflo(sw.y), bfhi(sw.y)};
        const float rs = rsqrtf(wave_sum(b[0] * b[0] + b[1] * b[1] + b[2] * b[2] + b[3] * b[3]) * (1.f / 256.f) + 1e-6f);
        u32x2* o8 = (u32x2*)(mixed + (size_t)m * DM);
#pragma unroll
        for (int j = 0; j < 3; ++j) { const f32x4 gv = ((const f32x4*)gatt)[64 * j + F.lane];
            u32x2 w; w.x = pk2(a[4 * j] * ra * gv.x, a[4 * j + 1] * ra * gv.y); w.y = pk2(a[4 * j + 2] * ra * gv.z, a[4 * j + 3] * ra * gv.w); o8[64 * j + F.lane] = w; }
        { const f32x4 gv = ((const f32x4*)gssm)[F.lane]; u32x2 w; w.x = pk2(b[0] * rs * gv.x, b[1] * rs * gv.y); w.y = pk2(b[2] * rs * gv.z, b[3] * rs * gv.w); o8[192 + F.lane] = w; }
    }
}

#define KPERM(rt, r) (32 * ((rt) >> 1) + 8 * ((r) >> 2) + 4 * ((rt) & 1) + ((r) & 3))
DI void vtranspose_phase(Frame& F, const bf16_t* proj, bf16_t* vts, bf16_t* vtw, bf16_t* kfs, unsigned* vmax_word, int cu0) {
    LAS bf16_t* scr = (LAS bf16_t*)(F.lds + F.wave * 8704);
    unsigned vm = 0u;
    const bool split = F.G > 96;
    if (split && F.bid < cu0) return;
    const int gw0 = split ? F.gw - cu0 * 8 : F.gw, ngw0 = split ? F.ngw - cu0 * 8 : F.ngw;
    const int c16 = F.lane & 15, kq = F.lane >> 4;
    for (int it = gw0; it < 3 * 6 * 256; it += ngw0) {
        const int which = it / 1536, r = it % 1536, bh = r >> 8, tt = r & 255, b = bh / 3, h = bh % 3;
        const bf16_t* src = proj + ((size_t)(b * SEQ + 64 * tt)) * PW + (which == 0 ? C_VS : (which == 1 ? C_VW : C_KS)) + h * 64;
        bf16_t* dst = (which == 0 ? vts : (which == 1 ? vtw : kfs)) + (size_t)bh * 64 * SEQ + (size_t)tt * 4096;
#pragma unroll
        for (int i = 0; i < 8; ++i) { const int tk = i * 8 + (F.lane >> 3), d8 = F.lane & 7; const u32x4 w = *(const u32x4*)(src + (size_t)tk * PW + 8 * d8);
            if (which == 0) { vm = max(vm, max(max(w.x & 0x7fff0000u, (w.x << 16) & 0x7fff0000u), max(w.y & 0x7fff0000u, (w.y << 16) & 0x7fff0000u)));
                              vm = max(vm, max(max(w.z & 0x7fff0000u, (w.z << 16) & 0x7fff0000u), max(w.w & 0x7fff0000u, (w.w << 16) & 0x7fff0000u))); }
            LAS bf16_t* sp = scr + tk * 66 + 8 * d8; ((LAS unsigned*)sp)[0] = w.x; ((LAS unsigned*)sp)[1] = w.y; ((LAS unsigned*)sp)[2] = w.z; ((LAS unsigned*)sp)[3] = w.w; }
        asm volatile("s_waitcnt lgkmcnt(0)" ::: "memory");
        if (which == 1) {
#pragma unroll
            for (int i = 0; i < 8; ++i) { const int d = i * 8 + (F.lane >> 3), t8 = F.lane & 7; unsigned short e[8];
#pragma unroll
                for (int j = 0; j < 8; ++j) e[j] = scr[(8 * t8 + j) * 66 + d];
                u32x4 w; w.x = e[0] | ((unsigned)e[1] << 16); w.y = e[2] | ((unsigned)e[3] << 16); w.z = e[4] | ((unsigned)e[5] << 16); w.w = e[6] | ((unsigned)e[7] << 16);
                *(u32x4*)(dst + (size_t)d * 64 + 8 * t8) = w; }
        } else if (which == 0) {
#pragma unroll
            for (int I = 0; I < 8; ++I) { const int dt = I >> 1, sp = I & 1; unsigned short e[8];
#pragma unroll
                for (int j = 0; j < 8; ++j) e[j] = scr[(32 * sp + 8 * kq + j) * 66 + 16 * dt + c16];
                u32x4 w; w.x = e[0] | ((unsigned)e[1] << 16); w.y = e[2] | ((unsigned)e[3] << 16); w.z = e[4] | ((unsigned)e[5] << 16); w.w = e[6] | ((unsigned)e[7] << 16);
                *(u32x4*)(dst + (I * 64 + F.lane) * 8) = w; }
        } else {
#pragma unroll
            for (int I = 0; I < 8; ++I) { const int rt = I >> 1, ks = I & 1; const LAS bf16_t* sp = scr + KPERM(rt, c16) * 66 + 32 * ks + 8 * kq;
                u32x4 w; w.x = ((const LAS unsigned*)sp)[0]; w.y = ((const LAS unsigned*)sp)[1]; w.z = ((const LAS unsigned*)sp)[2]; w.w = ((const LAS unsigned*)sp)[3];
                *(u32x4*)(dst + (I * 64 + F.lane) * 8) = w; }
        }
        asm volatile("s_waitcnt lgkmcnt(0)" ::: "memory");
    }
    vm = wave_max_u32(vm);
    if (F.lane == 0 && vm != 0u) __hip_atomic_fetch_max(vmax_word, vm, __ATOMIC_RELAXED, __HIP_MEMORY_SCOPE_AGENT);
}

#define MFMA32(a, b, c) __builtin_amdgcn_mfma_f32_32x32x16_bf16((a), (b), (c), 0, 0, 0)
#define MFMA16(a, b, c) __builtin_amdgcn_mfma_f32_16x16x32_bf16((a), (b), (c), 0, 0, 0)

DI void compress2_phase(Frame& F, const bf16_t* hidc, const bf16_t* w2t, const float* b2  , bf16_t* kc, bf16_t* vct, int it0, int it_end, int it_step) {
    const int r = F.lane & 31, h = F.lane >> 5;
    for (int it = it0; it < it_end; it += it_step) {
        const int kv = it / 192, rb = it % 192; const int R0 = kv * 6144 + rb * 32;
        f32x16 acc0, acc1;
#pragma unroll
        for (int i = 0; i < 16; ++i) { acc0[i] = 0.f; acc1[i] = 0.f; }
        const bf16_t* ap = hidc + (size_t)(R0 + r) * 256 + 8 * h; const bf16_t* bp = w2t + (size_t)kv * 64 * 256 + (size_t)r * 256 + 8 * h;
#pragma unroll 4
        for (int ks = 0; ks < 16; ++ks) { const bf16x8 a = *(const bf16x8*)(ap + 16 * ks); const bf16x8 b0 = *(const bf16x8*)(bp + 16 * ks), b1 = *(const bf16x8*)(bp + 32 * 256 + 16 * ks);
            acc0 = MFMA32(a, b0, acc0); acc1 = MFMA32(a, b1, acc1); }
        const int bh = rb >> 5, i0 = (rb & 31) * 32;
        const float bb0 = b2[kv * 64 + r], bb1 = b2[kv * 64 + 32 + r];
        if (kv == 0) {
#pragma unroll
            for (int i = 0; i < 16; ++i) { const int row = i0 + (i & 3) + 8 * (i >> 2) + 4 * h; bf16_t* o = kc + ((size_t)bh * 1024 + row) * 64;
                const bool junk = (row == 1023);
                o[r] = junk ? (bf16_t)0 : f2bf(acc0[i] + bb0); o[32 + r] = junk ? (bf16_t)0 : f2bf(acc1[i] + bb1); }
        } else {
#pragma unroll
            for (int g4 = 0; g4 < 4; ++g4) { const int row = i0 + 8 * g4 + 4 * h;
                u32x2 w0, w1; w0.x = pk2(acc0[4 * g4] + bb0, acc0[4 * g4 + 1] + bb0); w0.y = pk2(acc0[4 * g4 + 2] + bb0, acc0[4 * g4 + 3] + bb0);
                w1.x = pk2(acc1[4 * g4] + bb1, acc1[4 * g4 + 1] + bb1); w1.y = pk2(acc1[4 * g4 + 2] + bb1, acc1[4 * g4 + 3] + bb1);
                if (row == 1020) { w0.y &= 0x0000ffffu; w1.y &= 0x0000ffffu; }
                bf16_t* vt = vct + (size_t)bh * 64 * 1024 + (size_t)(row >> 6) * 4096 + (row & 63);
                *(u32x2*)(vt + r * 64) = w0; *(u32x2*)(vt + (32 + r) * 64) = w1; }
        }
    }
}

DI void ssm_carry_phase(Frame& F, const float* hl, const f32x2* ab16, const f32x2* ab512, bf16_t* hin, int bg0, int bg_end, int bg_step) {
    LAS f32x2* E = (LAS f32x2*)F.lds;
    const int s = F.lane;
    for (int bg = bg0; bg < bg_end; bg += bg_step) {
        const int gi = bg & 15; const f32x2 a16 = ab16[gi * 64 + s], a5 = ab512[gi * 64 + s];
        const float* hp = hl + (size_t)bg * 1024 * 128 + s;
        float hr[4], hi[4];
#pragma unroll
        for (int j = 0; j < 4; ++j) { hr[j] = 0.f; hi[j] = 0.f; }
#pragma unroll 4
        for (int c = 0; c < 32; ++c) {
#pragma unroll
            for (int j = 0; j < 4; ++j) { const float* q = hp + (size_t)((4 * F.wave + j) * 32 + c) * 128; const float lr = q[0], li = q[64];
                const float nr = a16.x * hr[j] - a16.y * hi[j] + lr, ni = a16.x * hi[j] + a16.y * hr[j] + li; hr[j] = nr; hi[j] = ni; } }
#pragma unroll
        for (int j = 0; j < 4; ++j) E[(4 * F.wave + j) * 64 + s] = (f32x2){hr[j], hi[j]};
        __syncthreads();
        { float pr = 0.f, pi = 0.f;
          for (int k = 0; k < 4 * F.wave; ++k) { const f32x2 e = E[k * 64 + s]; const float nr = a5.x * pr - a5.y * pi + e.x, ni = a5.x * pi + a5.y * pr + e.y; pr = nr; pi = ni; }
#pragma unroll
          for (int j = 0; j < 4; ++j) { hr[j] = pr; hi[j] = pi; const f32x2 e = E[(4 * F.wave + j) * 64 + s]; const float nr = a5.x * pr - a5.y * pi + e.x, ni = a5.x * pi + a5.y * pr + e.y; pr = nr; pi = ni; } }
#pragma unroll 4
        for (int c = 0; c < 32; ++c) {
#pragma unroll
            for (int j = 0; j < 4; ++j) { const int ch = (4 * F.wave + j) * 32 + c; const float* q = hp + (size_t)ch * 128; const float lr = q[0], li = q[64];
                bf16_t* o = hin + ((size_t)bg * 1024 + ch) * 256; o[s] = f2bf(hr[j]); o[64 + s] = f2bf(hi[j]); ((unsigned*)(o + 128))[s] = 0u;
                const float nr = a16.x * hr[j] - a16.y * hi[j] + lr, ni = a16.x * hi[j] + a16.y * hr[j] + li; hr[j] = nr; hi[j] = ni; } }
        __syncthreads();
    }
}

constexpr float AL2E = 1.0f;
constexpr int IMP_STRIDE = 257;
constexpr int OS_QS = 261, OS_HS = 65;
constexpr int LDS_RA = 0, LDS_RB = 64 * IMP_STRIDE * 4, LDS_WM = LDS_RB + 64 * OS_QS * 4;
constexpr int QT_ROW = 144, LDS_QT = LDS_RA, LDS_QL = LDS_QT + 256 * QT_ROW, LDS_MREF = LDS_QL + 512, LDS_LS = LDS_MREF + 1024;
constexpr int LDS_QCNT = LDS_WM + 2048;
static_assert(LDS_LS + 1024 <= LDS_RB && LDS_QCNT + 16 <= LDS_BYTES - 256, "LDS map");
constexpr int TROW = 144, TILE_V = 64 * TROW, TILE_BYTES = 2 * 64 * TROW;

struct TileSrc { const bf16_t* k; long kstep, kstride; const bf16_t* v; long vstep, vstride; };

constexpr int PD = 1;
struct IdMap { DI int operator()(int i) const { return i; } };
template <bool WITH_V, class Compute, class Map = IdMap, bool FRAG = false>
DI void kv_pipeline(Frame& F, LAS unsigned char* sb, const TileSrc& ts, int n, Compute&& compute, Map tmap = Map()) {
    if (n <= 0) return;
    const int row = F.tid >> 3, ch = F.tid & 7, nl = n - 1;
    const bf16_t* kp = FRAG ? ts.k + F.tid * 8 : ts.k + (long)row * ts.kstride + ch * 8; const bf16_t* vp = FRAG ? ts.v + F.tid * 8 : ts.v + (long)row * ts.vstride + ch * 8;
    LAS unsigned char* wk = sb + row * TROW + ch * 16; int vdel = TILE_V;
    if (FRAG) { const int I = F.tid >> 6, l_ = F.tid & 63, c16_ = l_ & 15, kq_ = l_ >> 4;
        const int kofs = KPERM(I >> 1, c16_) * TROW + (32 * (I & 1) + 8 * kq_) * 2, vofs = TILE_V + (16 * (I >> 1) + c16_) * TROW + (32 * (I & 1) + 8 * kq_) * 2;
        wk = sb + kofs; vdel = vofs - kofs; }
    u32x4 kr[PD], vr[PD];
#pragma unroll
    for (int u = 0; u < PD; ++u) { const int t = tmap(u < nl ? u : nl); kr[u] = *(const u32x4*)(kp + (long)t * ts.kstep); vr[u] = WITH_V ? *(const u32x4*)(vp + (long)t * ts.vstep) : (u32x4){0u, 0u, 0u, 0u}; }
    *(LAS u32x4*)wk = kr[0]; if (WITH_V) *(LAS u32x4*)(wk + vdel) = vr[0];
    { const int t = tmap(PD < nl ? PD : nl); kr[0] = *(const u32x4*)(kp + (long)t * ts.kstep); if (WITH_V) vr[0] = *(const u32x4*)(vp + (long)t * ts.vstep); }
    __syncthreads();
    for (int i0 = 0; i0 < n; i0 += PD) {
#pragma unroll
        for (int u = 0; u < PD; ++u) {
            const int i = i0 + u; const int s1 = (u + 1) % PD;
            { LAS unsigned char* w1 = wk + ((i + 1) & 1) * TILE_BYTES; *(LAS u32x4*)w1 = kr[s1]; if (WITH_V) *(LAS u32x4*)(w1 + vdel) = vr[s1]; }
            { const int t = tmap((i + 1 + PD) < nl ? (i + 1 + PD) : nl); kr[s1] = *(const u32x4*)(kp + (long)t * ts.kstep); if (WITH_V) vr[s1] = *(const u32x4*)(vp + (long)t * ts.vstep); }
            if (i < n) compute(i, sb + (i & 1) * TILE_BYTES);
            __syncthreads();
        }
    }
}

DI f32x16 qk32(const LAS unsigned char* tb, int kh, int r32, int h, const bf16x8 (&qf)[4]) {
    f32x16 sc;
#pragma unroll
    for (int i = 0; i < 16; ++i) sc[i] = 0.f;
    const LAS unsigned char* kp = tb + (32 * kh + r32) * TROW + 16 * h;
#pragma unroll
    for (int s = 0; s < 4; ++s) { const bf16x8 a = *(const LAS bf16x8*)(kp + 32 * s); sc = MFMA32(a, qf[s], sc); }
    return sc;
}
DI void qk32x2(const LAS unsigned char* tb, int r32, int h, const bf16x8 (&qf)[4], f32x16& s0, f32x16& s1) {
#pragma unroll
    for (int i = 0; i < 16; ++i) { s0[i] = 0.f; s1[i] = 0.f; }
    const LAS unsigned char* kp = tb + r32 * TROW + 16 * h;
#pragma unroll
    for (int s = 0; s < 4; ++s) { const bf16x8 a0 = *(const LAS bf16x8*)(kp + 32 * s), a1 = *(const LAS bf16x8*)(kp + 32 * TROW + 32 * s); s0 = MFMA32(a0, qf[s], s0); s1 = MFMA32(a1, qf[s], s1); }
}
DI void pv32(const LAS unsigned char* tb, int kh, int r32, int h, const f32x16& p, f32x16& o0, f32x16& o1) {
#pragma unroll
    for (int s2 = 0; s2 < 2; ++s2) {
        u32x4 pw; pw.x = pk2(p[8 * s2], p[8 * s2 + 1]); pw.y = pk2(p[8 * s2 + 2], p[8 * s2 + 3]); pw.z = pk2(p[8 * s2 + 4], p[8 * s2 + 5]); pw.w = pk2(p[8 * s2 + 6], p[8 * s2 + 7]);
        const bf16x8 pb = __builtin_bit_cast(bf16x8, pw);
        const LAS unsigned char* vp = tb + TILE_V + r32 * TROW + (32 * kh + 16 * s2 + 4 * h) * 2;
        { const s16x4 lo = *(const LAS s16x4*)vp, hi = *(const LAS s16x4*)(vp + 16); const bf16x8 a = __builtin_shufflevector(lo, hi, 0, 1, 2, 3, 4, 5, 6, 7); o0 = MFMA32(a, pb, o0); }
        { const s16x4 lo = *(const LAS s16x4*)(vp + 32 * TROW), hi = *(const LAS s16x4*)(vp + 32 * TROW + 16); const bf16x8 a = __builtin_shufflevector(lo, hi, 0, 1, 2, 3, 4, 5, 6, 7); o1 = MFMA32(a, pb, o1); }
    }
}

DI void attn_unit(Frame& F, const bf16_t* proj, const bf16_t* kcb, const bf16_t* vctb, const bf16_t* vts, const bf16_t* vtw, bf16_t* oatt, int bh, int qb, float os_scale, float os_inv, float os_e2, float* park, const bf16_t* kfs, unsigned long long* sst) {
    const float ls_scale = 1048576.0f * os_inv;
    LAS unsigned* IMP = (LAS unsigned*)(F.lds + LDS_RA); LAS unsigned char* WM = F.lds + LDS_WM;
    const int b = bh / 3, hkv = bh % 3, lane = F.lane, w = F.wave;
    const float NEG = -__builtin_inff();
    for (int i = F.tid; i < 64 * IMP_STRIDE; i += 512) IMP[i] = 0u;
    for (int i = F.tid; i < 512; i += 512) ((LAS unsigned*)WM)[i] = 0u;
    const int r32 = lane & 31, h = lane >> 5, gq = w & 3, qh = w >> 2;
    const int ql = 32 * qh + r32, t = 64 * qb + ql;
    const size_t trow = (size_t)(b * SEQ + t);
    const bf16_t* qrow = proj + trow * PW + C_Q + (hkv * 4 + gq) * 64;
    bf16x8 qf[4];
#pragma unroll
    for (int s = 0; s < 4; ++s) qf[s] = *(const bf16x8*)(qrow + 16 * s + 8 * h);
    const bf16_t* grow = proj + trow * PW + C_G + hkv * 12 + gq * 3;
    const float g0 = sigmoidf_(bf2f(grow[0])), g2 = sigmoidf_(bf2f(grow[2]));
    f32x16 oc0, oc1; float inv_c = 0.f;
#pragma unroll
    for (int i = 0; i < 16; ++i) { oc0[i] = 0.f; oc1[i] = 0.f; }
    {
        const int ntile = (4 * qb + 3 + 63) >> 6;
        const int vis = (t - 31) >> 4;
        const int vis_w = (64 * qb + 32 * qh + 31 - 31) >> 4;
        const int vis_min = (64 * qb + 32 * qh - 31) >> 4;
        TileSrc ts{kcb + (size_t)bh * 1024 * 64, 64 * 64, 64, vctb + (size_t)bh * 64 * 1024, 4096, 64};
        float m = NEG, lsum = 0.f;
        for (int rep_ = 0; rep_ < REP_B1; ++rep_)
        kv_pipeline<false>(F, F.lds + LDS_RB, ts, ntile, [&](int i, const LAS unsigned char* tb) {
            if (64 * i > vis_w) return;
            const bool two = (64 * i + 32 <= vis_w); f32x16 sq0, sq1;
            if (two) qk32x2(tb, r32, h, qf, sq0, sq1); else { sq0 = qk32(tb, 0, r32, h, qf); sq1 = sq0; }
#pragma unroll
            for (int kh = 0; kh < 2; ++kh) {
                if (kh == 1 && !two) continue;
                f32x16 sc = kh ? sq1 : sq0;
                float tm = NEG;
                if (64 * i + 32 * kh + 31 > vis_min) {
#pragma unroll
                    for (int e = 0; e < 16; ++e) { const int ki = 64 * i + 32 * kh + (e & 3) + 8 * (e >> 2) + 4 * h; sc[e] = (ki <= vis) ? sc[e] : NEG; }
                }
#pragma unroll
                for (int e = 0; e < 16; ++e) tm = fmaxf(tm, sc[e]);
                const float mn = fmaxf(m, tm);
                if (mn > NEG) { float ps = 0.f;
#pragma unroll
                    for (int e = 0; e < 16; ++e) ps += fexp2((sc[e] - mn) * AL2E);
                    lsum = lsum * fexp2((m - mn) * AL2E) + ps; m = mn; }
            }
        });
        const F2 mm = halves32(m), ll = halves32(lsum);
        float M = fmaxf(mm.lo, mm.hi), Lt = 0.f;
        if (M > NEG) Lt = ll.lo * fexp2((mm.lo - M) * AL2E) + ll.hi * fexp2((mm.hi - M) * AL2E); else M = 0.f;
        const float inv = 1.0f / fmaxf(Lt, 1e-30f), inv24 = inv * 16777216.0f;
        inv_c = inv;
        for (int rep_ = 0; rep_ < REP_B1; ++rep_)
        kv_pipeline<true>(F, F.lds + LDS_RB, ts, ntile, [&](int i, const LAS unsigned char* tb) {
            if (64 * i > vis_w) return;
            const bool two = (64 * i + 32 <= vis_w); f32x16 sq0, sq1;
            if (two) qk32x2(tb, r32, h, qf, sq0, sq1); else { sq0 = qk32(tb, 0, r32, h, qf); sq1 = sq0; }
#pragma unroll
            for (int kh = 0; kh < 2; ++kh) {
                if (kh == 1 && !two) continue;
                f32x16 sc = kh ? sq1 : sq0;
#pragma unroll
                for (int e = 0; e < 16; ++e) sc[e] = fexp2((sc[e] - M) * AL2E);
                if (64 * i + 32 * kh + 31 > vis_min) {
#pragma unroll
                    for (int e = 0; e < 16; ++e) { const int ki = 64 * i + 32 * kh + (e & 3) + 8 * (e >> 2) + 4 * h; sc[e] = (ki <= vis) ? sc[e] : 0.f; }
                }
#pragma unroll
                for (int a = 0; a < 4; ++a) { const float G = (sc[4 * a] + sc[4 * a + 1]) + (sc[4 * a + 2] + sc[4 * a + 3]); const int j = 16 * i + 8 * kh + 2 * a + h;
                    __hip_atomic_fetch_add(IMP + ql * IMP_STRIDE + j, (unsigned)(G * inv24 + 0.5f), __ATOMIC_RELAXED, __HIP_MEMORY_SCOPE_WORKGROUP);
                    __hip_atomic_fetch_add(IMP + ql * IMP_STRIDE + j + 1, (unsigned)(sc[4 * a + 3] * inv24 + 0.5f), __ATOMIC_RELAXED, __HIP_MEMORY_SCOPE_WORKGROUP); }
                pv32(tb, kh, r32, h, sc, oc0, oc1);
            }
        });
    }
    {
        const int cur = qb; LAS unsigned char* wm = WM + w * 256;
        if (cur + 1 <= 16) { if (lane <= cur) wm[lane] = 0xff; }
        else for (int rep_ = 0; rep_ < REP_TK; ++rep_) {
            unsigned key[8][4]; unsigned selbits = 0u;
#pragma unroll
            for (int qi = 0; qi < 8; ++qi) {
#pragma unroll
                for (int i = 0; i < 4; ++i) { const int j = 4 * lane + i; const unsigned x = IMP[(8 * w + qi) * IMP_STRIDE + j]; key[qi][i] = (j >= 1 && j <= cur - 2) ? (((x + 1u) << 2) | (unsigned)(3 - i)) : 0u; }
#define CE_(a_, b_) do { const unsigned hi_ = max(key[qi][a_], key[qi][b_]), lo_ = min(key[qi][a_], key[qi][b_]); key[qi][a_] = hi_; key[qi][b_] = lo_; } while (0)
                CE_(0, 1); CE_(2, 3); CE_(0, 2); CE_(1, 3); CE_(1, 2);
#undef CE_
            }
            for (int k = 0; k < 13; ++k) {
#pragma unroll
                for (int qi = 0; qi < 8; ++qi) {
                    const unsigned hv = key[qi][0] >> 2; const unsigned Mx = wave_max_u32(hv);
                    const unsigned long long bal = __ballot(hv == Mx); const int L = __ffsll((long long)bal) - 1;
                    const unsigned hk = (unsigned)__builtin_amdgcn_readlane((int)key[qi][0], L);
                    const unsigned bit = 1u << (8 * (3 - (int)(hk & 3u)) + qi);
                    const bool win = (lane == L);
                    selbits |= win ? bit : 0u;
                    key[qi][0] = win ? key[qi][1] : key[qi][0]; key[qi][1] = win ? key[qi][2] : key[qi][1]; key[qi][2] = win ? key[qi][3] : key[qi][2]; key[qi][3] = win ? 0u : key[qi][3];
                }
            }
            unsigned mybits[4];
#pragma unroll
            for (int i = 0; i < 4; ++i) mybits[i] = (selbits >> (8 * i)) & 0xffu;
#pragma unroll
            for (int i = 0; i < 4; ++i) { const int j = 4 * lane + i; unsigned bits = mybits[i]; if (j == 0 || j == cur - 1 || j == cur) bits = 0xffu; wm[j] = (unsigned char)bits; }
        }
    }
    __syncthreads();
    {
        const int kt_lo = (qb - 8) > 0 ? (qb - 8) : 0; const int ntile = qb - kt_lo + 1;
        const int t0w = 64 * qb + 32 * qh;
        TileSrc ts{proj + ((size_t)(b * SEQ) + 64 * kt_lo) * PW + C_KW + hkv * 64, 64 * PW, PW, vtw + (size_t)bh * 64 * SEQ + (size_t)kt_lo * 4096, 4096, 64};
        float m = NEG, lsum = 0.f; f32x16 o0, o1;
#pragma unroll
        for (int i = 0; i < 16; ++i) { o0[i] = 0.f; o1[i] = 0.f; }
        kv_pipeline<true>(F, F.lds + LDS_RA, ts, ntile, [&](int i, const LAS unsigned char* tb) {
#pragma unroll
            for (int kh = 0; kh < 2; ++kh) {
                const int k0 = 64 * (kt_lo + i) + 32 * kh;
                if (k0 > t0w + 31 || k0 + 31 <= t0w - 512) continue;
                f32x16 sc = qk32(tb, kh, r32, h, qf);
                float tm = NEG;
                if (!(k0 + 31 <= t0w && k0 > t0w + 31 - 512)) {
#pragma unroll
                    for (int e = 0; e < 16; ++e) { const int key = k0 + (e & 3) + 8 * (e >> 2) + 4 * h; sc[e] = (key <= t && key > t - 512) ? sc[e] : NEG; }
                }
#pragma unroll
                for (int e = 0; e < 16; ++e) tm = fmaxf(tm, sc[e]);
                tm = xor32_max(tm);
                const float mn = fmaxf(m, tm); const float ms = (mn > NEG) ? mn : 0.f;
                const float alpha = fexp2((m - ms) * AL2E); float ps = 0.f;
#pragma unroll
                for (int e = 0; e < 16; ++e) { sc[e] = fexp2((sc[e] - ms) * AL2E); ps += sc[e]; }
                lsum = lsum * alpha + ps; m = mn;
                if (__any(alpha != 1.0f)) {
#pragma unroll
                    for (int e = 0; e < 16; ++e) { o0[e] *= alpha; o1[e] *= alpha; }
                }
                pv32(tb, kh, r32, h, sc, o0, o1);
            }
        });
        const float Lw = xor32_sum(lsum); const float gw = g2 / fmaxf(Lw, 1e-30f);
        const float gc = g0 * inv_c;
#pragma unroll
        for (int e = 0; e < 16; ++e) { oc0[e] = gc * oc0[e] + gw * o0[e]; oc1[e] = gc * oc1[e] + gw * o1[e]; }
        bf16_t* op = oatt + trow * 1024 + (hkv * 4 + gq) * 64;
#pragma unroll
        for (int g4 = 0; g4 < 4; ++g4) { const int d = 8 * g4 + 4 * h; u32x2 w0, w1;
            w0.x = pk2(oc0[4 * g4], oc0[4 * g4 + 1]); w0.y = pk2(oc0[4 * g4 + 2], oc0[4 * g4 + 3]); w1.x = pk2(oc1[4 * g4], oc1[4 * g4 + 1]); w1.y = pk2(oc1[4 * g4 + 2], oc1[4 * g4 + 3]);
            *(u32x2*)(op + d) = w0; *(u32x2*)(op + 32 + d) = w1; }
    }
    const int cur = qb; const bool dense = (cur + 1 <= 16);
    float mf = NEG, lf = 0.f;
    {
        const int nfb = dense ? (cur + 1) : 3;
        TileSrc ts{kfs + (size_t)bh * 64 * SEQ, 4096, 0, vts + (size_t)bh * 64 * SEQ, 4096, 0};
#pragma unroll
        for (int e = 0; e < 16; ++e) { oc0[e] = 0.f; oc1[e] = 0.f; }
        auto dense_fn = [&](int i, const LAS unsigned char* tb) {
            const int j = dense ? i : (i == 0 ? 0 : cur - 2 + i);
#pragma unroll
            for (int kh = 0; kh < 2; ++kh) {
                const int k0 = 64 * j + 32 * kh;
                if (k0 > 64 * qb + 32 * qh + 31) continue;
                f32x16 sc = qk32(tb, kh, r32, h, qf);
                float tm = NEG;
                if (k0 + 31 > 64 * qb + 32 * qh) {
#pragma unroll
                    for (int e = 0; e < 16; ++e) { const int key = k0 + (e & 3) + 8 * (e >> 2) + 4 * h; sc[e] = (key <= t) ? sc[e] : NEG; }
                }
#pragma unroll
                for (int e = 0; e < 16; ++e) tm = fmaxf(tm, sc[e]);
                tm = xor32_max(tm);
                const float mn = fmaxf(mf, tm); const float ms = (mn > NEG) ? mn : 0.f;
                const float alpha = fexp2((mf - ms) * AL2E); float ps = 0.f;
#pragma unroll
                for (int e = 0; e < 16; ++e) { sc[e] = fexp2((sc[e] - ms) * AL2E); ps += sc[e]; }
                lf = lf * alpha + ps; mf = mn;
                if (__any(alpha != 1.0f)) {
#pragma unroll
                    for (int e = 0; e < 16; ++e) { oc0[e] *= alpha; oc1[e] *= alpha; }
                }
                pv32(tb, kh, r32, h, sc, oc0, oc1);
            }
        };
        auto dense_map = [&](int i) -> int { return dense ? i : (i == 0 ? 0 : cur - 2 + i); };
        kv_pipeline<true, decltype(dense_fn)&, decltype(dense_map), true>(F, F.lds + LDS_RA, ts, nfb, dense_fn, dense_map);
        lf = xor32_sum(lf);
#pragma unroll
        for (int g4 = 0; g4 < 4; ++g4) { *(f32x4*)(park + 4 * g4) = (f32x4){oc0[4 * g4], oc0[4 * g4 + 1], oc0[4 * g4 + 2], oc0[4 * g4 + 3]}; *(f32x4*)(park + 16 + 4 * g4) = (f32x4){oc1[4 * g4], oc1[4 * g4 + 1], oc1[4 * g4 + 2], oc1[4 * g4 + 3]}; }
    }
    {
        const int c16 = lane & 15, kq = lane >> 4, hd = c16 & 3, qs = c16 >> 2;
        LAS unsigned char* QT = F.lds + LDS_QT; LAS unsigned char* QL = F.lds + LDS_QL + w * 64; LAS int* MREF = (LAS int*)(F.lds + LDS_MREF); LAS unsigned* LS = (LAS unsigned*)(F.lds + LDS_LS);
        LAS int* OS = (LAS int*)(F.lds + LDS_RB);
        LAS int* QCNT = (LAS int*)(F.lds + LDS_QCNT); LAS int* FLAGW = (LAS int*)(F.lds + LDS_QCNT + 12);
        bool exact = false;
        const int nsp = dense ? 0 : (cur - 2);
        if (nsp > 0) {
        { const int row = F.tid >> 1, half = F.tid & 1, q = row >> 2, hh = row & 3;
          const bf16_t* src = proj + (size_t)(b * SEQ + 64 * qb + q) * PW + C_Q + (hkv * 4 + hh) * 64 + 32 * half;
          const u32x4 v0 = *(const u32x4*)src, v1 = *(const u32x4*)(src + 8), v2 = *(const u32x4*)(src + 16), v3 = *(const u32x4*)(src + 24);
          LAS u32x4* d = (LAS u32x4*)(QT + row * QT_ROW + 64 * half); d[0] = v0; d[1] = v1; d[2] = v2; d[3] = v3; }
        for (int i = F.tid; i < 64 * OS_QS; i += 512) OS[i] = 0;
        if (F.tid < 256) LS[F.tid] = 0u;
        if (h == 0) MREF[ql * 4 + gq] = __float_as_int(mf);
        if (F.tid < 2) QCNT[F.tid] = 0;
        if (F.tid == 2) FLAGW[0] = 0;
        __syncthreads();
        const bf16_t* Ksb = kfs + (size_t)bh * 64 * SEQ + lane * 8;
        const bf16_t* Vsb = vts + (size_t)bh * 64 * SEQ + lane * 8;
        auto ticket = [&](LAS int* cnt) -> int { int tk = 0; if (lane == 0) tk = __hip_atomic_fetch_add(cnt, 1, __ATOMIC_RELAXED, __HIP_MEMORY_SCOPE_WORKGROUP); return __builtin_amdgcn_readfirstlane(tk); };
        auto load_k = [&](int j, bf16x8 (&kf)[4][2]) {
#pragma unroll
            for (int rt = 0; rt < 4; ++rt)
#pragma unroll
                for (int ks = 0; ks < 2; ++ks) kf[rt][ks] = *(const bf16x8*)(Ksb + (size_t)j * 4096 + 512 * (2 * rt + ks)); };
        auto load_v = [&](int j, bf16x8 (&vf)[4][2]) {
#pragma unroll
            for (int dt = 0; dt < 4; ++dt)
#pragma unroll
                for (int sp = 0; sp < 2; ++sp) vf[dt][sp] = *(const bf16x8*)(Vsb + (size_t)j * 4096 + 512 * (2 * dt + sp)); };
        auto make_list = [&](int j, int& nj) -> int {
            const unsigned byte = WM[(lane >> 3) * 256 + j]; const bool act = (byte >> (lane & 7)) & 1u;
            const unsigned long long bal = __ballot(act); nj = __popcll(bal);
            const int rank = __builtin_amdgcn_mbcnt_hi((unsigned)(bal >> 32), __builtin_amdgcn_mbcnt_lo((unsigned)bal, 0u));
            if (act) QL[rank] = (unsigned char)lane;
            asm volatile("s_waitcnt lgkmcnt(0)" ::: "memory");
            return (nj + 3) >> 2; };
        auto col_query = [&](int tl, int nj, bool& valid) -> int { const int idx = 4 * tl + qs; valid = idx < nj; return (int)QL[valid ? idx : 0]; };
        auto scores = [&](const bf16x8 (&kf)[4][2], int q, bool valid, f32x4 (&st)[4]) {
            const LAS unsigned char* qp = QT + (q * 4 + hd) * QT_ROW + 16 * kq;
            const bf16x8 q0 = *(const LAS bf16x8*)qp, q1 = *(const LAS bf16x8*)(qp + 64);
#pragma unroll
            for (int rt = 0; rt < 4; ++rt) { st[rt] = (f32x4){0.f, 0.f, 0.f, 0.f}; st[rt] = MFMA16(kf[rt][0], q0, st[rt]); st[rt] = MFMA16(kf[rt][1], q1, st[rt]); }
            if (!valid) {
#pragma unroll
                for (int rt = 0; rt < 4; ++rt) st[rt] = (f32x4){NEG, NEG, NEG, NEG};
            } };
        auto run_pass2 = [&](const bool FAST) {
            bf16x8 kf[4][2], kn[4][2], vf[4][2], vn[4][2];
            int t0 = ticket(QCNT + 1), t1;
            if (t0 < nsp) { load_k(1 + t0, kf); load_v(1 + t0, vf); }
            while (t0 < nsp) {
                t1 = ticket(QCNT + 1);
                if (t1 < nsp) { load_k(1 + t1, kn); load_v(1 + t1, vn); }
                int nj; const int ntl = make_list(1 + t0, nj);
#pragma unroll 2
                for (int tl = 0; tl < ntl; ++tl) {
                    bool valid; const int q = col_query(tl, nj, valid);
                    f32x4 st[4]; scores(kf, q, valid, st);
                    float mr;
                    if (FAST) mr = __int_as_float(MREF[q * 4 + hd]);
                    else { const int key = MREF[q * 4 + hd]; const int ib = key >= 0 ? key : (key ^ 0x7fffffff); mr = __int_as_float(ib); mr = (mr > NEG) ? mr : 0.f; }
                    float ps = 0.f; mr -= os_e2;
#pragma unroll
                    for (int rt = 0; rt < 4; ++rt)
#pragma unroll
                        for (int e = 0; e < 4; ++e) { st[rt][e] = fexp2((st[rt][e] - mr) * AL2E); ps += st[rt][e]; }
                    ps = xor32_sum(xor16_sum(ps));
                    if (FAST) { if (ps > 218.0f * os_scale) FLAGW[0] = 1; }
                    f32x4 o[4];
#pragma unroll
                    for (int dt = 0; dt < 4; ++dt) o[dt] = (f32x4){0.f, 0.f, 0.f, 0.f};
#pragma unroll
                    for (int sp = 0; sp < 2; ++sp) {
                        u32x4 pw; pw.x = pk2(st[2 * sp][0], st[2 * sp][1]); pw.y = pk2(st[2 * sp][2], st[2 * sp][3]); pw.z = pk2(st[2 * sp + 1][0], st[2 * sp + 1][1]); pw.w = pk2(st[2 * sp + 1][2], st[2 * sp + 1][3]);
                        const bf16x8 pb = __builtin_bit_cast(bf16x8, pw);
#pragma unroll
                        for (int dt = 0; dt < 4; ++dt) o[dt] = MFMA16(vf[dt][sp], pb, o[dt]);
                    }
                    if (valid) {
                        LAS int* op = OS + q * OS_QS + hd * OS_HS + 4 * kq;
#pragma unroll
                        for (int dt = 0; dt < 4; ++dt)
#pragma unroll
                            for (int e = 0; e < 4; ++e) __hip_atomic_fetch_add(op + 16 * dt + e, (int)o[dt][e], __ATOMIC_RELAXED, __HIP_MEMORY_SCOPE_WORKGROUP);
                        if (kq == 0) __hip_atomic_fetch_add(LS + q * 4 + hd, (unsigned)(ps * ls_scale + 0.5f), __ATOMIC_RELAXED, __HIP_MEMORY_SCOPE_WORKGROUP);
                    }
                }
#pragma unroll
                for (int rt = 0; rt < 4; ++rt)
#pragma unroll
                    for (int ks = 0; ks < 2; ++ks) { kf[rt][ks] = kn[rt][ks]; vf[rt][ks] = vn[rt][ks]; }
                t0 = t1;
            }
        };
        for (int rep2_ = 0; rep2_ < REP_B3; ++rep2_) {
            if (rep2_ > 0) { __syncthreads(); if (F.tid == 0) QCNT[1] = 0; __syncthreads(); }
            run_pass2(true);
        }
        __syncthreads();
        exact = (FLAGW[0] != 0) || (REP_B2 > 1);
        if (exact) {
            __syncthreads();
            for (int i = F.tid; i < 64 * OS_QS; i += 512) OS[i] = 0;
            if (F.tid < 256) { MREF[F.tid] = (int)0x80000000; LS[F.tid] = 0u; }
            if (F.tid < 2) QCNT[F.tid] = 0;
            __syncthreads();
            {
                bf16x8 kf[4][2], kn[4][2], kn2[4][2];
                int t0 = ticket(QCNT), t1 = ticket(QCNT), t2;
                if (t0 < nsp) load_k(1 + t0, kf);
                if (t1 < nsp) load_k(1 + t1, kn);
                while (t0 < nsp) {
                    t2 = ticket(QCNT);
                    if (t2 < nsp) load_k(1 + t2, kn2);
                    int nj; const int ntl = make_list(1 + t0, nj);
                    for (int tl = 0; tl < ntl; ++tl) {
                        bool valid; const int q = col_query(tl, nj, valid);
                        f32x4 st[4]; scores(kf, q, valid, st);
                        float bm = NEG;
#pragma unroll
                        for (int rt = 0; rt < 4; ++rt)
#pragma unroll
                            for (int e = 0; e < 4; ++e) bm = fmaxf(bm, st[rt][e]);
                        bm = xor32_max(xor16_max(bm));
                        if (valid && kq == 0) { const int ib = __float_as_int(bm); const int key = ib >= 0 ? ib : (ib ^ 0x7fffffff);
                            __hip_atomic_fetch_max(MREF + q * 4 + hd, key, __ATOMIC_RELAXED, __HIP_MEMORY_SCOPE_WORKGROUP); }
                    }
#pragma unroll
                    for (int rt = 0; rt < 4; ++rt)
#pragma unroll
                        for (int ks = 0; ks < 2; ++ks) { kf[rt][ks] = kn[rt][ks]; kn[rt][ks] = kn2[rt][ks]; }
                    t0 = t1; t1 = t2;
                }
            }
            __syncthreads();
            run_pass2(false);
            __syncthreads();
        }
        }
        {
            float ms_ = NEG, ls_ = 0.f;
            if (nsp > 0) { const int key = MREF[ql * 4 + gq]; const int ib = key >= 0 ? key : (key ^ 0x7fffffff); const float m0 = exact ? __int_as_float(ib) : mf;
                if ((!exact || key != (int)0x80000000) && m0 > NEG) { ms_ = m0; ls_ = (float)LS[ql * 4 + gq] * (1.0f / 1048576.0f); } }
            const float Mx = fmaxf(mf, ms_);
            const float wf = fexp2((mf - Mx) * AL2E), ws_ = (ms_ > NEG) ? fexp2((ms_ - Mx) * AL2E) : 0.f;
            const float Lt = lf * wf + ls_ * ws_;
            const float g1 = sigmoidf_(bf2f(grow[1])) / fmaxf(Lt, 1e-30f);
            const float cf = g1 * wf, cs = g1 * ws_ * os_inv;
            const LAS int* ap = OS + ql * OS_QS + gq * OS_HS; float osq = 0.f;
            bf16_t* op = oatt + trow * 1024 + (hkv * 4 + gq) * 64;
#pragma unroll
            for (int g4 = 0; g4 < 4; ++g4) { const int d = 8 * g4 + 4 * h;
                const u32x2 p0 = *(const u32x2*)(op + d), p1 = *(const u32x2*)(op + 32 + d);
                const f32x4 f0 = *(const f32x4*)(park + 4 * g4), f1 = *(const f32x4*)(park + 16 + 4 * g4);
                float s0[4], s1[4];
#pragma unroll
                for (int e = 0; e < 4; ++e) { s0[e] = (nsp > 0) ? (float)ap[d + e] : 0.f; s1[e] = (nsp > 0) ? (float)ap[32 + d + e] : 0.f; }
                u32x2 w0, w1;
                w0.x = pk2(bflo(p0.x) + cf * f0[0] + cs * s0[0], bfhi(p0.x) + cf * f0[1] + cs * s0[1]); w0.y = pk2(bflo(p0.y) + cf * f0[2] + cs * s0[2], bfhi(p0.y) + cf * f0[3] + cs * s0[3]);
                w1.x = pk2(bflo(p1.x) + cf * f1[0] + cs * s1[0], bfhi(p1.x) + cf * f1[1] + cs * s1[1]); w1.y = pk2(bflo(p1.y) + cf * f1[2] + cs * s1[2], bfhi(p1.y) + cf * f1[3] + cs * s1[3]);
                *(u32x2*)(op + d) = w0; *(u32x2*)(op + 32 + d) = w1;
                osq += (bflo(w0.x) * bflo(w0.x) + bfhi(w0.x) * bfhi(w0.x)) + (bflo(w0.y) * bflo(w0.y) + bfhi(w0.y) * bfhi(w0.y)) + (bflo(w1.x) * bflo(w1.x) + bfhi(w1.x) * bfhi(w1.x)) + (bflo(w1.y) * bflo(w1.y) + bfhi(w1.y) * bfhi(w1.y)); }
            (void)__hip_atomic_fetch_add(sst + trow * 2, (unsigned long long)(osq * 16777216.f), __ATOMIC_RELAXED, __HIP_MEMORY_SCOPE_AGENT);
        }
    }
    __syncthreads();
}

DI void attn_phase(Frame& F, const bf16_t* proj, const bf16_t* kcb, const bf16_t* vctb, const bf16_t* vts, const bf16_t* vtw, bf16_t* oatt, const unsigned* vmax_word, float* park, unsigned* qctr, const bf16_t* kfs, unsigned long long* sst) {
    const float vmaxf = fmaxf(__uint_as_float(__hip_atomic_load(vmax_word, __ATOMIC_RELAXED, __HIP_MEMORY_SCOPE_AGENT)), 1e-20f);
    int e2 = (int)floorf(log2f(2.0e9f / (1100.0f * 55.0f * vmaxf)));
    e2 = e2 > 100 ? 100 : (e2 < -100 ? -100 : e2);
    const float os_scale = exp2f((float)e2), os_inv = exp2f((float)-e2);
    LAS int* QW = (LAS int*)(F.lds + LDS_QCNT + 8);
    int xq; { unsigned xx; asm volatile("s_getreg_b32 %0, hwreg(20, 0, 4)" : "=s"(xx)); xq = (int)(xx & 7u); }
    for (int tries = 0; tries < 8; ) {
        __syncthreads();
        if (F.tid == 0) QW[0] = (int)__hip_atomic_fetch_add(qctr + xq, 1u, __ATOMIC_RELAXED, __HIP_MEMORY_SCOPE_AGENT);
        __syncthreads();
        const int k = __builtin_amdgcn_readfirstlane(QW[0]);
        if (k >= 192) { xq = (xq + 1) & 7; ++tries; continue; }
        int bh, qb;
        if (xq < 6) { bh = xq; qb = 4 * (63 - k / 3) + (2 - k % 3); }
        else { bh = 3 * (xq - 6) + (k >> 6); qb = 4 * (63 - (k & 63)) + 3; }
        attn_unit(F, proj, kcb, vctb, vts, vtw, oatt, bh, qb, os_scale, os_inv, (float)e2, park + (size_t)F.bid * 16384 + (size_t)F.tid * 32, kfs, sst);
    }
    __syncthreads();
}


#define XB_TMO      128
#define XB_XCNT(j)  (256  + 64 * (j))
#define XB_XSUB(j)  (1280 + 64 * (j))
#define XB_XGEN(j)  (2304 + 64 * (j))
#define XB_TOP      3328
#define XB_TOPGEN   3392
#define XCD_BAR_WORDS 3456
#define XB_SPIN_CAP (1u << 22)
DI unsigned xb_ld(unsigned* p)              { return __hip_atomic_load(p, __ATOMIC_RELAXED, __HIP_MEMORY_SCOPE_AGENT); }
DI unsigned xb_add(unsigned* p, unsigned v) { return __hip_atomic_fetch_add(p, v, __ATOMIC_RELAXED, __HIP_MEMORY_SCOPE_AGENT); }
DI unsigned xb_xcc_id() { unsigned x; asm volatile("s_getreg_b32 %0, hwreg(20, 0, 4)" : "=s"(x)); return x & 0xFu; }
#define XB_SPIN(cond, bar) do { unsigned _sp = 0; while (cond) { __builtin_amdgcn_s_sleep(1); \
    if ((++_sp & 255u) == 0u) { if (xb_ld(&(bar)[XB_TMO])) break; if (_sp > XB_SPIN_CAP) { atomicAdd(&(bar)[XB_TMO], 1u); break; } } } } while (0)
DI void xcd_barrier_complete(unsigned* bar, unsigned x, unsigned& nloc, unsigned& nx) {
    const unsigned G = gridDim.x * gridDim.y * gridDim.z;
    unsigned sum, cnt, mine, sp = 0u;
    for (;;) {
        sum = 0u; cnt = 0u; mine = 0u;
#pragma unroll
        for (unsigned j = 0; j < 16; ++j) { const unsigned c = xb_ld(&bar[XB_XCNT(j)]); sum += c; cnt += (c > 0u) ? 1u : 0u; mine = (j == x) ? c : mine; }
        if (sum == G) break;
        __builtin_amdgcn_s_sleep(1);
        if ((++sp & 255u) == 0u) { if (xb_ld(&bar[XB_TMO])) break; if (sp > XB_SPIN_CAP) { atomicAdd(&bar[XB_TMO], 1u); break; } }
    }
    nloc = mine > 0u ? mine : 1u; nx = cnt > 0u ? cnt : 1u;
}
DI void xcd_barrier(unsigned* bar, volatile LAS unsigned* st, int tid) {
    asm volatile("s_waitcnt vmcnt(0)" ::: "memory");
    __syncthreads();
    if (tid == 0) {
        const unsigned x = xb_xcc_id();
        __builtin_amdgcn_s_waitcnt(0);
        unsigned nloc = st[0], nx = st[1];
        if (nloc == 0u) { xcd_barrier_complete(bar, x, nloc, nx); st[0] = nloc; st[1] = nx; }
        const unsigned old = xb_add(&bar[XB_XSUB(x)], 1u);
        const unsigned gen = old / nloc;
        if (old + 1u == (gen + 1u) * nloc) {
            __builtin_amdgcn_fence(__ATOMIC_RELEASE, "agent");
            asm volatile("s_waitcnt vmcnt(0)" ::: "memory");
            const unsigned og = xb_add(&bar[XB_TOP], 1u);
            const unsigned tg = og / nx;
            if (og + 1u == (tg + 1u) * nx) xb_add(&bar[XB_TOPGEN], 1u);
            else XB_SPIN(xb_ld(&bar[XB_TOPGEN]) == tg, bar);
            __builtin_amdgcn_fence(__ATOMIC_ACQUIRE, "agent");
            xb_add(&bar[XB_XGEN(x)], 1u);
            asm volatile("s_waitcnt vmcnt(0)" ::: "memory");
        } else {
            XB_SPIN(xb_ld(&bar[XB_XGEN(x)]) == gen, bar);
            __builtin_amdgcn_fence(__ATOMIC_ACQUIRE, "agent");
            asm volatile("s_waitcnt vmcnt(0)" ::: "memory");
        }
    }
    __syncthreads();
}

#define REFRESH() do { int w_ = wave0, b_ = blockIdx.x, g_ = gridDim.x; asm volatile("" : "+s"(w_), "+s"(b_), "+s"(g_)); \
    int l_; asm volatile("v_mbcnt_lo_u32_b32 %0, -1, 0\n\tv_mbcnt_hi_u32_b32 %0, -1, %0" : "=v"(l_)); \
    F.lane = l_; F.wave = w_; F.tid = w_ * 64 + l_; F.bid = b_; F.G = g_; F.gw = b_ * 8 + w_; F.ngw = g_ * 8; } while (0)
#define XBAR() xcd_barrier((unsigned*)(F.wsp() + WS_CTL), (volatile LAS unsigned*)(F.lds + LDS_PT + 232), F.tid)
#if REP_SYNC > 1
#define GSYNC() do { XBAR(); XBAR(); REFRESH(); } while (0)
#else
#define GSYNC() do { REFRESH(); XBAR(); REFRESH(); } while (0)
#endif
#define WSP(off) (F.wsp() + (off))
#define WL(off) (F.wsp() + WS_W + (size_t)l * WL_STRIDE + (off))
#define MSL(off) (F.wsp() + WS_MISC + (size_t)l * MS_L + (off))
#define CTL(off) (F.wsp() + WS_CTL + CT_BASE + (size_t)l * CT_L + (off))
__global__ void __launch_bounds__(512, 2) mk_fwd(Params p) {
    extern __shared__ __attribute__((aligned(16))) unsigned char lds_raw[];
    cg::grid_group grid = cg::this_grid();
    Frame F;
    F.lds = (LAS unsigned char*)lds_raw; F.pt = (LAS const unsigned long long*)(F.lds + LDS_PT);
    const int wave0 = __builtin_amdgcn_readfirstlane((int)threadIdx.x >> 6);
    REFRESH();
    {
        LAS unsigned long long* ptw = (LAS unsigned long long*)(F.lds + LDS_PT);
        if (F.tid < 26) ptw[F.tid] = (unsigned long long)p.in[F.tid];
        if (F.tid == 26) ptw[26] = (unsigned long long)p.out;
        if (F.tid == 27) ptw[27] = (unsigned long long)p.ws;
        if (F.tid == 28) ptw[29] = 0ull;
        if (F.tid == 0) (void)xb_add((unsigned*)p.ws + XB_XCNT(xb_xcc_id()), 1u);
    }
    __syncthreads();

    PH(2, convert_rows_stats(F, F.in(0), (bf16_t*)WSP(WS_ACT), (unsigned long long*)WSP(WS_SSX)); REFRESH(););
    { unsigned long long* z = (unsigned long long*)WSP(WS_SSX) + (size_t)NT * 2; for (int i = F.bid * 512 + F.tid; i < (NL - 1) * NT * 2; i += F.G * 512) z[i] = 0ull; }
    { unsigned long long* z = (unsigned long long*)WSP(WS_SST); for (int i = F.bid * 512 + F.tid; i < NL * NT * 2; i += F.G * 512) z[i] = 0ull; }
    PH(0, prologue_a(F, 0, F.gw, F.ngw); REFRESH(););
    if (F.G == 0x7fffffff) grid.sync();
    GSYNC();
    PH(1, prologue_b(F); REFRESH(););
    if (F.G != 256) { prologue_a(F, 1, F.gw, F.ngw); __syncthreads(); REFRESH(); }
    else if (F.bid >= 128) { prologue_a(F, 1, (F.bid - 128) * 8 + F.wave, 1024); __syncthreads(); REFRESH(); }

#if STAGE >= 2
#pragma unroll 1
    for (int l = 0; l < NL; ++l) {
        REFRESH();
        { pg8::APlain g{(l == 0) ? (const char*)WSP(WS_ACT) : (const char*)F.out(), (const char*)WL(WO_WIN), 1024}; pg8::StaticOrder S; S.init(NT / 256, PW / 256, F.G, F.bid);
          pg8::EpiBf16 E{(bf16_t*)WSP(WS_PROJ), PW, (const unsigned long long*)WSP(WS_SSX) + (size_t)l * NT * 2}; pg8::gemm_phase<pg8::EpiBf16, pg8::APlain, true>(F.lds, g, S, E, F.tid); }
#if REP_INPROJ > 1
        REFRESH();
        { pg8::APlain g{(l == 0) ? (const char*)WSP(WS_ACT) : (const char*)F.out(), (const char*)WL(WO_WIN), 1024}; pg8::StaticOrder S; S.init(NT / 256, PW / 256, F.G, F.bid);
          pg8::EpiBf16 E{(bf16_t*)WSP(WS_PROJ), PW, (const unsigned long long*)WSP(WS_SSX) + (size_t)l * NT * 2}; pg8::gemm_phase<pg8::EpiBf16, pg8::APlain, true>(F.lds, g, S, E, F.tid); }
#endif
        GSYNC();
#define LOCAL_HANDOFF() do { asm volatile("s_waitcnt vmcnt(0)" ::: "memory"); __syncthreads(); if (F.tid == 0) { __builtin_amdgcn_fence(__ATOMIC_ACQUIRE, "agent"); asm volatile("s_waitcnt vmcnt(0)" ::: "memory"); } __syncthreads(); } while (0)
        if (F.G == 256) {
            if (F.bid < 48) {
                REFRESH();
                { pg8::ACompress g{(const char*)WSP(WS_PROJ), (const char*)WL(WO_W1)}; pg8::StaticOrder S; S.init_run(F.bid, 0, 1);
                  pg8::EpiCmpHid E{(bf16_t*)WSP(WS_HIDC), (const float*)CTL(CT_CB1)}; pg8::gemm_phase<pg8::EpiCmpHid, pg8::ACompress, true>(F.lds, g, S, E, F.tid); }
                REFRESH(); LOCAL_HANDOFF(); REFRESH();
                { const int pm = F.bid, it = (pm / 24) * 192 + (pm % 24) * 8 + F.wave;
                  compress2_phase(F, (const bf16_t*)WSP(WS_HIDC), (const bf16_t*)CTL(CT_W2T), F.in(7) + (size_t)l * 2 * 64, (bf16_t*)WSP(WS_KC), (bf16_t*)WSP(WS_VCT), it, it + 1, 1); }
            } else if (F.bid < 80) {
                REFRESH();
                { pg8::ASsm1 g{(const char*)WSP(WS_UC), (const char*)WL(WO_SS1)}; pg8::StaticOrder S; S.init_run((F.bid - 48) * 4, 1, 4);
                  pg8::EpiSsm1 E{(float*)WSP(WS_YI), (float*)WSP(WS_HL)}; pg8::gemm_phase<pg8::EpiSsm1, pg8::ASsm1, true>(F.lds, g, S, E, F.tid); }
                REFRESH(); LOCAL_HANDOFF(); REFRESH();
                ssm_carry_phase(F, (const float*)WSP(WS_HL), (const f32x2*)CTL(CT_AB16), (const f32x2*)CTL(CT_AB1K), (bf16_t*)WSP(WS_HIN), F.bid - 48, F.bid - 47, 1);
            } else {
                REFRESH();
                vtranspose_phase(F, (const bf16_t*)WSP(WS_PROJ), (bf16_t*)WSP(WS_VTS), (bf16_t*)WSP(WS_VTW), (bf16_t*)WSP(WS_KFS), (unsigned*)WSP(WS_CTL) + 3584 + l, 80);
                __syncthreads(); REFRESH();
                { pg8::ASsm1 g{(const char*)WSP(WS_UC), (const char*)WL(WO_SS1)}; pg8::StaticOrder S; S.init(128, 1, 176, F.bid - 80);
                  pg8::EpiSsm1 E{(float*)WSP(WS_YI), (float*)WSP(WS_HL)}; pg8::gemm_phase<pg8::EpiSsm1, pg8::ASsm1, true>(F.lds, g, S, E, F.tid); }
            }
            GSYNC();
        } else {
        PH(3, REFRESH(); vtranspose_phase(F, (const bf16_t*)WSP(WS_PROJ), (bf16_t*)WSP(WS_VTS), (bf16_t*)WSP(WS_VTW), (bf16_t*)WSP(WS_KFS), (unsigned*)WSP(WS_CTL) + 3584 + l, 48);
        __syncthreads(); REFRESH(););
        PH(4, REFRESH();
        { pg8::ACompress g{(const char*)WSP(WS_PROJ), (const char*)WL(WO_W1)}; pg8::StaticOrder S; S.init(48, 1, F.G, F.bid);
          pg8::EpiCmpHid E{(bf16_t*)WSP(WS_HIDC), (const float*)CTL(CT_CB1)}; pg8::gemm_phase<pg8::EpiCmpHid, pg8::ACompress, true>(F.lds, g, S, E, F.tid); });
        PH(5, REFRESH();
        { pg8::ASsm1 g{(const char*)WSP(WS_UC), (const char*)WL(WO_SS1)}; pg8::StaticOrder S; S.init(128, 2, F.G, F.bid);
          pg8::EpiSsm1 E{(float*)WSP(WS_YI), (float*)WSP(WS_HL)}; pg8::gemm_phase<pg8::EpiSsm1, pg8::ASsm1, true>(F.lds, g, S, E, F.tid); });
        GSYNC();
        PH(6, compress2_phase(F, (const bf16_t*)WSP(WS_HIDC), (const bf16_t*)CTL(CT_W2T), F.in(7) + (size_t)l * 2 * 64, (bf16_t*)WSP(WS_KC), (bf16_t*)WSP(WS_VCT), F.gw, 2 * 192, F.ngw);
        __syncthreads(); REFRESH(););
        PH(7, ssm_carry_phase(F, (const float*)WSP(WS_HL), (const f32x2*)CTL(CT_AB16), (const f32x2*)CTL(CT_AB1K), (bf16_t*)WSP(WS_HIN), F.bid, 32, F.G); REFRESH(););
        GSYNC();
        }
        PH(8,         REFRESH();
        { pg8::ASsm2 g{(const char*)WSP(WS_HIN), (const char*)WL(WO_SS2)}; pg8::StaticOrder S; S.init(128, 1, F.G, F.bid);
          pg8::EpiSsm2 E{(const float*)WSP(WS_YI), (const bf16_t*)WSP(WS_PROJ), F.in(15) + (size_t)l * 256, (bf16_t*)WSP(WS_YS2)}; pg8::gemm_phase<pg8::EpiSsm2, pg8::ASsm2, true>(F.lds, g, S, E, F.tid); });
#if STAGE >= 3
        REFRESH();
        attn_phase(F, (const bf16_t*)WSP(WS_PROJ), (const bf16_t*)WSP(WS_KC), (const bf16_t*)WSP(WS_VCT), (const bf16_t*)WSP(WS_VTS), (const bf16_t*)WSP(WS_VTW), (bf16_t*)WSP(WS_OATT), (const unsigned*)WSP(WS_CTL) + 3584 + l, (float*)WSP(WS_PARK), (unsigned*)WSP(WS_CTL) + 3600 + 16 * l, (const bf16_t*)WSP(WS_KFS), (unsigned long long*)WSP(WS_SST) + (size_t)l * NT * 2);
#if REP_ATTN > 1
        REFRESH();
        attn_phase(F, (const bf16_t*)WSP(WS_PROJ), (const bf16_t*)WSP(WS_KC), (const bf16_t*)WSP(WS_VCT), (const bf16_t*)WSP(WS_VTS), (const bf16_t*)WSP(WS_VTW), (bf16_t*)WSP(WS_OATT), (const unsigned*)WSP(WS_CTL) + 3584 + l, (float*)WSP(WS_PARK), (unsigned*)WSP(WS_CTL) + 3600 + 16 * l, (const bf16_t*)WSP(WS_KFS), (unsigned long long*)WSP(WS_SST) + (size_t)l * NT * 2);
#endif
#else
        { unsigned* oz = (unsigned*)WSP(WS_OATT); for (size_t i = (size_t)F.bid * 512 + F.tid; i < (size_t)NT * 768 / 2; i += (size_t)F.G * 512) oz[i] = 0u; }
#endif
        GSYNC();
        PH(9,         REFRESH();
        { pg8::APlain g{(const char*)WSP(WS_YS2), (const char*)MSL(MS_WGLU), 256}; pg8::StaticOrder S; S.init(NT / 256, 2, F.G, F.bid);
          pg8::EpiGlu E{(bf16_t*)WSP(WS_OATT), F.in(17) + (size_t)l * 512, (unsigned long long*)WSP(WS_SST) + (size_t)l * NT * 2}; pg8::gemm_phase<pg8::EpiGlu, pg8::APlain, true>(F.lds, g, S, E, F.tid); });
        GSYNC();
        REFRESH();
        { pg8::APlain g{(const char*)WSP(WS_OATT), (const char*)WL(WO_WOUT), 1024}; pg8::StaticOrder S; S.init(NT / 256, 4, F.G, F.bid);
          pg8::EpiResB<true, 0> E{(l == 0) ? F.in(0) : (const float*)nullptr, (const bf16_t*)F.out(), (bf16_t*)F.out(), (const unsigned long long*)WSP(WS_SST) + (size_t)l * NT * 2, (unsigned long long*)nullptr}; pg8::gemm_phase<pg8::EpiResB<true, 0>, pg8::APlain, true>(F.lds, g, S, E, F.tid); }
        GSYNC();
#if STAGE >= 4
        PH(11, rmsnorm_rows_xb<1>(F, (const bf16_t*)F.out(), F.in(21) + (size_t)l * DM, WSP(WS_ACT)); REFRESH(););
        GSYNC();
        REFRESH();
        { pg8::APlain g{(const char*)WSP(WS_ACT), (const char*)WL(WO_WGU), 512, 0x7c7c7c7c, 0x7c7c7c7c}; pg8::StaticOrder S; S.init(NT / 256, 22, F.G, F.bid);
          pg8::EpiSwiglu8 E{(unsigned char*)WSP(WS_PROJ), 0.015625f * FP8FIX}; pg8::gemm_phase<pg8::EpiSwiglu8, pg8::APlain, true, true>(F.lds, g, S, E, F.tid); }
        GSYNC();
        REFRESH();
        { pg8::APlain g{(const char*)WSP(WS_PROJ), (const char*)WL(WO_WD), DFF / 2, 0x7b7b7b7b, 0x7b7b7b7b}; pg8::StaticOrder S; S.init(NT / 256, 4, F.G, F.bid);
          pg8::EpiResB<false, 8> E{(const float*)nullptr, (const bf16_t*)F.out(), (l == NL - 1) ? (bf16_t*)WSP(WS_XLAST) : (bf16_t*)F.out(), (const unsigned long long*)nullptr, (l == NL - 1) ? (unsigned long long*)nullptr : (unsigned long long*)WSP(WS_SSX) + (size_t)(l + 1) * NT * 2}; pg8::gemm_phase<pg8::EpiResB<false, 8>, pg8::APlain, true, true>(F.lds, g, S, E, F.tid); }
        GSYNC();
#endif
#if STAGE < 5
        break;
#endif
    }
    rmsnorm_rows_xb<2>(F, (const bf16_t*)WSP(WS_XLAST), F.in(25), F.out());
#else
    {
        const float* x0 = F.in(0); const float* fg = F.in(25); float* X = F.out();
        for (int m = F.gw; m < NT; m += F.ngw) {
            const f32x4* xr = (const f32x4*)(x0 + (size_t)m * DM) + F.lane; f32x4 v[4]; float s = 0.f;
#pragma unroll
            for (int j = 0; j < 4; ++j) { v[j] = xr[64 * j]; s += (v[j].x * v[j].x + v[j].y * v[j].y) + (v[j].z * v[j].z + v[j].w * v[j].w); }
            const float rstd = rsqrtf(wave_sum(s) * (1.f / DM) + 1e-6f);
            f32x4* o = (f32x4*)(X + (size_t)m * DM) + F.lane;
#pragma unroll
            for (int j = 0; j < 4; ++j) o[64 * j] = v[j] * rstd * ((const f32x4*)fg)[64 * j + F.lane];
        }
    }
#endif
}

extern "C" void kernel_launch(void* const* d_in, const int* in_sizes, int n_in, void* d_out, int out_size, void* d_ws, size_t ws_size, hipStream_t stream) {
    static int grid_blocks = 0;
    if (grid_blocks == 0) {
        if (n_in != 26 || ws_size < WS_END) { fprintf(stderr, "kernel_launch: unexpected n_in %d or ws_size %zu (< %zu)\n", n_in, ws_size, (size_t)WS_END); grid_blocks = -1; return; }
        int dev = 0, cus = 0, per_cu = 0;
        hipGetDevice(&dev);
        hipDeviceGetAttribute(&cus, hipDeviceAttributeMultiprocessorCount, dev);
        hipFuncSetAttribute((const void*)mk_fwd, hipFuncAttributeMaxDynamicSharedMemorySize, LDS_BYTES);
        hipOccupancyMaxActiveBlocksPerMultiprocessor(&per_cu, (const void*)mk_fwd, 512, LDS_BYTES);
        if (per_cu < 1) { fprintf(stderr, "kernel_launch: occupancy query says %d blocks per CU\n", per_cu); per_cu = 1; }
        grid_blocks = cus;
        (void)hipGetLastError();
    }
    if (grid_blocks < 0) return;
    if (hipMemsetAsync((char*)d_ws + WS_CTL, 0, 16384, stream) != hipSuccess) { fprintf(stderr, "kernel_launch: memset of the barrier words failed\n"); return; }
    Params p{};
    for (int i = 0; i < 26; ++i) p.in[i] = (const float*)d_in[i];
    p.out = (float*)d_out; p.ws = (unsigned char*)d_ws;
    void* args[] = {&p};
    hipError_t e = hipLaunchCooperativeKernel((const void*)mk_fwd, dim3(grid_blocks), dim3(512), args, LDS_BYTES, stream);
    if (e != hipSuccess) fprintf(stderr, "cooperative launch failed: %s (grid %d)\n", hipGetErrorString(e), grid_blocks);
}
```

```cpp
#include <hip/hip_runtime.h>
#include <hip/hip_cooperative_groups.h>
#include <cstdio>
#include <cstdint>
namespace cg = cooperative_groups;

#ifndef STAGE
#define STAGE 99
#endif
#ifndef REP_ATTN
#define REP_ATTN 1
#endif
#ifndef REP_B1
#define REP_B1 1
#endif
#ifndef REP_B2
#define REP_B2 1
#endif
#ifndef REP_B3
#define REP_B3 1
#endif
#ifndef REP_TK
#define REP_TK 1
#endif
#ifndef FP8FIX
#define FP8FIX 1.0f
#endif
#ifndef PROBE_DUP
#define PROBE_DUP 0
#endif
#define PH(bit, ...) do { __VA_ARGS__ if (PROBE_DUP & (1 << (bit))) { __VA_ARGS__ } } while (0)
#ifndef REP_GU
#define REP_GU 1
#endif
#ifndef REP_INPROJ
#define REP_INPROJ 1
#endif
#ifndef REP_SYNC
#define REP_SYNC 1
#endif

#define DI __device__ __forceinline__
#define LAS __attribute__((address_space(3)))
typedef unsigned short bf16_t;
typedef short bf16x8 __attribute__((ext_vector_type(8)));
typedef short s16x4 __attribute__((ext_vector_type(4)));
typedef float f32x4 __attribute__((ext_vector_type(4)));
typedef float f32x2 __attribute__((ext_vector_type(2)));
typedef float f32x16 __attribute__((ext_vector_type(16)));
typedef unsigned u32x4 __attribute__((ext_vector_type(4)));
typedef unsigned u32x2 __attribute__((ext_vector_type(2)));
typedef __bf16 bf2_t __attribute__((ext_vector_type(2)));
typedef int i32x8 __attribute__((ext_vector_type(8)));
typedef int i32x4 __attribute__((ext_vector_type(4)));

DI float clamp8(float v) { return fminf(fmaxf(v, -440.f), 440.f); }
DI unsigned pk4_fp8(float a, float b, float c, float d) { int w = 0; w = __builtin_amdgcn_cvt_pk_fp8_f32(clamp8(a), clamp8(b), w, false); w = __builtin_amdgcn_cvt_pk_fp8_f32(clamp8(c), clamp8(d), w, true); return (unsigned)w; }
DI unsigned pk2(float lo, float hi) { f32x2 v = {lo, hi}; return __builtin_bit_cast(unsigned, __builtin_convertvector(v, bf2_t)); }
DI bf16_t f2bf(float f) { return (bf16_t)(pk2(f, 0.f) & 0xffffu); }
DI float bf2f(bf16_t u) { return __uint_as_float((unsigned)u << 16); }
DI float bflo(unsigned w) { return __uint_as_float(w << 16); }
DI float bfhi(unsigned w) { return __uint_as_float(w & 0xffff0000u); }
DI float fexp2(float x) { return __builtin_amdgcn_exp2f(x); }
DI float sigmoidf_(float x) { return __builtin_amdgcn_rcpf(1.0f + __builtin_amdgcn_exp2f(-1.4426950408889634f * x)); }
DI float gelu_tanh(float x) { const float y = 0.7978845608028654f * (x + 0.044715f * x * x * x); return x * __builtin_amdgcn_rcpf(1.0f + __builtin_amdgcn_exp2f(-2.8853900817779268f * y)); }
template <int CTRL> DI float dppf(float v) { return __builtin_bit_cast(float, __builtin_amdgcn_update_dpp(0, __builtin_bit_cast(int, v), CTRL, 0xF, 0xF, false)); }
struct F2 { float lo, hi; };
DI F2 halves32(float v) { const auto r = __builtin_amdgcn_permlane32_swap(__float_as_uint(v), __float_as_uint(v), false, false); return {__uint_as_float(r[0]), __uint_as_float(r[1])}; }
DI F2 rows16(float v) { const auto r = __builtin_amdgcn_permlane16_swap(__float_as_uint(v), __float_as_uint(v), false, false); return {__uint_as_float(r[0]), __uint_as_float(r[1])}; }
DI float xor32_sum(float v) { const F2 p = halves32(v); return p.lo + p.hi; }
DI float xor32_max(float v) { const F2 p = halves32(v); return fmaxf(p.lo, p.hi); }
DI float xor16_sum(float v) { const F2 p = rows16(v); return p.lo + p.hi; }
DI float xor16_max(float v) { const F2 p = rows16(v); return fmaxf(p.lo, p.hi); }
DI float wave_sum(float v) {
    v += dppf<0xB1>(v); v += dppf<0x4E>(v); v += dppf<0x141>(v); v += dppf<0x140>(v);
    return xor32_sum(xor16_sum(v));
}

DI unsigned wave_max_u32(unsigned v) {
    v = max(v, (unsigned)__builtin_amdgcn_update_dpp(0, (int)v, 0xB1, 0xF, 0xF, false));
    v = max(v, (unsigned)__builtin_amdgcn_update_dpp(0, (int)v, 0x4E, 0xF, 0xF, false));
    v = max(v, (unsigned)__builtin_amdgcn_update_dpp(0, (int)v, 0x141, 0xF, 0xF, false));
    v = max(v, (unsigned)__builtin_amdgcn_update_dpp(0, (int)v, 0x140, 0xF, 0xF, false));
    const unsigned a = __builtin_amdgcn_readlane(v, 0), b = __builtin_amdgcn_readlane(v, 16), c = __builtin_amdgcn_readlane(v, 32), d = __builtin_amdgcn_readlane(v, 48);
    return max(max(a, b), max(c, d));
}

constexpr int NB = 2, SEQ = 16384, DM = 1024, NT = NB * SEQ, NL = 2;
constexpr int PW = 2304;
constexpr int C_Q = 0, C_KC = 768, C_VC = 960, C_KS = 1152, C_VS = 1344, C_KW = 1536, C_VW = 1728, C_U = 1920, C_G = 2176;
constexpr int DFF = 2816;
constexpr float L2E = 1.4426950408889634f;

constexpr size_t MiB = 1u << 20;
constexpr size_t WS_CTL = 0;
constexpr size_t WS_W = 1 * MiB;
constexpr size_t WL_STRIDE = 32 * MiB;
constexpr size_t WO_WIN = 0;
constexpr size_t WO_WOUT = 5 * MiB;
constexpr size_t WO_WGU = 7 * MiB;
constexpr size_t WO_WD = 18 * MiB;
constexpr size_t WO_W1 = 24 * MiB;
constexpr size_t WO_SS1 = 26 * MiB;
constexpr size_t WO_SS2 = 30 * MiB;
constexpr size_t CT_L = 256 * 1024;
constexpr size_t CT_BASE = 64 * 1024;
constexpr size_t CT_AB16 = 0;
constexpr size_t CT_AB1K = 8 * 1024;
constexpr size_t CT_CB1 = 16 * 1024;
constexpr size_t CT_W2T = 20 * 1024;
constexpr size_t CT_WGLU = 84 * 1024;
constexpr size_t WS_ACT = WS_W + 2 * WL_STRIDE;
constexpr size_t WS_PROJ = WS_ACT + 64 * MiB;
constexpr size_t WS_OATT = WS_PROJ + 176 * MiB;
constexpr size_t WS_OSSM = WS_OATT + 48 * MiB;
constexpr size_t WS_YS2 = WS_OSSM + 16 * MiB;
constexpr size_t WS_YI = WS_ACT;
constexpr size_t WS_HL = WS_YS2 + 16 * MiB;
constexpr size_t WS_HIN = WS_HL + 16 * MiB;
constexpr size_t WS_VTS = WS_HIN + 16 * MiB;
constexpr size_t WS_VTW = WS_VTS + 12 * MiB;
constexpr size_t WS_KC = WS_VTW + 12 * MiB;
constexpr size_t WS_VCT = WS_KC + 1 * MiB;
constexpr size_t WS_HIDC = WS_VCT + 1 * MiB;
constexpr size_t WS_MISC = WS_HIDC + 6 * MiB;
constexpr size_t WS_PARK = WS_MISC + 4 * MiB;
constexpr size_t WS_KFS = WS_PARK + 16 * MiB;
constexpr size_t WS_SST = WS_KFS + 12 * MiB;
constexpr size_t WS_SSX = WS_SST + 1 * MiB;
constexpr size_t WS_UC = WS_SSX + 1 * MiB;
constexpr size_t WS_END = WS_UC + 16 * MiB;
constexpr size_t WS_XLAST = WS_PROJ + 96 * MiB;
constexpr size_t MS_L = 2 * MiB;
constexpr size_t MS_MTAB = 0;
constexpr size_t MS_CBP = 256 * 1024;
constexpr size_t MS_WGLU = 512 * 1024;
constexpr size_t MS_BBAR = 1024 * 1024;
constexpr size_t MS_FTAB = 1024 * 1024 + 128 * 1024;

constexpr int LDS_BYTES = 143360;

struct Params { const float* in[26]; float* out; unsigned char* ws; };

namespace pg8 {
constexpr int BM = 256, BK = 64, HALF = 128, HTB = HALF * BK * 2, STAGE_BYTES = 8 * HTB, NXCD = 8, WGM = 8;
__host__ __device__ __forceinline__ int lds_byte(int r, int c) { const int st = (r >> 4) * 2 + (c >> 5), rr = r & 15, cc = c & 31, ob = rr * 64 + cc * 2; return st * 1024 + (ob ^ (((ob >> 9) & 1) << 5)); }
__host__ __device__ __forceinline__ void stage_rc(int b, int& R, int& C) { const int st = b / 1024, sb = b % 1024, swz = sb ^ (((sb >> 9) & 1) << 5); R = (st >> 1) * 16 + swz / 64; C = (st & 1) * 32 + (swz % 64) / 2; }
__host__ __device__ __forceinline__ int perm32(int rho) { const int n = rho >> 4, i = rho & 15; return 8 * (i >> 2) + 4 * n + (i & 3); }
struct Unit { int pm, pn, part; };
constexpr int ROWTAB_OFF = STAGE_BYTES;
struct StaticOrder {
    int nM, nN, nwg, G, c, lmode = 0, lbase = 0, lpn = 0, lcount = 0;
    __device__ void init(int nM_, int nN_, int G_, int c_) { nM = nM_; nN = nN_; nwg = nM * nN; G = G_; c = c_; lmode = 0; }
    __device__ void init_run(int base, int pn, int count) { lmode = 1; lbase = base; lpn = pn; lcount = count; nM = 0; nN = 0; nwg = 0; G = 1; c = 0; }
    __device__ bool next(int i, Unit& u) const {
        if (lmode == 1) { if (i >= lcount) return false; u.pm = lbase + i; u.pn = lpn; return true; }
        const long L = (long)i * G + c; if (L >= nwg) return false;
        int wgid = (int)L; { const int q = nwg / NXCD, r = nwg % NXCD, xcd = wgid % NXCD, off = wgid / NXCD; wgid = (xcd < r ? xcd * (q + 1) : r * (q + 1) + (xcd - r) * q) + off; }
        const int nig = WGM * nN, gid = wgid / nig, fm = gid * WGM, gsz = (nM - fm) < WGM ? (nM - fm) : WGM;
        u.pm = fm + ((wgid % nig) % gsz); u.pn = (wgid % nig) / gsz; return true;
    }
};

template <class Epi, class Addr, bool ALIGN_EPI, bool FP8 = false>
__device__ __forceinline__ void gemm_phase(LAS unsigned char* lds, const Addr& g, const StaticOrder& S, const Epi& E, int tid) {
    asm volatile("" : "+v"(tid));
    const int wid = __builtin_amdgcn_readfirstlane(tid >> 6), lane = tid & 63, wr = wid >> 2, wc = wid & 3, fr = lane & 15, fq = lane >> 4;
    const int K = g.K(), nt0 = K / BK;
    unsigned voffA[2], voffB[2];
#pragma unroll
    for (int i = 0; i < 2; ++i) { int R, C; stage_rc(tid * 16 + i * 8192, R, C); const int Rb = Epi::PERM ? ((R & ~31) + perm32(R & 31)) : R;
        voffA[i] = (unsigned)R * g.a_row_bytes() + g.a_col_off(C); voffB[i] = (unsigned)(Rb * K + C) * 2u; }
    const size_t kstepA = g.a_kstep(), kstepB = (size_t)(BK * 2);
    const size_t hstepA = (size_t)HALF * g.a_row_bytes(), hstepB = (size_t)HALF * K * 2;
    const unsigned ldsw = (unsigned)wid * 1024u;
    const int aoff = lds_byte(wr * 64 + fr, fq * 8), boff = lds_byte(wc * 32 + fr, fq * 8);
#define PG8_SA(b, h) (((b) * 2 + (h)) * HTB)
#define PG8_SB(b, h) ((4 + (b) * 2 + (h)) * HTB)
#define PG8_STAGE(bufoff, gbase, voff) do { _Pragma("unroll") for (int _i = 0; _i < 2; ++_i) \
        __builtin_amdgcn_global_load_lds((const unsigned*)((const char*)(gbase) + (voff)[_i]), (LAS unsigned*)(lds + (bufoff) + ldsw + _i * 8192), 16, 0, 0); } while (0)
#define PG8_LDA(dst, b, h) do { _Pragma("unroll") for (int m = 0; m < 4; ++m) _Pragma("unroll") for (int k = 0; k < 2; ++k) dst[m][k] = *(const LAS bf16x8*)(lds + PG8_SA(b, h) + aoff + m * 2048 + k * 1024); } while (0)
#define PG8_LDB(dst, b, h) do { _Pragma("unroll") for (int n = 0; n < 2; ++n) _Pragma("unroll") for (int k = 0; k < 2; ++k) dst[n][k] = *(const LAS bf16x8*)(lds + PG8_SB(b, h) + boff + n * 2048 + k * 1024); } while (0)
#define PG8_CAT(x, y) __builtin_bit_cast(i32x8, __builtin_shufflevector((x), (y), 0, 1, 2, 3, 4, 5, 6, 7, 8, 9, 10, 11, 12, 13, 14, 15))
#define PG8_MMA(ai, bj, At, Bt) do { __builtin_amdgcn_s_setprio(1); _Pragma("unroll") for (int m = 0; m < 4; ++m) _Pragma("unroll") for (int n = 0; n < 2; ++n) { \
        if constexpr (FP8) { const i32x8 bw_ = PG8_CAT(Bt[n][0], Bt[n][1]), aw_ = PG8_CAT(At[m][0], At[m][1]); \
            asm volatile("v_mfma_f32_16x16x128_f8f6f4 %0, %1, %2, %0" : "+v"(acc[ai][bj][m][n]) : "v"(bw_), "v"(aw_));   } \
        else { _Pragma("unroll") for (int k = 0; k < 2; ++k) acc[ai][bj][m][n] = __builtin_amdgcn_mfma_f32_16x16x32_bf16(Bt[n][k], At[m][k], acc[ai][bj][m][n], 0, 0, 0); } } \
        __builtin_amdgcn_s_setprio(0); } while (0)
#define PG8_WAIT_V(n) asm volatile("s_waitcnt vmcnt(" #n ")" ::: "memory")
#define PG8_WAIT_L(n) asm volatile("s_waitcnt lgkmcnt(" #n ")" ::: "memory")
#define PG8_BAR __builtin_amdgcn_s_barrier()
#define PG8_SCHED __builtin_amdgcn_sched_barrier(0)
    Unit cur, nxt; int ui = 0;
    constexpr bool SPLIT = Epi::MID_T > 0;
    auto get_unit = [&](int i, Unit& u) -> bool { if constexpr (SPLIT) { const bool ok = S.next(i >> 1, u); u.part = i & 1; return ok; } else { const bool ok = S.next(i, u); u.part = 0; return ok; } };
    auto part_off = [&](const Unit& u) -> size_t { if constexpr (SPLIT) return (size_t)u.part * (Epi::MID_T * BK * 2); else return 0; };
    if (!get_unit(0, cur)) return;
    f32x4 acc[2][2][4][2];
#pragma unroll
    for (int a = 0; a < 2; ++a)
#pragma unroll
        for (int b = 0; b < 2; ++b)
#pragma unroll
            for (int m = 0; m < 4; ++m)
#pragma unroll
                for (int n = 0; n < 2; ++n) acc[a][b][m][n] = (f32x4){0.f, 0.f, 0.f, 0.f};
    bf16x8 At[4][2], B0[2][2], B1[2][2];
    const char* cA = g.a_base(cur) + part_off(cur); const char* cB = g.b_base(cur) + part_off(cur);
    PG8_STAGE(PG8_SB(0, 0), cB, voffB); PG8_STAGE(PG8_SB(0, 1), cB + hstepB, voffB); PG8_STAGE(PG8_SA(0, 0), cA, voffA); PG8_STAGE(PG8_SA(0, 1), cA + hstepA, voffA);
    if (wr == 1) PG8_BAR;
    PG8_WAIT_V(2); PG8_BAR;
    PG8_STAGE(PG8_SB(1, 0), cB + kstepB, voffB); PG8_STAGE(PG8_SA(1, 0), cA + kstepA, voffA); PG8_STAGE(PG8_SB(1, 1), cB + hstepB + kstepB, voffB);
    PG8_WAIT_V(6); PG8_BAR;
    for (;;) {
        const bool has_next = get_unit(ui + 1, nxt);
        const char* nA = has_next ? g.a_base(nxt) + part_off(nxt) : cA; const char* nB = has_next ? g.b_base(nxt) + part_off(nxt) : cB;
        int nt = nt0; if constexpr (SPLIT) nt = cur.part ? nt0 - Epi::MID_T : Epi::MID_T;
        for (int t = 0; t < nt; t += 2) {
            const bool last = (t == nt - 2);
            if constexpr (Epi::ROWTAB) {
                if (t == 0 && wid < 4 && cur.part == 0) {
                    int l_; asm volatile("v_mbcnt_lo_u32_b32 %0, -1, 0\n\tv_mbcnt_hi_u32_b32 %0, -1, %0" : "=v"(l_));
                    __builtin_amdgcn_global_load_lds((const unsigned*)(E.rowtab + ((size_t)cur.pm * BM + wid * 64 + l_) * 2), (LAS unsigned*)(lds + ROWTAB_OFF + ((SPLIT ? (ui >> 1) : ui) & 1) * 4096 + wid * 1024), 16, 0, 0); } }
            const char* a1 = cA + (size_t)(t + 1) * kstepA;
            const char* a2 = last ? nA : cA + (size_t)(t + 2) * kstepA; const char* b2 = last ? nB : cB + (size_t)(t + 2) * kstepB;
            const char* a3 = a2 + kstepA; const char* b3 = b2 + kstepB;
            PG8_LDB(B0, 0, 0); PG8_LDB(B1, 0, 1); PG8_SCHED; PG8_LDA(At, 0, 0); PG8_STAGE(PG8_SA(1, 1), a1 + hstepA, voffA);
            PG8_WAIT_V(8); PG8_WAIT_L(0); PG8_BAR; PG8_MMA(0, 0, At, B0); PG8_MMA(0, 1, At, B1); PG8_BAR; PG8_SCHED;
            PG8_LDA(At, 0, 1); PG8_STAGE(PG8_SB(0, 0), b2, voffB); PG8_STAGE(PG8_SB(0, 1), b2 + hstepB, voffB); PG8_STAGE(PG8_SA(0, 0), a2, voffA);
            PG8_WAIT_V(8); PG8_WAIT_L(0); PG8_BAR; PG8_MMA(1, 0, At, B0); PG8_MMA(1, 1, At, B1); PG8_BAR; PG8_SCHED;
            PG8_LDB(B0, 1, 0); PG8_LDB(B1, 1, 1); PG8_SCHED; PG8_LDA(At, 1, 0); PG8_STAGE(PG8_SA(0, 1), a2 + hstepA, voffA);
            PG8_WAIT_V(8); PG8_WAIT_L(0); PG8_BAR; PG8_MMA(0, 0, At, B0); PG8_MMA(0, 1, At, B1); PG8_BAR; PG8_SCHED;
            PG8_LDA(At, 1, 1); PG8_STAGE(PG8_SB(1, 0), b3, voffB); PG8_STAGE(PG8_SB(1, 1), b3 + hstepB, voffB); PG8_STAGE(PG8_SA(1, 0), a3, voffA);
            PG8_WAIT_V(8); PG8_WAIT_L(0); PG8_BAR; PG8_MMA(1, 0, At, B0); PG8_MMA(1, 1, At, B1); PG8_BAR; PG8_SCHED;
        }
        if constexpr (ALIGN_EPI) { if (wr == 0) PG8_BAR; }
        if constexpr (FP8) asm volatile("s_nop 15\n\ts_nop 15" ::: "memory");
        { int le_; asm volatile("v_mbcnt_lo_u32_b32 %0, -1, 0\n\tv_mbcnt_hi_u32_b32 %0, -1, %0" : "=v"(le_)); const int fr_e = le_ & 15, fq_e = le_ >> 4;
          if constexpr (Epi::ROWTAB) {
              const LAS unsigned long long* tab = (const LAS unsigned long long*)(lds + ROWTAB_OFF + ((SPLIT ? (ui >> 1) : ui) & 1) * 4096);
              if (SPLIT && cur.part == 0) {
                  const LAS unsigned long long* tb = tab + (wr * 64 + fr_e) * 2;
#pragma unroll
                  for (int a = 0; a < 2; ++a)
#pragma unroll
                      for (int m = 0; m < 4; ++m) { const float ratio = Epi::row_ratio(tb[(a * HALF + m * 16) * 2], tb[(a * HALF + m * 16) * 2 + 1]);
#pragma unroll
                          for (int b = 0; b < 2; ++b)
#pragma unroll
                              for (int n = 0; n < 2; ++n) acc[a][b][m][n] = acc[a][b][m][n] * ratio; }
              } else E(acc, cur, wr, wc, fr_e, fq_e, tab);
          } else E(acc, cur, wr, wc, fr_e, fq_e); }
        if (!has_next) break;
        if (!SPLIT || cur.part != 0) {
#pragma unroll
        for (int a = 0; a < 2; ++a)
#pragma unroll
            for (int b = 0; b < 2; ++b)
#pragma unroll
                for (int m = 0; m < 4; ++m)
#pragma unroll
                    for (int n = 0; n < 2; ++n) acc[a][b][m][n] = (f32x4){0.f, 0.f, 0.f, 0.f};
        }
        cur = nxt; cA = nA; cB = nB; ++ui;
        if constexpr (ALIGN_EPI) { if (wr == 1) PG8_BAR; }
    }
    PG8_WAIT_V(0);
    if constexpr (!ALIGN_EPI) { if (wr == 0) PG8_BAR; }
    PG8_BAR;
#undef PG8_SA
#undef PG8_SB
#undef PG8_STAGE
#undef PG8_LDA
#undef PG8_LDB
#undef PG8_MMA
#undef PG8_CAT
#undef PG8_WAIT_V
#undef PG8_WAIT_L
#undef PG8_BAR
#undef PG8_SCHED
}

struct APlain {
    const char* A; const char* Bt; int k; int sw = 0x7f7f7f7f, sa = 0x7f7f7f7f;
    DI int scale_w() const { return sw; } DI int scale_a() const { return sa; }
    DI int K() const { return k; }
    DI unsigned a_row_bytes() const { return (unsigned)k * 2u; }
    DI unsigned a_kstep() const { return 128u; }
    DI unsigned a_col_off(int C) const { return (unsigned)C * 2u; }
    DI const char* a_base(const Unit& u) const { return A + (size_t)u.pm * 256 * k * 2; }
    DI const char* b_base(const Unit& u) const { return Bt + (size_t)u.pn * 256 * k * 2; }
};
struct ACompress {
    const char* proj; const char* w1t;
    DI int scale_w() const { return 0x7f7f7f7f; } DI int scale_a() const { return 0x7f7f7f7f; }
    DI int K() const { return 2048; }
    DI unsigned a_row_bytes() const { return 16u * PW * 2u; }
    DI unsigned a_kstep() const { return (unsigned)PW * 2u; }
    DI unsigned a_col_off(int C) const { return (unsigned)C * 2u; }
    DI const char* a_base(const Unit& u) const { const int kv = u.pm / 24, r = u.pm % 24, bh = r >> 2, qt = r & 3, b = bh / 3, h = bh % 3;
        return proj + ((size_t)(b * SEQ + 4096 * qt) * PW + (kv ? C_VC : C_KC) + h * 64) * 2; }
    DI const char* b_base(const Unit& u) const { return w1t + (size_t)(u.pm / 24) * 256 * 2048 * 2; }
};
struct ASsm1 {
    const char* uc; const char* ss1;
    DI int scale_w() const { return 0x7f7f7f7f; } DI int scale_a() const { return 0x7f7f7f7f; }
    DI int K() const { return 256; }
    DI unsigned a_row_bytes() const { return 512u; }
    DI unsigned a_kstep() const { return 128u; }
    DI unsigned a_col_off(int C) const { return (unsigned)C * 2u; }
    DI const char* a_base(const Unit& u) const { const int bg = u.pm >> 2, qt = u.pm & 3; return uc + ((size_t)bg * SEQ + 4096 * qt) * 32; }
    DI const char* b_base(const Unit& u) const { const int gi = (u.pm >> 2) & 15; return ss1 + ((size_t)gi * 512 + (size_t)u.pn * 256) * 256 * 2; }
};
struct ASsm2 {
    const char* hin; const char* ss2;
    DI int scale_w() const { return 0x7f7f7f7f; } DI int scale_a() const { return 0x7f7f7f7f; }
    DI int K() const { return 256; }
    DI unsigned a_row_bytes() const { return 512u; }
    DI unsigned a_kstep() const { return 128u; }
    DI unsigned a_col_off(int C) const { return (unsigned)C * 2u; }
    DI const char* a_base(const Unit& u) const { return hin + (size_t)u.pm * 256 * 512; }
    DI const char* b_base(const Unit& u) const { const int gi = (u.pm >> 2) & 15; return ss2 + (size_t)gi * 256 * 256 * 2; }
};

struct EpiBf16 {
    static constexpr bool PERM = true; static constexpr bool ROWTAB = true; static constexpr int MID_T = -1;
    bf16_t* O; int ldc; const unsigned long long* rowtab;
    static DI float row_ratio(unsigned long long, unsigned long long) { return 1.f; }
    DI void operator()(const f32x4 (&acc)[2][2][4][2], const Unit& u, int wr, int wc, int fr, int fq, const LAS unsigned long long* tab) const {
        const int row0 = u.pm * BM + wr * 64 + fr, col0 = u.pn * BM + wc * 32 + 8 * fq;
        const int ubj = (u.pn == C_U / 256) ? 1 : ((u.pn == C_U / 256 + 1) ? 0 : -1);
#pragma unroll
        for (int ai = 0; ai < 2; ++ai)
#pragma unroll
            for (int m = 0; m < 4; ++m) { bf16_t* rowp = O + (size_t)(row0 + ai * HALF + m * 16) * ldc + col0;
                const float sc = rsqrtf((float)tab[(wr * 64 + fr + ai * HALF + m * 16) * 2] * (1.f / (1048576.f * DM)) + 1e-6f);
#pragma unroll
                for (int bj = 0; bj < 2; ++bj) { const f32x4 v0 = acc[ai][bj][m][0] * sc, v1 = acc[ai][bj][m][1] * sc;
                    u32x4 w; w.x = pk2(v0[0], v0[1]); w.y = pk2(v0[2], v0[3]); w.z = pk2(v1[0], v1[1]); w.w = pk2(v1[2], v1[3]);
                    *(u32x4*)(rowp + bj * HALF) = w;
                    if (bj == ubj) { const int row = row0 + ai * HALF + m * 16, ucol = col0 + bj * HALF - C_U;
                        bf16_t* uc = (bf16_t*)((unsigned char*)O + (WS_UC - WS_PROJ));
                        *(u32x4*)(uc + (((size_t)((row >> 14) * 16 + (ucol >> 4)) * SEQ + (row & (SEQ - 1))) * 16 + (ucol & 15))) = w; } } }
    }
};
struct EpiCmpHid {
    static constexpr bool PERM = true; static constexpr bool ROWTAB = false; static constexpr int MID_T = -1;
    bf16_t* O; const float* cb1;
    DI void operator()(const f32x4 (&acc)[2][2][4][2], const Unit& u, int wr, int wc, int fr, int fq) const {
        const int row0 = u.pm * BM + wr * 64 + fr, col0 = wc * 32 + 8 * fq; const float* bb = cb1 + (u.pm / 24) * 256;
        f32x4 bv[2][2];
#pragma unroll
        for (int bj = 0; bj < 2; ++bj)
#pragma unroll
            for (int n = 0; n < 2; ++n) bv[bj][n] = *(const f32x4*)(bb + col0 + bj * HALF + 4 * n);
#pragma unroll
        for (int ai = 0; ai < 2; ++ai)
#pragma unroll
            for (int m = 0; m < 4; ++m) { bf16_t* rowp = O + (size_t)(row0 + ai * HALF + m * 16) * 256 + col0;
#pragma unroll
                for (int bj = 0; bj < 2; ++bj) { f32x4 v0 = acc[ai][bj][m][0] + bv[bj][0], v1 = acc[ai][bj][m][1] + bv[bj][1];
#pragma unroll
                    for (int e = 0; e < 4; ++e) { v0[e] = gelu_tanh(v0[e]); v1[e] = gelu_tanh(v1[e]); }
                    u32x4 w; w.x = pk2(v0[0], v0[1]); w.y = pk2(v0[2], v0[3]); w.z = pk2(v1[0], v1[1]); w.w = pk2(v1[2], v1[3]);
                    *(u32x4*)(rowp + bj * HALF) = w; } }
    }
};
struct EpiSsm1 {
    static constexpr bool PERM = false; static constexpr bool ROWTAB = false; static constexpr int MID_T = -1;
    float* YI; float* HL;
    DI void operator()(const f32x4 (&acc)[2][2][4][2], const Unit& u, int wr, int wc, int fr, int fq) const {
        const int row0 = u.pm * BM + wr * 64 + fr, col0 = wc * 32 + 4 * fq;
#pragma unroll
        for (int ai = 0; ai < 2; ++ai)
#pragma unroll
            for (int m = 0; m < 4; ++m) { const size_t row = (size_t)(row0 + ai * HALF + m * 16);
                if (u.pn == 0) {
#pragma unroll
                    for (int bj = 0; bj < 2; ++bj)
#pragma unroll
                        for (int n = 0; n < 2; ++n) *(f32x4*)(YI + row * 256 + col0 + bj * HALF + n * 16) = acc[ai][bj][m][n];
                } else {
#pragma unroll
                    for (int n = 0; n < 2; ++n) *(f32x4*)(HL + row * 128 + col0 + n * 16) = acc[ai][0][m][n];
                } }
    }
};
struct EpiSsm2 {
    static constexpr bool PERM = false; static constexpr bool ROWTAB = false; static constexpr int MID_T = -1;
    const float* YI; const bf16_t* proj; const float* dskip; bf16_t* YS2;
    DI void operator()(const f32x4 (&acc)[2][2][4][2], const Unit& u, int wr, int wc, int fr, int fq) const {
        const int row0 = u.pm * BM + wr * 64 + fr, col0 = wc * 32 + 4 * fq;
        const int bg = u.pm >> 2, b = bg >> 4, gi = bg & 15;
        const f32x4 dsk = *(const f32x4*)(dskip + gi * 16 + 4 * fq);
#pragma unroll
        for (int ai = 0; ai < 2; ++ai)
#pragma unroll
            for (int m = 0; m < 4; ++m) { const int row = row0 + ai * HALF + m * 16; const int chunk = row & 1023;
#pragma unroll
                for (int bj = 0; bj < 2; ++bj)
#pragma unroll
                    for (int n = 0; n < 2; ++n) { const int col = col0 + bj * HALF + n * 16, tau = col >> 4;
                        const size_t tok = (size_t)b * SEQ + chunk * 16 + tau;
                        const f32x4 yi = *(const f32x4*)(YI + (size_t)row * 256 + col);
                        const u32x2 uw = *(const u32x2*)(proj + tok * PW + C_U + gi * 16 + 4 * fq);
                        f32x4 y = acc[ai][bj][m][n] + yi;
                        y[0] += dsk[0] * bflo(uw.x); y[1] += dsk[1] * bfhi(uw.x); y[2] += dsk[2] * bflo(uw.y); y[3] += dsk[3] * bfhi(uw.y);
                        u32x2 w; w.x = pk2(gelu_tanh(y[0]), gelu_tanh(y[1])); w.y = pk2(gelu_tanh(y[2]), gelu_tanh(y[3]));
                        *(u32x2*)(YS2 + tok * 256 + gi * 16 + 4 * fq) = w; } }
    }
};
struct EpiGlu {
    static constexpr bool PERM = true; static constexpr bool ROWTAB = false; static constexpr int MID_T = -1;
    bf16_t* O; const float* bglu; unsigned long long* sst;
    DI void operator()(const f32x4 (&acc)[2][2][4][2], const Unit& u, int wr, int wc, int fr, int fq) const {
        const int row0 = u.pm * BM + wr * 64 + fr, col0 = u.pn * HALF + wc * 32 + 8 * fq;
        f32x4 bvv[2], bgg[2];
#pragma unroll
        for (int n = 0; n < 2; ++n) { bvv[n] = *(const f32x4*)(bglu + col0 + 4 * n); bgg[n] = *(const f32x4*)(bglu + 256 + col0 + 4 * n); }
#pragma unroll
        for (int ai = 0; ai < 2; ++ai)
#pragma unroll
            for (int m = 0; m < 4; ++m) { const int row = row0 + ai * HALF + m * 16; bf16_t* rowp = O + (size_t)row * 1024 + 768 + col0;
                f32x4 o[2];
#pragma unroll
                for (int n = 0; n < 2; ++n) { const f32x4 v = acc[ai][0][m][n] + bvv[n], gt = acc[ai][1][m][n] + bgg[n];
#pragma unroll
                    for (int e = 0; e < 4; ++e) o[n][e] = v[e] * sigmoidf_(gt[e]); }
                u32x4 w; w.x = pk2(o[0][0], o[0][1]); w.y = pk2(o[0][2], o[0][3]); w.z = pk2(o[1][0], o[1][1]); w.w = pk2(o[1][2], o[1][3]);
                *(u32x4*)rowp = w;
                const f32x4 q = o[0] * o[0] + o[1] * o[1]; const float t = xor32_sum(xor16_sum((q[0] + q[1]) + (q[2] + q[3])));
                if (fq == 0) (void)__hip_atomic_fetch_add(sst + (size_t)row * 2 + 1, (unsigned long long)(t * 16777216.f), __ATOMIC_RELAXED, __HIP_MEMORY_SCOPE_AGENT); }
    }
};
struct EpiSwiglu8 {
    static constexpr bool PERM = true; static constexpr bool ROWTAB = false; static constexpr int MID_T = -1;
    unsigned char* O; float asc;
    DI void operator()(const f32x4 (&acc)[2][2][4][2], const Unit& u, int wr, int wc, int fr, int fq) const {
        const int row0 = u.pm * BM + wr * 64 + fr, col0 = u.pn * HALF + wc * 32 + 8 * fq;
#pragma unroll
        for (int ai = 0; ai < 2; ++ai)
#pragma unroll
            for (int m = 0; m < 4; ++m) { unsigned char* rowp = O + (size_t)(row0 + ai * HALF + m * 16) * DFF + col0;
                f32x4 o[2];
#pragma unroll
                for (int n = 0; n < 2; ++n) { const f32x4 gt = acc[ai][0][m][n] * asc, up = acc[ai][1][m][n] * asc;
#pragma unroll
                    for (int e = 0; e < 4; ++e) o[n][e] = 4.0f * gt[e] * sigmoidf_(gt[e]) * up[e]; }
                u32x2 w; w.x = pk4_fp8(o[0][0], o[0][1], o[0][2], o[0][3]); w.y = pk4_fp8(o[1][0], o[1][1], o[1][2], o[1][3]);
                *(u32x2*)rowp = w; }
    }
};
struct EpiSwiglu {
    static constexpr bool PERM = true; static constexpr bool ROWTAB = false; static constexpr int MID_T = -1;
    bf16_t* O;
    DI void operator()(const f32x4 (&acc)[2][2][4][2], const Unit& u, int wr, int wc, int fr, int fq) const {
        const int row0 = u.pm * BM + wr * 64 + fr, col0 = u.pn * HALF + wc * 32 + 8 * fq;
#pragma unroll
        for (int ai = 0; ai < 2; ++ai)
#pragma unroll
            for (int m = 0; m < 4; ++m) { bf16_t* rowp = O + (size_t)(row0 + ai * HALF + m * 16) * DFF + col0;
                f32x4 o[2];
#pragma unroll
                for (int n = 0; n < 2; ++n) { const f32x4 gt = acc[ai][0][m][n], up = acc[ai][1][m][n];
#pragma unroll
                    for (int e = 0; e < 4; ++e) o[n][e] = gt[e] * sigmoidf_(gt[e]) * up[e]; }
                u32x4 w; w.x = pk2(o[0][0], o[0][1]); w.y = pk2(o[0][2], o[0][3]); w.z = pk2(o[1][0], o[1][1]); w.w = pk2(o[1][2], o[1][3]);
                *(u32x4*)rowp = w; }
    }
};
struct EpiResF32 {
    static constexpr bool PERM = false; static constexpr bool ROWTAB = false; static constexpr int MID_T = -1;
    const float* base; float* out; float asc = 1.0f;
    DI void operator()(const f32x4 (&acc)[2][2][4][2], const Unit& u, int wr, int wc, int fr, int fq) const {
        const int row0 = u.pm * BM + wr * 64 + fr, col0 = u.pn * BM + wc * 32 + 4 * fq;
#pragma unroll
        for (int ai = 0; ai < 2; ++ai)
#pragma unroll
            for (int m = 0; m < 4; ++m) { const size_t off = (size_t)(row0 + ai * HALF + m * 16) * DM + col0;
#pragma unroll
                for (int bj = 0; bj < 2; ++bj)
#pragma unroll
                    for (int n = 0; n < 2; ++n) { const f32x4 bs = *(const f32x4*)(base + off + bj * HALF + n * 16);
                        *(f32x4*)(out + off + bj * HALF + n * 16) = bs + acc[ai][bj][m][n] * asc; } }
    }
};
template <bool MID, int ASC_EXP>
struct EpiResB {
    static constexpr bool PERM = true; static constexpr bool ROWTAB = MID; static constexpr int MID_T = MID ? 12 : -1;
    static constexpr float asc = 1.0f / (float)(1 << ASC_EXP);
    const float* basef; const bf16_t* baseb; bf16_t* out; const unsigned long long* rowtab; unsigned long long* ssx;
    static DI float rstd_a(unsigned long long v) { return rsqrtf((float)v * (1.f / (16777216.f * 768.f)) + 1e-6f); }
    static DI float rstd_s(unsigned long long v) { return rsqrtf((float)v * (1.f / (16777216.f * 256.f)) + 1e-6f); }
    static DI float row_ratio(unsigned long long a, unsigned long long s_) { return rstd_a(a) / rstd_s(s_); }
    template <bool F32B>
    DI void run(const f32x4 (&acc)[2][2][4][2], const Unit& u, int wr, int wc, int fr, int fq, const LAS unsigned long long* tab) const {
        const int row0 = u.pm * BM + wr * 64 + fr, col0 = u.pn * BM + wc * 32 + 8 * fq;
#pragma unroll
        for (int ai = 0; ai < 2; ++ai)
#pragma unroll
            for (int m = 0; m < 4; ++m) { const int row = row0 + ai * HALF + m * 16; const size_t off = (size_t)row * DM + col0; float sq = 0.f;
                float sc = asc; if constexpr (MID) sc = asc * rstd_s(tab[(wr * 64 + fr + ai * HALF + m * 16) * 2 + 1]);
#pragma unroll
                for (int bj = 0; bj < 2; ++bj) { f32x4 b0, b1;
                    if constexpr (F32B) { b0 = *(const f32x4*)(basef + off + bj * HALF); b1 = *(const f32x4*)(basef + off + bj * HALF + 4); }
                    else { const u32x4 b = *(const u32x4*)(baseb + off + bj * HALF); b0 = f32x4{bflo(b.x), bfhi(b.x), bflo(b.y), bfhi(b.y)}; b1 = f32x4{bflo(b.z), bfhi(b.z), bflo(b.w), bfhi(b.w)}; }
                    const f32x4 v0 = b0 + acc[ai][bj][m][0] * sc, v1 = b1 + acc[ai][bj][m][1] * sc;
                    u32x4 w; w.x = pk2(v0[0], v0[1]); w.y = pk2(v0[2], v0[3]); w.z = pk2(v1[0], v1[1]); w.w = pk2(v1[2], v1[3]);
                    *(u32x4*)(out + off + bj * HALF) = w;
                    if constexpr (!MID) { const f32x4 q = v0 * v0 + v1 * v1; sq += (q[0] + q[1]) + (q[2] + q[3]); } }
                if constexpr (!MID) { if (ssx != nullptr) { const float t = xor32_sum(xor16_sum(sq));
                    if (fq == 0) (void)__hip_atomic_fetch_add(ssx + (size_t)row * 2, (unsigned long long)(t * 1048576.f), __ATOMIC_RELAXED, __HIP_MEMORY_SCOPE_AGENT); } } }
    }
    DI void operator()(const f32x4 (&acc)[2][2][4][2], const Unit& u, int wr, int wc, int fr, int fq, const LAS unsigned long long* tab = nullptr) const {
        if (basef != nullptr) run<true>(acc, u, wr, wc, fr, fq, tab); else run<false>(acc, u, wr, wc, fr, fq, tab);
    }
};
}

struct Frame {
    LAS unsigned char* lds;
    LAS const unsigned long long* pt;
    int tid, lane, wave, G, gw, ngw, bid;
    DI const float* in(int i) const { const unsigned long long v = pt[i]; const unsigned lo = __builtin_amdgcn_readfirstlane((unsigned)v), hi = __builtin_amdgcn_readfirstlane((unsigned)(v >> 32));
        return (const float*)(const __attribute__((address_space(1))) float*)(((unsigned long long)hi << 32) | lo); }
    DI float* out() const { return (float*)in(26); }
    DI unsigned char* wsp() const { return (unsigned char*)in(27); }
};
constexpr int LDS_PT = LDS_BYTES - 256;

DI void transpose_item(const float* W, int K, int ldw, int nvalid, bf16_t* WT, int drow0, LAS float* scr, int k0, int n0, float scale, int lane, const float* gam64 = nullptr) {
    if (n0 + 32 <= nvalid) {
        const int n4 = (lane & 7) * 4; f32x4 v[8];
#pragma unroll
        for (int i = 0; i < 8; ++i) v[i] = *(const f32x4*)(W + (size_t)(k0 + 8 * i + (lane >> 3)) * ldw + n0 + n4);
        if (gam64 != nullptr) {
#pragma unroll
            for (int i = 0; i < 8; ++i) v[i] = v[i] * gam64[8 * i + (lane >> 3)];
        }
#pragma unroll
        for (int i = 0; i < 8; ++i) { LAS float* s = scr + (8 * i + (lane >> 3)) * 33 + n4; s[0] = v[i].x * scale; s[1] = v[i].y * scale; s[2] = v[i].z * scale; s[3] = v[i].w * scale; }
    } else {
    const int nn = n0 + (lane & 31); const bool ok = nn < nvalid;
#pragma unroll 8
    for (int i = 0; i < 32; ++i) { const int kk = 2 * i + (lane >> 5); scr[kk * 33 + (lane & 31)] = ok ? W[(size_t)(k0 + kk) * ldw + nn] * scale : 0.f; }
    }
    asm volatile("s_waitcnt lgkmcnt(0)" ::: "memory");
    const int c = lane & 7;
#pragma unroll
    for (int j = 0; j < 4; ++j) { const int n = (lane >> 3) + 8 * j; const LAS float* s = scr + (8 * c) * 33 + n;
        u32x4 o; o.x = pk2(s[0 * 33], s[1 * 33]); o.y = pk2(s[2 * 33], s[3 * 33]); o.z = pk2(s[4 * 33], s[5 * 33]); o.w = pk2(s[6 * 33], s[7 * 33]);
        *(u32x4*)(WT + (size_t)(drow0 + n) * K + k0 + 8 * c) = o; }
    asm volatile("s_waitcnt lgkmcnt(0)" ::: "memory");
}

DI void transpose_item_fp8(const float* W, int K, int ldw, unsigned char* WT, int drow0, LAS float* scr, int k0, int n0, float scale, int lane) {
    const int n4 = (lane & 7) * 4; f32x4 v[8];
#pragma unroll
    for (int i = 0; i < 8; ++i) v[i] = *(const f32x4*)(W + (size_t)(k0 + 8 * i + (lane >> 3)) * ldw + n0 + n4);
#pragma unroll
    for (int i = 0; i < 8; ++i) { LAS float* s = scr + (8 * i + (lane >> 3)) * 33 + n4; s[0] = v[i].x * scale; s[1] = v[i].y * scale; s[2] = v[i].z * scale; s[3] = v[i].w * scale; }
    asm volatile("s_waitcnt lgkmcnt(0)" ::: "memory");
    const int c = lane & 7;
#pragma unroll
    for (int j = 0; j < 4; ++j) { const int n = (lane >> 3) + 8 * j; const LAS float* s = scr + (8 * c) * 33 + n;
        u32x2 o; o.x = pk4_fp8(s[0 * 33], s[1 * 33], s[2 * 33], s[3 * 33]); o.y = pk4_fp8(s[4 * 33], s[5 * 33], s[6 * 33], s[7 * 33]);
        *(u32x2*)(WT + (size_t)(drow0 + n) * K + k0 + 8 * c) = o; }
    asm volatile("s_waitcnt lgkmcnt(0)" ::: "memory");
}

DI int win_dest_row(int n) {
    if (n < 1920) return n;
    if (n < 1956) return C_G + (n - 1920);
    return C_U + (n - 1956);
}

DI void prologue_a(Frame& F, int mode, int gw0, int ngw0) {
    LAS float* scr = (LAS float*)(F.lds + F.wave * 16640);
    constexpr int I_WIN = 16 * 72, I_WOUT = 16 * 32, I_WG = 16 * 88, I_WD = 44 * 32, I_W1 = 2 * 32 * 8, I_WGLU = 4 * 16, I_W2 = 2 * 4 * 2, I_CB = 64, I_M = 1024, I_TAB = 16;
    constexpr int PER_L = I_WIN + I_WOUT + 2 * I_WG + I_WD + I_W1 + I_WGLU + I_W2 + I_CB + I_M + I_TAB;
    const int lane = F.lane;
    constexpr int A1 = I_WIN, A3E = I_WIN + I_WOUT + 2 * I_WG + I_WD, A4E = A3E + I_W1, A5E = A4E + I_WGLU;
    for (int it = gw0; it < NL * PER_L; it += ngw0) {
        const int l = it / PER_L; int r = it % PER_L;
        { const bool late = (r >= A1 && r < A3E) || (r >= A4E && r < A5E) || (l > 0 && (r < A1 || (r >= A3E && r < A4E)));
          if (late != (mode == 1)) continue; }
        unsigned char* wl = F.wsp() + WS_W + (size_t)l * WL_STRIDE;
        unsigned char* ms = F.wsp() + WS_MISC + (size_t)l * MS_L;
        unsigned char* ct = F.wsp() + WS_CTL + CT_BASE + (size_t)l * CT_L;
        if (r < I_WIN) {
            const int kb = r / 72, nb = r % 72, k0 = 64 * kb, n0 = 32 * nb;
            const float* W = F.in(2) + (size_t)l * 1024 * 2212;
            bf16_t* WT = (bf16_t*)(wl + WO_WIN);
            const float* gam = F.in(1) + (size_t)l * DM + k0;
            if (n0 + 32 <= 1920) { transpose_item(W, 1024, 2212, 2212, WT, n0, scr, k0, n0, n0 < 768 ? 0.125f * L2E : 1.0f, lane, gam); }
            else {
                const int d = n0 + (lane & 31);
                int srcn = -1;
                if (d < 1920) srcn = d; else if (d >= C_U && d < C_U + 256) srcn = 1956 + (d - C_U); else if (d >= C_G && d < C_G + 36) srcn = 1920 + (d - C_G);
#pragma unroll 8
                for (int i = 0; i < 32; ++i) { const int kk = 2 * i + (lane >> 5); scr[kk * 33 + (lane & 31)] = srcn >= 0 ? W[(size_t)(k0 + kk) * 2212 + srcn] * gam[kk] : 0.f; }
                asm volatile("s_waitcnt lgkmcnt(0)" ::: "memory");
                const int c = lane & 7;
#pragma unroll
                for (int j = 0; j < 4; ++j) { const int n = (lane >> 3) + 8 * j; const LAS float* s = scr + (8 * c) * 33 + n;
                    u32x4 o; o.x = pk2(s[0 * 33], s[1 * 33]); o.y = pk2(s[2 * 33], s[3 * 33]); o.z = pk2(s[4 * 33], s[5 * 33]); o.w = pk2(s[6 * 33], s[7 * 33]);
                    *(u32x4*)(WT + (size_t)(n0 + n) * 1024 + k0 + 8 * c) = o; }
                asm volatile("s_waitcnt lgkmcnt(0)" ::: "memory");
            }
            continue; }
        r -= I_WIN;
        if (r < I_WOUT) { const int kb = r / 32, nb = r % 32;
            transpose_item(F.in(20) + (size_t)l * 1024 * 1024, 1024, 1024, 1024, (bf16_t*)(wl + WO_WOUT), 32 * nb, scr, 64 * kb, 32 * nb, 1.f, lane, kb < 12 ? F.in(18) + (size_t)l * 768 + 64 * kb : F.in(19) + (size_t)l * 256 + 64 * (kb - 12)); continue; }
        r -= I_WOUT;
        if (r < 2 * I_WG) { const int up = r / I_WG; const int rr = r % I_WG; const int kb = rr / 88, nb = rr % 88, n0 = 32 * nb;
            const int drow = (n0 / 128) * 256 + up * 128 + (n0 % 128);
            transpose_item_fp8(F.in(up ? 23 : 22) + (size_t)l * 1024 * DFF, 1024, DFF, (unsigned char*)(wl + WO_WGU), drow, scr, 64 * kb, n0, 64.f, lane); continue; }
        r -= 2 * I_WG;
        if (r < I_WD) { const int kb = r / 32, nb = r % 32; transpose_item_fp8(F.in(24) + (size_t)l * DFF * 1024, DFF, 1024, (unsigned char*)(wl + WO_WD), 32 * nb, scr, 64 * kb, 32 * nb, 64.f, lane); continue; }
        r -= I_WD;
        if (r < I_W1) { const int kv = r / 256; const int rr = r % 256; const int kb = rr / 8, nb = rr % 8;
            transpose_item(F.in(4) + ((size_t)l * 2 + kv) * 2048 * 256, 2048, 256, 256, (bf16_t*)(wl + WO_W1) + (size_t)kv * 256 * 2048, 32 * nb, scr, 64 * kb, 32 * nb, 1.f, lane); continue; }
        r -= I_W1;
        if (r < I_WGLU) { const int kb = r / 16, nb = r % 16, n0 = 32 * nb; const int gate = n0 >= 256, nn = n0 & 255;
            const int drow = (nn / 128) * 256 + gate * 128 + (nn % 128);
            transpose_item(F.in(16) + (size_t)l * 256 * 512, 256, 512, 512, (bf16_t*)(ms + MS_WGLU), drow, scr, 64 * kb, n0, 1.f, lane); continue; }
        r -= I_WGLU;
        if (r < I_W2) { const int kv = r / 8; const int rr = r % 8; const int kb = rr / 2, nb = rr % 2;
            transpose_item(F.in(6) + ((size_t)l * 2 + kv) * 256 * 64, 256, 64, 64, (bf16_t*)(ct + CT_W2T) + (size_t)kv * 64 * 256, 32 * nb, scr, 64 * kb, 32 * nb, 1.f, lane); continue; }
        r -= I_W2;
        if (r < I_CB) {
            const int kv = r / 32, ch = r % 32; const float* pe = F.in(3) + ((size_t)l * 2 + kv) * 2048; const float* w1 = F.in(4) + ((size_t)l * 2 + kv) * 2048 * 256;
            f32x4 s = {0.f, 0.f, 0.f, 0.f};
#pragma unroll 8
            for (int i = 0; i < 64; ++i) { const int k = 64 * ch + i; const float pv = pe[k]; const f32x4 w = *(const f32x4*)(w1 + (size_t)k * 256 + 4 * lane); s += w * pv; }
            *(f32x4*)((float*)(ms + MS_CBP) + ((size_t)kv * 32 + ch) * 256 + 4 * lane) = s; continue; }
        r -= I_CB;
        if (r < I_M) {
            const int e0 = r * 64; const int gi = e0 >> 12, dl = (e0 >> 8) & 15, cp0 = (e0 >> 4) & 15, n = lane;
            const float dt = __expf(F.in(8)[l * 16 + gi]);
            const float ar = F.in(9)[((size_t)l * 16 + gi) * 64 + n], ai = F.in(10)[((size_t)l * 16 + gi) * 64 + n];
            const float x = dt * ar, y = dt * ai; const float sy = __sinf(y), cy = __cosf(y), sh = __sinf(0.5f * y);
            const float em1 = (fabsf(x) < 0.25f) ? x * (1.f + x * (0.5f + x * (0.16666667f + x * (0.041666668f + x * 0.0083333338f)))) : expm1f(x);
            const float nr = em1 * cy - 2.f * sh * sh; const float abi = (em1 + 1.f) * sy;
            const float den = ar * ar + ai * ai;
            const float fr_ = (nr * ar + abi * ai) / den, fi_ = (abi * ar - nr * ai) / den;
            const float mg = __expf((float)dl * x); const float pr = mg * __cosf((float)dl * y), pi = mg * __sinf((float)dl * y);
            const f32x4* bre = (const f32x4*)(F.in(11) + (((size_t)l * 16 + gi) * 64 + n) * 16); const f32x4* bim = (const f32x4*)(F.in(12) + (((size_t)l * 16 + gi) * 64 + n) * 16);
            float zr[16], zi[16];
#pragma unroll
            for (int q4 = 0; q4 < 4; ++q4) { const f32x4 br = bre[q4], bi = bim[q4];
#pragma unroll
                for (int j = 0; j < 4; ++j) { const float bbr = fr_ * br[j] - fi_ * bi[j], bbi = fr_ * bi[j] + fi_ * br[j]; zr[4 * q4 + j] = pr * bbr - pi * bbi; zi[4 * q4 + j] = pr * bbi + pi * bbr; } }
#pragma unroll
            for (int cc = 0; cc < 4; ++cc) { const int cp = cp0 + cc;
                const float cr = F.in(13)[(((size_t)l * 16 + gi) * 16 + cp) * 64 + n], ci = F.in(14)[(((size_t)l * 16 + gi) * 16 + cp) * 64 + n];
#pragma unroll
                for (int c = 0; c < 16; ++c) scr[n * 65 + cc * 16 + c] = cr * zr[c] - ci * zi[c]; }
            asm volatile("s_waitcnt lgkmcnt(0)" ::: "memory");
            float mine = 0.f;
#pragma unroll 8
            for (int nn = 0; nn < 64; ++nn) mine += scr[nn * 65 + lane];
            ((float*)(ms + MS_MTAB))[e0 + lane] = mine;
            asm volatile("s_waitcnt lgkmcnt(0)" ::: "memory"); continue; }
        r -= I_M;
        {
            const int e = r * 64 + lane; const int gi = e >> 6, n = e & 63;
            const float dt = __expf(F.in(8)[l * 16 + gi]);
            const float ar = F.in(9)[((size_t)l * 16 + gi) * 64 + n], ai = F.in(10)[((size_t)l * 16 + gi) * 64 + n];
            const float x = dt * ar, y = dt * ai; float sy, cy; sy = __sinf(y); cy = __cosf(y); const float sh = __sinf(0.5f * y);
            const float em1 = (fabsf(x) < 0.25f) ? x * (1.f + x * (0.5f + x * (0.16666667f + x * (0.041666668f + x * 0.0083333338f)))) : expm1f(x); const float nr = em1 * cy - 2.f * sh * sh; const float abi = (em1 + 1.f) * sy;
            const float den = ar * ar + ai * ai;
            const float fr_ = (nr * ar + abi * ai) / den, fi_ = (abi * ar - nr * ai) / den;
            float s16, c16; s16 = __sinf(16.f * y); c16 = __cosf(16.f * y); const float m16 = __expf(16.f * x);
            ((f32x2*)(ct + CT_AB16))[e] = (f32x2){m16 * c16, m16 * s16};
            float s1k, c1k; s1k = __sinf(512.f * y); c1k = __cosf(512.f * y); const float m1k = __expf(512.f * x);
            ((f32x2*)(ct + CT_AB1K))[e] = (f32x2){m1k * c1k, m1k * s1k};
            const float* bre = F.in(11) + (((size_t)l * 16 + gi) * 64 + n) * 16; const float* bim = F.in(12) + (((size_t)l * 16 + gi) * 64 + n) * 16;
            f32x2* bb = (f32x2*)(ms + MS_BBAR) + (size_t)e * 16;
#pragma unroll
            for (int c = 0; c < 16; ++c) { const float br = bre[c], bi = bim[c]; bb[c] = (f32x2){fr_ * br - fi_ * bi, fr_ * bi + fi_ * br}; }
        }
    }
}

DI void prologue_b(Frame& F) {
    const int gt = F.gw * 64 + F.lane, ngt = F.ngw * 64;
    for (int l = 0; l < NL; ++l) {
        unsigned char* wl = F.wsp() + WS_W + (size_t)l * WL_STRIDE;
        unsigned char* ms = F.wsp() + WS_MISC + (size_t)l * MS_L;
        unsigned char* ct = F.wsp() + WS_CTL + CT_BASE + (size_t)l * CT_L;
        const float* MT = (const float*)(ms + MS_MTAB);
        const f32x2* BB = (const f32x2*)(ms + MS_BBAR);
        const float dtl_base = 0.f; (void)dtl_base;
        for (int e = gt; e < 16 * 512 * 256; e += ngt) {
            const int gi = e >> 17, n = (e >> 8) & 511, k = e & 255; float v = 0.f;
            if (n < 256) { const int tp = n >> 4, cp = n & 15, ta = k >> 4, c = k & 15; if (tp >= ta) v = MT[((gi * 16 + (tp - ta)) * 16 + cp) * 16 + c]; }
            else if (n < 384) { const int s = (n - 256) & 63, part = (n - 256) >> 6, ta = k >> 4, c = k & 15;
                const float dt = __expf(F.in(8)[l * 16 + gi]);
                const float ar = F.in(9)[((size_t)l * 16 + gi) * 64 + s], ai = F.in(10)[((size_t)l * 16 + gi) * 64 + s];
                const float pw = (float)(15 - ta); float sp, cpw; sp = __sinf(pw * dt * ai); cpw = __cosf(pw * dt * ai); const float mg = __expf(pw * dt * ar);
                const float pr = mg * cpw, pi = mg * sp; const f32x2 b = BB[((size_t)gi * 64 + s) * 16 + c];
                v = part ? (pr * b.y + pi * b.x) : (pr * b.x - pi * b.y); }
            ((bf16_t*)(wl + WO_SS1))[e] = f2bf(v);
        }
        for (int e = gt; e < 16 * 256 * 256; e += ngt) {
            const int gi = e >> 16, n = (e >> 8) & 255, k = e & 255; float v = 0.f;
            if (k < 128) { const int s = k & 63, part = k >> 6, ta = n >> 4, c = n & 15;
                const float dt = __expf(F.in(8)[l * 16 + gi]);
                const float ar = F.in(9)[((size_t)l * 16 + gi) * 64 + s], ai = F.in(10)[((size_t)l * 16 + gi) * 64 + s];
                const float pw = (float)(ta + 1); float sp, cpw; sp = __sinf(pw * dt * ai); cpw = __cosf(pw * dt * ai); const float mg = __expf(pw * dt * ar);
                const float pr = mg * cpw, pi = mg * sp;
                const float cr = F.in(13)[(((size_t)l * 16 + gi) * 16 + c) * 64 + s], ci = F.in(14)[(((size_t)l * 16 + gi) * 16 + c) * 64 + s];
                v = part ? -(cr * pi + ci * pr) : (cr * pr - ci * pi); }
            ((bf16_t*)(wl + WO_SS2))[e] = f2bf(v);
        }
        for (int e = gt; e < 512; e += ngt) { const int kv = e >> 8, n = e & 255; float s = F.in(5)[((size_t)l * 2 + kv) * 256 + n];
            const float* pp = (const float*)(ms + MS_CBP) + (size_t)kv * 32 * 256 + n;
            for (int ch = 0; ch < 32; ++ch) s += pp[ch * 256];
            ((float*)(ct + CT_CB1))[e] = s; }
    }
}

DI void convert_rows_stats(Frame& F, const float* x, bf16_t* o, unsigned long long* ssx) {
    for (int m = F.gw; m < NT; m += F.ngw) {
        const f32x4* xr = (const f32x4*)(x + (size_t)m * DM) + F.lane; f32x4 v[4]; float s = 0.f;
#pragma unroll
        for (int j = 0; j < 4; ++j) { v[j] = xr[64 * j]; s += (v[j].x * v[j].x + v[j].y * v[j].y) + (v[j].z * v[j].z + v[j].w * v[j].w); }
        u32x2* o8 = (u32x2*)(o + (size_t)m * DM) + F.lane;
#pragma unroll
        for (int j = 0; j < 4; ++j) { u32x2 w; w.x = pk2(v[j].x, v[j].y); w.y = pk2(v[j].z, v[j].w); o8[64 * j] = w; }
        s = wave_sum(s);
        if (F.lane == 0) ssx[(size_t)m * 2] = (unsigned long long)(s * 1048576.f);
    }
}
DI void rmsnorm_rows_bf16(Frame& F, const float* x, const float* g, bf16_t* o) {
    const f32x4* gp = (const f32x4*)g + F.lane; f32x4 gv[4];
#pragma unroll
    for (int j = 0; j < 4; ++j) gv[j] = gp[64 * j];
    for (int m = F.gw; m < NT; m += F.ngw) {
        const f32x4* xr = (const f32x4*)(x + (size_t)m * DM) + F.lane; f32x4 v[4]; float s = 0.f;
#pragma unroll
        for (int j = 0; j < 4; ++j) { v[j] = xr[64 * j]; s += (v[j].x * v[j].x + v[j].y * v[j].y) + (v[j].z * v[j].z + v[j].w * v[j].w); }
        const float rstd = rsqrtf(wave_sum(s) * (1.f / DM) + 1e-6f);
        u32x2* o8 = (u32x2*)(o + (size_t)m * DM) + F.lane;
#pragma unroll
        for (int j = 0; j < 4; ++j) { u32x2 w; w.x = pk2(v[j].x * rstd * gv[j].x, v[j].y * rstd * gv[j].y); w.y = pk2(v[j].z * rstd * gv[j].z, v[j].w * rstd * gv[j].w); o8[64 * j] = w; }
    }
}
DI void rmsnorm_rows_fp8(Frame& F, const float* x, const float* g, unsigned char* o) {
    const f32x4* gp = (const f32x4*)g + F.lane; f32x4 gv[4];
#pragma unroll
    for (int j = 0; j < 4; ++j) gv[j] = gp[64 * j];
    for (int m = F.gw; m < NT; m += F.ngw) {
        const f32x4* xr = (const f32x4*)(x + (size_t)m * DM) + F.lane; f32x4 v[4]; float s = 0.f;
#pragma unroll
        for (int j = 0; j < 4; ++j) { v[j] = xr[64 * j]; s += (v[j].x * v[j].x + v[j].y * v[j].y) + (v[j].z * v[j].z + v[j].w * v[j].w); }
        const float rstd = rsqrtf(wave_sum(s) * (1.f / DM) + 1e-6f);
        unsigned* o4 = (unsigned*)(o + (size_t)m * DM) + F.lane;
#pragma unroll
        for (int j = 0; j < 4; ++j) o4[64 * j] = pk4_fp8(v[j].x * rstd * gv[j].x, v[j].y * rstd * gv[j].y, v[j].z * rstd * gv[j].z, v[j].w * rstd * gv[j].w);
    }
}
DI void rmsnorm_rows_f32_inplace(Frame& F, float* x, const float* g) {
    const f32x4* gp = (const f32x4*)g + F.lane; f32x4 gv[4];
#pragma unroll
    for (int j = 0; j < 4; ++j) gv[j] = gp[64 * j];
    for (int m = F.gw; m < NT; m += F.ngw) {
        f32x4* xr = (f32x4*)(x + (size_t)m * DM) + F.lane; f32x4 v[4]; float s = 0.f;
#pragma unroll
        for (int j = 0; j < 4; ++j) { v[j] = xr[64 * j]; s += (v[j].x * v[j].x + v[j].y * v[j].y) + (v[j].z * v[j].z + v[j].w * v[j].w); }
        const float rstd = rsqrtf(wave_sum(s) * (1.f / DM) + 1e-6f);
#pragma unroll
        for (int j = 0; j < 4; ++j) xr[64 * j] = v[j] * rstd * gv[j];
    }
}
template <int OUT>
DI void rmsnorm_rows_xb(Frame& F, const bf16_t* x, const float* g, void* o) {
    const f32x4* gp = (const f32x4*)g + 2 * F.lane; f32x4 gv[2][2];
#pragma unroll
    for (int j = 0; j < 2; ++j) { gv[j][0] = gp[128 * j]; gv[j][1] = gp[128 * j + 1]; }
    for (int m = 2 * F.gw; m < NT; m += 2 * F.ngw) {
        u32x4 w[2][2];
#pragma unroll
        for (int r = 0; r < 2; ++r)
#pragma unroll
            for (int j = 0; j < 2; ++j) w[r][j] = ((const u32x4*)(x + (size_t)(m + r) * DM) + F.lane)[64 * j];
#pragma unroll
        for (int r = 0; r < 2; ++r) {
            f32x4 v[2][2]; float s = 0.f;
#pragma unroll
            for (int j = 0; j < 2; ++j) { const u32x4 q = w[r][j];
                v[j][0] = f32x4{bflo(q.x), bfhi(q.x), bflo(q.y), bfhi(q.y)}; v[j][1] = f32x4{bflo(q.z), bfhi(q.z), bflo(q.w), bfhi(q.w)};
                const f32x4 a = v[j][0] * v[j][0] + v[j][1] * v[j][1]; s += (a.x + a.y) + (a.z + a.w); }
            const float rstd = rsqrtf(wave_sum(s) * (1.f / DM) + 1e-6f);
#pragma unroll
            for (int j = 0; j < 2; ++j) { const f32x4 y0 = v[j][0] * rstd * gv[j][0], y1 = v[j][1] * rstd * gv[j][1];
                if constexpr (OUT == 0) { u32x4 t; t.x = pk2(y0.x, y0.y); t.y = pk2(y0.z, y0.w); t.z = pk2(y1.x, y1.y); t.w = pk2(y1.z, y1.w);
                    ((u32x4*)((bf16_t*)o + (size_t)(m + r) * DM) + F.lane)[64 * j] = t; }
                else if constexpr (OUT == 1) { u32x2 t; t.x = pk4_fp8(y0.x, y0.y, y0.z, y0.w); t.y = pk4_fp8(y1.x, y1.y, y1.z, y1.w);
                    ((u32x2*)((unsigned char*)o + (size_t)(m + r) * DM) + F.lane)[64 * j] = t; }
                else { f32x4* op = (f32x4*)((float*)o + (size_t)(m + r) * DM) + 2 * F.lane + 128 * j; op[0] = y0; op[1] = y1; } }
        }
    }
}
DI void mix_norm_rows(Frame& F, const bf16_t* oatt, const bf16_t* ossm, const float* gatt, const float* gssm, bf16_t* mixed) {
    for (int m = F.gw; m < NT; m += F.ngw) {
        const u32x2* ar = (const u32x2*)(oatt + (size_t)m * 768) + F.lane;
        float a[12]; float s = 0.f;
#pragma unroll
        for (int j = 0; j < 3; ++j) { const u32x2 w = ar[64 * j]; a[4 * j] = bflo(w.x); a[4 * j + 1] = bfhi(w.x); a[4 * j + 2] = bflo(w.y); a[4 * j + 3] = bfhi(w.y); }
#pragma unroll
        for (int j = 0; j < 12; ++j) s += a[j] * a[j];
        const float ra = rsqrtf(wave_sum(s) * (1.f / 768.f) + 1e-6f);
        const u32x2 sw = ((const u32x2*)(ossm + (size_t)m * 256))[F.lane];
        float b[4] = {bflo(sw.x), bfhi(sw.x), bflo(sw.y), bfhi(sw.y)};
        const float rs = rsqrtf(wave_sum(b[0] * b[0] + b[1] * b[1] + b[2] * b[2] + b[3] * b[3]) * (1.f / 256.f) + 1e-6f);
        u32x2* o8 = (u32x2*)(mixed + (size_t)m * DM);
#pragma unroll
        for (int j = 0; j < 3; ++j) { const f32x4 gv = ((const f32x4*)gatt)[64 * j + F.lane];
            u32x2 w; w.x = pk2(a[4 * j] * ra * gv.x, a[4 * j + 1] * ra * gv.y); w.y = pk2(a[4 * j + 2] * ra * gv.z, a[4 * j + 3] * ra * gv.w); o8[64 * j + F.lane] = w; }
        { const f32x4 gv = ((const f32x4*)gssm)[F.lane]; u32x2 w; w.x = pk2(b[0] * rs * gv.x, b[1] * rs * gv.y); w.y = pk2(b[2] * rs * gv.z, b[3] * rs * gv.w); o8[192 + F.lane] = w; }
    }
}

#define KPERM(rt, r) (32 * ((rt) >> 1) + 8 * ((r) >> 2) + 4 * ((rt) & 1) + ((r) & 3))
DI void vtranspose_phase(Frame& F, const bf16_t* proj, bf16_t* vts, bf16_t* vtw, bf16_t* kfs, unsigned* vmax_word, int cu0) {
    LAS bf16_t* scr = (LAS bf16_t*)(F.lds + F.wave * 8704);
    unsigned vm = 0u;
    const bool split = F.G > 96;
    if (split && F.bid < cu0) return;
    const int gw0 = split ? F.gw - cu0 * 8 : F.gw, ngw0 = split ? F.ngw - cu0 * 8 : F.ngw;
    const int c16 = F.lane & 15, kq = F.lane >> 4;
    for (int it = gw0; it < 3 * 6 * 256; it += ngw0) {
        const int which = it / 1536, r = it % 1536, bh = r >> 8, tt = r & 255, b = bh / 3, h = bh % 3;
        const bf16_t* src = proj + ((size_t)(b * SEQ + 64 * tt)) * PW + (which == 0 ? C_VS : (which == 1 ? C_VW : C_KS)) + h * 64;
        bf16_t* dst = (which == 0 ? vts : (which == 1 ? vtw : kfs)) + (size_t)bh * 64 * SEQ + (size_t)tt * 4096;
#pragma unroll
        for (int i = 0; i < 8; ++i) { const int tk = i * 8 + (F.lane >> 3), d8 = F.lane & 7; const u32x4 w = *(const u32x4*)(src + (size_t)tk * PW + 8 * d8);
            if (which == 0) { vm = max(vm, max(max(w.x & 0x7fff0000u, (w.x << 16) & 0x7fff0000u), max(w.y & 0x7fff0000u, (w.y << 16) & 0x7fff0000u)));
                              vm = max(vm, max(max(w.z & 0x7fff0000u, (w.z << 16) & 0x7fff0000u), max(w.w & 0x7fff0000u, (w.w << 16) & 0x7fff0000u))); }
            LAS bf16_t* sp = scr + tk * 66 + 8 * d8; ((LAS unsigned*)sp)[0] = w.x; ((LAS unsigned*)sp)[1] = w.y; ((LAS unsigned*)sp)[2] = w.z; ((LAS unsigned*)sp)[3] = w.w; }
        asm volatile("s_waitcnt lgkmcnt(0)" ::: "memory");
        if (which == 1) {
#pragma unroll
            for (int i = 0; i < 8; ++i) { const int d = i * 8 + (F.lane >> 3), t8 = F.lane & 7; unsigned short e[8];
#pragma unroll
                for (int j = 0; j < 8; ++j) e[j] = scr[(8 * t8 + j) * 66 + d];
                u32x4 w; w.x = e[0] | ((unsigned)e[1] << 16); w.y = e[2] | ((unsigned)e[3] << 16); w.z = e[4] | ((unsigned)e[5] << 16); w.w = e[6] | ((unsigned)e[7] << 16);
                *(u32x4*)(dst + (size_t)d * 64 + 8 * t8) = w; }
        } else if (which == 0) {
#pragma unroll
            for (int I = 0; I < 8; ++I) { const int dt = I >> 1, sp = I & 1; unsigned short e[8];
#pragma unroll
                for (int j = 0; j < 8; ++j) e[j] = scr[(32 * sp + 8 * kq + j) * 66 + 16 * dt + c16];
                u32x4 w; w.x = e[0] | ((unsigned)e[1] << 16); w.y = e[2] | ((unsigned)e[3] << 16); w.z = e[4] | ((unsigned)e[5] << 16); w.w = e[6] | ((unsigned)e[7] << 16);
                *(u32x4*)(dst + (I * 64 + F.lane) * 8) = w; }
        } else {
#pragma unroll
            for (int I = 0; I < 8; ++I) { const int rt = I >> 1, ks = I & 1; const LAS bf16_t* sp = scr + KPERM(rt, c16) * 66 + 32 * ks + 8 * kq;
                u32x4 w; w.x = ((const LAS unsigned*)sp)[0]; w.y = ((const LAS unsigned*)sp)[1]; w.z = ((const LAS unsigned*)sp)[2]; w.w = ((const LAS unsigned*)sp)[3];
                *(u32x4*)(dst + (I * 64 + F.lane) * 8) = w; }
        }
        asm volatile("s_waitcnt lgkmcnt(0)" ::: "memory");
    }
    vm = wave_max_u32(vm);
    if (F.lane == 0 && vm != 0u) __hip_atomic_fetch_max(vmax_word, vm, __ATOMIC_RELAXED, __HIP_MEMORY_SCOPE_AGENT);
}

#define MFMA32(a, b, c) __builtin_amdgcn_mfma_f32_32x32x16_bf16((a), (b), (c), 0, 0, 0)
#define MFMA16(a, b, c) __builtin_amdgcn_mfma_f32_16x16x32_bf16((a), (b), (c), 0, 0, 0)

DI void compress2_phase(Frame& F, const bf16_t* hidc, const bf16_t* w2t, const float* b2  , bf16_t* kc, bf16_t* vct, int it0, int it_end, int it_step) {
    const int r = F.lane & 31, h = F.lane >> 5;
    for (int it = it0; it < it_end; it += it_step) {
        const int kv = it / 192, rb = it % 192; const int R0 = kv * 6144 + rb * 32;
        f32x16 acc0, acc1;
#pragma unroll
        for (int i = 0; i < 16; ++i) { acc0[i] = 0.f; acc1[i] = 0.f; }
        const bf16_t* ap = hidc + (size_t)(R0 + r) * 256 + 8 * h; const bf16_t* bp = w2t + (size_t)kv * 64 * 256 + (size_t)r * 256 + 8 * h;
#pragma unroll 4
        for (int ks = 0; ks < 16; ++ks) { const bf16x8 a = *(const bf16x8*)(ap + 16 * ks); const bf16x8 b0 = *(const bf16x8*)(bp + 16 * ks), b1 = *(const bf16x8*)(bp + 32 * 256 + 16 * ks);
            acc0 = MFMA32(a, b0, acc0); acc1 = MFMA32(a, b1, acc1); }
        const int bh = rb >> 5, i0 = (rb & 31) * 32;
        const float bb0 = b2[kv * 64 + r], bb1 = b2[kv * 64 + 32 + r];
        if (kv == 0) {
#pragma unroll
            for (int i = 0; i < 16; ++i) { const int row = i0 + (i & 3) + 8 * (i >> 2) + 4 * h; bf16_t* o = kc + ((size_t)bh * 1024 + row) * 64;
                const bool junk = (row == 1023);
                o[r] = junk ? (bf16_t)0 : f2bf(acc0[i] + bb0); o[32 + r] = junk ? (bf16_t)0 : f2bf(acc1[i] + bb1); }
        } else {
#pragma unroll
            for (int g4 = 0; g4 < 4; ++g4) { const int row = i0 + 8 * g4 + 4 * h;
                u32x2 w0, w1; w0.x = pk2(acc0[4 * g4] + bb0, acc0[4 * g4 + 1] + bb0); w0.y = pk2(acc0[4 * g4 + 2] + bb0, acc0[4 * g4 + 3] + bb0);
                w1.x = pk2(acc1[4 * g4] + bb1, acc1[4 * g4 + 1] + bb1); w1.y = pk2(acc1[4 * g4 + 2] + bb1, acc1[4 * g4 + 3] + bb1);
                if (row == 1020) { w0.y &= 0x0000ffffu; w1.y &= 0x0000ffffu; }
                bf16_t* vt = vct + (size_t)bh * 64 * 1024 + (size_t)(row >> 6) * 4096 + (row & 63);
                *(u32x2*)(vt + r * 64) = w0; *(u32x2*)(vt + (32 + r) * 64) = w1; }
        }
    }
}

DI void ssm_carry_phase(Frame& F, const float* hl, const f32x2* ab16, const f32x2* ab512, bf16_t* hin, int bg0, int bg_end, int bg_step) {
    LAS f32x2* E = (LAS f32x2*)F.lds;
    const int s = F.lane;
    for (int bg = bg0; bg < bg_end; bg += bg_step) {
        const int gi = bg & 15; const f32x2 a16 = ab16[gi * 64 + s], a5 = ab512[gi * 64 + s];
        const float* hp = hl + (size_t)bg * 1024 * 128 + s;
        float hr[4], hi[4];
#pragma unroll
        for (int j = 0; j < 4; ++j) { hr[j] = 0.f; hi[j] = 0.f; }
#pragma unroll 4
        for (int c = 0; c < 32; ++c) {
#pragma unroll
            for (int j = 0; j < 4; ++j) { const float* q = hp + (size_t)((4 * F.wave + j) * 32 + c) * 128; const float lr = q[0], li = q[64];
                const float nr = a16.x * hr[j] - a16.y * hi[j] + lr, ni = a16.x * hi[j] + a16.y * hr[j] + li; hr[j] = nr; hi[j] = ni; } }
#pragma unroll
        for (int j = 0; j < 4; ++j) E[(4 * F.wave + j) * 64 + s] = (f32x2){hr[j], hi[j]};
        __syncthreads();
        { float pr = 0.f, pi = 0.f;
          for (int k = 0; k < 4 * F.wave; ++k) { const f32x2 e = E[k * 64 + s]; const float nr = a5.x * pr - a5.y * pi + e.x, ni = a5.x * pi + a5.y * pr + e.y; pr = nr; pi = ni; }
#pragma unroll
          for (int j = 0; j < 4; ++j) { hr[j] = pr; hi[j] = pi; const f32x2 e = E[(4 * F.wave + j) * 64 + s]; const float nr = a5.x * pr - a5.y * pi + e.x, ni = a5.x * pi + a5.y * pr + e.y; pr = nr; pi = ni; } }
#pragma unroll 4
        for (int c = 0; c < 32; ++c) {
#pragma unroll
            for (int j = 0; j < 4; ++j) { const int ch = (4 * F.wave + j) * 32 + c; const float* q = hp + (size_t)ch * 128; const float lr = q[0], li = q[64];
                bf16_t* o = hin + ((size_t)bg * 1024 + ch) * 256; o[s] = f2bf(hr[j]); o[64 + s] = f2bf(hi[j]); ((unsigned*)(o + 128))[s] = 0u;
                const float nr = a16.x * hr[j] - a16.y * hi[j] + lr, ni = a16.x * hi[j] + a16.y * hr[j] + li; hr[j] = nr; hi[j] = ni; } }
        __syncthreads();
    }
}

constexpr float AL2E = 1.0f;
constexpr int IMP_STRIDE = 257;
constexpr int OS_QS = 261, OS_HS = 65;
constexpr int LDS_RA = 0, LDS_RB = 64 * IMP_STRIDE * 4, LDS_WM = LDS_RB + 64 * OS_QS * 4;
constexpr int QT_ROW = 144, LDS_QT = LDS_RA, LDS_QL = LDS_QT + 256 * QT_ROW, LDS_MREF = LDS_QL + 512, LDS_LS = LDS_MREF + 1024;
constexpr int LDS_QCNT = LDS_WM + 2048;
static_assert(LDS_LS + 1024 <= LDS_RB && LDS_QCNT + 16 <= LDS_BYTES - 256, "LDS map");
constexpr int TROW = 144, TILE_V = 64 * TROW, TILE_BYTES = 2 * 64 * TROW;

struct TileSrc { const bf16_t* k; long kstep, kstride; const bf16_t* v; long vstep, vstride; };

constexpr int PD = 1;
struct IdMap { DI int operator()(int i) const { return i; } };
template <bool WITH_V, class Compute, class Map = IdMap, bool FRAG = false>
DI void kv_pipeline(Frame& F, LAS unsigned char* sb, const TileSrc& ts, int n, Compute&& compute, Map tmap = Map()) {
    if (n <= 0) return;
    const int row = F.tid >> 3, ch = F.tid & 7, nl = n - 1;
    const bf16_t* kp = FRAG ? ts.k + F.tid * 8 : ts.k + (long)row * ts.kstride + ch * 8; const bf16_t* vp = FRAG ? ts.v + F.tid * 8 : ts.v + (long)row * ts.vstride + ch * 8;
    LAS unsigned char* wk = sb + row * TROW + ch * 16; int vdel = TILE_V;
    if (FRAG) { const int I = F.tid >> 6, l_ = F.tid & 63, c16_ = l_ & 15, kq_ = l_ >> 4;
        const int kofs = KPERM(I >> 1, c16_) * TROW + (32 * (I & 1) + 8 * kq_) * 2, vofs = TILE_V + (16 * (I >> 1) + c16_) * TROW + (32 * (I & 1) + 8 * kq_) * 2;
        wk = sb + kofs; vdel = vofs - kofs; }
    u32x4 kr[PD], vr[PD];
#pragma unroll
    for (int u = 0; u < PD; ++u) { const int t = tmap(u < nl ? u : nl); kr[u] = *(const u32x4*)(kp + (long)t * ts.kstep); vr[u] = WITH_V ? *(const u32x4*)(vp + (long)t * ts.vstep) : (u32x4){0u, 0u, 0u, 0u}; }
    *(LAS u32x4*)wk = kr[0]; if (WITH_V) *(LAS u32x4*)(wk + vdel) = vr[0];
    { const int t = tmap(PD < nl ? PD : nl); kr[0] = *(const u32x4*)(kp + (long)t * ts.kstep); if (WITH_V) vr[0] = *(const u32x4*)(vp + (long)t * ts.vstep); }
    __syncthreads();
    for (int i0 = 0; i0 < n; i0 += PD) {
#pragma unroll
        for (int u = 0; u < PD; ++u) {
            const int i = i0 + u; const int s1 = (u + 1) % PD;
            { LAS unsigned char* w1 = wk + ((i + 1) & 1) * TILE_BYTES; *(LAS u32x4*)w1 = kr[s1]; if (WITH_V) *(LAS u32x4*)(w1 + vdel) = vr[s1]; }
            { const int t = tmap((i + 1 + PD) < nl ? (i + 1 + PD) : nl); kr[s1] = *(const u32x4*)(kp + (long)t * ts.kstep); if (WITH_V) vr[s1] = *(const u32x4*)(vp + (long)t * ts.vstep); }
            if (i < n) compute(i, sb + (i & 1) * TILE_BYTES);
            __syncthreads();
        }
    }
}

DI f32x16 qk32(const LAS unsigned char* tb, int kh, int r32, int h, const bf16x8 (&qf)[4]) {
    f32x16 sc;
#pragma unroll
    for (int i = 0; i < 16; ++i) sc[i] = 0.f;
    const LAS unsigned char* kp = tb + (32 * kh + r32) * TROW + 16 * h;
#pragma unroll
    for (int s = 0; s < 4; ++s) { const bf16x8 a = *(const LAS bf16x8*)(kp + 32 * s); sc = MFMA32(a, qf[s], sc); }
    return sc;
}
DI void qk32x2(const LAS unsigned char* tb, int r32, int h, const bf16x8 (&qf)[4], f32x16& s0, f32x16& s1) {
#pragma unroll
    for (int i = 0; i < 16; ++i) { s0[i] = 0.f; s1[i] = 0.f; }
    const LAS unsigned char* kp = tb + r32 * TROW + 16 * h;
#pragma unroll
    for (int s = 0; s < 4; ++s) { const bf16x8 a0 = *(const LAS bf16x8*)(kp + 32 * s), a1 = *(const LAS bf16x8*)(kp + 32 * TROW + 32 * s); s0 = MFMA32(a0, qf[s], s0); s1 = MFMA32(a1, qf[s], s1); }
}
DI void pv32(const LAS unsigned char* tb, int kh, int r32, int h, const f32x16& p, f32x16& o0, f32x16& o1) {
#pragma unroll
    for (int s2 = 0; s2 < 2; ++s2) {
        u32x4 pw; pw.x = pk2(p[8 * s2], p[8 * s2 + 1]); pw.y = pk2(p[8 * s2 + 2], p[8 * s2 + 3]); pw.z = pk2(p[8 * s2 + 4], p[8 * s2 + 5]); pw.w = pk2(p[8 * s2 + 6], p[8 * s2 + 7]);
        const bf16x8 pb = __builtin_bit_cast(bf16x8, pw);
        const LAS unsigned char* vp = tb + TILE_V + r32 * TROW + (32 * kh + 16 * s2 + 4 * h) * 2;
        { const s16x4 lo = *(const LAS s16x4*)vp, hi = *(const LAS s16x4*)(vp + 16); const bf16x8 a = __builtin_shufflevector(lo, hi, 0, 1, 2, 3, 4, 5, 6, 7); o0 = MFMA32(a, pb, o0); }
        { const s16x4 lo = *(const LAS s16x4*)(vp + 32 * TROW), hi = *(const LAS s16x4*)(vp + 32 * TROW + 16); const bf16x8 a = __builtin_shufflevector(lo, hi, 0, 1, 2, 3, 4, 5, 6, 7); o1 = MFMA32(a, pb, o1); }
    }
}

DI void attn_unit(Frame& F, const bf16_t* proj, const bf16_t* kcb, const bf16_t* vctb, const bf16_t* vts, const bf16_t* vtw, bf16_t* oatt, int bh, int qb, float os_scale, float os_inv, float os_e2, float* park, const bf16_t* kfs, unsigned long long* sst) {
    const float ls_scale = 1048576.0f * os_inv;
    LAS unsigned* IMP = (LAS unsigned*)(F.lds + LDS_RA); LAS unsigned char* WM = F.lds + LDS_WM;
    const int b = bh / 3, hkv = bh % 3, lane = F.lane, w = F.wave;
    const float NEG = -__builtin_inff();
    for (int i = F.tid; i < 64 * IMP_STRIDE; i += 512) IMP[i] = 0u;
    for (int i = F.tid; i < 512; i += 512) ((LAS unsigned*)WM)[i] = 0u;
    const int r32 = lane & 31, h = lane >> 5, gq = w & 3, qh = w >> 2;
    const int ql = 32 * qh + r32, t = 64 * qb + ql;
    const size_t trow = (size_t)(b * SEQ + t);
    const bf16_t* qrow = proj + trow * PW + C_Q + (hkv * 4 + gq) * 64;
    bf16x8 qf[4];
#pragma unroll
    for (int s = 0; s < 4; ++s) qf[s] = *(const bf16x8*)(qrow + 16 * s + 8 * h);
    const bf16_t* grow = proj + trow * PW + C_G + hkv * 12 + gq * 3;
    const float g0 = sigmoidf_(bf2f(grow[0])), g2 = sigmoidf_(bf2f(grow[2]));
    f32x16 oc0, oc1; float inv_c = 0.f;
#pragma unroll
    for (int i = 0; i < 16; ++i) { oc0[i] = 0.f; oc1[i] = 0.f; }
    {
        const int ntile = (4 * qb + 3 + 63) >> 6;
        const int vis = (t - 31) >> 4;
        const int vis_w = (64 * qb + 32 * qh + 31 - 31) >> 4;
        const int vis_min = (64 * qb + 32 * qh - 31) >> 4;
        TileSrc ts{kcb + (size_t)bh * 1024 * 64, 64 * 64, 64, vctb + (size_t)bh * 64 * 1024, 4096, 64};
        float m = NEG, lsum = 0.f;
        for (int rep_ = 0; rep_ < REP_B1; ++rep_)
        kv_pipeline<false>(F, F.lds + LDS_RB, ts, ntile, [&](int i, const LAS unsigned char* tb) {
            if (64 * i > vis_w) return;
            const bool two = (64 * i + 32 <= vis_w); f32x16 sq0, sq1;
            if (two) qk32x2(tb, r32, h, qf, sq0, sq1); else { sq0 = qk32(tb, 0, r32, h, qf); sq1 = sq0; }
#pragma unroll
            for (int kh = 0; kh < 2; ++kh) {
                if (kh == 1 && !two) continue;
                f32x16 sc = kh ? sq1 : sq0;
                float tm = NEG;
                if (64 * i + 32 * kh + 31 > vis_min) {
#pragma unroll
                    for (int e = 0; e < 16; ++e) { const int ki = 64 * i + 32 * kh + (e & 3) + 8 * (e >> 2) + 4 * h; sc[e] = (ki <= vis) ? sc[e] : NEG; }
                }
#pragma unroll
                for (int e = 0; e < 16; ++e) tm = fmaxf(tm, sc[e]);
                const float mn = fmaxf(m, tm);
                if (mn > NEG) { float ps = 0.f;
#pragma unroll
                    for (int e = 0; e < 16; ++e) ps += fexp2((sc[e] - mn) * AL2E);
                    lsum = lsum * fexp2((m - mn) * AL2E) + ps; m = mn; }
            }
        });
        const F2 mm = halves32(m), ll = halves32(lsum);
        float M = fmaxf(mm.lo, mm.hi), Lt = 0.f;
        if (M > NEG) Lt = ll.lo * fexp2((mm.lo - M) * AL2E) + ll.hi * fexp2((mm.hi - M) * AL2E); else M = 0.f;
        const float inv = 1.0f / fmaxf(Lt, 1e-30f), inv24 = inv * 16777216.0f;
        inv_c = inv;
        for (int rep_ = 0; rep_ < REP_B1; ++rep_)
        kv_pipeline<true>(F, F.lds + LDS_RB, ts, ntile, [&](int i, const LAS unsigned char* tb) {
            if (64 * i > vis_w) return;
            const bool two = (64 * i + 32 <= vis_w); f32x16 sq0, sq1;
            if (two) qk32x2(tb, r32, h, qf, sq0, sq1); else { sq0 = qk32(tb, 0, r32, h, qf); sq1 = sq0; }
#pragma unroll
            for (int kh = 0; kh < 2; ++kh) {
                if (kh == 1 && !two) continue;
                f32x16 sc = kh ? sq1 : sq0;
#pragma unroll
                for (int e = 0; e < 16; ++e) sc[e] = fexp2((sc[e] - M) * AL2E);
                if (64 * i + 32 * kh + 31 > vis_min) {
#pragma unroll
                    for (int e = 0; e < 16; ++e) { const int ki = 64 * i + 32 * kh + (e & 3) + 8 * (e >> 2) + 4 * h; sc[e] = (ki <= vis) ? sc[e] : 0.f; }
                }
#pragma unroll
                for (int a = 0; a < 4; ++a) { const float G = (sc[4 * a] + sc[4 * a + 1]) + (sc[4 * a + 2] + sc[4 * a + 3]); const int j = 16 * i + 8 * kh + 2 * a + h;
                    __hip_atomic_fetch_add(IMP + ql * IMP_STRIDE + j, (unsigned)(G * inv24 + 0.5f), __ATOMIC_RELAXED, __HIP_MEMORY_SCOPE_WORKGROUP);
                    __hip_atomic_fetch_add(IMP + ql * IMP_STRIDE + j + 1, (unsigned)(sc[4 * a + 3] * inv24 + 0.5f), __ATOMIC_RELAXED, __HIP_MEMORY_SCOPE_WORKGROUP); }
                pv32(tb, kh, r32, h, sc, oc0, oc1);
            }
        });
    }
    {
        const int cur = qb; LAS unsigned char* wm = WM + w * 256;
        if (cur + 1 <= 16) { if (lane <= cur) wm[lane] = 0xff; }
        else for (int rep_ = 0; rep_ < REP_TK; ++rep_) {
            unsigned key[8][4]; unsigned selbits = 0u;
#pragma unroll
            for (int qi = 0; qi < 8; ++qi) {
#pragma unroll
                for (int i = 0; i < 4; ++i) { const int j = 4 * lane + i; const unsigned x = IMP[(8 * w + qi) * IMP_STRIDE + j]; key[qi][i] = (j >= 1 && j <= cur - 2) ? (((x + 1u) << 2) | (unsigned)(3 - i)) : 0u; }
#define CE_(a_, b_) do { const unsigned hi_ = max(key[qi][a_], key[qi][b_]), lo_ = min(key[qi][a_], key[qi][b_]); key[qi][a_] = hi_; key[qi][b_] = lo_; } while (0)
                CE_(0, 1); CE_(2, 3); CE_(0, 2); CE_(1, 3); CE_(1, 2);
#undef CE_
            }
            for (int k = 0; k < 13; ++k) {
#pragma unroll
                for (int qi = 0; qi < 8; ++qi) {
                    const unsigned hv = key[qi][0] >> 2; const unsigned Mx = wave_max_u32(hv);
                    const unsigned long long bal = __ballot(hv == Mx); const int L = __ffsll((long long)bal) - 1;
                    const unsigned hk = (unsigned)__builtin_amdgcn_readlane((int)key[qi][0], L);
                    const unsigned bit = 1u << (8 * (3 - (int)(hk & 3u)) + qi);
                    const bool win = (lane == L);
                    selbits |= win ? bit : 0u;
                    key[qi][0] = win ? key[qi][1] : key[qi][0]; key[qi][1] = win ? key[qi][2] : key[qi][1]; key[qi][2] = win ? key[qi][3] : key[qi][2]; key[qi][3] = win ? 0u : key[qi][3];
                }
            }
            unsigned mybits[4];
#pragma unroll
            for (int i = 0; i < 4; ++i) mybits[i] = (selbits >> (8 * i)) & 0xffu;
#pragma unroll
            for (int i = 0; i < 4; ++i) { const int j = 4 * lane + i; unsigned bits = mybits[i]; if (j == 0 || j == cur - 1 || j == cur) bits = 0xffu; wm[j] = (unsigned char)bits; }
        }
    }
    __syncthreads();
    {
        const int kt_lo = (qb - 8) > 0 ? (qb - 8) : 0; const int ntile = qb - kt_lo + 1;
        const int t0w = 64 * qb + 32 * qh;
        TileSrc ts{proj + ((size_t)(b * SEQ) + 64 * kt_lo) * PW + C_KW + hkv * 64, 64 * PW, PW, vtw + (size_t)bh * 64 * SEQ + (size_t)kt_lo * 4096, 4096, 64};
        float m = NEG, lsum = 0.f; f32x16 o0, o1;
#pragma unroll
        for (int i = 0; i < 16; ++i) { o0[i] = 0.f; o1[i] = 0.f; }
        kv_pipeline<true>(F, F.lds + LDS_RA, ts, ntile, [&](int i, const LAS unsigned char* tb) {
#pragma unroll
            for (int kh = 0; kh < 2; ++kh) {
                const int k0 = 64 * (kt_lo + i) + 32 * kh;
                if (k0 > t0w + 31 || k0 + 31 <= t0w - 512) continue;
                f32x16 sc = qk32(tb, kh, r32, h, qf);
                float tm = NEG;
                if (!(k0 + 31 <= t0w && k0 > t0w + 31 - 512)) {
#pragma unroll
                    for (int e = 0; e < 16; ++e) { const int key = k0 + (e & 3) + 8 * (e >> 2) + 4 * h; sc[e] = (key <= t && key > t - 512) ? sc[e] : NEG; }
                }
#pragma unroll
                for (int e = 0; e < 16; ++e) tm = fmaxf(tm, sc[e]);
                tm = xor32_max(tm);
                const float mn = fmaxf(m, tm); const float ms = (mn > NEG) ? mn : 0.f;
                const float alpha = fexp2((m - ms) * AL2E); float ps = 0.f;
#pragma unroll
                for (int e = 0; e < 16; ++e) { sc[e] = fexp2((sc[e] - ms) * AL2E); ps += sc[e]; }
                lsum = lsum * alpha + ps; m = mn;
                if (__any(alpha != 1.0f)) {
#pragma unroll
                    for (int e = 0; e < 16; ++e) { o0[e] *= alpha; o1[e] *= alpha; }
                }
                pv32(tb, kh, r32, h, sc, o0, o1);
            }
        });
        const float Lw = xor32_sum(lsum); const float gw = g2 / fmaxf(Lw, 1e-30f);
        const float gc = g0 * inv_c;
#pragma unroll
        for (int e = 0; e < 16; ++e) { oc0[e] = gc * oc0[e] + gw * o0[e]; oc1[e] = gc * oc1[e] + gw * o1[e]; }
        bf16_t* op = oatt + trow * 1024 + (hkv * 4 + gq) * 64;
#pragma unroll
        for (int g4 = 0; g4 < 4; ++g4) { const int d = 8 * g4 + 4 * h; u32x2 w0, w1;
            w0.x = pk2(oc0[4 * g4], oc0[4 * g4 + 1]); w0.y = pk2(oc0[4 * g4 + 2], oc0[4 * g4 + 3]); w1.x = pk2(oc1[4 * g4], oc1[4 * g4 + 1]); w1.y = pk2(oc1[4 * g4 + 2], oc1[4 * g4 + 3]);
            *(u32x2*)(op + d) = w0; *(u32x2*)(op + 32 + d) = w1; }
    }
    const int cur = qb; const bool dense = (cur + 1 <= 16);
    float mf = NEG, lf = 0.f;
    {
        const int nfb = dense ? (cur + 1) : 3;
        TileSrc ts{kfs + (size_t)bh * 64 * SEQ, 4096, 0, vts + (size_t)bh * 64 * SEQ, 4096, 0};
#pragma unroll
        for (int e = 0; e < 16; ++e) { oc0[e] = 0.f; oc1[e] = 0.f; }
        auto dense_fn = [&](int i, const LAS unsigned char* tb) {
            const int j = dense ? i : (i == 0 ? 0 : cur - 2 + i);
#pragma unroll
            for (int kh = 0; kh < 2; ++kh) {
                const int k0 = 64 * j + 32 * kh;
                if (k0 > 64 * qb + 32 * qh + 31) continue;
                f32x16 sc = qk32(tb, kh, r32, h, qf);
                float tm = NEG;
                if (k0 + 31 > 64 * qb + 32 * qh) {
#pragma unroll
                    for (int e = 0; e < 16; ++e) { const int key = k0 + (e & 3) + 8 * (e >> 2) + 4 * h; sc[e] = (key <= t) ? sc[e] : NEG; }
                }
#pragma unroll
                for (int e = 0; e < 16; ++e) tm = fmaxf(tm, sc[e]);
                tm = xor32_max(tm);
                const float mn = fmaxf(mf, tm); const float ms = (mn > NEG) ? mn : 0.f;
                const float alpha = fexp2((mf - ms) * AL2E); float ps = 0.f;
#pragma unroll
                for (int e = 0; e < 16; ++e) { sc[e] = fexp2((sc[e] - ms) * AL2E); ps += sc[e]; }
                lf = lf * alpha + ps; mf = mn;
                if (__any(alpha != 1.0f)) {
#pragma unroll
                    for (int e = 0; e < 16; ++e) { oc0[e] *= alpha; oc1[e] *= alpha; }
                }
                pv32(tb, kh, r32, h, sc, oc0, oc1);
            }
        };
        auto dense_map = [&](int i) -> int { return dense ? i : (i == 0 ? 0 : cur - 2 + i); };
        kv_pipeline<true, decltype(dense_fn)&, decltype(dense_map), true>(F, F.lds + LDS_RA, ts, nfb, dense_fn, dense_map);
        lf = xor32_sum(lf);
#pragma unroll
        for (int g4 = 0; g4 < 4; ++g4) { *(f32x4*)(park + 4 * g4) = (f32x4){oc0[4 * g4], oc0[4 * g4 + 1], oc0[4 * g4 + 2], oc0[4 * g4 + 3]}; *(f32x4*)(park + 16 + 4 * g4) = (f32x4){oc1[4 * g4], oc1[4 * g4 + 1], oc1[4 * g4 + 2], oc1[4 * g4 + 3]}; }
    }
    {
        const int c16 = lane & 15, kq = lane >> 4, hd = c16 & 3, qs = c16 >> 2;
        LAS unsigned char* QT = F.lds + LDS_QT; LAS unsigned char* QL = F.lds + LDS_QL + w * 64; LAS int* MREF = (LAS int*)(F.lds + LDS_MREF); LAS unsigned* LS = (LAS unsigned*)(F.lds + LDS_LS);
        LAS int* OS = (LAS int*)(F.lds + LDS_RB);
        LAS int* QCNT = (LAS int*)(F.lds + LDS_QCNT); LAS int* FLAGW = (LAS int*)(F.lds + LDS_QCNT + 12);
        bool exact = false;
        const int nsp = dense ? 0 : (cur - 2);
        if (nsp > 0) {
        { const int row = F.tid >> 1, half = F.tid & 1, q = row >> 2, hh = row & 3;
          const bf16_t* src = proj + (size_t)(b * SEQ + 64 * qb + q) * PW + C_Q + (hkv * 4 + hh) * 64 + 32 * half;
          const u32x4 v0 = *(const u32x4*)src, v1 = *(const u32x4*)(src + 8), v2 = *(const u32x4*)(src + 16), v3 = *(const u32x4*)(src + 24);
          LAS u32x4* d = (LAS u32x4*)(QT + row * QT_ROW + 64 * half); d[0] = v0; d[1] = v1; d[2] = v2; d[3] = v3; }
        for (int i = F.tid; i < 64 * OS_QS; i += 512) OS[i] = 0;
        if (F.tid < 256) LS[F.tid] = 0u;
        if (h == 0) MREF[ql * 4 + gq] = __float_as_int(mf);
        if (F.tid < 2) QCNT[F.tid] = 0;
        if (F.tid == 2) FLAGW[0] = 0;
        __syncthreads();
        const bf16_t* Ksb = kfs + (size_t)bh * 64 * SEQ + lane * 8;
        const bf16_t* Vsb = vts + (size_t)bh * 64 * SEQ + lane * 8;
        auto ticket = [&](LAS int* cnt) -> int { int tk = 0; if (lane == 0) tk = __hip_atomic_fetch_add(cnt, 1, __ATOMIC_RELAXED, __HIP_MEMORY_SCOPE_WORKGROUP); return __builtin_amdgcn_readfirstlane(tk); };
        auto load_k = [&](int j, bf16x8 (&kf)[4][2]) {
#pragma unroll
            for (int rt = 0; rt < 4; ++rt)
#pragma unroll
                for (int ks = 0; ks < 2; ++ks) kf[rt][ks] = *(const bf16x8*)(Ksb + (size_t)j * 4096 + 512 * (2 * rt + ks)); };
        auto load_v = [&](int j, bf16x8 (&vf)[4][2]) {
#pragma unroll
            for (int dt = 0; dt < 4; ++dt)
#pragma unroll
                for (int sp = 0; sp < 2; ++sp) vf[dt][sp] = *(const bf16x8*)(Vsb + (size_t)j * 4096 + 512 * (2 * dt + sp)); };
        auto make_list = [&](int j, int& nj) -> int {
            const unsigned byte = WM[(lane >> 3) * 256 + j]; const bool act = (byte >> (lane & 7)) & 1u;
            const unsigned long long bal = __ballot(act); nj = __popcll(bal);
            const int rank = __builtin_amdgcn_mbcnt_hi((unsigned)(bal >> 32), __builtin_amdgcn_mbcnt_lo((unsigned)bal, 0u));
            if (act) QL[rank] = (unsigned char)lane;
            asm volatile("s_waitcnt lgkmcnt(0)" ::: "memory");
            return (nj + 3) >> 2; };
        auto col_query = [&](int tl, int nj, bool& valid) -> int { const int idx = 4 * tl + qs; valid = idx < nj; return (int)QL[valid ? idx : 0]; };
        auto scores = [&](const bf16x8 (&kf)[4][2], int q, bool valid, f32x4 (&st)[4]) {
            const LAS unsigned char* qp = QT + (q * 4 + hd) * QT_ROW + 16 * kq;
            const bf16x8 q0 = *(const LAS bf16x8*)qp, q1 = *(const LAS bf16x8*)(qp + 64);
#pragma unroll
            for (int rt = 0; rt < 4; ++rt) { st[rt] = (f32x4){0.f, 0.f, 0.f, 0.f}; st[rt] = MFMA16(kf[rt][0], q0, st[rt]); st[rt] = MFMA16(kf[rt][1], q1, st[rt]); }
            if (!valid) {
#pragma unroll
                for (int rt = 0; rt < 4; ++rt) st[rt] = (f32x4){NEG, NEG, NEG, NEG};
            } };
        auto run_pass2 = [&](const bool FAST) {
            bf16x8 kf[4][2], kn[4][2], vf[4][2], vn[4][2];
            int t0 = ticket(QCNT + 1), t1;
            { const int j0 = t0 < nsp ? t0 : nsp - 1; load_k(1 + j0, kn); load_v(1 + j0, vn); }
            while (t0 < nsp) {
                asm volatile("s_waitcnt vmcnt(0)" ::: "memory");
#pragma unroll
                for (int rt = 0; rt < 4; ++rt)
#pragma unroll
                    for (int ks = 0; ks < 2; ++ks) { kf[rt][ks] = kn[rt][ks]; vf[rt][ks] = vn[rt][ks]; }
#pragma unroll
                for (int rt = 0; rt < 4; ++rt)
#pragma unroll
                    for (int ks = 0; ks < 2; ++ks) { asm volatile("" : "+v"(kf[rt][ks])); asm volatile("" : "+v"(vf[rt][ks])); }
                t1 = ticket(QCNT + 1);
                { const int j1 = t1 < nsp ? t1 : nsp - 1; load_k(1 + j1, kn); load_v(1 + j1, vn); }
                int nj; const int ntl = make_list(1 + t0, nj);
                for (int tl = 0; tl < ntl; ++tl) {
                    bool valid; const int q = col_query(tl, nj, valid);
                    f32x4 st[4]; scores(kf, q, valid, st);
                    float mr;
                    if (FAST) mr = __int_as_float(MREF[q * 4 + hd]);
                    else { const int key = MREF[q * 4 + hd]; const int ib = key >= 0 ? key : (key ^ 0x7fffffff); mr = __int_as_float(ib); mr = (mr > NEG) ? mr : 0.f; }
                    float ps = 0.f; mr -= os_e2;
#pragma unroll
                    for (int rt = 0; rt < 4; ++rt)
#pragma unroll
                        for (int e = 0; e < 4; ++e) { st[rt][e] = fexp2((st[rt][e] - mr) * AL2E); ps += st[rt][e]; }
                    ps = xor32_sum(xor16_sum(ps));
                    if (FAST) { if (ps > 218.0f * os_scale) FLAGW[0] = 1; }
                    f32x4 o[4];
#pragma unroll
                    for (int dt = 0; dt < 4; ++dt) o[dt] = (f32x4){0.f, 0.f, 0.f, 0.f};
#pragma unroll
                    for (int sp = 0; sp < 2; ++sp) {
                        u32x4 pw; pw.x = pk2(st[2 * sp][0], st[2 * sp][1]); pw.y = pk2(st[2 * sp][2], st[2 * sp][3]); pw.z = pk2(st[2 * sp + 1][0], st[2 * sp + 1][1]); pw.w = pk2(st[2 * sp + 1][2], st[2 * sp + 1][3]);
                        const bf16x8 pb = __builtin_bit_cast(bf16x8, pw);
#pragma unroll
                        for (int dt = 0; dt < 4; ++dt) o[dt] = MFMA16(vf[dt][sp], pb, o[dt]);
                    }
                    if (valid) {
                        LAS int* op = OS + q * OS_QS + hd * OS_HS + 4 * kq;
#pragma unroll
                        for (int dt = 0; dt < 4; ++dt)
#pragma unroll
                            for (int e = 0; e < 4; ++e) __hip_atomic_fetch_add(op + 16 * dt + e, (int)o[dt][e], __ATOMIC_RELAXED, __HIP_MEMORY_SCOPE_WORKGROUP);
                        if (kq == 0) __hip_atomic_fetch_add(LS + q * 4 + hd, (unsigned)(ps * ls_scale + 0.5f), __ATOMIC_RELAXED, __HIP_MEMORY_SCOPE_WORKGROUP);
                    }
                }
                t0 = t1;
            }
            asm volatile("s_waitcnt vmcnt(0)" ::: "memory");
        };
        for (int rep2_ = 0; rep2_ < REP_B3; ++rep2_) {
            if (rep2_ > 0) { __syncthreads(); if (F.tid == 0) QCNT[1] = 0; __syncthreads(); }
            run_pass2(true);
        }
        __syncthreads();
        exact = (FLAGW[0] != 0) || (REP_B2 > 1);
        if (exact) {
            __syncthreads();
            for (int i = F.tid; i < 64 * OS_QS; i += 512) OS[i] = 0;
            if (F.tid < 256) { MREF[F.tid] = (int)0x80000000; LS[F.tid] = 0u; }
            if (F.tid < 2) QCNT[F.tid] = 0;
            __syncthreads();
            {
                bf16x8 kf[4][2], kn[4][2], kn2[4][2];
                int t0 = ticket(QCNT), t1 = ticket(QCNT), t2;
                if (t0 < nsp) load_k(1 + t0, kf);
                if (t1 < nsp) load_k(1 + t1, kn);
                while (t0 < nsp) {
                    t2 = ticket(QCNT);
                    if (t2 < nsp) load_k(1 + t2, kn2);
                    int nj; const int ntl = make_list(1 + t0, nj);
                    for (int tl = 0; tl < ntl; ++tl) {
                        bool valid; const int q = col_query(tl, nj, valid);
                        f32x4 st[4]; scores(kf, q, valid, st);
                        float bm = NEG;
#pragma unroll
                        for (int rt = 0; rt < 4; ++rt)
#pragma unroll
                            for (int e = 0; e < 4; ++e) bm = fmaxf(bm, st[rt][e]);
                        bm = xor32_max(xor16_max(bm));
                        if (valid && kq == 0) { const int ib = __float_as_int(bm); const int key = ib >= 0 ? ib : (ib ^ 0x7fffffff);
                            __hip_atomic_fetch_max(MREF + q * 4 + hd, key, __ATOMIC_RELAXED, __HIP_MEMORY_SCOPE_WORKGROUP); }
                    }
#pragma unroll
                    for (int rt = 0; rt < 4; ++rt)
#pragma unroll
                        for (int ks = 0; ks < 2; ++ks) { kf[rt][ks] = kn[rt][ks]; kn[rt][ks] = kn2[rt][ks]; }
                    t0 = t1; t1 = t2;
                }
            }
            __syncthreads();
            run_pass2(false);
            __syncthreads();
        }
        }
        {
            float ms_ = NEG, ls_ = 0.f;
            if (nsp > 0) { const int key = MREF[ql * 4 + gq]; const int ib = key >= 0 ? key : (key ^ 0x7fffffff); const float m0 = exact ? __int_as_float(ib) : mf;
                if ((!exact || key != (int)0x80000000) && m0 > NEG) { ms_ = m0; ls_ = (float)LS[ql * 4 + gq] * (1.0f / 1048576.0f); } }
            const float Mx = fmaxf(mf, ms_);
            const float wf = fexp2((mf - Mx) * AL2E), ws_ = (ms_ > NEG) ? fexp2((ms_ - Mx) * AL2E) : 0.f;
            const float Lt = lf * wf + ls_ * ws_;
            const float g1 = sigmoidf_(bf2f(grow[1])) / fmaxf(Lt, 1e-30f);
            const float cf = g1 * wf, cs = g1 * ws_ * os_inv;
            const LAS int* ap = OS + ql * OS_QS + gq * OS_HS; float osq = 0.f;
            bf16_t* op = oatt + trow * 1024 + (hkv * 4 + gq) * 64;
#pragma unroll
            for (int g4 = 0; g4 < 4; ++g4) { const int d = 8 * g4 + 4 * h;
                const u32x2 p0 = *(const u32x2*)(op + d), p1 = *(const u32x2*)(op + 32 + d);
                const f32x4 f0 = *(const f32x4*)(park + 4 * g4), f1 = *(const f32x4*)(park + 16 + 4 * g4);
                float s0[4], s1[4];
#pragma unroll
                for (int e = 0; e < 4; ++e) { s0[e] = (nsp > 0) ? (float)ap[d + e] : 0.f; s1[e] = (nsp > 0) ? (float)ap[32 + d + e] : 0.f; }
                u32x2 w0, w1;
                w0.x = pk2(bflo(p0.x) + cf * f0[0] + cs * s0[0], bfhi(p0.x) + cf * f0[1] + cs * s0[1]); w0.y = pk2(bflo(p0.y) + cf * f0[2] + cs * s0[2], bfhi(p0.y) + cf * f0[3] + cs * s0[3]);
                w1.x = pk2(bflo(p1.x) + cf * f1[0] + cs * s1[0], bfhi(p1.x) + cf * f1[1] + cs * s1[1]); w1.y = pk2(bflo(p1.y) + cf * f1[2] + cs * s1[2], bfhi(p1.y) + cf * f1[3] + cs * s1[3]);
                *(u32x2*)(op + d) = w0; *(u32x2*)(op + 32 + d) = w1;
                osq += (bflo(w0.x) * bflo(w0.x) + bfhi(w0.x) * bfhi(w0.x)) + (bflo(w0.y) * bflo(w0.y) + bfhi(w0.y) * bfhi(w0.y)) + (bflo(w1.x) * bflo(w1.x) + bfhi(w1.x) * bfhi(w1.x)) + (bflo(w1.y) * bflo(w1.y) + bfhi(w1.y) * bfhi(w1.y)); }
            (void)__hip_atomic_fetch_add(sst + trow * 2, (unsigned long long)(osq * 16777216.f), __ATOMIC_RELAXED, __HIP_MEMORY_SCOPE_AGENT);
        }
    }
    __syncthreads();
}

DI void attn_phase(Frame& F, const bf16_t* proj, const bf16_t* kcb, const bf16_t* vctb, const bf16_t* vts, const bf16_t* vtw, bf16_t* oatt, const unsigned* vmax_word, float* park, unsigned* qctr, const bf16_t* kfs, unsigned long long* sst) {
    const float vmaxf = fmaxf(__uint_as_float(__hip_atomic_load(vmax_word, __ATOMIC_RELAXED, __HIP_MEMORY_SCOPE_AGENT)), 1e-20f);
    int e2 = (int)floorf(log2f(2.0e9f / (1100.0f * 55.0f * vmaxf)));
    e2 = e2 > 100 ? 100 : (e2 < -100 ? -100 : e2);
    const float os_scale = exp2f((float)e2), os_inv = exp2f((float)-e2);
    LAS int* QW = (LAS int*)(F.lds + LDS_QCNT + 8);
    int xq; { unsigned xx; asm volatile("s_getreg_b32 %0, hwreg(20, 0, 4)" : "=s"(xx)); xq = (int)(xx & 7u); }
    for (int tries = 0; tries < 8; ) {
        __syncthreads();
        if (F.tid == 0) QW[0] = (int)__hip_atomic_fetch_add(qctr + xq, 1u, __ATOMIC_RELAXED, __HIP_MEMORY_SCOPE_AGENT);
        __syncthreads();
        const int k = __builtin_amdgcn_readfirstlane(QW[0]);
        if (k >= 192) { xq = (xq + 1) & 7; ++tries; continue; }
        int bh, qb;
        if (xq < 6) { bh = xq; qb = 4 * (63 - k / 3) + (2 - k % 3); }
        else { bh = 3 * (xq - 6) + (k >> 6); qb = 4 * (63 - (k & 63)) + 3; }
        attn_unit(F, proj, kcb, vctb, vts, vtw, oatt, bh, qb, os_scale, os_inv, (float)e2, park + (size_t)F.bid * 16384 + (size_t)F.tid * 32, kfs, sst);
    }
    __syncthreads();
}


#define XB_TMO      128
#define XB_XCNT(j)  (256  + 64 * (j))
#define XB_XSUB(j)  (1280 + 64 * (j))
#define XB_XGEN(j)  (2304 + 64 * (j))
#define XB_TOP      3328
#define XB_TOPGEN   3392
#define XCD_BAR_WORDS 3456
#define XB_SPIN_CAP (1u << 22)
DI unsigned xb_ld(unsigned* p)              { return __hip_atomic_load(p, __ATOMIC_RELAXED, __HIP_MEMORY_SCOPE_AGENT); }
DI unsigned xb_add(unsigned* p, unsigned v) { return __hip_atomic_fetch_add(p, v, __ATOMIC_RELAXED, __HIP_MEMORY_SCOPE_AGENT); }
DI unsigned xb_xcc_id() { unsigned x; asm volatile("s_getreg_b32 %0, hwreg(20, 0, 4)" : "=s"(x)); return x & 0xFu; }
#define XB_SPIN(cond, bar) do { unsigned _sp = 0; while (cond) { __builtin_amdgcn_s_sleep(1); \
    if ((++_sp & 255u) == 0u) { if (xb_ld(&(bar)[XB_TMO])) break; if (_sp > XB_SPIN_CAP) { atomicAdd(&(bar)[XB_TMO], 1u); break; } } } } while (0)
DI void xcd_barrier_complete(unsigned* bar, unsigned x, unsigned& nloc, unsigned& nx) {
    const unsigned G = gridDim.x * gridDim.y * gridDim.z;
    unsigned sum, cnt, mine, sp = 0u;
    for (;;) {
        sum = 0u; cnt = 0u; mine = 0u;
#pragma unroll
        for (unsigned j = 0; j < 16; ++j) { const unsigned c = xb_ld(&bar[XB_XCNT(j)]); sum += c; cnt += (c > 0u) ? 1u : 0u; mine = (j == x) ? c : mine; }
        if (sum == G) break;
        __builtin_amdgcn_s_sleep(1);
        if ((++sp & 255u) == 0u) { if (xb_ld(&bar[XB_TMO])) break; if (sp > XB_SPIN_CAP) { atomicAdd(&bar[XB_TMO], 1u); break; } }
    }
    nloc = mine > 0u ? mine : 1u; nx = cnt > 0u ? cnt : 1u;
}
DI void xcd_barrier(unsigned* bar, volatile LAS unsigned* st, int tid) {
    asm volatile("s_waitcnt vmcnt(0)" ::: "memory");
    __syncthreads();
    if (tid == 0) {
        const unsigned x = xb_xcc_id();
        __builtin_amdgcn_s_waitcnt(0);
        unsigned nloc = st[0], nx = st[1];
        if (nloc == 0u) { xcd_barrier_complete(bar, x, nloc, nx); st[0] = nloc; st[1] = nx; }
        const unsigned old = xb_add(&bar[XB_XSUB(x)], 1u);
        const unsigned gen = old / nloc;
        if (old + 1u == (gen + 1u) * nloc) {
            __builtin_amdgcn_fence(__ATOMIC_RELEASE, "agent");
            asm volatile("s_waitcnt vmcnt(0)" ::: "memory");
            const unsigned og = xb_add(&bar[XB_TOP], 1u);
            const unsigned tg = og / nx;
            if (og + 1u == (tg + 1u) * nx) xb_add(&bar[XB_TOPGEN], 1u);
            else XB_SPIN(xb_ld(&bar[XB_TOPGEN]) == tg, bar);
            __builtin_amdgcn_fence(__ATOMIC_ACQUIRE, "agent");
            xb_add(&bar[XB_XGEN(x)], 1u);
            asm volatile("s_waitcnt vmcnt(0)" ::: "memory");
        } else {
            XB_SPIN(xb_ld(&bar[XB_XGEN(x)]) == gen, bar);
            __builtin_amdgcn_fence(__ATOMIC_ACQUIRE, "agent");
            asm volatile("s_waitcnt vmcnt(0)" ::: "memory");
        }
    }
    __syncthreads();
}

#define REFRESH() do { int w_ = wave0, b_ = blockIdx.x, g_ = gridDim.x; asm volatile("" : "+s"(w_), "+s"(b_), "+s"(g_)); \
    int l_; asm volatile("v_mbcnt_lo_u32_b32 %0, -1, 0\n\tv_mbcnt_hi_u32_b32 %0, -1, %0" : "=v"(l_)); \
    F.lane = l_; F.wave = w_; F.tid = w_ * 64 + l_; F.bid = b_; F.G = g_; F.gw = b_ * 8 + w_; F.ngw = g_ * 8; } while (0)
#define XBAR() xcd_barrier((unsigned*)(F.wsp() + WS_CTL), (volatile LAS unsigned*)(F.lds + LDS_PT + 232), F.tid)
#if REP_SYNC > 1
#define GSYNC() do { XBAR(); XBAR(); REFRESH(); } while (0)
#else
#define GSYNC() do { REFRESH(); XBAR(); REFRESH(); } while (0)
#endif
#define WSP(off) (F.wsp() + (off))
#define WL(off) (F.wsp() + WS_W + (size_t)l * WL_STRIDE + (off))
#define MSL(off) (F.wsp() + WS_MISC + (size_t)l * MS_L + (off))
#define CTL(off) (F.wsp() + WS_CTL + CT_BASE + (size_t)l * CT_L + (off))
__global__ void __launch_bounds__(512, 2) mk_fwd(Params p) {
    extern __shared__ __attribute__((aligned(16))) unsigned char lds_raw[];
    cg::grid_group grid = cg::this_grid();
    Frame F;
    F.lds = (LAS unsigned char*)lds_raw; F.pt = (LAS const unsigned long long*)(F.lds + LDS_PT);
    const int wave0 = __builtin_amdgcn_readfirstlane((int)threadIdx.x >> 6);
    REFRESH();
    {
        LAS unsigned long long* ptw = (LAS unsigned long long*)(F.lds + LDS_PT);
        if (F.tid < 26) ptw[F.tid] = (unsigned long long)p.in[F.tid];
        if (F.tid == 26) ptw[26] = (unsigned long long)p.out;
        if (F.tid == 27) ptw[27] = (unsigned long long)p.ws;
        if (F.tid == 28) ptw[29] = 0ull;
        if (F.tid == 0) (void)xb_add((unsigned*)p.ws + XB_XCNT(xb_xcc_id()), 1u);
    }
    __syncthreads();

    PH(2, convert_rows_stats(F, F.in(0), (bf16_t*)WSP(WS_ACT), (unsigned long long*)WSP(WS_SSX)); REFRESH(););
    { unsigned long long* z = (unsigned long long*)WSP(WS_SSX) + (size_t)NT * 2; for (int i = F.bid * 512 + F.tid; i < (NL - 1) * NT * 2; i += F.G * 512) z[i] = 0ull; }
    { unsigned long long* z = (unsigned long long*)WSP(WS_SST); for (int i = F.bid * 512 + F.tid; i < NL * NT * 2; i += F.G * 512) z[i] = 0ull; }
    PH(0, prologue_a(F, 0, F.gw, F.ngw); REFRESH(););
    if (F.G == 0x7fffffff) grid.sync();
    GSYNC();
    PH(1, prologue_b(F); REFRESH(););
    if (F.G != 256) { prologue_a(F, 1, F.gw, F.ngw); __syncthreads(); REFRESH(); }
    else if (F.bid >= 128) { prologue_a(F, 1, (F.bid - 128) * 8 + F.wave, 1024); __syncthreads(); REFRESH(); }

#if STAGE >= 2
#pragma unroll 1
    for (int l = 0; l < NL; ++l) {
        REFRESH();
        { pg8::APlain g{(l == 0) ? (const char*)WSP(WS_ACT) : (const char*)F.out(), (const char*)WL(WO_WIN), 1024}; pg8::StaticOrder S; S.init(NT / 256, PW / 256, F.G, F.bid);
          pg8::EpiBf16 E{(bf16_t*)WSP(WS_PROJ), PW, (const unsigned long long*)WSP(WS_SSX) + (size_t)l * NT * 2}; pg8::gemm_phase<pg8::EpiBf16, pg8::APlain, true>(F.lds, g, S, E, F.tid); }
#if REP_INPROJ > 1
        REFRESH();
        { pg8::APlain g{(l == 0) ? (const char*)WSP(WS_ACT) : (const char*)F.out(), (const char*)WL(WO_WIN), 1024}; pg8::StaticOrder S; S.init(NT / 256, PW / 256, F.G, F.bid);
          pg8::EpiBf16 E{(bf16_t*)WSP(WS_PROJ), PW, (const unsigned long long*)WSP(WS_SSX) + (size_t)l * NT * 2}; pg8::gemm_phase<pg8::EpiBf16, pg8::APlain, true>(F.lds, g, S, E, F.tid); }
#endif
        GSYNC();
#define LOCAL_HANDOFF() do { asm volatile("s_waitcnt vmcnt(0)" ::: "memory"); __syncthreads(); if (F.tid == 0) { __builtin_amdgcn_fence(__ATOMIC_ACQUIRE, "agent"); asm volatile("s_waitcnt vmcnt(0)" ::: "memory"); } __syncthreads(); } while (0)
        if (F.G == 256) {
            if (F.bid < 48) {
                REFRESH();
                { pg8::ACompress g{(const char*)WSP(WS_PROJ), (const char*)WL(WO_W1)}; pg8::StaticOrder S; S.init_run(F.bid, 0, 1);
                  pg8::EpiCmpHid E{(bf16_t*)WSP(WS_HIDC), (const float*)CTL(CT_CB1)}; pg8::gemm_phase<pg8::EpiCmpHid, pg8::ACompress, true>(F.lds, g, S, E, F.tid); }
                REFRESH(); LOCAL_HANDOFF(); REFRESH();
                { const int pm = F.bid, it = (pm / 24) * 192 + (pm % 24) * 8 + F.wave;
                  compress2_phase(F, (const bf16_t*)WSP(WS_HIDC), (const bf16_t*)CTL(CT_W2T), F.in(7) + (size_t)l * 2 * 64, (bf16_t*)WSP(WS_KC), (bf16_t*)WSP(WS_VCT), it, it + 1, 1); }
            } else if (F.bid < 80) {
                REFRESH();
                { pg8::ASsm1 g{(const char*)WSP(WS_UC), (const char*)WL(WO_SS1)}; pg8::StaticOrder S; S.init_run((F.bid - 48) * 4, 1, 4);
                  pg8::EpiSsm1 E{(float*)WSP(WS_YI), (float*)WSP(WS_HL)}; pg8::gemm_phase<pg8::EpiSsm1, pg8::ASsm1, true>(F.lds, g, S, E, F.tid); }
                REFRESH(); LOCAL_HANDOFF(); REFRESH();
                ssm_carry_phase(F, (const float*)WSP(WS_HL), (const f32x2*)CTL(CT_AB16), (const f32x2*)CTL(CT_AB1K), (bf16_t*)WSP(WS_HIN), F.bid - 48, F.bid - 47, 1);
            } else {
                REFRESH();
                vtranspose_phase(F, (const bf16_t*)WSP(WS_PROJ), (bf16_t*)WSP(WS_VTS), (bf16_t*)WSP(WS_VTW), (bf16_t*)WSP(WS_KFS), (unsigned*)WSP(WS_CTL) + 3584 + l, 80);
                __syncthreads(); REFRESH();
                { pg8::ASsm1 g{(const char*)WSP(WS_UC), (const char*)WL(WO_SS1)}; pg8::StaticOrder S; S.init(128, 1, 176, F.bid - 80);
                  pg8::EpiSsm1 E{(float*)WSP(WS_YI), (float*)WSP(WS_HL)}; pg8::gemm_phase<pg8::EpiSsm1, pg8::ASsm1, true>(F.lds, g, S, E, F.tid); }
            }
            GSYNC();
        } else {
        PH(3, REFRESH(); vtranspose_phase(F, (const bf16_t*)WSP(WS_PROJ), (bf16_t*)WSP(WS_VTS), (bf16_t*)WSP(WS_VTW), (bf16_t*)WSP(WS_KFS), (unsigned*)WSP(WS_CTL) + 3584 + l, 48);
        __syncthreads(); REFRESH(););
        PH(4, REFRESH();
        { pg8::ACompress g{(const char*)WSP(WS_PROJ), (const char*)WL(WO_W1)}; pg8::StaticOrder S; S.init(48, 1, F.G, F.bid);
          pg8::EpiCmpHid E{(bf16_t*)WSP(WS_HIDC), (const float*)CTL(CT_CB1)}; pg8::gemm_phase<pg8::EpiCmpHid, pg8::ACompress, true>(F.lds, g, S, E, F.tid); });
        PH(5, REFRESH();
        { pg8::ASsm1 g{(const char*)WSP(WS_UC), (const char*)WL(WO_SS1)}; pg8::StaticOrder S; S.init(128, 2, F.G, F.bid);
          pg8::EpiSsm1 E{(float*)WSP(WS_YI), (float*)WSP(WS_HL)}; pg8::gemm_phase<pg8::EpiSsm1, pg8::ASsm1, true>(F.lds, g, S, E, F.tid); });
        GSYNC();
        PH(6, compress2_phase(F, (const bf16_t*)WSP(WS_HIDC), (const bf16_t*)CTL(CT_W2T), F.in(7) + (size_t)l * 2 * 64, (bf16_t*)WSP(WS_KC), (bf16_t*)WSP(WS_VCT), F.gw, 2 * 192, F.ngw);
        __syncthreads(); REFRESH(););
        PH(7, ssm_carry_phase(F, (const float*)WSP(WS_HL), (const f32x2*)CTL(CT_AB16), (const f32x2*)CTL(CT_AB1K), (bf16_t*)WSP(WS_HIN), F.bid, 32, F.G); REFRESH(););
        GSYNC();
        }
        PH(8,         REFRESH();
        { pg8::ASsm2 g{(const char*)WSP(WS_HIN), (const char*)WL(WO_SS2)}; pg8::StaticOrder S; S.init(128, 1, F.G, F.bid);
          pg8::EpiSsm2 E{(const float*)WSP(WS_YI), (const bf16_t*)WSP(WS_PROJ), F.in(15) + (size_t)l * 256, (bf16_t*)WSP(WS_YS2)}; pg8::gemm_phase<pg8::EpiSsm2, pg8::ASsm2, true>(F.lds, g, S, E, F.tid); });
#if STAGE >= 3
        REFRESH();
        attn_phase(F, (const bf16_t*)WSP(WS_PROJ), (const bf16_t*)WSP(WS_KC), (const bf16_t*)WSP(WS_VCT), (const bf16_t*)WSP(WS_VTS), (const bf16_t*)WSP(WS_VTW), (bf16_t*)WSP(WS_OATT), (const unsigned*)WSP(WS_CTL) + 3584 + l, (float*)WSP(WS_PARK), (unsigned*)WSP(WS_CTL) + 3600 + 16 * l, (const bf16_t*)WSP(WS_KFS), (unsigned long long*)WSP(WS_SST) + (size_t)l * NT * 2);
#if REP_ATTN > 1
        REFRESH();
        attn_phase(F, (const bf16_t*)WSP(WS_PROJ), (const bf16_t*)WSP(WS_KC), (const bf16_t*)WSP(WS_VCT), (const bf16_t*)WSP(WS_VTS), (const bf16_t*)WSP(WS_VTW), (bf16_t*)WSP(WS_OATT), (const unsigned*)WSP(WS_CTL) + 3584 + l, (float*)WSP(WS_PARK), (unsigned*)WSP(WS_CTL) + 3600 + 16 * l, (const bf16_t*)WSP(WS_KFS), (unsigned long long*)WSP(WS_SST) + (size_t)l * NT * 2);
#endif
#else
        { unsigned* oz = (unsigned*)WSP(WS_OATT); for (size_t i = (size_t)F.bid * 512 + F.tid; i < (size_t)NT * 768 / 2; i += (size_t)F.G * 512) oz[i] = 0u; }
#endif
        GSYNC();
        PH(9,         REFRESH();
        { pg8::APlain g{(const char*)WSP(WS_YS2), (const char*)MSL(MS_WGLU), 256}; pg8::StaticOrder S; S.init(NT / 256, 2, F.G, F.bid);
          pg8::EpiGlu E{(bf16_t*)WSP(WS_OATT), F.in(17) + (size_t)l * 512, (unsigned long long*)WSP(WS_SST) + (size_t)l * NT * 2}; pg8::gemm_phase<pg8::EpiGlu, pg8::APlain, true>(F.lds, g, S, E, F.tid); });
        GSYNC();
        REFRESH();
        { pg8::APlain g{(const char*)WSP(WS_OATT), (const char*)WL(WO_WOUT), 1024}; pg8::StaticOrder S; S.init(NT / 256, 4, F.G, F.bid);
          pg8::EpiResB<true, 0> E{(l == 0) ? F.in(0) : (const float*)nullptr, (const bf16_t*)F.out(), (bf16_t*)F.out(), (const unsigned long long*)WSP(WS_SST) + (size_t)l * NT * 2, (unsigned long long*)nullptr}; pg8::gemm_phase<pg8::EpiResB<true, 0>, pg8::APlain, true>(F.lds, g, S, E, F.tid); }
        GSYNC();
#if STAGE >= 4
        PH(11, rmsnorm_rows_xb<1>(F, (const bf16_t*)F.out(), F.in(21) + (size_t)l * DM, WSP(WS_ACT)); REFRESH(););
        GSYNC();
        REFRESH();
        { pg8::APlain g{(const char*)WSP(WS_ACT), (const char*)WL(WO_WGU), 512, 0x7c7c7c7c, 0x7c7c7c7c}; pg8::StaticOrder S; S.init(NT / 256, 22, F.G, F.bid);
          pg8::EpiSwiglu8 E{(unsigned char*)WSP(WS_PROJ), 0.015625f * FP8FIX}; pg8::gemm_phase<pg8::EpiSwiglu8, pg8::APlain, true, true>(F.lds, g, S, E, F.tid); }
        GSYNC();
        REFRESH();
        { pg8::APlain g{(const char*)WSP(WS_PROJ), (const char*)WL(WO_WD), DFF / 2, 0x7b7b7b7b, 0x7b7b7b7b}; pg8::StaticOrder S; S.init(NT / 256, 4, F.G, F.bid);
          pg8::EpiResB<false, 8> E{(const float*)nullptr, (const bf16_t*)F.out(), (l == NL - 1) ? (bf16_t*)WSP(WS_XLAST) : (bf16_t*)F.out(), (const unsigned long long*)nullptr, (l == NL - 1) ? (unsigned long long*)nullptr : (unsigned long long*)WSP(WS_SSX) + (size_t)(l + 1) * NT * 2}; pg8::gemm_phase<pg8::EpiResB<false, 8>, pg8::APlain, true, true>(F.lds, g, S, E, F.tid); }
        GSYNC();
#endif
#if STAGE < 5
        break;
#endif
    }
    rmsnorm_rows_xb<2>(F, (const bf16_t*)WSP(WS_XLAST), F.in(25), F.out());
#else
    {
        const float* x0 = F.in(0); const float* fg = F.in(25); float* X = F.out();
        for (int m = F.gw; m < NT; m += F.ngw) {
            const f32x4* xr = (const f32x4*)(x0 + (size_t)m * DM) + F.lane; f32x4 v[4]; float s = 0.f;
#pragma unroll
            for (int j = 0; j < 4; ++j) { v[j] = xr[64 * j]; s += (v[j].x * v[j].x + v[j].y * v[j].y) + (v[j].z * v[j].z + v[j].w * v[j].w); }
            const float rstd = rsqrtf(wave_sum(s) * (1.f / DM) + 1e-6f);
            f32x4* o = (f32x4*)(X + (size_t)m * DM) + F.lane;
#pragma unroll
            for (int j = 0; j < 4; ++j) o[64 * j] = v[j] * rstd * ((const f32x4*)fg)[64 * j + F.lane];
        }
    }
#endif
}

extern "C" void kernel_launch(void* const* d_in, const int* in_sizes, int n_in, void* d_out, int out_size, void* d_ws, size_t ws_size, hipStream_t stream) {
    static int grid_blocks = 0;
    if (grid_blocks == 0) {
        if (n_in != 26 || ws_size < WS_END) { fprintf(stderr, "kernel_launch: unexpected n_in %d or ws_size %zu (< %zu)\n", n_in, ws_size, (size_t)WS_END); grid_blocks = -1; return; }
        int dev = 0, cus = 0, per_cu = 0;
        hipGetDevice(&dev);
        hipDeviceGetAttribute(&cus, hipDeviceAttributeMultiprocessorCount, dev);
        hipFuncSetAttribute((const void*)mk_fwd, hipFuncAttributeMaxDynamicSharedMemorySize, LDS_BYTES);
        hipOccupancyMaxActiveBlocksPerMultiprocessor(&per_cu, (const void*)mk_fwd, 512, LDS_BYTES);
        if (per_cu < 1) { fprintf(stderr, "kernel_launch: occupancy query says %d blocks per CU\n", per_cu); per_cu = 1; }
        grid_blocks = cus;
        (void)hipGetLastError();
    }
    if (grid_blocks < 0) return;
    if (hipMemsetAsync((char*)d_ws + WS_CTL, 0, 16384, stream) != hipSuccess) { fprintf(stderr, "kernel_launch: memset of the barrier words failed\n"); return; }
    Params p{};
    for (int i = 0; i < 26; ++i) p.in[i] = (const float*)d_in[i];
    p.out = (float*)d_out; p.ws = (unsigned char*)d_ws;
    void* args[] = {&p};
    hipError_t e = hipLaunchCooperativeKernel((const void*)mk_fwd, dim3(grid_blocks), dim3(512), args, LDS_BYTES, stream);
    if (e != hipSuccess) fprintf(stderr, "cooperative launch failed: %s (grid %d)\n", hipGetErrorString(e), grid_blocks);
}
```

```cpp
#include <hip/hip_runtime.h>
#include <hip/hip_cooperative_groups.h>
#include <cstdio>
#include <cstdint>
namespace cg = cooperative_groups;

#ifndef STAGE
#define STAGE 99
#endif
#ifndef REP_ATTN
#define REP_ATTN 1
#endif
#ifndef REP_B1
#define REP_B1 1
#endif
#ifndef REP_B2
#define REP_B2 1
#endif
#ifndef REP_B3
#define REP_B3 1
#endif
#ifndef REP_TK
#define REP_TK 1
#endif
#ifndef FP8FIX
#define FP8FIX 1.0f
#endif
#ifndef PROBE_DUP
#define PROBE_DUP 0
#endif
#define PH(bit, ...) do { __VA_ARGS__ if (PROBE_DUP & (1 << (bit))) { __VA_ARGS__ } } while (0)
#ifndef REP_GU
#define REP_GU 1
#endif
#ifndef REP_INPROJ
#define REP_INPROJ 1
#endif
#ifndef REP_SYNC
#define REP_SYNC 1
#endif

#define DI __device__ __forceinline__
#define LAS __attribute__((address_space(3)))
typedef unsigned short bf16_t;
typedef short bf16x8 __attribute__((ext_vector_type(8)));
typedef short s16x4 __attribute__((ext_vector_type(4)));
typedef float f32x4 __attribute__((ext_vector_type(4)));
typedef float f32x2 __attribute__((ext_vector_type(2)));
typedef float f32x16 __attribute__((ext_vector_type(16)));
typedef unsigned u32x4 __attribute__((ext_vector_type(4)));
typedef unsigned u32x2 __attribute__((ext_vector_type(2)));
typedef __bf16 bf2_t __attribute__((ext_vector_type(2)));
typedef int i32x8 __attribute__((ext_vector_type(8)));
typedef int i32x4 __attribute__((ext_vector_type(4)));

DI float clamp8(float v) { return fminf(fmaxf(v, -440.f), 440.f); }
DI unsigned pk4_fp8(float a, float b, float c, float d) { int w = 0; w = __builtin_amdgcn_cvt_pk_fp8_f32(clamp8(a), clamp8(b), w, false); w = __builtin_amdgcn_cvt_pk_fp8_f32(clamp8(c), clamp8(d), w, true); return (unsigned)w; }
DI unsigned pk2(float lo, float hi) { f32x2 v = {lo, hi}; return __builtin_bit_cast(unsigned, __builtin_convertvector(v, bf2_t)); }
DI bf16_t f2bf(float f) { return (bf16_t)(pk2(f, 0.f) & 0xffffu); }
DI float bf2f(bf16_t u) { return __uint_as_float((unsigned)u << 16); }
DI float bflo(unsigned w) { return __uint_as_float(w << 16); }
DI float bfhi(unsigned w) { return __uint_as_float(w & 0xffff0000u); }
DI float fexp2(float x) { return __builtin_amdgcn_exp2f(x); }
DI float sigmoidf_(float x) { return __builtin_amdgcn_rcpf(1.0f + __builtin_amdgcn_exp2f(-1.4426950408889634f * x)); }
DI float gelu_tanh(float x) { const float y = 0.7978845608028654f * (x + 0.044715f * x * x * x); return x * __builtin_amdgcn_rcpf(1.0f + __builtin_amdgcn_exp2f(-2.8853900817779268f * y)); }
template <int CTRL> DI float dppf(float v) { return __builtin_bit_cast(float, __builtin_amdgcn_update_dpp(0, __builtin_bit_cast(int, v), CTRL, 0xF, 0xF, false)); }
struct F2 { float lo, hi; };
DI F2 halves32(float v) { const auto r = __builtin_amdgcn_permlane32_swap(__float_as_uint(v), __float_as_uint(v), false, false); return {__uint_as_float(r[0]), __uint_as_float(r[1])}; }
DI F2 rows16(float v) { const auto r = __builtin_amdgcn_permlane16_swap(__float_as_uint(v), __float_as_uint(v), false, false); return {__uint_as_float(r[0]), __uint_as_float(r[1])}; }
DI float xor32_sum(float v) { const F2 p = halves32(v); return p.lo + p.hi; }
DI float xor32_max(float v) { const F2 p = halves32(v); return fmaxf(p.lo, p.hi); }
DI float xor16_sum(float v) { const F2 p = rows16(v); return p.lo + p.hi; }
DI float xor16_max(float v) { const F2 p = rows16(v); return fmaxf(p.lo, p.hi); }
DI float wave_sum(float v) {
    v += dppf<0xB1>(v); v += dppf<0x4E>(v); v += dppf<0x141>(v); v += dppf<0x140>(v);
    return xor32_sum(xor16_sum(v));
}

DI unsigned wave_max_u32(unsigned v) {
    v = max(v, (unsigned)__builtin_amdgcn_update_dpp(0, (int)v, 0xB1, 0xF, 0xF, false));
    v = max(v, (unsigned)__builtin_amdgcn_update_dpp(0, (int)v, 0x4E, 0xF, 0xF, false));
    v = max(v, (unsigned)__builtin_amdgcn_update_dpp(0, (int)v, 0x141, 0xF, 0xF, false));
    v = max(v, (unsigned)__builtin_amdgcn_update_dpp(0, (int)v, 0x140, 0xF, 0xF, false));
    const unsigned a = __builtin_amdgcn_readlane(v, 0), b = __builtin_amdgcn_readlane(v, 16), c = __builtin_amdgcn_readlane(v, 32), d = __builtin_amdgcn_readlane(v, 48);
    return max(max(a, b), max(c, d));
}

constexpr int NB = 2, SEQ = 16384, DM = 1024, NT = NB * SEQ, NL = 2;
constexpr int PW = 2304;
constexpr int C_Q = 0, C_KC = 768, C_VC = 960, C_KS = 1152, C_VS = 1344, C_KW = 1536, C_VW = 1728, C_U = 1920, C_G = 2176;
constexpr int DFF = 2816;
constexpr float L2E = 1.4426950408889634f;

constexpr size_t MiB = 1u << 20;
constexpr size_t WS_CTL = 0;
constexpr size_t WS_W = 1 * MiB;
constexpr size_t WL_STRIDE = 32 * MiB;
constexpr size_t WO_WIN = 0;
constexpr size_t WO_WOUT = 5 * MiB;
constexpr size_t WO_WGU = 7 * MiB;
constexpr size_t WO_WD = 18 * MiB;
constexpr size_t WO_W1 = 24 * MiB;
constexpr size_t WO_SS1 = 26 * MiB;
constexpr size_t WO_SS2 = 30 * MiB;
constexpr size_t CT_L = 256 * 1024;
constexpr size_t CT_BASE = 64 * 1024;
constexpr size_t CT_AB16 = 0;
constexpr size_t CT_AB1K = 8 * 1024;
constexpr size_t CT_CB1 = 16 * 1024;
constexpr size_t CT_W2T = 20 * 1024;
constexpr size_t CT_WGLU = 84 * 1024;
constexpr size_t WS_ACT = WS_W + 2 * WL_STRIDE;
constexpr size_t WS_PROJ = WS_ACT + 64 * MiB;
constexpr size_t WS_OATT = WS_PROJ + 176 * MiB;
constexpr size_t WS_OSSM = WS_OATT + 48 * MiB;
constexpr size_t WS_YS2 = WS_OSSM + 16 * MiB;
constexpr size_t WS_YI = WS_ACT;
constexpr size_t WS_HL = WS_YS2 + 16 * MiB;
constexpr size_t WS_HIN = WS_HL + 16 * MiB;
constexpr size_t WS_VTS = WS_HIN + 16 * MiB;
constexpr size_t WS_VTW = WS_VTS + 12 * MiB;
constexpr size_t WS_KC = WS_VTW + 12 * MiB;
constexpr size_t WS_VCT = WS_KC + 1 * MiB;
constexpr size_t WS_HIDC = WS_VCT + 1 * MiB;
constexpr size_t WS_MISC = WS_HIDC + 6 * MiB;
constexpr size_t WS_PARK = WS_MISC + 4 * MiB;
constexpr size_t WS_KFS = WS_PARK + 16 * MiB;
constexpr size_t WS_SST = WS_KFS + 12 * MiB;
constexpr size_t WS_SSX = WS_SST + 1 * MiB;
constexpr size_t WS_UC = WS_SSX + 1 * MiB;
constexpr size_t WS_END = WS_UC + 16 * MiB;
constexpr size_t WS_XLAST = WS_PROJ + 96 * MiB;
constexpr size_t MS_L = 2 * MiB;
constexpr size_t MS_MTAB = 0;
constexpr size_t MS_CBP = 256 * 1024;
constexpr size_t MS_WGLU = 512 * 1024;
constexpr size_t MS_BBAR = 1024 * 1024;
constexpr size_t MS_FTAB = 1024 * 1024 + 128 * 1024;

constexpr int LDS_BYTES = 143360;

struct Params { const float* in[26]; float* out; unsigned char* ws; };

namespace pg8 {
constexpr int BM = 256, BK = 64, HALF = 128, HTB = HALF * BK * 2, STAGE_BYTES = 8 * HTB, NXCD = 8, WGM = 8;
__host__ __device__ __forceinline__ int lds_byte(int r, int c) { const int st = (r >> 4) * 2 + (c >> 5), rr = r & 15, cc = c & 31, ob = rr * 64 + cc * 2; return st * 1024 + (ob ^ (((ob >> 9) & 1) << 5)); }
__host__ __device__ __forceinline__ void stage_rc(int b, int& R, int& C) { const int st = b / 1024, sb = b % 1024, swz = sb ^ (((sb >> 9) & 1) << 5); R = (st >> 1) * 16 + swz / 64; C = (st & 1) * 32 + (swz % 64) / 2; }
__host__ __device__ __forceinline__ int perm32(int rho) { const int n = rho >> 4, i = rho & 15; return 8 * (i >> 2) + 4 * n + (i & 3); }
struct Unit { int pm, pn, part; };
constexpr int ROWTAB_OFF = STAGE_BYTES;
struct StaticOrder {
    int nM, nN, nwg, G, c, lmode = 0, lbase = 0, lpn = 0, lcount = 0;
    __device__ void init(int nM_, int nN_, int G_, int c_) { nM = nM_; nN = nN_; nwg = nM * nN; G = G_; c = c_; lmode = 0; }
    __device__ void init_run(int base, int pn, int count) { lmode = 1; lbase = base; lpn = pn; lcount = count; nM = 0; nN = 0; nwg = 0; G = 1; c = 0; }
    __device__ bool next(int i, Unit& u) const {
        if (lmode == 1) { if (i >= lcount) return false; u.pm = lbase + i; u.pn = lpn; return true; }
        const long L = (long)i * G + c; if (L >= nwg) return false;
        int wgid = (int)L; { const int q = nwg / NXCD, r = nwg % NXCD, xcd = wgid % NXCD, off = wgid / NXCD; wgid = (xcd < r ? xcd * (q + 1) : r * (q + 1) + (xcd - r) * q) + off; }
        const int nig = WGM * nN, gid = wgid / nig, fm = gid * WGM, gsz = (nM - fm) < WGM ? (nM - fm) : WGM;
        u.pm = fm + ((wgid % nig) % gsz); u.pn = (wgid % nig) / gsz; return true;
    }
};

template <class Epi, class Addr, bool ALIGN_EPI, bool FP8 = false>
__device__ __forceinline__ void gemm_phase(LAS unsigned char* lds, const Addr& g, const StaticOrder& S, const Epi& E, int tid) {
    asm volatile("" : "+v"(tid));
    const int wid = __builtin_amdgcn_readfirstlane(tid >> 6), lane = tid & 63, wr = wid >> 2, wc = wid & 3, fr = lane & 15, fq = lane >> 4;
    const int K = g.K(), nt0 = K / BK;
    unsigned voffA[2], voffB[2];
#pragma unroll
    for (int i = 0; i < 2; ++i) { int R, C; stage_rc(tid * 16 + i * 8192, R, C); const int Rb = Epi::PERM ? ((R & ~31) + perm32(R & 31)) : R;
        voffA[i] = (unsigned)R * g.a_row_bytes() + g.a_col_off(C); voffB[i] = (unsigned)(Rb * K + C) * 2u; }
    const size_t kstepA = g.a_kstep(), kstepB = (size_t)(BK * 2);
    const size_t hstepA = (size_t)HALF * g.a_row_bytes(), hstepB = (size_t)HALF * K * 2;
    const unsigned ldsw = (unsigned)wid * 1024u;
    const int aoff = lds_byte(wr * 64 + fr, fq * 8), boff = lds_byte(wc * 32 + fr, fq * 8);
#define PG8_SA(b, h) (((b) * 2 + (h)) * HTB)
#define PG8_SB(b, h) ((4 + (b) * 2 + (h)) * HTB)
#define PG8_STAGE(bufoff, gbase, voff) do { _Pragma("unroll") for (int _i = 0; _i < 2; ++_i) \
        __builtin_amdgcn_global_load_lds((const unsigned*)((const char*)(gbase) + (voff)[_i]), (LAS unsigned*)(lds + (bufoff) + ldsw + _i * 8192), 16, 0, 0); } while (0)
#define PG8_LDA(dst, b, h) do { _Pragma("unroll") for (int m = 0; m < 4; ++m) _Pragma("unroll") for (int k = 0; k < 2; ++k) dst[m][k] = *(const LAS bf16x8*)(lds + PG8_SA(b, h) + aoff + m * 2048 + k * 1024); } while (0)
#define PG8_LDB(dst, b, h) do { _Pragma("unroll") for (int n = 0; n < 2; ++n) _Pragma("unroll") for (int k = 0; k < 2; ++k) dst[n][k] = *(const LAS bf16x8*)(lds + PG8_SB(b, h) + boff + n * 2048 + k * 1024); } while (0)
#define PG8_CAT(x, y) __builtin_bit_cast(i32x8, __builtin_shufflevector((x), (y), 0, 1, 2, 3, 4, 5, 6, 7, 8, 9, 10, 11, 12, 13, 14, 15))
#define PG8_MMA(ai, bj, At, Bt) do { __builtin_amdgcn_s_setprio(1); _Pragma("unroll") for (int m = 0; m < 4; ++m) _Pragma("unroll") for (int n = 0; n < 2; ++n) { \
        if constexpr (FP8) { const i32x8 bw_ = PG8_CAT(Bt[n][0], Bt[n][1]), aw_ = PG8_CAT(At[m][0], At[m][1]); \
            asm volatile("v_mfma_f32_16x16x128_f8f6f4 %0, %1, %2, %0" : "+v"(acc[ai][bj][m][n]) : "v"(bw_), "v"(aw_));   } \
        else { _Pragma("unroll") for (int k = 0; k < 2; ++k) acc[ai][bj][m][n] = __builtin_amdgcn_mfma_f32_16x16x32_bf16(Bt[n][k], At[m][k], acc[ai][bj][m][n], 0, 0, 0); } } \
        __builtin_amdgcn_s_setprio(0); } while (0)
#define PG8_WAIT_V(n) asm volatile("s_waitcnt vmcnt(" #n ")" ::: "memory")
#define PG8_WAIT_L(n) asm volatile("s_waitcnt lgkmcnt(" #n ")" ::: "memory")
#define PG8_BAR __builtin_amdgcn_s_barrier()
#define PG8_SCHED __builtin_amdgcn_sched_barrier(0)
    Unit cur, nxt; int ui = 0;
    constexpr bool SPLIT = Epi::MID_T > 0;
    auto get_unit = [&](int i, Unit& u) -> bool { if constexpr (SPLIT) { const bool ok = S.next(i >> 1, u); u.part = i & 1; return ok; } else { const bool ok = S.next(i, u); u.part = 0; return ok; } };
    auto part_off = [&](const Unit& u) -> size_t { if constexpr (SPLIT) return (size_t)u.part * (Epi::MID_T * BK * 2); else return 0; };
    if (!get_unit(0, cur)) return;
    f32x4 acc[2][2][4][2];
#pragma unroll
    for (int a = 0; a < 2; ++a)
#pragma unroll
        for (int b = 0; b < 2; ++b)
#pragma unroll
            for (int m = 0; m < 4; ++m)
#pragma unroll
                for (int n = 0; n < 2; ++n) acc[a][b][m][n] = (f32x4){0.f, 0.f, 0.f, 0.f};
    bf16x8 At[4][2], B0[2][2], B1[2][2];
    const char* cA = g.a_base(cur) + part_off(cur); const char* cB = g.b_base(cur) + part_off(cur);
    PG8_STAGE(PG8_SB(0, 0), cB, voffB); PG8_STAGE(PG8_SB(0, 1), cB + hstepB, voffB); PG8_STAGE(PG8_SA(0, 0), cA, voffA); PG8_STAGE(PG8_SA(0, 1), cA + hstepA, voffA);
    if (wr == 1) PG8_BAR;
    PG8_WAIT_V(2); PG8_BAR;
    PG8_STAGE(PG8_SB(1, 0), cB + kstepB, voffB); PG8_STAGE(PG8_SA(1, 0), cA + kstepA, voffA); PG8_STAGE(PG8_SB(1, 1), cB + hstepB + kstepB, voffB);
    PG8_WAIT_V(6); PG8_BAR;
    for (;;) {
        const bool has_next = get_unit(ui + 1, nxt);
        const char* nA = has_next ? g.a_base(nxt) + part_off(nxt) : cA; const char* nB = has_next ? g.b_base(nxt) + part_off(nxt) : cB;
        int nt = nt0; if constexpr (SPLIT) nt = cur.part ? nt0 - Epi::MID_T : Epi::MID_T;
        for (int t = 0; t < nt; t += 2) {
            const bool last = (t == nt - 2);
            if constexpr (Epi::ROWTAB) {
                if (t == 0 && wid < 4 && cur.part == 0) {
                    int l_; asm volatile("v_mbcnt_lo_u32_b32 %0, -1, 0\n\tv_mbcnt_hi_u32_b32 %0, -1, %0" : "=v"(l_));
                    __builtin_amdgcn_global_load_lds((const unsigned*)(E.rowtab + ((size_t)cur.pm * BM + wid * 64 + l_) * 2), (LAS unsigned*)(lds + ROWTAB_OFF + ((SPLIT ? (ui >> 1) : ui) & 1) * 4096 + wid * 1024), 16, 0, 0); } }
            const char* a1 = cA + (size_t)(t + 1) * kstepA;
            const char* a2 = last ? nA : cA + (size_t)(t + 2) * kstepA; const char* b2 = last ? nB : cB + (size_t)(t + 2) * kstepB;
            const char* a3 = a2 + kstepA; const char* b3 = b2 + kstepB;
            PG8_LDB(B0, 0, 0); PG8_LDB(B1, 0, 1); PG8_SCHED; PG8_LDA(At, 0, 0); PG8_STAGE(PG8_SA(1, 1), a1 + hstepA, voffA);
            PG8_WAIT_V(8); PG8_WAIT_L(0); PG8_BAR; PG8_MMA(0, 0, At, B0); PG8_MMA(0, 1, At, B1); PG8_BAR; PG8_SCHED;
            PG8_LDA(At, 0, 1); PG8_STAGE(PG8_SB(0, 0), b2, voffB); PG8_STAGE(PG8_SB(0, 1), b2 + hstepB, voffB); PG8_STAGE(PG8_SA(0, 0), a2, voffA);
            PG8_WAIT_V(8); PG8_WAIT_L(0); PG8_BAR; PG8_MMA(1, 0, At, B0); PG8_MMA(1, 1, At, B1); PG8_BAR; PG8_SCHED;
            PG8_LDB(B0, 1, 0); PG8_LDB(B1, 1, 1); PG8_SCHED; PG8_LDA(At, 1, 0); PG8_STAGE(PG8_SA(0, 1), a2 + hstepA, voffA);
            PG8_WAIT_V(8); PG8_WAIT_L(0); PG8_BAR; PG8_MMA(0, 0, At, B0); PG8_MMA(0, 1, At, B1); PG8_BAR; PG8_SCHED;
            PG8_LDA(At, 1, 1); PG8_STAGE(PG8_SB(1, 0), b3, voffB); PG8_STAGE(PG8_SB(1, 1), b3 + hstepB, voffB); PG8_STAGE(PG8_SA(1, 0), a3, voffA);
            PG8_WAIT_V(8); PG8_WAIT_L(0); PG8_BAR; PG8_MMA(1, 0, At, B0); PG8_MMA(1, 1, At, B1); PG8_BAR; PG8_SCHED;
        }
        if constexpr (ALIGN_EPI) { if (wr == 0) PG8_BAR; }
        if constexpr (FP8) asm volatile("s_nop 15\n\ts_nop 15" ::: "memory");
        { int le_; asm volatile("v_mbcnt_lo_u32_b32 %0, -1, 0\n\tv_mbcnt_hi_u32_b32 %0, -1, %0" : "=v"(le_)); const int fr_e = le_ & 15, fq_e = le_ >> 4;
          if constexpr (Epi::ROWTAB) {
              const LAS unsigned long long* tab = (const LAS unsigned long long*)(lds + ROWTAB_OFF + ((SPLIT ? (ui >> 1) : ui) & 1) * 4096);
              if (SPLIT && cur.part == 0) {
                  const LAS unsigned long long* tb = tab + (wr * 64 + fr_e) * 2;
#pragma unroll
                  for (int a = 0; a < 2; ++a)
#pragma unroll
                      for (int m = 0; m < 4; ++m) { const float ratio = Epi::row_ratio(tb[(a * HALF + m * 16) * 2], tb[(a * HALF + m * 16) * 2 + 1]);
#pragma unroll
                          for (int b = 0; b < 2; ++b)
#pragma unroll
                              for (int n = 0; n < 2; ++n) acc[a][b][m][n] = acc[a][b][m][n] * ratio; }
              } else E(acc, cur, wr, wc, fr_e, fq_e, tab);
          } else E(acc, cur, wr, wc, fr_e, fq_e); }
        if (!has_next) break;
        if (!SPLIT || cur.part != 0) {
#pragma unroll
        for (int a = 0; a < 2; ++a)
#pragma unroll
            for (int b = 0; b < 2; ++b)
#pragma unroll
                for (int m = 0; m < 4; ++m)
#pragma unroll
                    for (int n = 0; n < 2; ++n) acc[a][b][m][n] = (f32x4){0.f, 0.f, 0.f, 0.f};
        }
        cur = nxt; cA = nA; cB = nB; ++ui;
        if constexpr (ALIGN_EPI) { if (wr == 1) PG8_BAR; }
    }
    PG8_WAIT_V(0);
    if constexpr (!ALIGN_EPI) { if (wr == 0) PG8_BAR; }
    PG8_BAR;
#undef PG8_SA
#undef PG8_SB
#undef PG8_STAGE
#undef PG8_LDA
#undef PG8_LDB
#undef PG8_MMA
#undef PG8_CAT
#undef PG8_WAIT_V
#undef PG8_WAIT_L
#undef PG8_BAR
#undef PG8_SCHED
}

struct APlain {
    const char* A; const char* Bt; int k; int sw = 0x7f7f7f7f, sa = 0x7f7f7f7f;
    DI int scale_w() const { return sw; } DI int scale_a() const { return sa; }
    DI int K() const { return k; }
    DI unsigned a_row_bytes() const { return (unsigned)k * 2u; }
    DI unsigned a_kstep() const { return 128u; }
    DI unsigned a_col_off(int C) const { return (unsigned)C * 2u; }
    DI const char* a_base(const Unit& u) const { return A + (size_t)u.pm * 256 * k * 2; }
    DI const char* b_base(const Unit& u) const { return Bt + (size_t)u.pn * 256 * k * 2; }
};
struct ACompress {
    const char* proj; const char* w1t;
    DI int scale_w() const { return 0x7f7f7f7f; } DI int scale_a() const { return 0x7f7f7f7f; }
    DI int K() const { return 2048; }
    DI unsigned a_row_bytes() const { return 16u * PW * 2u; }
    DI unsigned a_kstep() const { return (unsigned)PW * 2u; }
    DI unsigned a_col_off(int C) const { return (unsigned)C * 2u; }
    DI const char* a_base(const Unit& u) const { const int kv = u.pm / 24, r = u.pm % 24, bh = r >> 2, qt = r & 3, b = bh / 3, h = bh % 3;
        return proj + ((size_t)(b * SEQ + 4096 * qt) * PW + (kv ? C_VC : C_KC) + h * 64) * 2; }
    DI const char* b_base(const Unit& u) const { return w1t + (size_t)(u.pm / 24) * 256 * 2048 * 2; }
};
struct ASsm1 {
    const char* uc; const char* ss1;
    DI int scale_w() const { return 0x7f7f7f7f; } DI int scale_a() const { return 0x7f7f7f7f; }
    DI int K() const { return 256; }
    DI unsigned a_row_bytes() const { return 512u; }
    DI unsigned a_kstep() const { return 128u; }
    DI unsigned a_col_off(int C) const { return (unsigned)C * 2u; }
    DI const char* a_base(const Unit& u) const { const int bg = u.pm >> 2, qt = u.pm & 3; return uc + ((size_t)bg * SEQ + 4096 * qt) * 32; }
    DI const char* b_base(const Unit& u) const { const int gi = (u.pm >> 2) & 15; return ss1 + ((size_t)gi * 512 + (size_t)u.pn * 256) * 256 * 2; }
};
struct ASsm2 {
    const char* hin; const char* ss2;
    DI int scale_w() const { return 0x7f7f7f7f; } DI int scale_a() const { return 0x7f7f7f7f; }
    DI int K() const { return 256; }
    DI unsigned a_row_bytes() const { return 512u; }
    DI unsigned a_kstep() const { return 128u; }
    DI unsigned a_col_off(int C) const { return (unsigned)C * 2u; }
    DI const char* a_base(const Unit& u) const { return hin + (size_t)u.pm * 256 * 512; }
    DI const char* b_base(const Unit& u) const { const int gi = (u.pm >> 2) & 15; return ss2 + (size_t)gi * 256 * 256 * 2; }
};

struct EpiBf16 {
    static constexpr bool PERM = true; static constexpr bool ROWTAB = true; static constexpr int MID_T = -1;
    bf16_t* O; int ldc; const unsigned long long* rowtab;
    static DI float row_ratio(unsigned long long, unsigned long long) { return 1.f; }
    DI void operator()(const f32x4 (&acc)[2][2][4][2], const Unit& u, int wr, int wc, int fr, int fq, const LAS unsigned long long* tab) const {
        const int row0 = u.pm * BM + wr * 64 + fr, col0 = u.pn * BM + wc * 32 + 8 * fq;
        const int ubj = (u.pn == C_U / 256) ? 1 : ((u.pn == C_U / 256 + 1) ? 0 : -1);
#pragma unroll
        for (int ai = 0; ai < 2; ++ai)
#pragma unroll
            for (int m = 0; m < 4; ++m) { bf16_t* rowp = O + (size_t)(row0 + ai * HALF + m * 16) * ldc + col0;
                const float sc = rsqrtf((float)tab[(wr * 64 + fr + ai * HALF + m * 16) * 2] * (1.f / (1048576.f * DM)) + 1e-6f);
#pragma unroll
                for (int bj = 0; bj < 2; ++bj) { const f32x4 v0 = acc[ai][bj][m][0] * sc, v1 = acc[ai][bj][m][1] * sc;
                    u32x4 w; w.x = pk2(v0[0], v0[1]); w.y = pk2(v0[2], v0[3]); w.z = pk2(v1[0], v1[1]); w.w = pk2(v1[2], v1[3]);
                    *(u32x4*)(rowp + bj * HALF) = w;
                    if (bj == ubj) { const int row = row0 + ai * HALF + m * 16, ucol = col0 + bj * HALF - C_U;
                        bf16_t* uc = (bf16_t*)((unsigned char*)O + (WS_UC - WS_PROJ));
                        *(u32x4*)(uc + (((size_t)((row >> 14) * 16 + (ucol >> 4)) * SEQ + (row & (SEQ - 1))) * 16 + (ucol & 15))) = w; } } }
    }
};
struct EpiCmpHid {
    static constexpr bool PERM = true; static constexpr bool ROWTAB = false; static constexpr int MID_T = -1;
    bf16_t* O; const float* cb1;
    DI void operator()(const f32x4 (&acc)[2][2][4][2], const Unit& u, int wr, int wc, int fr, int fq) const {
        const int row0 = u.pm * BM + wr * 64 + fr, col0 = wc * 32 + 8 * fq; const float* bb = cb1 + (u.pm / 24) * 256;
        f32x4 bv[2][2];
#pragma unroll
        for (int bj = 0; bj < 2; ++bj)
#pragma unroll
            for (int n = 0; n < 2; ++n) bv[bj][n] = *(const f32x4*)(bb + col0 + bj * HALF + 4 * n);
#pragma unroll
        for (int ai = 0; ai < 2; ++ai)
#pragma unroll
            for (int m = 0; m < 4; ++m) { bf16_t* rowp = O + (size_t)(row0 + ai * HALF + m * 16) * 256 + col0;
#pragma unroll
                for (int bj = 0; bj < 2; ++bj) { f32x4 v0 = acc[ai][bj][m][0] + bv[bj][0], v1 = acc[ai][bj][m][1] + bv[bj][1];
#pragma unroll
                    for (int e = 0; e < 4; ++e) { v0[e] = gelu_tanh(v0[e]); v1[e] = gelu_tanh(v1[e]); }
                    u32x4 w; w.x = pk2(v0[0], v0[1]); w.y = pk2(v0[2], v0[3]); w.z = pk2(v1[0], v1[1]); w.w = pk2(v1[2], v1[3]);
                    *(u32x4*)(rowp + bj * HALF) = w; } }
    }
};
struct EpiSsm1 {
    static constexpr bool PERM = false; static constexpr bool ROWTAB = false; static constexpr int MID_T = -1;
    float* YI; float* HL;
    DI void operator()(const f32x4 (&acc)[2][2][4][2], const Unit& u, int wr, int wc, int fr, int fq) const {
        const int row0 = u.pm * BM + wr * 64 + fr, col0 = wc * 32 + 4 * fq;
#pragma unroll
        for (int ai = 0; ai < 2; ++ai)
#pragma unroll
            for (int m = 0; m < 4; ++m) { const size_t row = (size_t)(row0 + ai * HALF + m * 16);
                if (u.pn == 0) {
#pragma unroll
                    for (int bj = 0; bj < 2; ++bj)
#pragma unroll
                        for (int n = 0; n < 2; ++n) *(f32x4*)(YI + row * 256 + col0 + bj * HALF + n * 16) = acc[ai][bj][m][n];
                } else {
#pragma unroll
                    for (int n = 0; n < 2; ++n) *(f32x4*)(HL + row * 128 + col0 + n * 16) = acc[ai][0][m][n];
                } }
    }
};
struct EpiSsm2 {
    static constexpr bool PERM = false; static constexpr bool ROWTAB = false; static constexpr int MID_T = -1;
    const float* YI; const bf16_t* proj; const float* dskip; bf16_t* YS2;
    DI void operator()(const f32x4 (&acc)[2][2][4][2], const Unit& u, int wr, int wc, int fr, int fq) const {
        const int row0 = u.pm * BM + wr * 64 + fr, col0 = wc * 32 + 4 * fq;
        const int bg = u.pm >> 2, b = bg >> 4, gi = bg & 15;
        const f32x4 dsk = *(const f32x4*)(dskip + gi * 16 + 4 * fq);
#pragma unroll
        for (int ai = 0; ai < 2; ++ai)
#pragma unroll
            for (int m = 0; m < 4; ++m) { const int row = row0 + ai * HALF + m * 16; const int chunk = row & 1023;
#pragma unroll
                for (int bj = 0; bj < 2; ++bj)
#pragma unroll
                    for (int n = 0; n < 2; ++n) { const int col = col0 + bj * HALF + n * 16, tau = col >> 4;
                        const size_t tok = (size_t)b * SEQ + chunk * 16 + tau;
                        const f32x4 yi = *(const f32x4*)(YI + (size_t)row * 256 + col);
                        const u32x2 uw = *(const u32x2*)(proj + tok * PW + C_U + gi * 16 + 4 * fq);
                        f32x4 y = acc[ai][bj][m][n] + yi;
                        y[0] += dsk[0] * bflo(uw.x); y[1] += dsk[1] * bfhi(uw.x); y[2] += dsk[2] * bflo(uw.y); y[3] += dsk[3] * bfhi(uw.y);
                        u32x2 w; w.x = pk2(gelu_tanh(y[0]), gelu_tanh(y[1])); w.y = pk2(gelu_tanh(y[2]), gelu_tanh(y[3]));
                        *(u32x2*)(YS2 + tok * 256 + gi * 16 + 4 * fq) = w; } }
    }
};
struct EpiGlu {
    static constexpr bool PERM = true; static constexpr bool ROWTAB = false; static constexpr int MID_T = -1;
    bf16_t* O; const float* bglu; unsigned long long* sst;
    DI void operator()(const f32x4 (&acc)[2][2][4][2], const Unit& u, int wr, int wc, int fr, int fq) const {
        const int row0 = u.pm * BM + wr * 64 + fr, col0 = u.pn * HALF + wc * 32 + 8 * fq;
        f32x4 bvv[2], bgg[2];
#pragma unroll
        for (int n = 0; n < 2; ++n) { bvv[n] = *(const f32x4*)(bglu + col0 + 4 * n); bgg[n] = *(const f32x4*)(bglu + 256 + col0 + 4 * n); }
#pragma unroll
        for (int ai = 0; ai < 2; ++ai)
#pragma unroll
            for (int m = 0; m < 4; ++m) { const int row = row0 + ai * HALF + m * 16; bf16_t* rowp = O + (size_t)row * 1024 + 768 + col0;
                f32x4 o[2];
#pragma unroll
                for (int n = 0; n < 2; ++n) { const f32x4 v = acc[ai][0][m][n] + bvv[n], gt = acc[ai][1][m][n] + bgg[n];
#pragma unroll
                    for (int e = 0; e < 4; ++e) o[n][e] = v[e] * sigmoidf_(gt[e]); }
                u32x4 w; w.x = pk2(o[0][0], o[0][1]); w.y = pk2(o[0][2], o[0][3]); w.z = pk2(o[1][0], o[1][1]); w.w = pk2(o[1][2], o[1][3]);
                *(u32x4*)rowp = w;
                const f32x4 q = o[0] * o[0] + o[1] * o[1]; const float t = xor32_sum(xor16_sum((q[0] + q[1]) + (q[2] + q[3])));
                if (fq == 0) (void)__hip_atomic_fetch_add(sst + (size_t)row * 2 + 1, (unsigned long long)(t * 16777216.f), __ATOMIC_RELAXED, __HIP_MEMORY_SCOPE_AGENT); }
    }
};
struct EpiSwiglu8 {
    static constexpr bool PERM = true; static constexpr bool ROWTAB = false; static constexpr int MID_T = -1;
    unsigned char* O; float asc;
    DI void operator()(const f32x4 (&acc)[2][2][4][2], const Unit& u, int wr, int wc, int fr, int fq) const {
        const int row0 = u.pm * BM + wr * 64 + fr, col0 = u.pn * HALF + wc * 32 + 8 * fq;
#pragma unroll
        for (int ai = 0; ai < 2; ++ai)
#pragma unroll
            for (int m = 0; m < 4; ++m) { unsigned char* rowp = O + (size_t)(row0 + ai * HALF + m * 16) * DFF + col0;
                f32x4 o[2];
#pragma unroll
                for (int n = 0; n < 2; ++n) { const f32x4 gt = acc[ai][0][m][n] * asc, up = acc[ai][1][m][n] * asc;
#pragma unroll
                    for (int e = 0; e < 4; ++e) o[n][e] = 4.0f * gt[e] * sigmoidf_(gt[e]) * up[e]; }
                u32x2 w; w.x = pk4_fp8(o[0][0], o[0][1], o[0][2], o[0][3]); w.y = pk4_fp8(o[1][0], o[1][1], o[1][2], o[1][3]);
                *(u32x2*)rowp = w; }
    }
};
struct EpiSwiglu {
    static constexpr bool PERM = true; static constexpr bool ROWTAB = false; static constexpr int MID_T = -1;
    bf16_t* O;
    DI void operator()(const f32x4 (&acc)[2][2][4][2], const Unit& u, int wr, int wc, int fr, int fq) const {
        const int row0 = u.pm * BM + wr * 64 + fr, col0 = u.pn * HALF + wc * 32 + 8 * fq;
#pragma unroll
        for (int ai = 0; ai < 2; ++ai)
#pragma unroll
            for (int m = 0; m < 4; ++m) { bf16_t* rowp = O + (size_t)(row0 + ai * HALF + m * 16) * DFF + col0;
                f32x4 o[2];
#pragma unroll
                for (int n = 0; n < 2; ++n) { const f32x4 gt = acc[ai][0][m][n], up = acc[ai][1][m][n];
#pragma unroll
                    for (int e = 0; e < 4; ++e) o[n][e] = gt[e] * sigmoidf_(gt[e]) * up[e]; }
                u32x4 w; w.x = pk2(o[0][0], o[0][1]); w.y = pk2(o[0][2], o[0][3]); w.z = pk2(o[1][0], o[1][1]); w.w = pk2(o[1][2], o[1][3]);
                *(u32x4*)rowp = w; }
    }
};
struct EpiResF32 {
    static constexpr bool PERM = false; static constexpr bool ROWTAB = false; static constexpr int MID_T = -1;
    const float* base; float* out; float asc = 1.0f;
    DI void operator()(const f32x4 (&acc)[2][2][4][2], const Unit& u, int wr, int wc, int fr, int fq) const {
        const int row0 = u.pm * BM + wr * 64 + fr, col0 = u.pn * BM + wc * 32 + 4 * fq;
#pragma unroll
        for (int ai = 0; ai < 2; ++ai)
#pragma unroll
            for (int m = 0; m < 4; ++m) { const size_t off = (size_t)(row0 + ai * HALF + m * 16) * DM + col0;
#pragma unroll
                for (int bj = 0; bj < 2; ++bj)
#pragma unroll
                    for (int n = 0; n < 2; ++n) { const f32x4 bs = *(const f32x4*)(base + off + bj * HALF + n * 16);
                        *(f32x4*)(out + off + bj * HALF + n * 16) = bs + acc[ai][bj][m][n] * asc; } }
    }
};
template <bool MID, int ASC_EXP>
struct EpiResB {
    static constexpr bool PERM = true; static constexpr bool ROWTAB = MID; static constexpr int MID_T = MID ? 12 : -1;
    static constexpr float asc = 1.0f / (float)(1 << ASC_EXP);
    const float* basef; const bf16_t* baseb; bf16_t* out; const unsigned long long* rowtab; unsigned long long* ssx;
    static DI float rstd_a(unsigned long long v) { return rsqrtf((float)v * (1.f / (16777216.f * 768.f)) + 1e-6f); }
    static DI float rstd_s(unsigned long long v) { return rsqrtf((float)v * (1.f / (16777216.f * 256.f)) + 1e-6f); }
    static DI float row_ratio(unsigned long long a, unsigned long long s_) { return rstd_a(a) / rstd_s(s_); }
    template <bool F32B>
    DI void run(const f32x4 (&acc)[2][2][4][2], const Unit& u, int wr, int wc, int fr, int fq, const LAS unsigned long long* tab) const {
        const int row0 = u.pm * BM + wr * 64 + fr, col0 = u.pn * BM + wc * 32 + 8 * fq;
#pragma unroll
        for (int ai = 0; ai < 2; ++ai)
#pragma unroll
            for (int m = 0; m < 4; ++m) { const int row = row0 + ai * HALF + m * 16; const size_t off = (size_t)row * DM + col0; float sq = 0.f;
                float sc = asc; if constexpr (MID) sc = asc * rstd_s(tab[(wr * 64 + fr + ai * HALF + m * 16) * 2 + 1]);
#pragma unroll
                for (int bj = 0; bj < 2; ++bj) { f32x4 b0, b1;
                    if constexpr (F32B) { b0 = *(const f32x4*)(basef + off + bj * HALF); b1 = *(const f32x4*)(basef + off + bj * HALF + 4); }
                    else { const u32x4 b = *(const u32x4*)(baseb + off + bj * HALF); b0 = f32x4{bflo(b.x), bfhi(b.x), bflo(b.y), bfhi(b.y)}; b1 = f32x4{bflo(b.z), bfhi(b.z), bflo(b.w), bfhi(b.w)}; }
                    const f32x4 v0 = b0 + acc[ai][bj][m][0] * sc, v1 = b1 + acc[ai][bj][m][1] * sc;
                    u32x4 w; w.x = pk2(v0[0], v0[1]); w.y = pk2(v0[2], v0[3]); w.z = pk2(v1[0], v1[1]); w.w = pk2(v1[2], v1[3]);
                    *(u32x4*)(out + off + bj * HALF) = w;
                    if constexpr (!MID) { const f32x4 q = v0 * v0 + v1 * v1; sq += (q[0] + q[1]) + (q[2] + q[3]); } }
                if constexpr (!MID) { if (ssx != nullptr) { const float t = xor32_sum(xor16_sum(sq));
                    if (fq == 0) (void)__hip_atomic_fetch_add(ssx + (size_t)row * 2, (unsigned long long)(t * 1048576.f), __ATOMIC_RELAXED, __HIP_MEMORY_SCOPE_AGENT); } } }
    }
    DI void operator()(const f32x4 (&acc)[2][2][4][2], const Unit& u, int wr, int wc, int fr, int fq, const LAS unsigned long long* tab = nullptr) const {
        if (basef != nullptr) run<true>(acc, u, wr, wc, fr, fq, tab); else run<false>(acc, u, wr, wc, fr, fq, tab);
    }
};
}

struct Frame {
    LAS unsigned char* lds;
    LAS const unsigned long long* pt;
    int tid, lane, wave, G, gw, ngw, bid;
    DI const float* in(int i) const { const unsigned long long v = pt[i]; const unsigned lo = __builtin_amdgcn_readfirstlane((unsigned)v), hi = __builtin_amdgcn_readfirstlane((unsigned)(v >> 32));
        return (const float*)(const __attribute__((address_space(1))) float*)(((unsigned long long)hi << 32) | lo); }
    DI float* out() const { return (float*)in(26); }
    DI unsigned char* wsp() const { return (unsigned char*)in(27); }
};
constexpr int LDS_PT = LDS_BYTES - 256;

DI void transpose_item(const float* W, int K, int ldw, int nvalid, bf16_t* WT, int drow0, LAS float* scr, int k0, int n0, float scale, int lane, const float* gam64 = nullptr) {
    if (n0 + 32 <= nvalid) {
        const int n4 = (lane & 7) * 4; f32x4 v[8];
#pragma unroll
        for (int i = 0; i < 8; ++i) v[i] = *(const f32x4*)(W + (size_t)(k0 + 8 * i + (lane >> 3)) * ldw + n0 + n4);
        if (gam64 != nullptr) {
#pragma unroll
            for (int i = 0; i < 8; ++i) v[i] = v[i] * gam64[8 * i + (lane >> 3)];
        }
#pragma unroll
        for (int i = 0; i < 8; ++i) { LAS float* s = scr + (8 * i + (lane >> 3)) * 33 + n4; s[0] = v[i].x * scale; s[1] = v[i].y * scale; s[2] = v[i].z * scale; s[3] = v[i].w * scale; }
    } else {
    const int nn = n0 + (lane & 31); const bool ok = nn < nvalid;
#pragma unroll 8
    for (int i = 0; i < 32; ++i) { const int kk = 2 * i + (lane >> 5); scr[kk * 33 + (lane & 31)] = ok ? W[(size_t)(k0 + kk) * ldw + nn] * scale : 0.f; }
    }
    asm volatile("s_waitcnt lgkmcnt(0)" ::: "memory");
    const int c = lane & 7;
#pragma unroll
    for (int j = 0; j < 4; ++j) { const int n = (lane >> 3) + 8 * j; const LAS float* s = scr + (8 * c) * 33 + n;
        u32x4 o; o.x = pk2(s[0 * 33], s[1 * 33]); o.y = pk2(s[2 * 33], s[3 * 33]); o.z = pk2(s[4 * 33], s[5 * 33]); o.w = pk2(s[6 * 33], s[7 * 33]);
        *(u32x4*)(WT + (size_t)(drow0 + n) * K + k0 + 8 * c) = o; }
    asm volatile("s_waitcnt lgkmcnt(0)" ::: "memory");
}

DI void transpose_item_fp8(const float* W, int K, int ldw, unsigned char* WT, int drow0, LAS float* scr, int k0, int n0, float scale, int lane) {
    const int n4 = (lane & 7) * 4; f32x4 v[8];
#pragma unroll
    for (int i = 0; i < 8; ++i) v[i] = *(const f32x4*)(W + (size_t)(k0 + 8 * i + (lane >> 3)) * ldw + n0 + n4);
#pragma unroll
    for (int i = 0; i < 8; ++i) { LAS float* s = scr + (8 * i + (lane >> 3)) * 33 + n4; s[0] = v[i].x * scale; s[1] = v[i].y * scale; s[2] = v[i].z * scale; s[3] = v[i].w * scale; }
    asm volatile("s_waitcnt lgkmcnt(0)" ::: "memory");
    const int c = lane & 7;
#pragma unroll
    for (int j = 0; j < 4; ++j) { const int n = (lane >> 3) + 8 * j; const LAS float* s = scr + (8 * c) * 33 + n;
        u32x2 o; o.x = pk4_fp8(s[0 * 33], s[1 * 33], s[2 * 33], s[3 * 33]); o.y = pk4_fp8(s[4 * 33], s[5 * 33], s[6 * 33], s[7 * 33]);
        *(u32x2*)(WT + (size_t)(drow0 + n) * K + k0 + 8 * c) = o; }
    asm volatile("s_waitcnt lgkmcnt(0)" ::: "memory");
}

DI int win_dest_row(int n) {
    if (n < 1920) return n;
    if (n < 1956) return C_G + (n - 1920);
    return C_U + (n - 1956);
}

DI void prologue_a(Frame& F, int mode, int gw0, int ngw0) {
    LAS float* scr = (LAS float*)(F.lds + F.wave * 16640);
    constexpr int I_WIN = 16 * 72, I_WOUT = 16 * 32, I_WG = 16 * 88, I_WD = 44 * 32, I_W1 = 2 * 32 * 8, I_WGLU = 4 * 16, I_W2 = 2 * 4 * 2, I_CB = 64, I_M = 1024, I_TAB = 16;
    constexpr int PER_L = I_WIN + I_WOUT + 2 * I_WG + I_WD + I_W1 + I_WGLU + I_W2 + I_CB + I_M + I_TAB;
    const int lane = F.lane;
    constexpr int A1 = I_WIN, A3E = I_WIN + I_WOUT + 2 * I_WG + I_WD, A4E = A3E + I_W1, A5E = A4E + I_WGLU;
    for (int it = gw0; it < NL * PER_L; it += ngw0) {
        const int l = it / PER_L; int r = it % PER_L;
        { const bool late = (r >= A1 && r < A3E) || (r >= A4E && r < A5E) || (l > 0 && (r < A1 || (r >= A3E && r < A4E)));
          if (late != (mode == 1)) continue; }
        unsigned char* wl = F.wsp() + WS_W + (size_t)l * WL_STRIDE;
        unsigned char* ms = F.wsp() + WS_MISC + (size_t)l * MS_L;
        unsigned char* ct = F.wsp() + WS_CTL + CT_BASE + (size_t)l * CT_L;
        if (r < I_WIN) {
            const int kb = r / 72, nb = r % 72, k0 = 64 * kb, n0 = 32 * nb;
            const float* W = F.in(2) + (size_t)l * 1024 * 2212;
            bf16_t* WT = (bf16_t*)(wl + WO_WIN);
            const float* gam = F.in(1) + (size_t)l * DM + k0;
            if (n0 + 32 <= 1920) { transpose_item(W, 1024, 2212, 2212, WT, n0, scr, k0, n0, n0 < 768 ? 0.125f * L2E : 1.0f, lane, gam); }
            else {
                const int d = n0 + (lane & 31);
                int srcn = -1;
                if (d < 1920) srcn = d; else if (d >= C_U && d < C_U + 256) srcn = 1956 + (d - C_U); else if (d >= C_G && d < C_G + 36) srcn = 1920 + (d - C_G);
#pragma unroll 8
                for (int i = 0; i < 32; ++i) { const int kk = 2 * i + (lane >> 5); scr[kk * 33 + (lane & 31)] = srcn >= 0 ? W[(size_t)(k0 + kk) * 2212 + srcn] * gam[kk] : 0.f; }
                asm volatile("s_waitcnt lgkmcnt(0)" ::: "memory");
                const int c = lane & 7;
#pragma unroll
                for (int j = 0; j < 4; ++j) { const int n = (lane >> 3) + 8 * j; const LAS float* s = scr + (8 * c) * 33 + n;
                    u32x4 o; o.x = pk2(s[0 * 33], s[1 * 33]); o.y = pk2(s[2 * 33], s[3 * 33]); o.z = pk2(s[4 * 33], s[5 * 33]); o.w = pk2(s[6 * 33], s[7 * 33]);
                    *(u32x4*)(WT + (size_t)(n0 + n) * 1024 + k0 + 8 * c) = o; }
                asm volatile("s_waitcnt lgkmcnt(0)" ::: "memory");
            }
            continue; }
        r -= I_WIN;
        if (r < I_WOUT) { const int kb = r / 32, nb = r % 32;
            transpose_item(F.in(20) + (size_t)l * 1024 * 1024, 1024, 1024, 1024, (bf16_t*)(wl + WO_WOUT), 32 * nb, scr, 64 * kb, 32 * nb, 1.f, lane, kb < 12 ? F.in(18) + (size_t)l * 768 + 64 * kb : F.in(19) + (size_t)l * 256 + 64 * (kb - 12)); continue; }
        r -= I_WOUT;
        if (r < 2 * I_WG) { const int up = r / I_WG; const int rr = r % I_WG; const int kb = rr / 88, nb = rr % 88, n0 = 32 * nb;
            const int drow = (n0 / 128) * 256 + up * 128 + (n0 % 128);
            transpose_item_fp8(F.in(up ? 23 : 22) + (size_t)l * 1024 * DFF, 1024, DFF, (unsigned char*)(wl + WO_WGU), drow, scr, 64 * kb, n0, 64.f, lane); continue; }
        r -= 2 * I_WG;
        if (r < I_WD) { const int kb = r / 32, nb = r % 32; transpose_item_fp8(F.in(24) + (size_t)l * DFF * 1024, DFF, 1024, (unsigned char*)(wl + WO_WD), 32 * nb, scr, 64 * kb, 32 * nb, 64.f, lane); continue; }
        r -= I_WD;
        if (r < I_W1) { const int kv = r / 256; const int rr = r % 256; const int kb = rr / 8, nb = rr % 8;
            transpose_item(F.in(4) + ((size_t)l * 2 + kv) * 2048 * 256, 2048, 256, 256, (bf16_t*)(wl + WO_W1) + (size_t)kv * 256 * 2048, 32 * nb, scr, 64 * kb, 32 * nb, 1.f, lane); continue; }
        r -= I_W1;
        if (r < I_WGLU) { const int kb = r / 16, nb = r % 16, n0 = 32 * nb; const int gate = n0 >= 256, nn = n0 & 255;
            const int drow = (nn / 128) * 256 + gate * 128 + (nn % 128);
            transpose_item(F.in(16) + (size_t)l * 256 * 512, 256, 512, 512, (bf16_t*)(ms + MS_WGLU), drow, scr, 64 * kb, n0, 1.f, lane); continue; }
        r -= I_WGLU;
        if (r < I_W2) { const int kv = r / 8; const int rr = r % 8; const int kb = rr / 2, nb = rr % 2;
            transpose_item(F.in(6) + ((size_t)l * 2 + kv) * 256 * 64, 256, 64, 64, (bf16_t*)(ct + CT_W2T) + (size_t)kv * 64 * 256, 32 * nb, scr, 64 * kb, 32 * nb, 1.f, lane); continue; }
        r -= I_W2;
        if (r < I_CB) {
            const int kv = r / 32, ch = r % 32; const float* pe = F.in(3) + ((size_t)l * 2 + kv) * 2048; const float* w1 = F.in(4) + ((size_t)l * 2 + kv) * 2048 * 256;
            f32x4 s = {0.f, 0.f, 0.f, 0.f};
#pragma unroll 8
            for (int i = 0; i < 64; ++i) { const int k = 64 * ch + i; const float pv = pe[k]; const f32x4 w = *(const f32x4*)(w1 + (size_t)k * 256 + 4 * lane); s += w * pv; }
            *(f32x4*)((float*)(ms + MS_CBP) + ((size_t)kv * 32 + ch) * 256 + 4 * lane) = s; continue; }
        r -= I_CB;
        if (r < I_M) {
            const int e0 = r * 64; const int gi = e0 >> 12, dl = (e0 >> 8) & 15, cp0 = (e0 >> 4) & 15, n = lane;
            const float dt = __expf(F.in(8)[l * 16 + gi]);
            const float ar = F.in(9)[((size_t)l * 16 + gi) * 64 + n], ai = F.in(10)[((size_t)l * 16 + gi) * 64 + n];
            const float x = dt * ar, y = dt * ai; const float sy = __sinf(y), cy = __cosf(y), sh = __sinf(0.5f * y);
            const float em1 = (fabsf(x) < 0.25f) ? x * (1.f + x * (0.5f + x * (0.16666667f + x * (0.041666668f + x * 0.0083333338f)))) : expm1f(x);
            const float nr = em1 * cy - 2.f * sh * sh; const float abi = (em1 + 1.f) * sy;
            const float den = ar * ar + ai * ai;
            const float fr_ = (nr * ar + abi * ai) / den, fi_ = (abi * ar - nr * ai) / den;
            const float mg = __expf((float)dl * x); const float pr = mg * __cosf((float)dl * y), pi = mg * __sinf((float)dl * y);
            const f32x4* bre = (const f32x4*)(F.in(11) + (((size_t)l * 16 + gi) * 64 + n) * 16); const f32x4* bim = (const f32x4*)(F.in(12) + (((size_t)l * 16 + gi) * 64 + n) * 16);
            float zr[16], zi[16];
#pragma unroll
            for (int q4 = 0; q4 < 4; ++q4) { const f32x4 br = bre[q4], bi = bim[q4];
#pragma unroll
                for (int j = 0; j < 4; ++j) { const float bbr = fr_ * br[j] - fi_ * bi[j], bbi = fr_ * bi[j] + fi_ * br[j]; zr[4 * q4 + j] = pr * bbr - pi * bbi; zi[4 * q4 + j] = pr * bbi + pi * bbr; } }
#pragma unroll
            for (int cc = 0; cc < 4; ++cc) { const int cp = cp0 + cc;
                const float cr = F.in(13)[(((size_t)l * 16 + gi) * 16 + cp) * 64 + n], ci = F.in(14)[(((size_t)l * 16 + gi) * 16 + cp) * 64 + n];
#pragma unroll
                for (int c = 0; c < 16; ++c) scr[n * 65 + cc * 16 + c] = cr * zr[c] - ci * zi[c]; }
            asm volatile("s_waitcnt lgkmcnt(0)" ::: "memory");
            float mine = 0.f;
#pragma unroll 8
            for (int nn = 0; nn < 64; ++nn) mine += scr[nn * 65 + lane];
            ((float*)(ms + MS_MTAB))[e0 + lane] = mine;
            asm volatile("s_waitcnt lgkmcnt(0)" ::: "memory"); continue; }
        r -= I_M;
        {
            const int e = r * 64 + lane; const int gi = e >> 6, n = e & 63;
            const float dt = __expf(F.in(8)[l * 16 + gi]);
            const float ar = F.in(9)[((size_t)l * 16 + gi) * 64 + n], ai = F.in(10)[((size_t)l * 16 + gi) * 64 + n];
            const float x = dt * ar, y = dt * ai; float sy, cy; sy = __sinf(y); cy = __cosf(y); const float sh = __sinf(0.5f * y);
            const float em1 = (fabsf(x) < 0.25f) ? x * (1.f + x * (0.5f + x * (0.16666667f + x * (0.041666668f + x * 0.0083333338f)))) : expm1f(x); const float nr = em1 * cy - 2.f * sh * sh; const float abi = (em1 + 1.f) * sy;
            const float den = ar * ar + ai * ai;
            const float fr_ = (nr * ar + abi * ai) / den, fi_ = (abi * ar - nr * ai) / den;
            float s16, c16; s16 = __sinf(16.f * y); c16 = __cosf(16.f * y); const float m16 = __expf(16.f * x);
            ((f32x2*)(ct + CT_AB16))[e] = (f32x2){m16 * c16, m16 * s16};
            float s1k, c1k; s1k = __sinf(512.f * y); c1k = __cosf(512.f * y); const float m1k = __expf(512.f * x);
            ((f32x2*)(ct + CT_AB1K))[e] = (f32x2){m1k * c1k, m1k * s1k};
            const float* bre = F.in(11) + (((size_t)l * 16 + gi) * 64 + n) * 16; const float* bim = F.in(12) + (((size_t)l * 16 + gi) * 64 + n) * 16;
            f32x2* bb = (f32x2*)(ms + MS_BBAR) + (size_t)e * 16;
#pragma unroll
            for (int c = 0; c < 16; ++c) { const float br = bre[c], bi = bim[c]; bb[c] = (f32x2){fr_ * br - fi_ * bi, fr_ * bi + fi_ * br}; }
        }
    }
}

DI void prologue_b(Frame& F) {
    const int gt = F.gw * 64 + F.lane, ngt = F.ngw * 64;
    for (int l = 0; l < NL; ++l) {
        unsigned char* wl = F.wsp() + WS_W + (size_t)l * WL_STRIDE;
        unsigned char* ms = F.wsp() + WS_MISC + (size_t)l * MS_L;
        unsigned char* ct = F.wsp() + WS_CTL + CT_BASE + (size_t)l * CT_L;
        const float* MT = (const float*)(ms + MS_MTAB);
        const f32x2* BB = (const f32x2*)(ms + MS_BBAR);
        const float dtl_base = 0.f; (void)dtl_base;
        for (int e = gt; e < 16 * 512 * 256; e += ngt) {
            const int gi = e >> 17, n = (e >> 8) & 511, k = e & 255; float v = 0.f;
            if (n < 256) { const int tp = n >> 4, cp = n & 15, ta = k >> 4, c = k & 15; if (tp >= ta) v = MT[((gi * 16 + (tp - ta)) * 16 + cp) * 16 + c]; }
            else if (n < 384) { const int s = (n - 256) & 63, part = (n - 256) >> 6, ta = k >> 4, c = k & 15;
                const float dt = __expf(F.in(8)[l * 16 + gi]);
                const float ar = F.in(9)[((size_t)l * 16 + gi) * 64 + s], ai = F.in(10)[((size_t)l * 16 + gi) * 64 + s];
                const float pw = (float)(15 - ta); float sp, cpw; sp = __sinf(pw * dt * ai); cpw = __cosf(pw * dt * ai); const float mg = __expf(pw * dt * ar);
                const float pr = mg * cpw, pi = mg * sp; const f32x2 b = BB[((size_t)gi * 64 + s) * 16 + c];
                v = part ? (pr * b.y + pi * b.x) : (pr * b.x - pi * b.y); }
            ((bf16_t*)(wl + WO_SS1))[e] = f2bf(v);
        }
        for (int e = gt; e < 16 * 256 * 256; e += ngt) {
            const int gi = e >> 16, n = (e >> 8) & 255, k = e & 255; float v = 0.f;
            if (k < 128) { const int s = k & 63, part = k >> 6, ta = n >> 4, c = n & 15;
                const float dt = __expf(F.in(8)[l * 16 + gi]);
                const float ar = F.in(9)[((size_t)l * 16 + gi) * 64 + s], ai = F.in(10)[((size_t)l * 16 + gi) * 64 + s];
                const float pw = (float)(ta + 1); float sp, cpw; sp = __sinf(pw * dt * ai); cpw = __cosf(pw * dt * ai); const float mg = __expf(pw * dt * ar);
                const float pr = mg * cpw, pi = mg * sp;
                const float cr = F.in(13)[(((size_t)l * 16 + gi) * 16 + c) * 64 + s], ci = F.in(14)[(((size_t)l * 16 + gi) * 16 + c) * 64 + s];
                v = part ? -(cr * pi + ci * pr) : (cr * pr - ci * pi); }
            ((bf16_t*)(wl + WO_SS2))[e] = f2bf(v);
        }
        for (int e = gt; e < 512; e += ngt) { const int kv = e >> 8, n = e & 255; float s = F.in(5)[((size_t)l * 2 + kv) * 256 + n];
            const float* pp = (const float*)(ms + MS_CBP) + (size_t)kv * 32 * 256 + n;
            for (int ch = 0; ch < 32; ++ch) s += pp[ch * 256];
            ((float*)(ct + CT_CB1))[e] = s; }
    }
}

DI void convert_rows_stats(Frame& F, const float* x, bf16_t* o, unsigned long long* ssx) {
    for (int m = F.gw; m < NT; m += F.ngw) {
        const f32x4* xr = (const f32x4*)(x + (size_t)m * DM) + F.lane; f32x4 v[4]; float s = 0.f;
#pragma unroll
        for (int j = 0; j < 4; ++j) { v[j] = xr[64 * j]; s += (v[j].x * v[j].x + v[j].y * v[j].y) + (v[j].z * v[j].z + v[j].w * v[j].w); }
        u32x2* o8 = (u32x2*)(o + (size_t)m * DM) + F.lane;
#pragma unroll
        for (int j = 0; j < 4; ++j) { u32x2 w; w.x = pk2(v[j].x, v[j].y); w.y = pk2(v[j].z, v[j].w); o8[64 * j] = w; }
        s = wave_sum(s);
        if (F.lane == 0) ssx[(size_t)m * 2] = (unsigned long long)(s * 1048576.f);
    }
}
DI void rmsnorm_rows_bf16(Frame& F, const float* x, const float* g, bf16_t* o) {
    const f32x4* gp = (const f32x4*)g + F.lane; f32x4 gv[4];
#pragma unroll
    for (int j = 0; j < 4; ++j) gv[j] = gp[64 * j];
    for (int m = F.gw; m < NT; m += F.ngw) {
        const f32x4* xr = (const f32x4*)(x + (size_t)m * DM) + F.lane; f32x4 v[4]; float s = 0.f;
#pragma unroll
        for (int j = 0; j < 4; ++j) { v[j] = xr[64 * j]; s += (v[j].x * v[j].x + v[j].y * v[j].y) + (v[j].z * v[j].z + v[j].w * v[j].w); }
        const float rstd = rsqrtf(wave_sum(s) * (1.f / DM) + 1e-6f);
        u32x2* o8 = (u32x2*)(o + (size_t)m * DM) + F.lane;
#pragma unroll
        for (int j = 0; j < 4; ++j) { u32x2 w; w.x = pk2(v[j].x * rstd * gv[j].x, v[j].y * rstd * gv[j].y); w.y = pk2(v[j].z * rstd * gv[j].z, v[j].w * rstd * gv[j].w); o8[64 * j] = w; }
    }
}
DI void rmsnorm_rows_fp8(Frame& F, const float* x, const float* g, unsigned char* o) {
    const f32x4* gp = (const f32x4*)g + F.lane; f32x4 gv[4];
#pragma unroll
    for (int j = 0; j < 4; ++j) gv[j] = gp[64 * j];
    for (int m = F.gw; m < NT; m += F.ngw) {
        const f32x4* xr = (const f32x4*)(x + (size_t)m * DM) + F.lane; f32x4 v[4]; float s = 0.f;
#pragma unroll
        for (int j = 0; j < 4; ++j) { v[j] = xr[64 * j]; s += (v[j].x * v[j].x + v[j].y * v[j].y) + (v[j].z * v[j].z + v[j].w * v[j].w); }
        const float rstd = rsqrtf(wave_sum(s) * (1.f / DM) + 1e-6f);
        unsigned* o4 = (unsigned*)(o + (size_t)m * DM) + F.lane;
#pragma unroll
        for (int j = 0; j < 4; ++j) o4[64 * j] = pk4_fp8(v[j].x * rstd * gv[j].x, v[j].y * rstd * gv[j].y, v[j].z * rstd * gv[j].z, v[j].w * rstd * gv[j].w);
    }
}
DI void rmsnorm_rows_f32_inplace(Frame& F, float* x, const float* g) {
    const f32x4* gp = (const f32x4*)g + F.lane; f32x4 gv[4];
#pragma unroll
    for (int j = 0; j < 4; ++j) gv[j] = gp[64 * j];
    for (int m = F.gw; m < NT; m += F.ngw) {
        f32x4* xr = (f32x4*)(x + (size_t)m * DM) + F.lane; f32x4 v[4]; float s = 0.f;
#pragma unroll
        for (int j = 0; j < 4; ++j) { v[j] = xr[64 * j]; s += (v[j].x * v[j].x + v[j].y * v[j].y) + (v[j].z * v[j].z + v[j].w * v[j].w); }
        const float rstd = rsqrtf(wave_sum(s) * (1.f / DM) + 1e-6f);
#pragma unroll
        for (int j = 0; j < 4; ++j) xr[64 * j] = v[j] * rstd * gv[j];
    }
}
template <int OUT>
DI void rmsnorm_rows_xb(Frame& F, const bf16_t* x, const float* g, void* o) {
    const f32x4* gp = (const f32x4*)g + 2 * F.lane; f32x4 gv[2][2];
#pragma unroll
    for (int j = 0; j < 2; ++j) { gv[j][0] = gp[128 * j]; gv[j][1] = gp[128 * j + 1]; }
    for (int m = 2 * F.gw; m < NT; m += 2 * F.ngw) {
        u32x4 w[2][2];
#pragma unroll
        for (int r = 0; r < 2; ++r)
#pragma unroll
            for (int j = 0; j < 2; ++j) w[r][j] = ((const u32x4*)(x + (size_t)(m + r) * DM) + F.lane)[64 * j];
#pragma unroll
        for (int r = 0; r < 2; ++r) {
            f32x4 v[2][2]; float s = 0.f;
#pragma unroll
            for (int j = 0; j < 2; ++j) { const u32x4 q = w[r][j];
                v[j][0] = f32x4{bflo(q.x), bfhi(q.x), bflo(q.y), bfhi(q.y)}; v[j][1] = f32x4{bflo(q.z), bfhi(q.z), bflo(q.w), bfhi(q.w)};
                const f32x4 a = v[j][0] * v[j][0] + v[j][1] * v[j][1]; s += (a.x + a.y) + (a.z + a.w); }
            const float rstd = rsqrtf(wave_sum(s) * (1.f / DM) + 1e-6f);
#pragma unroll
            for (int j = 0; j < 2; ++j) { const f32x4 y0 = v[j][0] * rstd * gv[j][0], y1 = v[j][1] * rstd * gv[j][1];
                if constexpr (OUT == 0) { u32x4 t; t.x = pk2(y0.x, y0.y); t.y = pk2(y0.z, y0.w); t.z = pk2(y1.x, y1.y); t.w = pk2(y1.z, y1.w);
                    ((u32x4*)((bf16_t*)o + (size_t)(m + r) * DM) + F.lane)[64 * j] = t; }
                else if constexpr (OUT == 1) { u32x2 t; t.x = pk4_fp8(y0.x, y0.y, y0.z, y0.w); t.y = pk4_fp8(y1.x, y1.y, y1.z, y1.w);
                    ((u32x2*)((unsigned char*)o + (size_t)(m + r) * DM) + F.lane)[64 * j] = t; }
                else { f32x4* op = (f32x4*)((float*)o + (size_t)(m + r) * DM) + 2 * F.lane + 128 * j; op[0] = y0; op[1] = y1; } }
        }
    }
}
DI void mix_norm_rows(Frame& F, const bf16_t* oatt, const bf16_t* ossm, const float* gatt, const float* gssm, bf16_t* mixed) {
    for (int m = F.gw; m < NT; m += F.ngw) {
        const u32x2* ar = (const u32x2*)(oatt + (size_t)m * 768) + F.lane;
        float a[12]; float s = 0.f;
#pragma unroll
        for (int j = 0; j < 3; ++j) { const u32x2 w = ar[64 * j]; a[4 * j] = bflo(w.x); a[4 * j + 1] = bfhi(w.x); a[4 * j + 2] = bflo(w.y); a[4 * j + 3] = bfhi(w.y); }
#pragma unroll
        for (int j = 0; j < 12; ++j) s += a[j] * a[j];
        const float ra = rsqrtf(wave_sum(s) * (1.f / 768.f) + 1e-6f);
        const u32x2 sw = ((const u32x2*)(ossm + (size_t)m * 256))[F.lane];
        float b[4] = {bflo(sw.x), bfhi(sw.x), bflo(sw.y), bfhi(sw.y)};
        const float rs = rsqrtf(wave_sum(b[0] * b[0] + b[1] * b[1] + b[2] * b[2] + b[3] * b[3]) * (1.f / 256.f) + 1e-6f);
        u32x2* o8 = (u32x2*)(mixed + (size_t)m * DM);
#pragma unroll
        for (int j = 0; j < 3; ++j) { const f32x4 gv = ((const f32x4*)gatt)[64 * j + F.lane];
            u32x2 w; w.x = pk2(a[4 * j] * ra * gv.x, a[4 * j + 1] * ra * gv.y); w.y = pk2(a[4 * j + 2] * ra * gv.z, a[4 * j + 3] * ra * gv.w); o8[64 * j + F.lane] = w; }
        { const f32x4 gv = ((const f32x4*)gssm)[F.lane]; u32x2 w; w.x = pk2(b[0] * rs * gv.x, b[1] * rs * gv.y); w.y = pk2(b[2] * rs * gv.z, b[3] * rs * gv.w); o8[192 + F.lane] = w; }
    }
}

#define KPERM(rt, r) (32 * ((rt) >> 1) + 8 * ((r) >> 2) + 4 * ((rt) & 1) + ((r) & 3))
DI void vtranspose_phase(Frame& F, const bf16_t* proj, bf16_t* vts, bf16_t* vtw, bf16_t* kfs, unsigned* vmax_word, int cu0) {
    LAS bf16_t* scr = (LAS bf16_t*)(F.lds + F.wave * 8704);
    unsigned vm = 0u;
    const bool split = F.G > 96;
    if (split && F.bid < cu0) return;
    const int gw0 = split ? F.gw - cu0 * 8 : F.gw, ngw0 = split ? F.ngw - cu0 * 8 : F.ngw;
    const int c16 = F.lane & 15, kq = F.lane >> 4;
    for (int it = gw0; it < 3 * 6 * 256; it += ngw0) {
        const int which = it / 1536, r = it % 1536, bh = r >> 8, tt = r & 255, b = bh / 3, h = bh % 3;
        const bf16_t* src = proj + ((size_t)(b * SEQ + 64 * tt)) * PW + (which == 0 ? C_VS : (which == 1 ? C_VW : C_KS)) + h * 64;
        bf16_t* dst = (which == 0 ? vts : (which == 1 ? vtw : kfs)) + (size_t)bh * 64 * SEQ + (size_t)tt * 4096;
#pragma unroll
        for (int i = 0; i < 8; ++i) { const int tk = i * 8 + (F.lane >> 3), d8 = F.lane & 7; const u32x4 w = *(const u32x4*)(src + (size_t)tk * PW + 8 * d8);
            if (which == 0) { vm = max(vm, max(max(w.x & 0x7fff0000u, (w.x << 16) & 0x7fff0000u), max(w.y & 0x7fff0000u, (w.y << 16) & 0x7fff0000u)));
                              vm = max(vm, max(max(w.z & 0x7fff0000u, (w.z << 16) & 0x7fff0000u), max(w.w & 0x7fff0000u, (w.w << 16) & 0x7fff0000u))); }
            LAS bf16_t* sp = scr + tk * 66 + 8 * d8; ((LAS unsigned*)sp)[0] = w.x; ((LAS unsigned*)sp)[1] = w.y; ((LAS unsigned*)sp)[2] = w.z; ((LAS unsigned*)sp)[3] = w.w; }
        asm volatile("s_waitcnt lgkmcnt(0)" ::: "memory");
        if (which == 1) {
#pragma unroll
            for (int i = 0; i < 8; ++i) { const int d = i * 8 + (F.lane >> 3), t8 = F.lane & 7; unsigned short e[8];
#pragma unroll
                for (int j = 0; j < 8; ++j) e[j] = scr[(8 * t8 + j) * 66 + d];
                u32x4 w; w.x = e[0] | ((unsigned)e[1] << 16); w.y = e[2] | ((unsigned)e[3] << 16); w.z = e[4] | ((unsigned)e[5] << 16); w.w = e[6] | ((unsigned)e[7] << 16);
                *(u32x4*)(dst + (size_t)d * 64 + 8 * t8) = w; }
        } else if (which == 0) {
#pragma unroll
            for (int I = 0; I < 8; ++I) { const int dt = I >> 1, sp = I & 1; unsigned short e[8];
#pragma unroll
                for (int j = 0; j < 8; ++j) e[j] = scr[(32 * sp + 8 * kq + j) * 66 + 16 * dt + c16];
                u32x4 w; w.x = e[0] | ((unsigned)e[1] << 16); w.y = e[2] | ((unsigned)e[3] << 16); w.z = e[4] | ((unsigned)e[5] << 16); w.w = e[6] | ((unsigned)e[7] << 16);
                *(u32x4*)(dst + (I * 64 + F.lane) * 8) = w; }
        } else {
#pragma unroll
            for (int I = 0; I < 8; ++I) { const int rt = I >> 1, ks = I & 1; const LAS bf16_t* sp = scr + KPERM(rt, c16) * 66 + 32 * ks + 8 * kq;
                u32x4 w; w.x = ((const LAS unsigned*)sp)[0]; w.y = ((const LAS unsigned*)sp)[1]; w.z = ((const LAS unsigned*)sp)[2]; w.w = ((const LAS unsigned*)sp)[3];
                *(u32x4*)(dst + (I * 64 + F.lane) * 8) = w; }
        }
        asm volatile("s_waitcnt lgkmcnt(0)" ::: "memory");
    }
    vm = wave_max_u32(vm);
    if (F.lane == 0 && vm != 0u) __hip_atomic_fetch_max(vmax_word, vm, __ATOMIC_RELAXED, __HIP_MEMORY_SCOPE_AGENT);
}

#define MFMA32(a, b, c) __builtin_amdgcn_mfma_f32_32x32x16_bf16((a), (b), (c), 0, 0, 0)
#define MFMA16(a, b, c) __builtin_amdgcn_mfma_f32_16x16x32_bf16((a), (b), (c), 0, 0, 0)

DI void compress2_phase(Frame& F, const bf16_t* hidc, const bf16_t* w2t, const float* b2  , bf16_t* kc, bf16_t* vct, int it0, int it_end, int it_step) {
    const int r = F.lane & 31, h = F.lane >> 5;
    for (int it = it0; it < it_end; it += it_step) {
        const int kv = it / 192, rb = it % 192; const int R0 = kv * 6144 + rb * 32;
        f32x16 acc0, acc1;
#pragma unroll
        for (int i = 0; i < 16; ++i) { acc0[i] = 0.f; acc1[i] = 0.f; }
        const bf16_t* ap = hidc + (size_t)(R0 + r) * 256 + 8 * h; const bf16_t* bp = w2t + (size_t)kv * 64 * 256 + (size_t)r * 256 + 8 * h;
#pragma unroll 4
        for (int ks = 0; ks < 16; ++ks) { const bf16x8 a = *(const bf16x8*)(ap + 16 * ks); const bf16x8 b0 = *(const bf16x8*)(bp + 16 * ks), b1 = *(const bf16x8*)(bp + 32 * 256 + 16 * ks);
            acc0 = MFMA32(a, b0, acc0); acc1 = MFMA32(a, b1, acc1); }
        const int bh = rb >> 5, i0 = (rb & 31) * 32;
        const float bb0 = b2[kv * 64 + r], bb1 = b2[kv * 64 + 32 + r];
        if (kv == 0) {
#pragma unroll
            for (int i = 0; i < 16; ++i) { const int row = i0 + (i & 3) + 8 * (i >> 2) + 4 * h; bf16_t* o = kc + ((size_t)bh * 1024 + row) * 64;
                const bool junk = (row == 1023);
                o[r] = junk ? (bf16_t)0 : f2bf(acc0[i] + bb0); o[32 + r] = junk ? (bf16_t)0 : f2bf(acc1[i] + bb1); }
        } else {
#pragma unroll
            for (int g4 = 0; g4 < 4; ++g4) { const int row = i0 + 8 * g4 + 4 * h;
                u32x2 w0, w1; w0.x = pk2(acc0[4 * g4] + bb0, acc0[4 * g4 + 1] + bb0); w0.y = pk2(acc0[4 * g4 + 2] + bb0, acc0[4 * g4 + 3] + bb0);
                w1.x = pk2(acc1[4 * g4] + bb1, acc1[4 * g4 + 1] + bb1); w1.y = pk2(acc1[4 * g4 + 2] + bb1, acc1[4 * g4 + 3] + bb1);
                if (row == 1020) { w0.y &= 0x0000ffffu; w1.y &= 0x0000ffffu; }
                bf16_t* vt = vct + (size_t)bh * 64 * 1024 + (size_t)(row >> 6) * 4096 + (row & 63);
                *(u32x2*)(vt + r * 64) = w0; *(u32x2*)(vt + (32 + r) * 64) = w1; }
        }
    }
}

DI void ssm_carry_phase(Frame& F, const float* hl, const f32x2* ab16, const f32x2* ab512, bf16_t* hin, int bg0, int bg_end, int bg_step) {
    LAS f32x2* E = (LAS f32x2*)F.lds;
    const int s = F.lane;
    for (int bg = bg0; bg < bg_end; bg += bg_step) {
        const int gi = bg & 15; const f32x2 a16 = ab16[gi * 64 + s], a5 = ab512[gi * 64 + s];
        const float* hp = hl + (size_t)bg * 1024 * 128 + s;
        float hr[4], hi[4];
#pragma unroll
        for (int j = 0; j < 4; ++j) { hr[j] = 0.f; hi[j] = 0.f; }
#pragma unroll 4
        for (int c = 0; c < 32; ++c) {
#pragma unroll
            for (int j = 0; j < 4; ++j) { const float* q = hp + (size_t)((4 * F.wave + j) * 32 + c) * 128; const float lr = q[0], li = q[64];
                const float nr = a16.x * hr[j] - a16.y * hi[j] + lr, ni = a16.x * hi[j] + a16.y * hr[j] + li; hr[j] = nr; hi[j] = ni; } }
#pragma unroll
        for (int j = 0; j < 4; ++j) E[(4 * F.wave + j) * 64 + s] = (f32x2){hr[j], hi[j]};
        __syncthreads();
        { float pr = 0.f, pi = 0.f;
          for (int k = 0; k < 4 * F.wave; ++k) { const f32x2 e = E[k * 64 + s]; const float nr = a5.x * pr - a5.y * pi + e.x, ni = a5.x * pi + a5.y * pr + e.y; pr = nr; pi = ni; }
#pragma unroll
          for (int j = 0; j < 4; ++j) { hr[j] = pr; hi[j] = pi; const f32x2 e = E[(4 * F.wave + j) * 64 + s]; const float nr = a5.x * pr - a5.y * pi + e.x, ni = a5.x * pi + a5.y * pr + e.y; pr = nr; pi = ni; } }
#pragma unroll 4
        for (int c = 0; c < 32; ++c) {
#pragma unroll
            for (int j = 0; j < 4; ++j) { const int ch = (4 * F.wave + j) * 32 + c; const float* q = hp + (size_t)ch * 128; const float lr = q[0], li = q[64];
                bf16_t* o = hin + ((size_t)bg * 1024 + ch) * 256; o[s] = f2bf(hr[j]); o[64 + s] = f2bf(hi[j]); ((unsigned*)(o + 128))[s] = 0u;
                const float nr = a16.x * hr[j] - a16.y * hi[j] + lr, ni = a16.x * hi[j] + a16.y * hr[j] + li; hr[j] = nr; hi[j] = ni; } }
        __syncthreads();
    }
}

constexpr float AL2E = 1.0f;
constexpr int IMP_STRIDE = 257;
constexpr int OS_QS = 261, OS_HS = 65;
constexpr int LDS_RA = 0, LDS_RB = 64 * IMP_STRIDE * 4, LDS_WM = LDS_RB + 64 * OS_QS * 4;
constexpr int QT_ROW = 144, LDS_QT = LDS_RA, LDS_QL = LDS_QT + 256 * QT_ROW, LDS_MREF = LDS_QL + 512, LDS_LS = LDS_MREF + 1024;
constexpr int LDS_QCNT = LDS_WM + 2048;
static_assert(LDS_LS + 1024 <= LDS_RB && LDS_QCNT + 20 <= LDS_BYTES - 256, "LDS map");
constexpr int TROW = 144, TILE_V = 64 * TROW, TILE_BYTES = 2 * 64 * TROW;

struct TileSrc { const bf16_t* k; long kstep, kstride; const bf16_t* v; long vstep, vstride; };

constexpr int PD = 1;
struct IdMap { DI int operator()(int i) const { return i; } };
template <bool WITH_V, class Compute, class Map = IdMap, bool FRAG = false>
DI void kv_pipeline(Frame& F, LAS unsigned char* sb, const TileSrc& ts, int n, Compute&& compute, Map tmap = Map()) {
    if (n <= 0) return;
    const int row = F.tid >> 3, ch = F.tid & 7, nl = n - 1;
    const bf16_t* kp = FRAG ? ts.k + F.tid * 8 : ts.k + (long)row * ts.kstride + ch * 8; const bf16_t* vp = FRAG ? ts.v + F.tid * 8 : ts.v + (long)row * ts.vstride + ch * 8;
    LAS unsigned char* wk = sb + row * TROW + ch * 16; int vdel = TILE_V;
    if (FRAG) { const int I = F.tid >> 6, l_ = F.tid & 63, c16_ = l_ & 15, kq_ = l_ >> 4;
        const int kofs = KPERM(I >> 1, c16_) * TROW + (32 * (I & 1) + 8 * kq_) * 2, vofs = TILE_V + (16 * (I >> 1) + c16_) * TROW + (32 * (I & 1) + 8 * kq_) * 2;
        wk = sb + kofs; vdel = vofs - kofs; }
    u32x4 kr[PD], vr[PD];
#pragma unroll
    for (int u = 0; u < PD; ++u) { const int t = tmap(u < nl ? u : nl); kr[u] = *(const u32x4*)(kp + (long)t * ts.kstep); vr[u] = WITH_V ? *(const u32x4*)(vp + (long)t * ts.vstep) : (u32x4){0u, 0u, 0u, 0u}; }
    *(LAS u32x4*)wk = kr[0]; if (WITH_V) *(LAS u32x4*)(wk + vdel) = vr[0];
    { const int t = tmap(PD < nl ? PD : nl); kr[0] = *(const u32x4*)(kp + (long)t * ts.kstep); if (WITH_V) vr[0] = *(const u32x4*)(vp + (long)t * ts.vstep); }
    __syncthreads();
    for (int i0 = 0; i0 < n; i0 += PD) {
#pragma unroll
        for (int u = 0; u < PD; ++u) {
            const int i = i0 + u; const int s1 = (u + 1) % PD;
            { LAS unsigned char* w1 = wk + ((i + 1) & 1) * TILE_BYTES; *(LAS u32x4*)w1 = kr[s1]; if (WITH_V) *(LAS u32x4*)(w1 + vdel) = vr[s1]; }
            { const int t = tmap((i + 1 + PD) < nl ? (i + 1 + PD) : nl); kr[s1] = *(const u32x4*)(kp + (long)t * ts.kstep); if (WITH_V) vr[s1] = *(const u32x4*)(vp + (long)t * ts.vstep); }
            if (i < n) compute(i, sb + (i & 1) * TILE_BYTES);
            __syncthreads();
        }
    }
}

DI f32x16 qk32(const LAS unsigned char* tb, int kh, int r32, int h, const bf16x8 (&qf)[4]) {
    f32x16 sc;
#pragma unroll
    for (int i = 0; i < 16; ++i) sc[i] = 0.f;
    const LAS unsigned char* kp = tb + (32 * kh + r32) * TROW + 16 * h;
#pragma unroll
    for (int s = 0; s < 4; ++s) { const bf16x8 a = *(const LAS bf16x8*)(kp + 32 * s); sc = MFMA32(a, qf[s], sc); }
    return sc;
}
DI void qk32x2(const LAS unsigned char* tb, int r32, int h, const bf16x8 (&qf)[4], f32x16& s0, f32x16& s1) {
#pragma unroll
    for (int i = 0; i < 16; ++i) { s0[i] = 0.f; s1[i] = 0.f; }
    const LAS unsigned char* kp = tb + r32 * TROW + 16 * h;
#pragma unroll
    for (int s = 0; s < 4; ++s) { const bf16x8 a0 = *(const LAS bf16x8*)(kp + 32 * s), a1 = *(const LAS bf16x8*)(kp + 32 * TROW + 32 * s); s0 = MFMA32(a0, qf[s], s0); s1 = MFMA32(a1, qf[s], s1); }
}
DI void pv32(const LAS unsigned char* tb, int kh, int r32, int h, const f32x16& p, f32x16& o0, f32x16& o1) {
#pragma unroll
    for (int s2 = 0; s2 < 2; ++s2) {
        u32x4 pw; pw.x = pk2(p[8 * s2], p[8 * s2 + 1]); pw.y = pk2(p[8 * s2 + 2], p[8 * s2 + 3]); pw.z = pk2(p[8 * s2 + 4], p[8 * s2 + 5]); pw.w = pk2(p[8 * s2 + 6], p[8 * s2 + 7]);
        const bf16x8 pb = __builtin_bit_cast(bf16x8, pw);
        const LAS unsigned char* vp = tb + TILE_V + r32 * TROW + (32 * kh + 16 * s2 + 4 * h) * 2;
        { const s16x4 lo = *(const LAS s16x4*)vp, hi = *(const LAS s16x4*)(vp + 16); const bf16x8 a = __builtin_shufflevector(lo, hi, 0, 1, 2, 3, 4, 5, 6, 7); o0 = MFMA32(a, pb, o0); }
        { const s16x4 lo = *(const LAS s16x4*)(vp + 32 * TROW), hi = *(const LAS s16x4*)(vp + 32 * TROW + 16); const bf16x8 a = __builtin_shufflevector(lo, hi, 0, 1, 2, 3, 4, 5, 6, 7); o1 = MFMA32(a, pb, o1); }
    }
}

DI void attn_unit(Frame& F, const bf16_t* proj, const bf16_t* kcb, const bf16_t* vctb, const bf16_t* vts, const bf16_t* vtw, bf16_t* oatt, int bh, int qb, float os_scale, float os_inv, float os_e2, float* park, const bf16_t* kfs, unsigned long long* sst) {
    const float ls_scale = 1048576.0f * os_inv;
    LAS unsigned* IMP = (LAS unsigned*)(F.lds + LDS_RA); LAS unsigned char* WM = F.lds + LDS_WM;
    const int b = bh / 3, hkv = bh % 3, lane = F.lane, w = F.wave;
    const float NEG = -__builtin_inff();
    for (int i = F.tid; i < 64 * IMP_STRIDE; i += 512) IMP[i] = 0u;
    for (int i = F.tid; i < 512; i += 512) ((LAS unsigned*)WM)[i] = 0u;
    if (F.tid == 0) ((LAS int*)(F.lds + LDS_QCNT + 16))[0] = 0;
    const int r32 = lane & 31, h = lane >> 5, gq = w & 3, qh = w >> 2;
    const int ql = 32 * qh + r32, t = 64 * qb + ql;
    const size_t trow = (size_t)(b * SEQ + t);
    const bf16_t* qrow = proj + trow * PW + C_Q + (hkv * 4 + gq) * 64;
    bf16x8 qf[4];
#pragma unroll
    for (int s = 0; s < 4; ++s) qf[s] = *(const bf16x8*)(qrow + 16 * s + 8 * h);
    const bf16_t* grow = proj + trow * PW + C_G + hkv * 12 + gq * 3;
    const float g0 = sigmoidf_(bf2f(grow[0])), g2 = sigmoidf_(bf2f(grow[2]));
    f32x16 oc0, oc1; float inv_c = 0.f;
#pragma unroll
    for (int i = 0; i < 16; ++i) { oc0[i] = 0.f; oc1[i] = 0.f; }
    {
        const int ntile = (4 * qb + 3 + 63) >> 6;
        const int vis = (t - 31) >> 4;
        const int vis_w = (64 * qb + 32 * qh + 31 - 31) >> 4;
        const int vis_min = (64 * qb + 32 * qh - 31) >> 4;
        TileSrc ts{kcb + (size_t)bh * 1024 * 64, 64 * 64, 64, vctb + (size_t)bh * 64 * 1024, 4096, 64};
        float m = NEG, lsum = 0.f;
        for (int rep_ = 0; rep_ < REP_B1; ++rep_)
        kv_pipeline<false>(F, F.lds + LDS_RB, ts, ntile, [&](int i, const LAS unsigned char* tb) {
            if (64 * i > vis_w) return;
            const bool two = (64 * i + 32 <= vis_w); f32x16 sq0, sq1;
            if (two) qk32x2(tb, r32, h, qf, sq0, sq1); else { sq0 = qk32(tb, 0, r32, h, qf); sq1 = sq0; }
#pragma unroll
            for (int kh = 0; kh < 2; ++kh) {
                if (kh == 1 && !two) continue;
                f32x16 sc = kh ? sq1 : sq0;
                float tm = NEG;
                if (64 * i + 32 * kh + 31 > vis_min) {
#pragma unroll
                    for (int e = 0; e < 16; ++e) { const int ki = 64 * i + 32 * kh + (e & 3) + 8 * (e >> 2) + 4 * h; sc[e] = (ki <= vis) ? sc[e] : NEG; }
                }
#pragma unroll
                for (int e = 0; e < 16; ++e) tm = fmaxf(tm, sc[e]);
                const float mn = fmaxf(m, tm);
                if (mn > NEG) { float ps = 0.f;
#pragma unroll
                    for (int e = 0; e < 16; ++e) ps += fexp2((sc[e] - mn) * AL2E);
                    lsum = lsum * fexp2((m - mn) * AL2E) + ps; m = mn; }
            }
        });
        const F2 mm = halves32(m), ll = halves32(lsum);
        float M = fmaxf(mm.lo, mm.hi), Lt = 0.f;
        if (M > NEG) Lt = ll.lo * fexp2((mm.lo - M) * AL2E) + ll.hi * fexp2((mm.hi - M) * AL2E); else M = 0.f;
        const float inv = 1.0f / fmaxf(Lt, 1e-30f), inv24 = inv * 16777216.0f;
        inv_c = inv;
        for (int rep_ = 0; rep_ < REP_B1; ++rep_)
        kv_pipeline<true>(F, F.lds + LDS_RB, ts, ntile, [&](int i, const LAS unsigned char* tb) {
            if (64 * i > vis_w) return;
            const bool two = (64 * i + 32 <= vis_w); f32x16 sq0, sq1;
            if (two) qk32x2(tb, r32, h, qf, sq0, sq1); else { sq0 = qk32(tb, 0, r32, h, qf); sq1 = sq0; }
#pragma unroll
            for (int kh = 0; kh < 2; ++kh) {
                if (kh == 1 && !two) continue;
                f32x16 sc = kh ? sq1 : sq0;
#pragma unroll
                for (int e = 0; e < 16; ++e) sc[e] = fexp2((sc[e] - M) * AL2E);
                if (64 * i + 32 * kh + 31 > vis_min) {
#pragma unroll
                    for (int e = 0; e < 16; ++e) { const int ki = 64 * i + 32 * kh + (e & 3) + 8 * (e >> 2) + 4 * h; sc[e] = (ki <= vis) ? sc[e] : 0.f; }
                }
#pragma unroll
                for (int a = 0; a < 4; ++a) { const float G = (sc[4 * a] + sc[4 * a + 1]) + (sc[4 * a + 2] + sc[4 * a + 3]); const int j = 16 * i + 8 * kh + 2 * a + h;
                    __hip_atomic_fetch_add(IMP + ql * IMP_STRIDE + j, (unsigned)(G * inv24 + 0.5f), __ATOMIC_RELAXED, __HIP_MEMORY_SCOPE_WORKGROUP);
                    __hip_atomic_fetch_add(IMP + ql * IMP_STRIDE + j + 1, (unsigned)(sc[4 * a + 3] * inv24 + 0.5f), __ATOMIC_RELAXED, __HIP_MEMORY_SCOPE_WORKGROUP); }
                pv32(tb, kh, r32, h, sc, oc0, oc1);
            }
        });
    }
    {
        const int cur = qb; LAS unsigned char* wm = WM + w * 256;
        if (cur + 1 <= 16) { if (lane <= cur) wm[lane] = 0xff; }
        else for (int rep_ = 0; rep_ < REP_TK; ++rep_) {
            unsigned key[8][4]; unsigned selbits = 0u;
#pragma unroll
            for (int qi = 0; qi < 8; ++qi) {
#pragma unroll
                for (int i = 0; i < 4; ++i) { const int j = 4 * lane + i; const unsigned x = IMP[(8 * w + qi) * IMP_STRIDE + j]; key[qi][i] = (j >= 1 && j <= cur - 2) ? (((x + 1u) << 2) | (unsigned)(3 - i)) : 0u; }
#define CE_(a_, b_) do { const unsigned hi_ = max(key[qi][a_], key[qi][b_]), lo_ = min(key[qi][a_], key[qi][b_]); key[qi][a_] = hi_; key[qi][b_] = lo_; } while (0)
                CE_(0, 1); CE_(2, 3); CE_(0, 2); CE_(1, 3); CE_(1, 2);
#undef CE_
            }
            for (int k = 0; k < 13; ++k) {
#pragma unroll
                for (int qi = 0; qi < 8; ++qi) {
                    const unsigned hv = key[qi][0] >> 2; const unsigned Mx = wave_max_u32(hv);
                    const unsigned long long bal = __ballot(hv == Mx); const int L = __ffsll((long long)bal) - 1;
                    const unsigned hk = (unsigned)__builtin_amdgcn_readlane((int)key[qi][0], L);
                    const unsigned bit = 1u << (8 * (3 - (int)(hk & 3u)) + qi);
                    const bool win = (lane == L);
                    selbits |= win ? bit : 0u;
                    key[qi][0] = win ? key[qi][1] : key[qi][0]; key[qi][1] = win ? key[qi][2] : key[qi][1]; key[qi][2] = win ? key[qi][3] : key[qi][2]; key[qi][3] = win ? 0u : key[qi][3];
                }
            }
            unsigned mybits[4];
#pragma unroll
            for (int i = 0; i < 4; ++i) mybits[i] = (selbits >> (8 * i)) & 0xffu;
#pragma unroll
            for (int i = 0; i < 4; ++i) { const int j = 4 * lane + i; unsigned bits = mybits[i]; if (j == 0 || j == cur - 1 || j == cur) bits = 0xffu; wm[j] = (unsigned char)bits; }
        }
    }
    __syncthreads();
    {
        const int kt_lo = (qb - 8) > 0 ? (qb - 8) : 0; const int ntile = qb - kt_lo + 1;
        const int t0w = 64 * qb + 32 * qh;
        TileSrc ts{proj + ((size_t)(b * SEQ) + 64 * kt_lo) * PW + C_KW + hkv * 64, 64 * PW, PW, vtw + (size_t)bh * 64 * SEQ + (size_t)kt_lo * 4096, 4096, 64};
        float m = NEG, lsum = 0.f; f32x16 o0, o1;
#pragma unroll
        for (int i = 0; i < 16; ++i) { o0[i] = 0.f; o1[i] = 0.f; }
        kv_pipeline<true>(F, F.lds + LDS_RA, ts, ntile, [&](int i, const LAS unsigned char* tb) {
#pragma unroll
            for (int kh = 0; kh < 2; ++kh) {
                const int k0 = 64 * (kt_lo + i) + 32 * kh;
                if (k0 > t0w + 31 || k0 + 31 <= t0w - 512) continue;
                f32x16 sc = qk32(tb, kh, r32, h, qf);
                if (!(k0 + 31 <= t0w && k0 > t0w + 31 - 512)) {
#pragma unroll
                    for (int e = 0; e < 16; ++e) { const int key = k0 + (e & 3) + 8 * (e >> 2) + 4 * h; sc[e] = (key <= t && key > t - 512) ? sc[e] : NEG; }
                }
                float ps = 0.f;
#pragma unroll
                for (int e = 0; e < 16; ++e) { sc[e] = fexp2(sc[e]); ps += sc[e]; }
                lsum += ps;
                pv32(tb, kh, r32, h, sc, o0, o1);
            }
        });
        bool redo; { const float Lq = xor32_sum(lsum); LAS int* WFLAG = (LAS int*)(F.lds + LDS_QCNT + 16);
          if (!(Lq > 5.4e-20f && Lq < 1.8e19f)) WFLAG[0] = 1;
          __syncthreads();
          redo = WFLAG[0] != 0; }
        if (redo) {
        lsum = 0.f;
#pragma unroll
        for (int i = 0; i < 16; ++i) { o0[i] = 0.f; o1[i] = 0.f; }
        kv_pipeline<true>(F, F.lds + LDS_RA, ts, ntile, [&](int i, const LAS unsigned char* tb) {
#pragma unroll
            for (int kh = 0; kh < 2; ++kh) {
                const int k0 = 64 * (kt_lo + i) + 32 * kh;
                if (k0 > t0w + 31 || k0 + 31 <= t0w - 512) continue;
                f32x16 sc = qk32(tb, kh, r32, h, qf);
                float tm = NEG;
                if (!(k0 + 31 <= t0w && k0 > t0w + 31 - 512)) {
#pragma unroll
                    for (int e = 0; e < 16; ++e) { const int key = k0 + (e & 3) + 8 * (e >> 2) + 4 * h; sc[e] = (key <= t && key > t - 512) ? sc[e] : NEG; }
                }
#pragma unroll
                for (int e = 0; e < 16; ++e) tm = fmaxf(tm, sc[e]);
                tm = xor32_max(tm);
                const float mn = fmaxf(m, tm); const float ms = (mn > NEG) ? mn : 0.f;
                const float alpha = fexp2((m - ms) * AL2E); float ps = 0.f;
#pragma unroll
                for (int e = 0; e < 16; ++e) { sc[e] = fexp2((sc[e] - ms) * AL2E); ps += sc[e]; }
                lsum = lsum * alpha + ps; m = mn;
                if (__any(alpha != 1.0f)) {
#pragma unroll
                    for (int e = 0; e < 16; ++e) { o0[e] *= alpha; o1[e] *= alpha; }
                }
                pv32(tb, kh, r32, h, sc, o0, o1);
            }
        });
        }
        const float Lw = xor32_sum(lsum); const float gw = g2 / fmaxf(Lw, 1e-30f);
        const float gc = g0 * inv_c;
#pragma unroll
        for (int e = 0; e < 16; ++e) { oc0[e] = gc * oc0[e] + gw * o0[e]; oc1[e] = gc * oc1[e] + gw * o1[e]; }
        bf16_t* op = oatt + trow * 1024 + (hkv * 4 + gq) * 64;
#pragma unroll
        for (int g4 = 0; g4 < 4; ++g4) { const int d = 8 * g4 + 4 * h; u32x2 w0, w1;
            w0.x = pk2(oc0[4 * g4], oc0[4 * g4 + 1]); w0.y = pk2(oc0[4 * g4 + 2], oc0[4 * g4 + 3]); w1.x = pk2(oc1[4 * g4], oc1[4 * g4 + 1]); w1.y = pk2(oc1[4 * g4 + 2], oc1[4 * g4 + 3]);
            *(u32x2*)(op + d) = w0; *(u32x2*)(op + 32 + d) = w1; }
    }
    const int cur = qb; const bool dense = (cur + 1 <= 16);
    float mf = NEG, lf = 0.f;
    {
        const int nfb = dense ? (cur + 1) : 3;
        TileSrc ts{kfs + (size_t)bh * 64 * SEQ, 4096, 0, vts + (size_t)bh * 64 * SEQ, 4096, 0};
#pragma unroll
        for (int e = 0; e < 16; ++e) { oc0[e] = 0.f; oc1[e] = 0.f; }
        auto dense_fn = [&](int i, const LAS unsigned char* tb) {
            const int j = dense ? i : (i == 0 ? 0 : cur - 2 + i);
#pragma unroll
            for (int kh = 0; kh < 2; ++kh) {
                const int k0 = 64 * j + 32 * kh;
                if (k0 > 64 * qb + 32 * qh + 31) continue;
                f32x16 sc = qk32(tb, kh, r32, h, qf);
                float tm = NEG;
                if (k0 + 31 > 64 * qb + 32 * qh) {
#pragma unroll
                    for (int e = 0; e < 16; ++e) { const int key = k0 + (e & 3) + 8 * (e >> 2) + 4 * h; sc[e] = (key <= t) ? sc[e] : NEG; }
                }
#pragma unroll
                for (int e = 0; e < 16; ++e) tm = fmaxf(tm, sc[e]);
                tm = xor32_max(tm);
                const float mn = fmaxf(mf, tm); const float ms = (mn > NEG) ? mn : 0.f;
                const float alpha = fexp2((mf - ms) * AL2E); float ps = 0.f;
#pragma unroll
                for (int e = 0; e < 16; ++e) { sc[e] = fexp2((sc[e] - ms) * AL2E); ps += sc[e]; }
                lf = lf * alpha + ps; mf = mn;
                if (__any(alpha != 1.0f)) {
#pragma unroll
                    for (int e = 0; e < 16; ++e) { oc0[e] *= alpha; oc1[e] *= alpha; }
                }
                pv32(tb, kh, r32, h, sc, oc0, oc1);
            }
        };
        auto dense_map = [&](int i) -> int { return dense ? i : (i == 0 ? 0 : cur - 2 + i); };
        kv_pipeline<true, decltype(dense_fn)&, decltype(dense_map), true>(F, F.lds + LDS_RA, ts, nfb, dense_fn, dense_map);
        lf = xor32_sum(lf);
#pragma unroll
        for (int g4 = 0; g4 < 4; ++g4) { *(f32x4*)(park + 4 * g4) = (f32x4){oc0[4 * g4], oc0[4 * g4 + 1], oc0[4 * g4 + 2], oc0[4 * g4 + 3]}; *(f32x4*)(park + 16 + 4 * g4) = (f32x4){oc1[4 * g4], oc1[4 * g4 + 1], oc1[4 * g4 + 2], oc1[4 * g4 + 3]}; }
    }
    {
        const int c16 = lane & 15, kq = lane >> 4, hd = c16 & 3, qs = c16 >> 2;
        LAS unsigned char* QT = F.lds + LDS_QT; LAS unsigned char* QL = F.lds + LDS_QL + w * 64; LAS int* MREF = (LAS int*)(F.lds + LDS_MREF); LAS unsigned* LS = (LAS unsigned*)(F.lds + LDS_LS);
        LAS int* OS = (LAS int*)(F.lds + LDS_RB);
        LAS int* QCNT = (LAS int*)(F.lds + LDS_QCNT); LAS int* FLAGW = (LAS int*)(F.lds + LDS_QCNT + 12);
        bool exact = false;
        const int nsp = dense ? 0 : (cur - 2);
        if (nsp > 0) {
        { const int row = F.tid >> 1, half = F.tid & 1, q = row >> 2, hh = row & 3;
          const bf16_t* src = proj + (size_t)(b * SEQ + 64 * qb + q) * PW + C_Q + (hkv * 4 + hh) * 64 + 32 * half;
          const u32x4 v0 = *(const u32x4*)src, v1 = *(const u32x4*)(src + 8), v2 = *(const u32x4*)(src + 16), v3 = *(const u32x4*)(src + 24);
          LAS u32x4* d = (LAS u32x4*)(QT + row * QT_ROW + 64 * half); d[0] = v0; d[1] = v1; d[2] = v2; d[3] = v3; }
        for (int i = F.tid; i < 64 * OS_QS; i += 512) OS[i] = 0;
        if (F.tid < 256) LS[F.tid] = 0u;
        if (h == 0) MREF[ql * 4 + gq] = __float_as_int(mf);
        if (F.tid < 2) QCNT[F.tid] = 0;
        if (F.tid == 2) FLAGW[0] = 0;
        __syncthreads();
        const bf16_t* Ksb = kfs + (size_t)bh * 64 * SEQ + lane * 8;
        const bf16_t* Vsb = vts + (size_t)bh * 64 * SEQ + lane * 8;
        auto ticket = [&](LAS int* cnt) -> int { int tk = 0; if (lane == 0) tk = __hip_atomic_fetch_add(cnt, 1, __ATOMIC_RELAXED, __HIP_MEMORY_SCOPE_WORKGROUP); return __builtin_amdgcn_readfirstlane(tk); };
        auto load_k = [&](int j, bf16x8 (&kf)[4][2]) {
#pragma unroll
            for (int rt = 0; rt < 4; ++rt)
#pragma unroll
                for (int ks = 0; ks < 2; ++ks) kf[rt][ks] = *(const bf16x8*)(Ksb + (size_t)j * 4096 + 512 * (2 * rt + ks)); };
        auto load_v = [&](int j, bf16x8 (&vf)[4][2]) {
#pragma unroll
            for (int dt = 0; dt < 4; ++dt)
#pragma unroll
                for (int sp = 0; sp < 2; ++sp) vf[dt][sp] = *(const bf16x8*)(Vsb + (size_t)j * 4096 + 512 * (2 * dt + sp)); };
        auto make_list = [&](int j, int& nj) -> int {
            const unsigned byte = WM[(lane >> 3) * 256 + j]; const bool act = (byte >> (lane & 7)) & 1u;
            const unsigned long long bal = __ballot(act); nj = __popcll(bal);
            const int rank = __builtin_amdgcn_mbcnt_hi((unsigned)(bal >> 32), __builtin_amdgcn_mbcnt_lo((unsigned)bal, 0u));
            if (act) QL[rank] = (unsigned char)lane;
            asm volatile("s_waitcnt lgkmcnt(0)" ::: "memory");
            return (nj + 3) >> 2; };
        auto col_query = [&](int tl, int nj, bool& valid) -> int { const int idx = 4 * tl + qs; valid = idx < nj; return (int)QL[valid ? idx : 0]; };
        auto scores = [&](const bf16x8 (&kf)[4][2], int q, bool valid, f32x4 (&st)[4]) {
            const LAS unsigned char* qp = QT + (q * 4 + hd) * QT_ROW + 16 * kq;
            const bf16x8 q0 = *(const LAS bf16x8*)qp, q1 = *(const LAS bf16x8*)(qp + 64);
#pragma unroll
            for (int rt = 0; rt < 4; ++rt) { st[rt] = (f32x4){0.f, 0.f, 0.f, 0.f}; st[rt] = MFMA16(kf[rt][0], q0, st[rt]); st[rt] = MFMA16(kf[rt][1], q1, st[rt]); }
            if (!valid) {
#pragma unroll
                for (int rt = 0; rt < 4; ++rt) st[rt] = (f32x4){NEG, NEG, NEG, NEG};
            } };
        auto run_pass2 = [&](const bool FAST) {
            bf16x8 kf[4][2], kn[4][2], vf[4][2], vn[4][2];
            int t0 = ticket(QCNT + 1), t1;
            { const int j0 = t0 < nsp ? t0 : nsp - 1; load_k(1 + j0, kn); load_v(1 + j0, vn); }
            while (t0 < nsp) {
                asm volatile("s_waitcnt vmcnt(0)" ::: "memory");
#pragma unroll
                for (int rt = 0; rt < 4; ++rt)
#pragma unroll
                    for (int ks = 0; ks < 2; ++ks) { kf[rt][ks] = kn[rt][ks]; vf[rt][ks] = vn[rt][ks]; }
#pragma unroll
                for (int rt = 0; rt < 4; ++rt)
#pragma unroll
                    for (int ks = 0; ks < 2; ++ks) { asm volatile("" : "+v"(kf[rt][ks])); asm volatile("" : "+v"(vf[rt][ks])); }
                t1 = ticket(QCNT + 1);
                { const int j1 = t1 < nsp ? t1 : nsp - 1; load_k(1 + j1, kn); load_v(1 + j1, vn); }
                int nj; const int ntl = make_list(1 + t0, nj);
                for (int tl = 0; tl < ntl; ++tl) {
                    bool valid; const int q = col_query(tl, nj, valid);
                    f32x4 st[4]; scores(kf, q, valid, st);
                    float mr;
                    if (FAST) mr = __int_as_float(MREF[q * 4 + hd]);
                    else { const int key = MREF[q * 4 + hd]; const int ib = key >= 0 ? key : (key ^ 0x7fffffff); mr = __int_as_float(ib); mr = (mr > NEG) ? mr : 0.f; }
                    float ps = 0.f; mr -= os_e2;
#pragma unroll
                    for (int rt = 0; rt < 4; ++rt)
#pragma unroll
                        for (int e = 0; e < 4; ++e) { st[rt][e] = fexp2((st[rt][e] - mr) * AL2E); ps += st[rt][e]; }
                    ps = xor32_sum(xor16_sum(ps));
                    if (FAST) { if (ps > 218.0f * os_scale) FLAGW[0] = 1; }
                    f32x4 o[4];
#pragma unroll
                    for (int dt = 0; dt < 4; ++dt) o[dt] = (f32x4){0.f, 0.f, 0.f, 0.f};
#pragma unroll
                    for (int sp = 0; sp < 2; ++sp) {
                        u32x4 pw; pw.x = pk2(st[2 * sp][0], st[2 * sp][1]); pw.y = pk2(st[2 * sp][2], st[2 * sp][3]); pw.z = pk2(st[2 * sp + 1][0], st[2 * sp + 1][1]); pw.w = pk2(st[2 * sp + 1][2], st[2 * sp + 1][3]);
                        const bf16x8 pb = __builtin_bit_cast(bf16x8, pw);
#pragma unroll
                        for (int dt = 0; dt < 4; ++dt) o[dt] = MFMA16(vf[dt][sp], pb, o[dt]);
                    }
                    if (valid) {
                        LAS int* op = OS + q * OS_QS + hd * OS_HS + 4 * kq;
#pragma unroll
                        for (int dt = 0; dt < 4; ++dt)
#pragma unroll
                            for (int e = 0; e < 4; ++e) __hip_atomic_fetch_add(op + 16 * dt + e, (int)o[dt][e], __ATOMIC_RELAXED, __HIP_MEMORY_SCOPE_WORKGROUP);
                        if (kq == 0) __hip_atomic_fetch_add(LS + q * 4 + hd, (unsigned)(ps * ls_scale + 0.5f), __ATOMIC_RELAXED, __HIP_MEMORY_SCOPE_WORKGROUP);
                    }
                }
                t0 = t1;
            }
            asm volatile("s_waitcnt vmcnt(0)" ::: "memory");
        };
        for (int rep2_ = 0; rep2_ < REP_B3; ++rep2_) {
            if (rep2_ > 0) { __syncthreads(); if (F.tid == 0) QCNT[1] = 0; __syncthreads(); }
            run_pass2(true);
        }
        __syncthreads();
        exact = (FLAGW[0] != 0) || (REP_B2 > 1);
        if (exact) {
            __syncthreads();
            for (int i = F.tid; i < 64 * OS_QS; i += 512) OS[i] = 0;
            if (F.tid < 256) { MREF[F.tid] = (int)0x80000000; LS[F.tid] = 0u; }
            if (F.tid < 2) QCNT[F.tid] = 0;
            __syncthreads();
            {
                bf16x8 kf[4][2], kn[4][2], kn2[4][2];
                int t0 = ticket(QCNT), t1 = ticket(QCNT), t2;
                if (t0 < nsp) load_k(1 + t0, kf);
                if (t1 < nsp) load_k(1 + t1, kn);
                while (t0 < nsp) {
                    t2 = ticket(QCNT);
                    if (t2 < nsp) load_k(1 + t2, kn2);
                    int nj; const int ntl = make_list(1 + t0, nj);
                    for (int tl = 0; tl < ntl; ++tl) {
                        bool valid; const int q = col_query(tl, nj, valid);
                        f32x4 st[4]; scores(kf, q, valid, st);
                        float bm = NEG;
#pragma unroll
                        for (int rt = 0; rt < 4; ++rt)
#pragma unroll
                            for (int e = 0; e < 4; ++e) bm = fmaxf(bm, st[rt][e]);
                        bm = xor32_max(xor16_max(bm));
                        if (valid && kq == 0) { const int ib = __float_as_int(bm); const int key = ib >= 0 ? ib : (ib ^ 0x7fffffff);
                            __hip_atomic_fetch_max(MREF + q * 4 + hd, key, __ATOMIC_RELAXED, __HIP_MEMORY_SCOPE_WORKGROUP); }
                    }
#pragma unroll
                    for (int rt = 0; rt < 4; ++rt)
#pragma unroll
                        for (int ks = 0; ks < 2; ++ks) { kf[rt][ks] = kn[rt][ks]; kn[rt][ks] = kn2[rt][ks]; }
                    t0 = t1; t1 = t2;
                }
            }
            __syncthreads();
            run_pass2(false);
            __syncthreads();
        }
        }
        {
            float ms_ = NEG, ls_ = 0.f;
            if (nsp > 0) { const int key = MREF[ql * 4 + gq]; const int ib = key >= 0 ? key : (key ^ 0x7fffffff); const float m0 = exact ? __int_as_float(ib) : mf;
                if ((!exact || key != (int)0x80000000) && m0 > NEG) { ms_ = m0; ls_ = (float)LS[ql * 4 + gq] * (1.0f / 1048576.0f); } }
            const float Mx = fmaxf(mf, ms_);
            const float wf = fexp2((mf - Mx) * AL2E), ws_ = (ms_ > NEG) ? fexp2((ms_ - Mx) * AL2E) : 0.f;
            const float Lt = lf * wf + ls_ * ws_;
            const float g1 = sigmoidf_(bf2f(grow[1])) / fmaxf(Lt, 1e-30f);
            const float cf = g1 * wf, cs = g1 * ws_ * os_inv;
            const LAS int* ap = OS + ql * OS_QS + gq * OS_HS; float osq = 0.f;
            bf16_t* op = oatt + trow * 1024 + (hkv * 4 + gq) * 64;
#pragma unroll
            for (int g4 = 0; g4 < 4; ++g4) { const int d = 8 * g4 + 4 * h;
                const u32x2 p0 = *(const u32x2*)(op + d), p1 = *(const u32x2*)(op + 32 + d);
                const f32x4 f0 = *(const f32x4*)(park + 4 * g4), f1 = *(const f32x4*)(park + 16 + 4 * g4);
                float s0[4], s1[4];
#pragma unroll
                for (int e = 0; e < 4; ++e) { s0[e] = (nsp > 0) ? (float)ap[d + e] : 0.f; s1[e] = (nsp > 0) ? (float)ap[32 + d + e] : 0.f; }
                u32x2 w0, w1;
                w0.x = pk2(bflo(p0.x) + cf * f0[0] + cs * s0[0], bfhi(p0.x) + cf * f0[1] + cs * s0[1]); w0.y = pk2(bflo(p0.y) + cf * f0[2] + cs * s0[2], bfhi(p0.y) + cf * f0[3] + cs * s0[3]);
                w1.x = pk2(bflo(p1.x) + cf * f1[0] + cs * s1[0], bfhi(p1.x) + cf * f1[1] + cs * s1[1]); w1.y = pk2(bflo(p1.y) + cf * f1[2] + cs * s1[2], bfhi(p1.y) + cf * f1[3] + cs * s1[3]);
                *(u32x2*)(op + d) = w0; *(u32x2*)(op + 32 + d) = w1;
                osq += (bflo(w0.x) * bflo(w0.x) + bfhi(w0.x) * bfhi(w0.x)) + (bflo(w0.y) * bflo(w0.y) + bfhi(w0.y) * bfhi(w0.y)) + (bflo(w1.x) * bflo(w1.x) + bfhi(w1.x) * bfhi(w1.x)) + (bflo(w1.y) * bflo(w1.y) + bfhi(w1.y) * bfhi(w1.y)); }
            (void)__hip_atomic_fetch_add(sst + trow * 2, (unsigned long long)(osq * 16777216.f), __ATOMIC_RELAXED, __HIP_MEMORY_SCOPE_AGENT);
        }
    }
    __syncthreads();
}

DI void attn_phase(Frame& F, const bf16_t* proj, const bf16_t* kcb, const bf16_t* vctb, const bf16_t* vts, const bf16_t* vtw, bf16_t* oatt, const unsigned* vmax_word, float* park, unsigned* qctr, const bf16_t* kfs, unsigned long long* sst) {
    const float vmaxf = fmaxf(__uint_as_float(__hip_atomic_load(vmax_word, __ATOMIC_RELAXED, __HIP_MEMORY_SCOPE_AGENT)), 1e-20f);
    int e2 = (int)floorf(log2f(2.0e9f / (1100.0f * 55.0f * vmaxf)));
    e2 = e2 > 100 ? 100 : (e2 < -100 ? -100 : e2);
    const float os_scale = exp2f((float)e2), os_inv = exp2f((float)-e2);
    LAS int* QW = (LAS int*)(F.lds + LDS_QCNT + 8);
    int xq; { unsigned xx; asm volatile("s_getreg_b32 %0, hwreg(20, 0, 4)" : "=s"(xx)); xq = (int)(xx & 7u); }
    for (int tries = 0; tries < 8; ) {
        __syncthreads();
        if (F.tid == 0) QW[0] = (int)__hip_atomic_fetch_add(qctr + xq, 1u, __ATOMIC_RELAXED, __HIP_MEMORY_SCOPE_AGENT);
        __syncthreads();
        const int k = __builtin_amdgcn_readfirstlane(QW[0]);
        if (k >= 192) { xq = (xq + 1) & 7; ++tries; continue; }
        int bh, qb;
        if (xq < 6) { bh = xq; qb = 4 * (63 - k / 3) + (2 - k % 3); }
        else { bh = 3 * (xq - 6) + (k >> 6); qb = 4 * (63 - (k & 63)) + 3; }
        attn_unit(F, proj, kcb, vctb, vts, vtw, oatt, bh, qb, os_scale, os_inv, (float)e2, park + (size_t)F.bid * 16384 + (size_t)F.tid * 32, kfs, sst);
    }
    __syncthreads();
}


#define XB_TMO      128
#define XB_XCNT(j)  (256  + 64 * (j))
#define XB_XSUB(j)  (1280 + 64 * (j))
#define XB_XGEN(j)  (2304 + 64 * (j))
#define XB_TOP      3328
#define XB_TOPGEN   3392
#define XCD_BAR_WORDS 3456
#define XB_SPIN_CAP (1u << 22)
DI unsigned xb_ld(unsigned* p)              { return __hip_atomic_load(p, __ATOMIC_RELAXED, __HIP_MEMORY_SCOPE_AGENT); }
DI unsigned xb_add(unsigned* p, unsigned v) { return __hip_atomic_fetch_add(p, v, __ATOMIC_RELAXED, __HIP_MEMORY_SCOPE_AGENT); }
DI unsigned xb_xcc_id() { unsigned x; asm volatile("s_getreg_b32 %0, hwreg(20, 0, 4)" : "=s"(x)); return x & 0xFu; }
#define XB_SPIN(cond, bar) do { unsigned _sp = 0; while (cond) { __builtin_amdgcn_s_sleep(1); \
    if ((++_sp & 255u) == 0u) { if (xb_ld(&(bar)[XB_TMO])) break; if (_sp > XB_SPIN_CAP) { atomicAdd(&(bar)[XB_TMO], 1u); break; } } } } while (0)
DI void xcd_barrier_complete(unsigned* bar, unsigned x, unsigned& nloc, unsigned& nx) {
    const unsigned G = gridDim.x * gridDim.y * gridDim.z;
    unsigned sum, cnt, mine, sp = 0u;
    for (;;) {
        sum = 0u; cnt = 0u; mine = 0u;
#pragma unroll
        for (unsigned j = 0; j < 16; ++j) { const unsigned c = xb_ld(&bar[XB_XCNT(j)]); sum += c; cnt += (c > 0u) ? 1u : 0u; mine = (j == x) ? c : mine; }
        if (sum == G) break;
        __builtin_amdgcn_s_sleep(1);
        if ((++sp & 255u) == 0u) { if (xb_ld(&bar[XB_TMO])) break; if (sp > XB_SPIN_CAP) { atomicAdd(&bar[XB_TMO], 1u); break; } }
    }
    nloc = mine > 0u ? mine : 1u; nx = cnt > 0u ? cnt : 1u;
}
DI void xcd_barrier(unsigned* bar, volatile LAS unsigned* st, int tid) {
    asm volatile("s_waitcnt vmcnt(0)" ::: "memory");
    __syncthreads();
    if (tid == 0) {
        const unsigned x = xb_xcc_id();
        __builtin_amdgcn_s_waitcnt(0);
        unsigned nloc = st[0], nx = st[1];
        if (nloc == 0u) { xcd_barrier_complete(bar, x, nloc, nx); st[0] = nloc; st[1] = nx; }
        const unsigned old = xb_add(&bar[XB_XSUB(x)], 1u);
        const unsigned gen = old / nloc;
        if (old + 1u == (gen + 1u) * nloc) {
            __builtin_amdgcn_fence(__ATOMIC_RELEASE, "agent");
            asm volatile("s_waitcnt vmcnt(0)" ::: "memory");
            const unsigned og = xb_add(&bar[XB_TOP], 1u);
            const unsigned tg = og / nx;
            if (og + 1u == (tg + 1u) * nx) xb_add(&bar[XB_TOPGEN], 1u);
            else XB_SPIN(xb_ld(&bar[XB_TOPGEN]) == tg, bar);
            __builtin_amdgcn_fence(__ATOMIC_ACQUIRE, "agent");
            xb_add(&bar[XB_XGEN(x)], 1u);
            asm volatile("s_waitcnt vmcnt(0)" ::: "memory");
        } else {
            XB_SPIN(xb_ld(&bar[XB_XGEN(x)]) == gen, bar);
            __builtin_amdgcn_fence(__ATOMIC_ACQUIRE, "agent");
            asm volatile("s_waitcnt vmcnt(0)" ::: "memory");
        }
    }
    __syncthreads();
}

#define REFRESH() do { int w_ = wave0, b_ = blockIdx.x, g_ = gridDim.x; asm volatile("" : "+s"(w_), "+s"(b_), "+s"(g_)); \
    int l_; asm volatile("v_mbcnt_lo_u32_b32 %0, -1, 0\n\tv_mbcnt_hi_u32_b32 %0, -1, %0" : "=v"(l_)); \
    F.lane = l_; F.wave = w_; F.tid = w_ * 64 + l_; F.bid = b_; F.G = g_; F.gw = b_ * 8 + w_; F.ngw = g_ * 8; } while (0)
#define XBAR() xcd_barrier((unsigned*)(F.wsp() + WS_CTL), (volatile LAS unsigned*)(F.lds + LDS_PT + 232), F.tid)
#if REP_SYNC > 1
#define GSYNC() do { XBAR(); XBAR(); REFRESH(); } while (0)
#else
#define GSYNC() do { REFRESH(); XBAR(); REFRESH(); } while (0)
#endif
#define WSP(off) (F.wsp() + (off))
#define WL(off) (F.wsp() + WS_W + (size_t)l * WL_STRIDE + (off))
#define MSL(off) (F.wsp() + WS_MISC + (size_t)l * MS_L + (off))
#define CTL(off) (F.wsp() + WS_CTL + CT_BASE + (size_t)l * CT_L + (off))
__global__ void __launch_bounds__(512, 2) mk_fwd(Params p) {
    extern __shared__ __attribute__((aligned(16))) unsigned char lds_raw[];
    cg::grid_group grid = cg::this_grid();
    Frame F;
    F.lds = (LAS unsigned char*)lds_raw; F.pt = (LAS const unsigned long long*)(F.lds + LDS_PT);
    const int wave0 = __builtin_amdgcn_readfirstlane((int)threadIdx.x >> 6);
    REFRESH();
    {
        LAS unsigned long long* ptw = (LAS unsigned long long*)(F.lds + LDS_PT);
        if (F.tid < 26) ptw[F.tid] = (unsigned long long)p.in[F.tid];
        if (F.tid == 26) ptw[26] = (unsigned long long)p.out;
        if (F.tid == 27) ptw[27] = (unsigned long long)p.ws;
        if (F.tid == 28) ptw[29] = 0ull;
        if (F.tid == 0) (void)xb_add((unsigned*)p.ws + XB_XCNT(xb_xcc_id()), 1u);
    }
    __syncthreads();

    PH(2, convert_rows_stats(F, F.in(0), (bf16_t*)WSP(WS_ACT), (unsigned long long*)WSP(WS_SSX)); REFRESH(););
    { unsigned long long* z = (unsigned long long*)WSP(WS_SSX) + (size_t)NT * 2; for (int i = F.bid * 512 + F.tid; i < (NL - 1) * NT * 2; i += F.G * 512) z[i] = 0ull; }
    { unsigned long long* z = (unsigned long long*)WSP(WS_SST); for (int i = F.bid * 512 + F.tid; i < NL * NT * 2; i += F.G * 512) z[i] = 0ull; }
    PH(0, prologue_a(F, 0, F.gw, F.ngw); REFRESH(););
    if (F.G == 0x7fffffff) grid.sync();
    GSYNC();
    PH(1, prologue_b(F); REFRESH(););
    if (F.G != 256) { prologue_a(F, 1, F.gw, F.ngw); __syncthreads(); REFRESH(); }
    else if (F.bid >= 128) { prologue_a(F, 1, (F.bid - 128) * 8 + F.wave, 1024); __syncthreads(); REFRESH(); }

#if STAGE >= 2
#pragma unroll 1
    for (int l = 0; l < NL; ++l) {
        REFRESH();
        { pg8::APlain g{(l == 0) ? (const char*)WSP(WS_ACT) : (const char*)F.out(), (const char*)WL(WO_WIN), 1024}; pg8::StaticOrder S; S.init(NT / 256, PW / 256, F.G, F.bid);
          pg8::EpiBf16 E{(bf16_t*)WSP(WS_PROJ), PW, (const unsigned long long*)WSP(WS_SSX) + (size_t)l * NT * 2}; pg8::gemm_phase<pg8::EpiBf16, pg8::APlain, true>(F.lds, g, S, E, F.tid); }
#if REP_INPROJ > 1
        REFRESH();
        { pg8::APlain g{(l == 0) ? (const char*)WSP(WS_ACT) : (const char*)F.out(), (const char*)WL(WO_WIN), 1024}; pg8::StaticOrder S; S.init(NT / 256, PW / 256, F.G, F.bid);
          pg8::EpiBf16 E{(bf16_t*)WSP(WS_PROJ), PW, (const unsigned long long*)WSP(WS_SSX) + (size_t)l * NT * 2}; pg8::gemm_phase<pg8::EpiBf16, pg8::APlain, true>(F.lds, g, S, E, F.tid); }
#endif
        GSYNC();
#define LOCAL_HANDOFF() do { asm volatile("s_waitcnt vmcnt(0)" ::: "memory"); __syncthreads(); if (F.tid == 0) { __builtin_amdgcn_fence(__ATOMIC_ACQUIRE, "agent"); asm volatile("s_waitcnt vmcnt(0)" ::: "memory"); } __syncthreads(); } while (0)
        if (F.G == 256) {
            if (F.bid < 48) {
                REFRESH();
                { pg8::ACompress g{(const char*)WSP(WS_PROJ), (const char*)WL(WO_W1)}; pg8::StaticOrder S; S.init_run(F.bid, 0, 1);
                  pg8::EpiCmpHid E{(bf16_t*)WSP(WS_HIDC), (const float*)CTL(CT_CB1)}; pg8::gemm_phase<pg8::EpiCmpHid, pg8::ACompress, true>(F.lds, g, S, E, F.tid); }
                REFRESH(); LOCAL_HANDOFF(); REFRESH();
                { const int pm = F.bid, it = (pm / 24) * 192 + (pm % 24) * 8 + F.wave;
                  compress2_phase(F, (const bf16_t*)WSP(WS_HIDC), (const bf16_t*)CTL(CT_W2T), F.in(7) + (size_t)l * 2 * 64, (bf16_t*)WSP(WS_KC), (bf16_t*)WSP(WS_VCT), it, it + 1, 1); }
            } else if (F.bid < 80) {
                REFRESH();
                { pg8::ASsm1 g{(const char*)WSP(WS_UC), (const char*)WL(WO_SS1)}; pg8::StaticOrder S; S.init_run((F.bid - 48) * 4, 1, 4);
                  pg8::EpiSsm1 E{(float*)WSP(WS_YI), (float*)WSP(WS_HL)}; pg8::gemm_phase<pg8::EpiSsm1, pg8::ASsm1, true>(F.lds, g, S, E, F.tid); }
                REFRESH(); LOCAL_HANDOFF(); REFRESH();
                ssm_carry_phase(F, (const float*)WSP(WS_HL), (const f32x2*)CTL(CT_AB16), (const f32x2*)CTL(CT_AB1K), (bf16_t*)WSP(WS_HIN), F.bid - 48, F.bid - 47, 1);
            } else {
                REFRESH();
                vtranspose_phase(F, (const bf16_t*)WSP(WS_PROJ), (bf16_t*)WSP(WS_VTS), (bf16_t*)WSP(WS_VTW), (bf16_t*)WSP(WS_KFS), (unsigned*)WSP(WS_CTL) + 3584 + l, 80);
                __syncthreads(); REFRESH();
                { pg8::ASsm1 g{(const char*)WSP(WS_UC), (const char*)WL(WO_SS1)}; pg8::StaticOrder S; S.init(128, 1, 176, F.bid - 80);
                  pg8::EpiSsm1 E{(float*)WSP(WS_YI), (float*)WSP(WS_HL)}; pg8::gemm_phase<pg8::EpiSsm1, pg8::ASsm1, true>(F.lds, g, S, E, F.tid); }
            }
            GSYNC();
        } else {
        PH(3, REFRESH(); vtranspose_phase(F, (const bf16_t*)WSP(WS_PROJ), (bf16_t*)WSP(WS_VTS), (bf16_t*)WSP(WS_VTW), (bf16_t*)WSP(WS_KFS), (unsigned*)WSP(WS_CTL) + 3584 + l, 48);
        __syncthreads(); REFRESH(););
        PH(4, REFRESH();
        { pg8::ACompress g{(const char*)WSP(WS_PROJ), (const char*)WL(WO_W1)}; pg8::StaticOrder S; S.init(48, 1, F.G, F.bid);
          pg8::EpiCmpHid E{(bf16_t*)WSP(WS_HIDC), (const float*)CTL(CT_CB1)}; pg8::gemm_phase<pg8::EpiCmpHid, pg8::ACompress, true>(F.lds, g, S, E, F.tid); });
        PH(5, REFRESH();
        { pg8::ASsm1 g{(const char*)WSP(WS_UC), (const char*)WL(WO_SS1)}; pg8::StaticOrder S; S.init(128, 2, F.G, F.bid);
          pg8::EpiSsm1 E{(float*)WSP(WS_YI), (float*)WSP(WS_HL)}; pg8::gemm_phase<pg8::EpiSsm1, pg8::ASsm1, true>(F.lds, g, S, E, F.tid); });
        GSYNC();
        PH(6, compress2_phase(F, (const bf16_t*)WSP(WS_HIDC), (const bf16_t*)CTL(CT_W2T), F.in(7) + (size_t)l * 2 * 64, (bf16_t*)WSP(WS_KC), (bf16_t*)WSP(WS_VCT), F.gw, 2 * 192, F.ngw);
        __syncthreads(); REFRESH(););
        PH(7, ssm_carry_phase(F, (const float*)WSP(WS_HL), (const f32x2*)CTL(CT_AB16), (const f32x2*)CTL(CT_AB1K), (bf16_t*)WSP(WS_HIN), F.bid, 32, F.G); REFRESH(););
        GSYNC();
        }
        PH(8,         REFRESH();
        { pg8::ASsm2 g{(const char*)WSP(WS_HIN), (const char*)WL(WO_SS2)}; pg8::StaticOrder S; S.init(128, 1, F.G, F.bid);
          pg8::EpiSsm2 E{(const float*)WSP(WS_YI), (const bf16_t*)WSP(WS_PROJ), F.in(15) + (size_t)l * 256, (bf16_t*)WSP(WS_YS2)}; pg8::gemm_phase<pg8::EpiSsm2, pg8::ASsm2, true>(F.lds, g, S, E, F.tid); });
#if STAGE >= 3
        REFRESH();
        attn_phase(F, (const bf16_t*)WSP(WS_PROJ), (const bf16_t*)WSP(WS_KC), (const bf16_t*)WSP(WS_VCT), (const bf16_t*)WSP(WS_VTS), (const bf16_t*)WSP(WS_VTW), (bf16_t*)WSP(WS_OATT), (const unsigned*)WSP(WS_CTL) + 3584 + l, (float*)WSP(WS_PARK), (unsigned*)WSP(WS_CTL) + 3600 + 16 * l, (const bf16_t*)WSP(WS_KFS), (unsigned long long*)WSP(WS_SST) + (size_t)l * NT * 2);
#if REP_ATTN > 1
        REFRESH();
        attn_phase(F, (const bf16_t*)WSP(WS_PROJ), (const bf16_t*)WSP(WS_KC), (const bf16_t*)WSP(WS_VCT), (const bf16_t*)WSP(WS_VTS), (const bf16_t*)WSP(WS_VTW), (bf16_t*)WSP(WS_OATT), (const unsigned*)WSP(WS_CTL) + 3584 + l, (float*)WSP(WS_PARK), (unsigned*)WSP(WS_CTL) + 3600 + 16 * l, (const bf16_t*)WSP(WS_KFS), (unsigned long long*)WSP(WS_SST) + (size_t)l * NT * 2);
#endif
#else
        { unsigned* oz = (unsigned*)WSP(WS_OATT); for (size_t i = (size_t)F.bid * 512 + F.tid; i < (size_t)NT * 768 / 2; i += (size_t)F.G * 512) oz[i] = 0u; }
#endif
        GSYNC();
        PH(9,         REFRESH();
        { pg8::APlain g{(const char*)WSP(WS_YS2), (const char*)MSL(MS_WGLU), 256}; pg8::StaticOrder S; S.init(NT / 256, 2, F.G, F.bid);
          pg8::EpiGlu E{(bf16_t*)WSP(WS_OATT), F.in(17) + (size_t)l * 512, (unsigned long long*)WSP(WS_SST) + (size_t)l * NT * 2}; pg8::gemm_phase<pg8::EpiGlu, pg8::APlain, true>(F.lds, g, S, E, F.tid); });
        GSYNC();
        REFRESH();
        { pg8::APlain g{(const char*)WSP(WS_OATT), (const char*)WL(WO_WOUT), 1024}; pg8::StaticOrder S; S.init(NT / 256, 4, F.G, F.bid);
          pg8::EpiResB<true, 0> E{(l == 0) ? F.in(0) : (const float*)nullptr, (const bf16_t*)F.out(), (bf16_t*)F.out(), (const unsigned long long*)WSP(WS_SST) + (size_t)l * NT * 2, (unsigned long long*)nullptr}; pg8::gemm_phase<pg8::EpiResB<true, 0>, pg8::APlain, true>(F.lds, g, S, E, F.tid); }
        GSYNC();
#if STAGE >= 4
        PH(11, rmsnorm_rows_xb<1>(F, (const bf16_t*)F.out(), F.in(21) + (size_t)l * DM, WSP(WS_ACT)); REFRESH(););
        GSYNC();
        REFRESH();
        { pg8::APlain g{(const char*)WSP(WS_ACT), (const char*)WL(WO_WGU), 512, 0x7c7c7c7c, 0x7c7c7c7c}; pg8::StaticOrder S; S.init(NT / 256, 22, F.G, F.bid);
          pg8::EpiSwiglu8 E{(unsigned char*)WSP(WS_PROJ), 0.015625f * FP8FIX}; pg8::gemm_phase<pg8::EpiSwiglu8, pg8::APlain, true, true>(F.lds, g, S, E, F.tid); }
        GSYNC();
        REFRESH();
        { pg8::APlain g{(const char*)WSP(WS_PROJ), (const char*)WL(WO_WD), DFF / 2, 0x7b7b7b7b, 0x7b7b7b7b}; pg8::StaticOrder S; S.init(NT / 256, 4, F.G, F.bid);
          pg8::EpiResB<false, 8> E{(const float*)nullptr, (const bf16_t*)F.out(), (l == NL - 1) ? (bf16_t*)WSP(WS_XLAST) : (bf16_t*)F.out(), (const unsigned long long*)nullptr, (l == NL - 1) ? (unsigned long long*)nullptr : (unsigned long long*)WSP(WS_SSX) + (size_t)(l + 1) * NT * 2}; pg8::gemm_phase<pg8::EpiResB<false, 8>, pg8::APlain, true, true>(F.lds, g, S, E, F.tid); }
        GSYNC();
#endif
#if STAGE < 5
        break;
#endif
    }
    rmsnorm_rows_xb<2>(F, (const bf16_t*)WSP(WS_XLAST), F.in(25), F.out());
#else
    {
        const float* x0 = F.in(0); const float* fg = F.in(25); float* X = F.out();
        for (int m = F.gw; m < NT; m += F.ngw) {
            const f32x4* xr = (const f32x4*)(x0 + (size_t)m * DM) + F.lane; f32x4 v[4]; float s = 0.f;
#pragma unroll
            for (int j = 0; j < 4; ++j) { v[j] = xr[64 * j]; s += (v[j].x * v[j].x + v[j].y * v[j].y) + (v[j].z * v[j].z + v[j].w * v[j].w); }
            const float rstd = rsqrtf(wave_sum(s) * (1.f / DM) + 1e-6f);
            f32x4* o = (f32x4*)(X + (size_t)m * DM) + F.lane;
#pragma unroll
            for (int j = 0; j < 4; ++j) o[64 * j] = v[j] * rstd * ((const f32x4*)fg)[64 * j + F.lane];
        }
    }
#endif
}

extern "C" void kernel_launch(void* const* d_in, const int* in_sizes, int n_in, void* d_out, int out_size, void* d_ws, size_t ws_size, hipStream_t stream) {
    static int grid_blocks = 0;
    if (grid_blocks == 0) {
        if (n_in != 26 || ws_size < WS_END) { fprintf(stderr, "kernel_launch: unexpected n_in %d or ws_size %zu (< %zu)\n", n_in, ws_size, (size_t)WS_END); grid_blocks = -1; return; }
        int dev = 0, cus = 0, per_cu = 0;
        hipGetDevice(&dev);
        hipDeviceGetAttribute(&cus, hipDeviceAttributeMultiprocessorCount, dev);
        hipFuncSetAttribute((const void*)mk_fwd, hipFuncAttributeMaxDynamicSharedMemorySize, LDS_BYTES);
        hipOccupancyMaxActiveBlocksPerMultiprocessor(&per_cu, (const void*)mk_fwd, 512, LDS_BYTES);
        if (per_cu < 1) { fprintf(stderr, "kernel_launch: occupancy query says %d blocks per CU\n", per_cu); per_cu = 1; }
        grid_blocks = cus;
        (void)hipGetLastError();
    }
    if (grid_blocks < 0) return;
    if (hipMemsetAsync((char*)d_ws + WS_CTL, 0, 16384, stream) != hipSuccess) { fprintf(stderr, "kernel_launch: memset of the barrier words failed\n"); return; }
    Params p{};
    for (int i = 0; i < 26; ++i) p.in[i] = (const float*)d_in[i];
    p.out = (float*)d_out; p.ws = (unsigned char*)d_ws;
    void* args[] = {&p};
    hipError_t e = hipLaunchCooperativeKernel((const void*)mk_fwd, dim3(grid_blocks), dim3(512), args, LDS_BYTES, stream);
    if (e != hipSuccess) fprintf(stderr, "cooperative launch failed: %s (grid %d)\n", hipGetErrorString(e), grid_blocks);
}
```

```cpp
#include <hip/hip_runtime.h>
#include <hip/hip_cooperative_groups.h>
#include <cstdio>
#include <cstdint>
namespace cg = cooperative_groups;

#ifndef STAGE
#define STAGE 99
#endif
#ifndef REP_ATTN
#define REP_ATTN 1
#endif
#ifndef REP_B1
#define REP_B1 1
#endif
#ifndef REP_B2
#define REP_B2 1
#endif
#ifndef REP_B3
#define REP_B3 1
#endif
#ifndef REP_TK
#define REP_TK 1
#endif
#ifndef FP8FIX
#define FP8FIX 1.0f
#endif
#ifndef PROBE_DUP
#define PROBE_DUP 0
#endif
#define PH(bit, ...) do { __VA_ARGS__ if (PROBE_DUP & (1 << (bit))) { __VA_ARGS__ } } while (0)
#ifndef REP_GU
#define REP_GU 1
#endif
#ifndef REP_INPROJ
#define REP_INPROJ 1
#endif
#ifndef REP_SYNC
#define REP_SYNC 1
#endif

#define DI __device__ __forceinline__
#define LAS __attribute__((address_space(3)))
typedef unsigned short bf16_t;
typedef short bf16x8 __attribute__((ext_vector_type(8)));
typedef short s16x4 __attribute__((ext_vector_type(4)));
typedef float f32x4 __attribute__((ext_vector_type(4)));
typedef float f32x2 __attribute__((ext_vector_type(2)));
typedef float f32x16 __attribute__((ext_vector_type(16)));
typedef unsigned u32x4 __attribute__((ext_vector_type(4)));
typedef unsigned u32x2 __attribute__((ext_vector_type(2)));
typedef __bf16 bf2_t __attribute__((ext_vector_type(2)));
typedef int i32x8 __attribute__((ext_vector_type(8)));
typedef int i32x4 __attribute__((ext_vector_type(4)));

DI float clamp8(float v) { return fminf(fmaxf(v, -440.f), 440.f); }
DI unsigned pk4_fp8(float a, float b, float c, float d) { int w = 0; w = __builtin_amdgcn_cvt_pk_fp8_f32(clamp8(a), clamp8(b), w, false); w = __builtin_amdgcn_cvt_pk_fp8_f32(clamp8(c), clamp8(d), w, true); return (unsigned)w; }
DI unsigned pk2(float lo, float hi) { f32x2 v = {lo, hi}; return __builtin_bit_cast(unsigned, __builtin_convertvector(v, bf2_t)); }
DI bf16_t f2bf(float f) { return (bf16_t)(pk2(f, 0.f) & 0xffffu); }
DI float bf2f(bf16_t u) { return __uint_as_float((unsigned)u << 16); }
DI float bflo(unsigned w) { return __uint_as_float(w << 16); }
DI float bfhi(unsigned w) { return __uint_as_float(w & 0xffff0000u); }
DI float fexp2(float x) { return __builtin_amdgcn_exp2f(x); }
DI float sigmoidf_(float x) { return __builtin_amdgcn_rcpf(1.0f + __builtin_amdgcn_exp2f(-1.4426950408889634f * x)); }
DI float gelu_tanh(float x) { const float y = 0.7978845608028654f * (x + 0.044715f * x * x * x); return x * __builtin_amdgcn_rcpf(1.0f + __builtin_amdgcn_exp2f(-2.8853900817779268f * y)); }
template <int CTRL> DI float dppf(float v) { return __builtin_bit_cast(float, __builtin_amdgcn_update_dpp(0, __builtin_bit_cast(int, v), CTRL, 0xF, 0xF, false)); }
struct F2 { float lo, hi; };
DI F2 halves32(float v) { const auto r = __builtin_amdgcn_permlane32_swap(__float_as_uint(v), __float_as_uint(v), false, false); return {__uint_as_float(r[0]), __uint_as_float(r[1])}; }
DI F2 rows16(float v) { const auto r = __builtin_amdgcn_permlane16_swap(__float_as_uint(v), __float_as_uint(v), false, false); return {__uint_as_float(r[0]), __uint_as_float(r[1])}; }
DI float xor32_sum(float v) { const F2 p = halves32(v); return p.lo + p.hi; }
DI float xor32_max(float v) { const F2 p = halves32(v); return fmaxf(p.lo, p.hi); }
DI float xor16_sum(float v) { const F2 p = rows16(v); return p.lo + p.hi; }
DI float xor16_max(float v) { const F2 p = rows16(v); return fmaxf(p.lo, p.hi); }
DI float wave_sum(float v) {
    v += dppf<0xB1>(v); v += dppf<0x4E>(v); v += dppf<0x141>(v); v += dppf<0x140>(v);
    return xor32_sum(xor16_sum(v));
}

DI unsigned wave_max_u32(unsigned v) {
    v = max(v, (unsigned)__builtin_amdgcn_update_dpp(0, (int)v, 0xB1, 0xF, 0xF, false));
    v = max(v, (unsigned)__builtin_amdgcn_update_dpp(0, (int)v, 0x4E, 0xF, 0xF, false));
    v = max(v, (unsigned)__builtin_amdgcn_update_dpp(0, (int)v, 0x141, 0xF, 0xF, false));
    v = max(v, (unsigned)__builtin_amdgcn_update_dpp(0, (int)v, 0x140, 0xF, 0xF, false));
    const unsigned a = __builtin_amdgcn_readlane(v, 0), b = __builtin_amdgcn_readlane(v, 16), c = __builtin_amdgcn_readlane(v, 32), d = __builtin_amdgcn_readlane(v, 48);
    return max(max(a, b), max(c, d));
}

constexpr int NB = 2, SEQ = 16384, DM = 1024, NT = NB * SEQ, NL = 2;
constexpr int PW = 2304;
constexpr int C_Q = 0, C_KC = 768, C_VC = 960, C_KS = 1152, C_VS = 1344, C_KW = 1536, C_VW = 1728, C_U = 1920, C_G = 2176;
constexpr int DFF = 2816;
constexpr float L2E = 1.4426950408889634f;

constexpr size_t MiB = 1u << 20;
constexpr size_t WS_CTL = 0;
constexpr size_t WS_W = 1 * MiB;
constexpr size_t WL_STRIDE = 32 * MiB;
constexpr size_t WO_WIN = 0;
constexpr size_t WO_WOUT = 5 * MiB;
constexpr size_t WO_WGU = 7 * MiB;
constexpr size_t WO_WD = 18 * MiB;
constexpr size_t WO_W1 = 24 * MiB;
constexpr size_t WO_SS1 = 26 * MiB;
constexpr size_t WO_SS2 = 30 * MiB;
constexpr size_t CT_L = 256 * 1024;
constexpr size_t CT_BASE = 64 * 1024;
constexpr size_t CT_AB16 = 0;
constexpr size_t CT_AB1K = 8 * 1024;
constexpr size_t CT_CB1 = 16 * 1024;
constexpr size_t CT_W2T = 20 * 1024;
constexpr size_t CT_WGLU = 84 * 1024;
constexpr size_t WS_ACT = WS_W + 2 * WL_STRIDE;
constexpr size_t WS_PROJ = WS_ACT + 64 * MiB;
constexpr size_t WS_OATT = WS_PROJ + 176 * MiB;
constexpr size_t WS_OSSM = WS_OATT + 48 * MiB;
constexpr size_t WS_YS2 = WS_OSSM + 16 * MiB;
constexpr size_t WS_YI = WS_ACT;
constexpr size_t WS_HL = WS_YS2 + 16 * MiB;
constexpr size_t WS_HIN = WS_HL + 16 * MiB;
constexpr size_t WS_VTS = WS_HIN + 16 * MiB;
constexpr size_t WS_VTW = WS_VTS + 12 * MiB;
constexpr size_t WS_KC = WS_VTW + 12 * MiB;
constexpr size_t WS_VCT = WS_KC + 1 * MiB;
constexpr size_t WS_HIDC = WS_VCT + 1 * MiB;
constexpr size_t WS_MISC = WS_HIDC + 6 * MiB;
constexpr size_t WS_PARK = WS_MISC + 4 * MiB;
constexpr size_t WS_KFS = WS_PARK + 16 * MiB;
constexpr size_t WS_SST = WS_KFS + 12 * MiB;
constexpr size_t WS_SSX = WS_SST + 1 * MiB;
constexpr size_t WS_UC = WS_SSX + 1 * MiB;
constexpr size_t WS_END = WS_UC + 16 * MiB;
constexpr size_t WS_XLAST = WS_PROJ + 96 * MiB;
constexpr size_t MS_L = 2 * MiB;
constexpr size_t MS_MTAB = 0;
constexpr size_t MS_CBP = 256 * 1024;
constexpr size_t MS_WGLU = 512 * 1024;
constexpr size_t MS_BBAR = 1024 * 1024;
constexpr size_t MS_FTAB = 1024 * 1024 + 128 * 1024;

constexpr int LDS_BYTES = 143360;

struct Params { const float* in[26]; float* out; unsigned char* ws; };

namespace pg8 {
constexpr int BM = 256, BK = 64, HALF = 128, HTB = HALF * BK * 2, STAGE_BYTES = 8 * HTB, NXCD = 8, WGM = 8;
__host__ __device__ __forceinline__ int lds_byte(int r, int c) { const int st = (r >> 4) * 2 + (c >> 5), rr = r & 15, cc = c & 31, ob = rr * 64 + cc * 2; return st * 1024 + (ob ^ (((ob >> 9) & 1) << 5)); }
__host__ __device__ __forceinline__ void stage_rc(int b, int& R, int& C) { const int st = b / 1024, sb = b % 1024, swz = sb ^ (((sb >> 9) & 1) << 5); R = (st >> 1) * 16 + swz / 64; C = (st & 1) * 32 + (swz % 64) / 2; }
__host__ __device__ __forceinline__ int perm32(int rho) { const int n = rho >> 4, i = rho & 15; return 8 * (i >> 2) + 4 * n + (i & 3); }
struct Unit { int pm, pn, part; };
constexpr int ROWTAB_OFF = STAGE_BYTES;
struct StaticOrder {
    int nM, nN, nwg, G, c, lmode = 0, lbase = 0, lpn = 0, lcount = 0;
    __device__ void init(int nM_, int nN_, int G_, int c_) { nM = nM_; nN = nN_; nwg = nM * nN; G = G_; c = c_; lmode = 0; }
    __device__ void init_run(int base, int pn, int count) { lmode = 1; lbase = base; lpn = pn; lcount = count; nM = 0; nN = 0; nwg = 0; G = 1; c = 0; }
    __device__ bool next(int i, Unit& u) const {
        if (lmode == 1) { if (i >= lcount) return false; u.pm = lbase + i; u.pn = lpn; return true; }
        const long L = (long)i * G + c; if (L >= nwg) return false;
        int wgid = (int)L; { const int q = nwg / NXCD, r = nwg % NXCD, xcd = wgid % NXCD, off = wgid / NXCD; wgid = (xcd < r ? xcd * (q + 1) : r * (q + 1) + (xcd - r) * q) + off; }
        const int nig = WGM * nN, gid = wgid / nig, fm = gid * WGM, gsz = (nM - fm) < WGM ? (nM - fm) : WGM;
        u.pm = fm + ((wgid % nig) % gsz); u.pn = (wgid % nig) / gsz; return true;
    }
};

template <class Epi, class Addr, bool ALIGN_EPI, bool FP8 = false>
__device__ __forceinline__ void gemm_phase(LAS unsigned char* lds, const Addr& g, const StaticOrder& S, const Epi& E, int tid) {
    asm volatile("" : "+v"(tid));
    const int wid = __builtin_amdgcn_readfirstlane(tid >> 6), lane = tid & 63, wr = wid >> 2, wc = wid & 3, fr = lane & 15, fq = lane >> 4;
    const int K = g.K(), nt0 = K / BK;
    unsigned voffA[2], voffB[2];
#pragma unroll
    for (int i = 0; i < 2; ++i) { int R, C; stage_rc(tid * 16 + i * 8192, R, C); const int Rb = Epi::PERM ? ((R & ~31) + perm32(R & 31)) : R;
        voffA[i] = (unsigned)R * g.a_row_bytes() + g.a_col_off(C); voffB[i] = (unsigned)(Rb * K + C) * 2u; }
    const size_t kstepA = g.a_kstep(), kstepB = (size_t)(BK * 2);
    const size_t hstepA = (size_t)HALF * g.a_row_bytes(), hstepB = (size_t)HALF * K * 2;
    const unsigned ldsw = (unsigned)wid * 1024u;
    const int aoff = lds_byte(wr * 64 + fr, fq * 8), boff = lds_byte(wc * 32 + fr, fq * 8);
#define PG8_SA(b, h) (((b) * 2 + (h)) * HTB)
#define PG8_SB(b, h) ((4 + (b) * 2 + (h)) * HTB)
#define PG8_STAGE(bufoff, gbase, voff) do { _Pragma("unroll") for (int _i = 0; _i < 2; ++_i) \
        __builtin_amdgcn_global_load_lds((const unsigned*)((const char*)(gbase) + (voff)[_i]), (LAS unsigned*)(lds + (bufoff) + ldsw + _i * 8192), 16, 0, 0); } while (0)
#define PG8_LDA(dst, b, h) do { _Pragma("unroll") for (int m = 0; m < 4; ++m) _Pragma("unroll") for (int k = 0; k < 2; ++k) dst[m][k] = *(const LAS bf16x8*)(lds + PG8_SA(b, h) + aoff + m * 2048 + k * 1024); } while (0)
#define PG8_LDB(dst, b, h) do { _Pragma("unroll") for (int n = 0; n < 2; ++n) _Pragma("unroll") for (int k = 0; k < 2; ++k) dst[n][k] = *(const LAS bf16x8*)(lds + PG8_SB(b, h) + boff + n * 2048 + k * 1024); } while (0)
#define PG8_CAT(x, y) __builtin_bit_cast(i32x8, __builtin_shufflevector((x), (y), 0, 1, 2, 3, 4, 5, 6, 7, 8, 9, 10, 11, 12, 13, 14, 15))
#define PG8_MMA(ai, bj, At, Bt) do { __builtin_amdgcn_s_setprio(1); _Pragma("unroll") for (int m = 0; m < 4; ++m) _Pragma("unroll") for (int n = 0; n < 2; ++n) { \
        if constexpr (FP8) { const i32x8 bw_ = PG8_CAT(Bt[n][0], Bt[n][1]), aw_ = PG8_CAT(At[m][0], At[m][1]); \
            asm volatile("v_mfma_f32_16x16x128_f8f6f4 %0, %1, %2, %0" : "+v"(acc[ai][bj][m][n]) : "v"(bw_), "v"(aw_));   } \
        else { _Pragma("unroll") for (int k = 0; k < 2; ++k) acc[ai][bj][m][n] = __builtin_amdgcn_mfma_f32_16x16x32_bf16(Bt[n][k], At[m][k], acc[ai][bj][m][n], 0, 0, 0); } } \
        __builtin_amdgcn_s_setprio(0); } while (0)
#define PG8_WAIT_V(n) asm volatile("s_waitcnt vmcnt(" #n ")" ::: "memory")
#define PG8_WAIT_L(n) asm volatile("s_waitcnt lgkmcnt(" #n ")" ::: "memory")
#define PG8_BAR __builtin_amdgcn_s_barrier()
#define PG8_SCHED __builtin_amdgcn_sched_barrier(0)
    Unit cur, nxt; int ui = 0;
    constexpr bool SPLIT = Epi::MID_T > 0;
    auto get_unit = [&](int i, Unit& u) -> bool { if constexpr (SPLIT) { const bool ok = S.next(i >> 1, u); u.part = i & 1; return ok; } else { const bool ok = S.next(i, u); u.part = 0; return ok; } };
    auto part_off = [&](const Unit& u) -> size_t { if constexpr (SPLIT) return (size_t)u.part * (Epi::MID_T * BK * 2); else return 0; };
    if (!get_unit(0, cur)) return;
    f32x4 acc[2][2][4][2];
#pragma unroll
    for (int a = 0; a < 2; ++a)
#pragma unroll
        for (int b = 0; b < 2; ++b)
#pragma unroll
            for (int m = 0; m < 4; ++m)
#pragma unroll
                for (int n = 0; n < 2; ++n) acc[a][b][m][n] = (f32x4){0.f, 0.f, 0.f, 0.f};
    bf16x8 At[4][2], B0[2][2], B1[2][2];
    const char* cA = g.a_base(cur) + part_off(cur); const char* cB = g.b_base(cur) + part_off(cur);
    PG8_STAGE(PG8_SB(0, 0), cB, voffB); PG8_STAGE(PG8_SB(0, 1), cB + hstepB, voffB); PG8_STAGE(PG8_SA(0, 0), cA, voffA); PG8_STAGE(PG8_SA(0, 1), cA + hstepA, voffA);
    if (wr == 1) PG8_BAR;
    PG8_WAIT_V(2); PG8_BAR;
    PG8_STAGE(PG8_SB(1, 0), cB + kstepB, voffB); PG8_STAGE(PG8_SA(1, 0), cA + kstepA, voffA); PG8_STAGE(PG8_SB(1, 1), cB + hstepB + kstepB, voffB);
    PG8_WAIT_V(6); PG8_BAR;
    for (;;) {
        const bool has_next = get_unit(ui + 1, nxt);
        const char* nA = has_next ? g.a_base(nxt) + part_off(nxt) : cA; const char* nB = has_next ? g.b_base(nxt) + part_off(nxt) : cB;
        int nt = nt0; if constexpr (SPLIT) nt = cur.part ? nt0 - Epi::MID_T : Epi::MID_T;
        for (int t = 0; t < nt; t += 2) {
            const bool last = (t == nt - 2);
            if constexpr (Epi::ROWTAB) {
                if (t == 0 && wid < 4 && cur.part == 0) {
                    int l_; asm volatile("v_mbcnt_lo_u32_b32 %0, -1, 0\n\tv_mbcnt_hi_u32_b32 %0, -1, %0" : "=v"(l_));
                    __builtin_amdgcn_global_load_lds((const unsigned*)(E.rowtab + ((size_t)cur.pm * BM + wid * 64 + l_) * 2), (LAS unsigned*)(lds + ROWTAB_OFF + ((SPLIT ? (ui >> 1) : ui) & 1) * 4096 + wid * 1024), 16, 0, 0); } }
            const char* a1 = cA + (size_t)(t + 1) * kstepA;
            const char* a2 = last ? nA : cA + (size_t)(t + 2) * kstepA; const char* b2 = last ? nB : cB + (size_t)(t + 2) * kstepB;
            const char* a3 = a2 + kstepA; const char* b3 = b2 + kstepB;
            PG8_LDB(B0, 0, 0); PG8_LDB(B1, 0, 1); PG8_SCHED; PG8_LDA(At, 0, 0); PG8_STAGE(PG8_SA(1, 1), a1 + hstepA, voffA);
            PG8_WAIT_V(8); PG8_WAIT_L(0); PG8_BAR; PG8_MMA(0, 0, At, B0); PG8_MMA(0, 1, At, B1); PG8_BAR; PG8_SCHED;
            PG8_LDA(At, 0, 1); PG8_STAGE(PG8_SB(0, 0), b2, voffB); PG8_STAGE(PG8_SB(0, 1), b2 + hstepB, voffB); PG8_STAGE(PG8_SA(0, 0), a2, voffA);
            PG8_WAIT_V(8); PG8_WAIT_L(0); PG8_BAR; PG8_MMA(1, 0, At, B0); PG8_MMA(1, 1, At, B1); PG8_BAR; PG8_SCHED;
            PG8_LDB(B0, 1, 0); PG8_LDB(B1, 1, 1); PG8_SCHED; PG8_LDA(At, 1, 0); PG8_STAGE(PG8_SA(0, 1), a2 + hstepA, voffA);
            PG8_WAIT_V(8); PG8_WAIT_L(0); PG8_BAR; PG8_MMA(0, 0, At, B0); PG8_MMA(0, 1, At, B1); PG8_BAR; PG8_SCHED;
            PG8_LDA(At, 1, 1); PG8_STAGE(PG8_SB(1, 0), b3, voffB); PG8_STAGE(PG8_SB(1, 1), b3 + hstepB, voffB); PG8_STAGE(PG8_SA(1, 0), a3, voffA);
            PG8_WAIT_V(8); PG8_WAIT_L(0); PG8_BAR; PG8_MMA(1, 0, At, B0); PG8_MMA(1, 1, At, B1); PG8_BAR; PG8_SCHED;
        }
        if constexpr (ALIGN_EPI) { if (wr == 0) PG8_BAR; }
        if constexpr (FP8) asm volatile("s_nop 15\n\ts_nop 15" ::: "memory");
        { int le_; asm volatile("v_mbcnt_lo_u32_b32 %0, -1, 0\n\tv_mbcnt_hi_u32_b32 %0, -1, %0" : "=v"(le_)); const int fr_e = le_ & 15, fq_e = le_ >> 4;
          if constexpr (Epi::ROWTAB) {
              const LAS unsigned long long* tab = (const LAS unsigned long long*)(lds + ROWTAB_OFF + ((SPLIT ? (ui >> 1) : ui) & 1) * 4096);
              if (SPLIT && cur.part == 0) {
                  const LAS unsigned long long* tb = tab + (wr * 64 + fr_e) * 2;
#pragma unroll
                  for (int a = 0; a < 2; ++a)
#pragma unroll
                      for (int m = 0; m < 4; ++m) { const float ratio = Epi::row_ratio(tb[(a * HALF + m * 16) * 2], tb[(a * HALF + m * 16) * 2 + 1]);
#pragma unroll
                          for (int b = 0; b < 2; ++b)
#pragma unroll
                              for (int n = 0; n < 2; ++n) acc[a][b][m][n] = acc[a][b][m][n] * ratio; }
              } else E(acc, cur, wr, wc, fr_e, fq_e, tab);
          } else E(acc, cur, wr, wc, fr_e, fq_e); }
        if (!has_next) break;
        if (!SPLIT || cur.part != 0) {
#pragma unroll
        for (int a = 0; a < 2; ++a)
#pragma unroll
            for (int b = 0; b < 2; ++b)
#pragma unroll
                for (int m = 0; m < 4; ++m)
#pragma unroll
                    for (int n = 0; n < 2; ++n) acc[a][b][m][n] = (f32x4){0.f, 0.f, 0.f, 0.f};
        }
        cur = nxt; cA = nA; cB = nB; ++ui;
        if constexpr (ALIGN_EPI) { if (wr == 1) PG8_BAR; }
    }
    PG8_WAIT_V(0);
    if constexpr (!ALIGN_EPI) { if (wr == 0) PG8_BAR; }
    PG8_BAR;
#undef PG8_SA
#undef PG8_SB
#undef PG8_STAGE
#undef PG8_LDA
#undef PG8_LDB
#undef PG8_MMA
#undef PG8_CAT
#undef PG8_WAIT_V
#undef PG8_WAIT_L
#undef PG8_BAR
#undef PG8_SCHED
}

struct APlain {
    const char* A; const char* Bt; int k; int sw = 0x7f7f7f7f, sa = 0x7f7f7f7f;
    DI int scale_w() const { return sw; } DI int scale_a() const { return sa; }
    DI int K() const { return k; }
    DI unsigned a_row_bytes() const { return (unsigned)k * 2u; }
    DI unsigned a_kstep() const { return 128u; }
    DI unsigned a_col_off(int C) const { return (unsigned)C * 2u; }
    DI const char* a_base(const Unit& u) const { return A + (size_t)u.pm * 256 * k * 2; }
    DI const char* b_base(const Unit& u) const { return Bt + (size_t)u.pn * 256 * k * 2; }
};
struct ACompress {
    const char* proj; const char* w1t;
    DI int scale_w() const { return 0x7f7f7f7f; } DI int scale_a() const { return 0x7f7f7f7f; }
    DI int K() const { return 2048; }
    DI unsigned a_row_bytes() const { return 16u * PW * 2u; }
    DI unsigned a_kstep() const { return (unsigned)PW * 2u; }
    DI unsigned a_col_off(int C) const { return (unsigned)C * 2u; }
    DI const char* a_base(const Unit& u) const { const int kv = u.pm / 24, r = u.pm % 24, bh = r >> 2, qt = r & 3, b = bh / 3, h = bh % 3;
        return proj + ((size_t)(b * SEQ + 4096 * qt) * PW + (kv ? C_VC : C_KC) + h * 64) * 2; }
    DI const char* b_base(const Unit& u) const { return w1t + (size_t)(u.pm / 24) * 256 * 2048 * 2; }
};
struct ASsm1 {
    const char* uc; const char* ss1;
    DI int scale_w() const { return 0x7f7f7f7f; } DI int scale_a() const { return 0x7f7f7f7f; }
    DI int K() const { return 256; }
    DI unsigned a_row_bytes() const { return 512u; }
    DI unsigned a_kstep() const { return 128u; }
    DI unsigned a_col_off(int C) const { return (unsigned)C * 2u; }
    DI const char* a_base(const Unit& u) const { const int bg = u.pm >> 2, qt = u.pm & 3; return uc + ((size_t)bg * SEQ + 4096 * qt) * 32; }
    DI const char* b_base(const Unit& u) const { const int gi = (u.pm >> 2) & 15; return ss1 + ((size_t)gi * 512 + (size_t)u.pn * 256) * 256 * 2; }
};
struct ASsm2 {
    const char* hin; const char* ss2;
    DI int scale_w() const { return 0x7f7f7f7f; } DI int scale_a() const { return 0x7f7f7f7f; }
    DI int K() const { return 256; }
    DI unsigned a_row_bytes() const { return 512u; }
    DI unsigned a_kstep() const { return 128u; }
    DI unsigned a_col_off(int C) const { return (unsigned)C * 2u; }
    DI const char* a_base(const Unit& u) const { return hin + (size_t)u.pm * 256 * 512; }
    DI const char* b_base(const Unit& u) const { const int gi = (u.pm >> 2) & 15; return ss2 + (size_t)gi * 256 * 256 * 2; }
};

struct EpiBf16 {
    static constexpr bool PERM = true; static constexpr bool ROWTAB = true; static constexpr int MID_T = -1;
    bf16_t* O; int ldc; const unsigned long long* rowtab;
    static DI float row_ratio(unsigned long long, unsigned long long) { return 1.f; }
    DI void operator()(const f32x4 (&acc)[2][2][4][2], const Unit& u, int wr, int wc, int fr, int fq, const LAS unsigned long long* tab) const {
        const int row0 = u.pm * BM + wr * 64 + fr, col0 = u.pn * BM + wc * 32 + 8 * fq;
        const int ubj = (u.pn == C_U / 256) ? 1 : ((u.pn == C_U / 256 + 1) ? 0 : -1);
#pragma unroll
        for (int ai = 0; ai < 2; ++ai)
#pragma unroll
            for (int m = 0; m < 4; ++m) { bf16_t* rowp = O + (size_t)(row0 + ai * HALF + m * 16) * ldc + col0;
                const float sc = rsqrtf((float)tab[(wr * 64 + fr + ai * HALF + m * 16) * 2] * (1.f / (1048576.f * DM)) + 1e-6f);
#pragma unroll
                for (int bj = 0; bj < 2; ++bj) { const f32x4 v0 = acc[ai][bj][m][0] * sc, v1 = acc[ai][bj][m][1] * sc;
                    u32x4 w; w.x = pk2(v0[0], v0[1]); w.y = pk2(v0[2], v0[3]); w.z = pk2(v1[0], v1[1]); w.w = pk2(v1[2], v1[3]);
                    *(u32x4*)(rowp + bj * HALF) = w;
                    if (bj == ubj) { const int row = row0 + ai * HALF + m * 16, ucol = col0 + bj * HALF - C_U;
                        bf16_t* uc = (bf16_t*)((unsigned char*)O + (WS_UC - WS_PROJ));
                        *(u32x4*)(uc + (((size_t)((row >> 14) * 16 + (ucol >> 4)) * SEQ + (row & (SEQ - 1))) * 16 + (ucol & 15))) = w; } } }
    }
};
struct EpiCmpHid {
    static constexpr bool PERM = true; static constexpr bool ROWTAB = false; static constexpr int MID_T = -1;
    bf16_t* O; const float* cb1;
    DI void operator()(const f32x4 (&acc)[2][2][4][2], const Unit& u, int wr, int wc, int fr, int fq) const {
        const int row0 = u.pm * BM + wr * 64 + fr, col0 = wc * 32 + 8 * fq; const float* bb = cb1 + (u.pm / 24) * 256;
        f32x4 bv[2][2];
#pragma unroll
        for (int bj = 0; bj < 2; ++bj)
#pragma unroll
            for (int n = 0; n < 2; ++n) bv[bj][n] = *(const f32x4*)(bb + col0 + bj * HALF + 4 * n);
#pragma unroll
        for (int ai = 0; ai < 2; ++ai)
#pragma unroll
            for (int m = 0; m < 4; ++m) { bf16_t* rowp = O + (size_t)(row0 + ai * HALF + m * 16) * 256 + col0;
#pragma unroll
                for (int bj = 0; bj < 2; ++bj) { f32x4 v0 = acc[ai][bj][m][0] + bv[bj][0], v1 = acc[ai][bj][m][1] + bv[bj][1];
#pragma unroll
                    for (int e = 0; e < 4; ++e) { v0[e] = gelu_tanh(v0[e]); v1[e] = gelu_tanh(v1[e]); }
                    u32x4 w; w.x = pk2(v0[0], v0[1]); w.y = pk2(v0[2], v0[3]); w.z = pk2(v1[0], v1[1]); w.w = pk2(v1[2], v1[3]);
                    *(u32x4*)(rowp + bj * HALF) = w; } }
    }
};
struct EpiSsm1 {
    static constexpr bool PERM = false; static constexpr bool ROWTAB = false; static constexpr int MID_T = -1;
    float* YI; float* HL;
    DI void operator()(const f32x4 (&acc)[2][2][4][2], const Unit& u, int wr, int wc, int fr, int fq) const {
        const int row0 = u.pm * BM + wr * 64 + fr, col0 = wc * 32 + 4 * fq;
#pragma unroll
        for (int ai = 0; ai < 2; ++ai)
#pragma unroll
            for (int m = 0; m < 4; ++m) { const size_t row = (size_t)(row0 + ai * HALF + m * 16);
                if (u.pn == 0) {
#pragma unroll
                    for (int bj = 0; bj < 2; ++bj)
#pragma unroll
                        for (int n = 0; n < 2; ++n) *(f32x4*)(YI + row * 256 + col0 + bj * HALF + n * 16) = acc[ai][bj][m][n];
                } else {
#pragma unroll
                    for (int n = 0; n < 2; ++n) *(f32x4*)(HL + row * 128 + col0 + n * 16) = acc[ai][0][m][n];
                } }
    }
};
struct EpiSsm2 {
    static constexpr bool PERM = false; static constexpr bool ROWTAB = false; static constexpr int MID_T = -1;
    const float* YI; const bf16_t* proj; const float* dskip; bf16_t* YS2;
    DI void operator()(const f32x4 (&acc)[2][2][4][2], const Unit& u, int wr, int wc, int fr, int fq) const {
        const int row0 = u.pm * BM + wr * 64 + fr, col0 = wc * 32 + 4 * fq;
        const int bg = u.pm >> 2, b = bg >> 4, gi = bg & 15;
        const f32x4 dsk = *(const f32x4*)(dskip + gi * 16 + 4 * fq);
#pragma unroll
        for (int ai = 0; ai < 2; ++ai)
#pragma unroll
            for (int m = 0; m < 4; ++m) { const int row = row0 + ai * HALF + m * 16; const int chunk = row & 1023;
#pragma unroll
                for (int bj = 0; bj < 2; ++bj)
#pragma unroll
                    for (int n = 0; n < 2; ++n) { const int col = col0 + bj * HALF + n * 16, tau = col >> 4;
                        const size_t tok = (size_t)b * SEQ + chunk * 16 + tau;
                        const f32x4 yi = *(const f32x4*)(YI + (size_t)row * 256 + col);
                        const u32x2 uw = *(const u32x2*)(proj + tok * PW + C_U + gi * 16 + 4 * fq);
                        f32x4 y = acc[ai][bj][m][n] + yi;
                        y[0] += dsk[0] * bflo(uw.x); y[1] += dsk[1] * bfhi(uw.x); y[2] += dsk[2] * bflo(uw.y); y[3] += dsk[3] * bfhi(uw.y);
                        u32x2 w; w.x = pk2(gelu_tanh(y[0]), gelu_tanh(y[1])); w.y = pk2(gelu_tanh(y[2]), gelu_tanh(y[3]));
                        *(u32x2*)(YS2 + tok * 256 + gi * 16 + 4 * fq) = w; } }
    }
};
struct EpiGlu {
    static constexpr bool PERM = true; static constexpr bool ROWTAB = false; static constexpr int MID_T = -1;
    bf16_t* O; const float* bglu; unsigned long long* sst;
    DI void operator()(const f32x4 (&acc)[2][2][4][2], const Unit& u, int wr, int wc, int fr, int fq) const {
        const int row0 = u.pm * BM + wr * 64 + fr, col0 = u.pn * HALF + wc * 32 + 8 * fq;
        f32x4 bvv[2], bgg[2];
#pragma unroll
        for (int n = 0; n < 2; ++n) { bvv[n] = *(const f32x4*)(bglu + col0 + 4 * n); bgg[n] = *(const f32x4*)(bglu + 256 + col0 + 4 * n); }
#pragma unroll
        for (int ai = 0; ai < 2; ++ai)
#pragma unroll
            for (int m = 0; m < 4; ++m) { const int row = row0 + ai * HALF + m * 16; bf16_t* rowp = O + (size_t)row * 1024 + 768 + col0;
                f32x4 o[2];
#pragma unroll
                for (int n = 0; n < 2; ++n) { const f32x4 v = acc[ai][0][m][n] + bvv[n], gt = acc[ai][1][m][n] + bgg[n];
#pragma unroll
                    for (int e = 0; e < 4; ++e) o[n][e] = v[e] * sigmoidf_(gt[e]); }
                u32x4 w; w.x = pk2(o[0][0], o[0][1]); w.y = pk2(o[0][2], o[0][3]); w.z = pk2(o[1][0], o[1][1]); w.w = pk2(o[1][2], o[1][3]);
                *(u32x4*)rowp = w;
                const f32x4 q = o[0] * o[0] + o[1] * o[1]; const float t = xor32_sum(xor16_sum((q[0] + q[1]) + (q[2] + q[3])));
                if (fq == 0) (void)__hip_atomic_fetch_add(sst + (size_t)row * 2 + 1, (unsigned long long)(t * 16777216.f), __ATOMIC_RELAXED, __HIP_MEMORY_SCOPE_AGENT); }
    }
};
struct EpiSwiglu8 {
    static constexpr bool PERM = true; static constexpr bool ROWTAB = false; static constexpr int MID_T = -1;
    unsigned char* O; float asc;
    DI void operator()(const f32x4 (&acc)[2][2][4][2], const Unit& u, int wr, int wc, int fr, int fq) const {
        const int row0 = u.pm * BM + wr * 64 + fr, col0 = u.pn * HALF + wc * 32 + 8 * fq;
#pragma unroll
        for (int ai = 0; ai < 2; ++ai)
#pragma unroll
            for (int m = 0; m < 4; ++m) { unsigned char* rowp = O + (size_t)(row0 + ai * HALF + m * 16) * DFF + col0;
                f32x4 o[2];
#pragma unroll
                for (int n = 0; n < 2; ++n) { const f32x4 gt = acc[ai][0][m][n] * asc, up = acc[ai][1][m][n] * asc;
#pragma unroll
                    for (int e = 0; e < 4; ++e) o[n][e] = 4.0f * gt[e] * sigmoidf_(gt[e]) * up[e]; }
                u32x2 w; w.x = pk4_fp8(o[0][0], o[0][1], o[0][2], o[0][3]); w.y = pk4_fp8(o[1][0], o[1][1], o[1][2], o[1][3]);
                *(u32x2*)rowp = w; }
    }
};
struct EpiSwiglu {
    static constexpr bool PERM = true; static constexpr bool ROWTAB = false; static constexpr int MID_T = -1;
    bf16_t* O;
    DI void operator()(const f32x4 (&acc)[2][2][4][2], const Unit& u, int wr, int wc, int fr, int fq) const {
        const int row0 = u.pm * BM + wr * 64 + fr, col0 = u.pn * HALF + wc * 32 + 8 * fq;
#pragma unroll
        for (int ai = 0; ai < 2; ++ai)
#pragma unroll
            for (int m = 0; m < 4; ++m) { bf16_t* rowp = O + (size_t)(row0 + ai * HALF + m * 16) * DFF + col0;
                f32x4 o[2];
#pragma unroll
                for (int n = 0; n < 2; ++n) { const f32x4 gt = acc[ai][0][m][n], up = acc[ai][1][m][n];
#pragma unroll
                    for (int e = 0; e < 4; ++e) o[n][e] = gt[e] * sigmoidf_(gt[e]) * up[e]; }
                u32x4 w; w.x = pk2(o[0][0], o[0][1]); w.y = pk2(o[0][2], o[0][3]); w.z = pk2(o[1][0], o[1][1]); w.w = pk2(o[1][2], o[1][3]);
                *(u32x4*)rowp = w; }
    }
};
struct EpiResF32 {
    static constexpr bool PERM = false; static constexpr bool ROWTAB = false; static constexpr int MID_T = -1;
    const float* base; float* out; float asc = 1.0f;
    DI void operator()(const f32x4 (&acc)[2][2][4][2], const Unit& u, int wr, int wc, int fr, int fq) const {
        const int row0 = u.pm * BM + wr * 64 + fr, col0 = u.pn * BM + wc * 32 + 4 * fq;
#pragma unroll
        for (int ai = 0; ai < 2; ++ai)
#pragma unroll
            for (int m = 0; m < 4; ++m) { const size_t off = (size_t)(row0 + ai * HALF + m * 16) * DM + col0;
#pragma unroll
                for (int bj = 0; bj < 2; ++bj)
#pragma unroll
                    for (int n = 0; n < 2; ++n) { const f32x4 bs = *(const f32x4*)(base + off + bj * HALF + n * 16);
                        *(f32x4*)(out + off + bj * HALF + n * 16) = bs + acc[ai][bj][m][n] * asc; } }
    }
};
template <bool MID, int ASC_EXP>
struct EpiResB {
    static constexpr bool PERM = true; static constexpr bool ROWTAB = MID; static constexpr int MID_T = MID ? 12 : -1;
    static constexpr float asc = 1.0f / (float)(1 << ASC_EXP);
    const float* basef; const bf16_t* baseb; bf16_t* out; const unsigned long long* rowtab; unsigned long long* ssx;
    static DI float rstd_a(unsigned long long v) { return rsqrtf((float)v * (1.f / (16777216.f * 768.f)) + 1e-6f); }
    static DI float rstd_s(unsigned long long v) { return rsqrtf((float)v * (1.f / (16777216.f * 256.f)) + 1e-6f); }
    static DI float row_ratio(unsigned long long a, unsigned long long s_) { return rstd_a(a) / rstd_s(s_); }
    template <bool F32B>
    DI void run(const f32x4 (&acc)[2][2][4][2], const Unit& u, int wr, int wc, int fr, int fq, const LAS unsigned long long* tab) const {
        const int row0 = u.pm * BM + wr * 64 + fr, col0 = u.pn * BM + wc * 32 + 8 * fq;
#pragma unroll
        for (int ai = 0; ai < 2; ++ai)
#pragma unroll
            for (int m = 0; m < 4; ++m) { const int row = row0 + ai * HALF + m * 16; const size_t off = (size_t)row * DM + col0; float sq = 0.f;
                float sc = asc; if constexpr (MID) sc = asc * rstd_s(tab[(wr * 64 + fr + ai * HALF + m * 16) * 2 + 1]);
#pragma unroll
                for (int bj = 0; bj < 2; ++bj) { f32x4 b0, b1;
                    if constexpr (F32B) { b0 = *(const f32x4*)(basef + off + bj * HALF); b1 = *(const f32x4*)(basef + off + bj * HALF + 4); }
                    else { const u32x4 b = *(const u32x4*)(baseb + off + bj * HALF); b0 = f32x4{bflo(b.x), bfhi(b.x), bflo(b.y), bfhi(b.y)}; b1 = f32x4{bflo(b.z), bfhi(b.z), bflo(b.w), bfhi(b.w)}; }
                    const f32x4 v0 = b0 + acc[ai][bj][m][0] * sc, v1 = b1 + acc[ai][bj][m][1] * sc;
                    u32x4 w; w.x = pk2(v0[0], v0[1]); w.y = pk2(v0[2], v0[3]); w.z = pk2(v1[0], v1[1]); w.w = pk2(v1[2], v1[3]);
                    *(u32x4*)(out + off + bj * HALF) = w;
                    if constexpr (!MID) { const f32x4 q = v0 * v0 + v1 * v1; sq += (q[0] + q[1]) + (q[2] + q[3]); } }
                if constexpr (!MID) { if (ssx != nullptr) { const float t = xor32_sum(xor16_sum(sq));
                    if (fq == 0) (void)__hip_atomic_fetch_add(ssx + (size_t)row * 2, (unsigned long long)(t * 1048576.f), __ATOMIC_RELAXED, __HIP_MEMORY_SCOPE_AGENT); } } }
    }
    DI void operator()(const f32x4 (&acc)[2][2][4][2], const Unit& u, int wr, int wc, int fr, int fq, const LAS unsigned long long* tab = nullptr) const {
        if (basef != nullptr) run<true>(acc, u, wr, wc, fr, fq, tab); else run<false>(acc, u, wr, wc, fr, fq, tab);
    }
};
}

struct Frame {
    LAS unsigned char* lds;
    LAS const unsigned long long* pt;
    int tid, lane, wave, G, gw, ngw, bid;
    DI const float* in(int i) const { const unsigned long long v = pt[i]; const unsigned lo = __builtin_amdgcn_readfirstlane((unsigned)v), hi = __builtin_amdgcn_readfirstlane((unsigned)(v >> 32));
        return (const float*)(const __attribute__((address_space(1))) float*)(((unsigned long long)hi << 32) | lo); }
    DI float* out() const { return (float*)in(26); }
    DI unsigned char* wsp() const { return (unsigned char*)in(27); }
};
constexpr int LDS_PT = LDS_BYTES - 256;

DI void transpose_item(const float* W, int K, int ldw, int nvalid, bf16_t* WT, int drow0, LAS float* scr, int k0, int n0, float scale, int lane, const float* gam64 = nullptr) {
    if (n0 + 32 <= nvalid) {
        const int n4 = (lane & 7) * 4; f32x4 v[8];
#pragma unroll
        for (int i = 0; i < 8; ++i) v[i] = *(const f32x4*)(W + (size_t)(k0 + 8 * i + (lane >> 3)) * ldw + n0 + n4);
        if (gam64 != nullptr) {
#pragma unroll
            for (int i = 0; i < 8; ++i) v[i] = v[i] * gam64[8 * i + (lane >> 3)];
        }
#pragma unroll
        for (int i = 0; i < 8; ++i) { LAS float* s = scr + (8 * i + (lane >> 3)) * 33 + n4; s[0] = v[i].x * scale; s[1] = v[i].y * scale; s[2] = v[i].z * scale; s[3] = v[i].w * scale; }
    } else {
    const int nn = n0 + (lane & 31); const bool ok = nn < nvalid;
#pragma unroll 8
    for (int i = 0; i < 32; ++i) { const int kk = 2 * i + (lane >> 5); scr[kk * 33 + (lane & 31)] = ok ? W[(size_t)(k0 + kk) * ldw + nn] * scale : 0.f; }
    }
    asm volatile("s_waitcnt lgkmcnt(0)" ::: "memory");
    const int c = lane & 7;
#pragma unroll
    for (int j = 0; j < 4; ++j) { const int n = (lane >> 3) + 8 * j; const LAS float* s = scr + (8 * c) * 33 + n;
        u32x4 o; o.x = pk2(s[0 * 33], s[1 * 33]); o.y = pk2(s[2 * 33], s[3 * 33]); o.z = pk2(s[4 * 33], s[5 * 33]); o.w = pk2(s[6 * 33], s[7 * 33]);
        *(u32x4*)(WT + (size_t)(drow0 + n) * K + k0 + 8 * c) = o; }
    asm volatile("s_waitcnt lgkmcnt(0)" ::: "memory");
}

DI void transpose_item_fp8(const float* W, int K, int ldw, unsigned char* WT, int drow0, LAS float* scr, int k0, int n0, float scale, int lane) {
    const int n4 = (lane & 7) * 4; f32x4 v[8];
#pragma unroll
    for (int i = 0; i < 8; ++i) v[i] = *(const f32x4*)(W + (size_t)(k0 + 8 * i + (lane >> 3)) * ldw + n0 + n4);
#pragma unroll
    for (int i = 0; i < 8; ++i) { LAS float* s = scr + (8 * i + (lane >> 3)) * 33 + n4; s[0] = v[i].x * scale; s[1] = v[i].y * scale; s[2] = v[i].z * scale; s[3] = v[i].w * scale; }
    asm volatile("s_waitcnt lgkmcnt(0)" ::: "memory");
    const int c = lane & 7;
#pragma unroll
    for (int j = 0; j < 4; ++j) { const int n = (lane >> 3) + 8 * j; const LAS float* s = scr + (8 * c) * 33 + n;
        u32x2 o; o.x = pk4_fp8(s[0 * 33], s[1 * 33], s[2 * 33], s[3 * 33]); o.y = pk4_fp8(s[4 * 33], s[5 * 33], s[6 * 33], s[7 * 33]);
        *(u32x2*)(WT + (size_t)(drow0 + n) * K + k0 + 8 * c) = o; }
    asm volatile("s_waitcnt lgkmcnt(0)" ::: "memory");
}

DI int win_dest_row(int n) {
    if (n < 1920) return n;
    if (n < 1956) return C_G + (n - 1920);
    return C_U + (n - 1956);
}

DI void prologue_a(Frame& F, int mode, int gw0, int ngw0) {
    LAS float* scr = (LAS float*)(F.lds + F.wave * 16640);
    constexpr int I_WIN = 16 * 72, I_WOUT = 16 * 32, I_WG = 16 * 88, I_WD = 44 * 32, I_W1 = 2 * 32 * 8, I_WGLU = 4 * 16, I_W2 = 2 * 4 * 2, I_CB = 64, I_M = 1024, I_TAB = 16;
    constexpr int PER_L = I_WIN + I_WOUT + 2 * I_WG + I_WD + I_W1 + I_WGLU + I_W2 + I_CB + I_M + I_TAB;
    const int lane = F.lane;
    constexpr int A1 = I_WIN, A3E = I_WIN + I_WOUT + 2 * I_WG + I_WD, A4E = A3E + I_W1, A5E = A4E + I_WGLU;
    for (int it = gw0; it < NL * PER_L; it += ngw0) {
        const int l = it / PER_L; int r = it % PER_L;
        { const bool late = (r >= A1 && r < A3E) || (r >= A4E && r < A5E) || (l > 0 && (r < A1 || (r >= A3E && r < A4E)));
          if (late != (mode == 1)) continue; }
        unsigned char* wl = F.wsp() + WS_W + (size_t)l * WL_STRIDE;
        unsigned char* ms = F.wsp() + WS_MISC + (size_t)l * MS_L;
        unsigned char* ct = F.wsp() + WS_CTL + CT_BASE + (size_t)l * CT_L;
        if (r < I_WIN) {
            const int kb = r / 72, nb = r % 72, k0 = 64 * kb, n0 = 32 * nb;
            const float* W = F.in(2) + (size_t)l * 1024 * 2212;
            bf16_t* WT = (bf16_t*)(wl + WO_WIN);
            const float* gam = F.in(1) + (size_t)l * DM + k0;
            if (n0 + 32 <= 1920) { transpose_item(W, 1024, 2212, 2212, WT, n0, scr, k0, n0, n0 < 768 ? 0.125f * L2E : 1.0f, lane, gam); }
            else {
                const int d = n0 + (lane & 31);
                int srcn = -1;
                if (d < 1920) srcn = d; else if (d >= C_U && d < C_U + 256) srcn = 1956 + (d - C_U); else if (d >= C_G && d < C_G + 36) srcn = 1920 + (d - C_G);
#pragma unroll 8
                for (int i = 0; i < 32; ++i) { const int kk = 2 * i + (lane >> 5); scr[kk * 33 + (lane & 31)] = srcn >= 0 ? W[(size_t)(k0 + kk) * 2212 + srcn] * gam[kk] : 0.f; }
                asm volatile("s_waitcnt lgkmcnt(0)" ::: "memory");
                const int c = lane & 7;
#pragma unroll
                for (int j = 0; j < 4; ++j) { const int n = (lane >> 3) + 8 * j; const LAS float* s = scr + (8 * c) * 33 + n;
                    u32x4 o; o.x = pk2(s[0 * 33], s[1 * 33]); o.y = pk2(s[2 * 33], s[3 * 33]); o.z = pk2(s[4 * 33], s[5 * 33]); o.w = pk2(s[6 * 33], s[7 * 33]);
                    *(u32x4*)(WT + (size_t)(n0 + n) * 1024 + k0 + 8 * c) = o; }
                asm volatile("s_waitcnt lgkmcnt(0)" ::: "memory");
            }
            continue; }
        r -= I_WIN;
        if (r < I_WOUT) { const int kb = r / 32, nb = r % 32;
            transpose_item(F.in(20) + (size_t)l * 1024 * 1024, 1024, 1024, 1024, (bf16_t*)(wl + WO_WOUT), 32 * nb, scr, 64 * kb, 32 * nb, 1.f, lane, kb < 12 ? F.in(18) + (size_t)l * 768 + 64 * kb : F.in(19) + (size_t)l * 256 + 64 * (kb - 12)); continue; }
        r -= I_WOUT;
        if (r < 2 * I_WG) { const int up = r / I_WG; const int rr = r % I_WG; const int kb = rr / 88, nb = rr % 88, n0 = 32 * nb;
            const int drow = (n0 / 128) * 256 + up * 128 + (n0 % 128);
            transpose_item_fp8(F.in(up ? 23 : 22) + (size_t)l * 1024 * DFF, 1024, DFF, (unsigned char*)(wl + WO_WGU), drow, scr, 64 * kb, n0, 64.f, lane); continue; }
        r -= 2 * I_WG;
        if (r < I_WD) { const int kb = r / 32, nb = r % 32; transpose_item_fp8(F.in(24) + (size_t)l * DFF * 1024, DFF, 1024, (unsigned char*)(wl + WO_WD), 32 * nb, scr, 64 * kb, 32 * nb, 64.f, lane); continue; }
        r -= I_WD;
        if (r < I_W1) { const int kv = r / 256; const int rr = r % 256; const int kb = rr / 8, nb = rr % 8;
            transpose_item(F.in(4) + ((size_t)l * 2 + kv) * 2048 * 256, 2048, 256, 256, (bf16_t*)(wl + WO_W1) + (size_t)kv * 256 * 2048, 32 * nb, scr, 64 * kb, 32 * nb, 1.f, lane); continue; }
        r -= I_W1;
        if (r < I_WGLU) { const int kb = r / 16, nb = r % 16, n0 = 32 * nb; const int gate = n0 >= 256, nn = n0 & 255;
            const int drow = (nn / 128) * 256 + gate * 128 + (nn % 128);
            transpose_item(F.in(16) + (size_t)l * 256 * 512, 256, 512, 512, (bf16_t*)(ms + MS_WGLU), drow, scr, 64 * kb, n0, 1.f, lane); continue; }
        r -= I_WGLU;
        if (r < I_W2) { const int kv = r / 8; const int rr = r % 8; const int kb = rr / 2, nb = rr % 2;
            transpose_item(F.in(6) + ((size_t)l * 2 + kv) * 256 * 64, 256, 64, 64, (bf16_t*)(ct + CT_W2T) + (size_t)kv * 64 * 256, 32 * nb, scr, 64 * kb, 32 * nb, 1.f, lane); continue; }
        r -= I_W2;
        if (r < I_CB) {
            const int kv = r / 32, ch = r % 32; const float* pe = F.in(3) + ((size_t)l * 2 + kv) * 2048; const float* w1 = F.in(4) + ((size_t)l * 2 + kv) * 2048 * 256;
            f32x4 s = {0.f, 0.f, 0.f, 0.f};
#pragma unroll 8
            for (int i = 0; i < 64; ++i) { const int k = 64 * ch + i; const float pv = pe[k]; const f32x4 w = *(const f32x4*)(w1 + (size_t)k * 256 + 4 * lane); s += w * pv; }
            *(f32x4*)((float*)(ms + MS_CBP) + ((size_t)kv * 32 + ch) * 256 + 4 * lane) = s; continue; }
        r -= I_CB;
        if (r < I_M) {
            const int e0 = r * 64; const int gi = e0 >> 12, dl = (e0 >> 8) & 15, cp0 = (e0 >> 4) & 15, n = lane;
            const float dt = __expf(F.in(8)[l * 16 + gi]);
            const float ar = F.in(9)[((size_t)l * 16 + gi) * 64 + n], ai = F.in(10)[((size_t)l * 16 + gi) * 64 + n];
            const float x = dt * ar, y = dt * ai; const float sy = __sinf(y), cy = __cosf(y), sh = __sinf(0.5f * y);
            const float em1 = (fabsf(x) < 0.25f) ? x * (1.f + x * (0.5f + x * (0.16666667f + x * (0.041666668f + x * 0.0083333338f)))) : expm1f(x);
            const float nr = em1 * cy - 2.f * sh * sh; const float abi = (em1 + 1.f) * sy;
            const float den = ar * ar + ai * ai;
            const float fr_ = (nr * ar + abi * ai) / den, fi_ = (abi * ar - nr * ai) / den;
            const float mg = __expf((float)dl * x); const float pr = mg * __cosf((float)dl * y), pi = mg * __sinf((float)dl * y);
            const f32x4* bre = (const f32x4*)(F.in(11) + (((size_t)l * 16 + gi) * 64 + n) * 16); const f32x4* bim = (const f32x4*)(F.in(12) + (((size_t)l * 16 + gi) * 64 + n) * 16);
            float zr[16], zi[16];
#pragma unroll
            for (int q4 = 0; q4 < 4; ++q4) { const f32x4 br = bre[q4], bi = bim[q4];
#pragma unroll
                for (int j = 0; j < 4; ++j) { const float bbr = fr_ * br[j] - fi_ * bi[j], bbi = fr_ * bi[j] + fi_ * br[j]; zr[4 * q4 + j] = pr * bbr - pi * bbi; zi[4 * q4 + j] = pr * bbi + pi * bbr; } }
#pragma unroll
            for (int cc = 0; cc < 4; ++cc) { const int cp = cp0 + cc;
                const float cr = F.in(13)[(((size_t)l * 16 + gi) * 16 + cp) * 64 + n], ci = F.in(14)[(((size_t)l * 16 + gi) * 16 + cp) * 64 + n];
#pragma unroll
                for (int c = 0; c < 16; ++c) scr[n * 65 + cc * 16 + c] = cr * zr[c] - ci * zi[c]; }
            asm volatile("s_waitcnt lgkmcnt(0)" ::: "memory");
            float mine = 0.f;
#pragma unroll 8
            for (int nn = 0; nn < 64; ++nn) mine += scr[nn * 65 + lane];
            ((float*)(ms + MS_MTAB))[e0 + lane] = mine;
            asm volatile("s_waitcnt lgkmcnt(0)" ::: "memory"); continue; }
        r -= I_M;
        {
            const int e = r * 64 + lane; const int gi = e >> 6, n = e & 63;
            const float dt = __expf(F.in(8)[l * 16 + gi]);
            const float ar = F.in(9)[((size_t)l * 16 + gi) * 64 + n], ai = F.in(10)[((size_t)l * 16 + gi) * 64 + n];
            const float x = dt * ar, y = dt * ai; float sy, cy; sy = __sinf(y); cy = __cosf(y); const float sh = __sinf(0.5f * y);
            const float em1 = (fabsf(x) < 0.25f) ? x * (1.f + x * (0.5f + x * (0.16666667f + x * (0.041666668f + x * 0.0083333338f)))) : expm1f(x); const float nr = em1 * cy - 2.f * sh * sh; const float abi = (em1 + 1.f) * sy;
            const float den = ar * ar + ai * ai;
            const float fr_ = (nr * ar + abi * ai) / den, fi_ = (abi * ar - nr * ai) / den;
            float s16, c16; s16 = __sinf(16.f * y); c16 = __cosf(16.f * y); const float m16 = __expf(16.f * x);
            ((f32x2*)(ct + CT_AB16))[e] = (f32x2){m16 * c16, m16 * s16};
            float s1k, c1k; s1k = __sinf(512.f * y); c1k = __cosf(512.f * y); const float m1k = __expf(512.f * x);
            ((f32x2*)(ct + CT_AB1K))[e] = (f32x2){m1k * c1k, m1k * s1k};
            const float* bre = F.in(11) + (((size_t)l * 16 + gi) * 64 + n) * 16; const float* bim = F.in(12) + (((size_t)l * 16 + gi) * 64 + n) * 16;
            f32x2* bb = (f32x2*)(ms + MS_BBAR) + (size_t)e * 16;
#pragma unroll
            for (int c = 0; c < 16; ++c) { const float br = bre[c], bi = bim[c]; bb[c] = (f32x2){fr_ * br - fi_ * bi, fr_ * bi + fi_ * br}; }
        }
    }
}

DI void prologue_b(Frame& F) {
    const int gt = F.gw * 64 + F.lane, ngt = F.ngw * 64;
    for (int l = 0; l < NL; ++l) {
        unsigned char* wl = F.wsp() + WS_W + (size_t)l * WL_STRIDE;
        unsigned char* ms = F.wsp() + WS_MISC + (size_t)l * MS_L;
        unsigned char* ct = F.wsp() + WS_CTL + CT_BASE + (size_t)l * CT_L;
        const float* MT = (const float*)(ms + MS_MTAB);
        const f32x2* BB = (const f32x2*)(ms + MS_BBAR);
        const float dtl_base = 0.f; (void)dtl_base;
        for (int e = gt; e < 16 * 512 * 256; e += ngt) {
            const int gi = e >> 17, n = (e >> 8) & 511, k = e & 255; float v = 0.f;
            if (n < 256) { const int tp = n >> 4, cp = n & 15, ta = k >> 4, c = k & 15; if (tp >= ta) v = MT[((gi * 16 + (tp - ta)) * 16 + cp) * 16 + c]; }
            else if (n < 384) { const int s = (n - 256) & 63, part = (n - 256) >> 6, ta = k >> 4, c = k & 15;
                const float dt = __expf(F.in(8)[l * 16 + gi]);
                const float ar = F.in(9)[((size_t)l * 16 + gi) * 64 + s], ai = F.in(10)[((size_t)l * 16 + gi) * 64 + s];
                const float pw = (float)(15 - ta); float sp, cpw; sp = __sinf(pw * dt * ai); cpw = __cosf(pw * dt * ai); const float mg = __expf(pw * dt * ar);
                const float pr = mg * cpw, pi = mg * sp; const f32x2 b = BB[((size_t)gi * 64 + s) * 16 + c];
                v = part ? (pr * b.y + pi * b.x) : (pr * b.x - pi * b.y); }
            ((bf16_t*)(wl + WO_SS1))[e] = f2bf(v);
        }
        for (int e = gt; e < 16 * 256 * 256; e += ngt) {
            const int gi = e >> 16, n = (e >> 8) & 255, k = e & 255; float v = 0.f;
            if (k < 128) { const int s = k & 63, part = k >> 6, ta = n >> 4, c = n & 15;
                const float dt = __expf(F.in(8)[l * 16 + gi]);
                const float ar = F.in(9)[((size_t)l * 16 + gi) * 64 + s], ai = F.in(10)[((size_t)l * 16 + gi) * 64 + s];
                const float pw = (float)(ta + 1); float sp, cpw; sp = __sinf(pw * dt * ai); cpw = __cosf(pw * dt * ai); const float mg = __expf(pw * dt * ar);
                const float pr = mg * cpw, pi = mg * sp;
                const float cr = F.in(13)[(((size_t)l * 16 + gi) * 16 + c) * 64 + s], ci = F.in(14)[(((size_t)l * 16 + gi) * 16 + c) * 64 + s];
                v = part ? -(cr * pi + ci * pr) : (cr * pr - ci * pi); }
            ((bf16_t*)(wl + WO_SS2))[e] = f2bf(v);
        }
        for (int e = gt; e < 512; e += ngt) { const int kv = e >> 8, n = e & 255; float s = F.in(5)[((size_t)l * 2 + kv) * 256 + n];
            const float* pp = (const float*)(ms + MS_CBP) + (size_t)kv * 32 * 256 + n;
            for (int ch = 0; ch < 32; ++ch) s += pp[ch * 256];
            ((float*)(ct + CT_CB1))[e] = s; }
    }
}

DI void convert_rows_stats(Frame& F, const float* x, bf16_t* o, unsigned long long* ssx) {
    for (int m = F.gw; m < NT; m += F.ngw) {
        const f32x4* xr = (const f32x4*)(x + (size_t)m * DM) + F.lane; f32x4 v[4]; float s = 0.f;
#pragma unroll
        for (int j = 0; j < 4; ++j) { v[j] = xr[64 * j]; s += (v[j].x * v[j].x + v[j].y * v[j].y) + (v[j].z * v[j].z + v[j].w * v[j].w); }
        u32x2* o8 = (u32x2*)(o + (size_t)m * DM) + F.lane;
#pragma unroll
        for (int j = 0; j < 4; ++j) { u32x2 w; w.x = pk2(v[j].x, v[j].y); w.y = pk2(v[j].z, v[j].w); o8[64 * j] = w; }
        s = wave_sum(s);
        if (F.lane == 0) ssx[(size_t)m * 2] = (unsigned long long)(s * 1048576.f);
    }
}
DI void rmsnorm_rows_bf16(Frame& F, const float* x, const float* g, bf16_t* o) {
    const f32x4* gp = (const f32x4*)g + F.lane; f32x4 gv[4];
#pragma unroll
    for (int j = 0; j < 4; ++j) gv[j] = gp[64 * j];
    for (int m = F.gw; m < NT; m += F.ngw) {
        const f32x4* xr = (const f32x4*)(x + (size_t)m * DM) + F.lane; f32x4 v[4]; float s = 0.f;
#pragma unroll
        for (int j = 0; j < 4; ++j) { v[j] = xr[64 * j]; s += (v[j].x * v[j].x + v[j].y * v[j].y) + (v[j].z * v[j].z + v[j].w * v[j].w); }
        const float rstd = rsqrtf(wave_sum(s) * (1.f / DM) + 1e-6f);
        u32x2* o8 = (u32x2*)(o + (size_t)m * DM) + F.lane;
#pragma unroll
        for (int j = 0; j < 4; ++j) { u32x2 w; w.x = pk2(v[j].x * rstd * gv[j].x, v[j].y * rstd * gv[j].y); w.y = pk2(v[j].z * rstd * gv[j].z, v[j].w * rstd * gv[j].w); o8[64 * j] = w; }
    }
}
DI void rmsnorm_rows_fp8(Frame& F, const float* x, const float* g, unsigned char* o) {
    const f32x4* gp = (const f32x4*)g + F.lane; f32x4 gv[4];
#pragma unroll
    for (int j = 0; j < 4; ++j) gv[j] = gp[64 * j];
    for (int m = F.gw; m < NT; m += F.ngw) {
        const f32x4* xr = (const f32x4*)(x + (size_t)m * DM) + F.lane; f32x4 v[4]; float s = 0.f;
#pragma unroll
        for (int j = 0; j < 4; ++j) { v[j] = xr[64 * j]; s += (v[j].x * v[j].x + v[j].y * v[j].y) + (v[j].z * v[j].z + v[j].w * v[j].w); }
        const float rstd = rsqrtf(wave_sum(s) * (1.f / DM) + 1e-6f);
        unsigned* o4 = (unsigned*)(o + (size_t)m * DM) + F.lane;
#pragma unroll
        for (int j = 0; j < 4; ++j) o4[64 * j] = pk4_fp8(v[j].x * rstd * gv[j].x, v[j].y * rstd * gv[j].y, v[j].z * rstd * gv[j].z, v[j].w * rstd * gv[j].w);
    }
}
DI void rmsnorm_rows_f32_inplace(Frame& F, float* x, const float* g) {
    const f32x4* gp = (const f32x4*)g + F.lane; f32x4 gv[4];
#pragma unroll
    for (int j = 0; j < 4; ++j) gv[j] = gp[64 * j];
    for (int m = F.gw; m < NT; m += F.ngw) {
        f32x4* xr = (f32x4*)(x + (size_t)m * DM) + F.lane; f32x4 v[4]; float s = 0.f;
#pragma unroll
        for (int j = 0; j < 4; ++j) { v[j] = xr[64 * j]; s += (v[j].x * v[j].x + v[j].y * v[j].y) + (v[j].z * v[j].z + v[j].w * v[j].w); }
        const float rstd = rsqrtf(wave_sum(s) * (1.f / DM) + 1e-6f);
#pragma unroll
        for (int j = 0; j < 4; ++j) xr[64 * j] = v[j] * rstd * gv[j];
    }
}
template <int OUT>
DI void rmsnorm_rows_xb(Frame& F, const bf16_t* x, const float* g, void* o) {
    const f32x4* gp = (const f32x4*)g + 2 * F.lane; f32x4 gv[2][2];
#pragma unroll
    for (int j = 0; j < 2; ++j) { gv[j][0] = gp[128 * j]; gv[j][1] = gp[128 * j + 1]; }
    for (int m = 2 * F.gw; m < NT; m += 2 * F.ngw) {
        u32x4 w[2][2];
#pragma unroll
        for (int r = 0; r < 2; ++r)
#pragma unroll
            for (int j = 0; j < 2; ++j) w[r][j] = ((const u32x4*)(x + (size_t)(m + r) * DM) + F.lane)[64 * j];
#pragma unroll
        for (int r = 0; r < 2; ++r) {
            f32x4 v[2][2]; float s = 0.f;
#pragma unroll
            for (int j = 0; j < 2; ++j) { const u32x4 q = w[r][j];
                v[j][0] = f32x4{bflo(q.x), bfhi(q.x), bflo(q.y), bfhi(q.y)}; v[j][1] = f32x4{bflo(q.z), bfhi(q.z), bflo(q.w), bfhi(q.w)};
                const f32x4 a = v[j][0] * v[j][0] + v[j][1] * v[j][1]; s += (a.x + a.y) + (a.z + a.w); }
            const float rstd = rsqrtf(wave_sum(s) * (1.f / DM) + 1e-6f);
#pragma unroll
            for (int j = 0; j < 2; ++j) { const f32x4 y0 = v[j][0] * rstd * gv[j][0], y1 = v[j][1] * rstd * gv[j][1];
                if constexpr (OUT == 0) { u32x4 t; t.x = pk2(y0.x, y0.y); t.y = pk2(y0.z, y0.w); t.z = pk2(y1.x, y1.y); t.w = pk2(y1.z, y1.w);
                    ((u32x4*)((bf16_t*)o + (size_t)(m + r) * DM) + F.lane)[64 * j] = t; }
                else if constexpr (OUT == 1) { u32x2 t; t.x = pk4_fp8(y0.x, y0.y, y0.z, y0.w); t.y = pk4_fp8(y1.x, y1.y, y1.z, y1.w);
                    ((u32x2*)((unsigned char*)o + (size_t)(m + r) * DM) + F.lane)[64 * j] = t; }
                else { f32x4* op = (f32x4*)((float*)o + (size_t)(m + r) * DM) + 2 * F.lane + 128 * j; op[0] = y0; op[1] = y1; } }
        }
    }
}
DI void mix_norm_rows(Frame& F, const bf16_t* oatt, const bf16_t* ossm, const float* gatt, const float* gssm, bf16_t* mixed) {
    for (int m = F.gw; m < NT; m += F.ngw) {
        const u32x2* ar = (const u32x2*)(oatt + (size_t)m * 768) + F.lane;
        float a[12]; float s = 0.f;
#pragma unroll
        for (int j = 0; j < 3; ++j) { const u32x2 w = ar[64 * j]; a[4 * j] = bflo(w.x); a[4 * j + 1] = bfhi(w.x); a[4 * j + 2] = bflo(w.y); a[4 * j + 3] = bfhi(w.y); }
#pragma unroll
        for (int j = 0; j < 12; ++j) s += a[j] * a[j];
        const float ra = rsqrtf(wave_sum(s) * (1.f / 768.f) + 1e-6f);
        const u32x2 sw = ((const u32x2*)(ossm + (size_t)m * 256))[F.lane];
        float b[4] = {bflo(sw.x), bfhi(sw.x), bflo(sw.y), bfhi(sw.y)};
        const float rs = rsqrtf(wave_sum(b[0] * b[0] + b[1] * b[1] + b[2] * b[2] + b[3] * b[3]) * (1.f / 256.f) + 1e-6f);
        u32x2* o8 = (u32x2*)(mixed + (size_t)m * DM);
#pragma unroll
        for (int j = 0; j < 3; ++j) { const f32x4 gv = ((const f32x4*)gatt)[64 * j + F.lane];
            u32x2 w; w.x = pk2(a[4 * j] * ra * gv.x, a[4 * j + 1] * ra * gv.y); w.y = pk2(a[4 * j + 2] * ra * gv.z, a[4 * j + 3] * ra * gv.w); o8[64 * j + F.lane] = w; }
        { const f32x4 gv = ((const f32x4*)gssm)[F.lane]; u32x2 w; w.x = pk2(b[0] * rs * gv.x, b[1] * rs * gv.y); w.y = pk2(b[2] * rs * gv.z, b[3] * rs * gv.w); o8[192 + F.lane] = w; }
    }
}

#define KPERM(rt, r) (32 * ((rt) >> 1) + 8 * ((r) >> 2) + 4 * ((rt) & 1) + ((r) & 3))
DI void vtranspose_phase(Frame& F, const bf16_t* proj, bf16_t* vts, bf16_t* vtw, bf16_t* kfs, unsigned* vmax_word, int cu0) {
    LAS bf16_t* scr = (LAS bf16_t*)(F.lds + F.wave * 8704);
    unsigned vm = 0u;
    const bool split = F.G > 96;
    if (split && F.bid < cu0) return;
    const int gw0 = split ? F.gw - cu0 * 8 : F.gw, ngw0 = split ? F.ngw - cu0 * 8 : F.ngw;
    const int c16 = F.lane & 15, kq = F.lane >> 4;
    for (int it = gw0; it < 3 * 6 * 256; it += ngw0) {
        const int which = it / 1536, r = it % 1536, bh = r >> 8, tt = r & 255, b = bh / 3, h = bh % 3;
        const bf16_t* src = proj + ((size_t)(b * SEQ + 64 * tt)) * PW + (which == 0 ? C_VS : (which == 1 ? C_VW : C_KS)) + h * 64;
        bf16_t* dst = (which == 0 ? vts : (which == 1 ? vtw : kfs)) + (size_t)bh * 64 * SEQ + (size_t)tt * 4096;
#pragma unroll
        for (int i = 0; i < 8; ++i) { const int tk = i * 8 + (F.lane >> 3), d8 = F.lane & 7; const u32x4 w = *(const u32x4*)(src + (size_t)tk * PW + 8 * d8);
            if (which == 0) { vm = max(vm, max(max(w.x & 0x7fff0000u, (w.x << 16) & 0x7fff0000u), max(w.y & 0x7fff0000u, (w.y << 16) & 0x7fff0000u)));
                              vm = max(vm, max(max(w.z & 0x7fff0000u, (w.z << 16) & 0x7fff0000u), max(w.w & 0x7fff0000u, (w.w << 16) & 0x7fff0000u))); }
            LAS bf16_t* sp = scr + tk * 66 + 8 * d8; ((LAS unsigned*)sp)[0] = w.x; ((LAS unsigned*)sp)[1] = w.y; ((LAS unsigned*)sp)[2] = w.z; ((LAS unsigned*)sp)[3] = w.w; }
        asm volatile("s_waitcnt lgkmcnt(0)" ::: "memory");
        if (which == 1) {
#pragma unroll
            for (int i = 0; i < 8; ++i) { const int d = i * 8 + (F.lane >> 3), t8 = F.lane & 7; unsigned short e[8];
#pragma unroll
                for (int j = 0; j < 8; ++j) e[j] = scr[(8 * t8 + j) * 66 + d];
                u32x4 w; w.x = e[0] | ((unsigned)e[1] << 16); w.y = e[2] | ((unsigned)e[3] << 16); w.z = e[4] | ((unsigned)e[5] << 16); w.w = e[6] | ((unsigned)e[7] << 16);
                *(u32x4*)(dst + (size_t)d * 64 + 8 * t8) = w; }
        } else if (which == 0) {
#pragma unroll
            for (int I = 0; I < 8; ++I) { const int dt = I >> 1, sp = I & 1; unsigned short e[8];
#pragma unroll
                for (int j = 0; j < 8; ++j) e[j] = scr[(32 * sp + 8 * kq + j) * 66 + 16 * dt + c16];
                u32x4 w; w.x = e[0] | ((unsigned)e[1] << 16); w.y = e[2] | ((unsigned)e[3] << 16); w.z = e[4] | ((unsigned)e[5] << 16); w.w = e[6] | ((unsigned)e[7] << 16);
                *(u32x4*)(dst + (I * 64 + F.lane) * 8) = w; }
        } else {
#pragma unroll
            for (int I = 0; I < 8; ++I) { const int rt = I >> 1, ks = I & 1; const LAS bf16_t* sp = scr + KPERM(rt, c16) * 66 + 32 * ks + 8 * kq;
                u32x4 w; w.x = ((const LAS unsigned*)sp)[0]; w.y = ((const LAS unsigned*)sp)[1]; w.z = ((const LAS unsigned*)sp)[2]; w.w = ((const LAS unsigned*)sp)[3];
                *(u32x4*)(dst + (I * 64 + F.lane) * 8) = w; }
        }
        asm volatile("s_waitcnt lgkmcnt(0)" ::: "memory");
    }
    vm = wave_max_u32(vm);
    if (F.lane == 0 && vm != 0u) __hip_atomic_fetch_max(vmax_word, vm, __ATOMIC_RELAXED, __HIP_MEMORY_SCOPE_AGENT);
}

#define MFMA32(a, b, c) __builtin_amdgcn_mfma_f32_32x32x16_bf16((a), (b), (c), 0, 0, 0)
#define MFMA16(a, b, c) __builtin_amdgcn_mfma_f32_16x16x32_bf16((a), (b), (c), 0, 0, 0)

DI void compress2_phase(Frame& F, const bf16_t* hidc, const bf16_t* w2t, const float* b2  , bf16_t* kc, bf16_t* vct, int it0, int it_end, int it_step) {
    const int r = F.lane & 31, h = F.lane >> 5;
    for (int it = it0; it < it_end; it += it_step) {
        const int kv = it / 192, rb = it % 192; const int R0 = kv * 6144 + rb * 32;
        f32x16 acc0, acc1;
#pragma unroll
        for (int i = 0; i < 16; ++i) { acc0[i] = 0.f; acc1[i] = 0.f; }
        const bf16_t* ap = hidc + (size_t)(R0 + r) * 256 + 8 * h; const bf16_t* bp = w2t + (size_t)kv * 64 * 256 + (size_t)r * 256 + 8 * h;
#pragma unroll 4
        for (int ks = 0; ks < 16; ++ks) { const bf16x8 a = *(const bf16x8*)(ap + 16 * ks); const bf16x8 b0 = *(const bf16x8*)(bp + 16 * ks), b1 = *(const bf16x8*)(bp + 32 * 256 + 16 * ks);
            acc0 = MFMA32(a, b0, acc0); acc1 = MFMA32(a, b1, acc1); }
        const int bh = rb >> 5, i0 = (rb & 31) * 32;
        const float bb0 = b2[kv * 64 + r], bb1 = b2[kv * 64 + 32 + r];
        if (kv == 0) {
#pragma unroll
            for (int i = 0; i < 16; ++i) { const int row = i0 + (i & 3) + 8 * (i >> 2) + 4 * h; bf16_t* o = kc + ((size_t)bh * 1024 + row) * 64;
                const bool junk = (row == 1023);
                o[r] = junk ? (bf16_t)0 : f2bf(acc0[i] + bb0); o[32 + r] = junk ? (bf16_t)0 : f2bf(acc1[i] + bb1); }
        } else {
#pragma unroll
            for (int g4 = 0; g4 < 4; ++g4) { const int row = i0 + 8 * g4 + 4 * h;
                u32x2 w0, w1; w0.x = pk2(acc0[4 * g4] + bb0, acc0[4 * g4 + 1] + bb0); w0.y = pk2(acc0[4 * g4 + 2] + bb0, acc0[4 * g4 + 3] + bb0);
                w1.x = pk2(acc1[4 * g4] + bb1, acc1[4 * g4 + 1] + bb1); w1.y = pk2(acc1[4 * g4 + 2] + bb1, acc1[4 * g4 + 3] + bb1);
                if (row == 1020) { w0.y &= 0x0000ffffu; w1.y &= 0x0000ffffu; }
                bf16_t* vt = vct + (size_t)bh * 64 * 1024 + (size_t)(row >> 6) * 4096 + (row & 63);
                *(u32x2*)(vt + r * 64) = w0; *(u32x2*)(vt + (32 + r) * 64) = w1; }
        }
    }
}

DI void ssm_carry_phase(Frame& F, const float* hl, const f32x2* ab16, const f32x2* ab512, bf16_t* hin, int bg0, int bg_end, int bg_step) {
    LAS f32x2* E = (LAS f32x2*)F.lds;
    const int s = F.lane;
    for (int bg = bg0; bg < bg_end; bg += bg_step) {
        const int gi = bg & 15; const f32x2 a16 = ab16[gi * 64 + s], a5 = ab512[gi * 64 + s];
        const float* hp = hl + (size_t)bg * 1024 * 128 + s;
        float hr[4], hi[4];
#pragma unroll
        for (int j = 0; j < 4; ++j) { hr[j] = 0.f; hi[j] = 0.f; }
#pragma unroll 4
        for (int c = 0; c < 32; ++c) {
#pragma unroll
            for (int j = 0; j < 4; ++j) { const float* q = hp + (size_t)((4 * F.wave + j) * 32 + c) * 128; const float lr = q[0], li = q[64];
                const float nr = a16.x * hr[j] - a16.y * hi[j] + lr, ni = a16.x * hi[j] + a16.y * hr[j] + li; hr[j] = nr; hi[j] = ni; } }
#pragma unroll
        for (int j = 0; j < 4; ++j) E[(4 * F.wave + j) * 64 + s] = (f32x2){hr[j], hi[j]};
        __syncthreads();
        { float pr = 0.f, pi = 0.f;
          for (int k = 0; k < 4 * F.wave; ++k) { const f32x2 e = E[k * 64 + s]; const float nr = a5.x * pr - a5.y * pi + e.x, ni = a5.x * pi + a5.y * pr + e.y; pr = nr; pi = ni; }
#pragma unroll
          for (int j = 0; j < 4; ++j) { hr[j] = pr; hi[j] = pi; const f32x2 e = E[(4 * F.wave + j) * 64 + s]; const float nr = a5.x * pr - a5.y * pi + e.x, ni = a5.x * pi + a5.y * pr + e.y; pr = nr; pi = ni; } }
#pragma unroll 4
        for (int c = 0; c < 32; ++c) {
#pragma unroll
            for (int j = 0; j < 4; ++j) { const int ch = (4 * F.wave + j) * 32 + c; const float* q = hp + (size_t)ch * 128; const float lr = q[0], li = q[64];
                bf16_t* o = hin + ((size_t)bg * 1024 + ch) * 256; o[s] = f2bf(hr[j]); o[64 + s] = f2bf(hi[j]); ((unsigned*)(o + 128))[s] = 0u;
                const float nr = a16.x * hr[j] - a16.y * hi[j] + lr, ni = a16.x * hi[j] + a16.y * hr[j] + li; hr[j] = nr; hi[j] = ni; } }
        __syncthreads();
    }
}

constexpr float AL2E = 1.0f;
constexpr int IMP_STRIDE = 257;
constexpr int OS_QS = 261, OS_HS = 65;
constexpr int LDS_RA = 0, LDS_RB = 64 * IMP_STRIDE * 4, LDS_WM = LDS_RB + 64 * OS_QS * 4;
constexpr int QT_ROW = 144, LDS_QT = LDS_RA, LDS_QL = LDS_QT + 256 * QT_ROW, LDS_MREF = LDS_QL + 512, LDS_LS = LDS_MREF + 1024;
constexpr int LDS_QCNT = LDS_WM + 2048;
static_assert(LDS_LS + 1024 <= LDS_RB && LDS_QCNT + 20 <= LDS_BYTES - 256, "LDS map");
constexpr int TROW = 144, TILE_V = 64 * TROW, TILE_BYTES = 2 * 64 * TROW;

struct TileSrc { const bf16_t* k; long kstep, kstride; const bf16_t* v; long vstep, vstride; };

constexpr int PD = 1;
struct IdMap { DI int operator()(int i) const { return i; } };
template <bool WITH_V, class Compute, class Map = IdMap, bool FRAG = false>
DI void kv_pipeline(Frame& F, LAS unsigned char* sb, const TileSrc& ts, int n, Compute&& compute, Map tmap = Map()) {
    if (n <= 0) return;
    const int row = F.tid >> 3, ch = F.tid & 7, nl = n - 1;
    const bf16_t* kp = FRAG ? ts.k + F.tid * 8 : ts.k + (long)row * ts.kstride + ch * 8; const bf16_t* vp = FRAG ? ts.v + F.tid * 8 : ts.v + (long)row * ts.vstride + ch * 8;
    LAS unsigned char* wk = sb + row * TROW + ch * 16; int vdel = TILE_V;
    if (FRAG) { const int I = F.tid >> 6, l_ = F.tid & 63, c16_ = l_ & 15, kq_ = l_ >> 4;
        const int kofs = KPERM(I >> 1, c16_) * TROW + (32 * (I & 1) + 8 * kq_) * 2, vofs = TILE_V + (16 * (I >> 1) + c16_) * TROW + (32 * (I & 1) + 8 * kq_) * 2;
        wk = sb + kofs; vdel = vofs - kofs; }
    u32x4 kr[PD], vr[PD];
#pragma unroll
    for (int u = 0; u < PD; ++u) { const int t = tmap(u < nl ? u : nl); kr[u] = *(const u32x4*)(kp + (long)t * ts.kstep); vr[u] = WITH_V ? *(const u32x4*)(vp + (long)t * ts.vstep) : (u32x4){0u, 0u, 0u, 0u}; }
    *(LAS u32x4*)wk = kr[0]; if (WITH_V) *(LAS u32x4*)(wk + vdel) = vr[0];
    { const int t = tmap(PD < nl ? PD : nl); kr[0] = *(const u32x4*)(kp + (long)t * ts.kstep); if (WITH_V) vr[0] = *(const u32x4*)(vp + (long)t * ts.vstep); }
    __syncthreads();
    for (int i0 = 0; i0 < n; i0 += PD) {
#pragma unroll
        for (int u = 0; u < PD; ++u) {
            const int i = i0 + u; const int s1 = (u + 1) % PD;
            { LAS unsigned char* w1 = wk + ((i + 1) & 1) * TILE_BYTES; *(LAS u32x4*)w1 = kr[s1]; if (WITH_V) *(LAS u32x4*)(w1 + vdel) = vr[s1]; }
            { const int t = tmap((i + 1 + PD) < nl ? (i + 1 + PD) : nl); kr[s1] = *(const u32x4*)(kp + (long)t * ts.kstep); if (WITH_V) vr[s1] = *(const u32x4*)(vp + (long)t * ts.vstep); }
            if (i < n) compute(i, sb + (i & 1) * TILE_BYTES);
            __syncthreads();
        }
    }
}

DI f32x16 qk32(const LAS unsigned char* tb, int kh, int r32, int h, const bf16x8 (&qf)[4]) {
    f32x16 sc;
#pragma unroll
    for (int i = 0; i < 16; ++i) sc[i] = 0.f;
    const LAS unsigned char* kp = tb + (32 * kh + r32) * TROW + 16 * h;
#pragma unroll
    for (int s = 0; s < 4; ++s) { const bf16x8 a = *(const LAS bf16x8*)(kp + 32 * s); sc = MFMA32(a, qf[s], sc); }
    return sc;
}
DI void qk32x2(const LAS unsigned char* tb, int r32, int h, const bf16x8 (&qf)[4], f32x16& s0, f32x16& s1) {
#pragma unroll
    for (int i = 0; i < 16; ++i) { s0[i] = 0.f; s1[i] = 0.f; }
    const LAS unsigned char* kp = tb + r32 * TROW + 16 * h;
#pragma unroll
    for (int s = 0; s < 4; ++s) { const bf16x8 a0 = *(const LAS bf16x8*)(kp + 32 * s), a1 = *(const LAS bf16x8*)(kp + 32 * TROW + 32 * s); s0 = MFMA32(a0, qf[s], s0); s1 = MFMA32(a1, qf[s], s1); }
}
DI void pv32(const LAS unsigned char* tb, int kh, int r32, int h, const f32x16& p, f32x16& o0, f32x16& o1) {
#pragma unroll
    for (int s2 = 0; s2 < 2; ++s2) {
        u32x4 pw; pw.x = pk2(p[8 * s2], p[8 * s2 + 1]); pw.y = pk2(p[8 * s2 + 2], p[8 * s2 + 3]); pw.z = pk2(p[8 * s2 + 4], p[8 * s2 + 5]); pw.w = pk2(p[8 * s2 + 6], p[8 * s2 + 7]);
        const bf16x8 pb = __builtin_bit_cast(bf16x8, pw);
        const LAS unsigned char* vp = tb + TILE_V + r32 * TROW + (32 * kh + 16 * s2 + 4 * h) * 2;
        { const s16x4 lo = *(const LAS s16x4*)vp, hi = *(const LAS s16x4*)(vp + 16); const bf16x8 a = __builtin_shufflevector(lo, hi, 0, 1, 2, 3, 4, 5, 6, 7); o0 = MFMA32(a, pb, o0); }
        { const s16x4 lo = *(const LAS s16x4*)(vp + 32 * TROW), hi = *(const LAS s16x4*)(vp + 32 * TROW + 16); const bf16x8 a = __builtin_shufflevector(lo, hi, 0, 1, 2, 3, 4, 5, 6, 7); o1 = MFMA32(a, pb, o1); }
    }
}

DI void attn_unit(Frame& F, const bf16_t* proj, const bf16_t* kcb, const bf16_t* vctb, const bf16_t* vts, const bf16_t* vtw, bf16_t* oatt, int bh, int qb, float os_scale, float os_inv, float os_e2, float* park, const bf16_t* kfs, unsigned long long* sst) {
    const float ls_scale = 1048576.0f * os_inv;
    LAS unsigned* IMP = (LAS unsigned*)(F.lds + LDS_RA); LAS unsigned char* WM = F.lds + LDS_WM;
    const int b = bh / 3, hkv = bh % 3, lane = F.lane, w = F.wave;
    const float NEG = -__builtin_inff();
    for (int i = F.tid; i < 64 * IMP_STRIDE; i += 512) IMP[i] = 0u;
    for (int i = F.tid; i < 512; i += 512) ((LAS unsigned*)WM)[i] = 0u;
    if (F.tid == 0) ((LAS int*)(F.lds + LDS_QCNT + 16))[0] = 0;
    const int r32 = lane & 31, h = lane >> 5, gq = w & 3, qh = w >> 2;
    const int ql = 32 * qh + r32, t = 64 * qb + ql;
    const size_t trow = (size_t)(b * SEQ + t);
    const bf16_t* qrow = proj + trow * PW + C_Q + (hkv * 4 + gq) * 64;
    bf16x8 qf[4];
#pragma unroll
    for (int s = 0; s < 4; ++s) qf[s] = *(const bf16x8*)(qrow + 16 * s + 8 * h);
    const bf16_t* grow = proj + trow * PW + C_G + hkv * 12 + gq * 3;
    const float g0 = sigmoidf_(bf2f(grow[0])), g2 = sigmoidf_(bf2f(grow[2]));
    f32x16 oc0, oc1; float inv_c = 0.f;
#pragma unroll
    for (int i = 0; i < 16; ++i) { oc0[i] = 0.f; oc1[i] = 0.f; }
    {
        const int ntile = (4 * qb + 3 + 63) >> 6;
        const int vis = (t - 31) >> 4;
        const int vis_w = (64 * qb + 32 * qh + 31 - 31) >> 4;
        const int vis_min = (64 * qb + 32 * qh - 31) >> 4;
        TileSrc ts{kcb + (size_t)bh * 1024 * 64, 64 * 64, 64, vctb + (size_t)bh * 64 * 1024, 4096, 64};
        float m = NEG, lsum = 0.f;
        kv_pipeline<false>(F, F.lds + LDS_RB, ts, ntile, [&](int i, const LAS unsigned char* tb) {
            if (64 * i > vis_w) return;
            const bool two = (64 * i + 32 <= vis_w); f32x16 sq0, sq1;
            if (two) qk32x2(tb, r32, h, qf, sq0, sq1); else { sq0 = qk32(tb, 0, r32, h, qf); sq1 = sq0; }
#pragma unroll
            for (int kh = 0; kh < 2; ++kh) {
                if (kh == 1 && !two) continue;
                f32x16 sc = kh ? sq1 : sq0;
                if (64 * i + 32 * kh + 31 > vis_min) {
#pragma unroll
                    for (int e = 0; e < 16; ++e) { const int ki = 64 * i + 32 * kh + (e & 3) + 8 * (e >> 2) + 4 * h; sc[e] = (ki <= vis) ? sc[e] : NEG; }
                }
                float ps = 0.f;
#pragma unroll
                for (int e = 0; e < 16; ++e) ps += fexp2(sc[e]);
                lsum += ps;
            }
        });
        bool redo1; { const float Lq = xor32_sum(lsum); LAS int* WFLAG = (LAS int*)(F.lds + LDS_QCNT + 16);
          if (!(Lq == 0.f || (Lq > 5.4e-20f && Lq < 1.8e19f))) WFLAG[0] = 1;
          __syncthreads();
          redo1 = WFLAG[0] != 0; }
        float M = 0.f, Lt = 0.f;
        if (!redo1) { Lt = xor32_sum(lsum); }
        else {
        lsum = 0.f;
        for (int rep_ = 0; rep_ < REP_B1; ++rep_)
        kv_pipeline<false>(F, F.lds + LDS_RB, ts, ntile, [&](int i, const LAS unsigned char* tb) {
            if (64 * i > vis_w) return;
            const bool two = (64 * i + 32 <= vis_w); f32x16 sq0, sq1;
            if (two) qk32x2(tb, r32, h, qf, sq0, sq1); else { sq0 = qk32(tb, 0, r32, h, qf); sq1 = sq0; }
#pragma unroll
            for (int kh = 0; kh < 2; ++kh) {
                if (kh == 1 && !two) continue;
                f32x16 sc = kh ? sq1 : sq0;
                float tm = NEG;
                if (64 * i + 32 * kh + 31 > vis_min) {
#pragma unroll
                    for (int e = 0; e < 16; ++e) { const int ki = 64 * i + 32 * kh + (e & 3) + 8 * (e >> 2) + 4 * h; sc[e] = (ki <= vis) ? sc[e] : NEG; }
                }
#pragma unroll
                for (int e = 0; e < 16; ++e) tm = fmaxf(tm, sc[e]);
                const float mn = fmaxf(m, tm);
                if (mn > NEG) { float ps = 0.f;
#pragma unroll
                    for (int e = 0; e < 16; ++e) ps += fexp2((sc[e] - mn) * AL2E);
                    lsum = lsum * fexp2((m - mn) * AL2E) + ps; m = mn; }
            }
        });
        const F2 mm = halves32(m), ll = halves32(lsum);
        M = fmaxf(mm.lo, mm.hi);
        if (M > NEG) Lt = ll.lo * fexp2((mm.lo - M) * AL2E) + ll.hi * fexp2((mm.hi - M) * AL2E); else M = 0.f;
        }
        const float inv = 1.0f / fmaxf(Lt, 1e-30f), inv24 = inv * 16777216.0f;
        inv_c = inv;
        for (int rep_ = 0; rep_ < REP_B1; ++rep_)
        kv_pipeline<true>(F, F.lds + LDS_RB, ts, ntile, [&](int i, const LAS unsigned char* tb) {
            if (64 * i > vis_w) return;
            const bool two = (64 * i + 32 <= vis_w); f32x16 sq0, sq1;
            if (two) qk32x2(tb, r32, h, qf, sq0, sq1); else { sq0 = qk32(tb, 0, r32, h, qf); sq1 = sq0; }
#pragma unroll
            for (int kh = 0; kh < 2; ++kh) {
                if (kh == 1 && !two) continue;
                f32x16 sc = kh ? sq1 : sq0;
#pragma unroll
                for (int e = 0; e < 16; ++e) sc[e] = fexp2((sc[e] - M) * AL2E);
                if (64 * i + 32 * kh + 31 > vis_min) {
#pragma unroll
                    for (int e = 0; e < 16; ++e) { const int ki = 64 * i + 32 * kh + (e & 3) + 8 * (e >> 2) + 4 * h; sc[e] = (ki <= vis) ? sc[e] : 0.f; }
                }
#pragma unroll
                for (int a = 0; a < 4; ++a) { const float G = (sc[4 * a] + sc[4 * a + 1]) + (sc[4 * a + 2] + sc[4 * a + 3]); const int j = 16 * i + 8 * kh + 2 * a + h;
                    __hip_atomic_fetch_add(IMP + ql * IMP_STRIDE + j, (unsigned)(G * inv24 + 0.5f), __ATOMIC_RELAXED, __HIP_MEMORY_SCOPE_WORKGROUP);
                    __hip_atomic_fetch_add(IMP + ql * IMP_STRIDE + j + 1, (unsigned)(sc[4 * a + 3] * inv24 + 0.5f), __ATOMIC_RELAXED, __HIP_MEMORY_SCOPE_WORKGROUP); }
                pv32(tb, kh, r32, h, sc, oc0, oc1);
            }
        });
    }
    {
        const int cur = qb; LAS unsigned char* wm = WM + w * 256;
        if (cur + 1 <= 16) { if (lane <= cur) wm[lane] = 0xff; }
        else for (int rep_ = 0; rep_ < REP_TK; ++rep_) {
            unsigned key[8][4]; unsigned selbits = 0u;
#pragma unroll
            for (int qi = 0; qi < 8; ++qi) {
#pragma unroll
                for (int i = 0; i < 4; ++i) { const int j = 4 * lane + i; const unsigned x = IMP[(8 * w + qi) * IMP_STRIDE + j]; key[qi][i] = (j >= 1 && j <= cur - 2) ? (((x + 1u) << 2) | (unsigned)(3 - i)) : 0u; }
#define CE_(a_, b_) do { const unsigned hi_ = max(key[qi][a_], key[qi][b_]), lo_ = min(key[qi][a_], key[qi][b_]); key[qi][a_] = hi_; key[qi][b_] = lo_; } while (0)
                CE_(0, 1); CE_(2, 3); CE_(0, 2); CE_(1, 3); CE_(1, 2);
#undef CE_
            }
            for (int k = 0; k < 13; ++k) {
#pragma unroll
                for (int qi = 0; qi < 8; ++qi) {
                    const unsigned hv = key[qi][0] >> 2; const unsigned Mx = wave_max_u32(hv);
                    const unsigned long long bal = __ballot(hv == Mx); const int L = __ffsll((long long)bal) - 1;
                    const unsigned hk = (unsigned)__builtin_amdgcn_readlane((int)key[qi][0], L);
                    const unsigned bit = 1u << (8 * (3 - (int)(hk & 3u)) + qi);
                    const bool win = (lane == L);
                    selbits |= win ? bit : 0u;
                    key[qi][0] = win ? key[qi][1] : key[qi][0]; key[qi][1] = win ? key[qi][2] : key[qi][1]; key[qi][2] = win ? key[qi][3] : key[qi][2]; key[qi][3] = win ? 0u : key[qi][3];
                }
            }
            unsigned mybits[4];
#pragma unroll
            for (int i = 0; i < 4; ++i) mybits[i] = (selbits >> (8 * i)) & 0xffu;
#pragma unroll
            for (int i = 0; i < 4; ++i) { const int j = 4 * lane + i; unsigned bits = mybits[i]; if (j == 0 || j == cur - 1 || j == cur) bits = 0xffu; wm[j] = (unsigned char)bits; }
        }
    }
    __syncthreads();
    {
        const int kt_lo = (qb - 8) > 0 ? (qb - 8) : 0; const int ntile = qb - kt_lo + 1;
        const int t0w = 64 * qb + 32 * qh;
        TileSrc ts{proj + ((size_t)(b * SEQ) + 64 * kt_lo) * PW + C_KW + hkv * 64, 64 * PW, PW, vtw + (size_t)bh * 64 * SEQ + (size_t)kt_lo * 4096, 4096, 64};
        float m = NEG, lsum = 0.f; f32x16 o0, o1;
#pragma unroll
        for (int i = 0; i < 16; ++i) { o0[i] = 0.f; o1[i] = 0.f; }
        kv_pipeline<true>(F, F.lds + LDS_RA, ts, ntile, [&](int i, const LAS unsigned char* tb) {
#pragma unroll
            for (int kh = 0; kh < 2; ++kh) {
                const int k0 = 64 * (kt_lo + i) + 32 * kh;
                if (k0 > t0w + 31 || k0 + 31 <= t0w - 512) continue;
                f32x16 sc = qk32(tb, kh, r32, h, qf);
                if (!(k0 + 31 <= t0w && k0 > t0w + 31 - 512)) {
#pragma unroll
                    for (int e = 0; e < 16; ++e) { const int key = k0 + (e & 3) + 8 * (e >> 2) + 4 * h; sc[e] = (key <= t && key > t - 512) ? sc[e] : NEG; }
                }
                float ps = 0.f;
#pragma unroll
                for (int e = 0; e < 16; ++e) { sc[e] = fexp2(sc[e]); ps += sc[e]; }
                lsum += ps;
                pv32(tb, kh, r32, h, sc, o0, o1);
            }
        });
        bool redo; { const float Lq = xor32_sum(lsum); LAS int* WFLAG = (LAS int*)(F.lds + LDS_QCNT + 16);
          if (!(Lq > 5.4e-20f && Lq < 1.8e19f)) WFLAG[0] = 1;
          __syncthreads();
          redo = WFLAG[0] != 0; }
        if (redo) {
        lsum = 0.f;
#pragma unroll
        for (int i = 0; i < 16; ++i) { o0[i] = 0.f; o1[i] = 0.f; }
        kv_pipeline<true>(F, F.lds + LDS_RA, ts, ntile, [&](int i, const LAS unsigned char* tb) {
#pragma unroll
            for (int kh = 0; kh < 2; ++kh) {
                const int k0 = 64 * (kt_lo + i) + 32 * kh;
                if (k0 > t0w + 31 || k0 + 31 <= t0w - 512) continue;
                f32x16 sc = qk32(tb, kh, r32, h, qf);
                float tm = NEG;
                if (!(k0 + 31 <= t0w && k0 > t0w + 31 - 512)) {
#pragma unroll
                    for (int e = 0; e < 16; ++e) { const int key = k0 + (e & 3) + 8 * (e >> 2) + 4 * h; sc[e] = (key <= t && key > t - 512) ? sc[e] : NEG; }
                }
#pragma unroll
                for (int e = 0; e < 16; ++e) tm = fmaxf(tm, sc[e]);
                tm = xor32_max(tm);
                const float mn = fmaxf(m, tm); const float ms = (mn > NEG) ? mn : 0.f;
                const float alpha = fexp2((m - ms) * AL2E); float ps = 0.f;
#pragma unroll
                for (int e = 0; e < 16; ++e) { sc[e] = fexp2((sc[e] - ms) * AL2E); ps += sc[e]; }
                lsum = lsum * alpha + ps; m = mn;
                if (__any(alpha != 1.0f)) {
#pragma unroll
                    for (int e = 0; e < 16; ++e) { o0[e] *= alpha; o1[e] *= alpha; }
                }
                pv32(tb, kh, r32, h, sc, o0, o1);
            }
        });
        }
        const float Lw = xor32_sum(lsum); const float gw = g2 / fmaxf(Lw, 1e-30f);
        const float gc = g0 * inv_c;
#pragma unroll
        for (int e = 0; e < 16; ++e) { oc0[e] = gc * oc0[e] + gw * o0[e]; oc1[e] = gc * oc1[e] + gw * o1[e]; }
        bf16_t* op = oatt + trow * 1024 + (hkv * 4 + gq) * 64;
#pragma unroll
        for (int g4 = 0; g4 < 4; ++g4) { const int d = 8 * g4 + 4 * h; u32x2 w0, w1;
            w0.x = pk2(oc0[4 * g4], oc0[4 * g4 + 1]); w0.y = pk2(oc0[4 * g4 + 2], oc0[4 * g4 + 3]); w1.x = pk2(oc1[4 * g4], oc1[4 * g4 + 1]); w1.y = pk2(oc1[4 * g4 + 2], oc1[4 * g4 + 3]);
            *(u32x2*)(op + d) = w0; *(u32x2*)(op + 32 + d) = w1; }
    }
    const int cur = qb; const bool dense = (cur + 1 <= 16);
    float mf = NEG, lf = 0.f;
    {
        const int nfb = dense ? (cur + 1) : 3;
        TileSrc ts{kfs + (size_t)bh * 64 * SEQ, 4096, 0, vts + (size_t)bh * 64 * SEQ, 4096, 0};
#pragma unroll
        for (int e = 0; e < 16; ++e) { oc0[e] = 0.f; oc1[e] = 0.f; }
        auto dense_fn = [&](int i, const LAS unsigned char* tb) {
            const int j = dense ? i : (i == 0 ? 0 : cur - 2 + i);
#pragma unroll
            for (int kh = 0; kh < 2; ++kh) {
                const int k0 = 64 * j + 32 * kh;
                if (k0 > 64 * qb + 32 * qh + 31) continue;
                f32x16 sc = qk32(tb, kh, r32, h, qf);
                float tm = NEG;
                if (k0 + 31 > 64 * qb + 32 * qh) {
#pragma unroll
                    for (int e = 0; e < 16; ++e) { const int key = k0 + (e & 3) + 8 * (e >> 2) + 4 * h; sc[e] = (key <= t) ? sc[e] : NEG; }
                }
#pragma unroll
                for (int e = 0; e < 16; ++e) tm = fmaxf(tm, sc[e]);
                tm = xor32_max(tm);
                const float mn = fmaxf(mf, tm); const float ms = (mn > NEG) ? mn : 0.f;
                const float alpha = fexp2((mf - ms) * AL2E); float ps = 0.f;
#pragma unroll
                for (int e = 0; e < 16; ++e) { sc[e] = fexp2((sc[e] - ms) * AL2E); ps += sc[e]; }
                lf = lf * alpha + ps; mf = mn;
                if (__any(alpha != 1.0f)) {
#pragma unroll
                    for (int e = 0; e < 16; ++e) { oc0[e] *= alpha; oc1[e] *= alpha; }
                }
                pv32(tb, kh, r32, h, sc, oc0, oc1);
            }
        };
        auto dense_map = [&](int i) -> int { return dense ? i : (i == 0 ? 0 : cur - 2 + i); };
        kv_pipeline<true, decltype(dense_fn)&, decltype(dense_map), true>(F, F.lds + LDS_RA, ts, nfb, dense_fn, dense_map);
        lf = xor32_sum(lf);
#pragma unroll
        for (int g4 = 0; g4 < 4; ++g4) { *(f32x4*)(park + 4 * g4) = (f32x4){oc0[4 * g4], oc0[4 * g4 + 1], oc0[4 * g4 + 2], oc0[4 * g4 + 3]}; *(f32x4*)(park + 16 + 4 * g4) = (f32x4){oc1[4 * g4], oc1[4 * g4 + 1], oc1[4 * g4 + 2], oc1[4 * g4 + 3]}; }
    }
    {
        const int c16 = lane & 15, kq = lane >> 4, hd = c16 & 3, qs = c16 >> 2;
        LAS unsigned char* QT = F.lds + LDS_QT; LAS unsigned char* QL = F.lds + LDS_QL + w * 64; LAS int* MREF = (LAS int*)(F.lds + LDS_MREF); LAS unsigned* LS = (LAS unsigned*)(F.lds + LDS_LS);
        LAS int* OS = (LAS int*)(F.lds + LDS_RB);
        LAS int* QCNT = (LAS int*)(F.lds + LDS_QCNT); LAS int* FLAGW = (LAS int*)(F.lds + LDS_QCNT + 12);
        bool exact = false;
        const int nsp = dense ? 0 : (cur - 2);
        if (nsp > 0) {
        { const int row = F.tid >> 1, half = F.tid & 1, q = row >> 2, hh = row & 3;
          const bf16_t* src = proj + (size_t)(b * SEQ + 64 * qb + q) * PW + C_Q + (hkv * 4 + hh) * 64 + 32 * half;
          const u32x4 v0 = *(const u32x4*)src, v1 = *(const u32x4*)(src + 8), v2 = *(const u32x4*)(src + 16), v3 = *(const u32x4*)(src + 24);
          LAS u32x4* d = (LAS u32x4*)(QT + row * QT_ROW + 64 * half); d[0] = v0; d[1] = v1; d[2] = v2; d[3] = v3; }
        for (int i = F.tid; i < 64 * OS_QS; i += 512) OS[i] = 0;
        if (F.tid < 256) LS[F.tid] = 0u;
        if (h == 0) MREF[ql * 4 + gq] = __float_as_int(mf);
        if (F.tid < 2) QCNT[F.tid] = 0;
        if (F.tid == 2) FLAGW[0] = 0;
        __syncthreads();
        const bf16_t* Ksb = kfs + (size_t)bh * 64 * SEQ + lane * 8;
        const bf16_t* Vsb = vts + (size_t)bh * 64 * SEQ + lane * 8;
        auto ticket = [&](LAS int* cnt) -> int { int tk = 0; if (lane == 0) tk = __hip_atomic_fetch_add(cnt, 1, __ATOMIC_RELAXED, __HIP_MEMORY_SCOPE_WORKGROUP); return __builtin_amdgcn_readfirstlane(tk); };
        auto load_k = [&](int j, bf16x8 (&kf)[4][2]) {
#pragma unroll
            for (int rt = 0; rt < 4; ++rt)
#pragma unroll
                for (int ks = 0; ks < 2; ++ks) kf[rt][ks] = *(const bf16x8*)(Ksb + (size_t)j * 4096 + 512 * (2 * rt + ks)); };
        auto load_v = [&](int j, bf16x8 (&vf)[4][2]) {
#pragma unroll
            for (int dt = 0; dt < 4; ++dt)
#pragma unroll
                for (int sp = 0; sp < 2; ++sp) vf[dt][sp] = *(const bf16x8*)(Vsb + (size_t)j * 4096 + 512 * (2 * dt + sp)); };
        auto make_list = [&](int j, int& nj) -> int {
            const unsigned byte = WM[(lane >> 3) * 256 + j]; const bool act = (byte >> (lane & 7)) & 1u;
            const unsigned long long bal = __ballot(act); nj = __popcll(bal);
            const int rank = __builtin_amdgcn_mbcnt_hi((unsigned)(bal >> 32), __builtin_amdgcn_mbcnt_lo((unsigned)bal, 0u));
            if (act) QL[rank] = (unsigned char)lane;
            asm volatile("s_waitcnt lgkmcnt(0)" ::: "memory");
            return (nj + 3) >> 2; };
        auto col_query = [&](int tl, int nj, bool& valid) -> int { const int idx = 4 * tl + qs; valid = idx < nj; return (int)QL[valid ? idx : 0]; };
        auto scores = [&](const bf16x8 (&kf)[4][2], int q, bool valid, f32x4 (&st)[4]) {
            const LAS unsigned char* qp = QT + (q * 4 + hd) * QT_ROW + 16 * kq;
            const bf16x8 q0 = *(const LAS bf16x8*)qp, q1 = *(const LAS bf16x8*)(qp + 64);
#pragma unroll
            for (int rt = 0; rt < 4; ++rt) { st[rt] = (f32x4){0.f, 0.f, 0.f, 0.f}; st[rt] = MFMA16(kf[rt][0], q0, st[rt]); st[rt] = MFMA16(kf[rt][1], q1, st[rt]); }
            if (!valid) {
#pragma unroll
                for (int rt = 0; rt < 4; ++rt) st[rt] = (f32x4){NEG, NEG, NEG, NEG};
            } };
        auto run_pass2 = [&](const bool FAST) {
            bf16x8 kf[4][2], kn[4][2], vf[4][2], vn[4][2];
            int t0 = ticket(QCNT + 1), t1;
            { const int j0 = t0 < nsp ? t0 : nsp - 1; load_k(1 + j0, kn); load_v(1 + j0, vn); }
            while (t0 < nsp) {
                asm volatile("s_waitcnt vmcnt(0)" ::: "memory");
#pragma unroll
                for (int rt = 0; rt < 4; ++rt)
#pragma unroll
                    for (int ks = 0; ks < 2; ++ks) { kf[rt][ks] = kn[rt][ks]; vf[rt][ks] = vn[rt][ks]; }
#pragma unroll
                for (int rt = 0; rt < 4; ++rt)
#pragma unroll
                    for (int ks = 0; ks < 2; ++ks) { asm volatile("" : "+v"(kf[rt][ks])); asm volatile("" : "+v"(vf[rt][ks])); }
                t1 = ticket(QCNT + 1);
                { const int j1 = t1 < nsp ? t1 : nsp - 1; load_k(1 + j1, kn); load_v(1 + j1, vn); }
                int nj; const int ntl = make_list(1 + t0, nj);
                for (int tl = 0; tl < ntl; ++tl) {
                    bool valid; const int q = col_query(tl, nj, valid);
                    f32x4 st[4]; scores(kf, q, valid, st);
                    float mr;
                    if (FAST) mr = __int_as_float(MREF[q * 4 + hd]);
                    else { const int key = MREF[q * 4 + hd]; const int ib = key >= 0 ? key : (key ^ 0x7fffffff); mr = __int_as_float(ib); mr = (mr > NEG) ? mr : 0.f; }
                    float ps = 0.f; mr -= os_e2;
#pragma unroll
                    for (int rt = 0; rt < 4; ++rt)
#pragma unroll
                        for (int e = 0; e < 4; ++e) { st[rt][e] = fexp2((st[rt][e] - mr) * AL2E); ps += st[rt][e]; }
                    ps = xor32_sum(xor16_sum(ps));
                    if (FAST) { if (ps > 218.0f * os_scale) FLAGW[0] = 1; }
                    f32x4 o[4];
#pragma unroll
                    for (int dt = 0; dt < 4; ++dt) o[dt] = (f32x4){0.f, 0.f, 0.f, 0.f};
#pragma unroll
                    for (int sp = 0; sp < 2; ++sp) {
                        u32x4 pw; pw.x = pk2(st[2 * sp][0], st[2 * sp][1]); pw.y = pk2(st[2 * sp][2], st[2 * sp][3]); pw.z = pk2(st[2 * sp + 1][0], st[2 * sp + 1][1]); pw.w = pk2(st[2 * sp + 1][2], st[2 * sp + 1][3]);
                        const bf16x8 pb = __builtin_bit_cast(bf16x8, pw);
#pragma unroll
                        for (int dt = 0; dt < 4; ++dt) o[dt] = MFMA16(vf[dt][sp], pb, o[dt]);
                    }
                    if (valid) {
                        LAS int* op = OS + q * OS_QS + hd * OS_HS + 4 * kq;
#pragma unroll
                        for (int dt = 0; dt < 4; ++dt)
#pragma unroll
                            for (int e = 0; e < 4; ++e) __hip_atomic_fetch_add(op + 16 * dt + e, (int)o[dt][e], __ATOMIC_RELAXED, __HIP_MEMORY_SCOPE_WORKGROUP);
                        if (kq == 0) __hip_atomic_fetch_add(LS + q * 4 + hd, (unsigned)(ps * ls_scale + 0.5f), __ATOMIC_RELAXED, __HIP_MEMORY_SCOPE_WORKGROUP);
                    }
                }
                t0 = t1;
            }
            asm volatile("s_waitcnt vmcnt(0)" ::: "memory");
        };
        for (int rep2_ = 0; rep2_ < REP_B3; ++rep2_) {
            if (rep2_ > 0) { __syncthreads(); if (F.tid == 0) QCNT[1] = 0; __syncthreads(); }
            run_pass2(true);
        }
        __syncthreads();
        exact = (FLAGW[0] != 0) || (REP_B2 > 1);
        if (exact) {
            __syncthreads();
            for (int i = F.tid; i < 64 * OS_QS; i += 512) OS[i] = 0;
            if (F.tid < 256) { MREF[F.tid] = (int)0x80000000; LS[F.tid] = 0u; }
            if (F.tid < 2) QCNT[F.tid] = 0;
            __syncthreads();
            {
                bf16x8 kf[4][2], kn[4][2], kn2[4][2];
                int t0 = ticket(QCNT), t1 = ticket(QCNT), t2;
                if (t0 < nsp) load_k(1 + t0, kf);
                if (t1 < nsp) load_k(1 + t1, kn);
                while (t0 < nsp) {
                    t2 = ticket(QCNT);
                    if (t2 < nsp) load_k(1 + t2, kn2);
                    int nj; const int ntl = make_list(1 + t0, nj);
                    for (int tl = 0; tl < ntl; ++tl) {
                        bool valid; const int q = col_query(tl, nj, valid);
                        f32x4 st[4]; scores(kf, q, valid, st);
                        float bm = NEG;
#pragma unroll
                        for (int rt = 0; rt < 4; ++rt)
#pragma unroll
                            for (int e = 0; e < 4; ++e) bm = fmaxf(bm, st[rt][e]);
                        bm = xor32_max(xor16_max(bm));
                        if (valid && kq == 0) { const int ib = __float_as_int(bm); const int key = ib >= 0 ? ib : (ib ^ 0x7fffffff);
                            __hip_atomic_fetch_max(MREF + q * 4 + hd, key, __ATOMIC_RELAXED, __HIP_MEMORY_SCOPE_WORKGROUP); }
                    }
#pragma unroll
                    for (int rt = 0; rt < 4; ++rt)
#pragma unroll
                        for (int ks = 0; ks < 2; ++ks) { kf[rt][ks] = kn[rt][ks]; kn[rt][ks] = kn2[rt][ks]; }
                    t0 = t1; t1 = t2;
                }
            }
            __syncthreads();
            run_pass2(false);
            __syncthreads();
        }
        }
        {
            float ms_ = NEG, ls_ = 0.f;
            if (nsp > 0) { const int key = MREF[ql * 4 + gq]; const int ib = key >= 0 ? key : (key ^ 0x7fffffff); const float m0 = exact ? __int_as_float(ib) : mf;
                if ((!exact || key != (int)0x80000000) && m0 > NEG) { ms_ = m0; ls_ = (float)LS[ql * 4 + gq] * (1.0f / 1048576.0f); } }
            const float Mx = fmaxf(mf, ms_);
            const float wf = fexp2((mf - Mx) * AL2E), ws_ = (ms_ > NEG) ? fexp2((ms_ - Mx) * AL2E) : 0.f;
            const float Lt = lf * wf + ls_ * ws_;
            const float g1 = sigmoidf_(bf2f(grow[1])) / fmaxf(Lt, 1e-30f);
            const float cf = g1 * wf, cs = g1 * ws_ * os_inv;
            const LAS int* ap = OS + ql * OS_QS + gq * OS_HS; float osq = 0.f;
            bf16_t* op = oatt + trow * 1024 + (hkv * 4 + gq) * 64;
#pragma unroll
            for (int g4 = 0; g4 < 4; ++g4) { const int d = 8 * g4 + 4 * h;
                const u32x2 p0 = *(const u32x2*)(op + d), p1 = *(const u32x2*)(op + 32 + d);
                const f32x4 f0 = *(const f32x4*)(park + 4 * g4), f1 = *(const f32x4*)(park + 16 + 4 * g4);
                float s0[4], s1[4];
#pragma unroll
                for (int e = 0; e < 4; ++e) { s0[e] = (nsp > 0) ? (float)ap[d + e] : 0.f; s1[e] = (nsp > 0) ? (float)ap[32 + d + e] : 0.f; }
                u32x2 w0, w1;
                w0.x = pk2(bflo(p0.x) + cf * f0[0] + cs * s0[0], bfhi(p0.x) + cf * f0[1] + cs * s0[1]); w0.y = pk2(bflo(p0.y) + cf * f0[2] + cs * s0[2], bfhi(p0.y) + cf * f0[3] + cs * s0[3]);
                w1.x = pk2(bflo(p1.x) + cf * f1[0] + cs * s1[0], bfhi(p1.x) + cf * f1[1] + cs * s1[1]); w1.y = pk2(bflo(p1.y) + cf * f1[2] + cs * s1[2], bfhi(p1.y) + cf * f1[3] + cs * s1[3]);
                *(u32x2*)(op + d) = w0; *(u32x2*)(op + 32 + d) = w1;
                osq += (bflo(w0.x) * bflo(w0.x) + bfhi(w0.x) * bfhi(w0.x)) + (bflo(w0.y) * bflo(w0.y) + bfhi(w0.y) * bfhi(w0.y)) + (bflo(w1.x) * bflo(w1.x) + bfhi(w1.x) * bfhi(w1.x)) + (bflo(w1.y) * bflo(w1.y) + bfhi(w1.y) * bfhi(w1.y)); }
            (void)__hip_atomic_fetch_add(sst + trow * 2, (unsigned long long)(osq * 16777216.f), __ATOMIC_RELAXED, __HIP_MEMORY_SCOPE_AGENT);
        }
    }
    __syncthreads();
}

DI void attn_phase(Frame& F, const bf16_t* proj, const bf16_t* kcb, const bf16_t* vctb, const bf16_t* vts, const bf16_t* vtw, bf16_t* oatt, const unsigned* vmax_word, float* park, unsigned* qctr, const bf16_t* kfs, unsigned long long* sst) {
    const float vmaxf = fmaxf(__uint_as_float(__hip_atomic_load(vmax_word, __ATOMIC_RELAXED, __HIP_MEMORY_SCOPE_AGENT)), 1e-20f);
    int e2 = (int)floorf(log2f(2.0e9f / (1100.0f * 55.0f * vmaxf)));
    e2 = e2 > 100 ? 100 : (e2 < -100 ? -100 : e2);
    const float os_scale = exp2f((float)e2), os_inv = exp2f((float)-e2);
    LAS int* QW = (LAS int*)(F.lds + LDS_QCNT + 8);
    int xq; { unsigned xx; asm volatile("s_getreg_b32 %0, hwreg(20, 0, 4)" : "=s"(xx)); xq = (int)(xx & 7u); }
    for (int tries = 0; tries < 8; ) {
        __syncthreads();
        if (F.tid == 0) QW[0] = (int)__hip_atomic_fetch_add(qctr + xq, 1u, __ATOMIC_RELAXED, __HIP_MEMORY_SCOPE_AGENT);
        __syncthreads();
        const int k = __builtin_amdgcn_readfirstlane(QW[0]);
        if (k >= 192) { xq = (xq + 1) & 7; ++tries; continue; }
        int bh, qb;
        if (xq < 6) { bh = xq; qb = 4 * (63 - k / 3) + (2 - k % 3); }
        else { bh = 3 * (xq - 6) + (k >> 6); qb = 4 * (63 - (k & 63)) + 3; }
        attn_unit(F, proj, kcb, vctb, vts, vtw, oatt, bh, qb, os_scale, os_inv, (float)e2, park + (size_t)F.bid * 16384 + (size_t)F.tid * 32, kfs, sst);
    }
    __syncthreads();
}


#define XB_TMO      128
#define XB_XCNT(j)  (256  + 64 * (j))
#define XB_XSUB(j)  (1280 + 64 * (j))
#define XB_XGEN(j)  (2304 + 64 * (j))
#define XB_TOP      3328
#define XB_TOPGEN   3392
#define XCD_BAR_WORDS 3456
#define XB_SPIN_CAP (1u << 22)
DI unsigned xb_ld(unsigned* p)              { return __hip_atomic_load(p, __ATOMIC_RELAXED, __HIP_MEMORY_SCOPE_AGENT); }
DI unsigned xb_add(unsigned* p, unsigned v) { return __hip_atomic_fetch_add(p, v, __ATOMIC_RELAXED, __HIP_MEMORY_SCOPE_AGENT); }
DI unsigned xb_xcc_id() { unsigned x; asm volatile("s_getreg_b32 %0, hwreg(20, 0, 4)" : "=s"(x)); return x & 0xFu; }
#define XB_SPIN(cond, bar) do { unsigned _sp = 0; while (cond) { __builtin_amdgcn_s_sleep(1); \
    if ((++_sp & 255u) == 0u) { if (xb_ld(&(bar)[XB_TMO])) break; if (_sp > XB_SPIN_CAP) { atomicAdd(&(bar)[XB_TMO], 1u); break; } } } } while (0)
DI void xcd_barrier_complete(unsigned* bar, unsigned x, unsigned& nloc, unsigned& nx) {
    const unsigned G = gridDim.x * gridDim.y * gridDim.z;
    unsigned sum, cnt, mine, sp = 0u;
    for (;;) {
        sum = 0u; cnt = 0u; mine = 0u;
#pragma unroll
        for (unsigned j = 0; j < 16; ++j) { const unsigned c = xb_ld(&bar[XB_XCNT(j)]); sum += c; cnt += (c > 0u) ? 1u : 0u; mine = (j == x) ? c : mine; }
        if (sum == G) break;
        __builtin_amdgcn_s_sleep(1);
        if ((++sp & 255u) == 0u) { if (xb_ld(&bar[XB_TMO])) break; if (sp > XB_SPIN_CAP) { atomicAdd(&bar[XB_TMO], 1u); break; } }
    }
    nloc = mine > 0u ? mine : 1u; nx = cnt > 0u ? cnt : 1u;
}
DI void xcd_barrier(unsigned* bar, volatile LAS unsigned* st, int tid) {
    asm volatile("s_waitcnt vmcnt(0)" ::: "memory");
    __syncthreads();
    if (tid == 0) {
        const unsigned x = xb_xcc_id();
        __builtin_amdgcn_s_waitcnt(0);
        unsigned nloc = st[0], nx = st[1];
        if (nloc == 0u) { xcd_barrier_complete(bar, x, nloc, nx); st[0] = nloc; st[1] = nx; }
        const unsigned old = xb_add(&bar[XB_XSUB(x)], 1u);
        const unsigned gen = old / nloc;
        if (old + 1u == (gen + 1u) * nloc) {
            __builtin_amdgcn_fence(__ATOMIC_RELEASE, "agent");
            asm volatile("s_waitcnt vmcnt(0)" ::: "memory");
            const unsigned og = xb_add(&bar[XB_TOP], 1u);
            const unsigned tg = og / nx;
            if (og + 1u == (tg + 1u) * nx) xb_add(&bar[XB_TOPGEN], 1u);
            else XB_SPIN(xb_ld(&bar[XB_TOPGEN]) == tg, bar);
            __builtin_amdgcn_fence(__ATOMIC_ACQUIRE, "agent");
            xb_add(&bar[XB_XGEN(x)], 1u);
            asm volatile("s_waitcnt vmcnt(0)" ::: "memory");
        } else {
            XB_SPIN(xb_ld(&bar[XB_XGEN(x)]) == gen, bar);
            __builtin_amdgcn_fence(__ATOMIC_ACQUIRE, "agent");
            asm volatile("s_waitcnt vmcnt(0)" ::: "memory");
        }
    }
    __syncthreads();
}

#define REFRESH() do { int w_ = wave0, b_ = blockIdx.x, g_ = gridDim.x; asm volatile("" : "+s"(w_), "+s"(b_), "+s"(g_)); \
    int l_; asm volatile("v_mbcnt_lo_u32_b32 %0, -1, 0\n\tv_mbcnt_hi_u32_b32 %0, -1, %0" : "=v"(l_)); \
    F.lane = l_; F.wave = w_; F.tid = w_ * 64 + l_; F.bid = b_; F.G = g_; F.gw = b_ * 8 + w_; F.ngw = g_ * 8; } while (0)
#define XBAR() xcd_barrier((unsigned*)(F.wsp() + WS_CTL), (volatile LAS unsigned*)(F.lds + LDS_PT + 232), F.tid)
#if REP_SYNC > 1
#define GSYNC() do { XBAR(); XBAR(); REFRESH(); } while (0)
#else
#define GSYNC() do { REFRESH(); XBAR(); REFRESH(); } while (0)
#endif
#define WSP(off) (F.wsp() + (off))
#define WL(off) (F.wsp() + WS_W + (size_t)l * WL_STRIDE + (off))
#define MSL(off) (F.wsp() + WS_MISC + (size_t)l * MS_L + (off))
#define CTL(off) (F.wsp() + WS_CTL + CT_BASE + (size_t)l * CT_L + (off))
__global__ void __launch_bounds__(512, 2) mk_fwd(Params p) {
    extern __shared__ __attribute__((aligned(16))) unsigned char lds_raw[];
    cg::grid_group grid = cg::this_grid();
    Frame F;
    F.lds = (LAS unsigned char*)lds_raw; F.pt = (LAS const unsigned long long*)(F.lds + LDS_PT);
    const int wave0 = __builtin_amdgcn_readfirstlane((int)threadIdx.x >> 6);
    REFRESH();
    {
        LAS unsigned long long* ptw = (LAS unsigned long long*)(F.lds + LDS_PT);
        if (F.tid < 26) ptw[F.tid] = (unsigned long long)p.in[F.tid];
        if (F.tid == 26) ptw[26] = (unsigned long long)p.out;
        if (F.tid == 27) ptw[27] = (unsigned long long)p.ws;
        if (F.tid == 28) ptw[29] = 0ull;
        if (F.tid == 0) (void)xb_add((unsigned*)p.ws + XB_XCNT(xb_xcc_id()), 1u);
    }
    __syncthreads();

    PH(2, convert_rows_stats(F, F.in(0), (bf16_t*)WSP(WS_ACT), (unsigned long long*)WSP(WS_SSX)); REFRESH(););
    { unsigned long long* z = (unsigned long long*)WSP(WS_SSX) + (size_t)NT * 2; for (int i = F.bid * 512 + F.tid; i < (NL - 1) * NT * 2; i += F.G * 512) z[i] = 0ull; }
    { unsigned long long* z = (unsigned long long*)WSP(WS_SST); for (int i = F.bid * 512 + F.tid; i < NL * NT * 2; i += F.G * 512) z[i] = 0ull; }
    PH(0, prologue_a(F, 0, F.gw, F.ngw); REFRESH(););
    if (F.G == 0x7fffffff) grid.sync();
    GSYNC();
    PH(1, prologue_b(F); REFRESH(););
    if (F.G != 256) { prologue_a(F, 1, F.gw, F.ngw); __syncthreads(); REFRESH(); }
    else if (F.bid >= 128) { prologue_a(F, 1, (F.bid - 128) * 8 + F.wave, 1024); __syncthreads(); REFRESH(); }

#if STAGE >= 2
#pragma unroll 1
    for (int l = 0; l < NL; ++l) {
        REFRESH();
        { pg8::APlain g{(l == 0) ? (const char*)WSP(WS_ACT) : (const char*)F.out(), (const char*)WL(WO_WIN), 1024}; pg8::StaticOrder S; S.init(NT / 256, PW / 256, F.G, F.bid);
          pg8::EpiBf16 E{(bf16_t*)WSP(WS_PROJ), PW, (const unsigned long long*)WSP(WS_SSX) + (size_t)l * NT * 2}; pg8::gemm_phase<pg8::EpiBf16, pg8::APlain, true>(F.lds, g, S, E, F.tid); }
#if REP_INPROJ > 1
        REFRESH();
        { pg8::APlain g{(l == 0) ? (const char*)WSP(WS_ACT) : (const char*)F.out(), (const char*)WL(WO_WIN), 1024}; pg8::StaticOrder S; S.init(NT / 256, PW / 256, F.G, F.bid);
          pg8::EpiBf16 E{(bf16_t*)WSP(WS_PROJ), PW, (const unsigned long long*)WSP(WS_SSX) + (size_t)l * NT * 2}; pg8::gemm_phase<pg8::EpiBf16, pg8::APlain, true>(F.lds, g, S, E, F.tid); }
#endif
        GSYNC();
#define LOCAL_HANDOFF() do { asm volatile("s_waitcnt vmcnt(0)" ::: "memory"); __syncthreads(); if (F.tid == 0) { __builtin_amdgcn_fence(__ATOMIC_ACQUIRE, "agent"); asm volatile("s_waitcnt vmcnt(0)" ::: "memory"); } __syncthreads(); } while (0)
        if (F.G == 256) {
            if (F.bid < 48) {
                REFRESH();
                { pg8::ACompress g{(const char*)WSP(WS_PROJ), (const char*)WL(WO_W1)}; pg8::StaticOrder S; S.init_run(F.bid, 0, 1);
                  pg8::EpiCmpHid E{(bf16_t*)WSP(WS_HIDC), (const float*)CTL(CT_CB1)}; pg8::gemm_phase<pg8::EpiCmpHid, pg8::ACompress, true>(F.lds, g, S, E, F.tid); }
                REFRESH(); LOCAL_HANDOFF(); REFRESH();
                { const int pm = F.bid, it = (pm / 24) * 192 + (pm % 24) * 8 + F.wave;
                  compress2_phase(F, (const bf16_t*)WSP(WS_HIDC), (const bf16_t*)CTL(CT_W2T), F.in(7) + (size_t)l * 2 * 64, (bf16_t*)WSP(WS_KC), (bf16_t*)WSP(WS_VCT), it, it + 1, 1); }
            } else if (F.bid < 80) {
                REFRESH();
                { pg8::ASsm1 g{(const char*)WSP(WS_UC), (const char*)WL(WO_SS1)}; pg8::StaticOrder S; S.init_run((F.bid - 48) * 4, 1, 4);
                  pg8::EpiSsm1 E{(float*)WSP(WS_YI), (float*)WSP(WS_HL)}; pg8::gemm_phase<pg8::EpiSsm1, pg8::ASsm1, true>(F.lds, g, S, E, F.tid); }
                REFRESH(); LOCAL_HANDOFF(); REFRESH();
                ssm_carry_phase(F, (const float*)WSP(WS_HL), (const f32x2*)CTL(CT_AB16), (const f32x2*)CTL(CT_AB1K), (bf16_t*)WSP(WS_HIN), F.bid - 48, F.bid - 47, 1);
            } else {
                REFRESH();
                vtranspose_phase(F, (const bf16_t*)WSP(WS_PROJ), (bf16_t*)WSP(WS_VTS), (bf16_t*)WSP(WS_VTW), (bf16_t*)WSP(WS_KFS), (unsigned*)WSP(WS_CTL) + 3584 + l, 80);
                __syncthreads(); REFRESH();
                { pg8::ASsm1 g{(const char*)WSP(WS_UC), (const char*)WL(WO_SS1)}; pg8::StaticOrder S; S.init(128, 1, 176, F.bid - 80);
                  pg8::EpiSsm1 E{(float*)WSP(WS_YI), (float*)WSP(WS_HL)}; pg8::gemm_phase<pg8::EpiSsm1, pg8::ASsm1, true>(F.lds, g, S, E, F.tid); }
            }
            GSYNC();
        } else {
        PH(3, REFRESH(); vtranspose_phase(F, (const bf16_t*)WSP(WS_PROJ), (bf16_t*)WSP(WS_VTS), (bf16_t*)WSP(WS_VTW), (bf16_t*)WSP(WS_KFS), (unsigned*)WSP(WS_CTL) + 3584 + l, 48);
        __syncthreads(); REFRESH(););
        PH(4, REFRESH();
        { pg8::ACompress g{(const char*)WSP(WS_PROJ), (const char*)WL(WO_W1)}; pg8::StaticOrder S; S.init(48, 1, F.G, F.bid);
          pg8::EpiCmpHid E{(bf16_t*)WSP(WS_HIDC), (const float*)CTL(CT_CB1)}; pg8::gemm_phase<pg8::EpiCmpHid, pg8::ACompress, true>(F.lds, g, S, E, F.tid); });
        PH(5, REFRESH();
        { pg8::ASsm1 g{(const char*)WSP(WS_UC), (const char*)WL(WO_SS1)}; pg8::StaticOrder S; S.init(128, 2, F.G, F.bid);
          pg8::EpiSsm1 E{(float*)WSP(WS_YI), (float*)WSP(WS_HL)}; pg8::gemm_phase<pg8::EpiSsm1, pg8::ASsm1, true>(F.lds, g, S, E, F.tid); });
        GSYNC();
        PH(6, compress2_phase(F, (const bf16_t*)WSP(WS_HIDC), (const bf16_t*)CTL(CT_W2T), F.in(7) + (size_t)l * 2 * 64, (bf16_t*)WSP(WS_KC), (bf16_t*)WSP(WS_VCT), F.gw, 2 * 192, F.ngw);
        __syncthreads(); REFRESH(););
        PH(7, ssm_carry_phase(F, (const float*)WSP(WS_HL), (const f32x2*)CTL(CT_AB16), (const f32x2*)CTL(CT_AB1K), (bf16_t*)WSP(WS_HIN), F.bid, 32, F.G); REFRESH(););
        GSYNC();
        }
        PH(8,         REFRESH();
        { pg8::ASsm2 g{(const char*)WSP(WS_HIN), (const char*)WL(WO_SS2)}; pg8::StaticOrder S; S.init(128, 1, F.G, F.bid);
          pg8::EpiSsm2 E{(const float*)WSP(WS_YI), (const bf16_t*)WSP(WS_PROJ), F.in(15) + (size_t)l * 256, (bf16_t*)WSP(WS_YS2)}; pg8::gemm_phase<pg8::EpiSsm2, pg8::ASsm2, true>(F.lds, g, S, E, F.tid); });
#if STAGE >= 3
        REFRESH();
        attn_phase(F, (const bf16_t*)WSP(WS_PROJ), (const bf16_t*)WSP(WS_KC), (const bf16_t*)WSP(WS_VCT), (const bf16_t*)WSP(WS_VTS), (const bf16_t*)WSP(WS_VTW), (bf16_t*)WSP(WS_OATT), (const unsigned*)WSP(WS_CTL) + 3584 + l, (float*)WSP(WS_PARK), (unsigned*)WSP(WS_CTL) + 3600 + 16 * l, (const bf16_t*)WSP(WS_KFS), (unsigned long long*)WSP(WS_SST) + (size_t)l * NT * 2);
#if REP_ATTN > 1
        REFRESH();
        attn_phase(F, (const bf16_t*)WSP(WS_PROJ), (const bf16_t*)WSP(WS_KC), (const bf16_t*)WSP(WS_VCT), (const bf16_t*)WSP(WS_VTS), (const bf16_t*)WSP(WS_VTW), (bf16_t*)WSP(WS_OATT), (const unsigned*)WSP(WS_CTL) + 3584 + l, (float*)WSP(WS_PARK), (unsigned*)WSP(WS_CTL) + 3600 + 16 * l, (const bf16_t*)WSP(WS_KFS), (unsigned long long*)WSP(WS_SST) + (size_t)l * NT * 2);
#endif
#else
        { unsigned* oz = (unsigned*)WSP(WS_OATT); for (size_t i = (size_t)F.bid * 512 + F.tid; i < (size_t)NT * 768 / 2; i += (size_t)F.G * 512) oz[i] = 0u; }
#endif
        GSYNC();
        PH(9,         REFRESH();
        { pg8::APlain g{(const char*)WSP(WS_YS2), (const char*)MSL(MS_WGLU), 256}; pg8::StaticOrder S; S.init(NT / 256, 2, F.G, F.bid);
          pg8::EpiGlu E{(bf16_t*)WSP(WS_OATT), F.in(17) + (size_t)l * 512, (unsigned long long*)WSP(WS_SST) + (size_t)l * NT * 2}; pg8::gemm_phase<pg8::EpiGlu, pg8::APlain, true>(F.lds, g, S, E, F.tid); });
        GSYNC();
        REFRESH();
        { pg8::APlain g{(const char*)WSP(WS_OATT), (const char*)WL(WO_WOUT), 1024}; pg8::StaticOrder S; S.init(NT / 256, 4, F.G, F.bid);
          pg8::EpiResB<true, 0> E{(l == 0) ? F.in(0) : (const float*)nullptr, (const bf16_t*)F.out(), (bf16_t*)F.out(), (const unsigned long long*)WSP(WS_SST) + (size_t)l * NT * 2, (unsigned long long*)nullptr}; pg8::gemm_phase<pg8::EpiResB<true, 0>, pg8::APlain, true>(F.lds, g, S, E, F.tid); }
        GSYNC();
#if STAGE >= 4
        PH(11, rmsnorm_rows_xb<1>(F, (const bf16_t*)F.out(), F.in(21) + (size_t)l * DM, WSP(WS_ACT)); REFRESH(););
        GSYNC();
        REFRESH();
        { pg8::APlain g{(const char*)WSP(WS_ACT), (const char*)WL(WO_WGU), 512, 0x7c7c7c7c, 0x7c7c7c7c}; pg8::StaticOrder S; S.init(NT / 256, 22, F.G, F.bid);
          pg8::EpiSwiglu8 E{(unsigned char*)WSP(WS_PROJ), 0.015625f * FP8FIX}; pg8::gemm_phase<pg8::EpiSwiglu8, pg8::APlain, true, true>(F.lds, g, S, E, F.tid); }
        GSYNC();
        REFRESH();
        { pg8::APlain g{(const char*)WSP(WS_PROJ), (const char*)WL(WO_WD), DFF / 2, 0x7b7b7b7b, 0x7b7b7b7b}; pg8::StaticOrder S; S.init(NT / 256, 4, F.G, F.bid);
          pg8::EpiResB<false, 8> E{(const float*)nullptr, (const bf16_t*)F.out(), (l == NL - 1) ? (bf16_t*)WSP(WS_XLAST) : (bf16_t*)F.out(), (const unsigned long long*)nullptr, (l == NL - 1) ? (unsigned long long*)nullptr : (unsigned long long*)WSP(WS_SSX) + (size_t)(l + 1) * NT * 2}; pg8::gemm_phase<pg8::EpiResB<false, 8>, pg8::APlain, true, true>(F.lds, g, S, E, F.tid); }
        GSYNC();
#endif
#if STAGE < 5
        break;
#endif
    }
    rmsnorm_rows_xb<2>(F, (const bf16_t*)WSP(WS_XLAST), F.in(25), F.out());
#else
    {
        const float* x0 = F.in(0); const float* fg = F.in(25); float* X = F.out();
        for (int m = F.gw; m < NT; m += F.ngw) {
            const f32x4* xr = (const f32x4*)(x0 + (size_t)m * DM) + F.lane; f32x4 v[4]; float s = 0.f;
#pragma unroll
            for (int j = 0; j < 4; ++j) { v[j] = xr[64 * j]; s += (v[j].x * v[j].x + v[j].y * v[j].y) + (v[j].z * v[j].z + v[j].w * v[j].w); }
            const float rstd = rsqrtf(wave_sum(s) * (1.f / DM) + 1e-6f);
            f32x4* o = (f32x4*)(X + (size_t)m * DM) + F.lane;
#pragma unroll
            for (int j = 0; j < 4; ++j) o[64 * j] = v[j] * rstd * ((const f32x4*)fg)[64 * j + F.lane];
        }
    }
#endif
}

extern "C" void kernel_launch(void* const* d_in, const int* in_sizes, int n_in, void* d_out, int out_size, void* d_ws, size_t ws_size, hipStream_t stream) {
    static int grid_blocks = 0;
    if (grid_blocks == 0) {
        if (n_in != 26 || ws_size < WS_END) { fprintf(stderr, "kernel_launch: unexpected n_in %d or ws_size %zu (< %zu)\n", n_in, ws_size, (size_t)WS_END); grid_blocks = -1; return; }
        int dev = 0, cus = 0, per_cu = 0;
        hipGetDevice(&dev);
        hipDeviceGetAttribute(&cus, hipDeviceAttributeMultiprocessorCount, dev);
        hipFuncSetAttribute((const void*)mk_fwd, hipFuncAttributeMaxDynamicSharedMemorySize, LDS_BYTES);
        hipOccupancyMaxActiveBlocksPerMultiprocessor(&per_cu, (const void*)mk_fwd, 512, LDS_BYTES);
        if (per_cu < 1) { fprintf(stderr, "kernel_launch: occupancy query says %d blocks per CU\n", per_cu); per_cu = 1; }
        grid_blocks = cus;
        (void)hipGetLastError();
    }
    if (grid_blocks < 0) return;
    if (hipMemsetAsync((char*)d_ws + WS_CTL, 0, 16384, stream) != hipSuccess) { fprintf(stderr, "kernel_launch: memset of the barrier words failed\n"); return; }
    Params p{};
    for (int i = 0; i < 26; ++i) p.in[i] = (const float*)d_in[i];
    p.out = (float*)d_out; p.ws = (unsigned char*)d_ws;
    void* args[] = {&p};
    hipError_t e = hipLaunchCooperativeKernel((const void*)mk_fwd, dim3(grid_blocks), dim3(512), args, LDS_BYTES, stream);
    if (e != hipSuccess) fprintf(stderr, "cooperative launch failed: %s (grid %d)\n", hipGetErrorString(e), grid_blocks);
}
```

```cpp
#include <hip/hip_runtime.h>
#include <hip/hip_cooperative_groups.h>
#include <cstdio>
#include <cstdint>
namespace cg = cooperative_groups;

#ifndef STAGE
#define STAGE 99
#endif
#ifndef REP_ATTN
#define REP_ATTN 1
#endif
#ifndef REP_B1
#define REP_B1 1
#endif
#ifndef REP_B2
#define REP_B2 1
#endif
#ifndef REP_B3
#define REP_B3 1
#endif
#ifndef REP_TK
#define REP_TK 1
#endif
#ifndef FP8FIX
#define FP8FIX 1.0f
#endif
#ifndef PROBE_DUP
#define PROBE_DUP 0
#endif
#define PH(bit, ...) do { __VA_ARGS__ if (PROBE_DUP & (1 << (bit))) { __VA_ARGS__ } } while (0)
#ifndef FORCE_REDO
#define FORCE_REDO 0
#endif
#ifndef REP_GU
#define REP_GU 1
#endif
#ifndef REP_INPROJ
#define REP_INPROJ 1
#endif
#ifndef REP_SYNC
#define REP_SYNC 1
#endif

#define DI __device__ __forceinline__
#define LAS __attribute__((address_space(3)))
typedef unsigned short bf16_t;
typedef short bf16x8 __attribute__((ext_vector_type(8)));
typedef short s16x4 __attribute__((ext_vector_type(4)));
typedef float f32x4 __attribute__((ext_vector_type(4)));
typedef float f32x2 __attribute__((ext_vector_type(2)));
typedef float f32x16 __attribute__((ext_vector_type(16)));
typedef unsigned u32x4 __attribute__((ext_vector_type(4)));
typedef unsigned u32x2 __attribute__((ext_vector_type(2)));
typedef __bf16 bf2_t __attribute__((ext_vector_type(2)));
typedef int i32x8 __attribute__((ext_vector_type(8)));
typedef int i32x4 __attribute__((ext_vector_type(4)));

DI float clamp8(float v) { return fminf(fmaxf(v, -440.f), 440.f); }
DI unsigned pk4_fp8(float a, float b, float c, float d) { int w = 0; w = __builtin_amdgcn_cvt_pk_fp8_f32(clamp8(a), clamp8(b), w, false); w = __builtin_amdgcn_cvt_pk_fp8_f32(clamp8(c), clamp8(d), w, true); return (unsigned)w; }
DI unsigned pk2(float lo, float hi) { f32x2 v = {lo, hi}; return __builtin_bit_cast(unsigned, __builtin_convertvector(v, bf2_t)); }
DI bf16_t f2bf(float f) { return (bf16_t)(pk2(f, 0.f) & 0xffffu); }
DI float bf2f(bf16_t u) { return __uint_as_float((unsigned)u << 16); }
DI float bflo(unsigned w) { return __uint_as_float(w << 16); }
DI float bfhi(unsigned w) { return __uint_as_float(w & 0xffff0000u); }
DI float fexp2(float x) { return __builtin_amdgcn_exp2f(x); }
DI float sigmoidf_(float x) { return __builtin_amdgcn_rcpf(1.0f + __builtin_amdgcn_exp2f(-1.4426950408889634f * x)); }
DI float gelu_tanh(float x) { const float y = 0.7978845608028654f * (x + 0.044715f * x * x * x); return x * __builtin_amdgcn_rcpf(1.0f + __builtin_amdgcn_exp2f(-2.8853900817779268f * y)); }
template <int CTRL> DI float dppf(float v) { return __builtin_bit_cast(float, __builtin_amdgcn_update_dpp(0, __builtin_bit_cast(int, v), CTRL, 0xF, 0xF, false)); }
struct F2 { float lo, hi; };
DI F2 halves32(float v) { const auto r = __builtin_amdgcn_permlane32_swap(__float_as_uint(v), __float_as_uint(v), false, false); return {__uint_as_float(r[0]), __uint_as_float(r[1])}; }
DI F2 rows16(float v) { const auto r = __builtin_amdgcn_permlane16_swap(__float_as_uint(v), __float_as_uint(v), false, false); return {__uint_as_float(r[0]), __uint_as_float(r[1])}; }
DI float xor32_sum(float v) { const F2 p = halves32(v); return p.lo + p.hi; }
DI float xor32_max(float v) { const F2 p = halves32(v); return fmaxf(p.lo, p.hi); }
DI float xor16_sum(float v) { const F2 p = rows16(v); return p.lo + p.hi; }
DI float xor16_max(float v) { const F2 p = rows16(v); return fmaxf(p.lo, p.hi); }
DI float wave_sum(float v) {
    v += dppf<0xB1>(v); v += dppf<0x4E>(v); v += dppf<0x141>(v); v += dppf<0x140>(v);
    return xor32_sum(xor16_sum(v));
}

DI unsigned wave_max_u32(unsigned v) {
    v = max(v, (unsigned)__builtin_amdgcn_update_dpp(0, (int)v, 0xB1, 0xF, 0xF, false));
    v = max(v, (unsigned)__builtin_amdgcn_update_dpp(0, (int)v, 0x4E, 0xF, 0xF, false));
    v = max(v, (unsigned)__builtin_amdgcn_update_dpp(0, (int)v, 0x141, 0xF, 0xF, false));
    v = max(v, (unsigned)__builtin_amdgcn_update_dpp(0, (int)v, 0x140, 0xF, 0xF, false));
    const unsigned a = __builtin_amdgcn_readlane(v, 0), b = __builtin_amdgcn_readlane(v, 16), c = __builtin_amdgcn_readlane(v, 32), d = __builtin_amdgcn_readlane(v, 48);
    return max(max(a, b), max(c, d));
}

constexpr int NB = 2, SEQ = 16384, DM = 1024, NT = NB * SEQ, NL = 2;
constexpr int PW = 2304;
constexpr int C_Q = 0, C_KC = 768, C_VC = 960, C_KS = 1152, C_VS = 1344, C_KW = 1536, C_VW = 1728, C_U = 1920, C_G = 2176;
constexpr int DFF = 2816;
constexpr float L2E = 1.4426950408889634f;

constexpr size_t MiB = 1u << 20;
constexpr size_t WS_CTL = 0;
constexpr size_t WS_W = 1 * MiB;
constexpr size_t WL_STRIDE = 32 * MiB;
constexpr size_t WO_WIN = 0;
constexpr size_t WO_WOUT = 5 * MiB;
constexpr size_t WO_WGU = 7 * MiB;
constexpr size_t WO_WD = 18 * MiB;
constexpr size_t WO_W1 = 24 * MiB;
constexpr size_t WO_SS1 = 26 * MiB;
constexpr size_t WO_SS2 = 30 * MiB;
constexpr size_t CT_L = 256 * 1024;
constexpr size_t CT_BASE = 64 * 1024;
constexpr size_t CT_AB16 = 0;
constexpr size_t CT_AB1K = 8 * 1024;
constexpr size_t CT_CB1 = 16 * 1024;
constexpr size_t CT_W2T = 20 * 1024;
constexpr size_t CT_WGLU = 84 * 1024;
constexpr size_t WS_ACT = WS_W + 2 * WL_STRIDE;
constexpr size_t WS_PROJ = WS_ACT + 64 * MiB;
constexpr size_t WS_OATT = WS_PROJ + 176 * MiB;
constexpr size_t WS_OSSM = WS_OATT + 48 * MiB;
constexpr size_t WS_YS2 = WS_OSSM + 16 * MiB;
constexpr size_t WS_YI = WS_ACT;
constexpr size_t WS_HL = WS_YS2 + 16 * MiB;
constexpr size_t WS_HIN = WS_HL + 16 * MiB;
constexpr size_t WS_VTS = WS_HIN + 16 * MiB;
constexpr size_t WS_VTW = WS_VTS + 12 * MiB;
constexpr size_t WS_KC = WS_VTW + 12 * MiB;
constexpr size_t WS_VCT = WS_KC + 1 * MiB;
constexpr size_t WS_HIDC = WS_VCT + 1 * MiB;
constexpr size_t WS_MISC = WS_HIDC + 6 * MiB;
constexpr size_t WS_PARK = WS_MISC + 4 * MiB;
constexpr size_t WS_KFS = WS_PARK + 16 * MiB;
constexpr size_t WS_SST = WS_KFS + 12 * MiB;
constexpr size_t WS_SSX = WS_SST + 1 * MiB;
constexpr size_t WS_UC = WS_SSX + 1 * MiB;
constexpr size_t WS_END = WS_UC + 16 * MiB;
constexpr size_t WS_XLAST = WS_PROJ + 96 * MiB;
constexpr size_t MS_L = 2 * MiB;
constexpr size_t MS_MTAB = 0;
constexpr size_t MS_CBP = 256 * 1024;
constexpr size_t MS_WGLU = 512 * 1024;
constexpr size_t MS_BBAR = 1024 * 1024;
constexpr size_t MS_FTAB = 1024 * 1024 + 128 * 1024;

constexpr int LDS_BYTES = 143360;

struct Params { const float* in[26]; float* out; unsigned char* ws; };

namespace pg8 {
constexpr int BM = 256, BK = 64, HALF = 128, HTB = HALF * BK * 2, STAGE_BYTES = 8 * HTB, NXCD = 8, WGM = 8;
__host__ __device__ __forceinline__ int lds_byte(int r, int c) { const int st = (r >> 4) * 2 + (c >> 5), rr = r & 15, cc = c & 31, ob = rr * 64 + cc * 2; return st * 1024 + (ob ^ (((ob >> 9) & 1) << 5)); }
__host__ __device__ __forceinline__ void stage_rc(int b, int& R, int& C) { const int st = b / 1024, sb = b % 1024, swz = sb ^ (((sb >> 9) & 1) << 5); R = (st >> 1) * 16 + swz / 64; C = (st & 1) * 32 + (swz % 64) / 2; }
__host__ __device__ __forceinline__ int perm32(int rho) { const int n = rho >> 4, i = rho & 15; return 8 * (i >> 2) + 4 * n + (i & 3); }
struct Unit { int pm, pn, part; };
constexpr int ROWTAB_OFF = STAGE_BYTES;
struct StaticOrder {
    int nM, nN, nwg, G, c, lmode = 0, lbase = 0, lpn = 0, lcount = 0;
    __device__ void init(int nM_, int nN_, int G_, int c_) { nM = nM_; nN = nN_; nwg = nM * nN; G = G_; c = c_; lmode = 0; }
    __device__ void init_run(int base, int pn, int count) { lmode = 1; lbase = base; lpn = pn; lcount = count; nM = 0; nN = 0; nwg = 0; G = 1; c = 0; }
    __device__ bool next(int i, Unit& u) const {
        if (lmode == 1) { if (i >= lcount) return false; u.pm = lbase + i; u.pn = lpn; return true; }
        const long L = (long)i * G + c; if (L >= nwg) return false;
        int wgid = (int)L; { const int q = nwg / NXCD, r = nwg % NXCD, xcd = wgid % NXCD, off = wgid / NXCD; wgid = (xcd < r ? xcd * (q + 1) : r * (q + 1) + (xcd - r) * q) + off; }
        const int nig = WGM * nN, gid = wgid / nig, fm = gid * WGM, gsz = (nM - fm) < WGM ? (nM - fm) : WGM;
        u.pm = fm + ((wgid % nig) % gsz); u.pn = (wgid % nig) / gsz; return true;
    }
};

template <class Epi, class Addr, bool ALIGN_EPI, bool FP8 = false>
__device__ __forceinline__ void gemm_phase(LAS unsigned char* lds, const Addr& g, const StaticOrder& S, const Epi& E, int tid) {
    asm volatile("" : "+v"(tid));
    const int wid = __builtin_amdgcn_readfirstlane(tid >> 6), lane = tid & 63, wr = wid >> 2, wc = wid & 3, fr = lane & 15, fq = lane >> 4;
    const int K = g.K(), nt0 = K / BK;
    unsigned voffA[2], voffB[2];
#pragma unroll
    for (int i = 0; i < 2; ++i) { int R, C; stage_rc(tid * 16 + i * 8192, R, C); const int Rb = Epi::PERM ? ((R & ~31) + perm32(R & 31)) : R;
        voffA[i] = (unsigned)R * g.a_row_bytes() + g.a_col_off(C); voffB[i] = (unsigned)(Rb * K + C) * 2u; }
    const size_t kstepA = g.a_kstep(), kstepB = (size_t)(BK * 2);
    const size_t hstepA = (size_t)HALF * g.a_row_bytes(), hstepB = (size_t)HALF * K * 2;
    const unsigned ldsw = (unsigned)wid * 1024u;
    const int aoff = lds_byte(wr * 64 + fr, fq * 8), boff = lds_byte(wc * 32 + fr, fq * 8);
#define PG8_SA(b, h) (((b) * 2 + (h)) * HTB)
#define PG8_SB(b, h) ((4 + (b) * 2 + (h)) * HTB)
#define PG8_STAGE(bufoff, gbase, voff) do { _Pragma("unroll") for (int _i = 0; _i < 2; ++_i) \
        __builtin_amdgcn_global_load_lds((const unsigned*)((const char*)(gbase) + (voff)[_i]), (LAS unsigned*)(lds + (bufoff) + ldsw + _i * 8192), 16, 0, 0); } while (0)
#define PG8_LDA(dst, b, h) do { _Pragma("unroll") for (int m = 0; m < 4; ++m) _Pragma("unroll") for (int k = 0; k < 2; ++k) dst[m][k] = *(const LAS bf16x8*)(lds + PG8_SA(b, h) + aoff + m * 2048 + k * 1024); } while (0)
#define PG8_LDB(dst, b, h) do { _Pragma("unroll") for (int n = 0; n < 2; ++n) _Pragma("unroll") for (int k = 0; k < 2; ++k) dst[n][k] = *(const LAS bf16x8*)(lds + PG8_SB(b, h) + boff + n * 2048 + k * 1024); } while (0)
#define PG8_CAT(x, y) __builtin_bit_cast(i32x8, __builtin_shufflevector((x), (y), 0, 1, 2, 3, 4, 5, 6, 7, 8, 9, 10, 11, 12, 13, 14, 15))
#define PG8_MMA(ai, bj, At, Bt) do { __builtin_amdgcn_s_setprio(1); _Pragma("unroll") for (int m = 0; m < 4; ++m) _Pragma("unroll") for (int n = 0; n < 2; ++n) { \
        if constexpr (FP8) { const i32x8 bw_ = PG8_CAT(Bt[n][0], Bt[n][1]), aw_ = PG8_CAT(At[m][0], At[m][1]); \
            asm volatile("v_mfma_f32_16x16x128_f8f6f4 %0, %1, %2, %0" : "+v"(acc[ai][bj][m][n]) : "v"(bw_), "v"(aw_));   } \
        else { _Pragma("unroll") for (int k = 0; k < 2; ++k) acc[ai][bj][m][n] = __builtin_amdgcn_mfma_f32_16x16x32_bf16(Bt[n][k], At[m][k], acc[ai][bj][m][n], 0, 0, 0); } } \
        __builtin_amdgcn_s_setprio(0); } while (0)
#define PG8_WAIT_V(n) asm volatile("s_waitcnt vmcnt(" #n ")" ::: "memory")
#define PG8_WAIT_L(n) asm volatile("s_waitcnt lgkmcnt(" #n ")" ::: "memory")
#define PG8_BAR __builtin_amdgcn_s_barrier()
#define PG8_SCHED __builtin_amdgcn_sched_barrier(0)
    Unit cur, nxt; int ui = 0;
    constexpr bool SPLIT = Epi::MID_T > 0;
    auto get_unit = [&](int i, Unit& u) -> bool { if constexpr (SPLIT) { const bool ok = S.next(i >> 1, u); u.part = i & 1; return ok; } else { const bool ok = S.next(i, u); u.part = 0; return ok; } };
    auto part_off = [&](const Unit& u) -> size_t { if constexpr (SPLIT) return (size_t)u.part * (Epi::MID_T * BK * 2); else return 0; };
    if (!get_unit(0, cur)) return;
    f32x4 acc[2][2][4][2];
#pragma unroll
    for (int a = 0; a < 2; ++a)
#pragma unroll
        for (int b = 0; b < 2; ++b)
#pragma unroll
            for (int m = 0; m < 4; ++m)
#pragma unroll
                for (int n = 0; n < 2; ++n) acc[a][b][m][n] = (f32x4){0.f, 0.f, 0.f, 0.f};
    bf16x8 At[4][2], B0[2][2], B1[2][2];
    const char* cA = g.a_base(cur) + part_off(cur); const char* cB = g.b_base(cur) + part_off(cur);
    PG8_STAGE(PG8_SB(0, 0), cB, voffB); PG8_STAGE(PG8_SB(0, 1), cB + hstepB, voffB); PG8_STAGE(PG8_SA(0, 0), cA, voffA); PG8_STAGE(PG8_SA(0, 1), cA + hstepA, voffA);
    if (wr == 1) PG8_BAR;
    PG8_WAIT_V(2); PG8_BAR;
    PG8_STAGE(PG8_SB(1, 0), cB + kstepB, voffB); PG8_STAGE(PG8_SA(1, 0), cA + kstepA, voffA); PG8_STAGE(PG8_SB(1, 1), cB + hstepB + kstepB, voffB);
    PG8_WAIT_V(6); PG8_BAR;
    for (;;) {
        const bool has_next = get_unit(ui + 1, nxt);
        const char* nA = has_next ? g.a_base(nxt) + part_off(nxt) : cA; const char* nB = has_next ? g.b_base(nxt) + part_off(nxt) : cB;
        int nt = nt0; if constexpr (SPLIT) nt = cur.part ? nt0 - Epi::MID_T : Epi::MID_T;
        for (int t = 0; t < nt; t += 2) {
            const bool last = (t == nt - 2);
            if constexpr (Epi::ROWTAB) {
                if (t == 0 && wid < 4 && cur.part == 0) {
                    int l_; asm volatile("v_mbcnt_lo_u32_b32 %0, -1, 0\n\tv_mbcnt_hi_u32_b32 %0, -1, %0" : "=v"(l_));
                    __builtin_amdgcn_global_load_lds((const unsigned*)(E.rowtab + ((size_t)cur.pm * BM + wid * 64 + l_) * 2), (LAS unsigned*)(lds + ROWTAB_OFF + ((SPLIT ? (ui >> 1) : ui) & 1) * 4096 + wid * 1024), 16, 0, 0); } }
            const char* a1 = cA + (size_t)(t + 1) * kstepA;
            const char* a2 = last ? nA : cA + (size_t)(t + 2) * kstepA; const char* b2 = last ? nB : cB + (size_t)(t + 2) * kstepB;
            const char* a3 = a2 + kstepA; const char* b3 = b2 + kstepB;
            PG8_LDB(B0, 0, 0); PG8_LDB(B1, 0, 1); PG8_SCHED; PG8_LDA(At, 0, 0); PG8_STAGE(PG8_SA(1, 1), a1 + hstepA, voffA);
            PG8_WAIT_V(8); PG8_WAIT_L(0); PG8_BAR; PG8_MMA(0, 0, At, B0); PG8_MMA(0, 1, At, B1); PG8_BAR; PG8_SCHED;
            PG8_LDA(At, 0, 1); PG8_STAGE(PG8_SB(0, 0), b2, voffB); PG8_STAGE(PG8_SB(0, 1), b2 + hstepB, voffB); PG8_STAGE(PG8_SA(0, 0), a2, voffA);
            PG8_WAIT_V(8); PG8_WAIT_L(0); PG8_BAR; PG8_MMA(1, 0, At, B0); PG8_MMA(1, 1, At, B1); PG8_BAR; PG8_SCHED;
            PG8_LDB(B0, 1, 0); PG8_LDB(B1, 1, 1); PG8_SCHED; PG8_LDA(At, 1, 0); PG8_STAGE(PG8_SA(0, 1), a2 + hstepA, voffA);
            PG8_WAIT_V(8); PG8_WAIT_L(0); PG8_BAR; PG8_MMA(0, 0, At, B0); PG8_MMA(0, 1, At, B1); PG8_BAR; PG8_SCHED;
            PG8_LDA(At, 1, 1); PG8_STAGE(PG8_SB(1, 0), b3, voffB); PG8_STAGE(PG8_SB(1, 1), b3 + hstepB, voffB); PG8_STAGE(PG8_SA(1, 0), a3, voffA);
            PG8_WAIT_V(8); PG8_WAIT_L(0); PG8_BAR; PG8_MMA(1, 0, At, B0); PG8_MMA(1, 1, At, B1); PG8_BAR; PG8_SCHED;
        }
        if constexpr (ALIGN_EPI) { if (wr == 0) PG8_BAR; }
        if constexpr (FP8) asm volatile("s_nop 15\n\ts_nop 15" ::: "memory");
        { int le_; asm volatile("v_mbcnt_lo_u32_b32 %0, -1, 0\n\tv_mbcnt_hi_u32_b32 %0, -1, %0" : "=v"(le_)); const int fr_e = le_ & 15, fq_e = le_ >> 4;
          if constexpr (Epi::ROWTAB) {
              const LAS unsigned long long* tab = (const LAS unsigned long long*)(lds + ROWTAB_OFF + ((SPLIT ? (ui >> 1) : ui) & 1) * 4096);
              if (SPLIT && cur.part == 0) {
                  const LAS unsigned long long* tb = tab + (wr * 64 + fr_e) * 2;
#pragma unroll
                  for (int a = 0; a < 2; ++a)
#pragma unroll
                      for (int m = 0; m < 4; ++m) { const float ratio = Epi::row_ratio(tb[(a * HALF + m * 16) * 2], tb[(a * HALF + m * 16) * 2 + 1]);
#pragma unroll
                          for (int b = 0; b < 2; ++b)
#pragma unroll
                              for (int n = 0; n < 2; ++n) acc[a][b][m][n] = acc[a][b][m][n] * ratio; }
              } else E(acc, cur, wr, wc, fr_e, fq_e, tab);
          } else E(acc, cur, wr, wc, fr_e, fq_e); }
        if (!has_next) break;
        if (!SPLIT || cur.part != 0) {
#pragma unroll
        for (int a = 0; a < 2; ++a)
#pragma unroll
            for (int b = 0; b < 2; ++b)
#pragma unroll
                for (int m = 0; m < 4; ++m)
#pragma unroll
                    for (int n = 0; n < 2; ++n) acc[a][b][m][n] = (f32x4){0.f, 0.f, 0.f, 0.f};
        }
        cur = nxt; cA = nA; cB = nB; ++ui;
        if constexpr (ALIGN_EPI) { if (wr == 1) PG8_BAR; }
    }
    PG8_WAIT_V(0);
    if constexpr (!ALIGN_EPI) { if (wr == 0) PG8_BAR; }
    PG8_BAR;
#undef PG8_SA
#undef PG8_SB
#undef PG8_STAGE
#undef PG8_LDA
#undef PG8_LDB
#undef PG8_MMA
#undef PG8_CAT
#undef PG8_WAIT_V
#undef PG8_WAIT_L
#undef PG8_BAR
#undef PG8_SCHED
}

struct APlain {
    const char* A; const char* Bt; int k; int sw = 0x7f7f7f7f, sa = 0x7f7f7f7f;
    DI int scale_w() const { return sw; } DI int scale_a() const { return sa; }
    DI int K() const { return k; }
    DI unsigned a_row_bytes() const { return (unsigned)k * 2u; }
    DI unsigned a_kstep() const { return 128u; }
    DI unsigned a_col_off(int C) const { return (unsigned)C * 2u; }
    DI const char* a_base(const Unit& u) const { return A + (size_t)u.pm * 256 * k * 2; }
    DI const char* b_base(const Unit& u) const { return Bt + (size_t)u.pn * 256 * k * 2; }
};
struct ACompress {
    const char* proj; const char* w1t;
    DI int scale_w() const { return 0x7f7f7f7f; } DI int scale_a() const { return 0x7f7f7f7f; }
    DI int K() const { return 2048; }
    DI unsigned a_row_bytes() const { return 16u * PW * 2u; }
    DI unsigned a_kstep() const { return (unsigned)PW * 2u; }
    DI unsigned a_col_off(int C) const { return (unsigned)C * 2u; }
    DI const char* a_base(const Unit& u) const { const int kv = u.pm / 24, r = u.pm % 24, bh = r >> 2, qt = r & 3, b = bh / 3, h = bh % 3;
        return proj + ((size_t)(b * SEQ + 4096 * qt) * PW + (kv ? C_VC : C_KC) + h * 64) * 2; }
    DI const char* b_base(const Unit& u) const { return w1t + (size_t)(u.pm / 24) * 256 * 2048 * 2; }
};
struct ASsm1 {
    const char* uc; const char* ss1;
    DI int scale_w() const { return 0x7f7f7f7f; } DI int scale_a() const { return 0x7f7f7f7f; }
    DI int K() const { return 256; }
    DI unsigned a_row_bytes() const { return 512u; }
    DI unsigned a_kstep() const { return 128u; }
    DI unsigned a_col_off(int C) const { return (unsigned)C * 2u; }
    DI const char* a_base(const Unit& u) const { const int bg = u.pm >> 2, qt = u.pm & 3; return uc + ((size_t)bg * SEQ + 4096 * qt) * 32; }
    DI const char* b_base(const Unit& u) const { const int gi = (u.pm >> 2) & 15; return ss1 + ((size_t)gi * 512 + (size_t)u.pn * 256) * 256 * 2; }
};
struct ASsm2 {
    const char* hin; const char* ss2;
    DI int scale_w() const { return 0x7f7f7f7f; } DI int scale_a() const { return 0x7f7f7f7f; }
    DI int K() const { return 256; }
    DI unsigned a_row_bytes() const { return 512u; }
    DI unsigned a_kstep() const { return 128u; }
    DI unsigned a_col_off(int C) const { return (unsigned)C * 2u; }
    DI const char* a_base(const Unit& u) const { return hin + (size_t)u.pm * 256 * 512; }
    DI const char* b_base(const Unit& u) const { const int gi = (u.pm >> 2) & 15; return ss2 + (size_t)gi * 256 * 256 * 2; }
};

struct EpiBf16 {
    static constexpr bool PERM = true; static constexpr bool ROWTAB = true; static constexpr int MID_T = -1;
    bf16_t* O; int ldc; const unsigned long long* rowtab;
    static DI float row_ratio(unsigned long long, unsigned long long) { return 1.f; }
    DI void operator()(const f32x4 (&acc)[2][2][4][2], const Unit& u, int wr, int wc, int fr, int fq, const LAS unsigned long long* tab) const {
        const int row0 = u.pm * BM + wr * 64 + fr, col0 = u.pn * BM + wc * 32 + 8 * fq;
        const int ubj = (u.pn == C_U / 256) ? 1 : ((u.pn == C_U / 256 + 1) ? 0 : -1);
#pragma unroll
        for (int ai = 0; ai < 2; ++ai)
#pragma unroll
            for (int m = 0; m < 4; ++m) { bf16_t* rowp = O + (size_t)(row0 + ai * HALF + m * 16) * ldc + col0;
                const float sc = rsqrtf((float)tab[(wr * 64 + fr + ai * HALF + m * 16) * 2] * (1.f / (1048576.f * DM)) + 1e-6f);
#pragma unroll
                for (int bj = 0; bj < 2; ++bj) { const f32x4 v0 = acc[ai][bj][m][0] * sc, v1 = acc[ai][bj][m][1] * sc;
                    u32x4 w; w.x = pk2(v0[0], v0[1]); w.y = pk2(v0[2], v0[3]); w.z = pk2(v1[0], v1[1]); w.w = pk2(v1[2], v1[3]);
                    *(u32x4*)(rowp + bj * HALF) = w;
                    if (bj == ubj) { const int row = row0 + ai * HALF + m * 16, ucol = col0 + bj * HALF - C_U;
                        bf16_t* uc = (bf16_t*)((unsigned char*)O + (WS_UC - WS_PROJ));
                        *(u32x4*)(uc + (((size_t)((row >> 14) * 16 + (ucol >> 4)) * SEQ + (row & (SEQ - 1))) * 16 + (ucol & 15))) = w; } } }
    }
};
struct EpiCmpHid {
    static constexpr bool PERM = true; static constexpr bool ROWTAB = false; static constexpr int MID_T = -1;
    bf16_t* O; const float* cb1;
    DI void operator()(const f32x4 (&acc)[2][2][4][2], const Unit& u, int wr, int wc, int fr, int fq) const {
        const int row0 = u.pm * BM + wr * 64 + fr, col0 = wc * 32 + 8 * fq; const float* bb = cb1 + (u.pm / 24) * 256;
        f32x4 bv[2][2];
#pragma unroll
        for (int bj = 0; bj < 2; ++bj)
#pragma unroll
            for (int n = 0; n < 2; ++n) bv[bj][n] = *(const f32x4*)(bb + col0 + bj * HALF + 4 * n);
#pragma unroll
        for (int ai = 0; ai < 2; ++ai)
#pragma unroll
            for (int m = 0; m < 4; ++m) { bf16_t* rowp = O + (size_t)(row0 + ai * HALF + m * 16) * 256 + col0;
#pragma unroll
                for (int bj = 0; bj < 2; ++bj) { f32x4 v0 = acc[ai][bj][m][0] + bv[bj][0], v1 = acc[ai][bj][m][1] + bv[bj][1];
#pragma unroll
                    for (int e = 0; e < 4; ++e) { v0[e] = gelu_tanh(v0[e]); v1[e] = gelu_tanh(v1[e]); }
                    u32x4 w; w.x = pk2(v0[0], v0[1]); w.y = pk2(v0[2], v0[3]); w.z = pk2(v1[0], v1[1]); w.w = pk2(v1[2], v1[3]);
                    *(u32x4*)(rowp + bj * HALF) = w; } }
    }
};
struct EpiSsm1 {
    static constexpr bool PERM = false; static constexpr bool ROWTAB = false; static constexpr int MID_T = -1;
    float* YI; float* HL;
    DI void operator()(const f32x4 (&acc)[2][2][4][2], const Unit& u, int wr, int wc, int fr, int fq) const {
        const int row0 = u.pm * BM + wr * 64 + fr, col0 = wc * 32 + 4 * fq;
#pragma unroll
        for (int ai = 0; ai < 2; ++ai)
#pragma unroll
            for (int m = 0; m < 4; ++m) { const size_t row = (size_t)(row0 + ai * HALF + m * 16);
                if (u.pn == 0) {
#pragma unroll
                    for (int bj = 0; bj < 2; ++bj)
#pragma unroll
                        for (int n = 0; n < 2; ++n) *(f32x4*)(YI + row * 256 + col0 + bj * HALF + n * 16) = acc[ai][bj][m][n];
                } else {
#pragma unroll
                    for (int n = 0; n < 2; ++n) *(f32x4*)(HL + row * 128 + col0 + n * 16) = acc[ai][0][m][n];
                } }
    }
};
struct EpiSsm2 {
    static constexpr bool PERM = false; static constexpr bool ROWTAB = false; static constexpr int MID_T = -1;
    const float* YI; const bf16_t* proj; const float* dskip; bf16_t* YS2;
    DI void operator()(const f32x4 (&acc)[2][2][4][2], const Unit& u, int wr, int wc, int fr, int fq) const {
        const int row0 = u.pm * BM + wr * 64 + fr, col0 = wc * 32 + 4 * fq;
        const int bg = u.pm >> 2, b = bg >> 4, gi = bg & 15;
        const f32x4 dsk = *(const f32x4*)(dskip + gi * 16 + 4 * fq);
#pragma unroll
        for (int ai = 0; ai < 2; ++ai)
#pragma unroll
            for (int m = 0; m < 4; ++m) { const int row = row0 + ai * HALF + m * 16; const int chunk = row & 1023;
#pragma unroll
                for (int bj = 0; bj < 2; ++bj)
#pragma unroll
                    for (int n = 0; n < 2; ++n) { const int col = col0 + bj * HALF + n * 16, tau = col >> 4;
                        const size_t tok = (size_t)b * SEQ + chunk * 16 + tau;
                        const f32x4 yi = *(const f32x4*)(YI + (size_t)row * 256 + col);
                        const u32x2 uw = *(const u32x2*)(proj + tok * PW + C_U + gi * 16 + 4 * fq);
                        f32x4 y = acc[ai][bj][m][n] + yi;
                        y[0] += dsk[0] * bflo(uw.x); y[1] += dsk[1] * bfhi(uw.x); y[2] += dsk[2] * bflo(uw.y); y[3] += dsk[3] * bfhi(uw.y);
                        u32x2 w; w.x = pk2(gelu_tanh(y[0]), gelu_tanh(y[1])); w.y = pk2(gelu_tanh(y[2]), gelu_tanh(y[3]));
                        *(u32x2*)(YS2 + tok * 256 + gi * 16 + 4 * fq) = w; } }
    }
};
struct EpiGlu {
    static constexpr bool PERM = true; static constexpr bool ROWTAB = false; static constexpr int MID_T = -1;
    bf16_t* O; const float* bglu; unsigned long long* sst;
    DI void operator()(const f32x4 (&acc)[2][2][4][2], const Unit& u, int wr, int wc, int fr, int fq) const {
        const int row0 = u.pm * BM + wr * 64 + fr, col0 = u.pn * HALF + wc * 32 + 8 * fq;
        f32x4 bvv[2], bgg[2];
#pragma unroll
        for (int n = 0; n < 2; ++n) { bvv[n] = *(const f32x4*)(bglu + col0 + 4 * n); bgg[n] = *(const f32x4*)(bglu + 256 + col0 + 4 * n); }
#pragma unroll
        for (int ai = 0; ai < 2; ++ai)
#pragma unroll
            for (int m = 0; m < 4; ++m) { const int row = row0 + ai * HALF + m * 16; bf16_t* rowp = O + (size_t)row * 1024 + 768 + col0;
                f32x4 o[2];
#pragma unroll
                for (int n = 0; n < 2; ++n) { const f32x4 v = acc[ai][0][m][n] + bvv[n], gt = acc[ai][1][m][n] + bgg[n];
#pragma unroll
                    for (int e = 0; e < 4; ++e) o[n][e] = v[e] * sigmoidf_(gt[e]); }
                u32x4 w; w.x = pk2(o[0][0], o[0][1]); w.y = pk2(o[0][2], o[0][3]); w.z = pk2(o[1][0], o[1][1]); w.w = pk2(o[1][2], o[1][3]);
                *(u32x4*)rowp = w;
                const f32x4 q = o[0] * o[0] + o[1] * o[1]; const float t = xor32_sum(xor16_sum((q[0] + q[1]) + (q[2] + q[3])));
                if (fq == 0) (void)__hip_atomic_fetch_add(sst + (size_t)row * 2 + 1, (unsigned long long)(t * 16777216.f), __ATOMIC_RELAXED, __HIP_MEMORY_SCOPE_AGENT); }
    }
};
struct EpiSwiglu8 {
    static constexpr bool PERM = true; static constexpr bool ROWTAB = false; static constexpr int MID_T = -1;
    unsigned char* O; float asc;
    DI void operator()(const f32x4 (&acc)[2][2][4][2], const Unit& u, int wr, int wc, int fr, int fq) const {
        const int row0 = u.pm * BM + wr * 64 + fr, col0 = u.pn * HALF + wc * 32 + 8 * fq;
#pragma unroll
        for (int ai = 0; ai < 2; ++ai)
#pragma unroll
            for (int m = 0; m < 4; ++m) { unsigned char* rowp = O + (size_t)(row0 + ai * HALF + m * 16) * DFF + col0;
                f32x4 o[2];
#pragma unroll
                for (int n = 0; n < 2; ++n) { const f32x4 gt = acc[ai][0][m][n] * asc, up = acc[ai][1][m][n] * asc;
#pragma unroll
                    for (int e = 0; e < 4; ++e) o[n][e] = 4.0f * gt[e] * sigmoidf_(gt[e]) * up[e]; }
                u32x2 w; w.x = pk4_fp8(o[0][0], o[0][1], o[0][2], o[0][3]); w.y = pk4_fp8(o[1][0], o[1][1], o[1][2], o[1][3]);
                *(u32x2*)rowp = w; }
    }
};
struct EpiSwiglu {
    static constexpr bool PERM = true; static constexpr bool ROWTAB = false; static constexpr int MID_T = -1;
    bf16_t* O;
    DI void operator()(const f32x4 (&acc)[2][2][4][2], const Unit& u, int wr, int wc, int fr, int fq) const {
        const int row0 = u.pm * BM + wr * 64 + fr, col0 = u.pn * HALF + wc * 32 + 8 * fq;
#pragma unroll
        for (int ai = 0; ai < 2; ++ai)
#pragma unroll
            for (int m = 0; m < 4; ++m) { bf16_t* rowp = O + (size_t)(row0 + ai * HALF + m * 16) * DFF + col0;
                f32x4 o[2];
#pragma unroll
                for (int n = 0; n < 2; ++n) { const f32x4 gt = acc[ai][0][m][n], up = acc[ai][1][m][n];
#pragma unroll
                    for (int e = 0; e < 4; ++e) o[n][e] = gt[e] * sigmoidf_(gt[e]) * up[e]; }
                u32x4 w; w.x = pk2(o[0][0], o[0][1]); w.y = pk2(o[0][2], o[0][3]); w.z = pk2(o[1][0], o[1][1]); w.w = pk2(o[1][2], o[1][3]);
                *(u32x4*)rowp = w; }
    }
};
struct EpiResF32 {
    static constexpr bool PERM = false; static constexpr bool ROWTAB = false; static constexpr int MID_T = -1;
    const float* base; float* out; float asc = 1.0f;
    DI void operator()(const f32x4 (&acc)[2][2][4][2], const Unit& u, int wr, int wc, int fr, int fq) const {
        const int row0 = u.pm * BM + wr * 64 + fr, col0 = u.pn * BM + wc * 32 + 4 * fq;
#pragma unroll
        for (int ai = 0; ai < 2; ++ai)
#pragma unroll
            for (int m = 0; m < 4; ++m) { const size_t off = (size_t)(row0 + ai * HALF + m * 16) * DM + col0;
#pragma unroll
                for (int bj = 0; bj < 2; ++bj)
#pragma unroll
                    for (int n = 0; n < 2; ++n) { const f32x4 bs = *(const f32x4*)(base + off + bj * HALF + n * 16);
                        *(f32x4*)(out + off + bj * HALF + n * 16) = bs + acc[ai][bj][m][n] * asc; } }
    }
};
template <bool MID, int ASC_EXP>
struct EpiResB {
    static constexpr bool PERM = true; static constexpr bool ROWTAB = MID; static constexpr int MID_T = MID ? 12 : -1;
    static constexpr float asc = 1.0f / (float)(1 << ASC_EXP);
    const float* basef; const bf16_t* baseb; bf16_t* out; const unsigned long long* rowtab; unsigned long long* ssx;
    static DI float rstd_a(unsigned long long v) { return rsqrtf((float)v * (1.f / (16777216.f * 768.f)) + 1e-6f); }
    static DI float rstd_s(unsigned long long v) { return rsqrtf((float)v * (1.f / (16777216.f * 256.f)) + 1e-6f); }
    static DI float row_ratio(unsigned long long a, unsigned long long s_) { return rstd_a(a) / rstd_s(s_); }
    template <bool F32B>
    DI void run(const f32x4 (&acc)[2][2][4][2], const Unit& u, int wr, int wc, int fr, int fq, const LAS unsigned long long* tab) const {
        const int row0 = u.pm * BM + wr * 64 + fr, col0 = u.pn * BM + wc * 32 + 8 * fq;
#pragma unroll
        for (int ai = 0; ai < 2; ++ai)
#pragma unroll
            for (int m = 0; m < 4; ++m) { const int row = row0 + ai * HALF + m * 16; const size_t off = (size_t)row * DM + col0; float sq = 0.f;
                float sc = asc; if constexpr (MID) sc = asc * rstd_s(tab[(wr * 64 + fr + ai * HALF + m * 16) * 2 + 1]);
#pragma unroll
                for (int bj = 0; bj < 2; ++bj) { f32x4 b0, b1;
                    if constexpr (F32B) { b0 = *(const f32x4*)(basef + off + bj * HALF); b1 = *(const f32x4*)(basef + off + bj * HALF + 4); }
                    else { const u32x4 b = *(const u32x4*)(baseb + off + bj * HALF); b0 = f32x4{bflo(b.x), bfhi(b.x), bflo(b.y), bfhi(b.y)}; b1 = f32x4{bflo(b.z), bfhi(b.z), bflo(b.w), bfhi(b.w)}; }
                    const f32x4 v0 = b0 + acc[ai][bj][m][0] * sc, v1 = b1 + acc[ai][bj][m][1] * sc;
                    u32x4 w; w.x = pk2(v0[0], v0[1]); w.y = pk2(v0[2], v0[3]); w.z = pk2(v1[0], v1[1]); w.w = pk2(v1[2], v1[3]);
                    *(u32x4*)(out + off + bj * HALF) = w;
                    if constexpr (!MID) { const f32x4 q = v0 * v0 + v1 * v1; sq += (q[0] + q[1]) + (q[2] + q[3]); } }
                if constexpr (!MID) { if (ssx != nullptr) { const float t = xor32_sum(xor16_sum(sq));
                    if (fq == 0) (void)__hip_atomic_fetch_add(ssx + (size_t)row * 2, (unsigned long long)(t * 1048576.f), __ATOMIC_RELAXED, __HIP_MEMORY_SCOPE_AGENT); } } }
    }
    DI void operator()(const f32x4 (&acc)[2][2][4][2], const Unit& u, int wr, int wc, int fr, int fq, const LAS unsigned long long* tab = nullptr) const {
        if (basef != nullptr) run<true>(acc, u, wr, wc, fr, fq, tab); else run<false>(acc, u, wr, wc, fr, fq, tab);
    }
};
}

struct Frame {
    LAS unsigned char* lds;
    LAS const unsigned long long* pt;
    int tid, lane, wave, G, gw, ngw, bid;
    DI const float* in(int i) const { const unsigned long long v = pt[i]; const unsigned lo = __builtin_amdgcn_readfirstlane((unsigned)v), hi = __builtin_amdgcn_readfirstlane((unsigned)(v >> 32));
        return (const float*)(const __attribute__((address_space(1))) float*)(((unsigned long long)hi << 32) | lo); }
    DI float* out() const { return (float*)in(26); }
    DI unsigned char* wsp() const { return (unsigned char*)in(27); }
};
constexpr int LDS_PT = LDS_BYTES - 256;

DI void transpose_item(const float* W, int K, int ldw, int nvalid, bf16_t* WT, int drow0, LAS float* scr, int k0, int n0, float scale, int lane, const float* gam64 = nullptr) {
    if (n0 + 32 <= nvalid) {
        const int n4 = (lane & 7) * 4; f32x4 v[8];
#pragma unroll
        for (int i = 0; i < 8; ++i) v[i] = *(const f32x4*)(W + (size_t)(k0 + 8 * i + (lane >> 3)) * ldw + n0 + n4);
        if (gam64 != nullptr) {
#pragma unroll
            for (int i = 0; i < 8; ++i) v[i] = v[i] * gam64[8 * i + (lane >> 3)];
        }
#pragma unroll
        for (int i = 0; i < 8; ++i) { LAS float* s = scr + (8 * i + (lane >> 3)) * 33 + n4; s[0] = v[i].x * scale; s[1] = v[i].y * scale; s[2] = v[i].z * scale; s[3] = v[i].w * scale; }
    } else {
    const int nn = n0 + (lane & 31); const bool ok = nn < nvalid;
#pragma unroll 8
    for (int i = 0; i < 32; ++i) { const int kk = 2 * i + (lane >> 5); scr[kk * 33 + (lane & 31)] = ok ? W[(size_t)(k0 + kk) * ldw + nn] * scale : 0.f; }
    }
    asm volatile("s_waitcnt lgkmcnt(0)" ::: "memory");
    const int c = lane & 7;
#pragma unroll
    for (int j = 0; j < 4; ++j) { const int n = (lane >> 3) + 8 * j; const LAS float* s = scr + (8 * c) * 33 + n;
        u32x4 o; o.x = pk2(s[0 * 33], s[1 * 33]); o.y = pk2(s[2 * 33], s[3 * 33]); o.z = pk2(s[4 * 33], s[5 * 33]); o.w = pk2(s[6 * 33], s[7 * 33]);
        *(u32x4*)(WT + (size_t)(drow0 + n) * K + k0 + 8 * c) = o; }
    asm volatile("s_waitcnt lgkmcnt(0)" ::: "memory");
}

DI void transpose_item_fp8(const float* W, int K, int ldw, unsigned char* WT, int drow0, LAS float* scr, int k0, int n0, float scale, int lane) {
    const int n4 = (lane & 7) * 4; f32x4 v[8];
#pragma unroll
    for (int i = 0; i < 8; ++i) v[i] = *(const f32x4*)(W + (size_t)(k0 + 8 * i + (lane >> 3)) * ldw + n0 + n4);
#pragma unroll
    for (int i = 0; i < 8; ++i) { LAS float* s = scr + (8 * i + (lane >> 3)) * 33 + n4; s[0] = v[i].x * scale; s[1] = v[i].y * scale; s[2] = v[i].z * scale; s[3] = v[i].w * scale; }
    asm volatile("s_waitcnt lgkmcnt(0)" ::: "memory");
    const int c = lane & 7;
#pragma unroll
    for (int j = 0; j < 4; ++j) { const int n = (lane >> 3) + 8 * j; const LAS float* s = scr + (8 * c) * 33 + n;
        u32x2 o; o.x = pk4_fp8(s[0 * 33], s[1 * 33], s[2 * 33], s[3 * 33]); o.y = pk4_fp8(s[4 * 33], s[5 * 33], s[6 * 33], s[7 * 33]);
        *(u32x2*)(WT + (size_t)(drow0 + n) * K + k0 + 8 * c) = o; }
    asm volatile("s_waitcnt lgkmcnt(0)" ::: "memory");
}

DI int win_dest_row(int n) {
    if (n < 1920) return n;
    if (n < 1956) return C_G + (n - 1920);
    return C_U + (n - 1956);
}

DI void prologue_a(Frame& F, int mode, int gw0, int ngw0) {
    LAS float* scr = (LAS float*)(F.lds + F.wave * 16640);
    constexpr int I_WIN = 16 * 72, I_WOUT = 16 * 32, I_WG = 16 * 88, I_WD = 44 * 32, I_W1 = 2 * 32 * 8, I_WGLU = 4 * 16, I_W2 = 2 * 4 * 2, I_CB = 64, I_M = 1024, I_TAB = 16;
    constexpr int PER_L = I_WIN + I_WOUT + 2 * I_WG + I_WD + I_W1 + I_WGLU + I_W2 + I_CB + I_M + I_TAB;
    const int lane = F.lane;
    constexpr int A1 = I_WIN, A3E = I_WIN + I_WOUT + 2 * I_WG + I_WD, A4E = A3E + I_W1, A5E = A4E + I_WGLU;
    for (int it = gw0; it < NL * PER_L; it += ngw0) {
        const int l = it / PER_L; int r = it % PER_L;
        { const bool late = (r >= A1 && r < A3E) || (r >= A4E && r < A5E) || (l > 0 && (r < A1 || (r >= A3E && r < A4E)));
          if (late != (mode == 1)) continue; }
        unsigned char* wl = F.wsp() + WS_W + (size_t)l * WL_STRIDE;
        unsigned char* ms = F.wsp() + WS_MISC + (size_t)l * MS_L;
        unsigned char* ct = F.wsp() + WS_CTL + CT_BASE + (size_t)l * CT_L;
        if (r < I_WIN) {
            const int kb = r / 72, nb = r % 72, k0 = 64 * kb, n0 = 32 * nb;
            const float* W = F.in(2) + (size_t)l * 1024 * 2212;
            bf16_t* WT = (bf16_t*)(wl + WO_WIN);
            const float* gam = F.in(1) + (size_t)l * DM + k0;
            if (n0 + 32 <= 1920) { transpose_item(W, 1024, 2212, 2212, WT, n0, scr, k0, n0, n0 < 768 ? 0.125f * L2E : 1.0f, lane, gam); }
            else {
                const int d = n0 + (lane & 31);
                int srcn = -1;
                if (d < 1920) srcn = d; else if (d >= C_U && d < C_U + 256) srcn = 1956 + (d - C_U); else if (d >= C_G && d < C_G + 36) srcn = 1920 + (d - C_G);
#pragma unroll 8
                for (int i = 0; i < 32; ++i) { const int kk = 2 * i + (lane >> 5); scr[kk * 33 + (lane & 31)] = srcn >= 0 ? W[(size_t)(k0 + kk) * 2212 + srcn] * gam[kk] : 0.f; }
                asm volatile("s_waitcnt lgkmcnt(0)" ::: "memory");
                const int c = lane & 7;
#pragma unroll
                for (int j = 0; j < 4; ++j) { const int n = (lane >> 3) + 8 * j; const LAS float* s = scr + (8 * c) * 33 + n;
                    u32x4 o; o.x = pk2(s[0 * 33], s[1 * 33]); o.y = pk2(s[2 * 33], s[3 * 33]); o.z = pk2(s[4 * 33], s[5 * 33]); o.w = pk2(s[6 * 33], s[7 * 33]);
                    *(u32x4*)(WT + (size_t)(n0 + n) * 1024 + k0 + 8 * c) = o; }
                asm volatile("s_waitcnt lgkmcnt(0)" ::: "memory");
            }
            continue; }
        r -= I_WIN;
        if (r < I_WOUT) { const int kb = r / 32, nb = r % 32;
            transpose_item(F.in(20) + (size_t)l * 1024 * 1024, 1024, 1024, 1024, (bf16_t*)(wl + WO_WOUT), 32 * nb, scr, 64 * kb, 32 * nb, 1.f, lane, kb < 12 ? F.in(18) + (size_t)l * 768 + 64 * kb : F.in(19) + (size_t)l * 256 + 64 * (kb - 12)); continue; }
        r -= I_WOUT;
        if (r < 2 * I_WG) { const int up = r / I_WG; const int rr = r % I_WG; const int kb = rr / 88, nb = rr % 88, n0 = 32 * nb;
            const int drow = (n0 / 128) * 256 + up * 128 + (n0 % 128);
            transpose_item_fp8(F.in(up ? 23 : 22) + (size_t)l * 1024 * DFF, 1024, DFF, (unsigned char*)(wl + WO_WGU), drow, scr, 64 * kb, n0, 64.f, lane); continue; }
        r -= 2 * I_WG;
        if (r < I_WD) { const int kb = r / 32, nb = r % 32; transpose_item_fp8(F.in(24) + (size_t)l * DFF * 1024, DFF, 1024, (unsigned char*)(wl + WO_WD), 32 * nb, scr, 64 * kb, 32 * nb, 64.f, lane); continue; }
        r -= I_WD;
        if (r < I_W1) { const int kv = r / 256; const int rr = r % 256; const int kb = rr / 8, nb = rr % 8;
            transpose_item(F.in(4) + ((size_t)l * 2 + kv) * 2048 * 256, 2048, 256, 256, (bf16_t*)(wl + WO_W1) + (size_t)kv * 256 * 2048, 32 * nb, scr, 64 * kb, 32 * nb, 1.f, lane); continue; }
        r -= I_W1;
        if (r < I_WGLU) { const int kb = r / 16, nb = r % 16, n0 = 32 * nb; const int gate = n0 >= 256, nn = n0 & 255;
            const int drow = (nn / 128) * 256 + gate * 128 + (nn % 128);
            transpose_item(F.in(16) + (size_t)l * 256 * 512, 256, 512, 512, (bf16_t*)(ms + MS_WGLU), drow, scr, 64 * kb, n0, 1.f, lane); continue; }
        r -= I_WGLU;
        if (r < I_W2) { const int kv = r / 8; const int rr = r % 8; const int kb = rr / 2, nb = rr % 2;
            transpose_item(F.in(6) + ((size_t)l * 2 + kv) * 256 * 64, 256, 64, 64, (bf16_t*)(ct + CT_W2T) + (size_t)kv * 64 * 256, 32 * nb, scr, 64 * kb, 32 * nb, 1.f, lane); continue; }
        r -= I_W2;
        if (r < I_CB) {
            const int kv = r / 32, ch = r % 32; const float* pe = F.in(3) + ((size_t)l * 2 + kv) * 2048; const float* w1 = F.in(4) + ((size_t)l * 2 + kv) * 2048 * 256;
            f32x4 s = {0.f, 0.f, 0.f, 0.f};
#pragma unroll 8
            for (int i = 0; i < 64; ++i) { const int k = 64 * ch + i; const float pv = pe[k]; const f32x4 w = *(const f32x4*)(w1 + (size_t)k * 256 + 4 * lane); s += w * pv; }
            *(f32x4*)((float*)(ms + MS_CBP) + ((size_t)kv * 32 + ch) * 256 + 4 * lane) = s; continue; }
        r -= I_CB;
        if (r < I_M) {
            const int e0 = r * 64; const int gi = e0 >> 12, dl = (e0 >> 8) & 15, cp0 = (e0 >> 4) & 15, n = lane;
            const float dt = __expf(F.in(8)[l * 16 + gi]);
            const float ar = F.in(9)[((size_t)l * 16 + gi) * 64 + n], ai = F.in(10)[((size_t)l * 16 + gi) * 64 + n];
            const float x = dt * ar, y = dt * ai; const float sy = __sinf(y), cy = __cosf(y), sh = __sinf(0.5f * y);
            const float em1 = (fabsf(x) < 0.25f) ? x * (1.f + x * (0.5f + x * (0.16666667f + x * (0.041666668f + x * 0.0083333338f)))) : expm1f(x);
            const float nr = em1 * cy - 2.f * sh * sh; const float abi = (em1 + 1.f) * sy;
            const float den = ar * ar + ai * ai;
            const float fr_ = (nr * ar + abi * ai) / den, fi_ = (abi * ar - nr * ai) / den;
            const float mg = __expf((float)dl * x); const float pr = mg * __cosf((float)dl * y), pi = mg * __sinf((float)dl * y);
            const f32x4* bre = (const f32x4*)(F.in(11) + (((size_t)l * 16 + gi) * 64 + n) * 16); const f32x4* bim = (const f32x4*)(F.in(12) + (((size_t)l * 16 + gi) * 64 + n) * 16);
            float zr[16], zi[16];
#pragma unroll
            for (int q4 = 0; q4 < 4; ++q4) { const f32x4 br = bre[q4], bi = bim[q4];
#pragma unroll
                for (int j = 0; j < 4; ++j) { const float bbr = fr_ * br[j] - fi_ * bi[j], bbi = fr_ * bi[j] + fi_ * br[j]; zr[4 * q4 + j] = pr * bbr - pi * bbi; zi[4 * q4 + j] = pr * bbi + pi * bbr; } }
#pragma unroll
            for (int cc = 0; cc < 4; ++cc) { const int cp = cp0 + cc;
                const float cr = F.in(13)[(((size_t)l * 16 + gi) * 16 + cp) * 64 + n], ci = F.in(14)[(((size_t)l * 16 + gi) * 16 + cp) * 64 + n];
#pragma unroll
                for (int c = 0; c < 16; ++c) scr[n * 65 + cc * 16 + c] = cr * zr[c] - ci * zi[c]; }
            asm volatile("s_waitcnt lgkmcnt(0)" ::: "memory");
            float mine = 0.f;
#pragma unroll 8
            for (int nn = 0; nn < 64; ++nn) mine += scr[nn * 65 + lane];
            ((float*)(ms + MS_MTAB))[e0 + lane] = mine;
            asm volatile("s_waitcnt lgkmcnt(0)" ::: "memory"); continue; }
        r -= I_M;
        {
            const int e = r * 64 + lane; const int gi = e >> 6, n = e & 63;
            const float dt = __expf(F.in(8)[l * 16 + gi]);
            const float ar = F.in(9)[((size_t)l * 16 + gi) * 64 + n], ai = F.in(10)[((size_t)l * 16 + gi) * 64 + n];
            const float x = dt * ar, y = dt * ai; float sy, cy; sy = __sinf(y); cy = __cosf(y); const float sh = __sinf(0.5f * y);
            const float em1 = (fabsf(x) < 0.25f) ? x * (1.f + x * (0.5f + x * (0.16666667f + x * (0.041666668f + x * 0.0083333338f)))) : expm1f(x); const float nr = em1 * cy - 2.f * sh * sh; const float abi = (em1 + 1.f) * sy;
            const float den = ar * ar + ai * ai;
            const float fr_ = (nr * ar + abi * ai) / den, fi_ = (abi * ar - nr * ai) / den;
            float s16, c16; s16 = __sinf(16.f * y); c16 = __cosf(16.f * y); const float m16 = __expf(16.f * x);
            ((f32x2*)(ct + CT_AB16))[e] = (f32x2){m16 * c16, m16 * s16};
            float s1k, c1k; s1k = __sinf(512.f * y); c1k = __cosf(512.f * y); const float m1k = __expf(512.f * x);
            ((f32x2*)(ct + CT_AB1K))[e] = (f32x2){m1k * c1k, m1k * s1k};
            const float* bre = F.in(11) + (((size_t)l * 16 + gi) * 64 + n) * 16; const float* bim = F.in(12) + (((size_t)l * 16 + gi) * 64 + n) * 16;
            f32x2* bb = (f32x2*)(ms + MS_BBAR) + (size_t)e * 16;
#pragma unroll
            for (int c = 0; c < 16; ++c) { const float br = bre[c], bi = bim[c]; bb[c] = (f32x2){fr_ * br - fi_ * bi, fr_ * bi + fi_ * br}; }
        }
    }
}

DI void prologue_b(Frame& F) {
    const int gt = F.gw * 64 + F.lane, ngt = F.ngw * 64;
    for (int l = 0; l < NL; ++l) {
        unsigned char* wl = F.wsp() + WS_W + (size_t)l * WL_STRIDE;
        unsigned char* ms = F.wsp() + WS_MISC + (size_t)l * MS_L;
        unsigned char* ct = F.wsp() + WS_CTL + CT_BASE + (size_t)l * CT_L;
        const float* MT = (const float*)(ms + MS_MTAB);
        const f32x2* BB = (const f32x2*)(ms + MS_BBAR);
        const float dtl_base = 0.f; (void)dtl_base;
        for (int e = gt; e < 16 * 512 * 256; e += ngt) {
            const int gi = e >> 17, n = (e >> 8) & 511, k = e & 255; float v = 0.f;
            if (n < 256) { const int tp = n >> 4, cp = n & 15, ta = k >> 4, c = k & 15; if (tp >= ta) v = MT[((gi * 16 + (tp - ta)) * 16 + cp) * 16 + c]; }
            else if (n < 384) { const int s = (n - 256) & 63, part = (n - 256) >> 6, ta = k >> 4, c = k & 15;
                const float dt = __expf(F.in(8)[l * 16 + gi]);
                const float ar = F.in(9)[((size_t)l * 16 + gi) * 64 + s], ai = F.in(10)[((size_t)l * 16 + gi) * 64 + s];
                const float pw = (float)(15 - ta); float sp, cpw; sp = __sinf(pw * dt * ai); cpw = __cosf(pw * dt * ai); const float mg = __expf(pw * dt * ar);
                const float pr = mg * cpw, pi = mg * sp; const f32x2 b = BB[((size_t)gi * 64 + s) * 16 + c];
                v = part ? (pr * b.y + pi * b.x) : (pr * b.x - pi * b.y); }
            ((bf16_t*)(wl + WO_SS1))[e] = f2bf(v);
        }
        for (int e = gt; e < 16 * 256 * 256; e += ngt) {
            const int gi = e >> 16, n = (e >> 8) & 255, k = e & 255; float v = 0.f;
            if (k < 128) { const int s = k & 63, part = k >> 6, ta = n >> 4, c = n & 15;
                const float dt = __expf(F.in(8)[l * 16 + gi]);
                const float ar = F.in(9)[((size_t)l * 16 + gi) * 64 + s], ai = F.in(10)[((size_t)l * 16 + gi) * 64 + s];
                const float pw = (float)(ta + 1); float sp, cpw; sp = __sinf(pw * dt * ai); cpw = __cosf(pw * dt * ai); const float mg = __expf(pw * dt * ar);
                const float pr = mg * cpw, pi = mg * sp;
                const float cr = F.in(13)[(((size_t)l * 16 + gi) * 16 + c) * 64 + s], ci = F.in(14)[(((size_t)l * 16 + gi) * 16 + c) * 64 + s];
                v = part ? -(cr * pi + ci * pr) : (cr * pr - ci * pi); }
            ((bf16_t*)(wl + WO_SS2))[e] = f2bf(v);
        }
        for (int e = gt; e < 512; e += ngt) { const int kv = e >> 8, n = e & 255; float s = F.in(5)[((size_t)l * 2 + kv) * 256 + n];
            const float* pp = (const float*)(ms + MS_CBP) + (size_t)kv * 32 * 256 + n;
            for (int ch = 0; ch < 32; ++ch) s += pp[ch * 256];
            ((float*)(ct + CT_CB1))[e] = s; }
    }
}

DI void convert_rows_stats(Frame& F, const float* x, bf16_t* o, unsigned long long* ssx) {
    for (int m = F.gw; m < NT; m += F.ngw) {
        const f32x4* xr = (const f32x4*)(x + (size_t)m * DM) + F.lane; f32x4 v[4]; float s = 0.f;
#pragma unroll
        for (int j = 0; j < 4; ++j) { v[j] = xr[64 * j]; s += (v[j].x * v[j].x + v[j].y * v[j].y) + (v[j].z * v[j].z + v[j].w * v[j].w); }
        u32x2* o8 = (u32x2*)(o + (size_t)m * DM) + F.lane;
#pragma unroll
        for (int j = 0; j < 4; ++j) { u32x2 w; w.x = pk2(v[j].x, v[j].y); w.y = pk2(v[j].z, v[j].w); o8[64 * j] = w; }
        s = wave_sum(s);
        if (F.lane == 0) ssx[(size_t)m * 2] = (unsigned long long)(s * 1048576.f);
    }
}
DI void rmsnorm_rows_bf16(Frame& F, const float* x, const float* g, bf16_t* o) {
    const f32x4* gp = (const f32x4*)g + F.lane; f32x4 gv[4];
#pragma unroll
    for (int j = 0; j < 4; ++j) gv[j] = gp[64 * j];
    for (int m = F.gw; m < NT; m += F.ngw) {
        const f32x4* xr = (const f32x4*)(x + (size_t)m * DM) + F.lane; f32x4 v[4]; float s = 0.f;
#pragma unroll
        for (int j = 0; j < 4; ++j) { v[j] = xr[64 * j]; s += (v[j].x * v[j].x + v[j].y * v[j].y) + (v[j].z * v[j].z + v[j].w * v[j].w); }
        const float rstd = rsqrtf(wave_sum(s) * (1.f / DM) + 1e-6f);
        u32x2* o8 = (u32x2*)(o + (size_t)m * DM) + F.lane;
#pragma unroll
        for (int j = 0; j < 4; ++j) { u32x2 w; w.x = pk2(v[j].x * rstd * gv[j].x, v[j].y * rstd * gv[j].y); w.y = pk2(v[j].z * rstd * gv[j].z, v[j].w * rstd * gv[j].w); o8[64 * j] = w; }
    }
}
DI void rmsnorm_rows_fp8(Frame& F, const float* x, const float* g, unsigned char* o) {
    const f32x4* gp = (const f32x4*)g + F.lane; f32x4 gv[4];
#pragma unroll
    for (int j = 0; j < 4; ++j) gv[j] = gp[64 * j];
    for (int m = F.gw; m < NT; m += F.ngw) {
        const f32x4* xr = (const f32x4*)(x + (size_t)m * DM) + F.lane; f32x4 v[4]; float s = 0.f;
#pragma unroll
        for (int j = 0; j < 4; ++j) { v[j] = xr[64 * j]; s += (v[j].x * v[j].x + v[j].y * v[j].y) + (v[j].z * v[j].z + v[j].w * v[j].w); }
        const float rstd = rsqrtf(wave_sum(s) * (1.f / DM) + 1e-6f);
        unsigned* o4 = (unsigned*)(o + (size_t)m * DM) + F.lane;
#pragma unroll
        for (int j = 0; j < 4; ++j) o4[64 * j] = pk4_fp8(v[j].x * rstd * gv[j].x, v[j].y * rstd * gv[j].y, v[j].z * rstd * gv[j].z, v[j].w * rstd * gv[j].w);
    }
}
DI void rmsnorm_rows_f32_inplace(Frame& F, float* x, const float* g) {
    const f32x4* gp = (const f32x4*)g + F.lane; f32x4 gv[4];
#pragma unroll
    for (int j = 0; j < 4; ++j) gv[j] = gp[64 * j];
    for (int m = F.gw; m < NT; m += F.ngw) {
        f32x4* xr = (f32x4*)(x + (size_t)m * DM) + F.lane; f32x4 v[4]; float s = 0.f;
#pragma unroll
        for (int j = 0; j < 4; ++j) { v[j] = xr[64 * j]; s += (v[j].x * v[j].x + v[j].y * v[j].y) + (v[j].z * v[j].z + v[j].w * v[j].w); }
        const float rstd = rsqrtf(wave_sum(s) * (1.f / DM) + 1e-6f);
#pragma unroll
        for (int j = 0; j < 4; ++j) xr[64 * j] = v[j] * rstd * gv[j];
    }
}
template <int OUT>
DI void rmsnorm_rows_xb(Frame& F, const bf16_t* x, const float* g, void* o) {
    const f32x4* gp = (const f32x4*)g + 2 * F.lane; f32x4 gv[2][2];
#pragma unroll
    for (int j = 0; j < 2; ++j) { gv[j][0] = gp[128 * j]; gv[j][1] = gp[128 * j + 1]; }
    for (int m = 2 * F.gw; m < NT; m += 2 * F.ngw) {
        u32x4 w[2][2];
#pragma unroll
        for (int r = 0; r < 2; ++r)
#pragma unroll
            for (int j = 0; j < 2; ++j) w[r][j] = ((const u32x4*)(x + (size_t)(m + r) * DM) + F.lane)[64 * j];
#pragma unroll
        for (int r = 0; r < 2; ++r) {
            f32x4 v[2][2]; float s = 0.f;
#pragma unroll
            for (int j = 0; j < 2; ++j) { const u32x4 q = w[r][j];
                v[j][0] = f32x4{bflo(q.x), bfhi(q.x), bflo(q.y), bfhi(q.y)}; v[j][1] = f32x4{bflo(q.z), bfhi(q.z), bflo(q.w), bfhi(q.w)};
                const f32x4 a = v[j][0] * v[j][0] + v[j][1] * v[j][1]; s += (a.x + a.y) + (a.z + a.w); }
            const float rstd = rsqrtf(wave_sum(s) * (1.f / DM) + 1e-6f);
#pragma unroll
            for (int j = 0; j < 2; ++j) { const f32x4 y0 = v[j][0] * rstd * gv[j][0], y1 = v[j][1] * rstd * gv[j][1];
                if constexpr (OUT == 0) { u32x4 t; t.x = pk2(y0.x, y0.y); t.y = pk2(y0.z, y0.w); t.z = pk2(y1.x, y1.y); t.w = pk2(y1.z, y1.w);
                    ((u32x4*)((bf16_t*)o + (size_t)(m + r) * DM) + F.lane)[64 * j] = t; }
                else if constexpr (OUT == 1) { u32x2 t; t.x = pk4_fp8(y0.x, y0.y, y0.z, y0.w); t.y = pk4_fp8(y1.x, y1.y, y1.z, y1.w);
                    ((u32x2*)((unsigned char*)o + (size_t)(m + r) * DM) + F.lane)[64 * j] = t; }
                else { f32x4* op = (f32x4*)((float*)o + (size_t)(m + r) * DM) + 2 * F.lane + 128 * j; op[0] = y0; op[1] = y1; } }
        }
    }
}
DI void mix_norm_rows(Frame& F, const bf16_t* oatt, const bf16_t* ossm, const float* gatt, const float* gssm, bf16_t* mixed) {
    for (int m = F.gw; m < NT; m += F.ngw) {
        const u32x2* ar = (const u32x2*)(oatt + (size_t)m * 768) + F.lane;
        float a[12]; float s = 0.f;
#pragma unroll
        for (int j = 0; j < 3; ++j) { const u32x2 w = ar[64 * j]; a[4 * j] = bflo(w.x); a[4 * j + 1] = bfhi(w.x); a[4 * j + 2] = bflo(w.y); a[4 * j + 3] = bfhi(w.y); }
#pragma unroll
        for (int j = 0; j < 12; ++j) s += a[j] * a[j];
        const float ra = rsqrtf(wave_sum(s) * (1.f / 768.f) + 1e-6f);
        const u32x2 sw = ((const u32x2*)(ossm + (size_t)m * 256))[F.lane];
        float b[4] = {bflo(sw.x), bfhi(sw.x), bflo(sw.y), bfhi(sw.y)};
        const float rs = rsqrtf(wave_sum(b[0] * b[0] + b[1] * b[1] + b[2] * b[2] + b[3] * b[3]) * (1.f / 256.f) + 1e-6f);
        u32x2* o8 = (u32x2*)(mixed + (size_t)m * DM);
#pragma unroll
        for (int j = 0; j < 3; ++j) { const f32x4 gv = ((const f32x4*)gatt)[64 * j + F.lane];
            u32x2 w; w.x = pk2(a[4 * j] * ra * gv.x, a[4 * j + 1] * ra * gv.y); w.y = pk2(a[4 * j + 2] * ra * gv.z, a[4 * j + 3] * ra * gv.w); o8[64 * j + F.lane] = w; }
        { const f32x4 gv = ((const f32x4*)gssm)[F.lane]; u32x2 w; w.x = pk2(b[0] * rs * gv.x, b[1] * rs * gv.y); w.y = pk2(b[2] * rs * gv.z, b[3] * rs * gv.w); o8[192 + F.lane] = w; }
    }
}

#define KPERM(rt, r) (32 * ((rt) >> 1) + 8 * ((r) >> 2) + 4 * ((rt) & 1) + ((r) & 3))
DI void vtranspose_phase(Frame& F, const bf16_t* proj, bf16_t* vts, bf16_t* vtw, bf16_t* kfs, unsigned* vmax_word, int cu0) {
    LAS bf16_t* scr = (LAS bf16_t*)(F.lds + F.wave * 8704);
    unsigned vm = 0u;
    const bool split = F.G > 96;
    if (split && F.bid < cu0) return;
    const int gw0 = split ? F.gw - cu0 * 8 : F.gw, ngw0 = split ? F.ngw - cu0 * 8 : F.ngw;
    const int c16 = F.lane & 15, kq = F.lane >> 4;
    for (int it = gw0; it < 3 * 6 * 256; it += ngw0) {
        const int which = it / 1536, r = it % 1536, bh = r >> 8, tt = r & 255, b = bh / 3, h = bh % 3;
        const bf16_t* src = proj + ((size_t)(b * SEQ + 64 * tt)) * PW + (which == 0 ? C_VS : (which == 1 ? C_VW : C_KS)) + h * 64;
        bf16_t* dst = (which == 0 ? vts : (which == 1 ? vtw : kfs)) + (size_t)bh * 64 * SEQ + (size_t)tt * 4096;
#pragma unroll
        for (int i = 0; i < 8; ++i) { const int tk = i * 8 + (F.lane >> 3), d8 = F.lane & 7; const u32x4 w = *(const u32x4*)(src + (size_t)tk * PW + 8 * d8);
            if (which == 0) { vm = max(vm, max(max(w.x & 0x7fff0000u, (w.x << 16) & 0x7fff0000u), max(w.y & 0x7fff0000u, (w.y << 16) & 0x7fff0000u)));
                              vm = max(vm, max(max(w.z & 0x7fff0000u, (w.z << 16) & 0x7fff0000u), max(w.w & 0x7fff0000u, (w.w << 16) & 0x7fff0000u))); }
            LAS bf16_t* sp = scr + tk * 66 + 8 * d8; ((LAS unsigned*)sp)[0] = w.x; ((LAS unsigned*)sp)[1] = w.y; ((LAS unsigned*)sp)[2] = w.z; ((LAS unsigned*)sp)[3] = w.w; }
        asm volatile("s_waitcnt lgkmcnt(0)" ::: "memory");
        if (which == 1) {
#pragma unroll
            for (int i = 0; i < 8; ++i) { const int d = i * 8 + (F.lane >> 3), t8 = F.lane & 7; unsigned short e[8];
#pragma unroll
                for (int j = 0; j < 8; ++j) e[j] = scr[(8 * t8 + j) * 66 + d];
                u32x4 w; w.x = e[0] | ((unsigned)e[1] << 16); w.y = e[2] | ((unsigned)e[3] << 16); w.z = e[4] | ((unsigned)e[5] << 16); w.w = e[6] | ((unsigned)e[7] << 16);
                *(u32x4*)(dst + (size_t)d * 64 + 8 * t8) = w; }
        } else if (which == 0) {
#pragma unroll
            for (int I = 0; I < 8; ++I) { const int dt = I >> 1, sp = I & 1; unsigned short e[8];
#pragma unroll
                for (int j = 0; j < 8; ++j) e[j] = scr[(32 * sp + 8 * kq + j) * 66 + 16 * dt + c16];
                u32x4 w; w.x = e[0] | ((unsigned)e[1] << 16); w.y = e[2] | ((unsigned)e[3] << 16); w.z = e[4] | ((unsigned)e[5] << 16); w.w = e[6] | ((unsigned)e[7] << 16);
                *(u32x4*)(dst + (I * 64 + F.lane) * 8) = w; }
        } else {
#pragma unroll
            for (int I = 0; I < 8; ++I) { const int rt = I >> 1, ks = I & 1; const LAS bf16_t* sp = scr + KPERM(rt, c16) * 66 + 32 * ks + 8 * kq;
                u32x4 w; w.x = ((const LAS unsigned*)sp)[0]; w.y = ((const LAS unsigned*)sp)[1]; w.z = ((const LAS unsigned*)sp)[2]; w.w = ((const LAS unsigned*)sp)[3];
                *(u32x4*)(dst + (I * 64 + F.lane) * 8) = w; }
        }
        asm volatile("s_waitcnt lgkmcnt(0)" ::: "memory");
    }
    vm = wave_max_u32(vm);
    if (F.lane == 0 && vm != 0u) __hip_atomic_fetch_max(vmax_word, vm, __ATOMIC_RELAXED, __HIP_MEMORY_SCOPE_AGENT);
}

#define MFMA32(a, b, c) __builtin_amdgcn_mfma_f32_32x32x16_bf16((a), (b), (c), 0, 0, 0)
#define MFMA16(a, b, c) __builtin_amdgcn_mfma_f32_16x16x32_bf16((a), (b), (c), 0, 0, 0)

DI void compress2_phase(Frame& F, const bf16_t* hidc, const bf16_t* w2t, const float* b2  , bf16_t* kc, bf16_t* vct, int it0, int it_end, int it_step) {
    const int r = F.lane & 31, h = F.lane >> 5;
    for (int it = it0; it < it_end; it += it_step) {
        const int kv = it / 192, rb = it % 192; const int R0 = kv * 6144 + rb * 32;
        f32x16 acc0, acc1;
#pragma unroll
        for (int i = 0; i < 16; ++i) { acc0[i] = 0.f; acc1[i] = 0.f; }
        const bf16_t* ap = hidc + (size_t)(R0 + r) * 256 + 8 * h; const bf16_t* bp = w2t + (size_t)kv * 64 * 256 + (size_t)r * 256 + 8 * h;
#pragma unroll 4
        for (int ks = 0; ks < 16; ++ks) { const bf16x8 a = *(const bf16x8*)(ap + 16 * ks); const bf16x8 b0 = *(const bf16x8*)(bp + 16 * ks), b1 = *(const bf16x8*)(bp + 32 * 256 + 16 * ks);
            acc0 = MFMA32(a, b0, acc0); acc1 = MFMA32(a, b1, acc1); }
        const int bh = rb >> 5, i0 = (rb & 31) * 32;
        const float bb0 = b2[kv * 64 + r], bb1 = b2[kv * 64 + 32 + r];
        if (kv == 0) {
#pragma unroll
            for (int i = 0; i < 16; ++i) { const int row = i0 + (i & 3) + 8 * (i >> 2) + 4 * h; bf16_t* o = kc + ((size_t)bh * 1024 + row) * 64;
                const bool junk = (row == 1023);
                o[r] = junk ? (bf16_t)0 : f2bf(acc0[i] + bb0); o[32 + r] = junk ? (bf16_t)0 : f2bf(acc1[i] + bb1); }
        } else {
#pragma unroll
            for (int g4 = 0; g4 < 4; ++g4) { const int row = i0 + 8 * g4 + 4 * h;
                u32x2 w0, w1; w0.x = pk2(acc0[4 * g4] + bb0, acc0[4 * g4 + 1] + bb0); w0.y = pk2(acc0[4 * g4 + 2] + bb0, acc0[4 * g4 + 3] + bb0);
                w1.x = pk2(acc1[4 * g4] + bb1, acc1[4 * g4 + 1] + bb1); w1.y = pk2(acc1[4 * g4 + 2] + bb1, acc1[4 * g4 + 3] + bb1);
                if (row == 1020) { w0.y &= 0x0000ffffu; w1.y &= 0x0000ffffu; }
                bf16_t* vt = vct + (size_t)bh * 64 * 1024 + (size_t)(row >> 6) * 4096 + (row & 63);
                *(u32x2*)(vt + r * 64) = w0; *(u32x2*)(vt + (32 + r) * 64) = w1; }
        }
    }
}

DI void ssm_carry_phase(Frame& F, const float* hl, const f32x2* ab16, const f32x2* ab512, bf16_t* hin, int bg0, int bg_end, int bg_step) {
    LAS f32x2* E = (LAS f32x2*)F.lds;
    const int s = F.lane;
    for (int bg = bg0; bg < bg_end; bg += bg_step) {
        const int gi = bg & 15; const f32x2 a16 = ab16[gi * 64 + s], a5 = ab512[gi * 64 + s];
        const float* hp = hl + (size_t)bg * 1024 * 128 + s;
        float hr[4], hi[4];
#pragma unroll
        for (int j = 0; j < 4; ++j) { hr[j] = 0.f; hi[j] = 0.f; }
#pragma unroll 4
        for (int c = 0; c < 32; ++c) {
#pragma unroll
            for (int j = 0; j < 4; ++j) { const float* q = hp + (size_t)((4 * F.wave + j) * 32 + c) * 128; const float lr = q[0], li = q[64];
                const float nr = a16.x * hr[j] - a16.y * hi[j] + lr, ni = a16.x * hi[j] + a16.y * hr[j] + li; hr[j] = nr; hi[j] = ni; } }
#pragma unroll
        for (int j = 0; j < 4; ++j) E[(4 * F.wave + j) * 64 + s] = (f32x2){hr[j], hi[j]};
        __syncthreads();
        { float pr = 0.f, pi = 0.f;
          for (int k = 0; k < 4 * F.wave; ++k) { const f32x2 e = E[k * 64 + s]; const float nr = a5.x * pr - a5.y * pi + e.x, ni = a5.x * pi + a5.y * pr + e.y; pr = nr; pi = ni; }
#pragma unroll
          for (int j = 0; j < 4; ++j) { hr[j] = pr; hi[j] = pi; const f32x2 e = E[(4 * F.wave + j) * 64 + s]; const float nr = a5.x * pr - a5.y * pi + e.x, ni = a5.x * pi + a5.y * pr + e.y; pr = nr; pi = ni; } }
#pragma unroll 4
        for (int c = 0; c < 32; ++c) {
#pragma unroll
            for (int j = 0; j < 4; ++j) { const int ch = (4 * F.wave + j) * 32 + c; const float* q = hp + (size_t)ch * 128; const float lr = q[0], li = q[64];
                bf16_t* o = hin + ((size_t)bg * 1024 + ch) * 256; o[s] = f2bf(hr[j]); o[64 + s] = f2bf(hi[j]); ((unsigned*)(o + 128))[s] = 0u;
                const float nr = a16.x * hr[j] - a16.y * hi[j] + lr, ni = a16.x * hi[j] + a16.y * hr[j] + li; hr[j] = nr; hi[j] = ni; } }
        __syncthreads();
    }
}

constexpr float AL2E = 1.0f;
constexpr int IMP_STRIDE = 257;
constexpr int OS_QS = 261, OS_HS = 65;
constexpr int LDS_RA = 0, LDS_RB = 64 * IMP_STRIDE * 4, LDS_WM = LDS_RB + 64 * OS_QS * 4;
constexpr int QT_ROW = 144, LDS_QT = LDS_RA, LDS_QL = LDS_QT + 256 * QT_ROW, LDS_MREF = LDS_QL + 512, LDS_LS = LDS_MREF + 1024;
constexpr int LDS_QCNT = LDS_WM + 2048;
static_assert(LDS_LS + 1024 <= LDS_RB && LDS_QCNT + 20 <= LDS_BYTES - 256, "LDS map");
constexpr int TROW = 144, TILE_V = 64 * TROW, TILE_BYTES = 2 * 64 * TROW;

struct TileSrc { const bf16_t* k; long kstep, kstride; const bf16_t* v; long vstep, vstride; };

constexpr int PD = 1;
struct IdMap { DI int operator()(int i) const { return i; } };
template <bool WITH_V, class Compute, class Map = IdMap, bool FRAG = false>
DI void kv_pipeline(Frame& F, LAS unsigned char* sb, const TileSrc& ts, int n, Compute&& compute, Map tmap = Map()) {
    if (n <= 0) return;
    const int row = F.tid >> 3, ch = F.tid & 7, nl = n - 1;
    const bf16_t* kp = FRAG ? ts.k + F.tid * 8 : ts.k + (long)row * ts.kstride + ch * 8; const bf16_t* vp = FRAG ? ts.v + F.tid * 8 : ts.v + (long)row * ts.vstride + ch * 8;
    LAS unsigned char* wk = sb + row * TROW + ch * 16; int vdel = TILE_V;
    if (FRAG) { const int I = F.tid >> 6, l_ = F.tid & 63, c16_ = l_ & 15, kq_ = l_ >> 4;
        const int kofs = KPERM(I >> 1, c16_) * TROW + (32 * (I & 1) + 8 * kq_) * 2, vofs = TILE_V + (16 * (I >> 1) + c16_) * TROW + (32 * (I & 1) + 8 * kq_) * 2;
        wk = sb + kofs; vdel = vofs - kofs; }
    u32x4 kr[PD], vr[PD];
#pragma unroll
    for (int u = 0; u < PD; ++u) { const int t = tmap(u < nl ? u : nl); kr[u] = *(const u32x4*)(kp + (long)t * ts.kstep); vr[u] = WITH_V ? *(const u32x4*)(vp + (long)t * ts.vstep) : (u32x4){0u, 0u, 0u, 0u}; }
    *(LAS u32x4*)wk = kr[0]; if (WITH_V) *(LAS u32x4*)(wk + vdel) = vr[0];
    { const int t = tmap(PD < nl ? PD : nl); kr[0] = *(const u32x4*)(kp + (long)t * ts.kstep); if (WITH_V) vr[0] = *(const u32x4*)(vp + (long)t * ts.vstep); }
    __syncthreads();
    for (int i0 = 0; i0 < n; i0 += PD) {
#pragma unroll
        for (int u = 0; u < PD; ++u) {
            const int i = i0 + u; const int s1 = (u + 1) % PD;
            { LAS unsigned char* w1 = wk + ((i + 1) & 1) * TILE_BYTES; *(LAS u32x4*)w1 = kr[s1]; if (WITH_V) *(LAS u32x4*)(w1 + vdel) = vr[s1]; }
            { const int t = tmap((i + 1 + PD) < nl ? (i + 1 + PD) : nl); kr[s1] = *(const u32x4*)(kp + (long)t * ts.kstep); if (WITH_V) vr[s1] = *(const u32x4*)(vp + (long)t * ts.vstep); }
            if (i < n) compute(i, sb + (i & 1) * TILE_BYTES);
            __syncthreads();
        }
    }
}

DI f32x16 qk32(const LAS unsigned char* tb, int kh, int r32, int h, const bf16x8 (&qf)[4]) {
    f32x16 sc;
#pragma unroll
    for (int i = 0; i < 16; ++i) sc[i] = 0.f;
    const LAS unsigned char* kp = tb + (32 * kh + r32) * TROW + 16 * h;
#pragma unroll
    for (int s = 0; s < 4; ++s) { const bf16x8 a = *(const LAS bf16x8*)(kp + 32 * s); sc = MFMA32(a, qf[s], sc); }
    return sc;
}
DI void qk32x2(const LAS unsigned char* tb, int r32, int h, const bf16x8 (&qf)[4], f32x16& s0, f32x16& s1) {
#pragma unroll
    for (int i = 0; i < 16; ++i) { s0[i] = 0.f; s1[i] = 0.f; }
    const LAS unsigned char* kp = tb + r32 * TROW + 16 * h;
#pragma unroll
    for (int s = 0; s < 4; ++s) { const bf16x8 a0 = *(const LAS bf16x8*)(kp + 32 * s), a1 = *(const LAS bf16x8*)(kp + 32 * TROW + 32 * s); s0 = MFMA32(a0, qf[s], s0); s1 = MFMA32(a1, qf[s], s1); }
}
DI void pv32(const LAS unsigned char* tb, int kh, int r32, int h, const f32x16& p, f32x16& o0, f32x16& o1) {
#pragma unroll
    for (int s2 = 0; s2 < 2; ++s2) {
        u32x4 pw; pw.x = pk2(p[8 * s2], p[8 * s2 + 1]); pw.y = pk2(p[8 * s2 + 2], p[8 * s2 + 3]); pw.z = pk2(p[8 * s2 + 4], p[8 * s2 + 5]); pw.w = pk2(p[8 * s2 + 6], p[8 * s2 + 7]);
        const bf16x8 pb = __builtin_bit_cast(bf16x8, pw);
        const LAS unsigned char* vp = tb + TILE_V + r32 * TROW + (32 * kh + 16 * s2 + 4 * h) * 2;
        { const s16x4 lo = *(const LAS s16x4*)vp, hi = *(const LAS s16x4*)(vp + 16); const bf16x8 a = __builtin_shufflevector(lo, hi, 0, 1, 2, 3, 4, 5, 6, 7); o0 = MFMA32(a, pb, o0); }
        { const s16x4 lo = *(const LAS s16x4*)(vp + 32 * TROW), hi = *(const LAS s16x4*)(vp + 32 * TROW + 16); const bf16x8 a = __builtin_shufflevector(lo, hi, 0, 1, 2, 3, 4, 5, 6, 7); o1 = MFMA32(a, pb, o1); }
    }
}

DI void attn_unit(Frame& F, const bf16_t* proj, const bf16_t* kcb, const bf16_t* vctb, const bf16_t* vts, const bf16_t* vtw, bf16_t* oatt, int bh, int qb, float os_scale, float os_inv, float os_e2, float* park, const bf16_t* kfs, unsigned long long* sst) {
    const float ls_scale = 1048576.0f * os_inv;
    LAS unsigned* IMP = (LAS unsigned*)(F.lds + LDS_RA); LAS unsigned char* WM = F.lds + LDS_WM;
    const int b = bh / 3, hkv = bh % 3, lane = F.lane, w = F.wave;
    const float NEG = -__builtin_inff();
    for (int i = F.tid; i < 64 * IMP_STRIDE; i += 512) IMP[i] = 0u;
    for (int i = F.tid; i < 512; i += 512) ((LAS unsigned*)WM)[i] = 0u;
    if (F.tid == 0) ((LAS int*)(F.lds + LDS_QCNT + 16))[0] = 0;
    const int r32 = lane & 31, h = lane >> 5, gq = w & 3, qh = w >> 2;
    const int ql = 32 * qh + r32, t = 64 * qb + ql;
    const size_t trow = (size_t)(b * SEQ + t);
    const bf16_t* qrow = proj + trow * PW + C_Q + (hkv * 4 + gq) * 64;
    bf16x8 qf[4];
#pragma unroll
    for (int s = 0; s < 4; ++s) qf[s] = *(const bf16x8*)(qrow + 16 * s + 8 * h);
    const bf16_t* grow = proj + trow * PW + C_G + hkv * 12 + gq * 3;
    const float g0 = sigmoidf_(bf2f(grow[0])), g2 = sigmoidf_(bf2f(grow[2]));
    f32x16 oc0, oc1; float inv_c = 0.f;
#pragma unroll
    for (int i = 0; i < 16; ++i) { oc0[i] = 0.f; oc1[i] = 0.f; }
    {
        const int ntile = (4 * qb + 3 + 63) >> 6;
        const int vis = (t - 31) >> 4;
        const int vis_w = (64 * qb + 32 * qh + 31 - 31) >> 4;
        const int vis_min = (64 * qb + 32 * qh - 31) >> 4;
        TileSrc ts{kcb + (size_t)bh * 1024 * 64, 64 * 64, 64, vctb + (size_t)bh * 64 * 1024, 4096, 64};
        float m = NEG, lsum = 0.f;
        kv_pipeline<false>(F, F.lds + LDS_RB, ts, ntile, [&](int i, const LAS unsigned char* tb) {
            if (64 * i > vis_w) return;
            const bool two = (64 * i + 32 <= vis_w); f32x16 sq0, sq1;
            if (two) qk32x2(tb, r32, h, qf, sq0, sq1); else { sq0 = qk32(tb, 0, r32, h, qf); sq1 = sq0; }
#pragma unroll
            for (int kh = 0; kh < 2; ++kh) {
                if (kh == 1 && !two) continue;
                f32x16 sc = kh ? sq1 : sq0;
                if (64 * i + 32 * kh + 31 > vis_min) {
#pragma unroll
                    for (int e = 0; e < 16; ++e) { const int ki = 64 * i + 32 * kh + (e & 3) + 8 * (e >> 2) + 4 * h; sc[e] = (ki <= vis) ? sc[e] : NEG; }
                }
                float ps = 0.f;
#pragma unroll
                for (int e = 0; e < 16; ++e) ps += fexp2(sc[e]);
                lsum += ps;
            }
        });
        bool redo1; { const float Lq = xor32_sum(lsum); LAS int* WFLAG = (LAS int*)(F.lds + LDS_QCNT + 16);
          if (!(Lq == 0.f || (Lq > 5.4e-20f && Lq < 1.8e19f))) WFLAG[0] = 1;
          __syncthreads();
          redo1 = (WFLAG[0] != 0) || (FORCE_REDO != 0); }
        float M = 0.f, Lt = 0.f;
        if (!redo1) { Lt = xor32_sum(lsum); }
        else {
        lsum = 0.f;
        for (int rep_ = 0; rep_ < REP_B1; ++rep_)
        kv_pipeline<false>(F, F.lds + LDS_RB, ts, ntile, [&](int i, const LAS unsigned char* tb) {
            if (64 * i > vis_w) return;
            const bool two = (64 * i + 32 <= vis_w); f32x16 sq0, sq1;
            if (two) qk32x2(tb, r32, h, qf, sq0, sq1); else { sq0 = qk32(tb, 0, r32, h, qf); sq1 = sq0; }
#pragma unroll
            for (int kh = 0; kh < 2; ++kh) {
                if (kh == 1 && !two) continue;
                f32x16 sc = kh ? sq1 : sq0;
                float tm = NEG;
                if (64 * i + 32 * kh + 31 > vis_min) {
#pragma unroll
                    for (int e = 0; e < 16; ++e) { const int ki = 64 * i + 32 * kh + (e & 3) + 8 * (e >> 2) + 4 * h; sc[e] = (ki <= vis) ? sc[e] : NEG; }
                }
#pragma unroll
                for (int e = 0; e < 16; ++e) tm = fmaxf(tm, sc[e]);
                const float mn = fmaxf(m, tm);
                if (mn > NEG) { float ps = 0.f;
#pragma unroll
                    for (int e = 0; e < 16; ++e) ps += fexp2((sc[e] - mn) * AL2E);
                    lsum = lsum * fexp2((m - mn) * AL2E) + ps; m = mn; }
            }
        });
        const F2 mm = halves32(m), ll = halves32(lsum);
        M = fmaxf(mm.lo, mm.hi);
        if (M > NEG) Lt = ll.lo * fexp2((mm.lo - M) * AL2E) + ll.hi * fexp2((mm.hi - M) * AL2E); else M = 0.f;
        }
        const float inv = 1.0f / fmaxf(Lt, 1e-30f), inv24 = inv * 16777216.0f;
        inv_c = inv;
        for (int rep_ = 0; rep_ < REP_B1; ++rep_)
        kv_pipeline<true>(F, F.lds + LDS_RB, ts, ntile, [&](int i, const LAS unsigned char* tb) {
            if (64 * i > vis_w) return;
            const bool two = (64 * i + 32 <= vis_w); f32x16 sq0, sq1;
            if (two) qk32x2(tb, r32, h, qf, sq0, sq1); else { sq0 = qk32(tb, 0, r32, h, qf); sq1 = sq0; }
#pragma unroll
            for (int kh = 0; kh < 2; ++kh) {
                if (kh == 1 && !two) continue;
                f32x16 sc = kh ? sq1 : sq0;
#pragma unroll
                for (int e = 0; e < 16; ++e) sc[e] = fexp2((sc[e] - M) * AL2E);
                if (64 * i + 32 * kh + 31 > vis_min) {
#pragma unroll
                    for (int e = 0; e < 16; ++e) { const int ki = 64 * i + 32 * kh + (e & 3) + 8 * (e >> 2) + 4 * h; sc[e] = (ki <= vis) ? sc[e] : 0.f; }
                }
#pragma unroll
                for (int a = 0; a < 4; ++a) { const float G = (sc[4 * a] + sc[4 * a + 1]) + (sc[4 * a + 2] + sc[4 * a + 3]); const int j = 16 * i + 8 * kh + 2 * a + h;
                    __hip_atomic_fetch_add(IMP + ql * IMP_STRIDE + j, (unsigned)(G * inv24 + 0.5f), __ATOMIC_RELAXED, __HIP_MEMORY_SCOPE_WORKGROUP);
                    __hip_atomic_fetch_add(IMP + ql * IMP_STRIDE + j + 1, (unsigned)(sc[4 * a + 3] * inv24 + 0.5f), __ATOMIC_RELAXED, __HIP_MEMORY_SCOPE_WORKGROUP); }
                pv32(tb, kh, r32, h, sc, oc0, oc1);
            }
        });
    }
    {
        const int cur = qb; LAS unsigned char* wm = WM + w * 256;
        if (cur + 1 <= 16) { if (lane <= cur) wm[lane] = 0xff; }
        else for (int rep_ = 0; rep_ < REP_TK; ++rep_) {
            unsigned key[8][4]; unsigned selbits = 0u;
#pragma unroll
            for (int qi = 0; qi < 8; ++qi) {
#pragma unroll
                for (int i = 0; i < 4; ++i) { const int j = 4 * lane + i; const unsigned x = IMP[(8 * w + qi) * IMP_STRIDE + j]; key[qi][i] = (j >= 1 && j <= cur - 2) ? (((x + 1u) << 2) | (unsigned)(3 - i)) : 0u; }
#define CE_(a_, b_) do { const unsigned hi_ = max(key[qi][a_], key[qi][b_]), lo_ = min(key[qi][a_], key[qi][b_]); key[qi][a_] = hi_; key[qi][b_] = lo_; } while (0)
                CE_(0, 1); CE_(2, 3); CE_(0, 2); CE_(1, 3); CE_(1, 2);
#undef CE_
            }
            for (int k = 0; k < 13; ++k) {
#pragma unroll
                for (int qi = 0; qi < 8; ++qi) {
                    const unsigned hv = key[qi][0] >> 2; const unsigned Mx = wave_max_u32(hv);
                    const unsigned long long bal = __ballot(hv == Mx); const int L = __ffsll((long long)bal) - 1;
                    const unsigned hk = (unsigned)__builtin_amdgcn_readlane((int)key[qi][0], L);
                    const unsigned bit = 1u << (8 * (3 - (int)(hk & 3u)) + qi);
                    const bool win = (lane == L);
                    selbits |= win ? bit : 0u;
                    key[qi][0] = win ? key[qi][1] : key[qi][0]; key[qi][1] = win ? key[qi][2] : key[qi][1]; key[qi][2] = win ? key[qi][3] : key[qi][2]; key[qi][3] = win ? 0u : key[qi][3];
                }
            }
            unsigned mybits[4];
#pragma unroll
            for (int i = 0; i < 4; ++i) mybits[i] = (selbits >> (8 * i)) & 0xffu;
#pragma unroll
            for (int i = 0; i < 4; ++i) { const int j = 4 * lane + i; unsigned bits = mybits[i]; if (j == 0 || j == cur - 1 || j == cur) bits = 0xffu; wm[j] = (unsigned char)bits; }
        }
    }
    __syncthreads();
    {
        const int kt_lo = (qb - 8) > 0 ? (qb - 8) : 0; const int ntile = qb - kt_lo + 1;
        const int t0w = 64 * qb + 32 * qh;
        TileSrc ts{proj + ((size_t)(b * SEQ) + 64 * kt_lo) * PW + C_KW + hkv * 64, 64 * PW, PW, vtw + (size_t)bh * 64 * SEQ + (size_t)kt_lo * 4096, 4096, 64};
        float m = NEG, lsum = 0.f; f32x16 o0, o1;
#pragma unroll
        for (int i = 0; i < 16; ++i) { o0[i] = 0.f; o1[i] = 0.f; }
        kv_pipeline<true>(F, F.lds + LDS_RA, ts, ntile, [&](int i, const LAS unsigned char* tb) {
#pragma unroll
            for (int kh = 0; kh < 2; ++kh) {
                const int k0 = 64 * (kt_lo + i) + 32 * kh;
                if (k0 > t0w + 31 || k0 + 31 <= t0w - 512) continue;
                f32x16 sc = qk32(tb, kh, r32, h, qf);
                if (!(k0 + 31 <= t0w && k0 > t0w + 31 - 512)) {
#pragma unroll
                    for (int e = 0; e < 16; ++e) { const int key = k0 + (e & 3) + 8 * (e >> 2) + 4 * h; sc[e] = (key <= t && key > t - 512) ? sc[e] : NEG; }
                }
                float ps = 0.f;
#pragma unroll
                for (int e = 0; e < 16; ++e) { sc[e] = fexp2(sc[e]); ps += sc[e]; }
                lsum += ps;
                pv32(tb, kh, r32, h, sc, o0, o1);
            }
        });
        bool redo; { const float Lq = xor32_sum(lsum); LAS int* WFLAG = (LAS int*)(F.lds + LDS_QCNT + 16);
          if (!(Lq > 5.4e-20f && Lq < 1.8e19f)) WFLAG[0] = 1;
          __syncthreads();
          redo = (WFLAG[0] != 0) || (FORCE_REDO != 0); }
        if (redo) {
        lsum = 0.f;
#pragma unroll
        for (int i = 0; i < 16; ++i) { o0[i] = 0.f; o1[i] = 0.f; }
        kv_pipeline<true>(F, F.lds + LDS_RA, ts, ntile, [&](int i, const LAS unsigned char* tb) {
#pragma unroll
            for (int kh = 0; kh < 2; ++kh) {
                const int k0 = 64 * (kt_lo + i) + 32 * kh;
                if (k0 > t0w + 31 || k0 + 31 <= t0w - 512) continue;
                f32x16 sc = qk32(tb, kh, r32, h, qf);
                float tm = NEG;
                if (!(k0 + 31 <= t0w && k0 > t0w + 31 - 512)) {
#pragma unroll
                    for (int e = 0; e < 16; ++e) { const int key = k0 + (e & 3) + 8 * (e >> 2) + 4 * h; sc[e] = (key <= t && key > t - 512) ? sc[e] : NEG; }
                }
#pragma unroll
                for (int e = 0; e < 16; ++e) tm = fmaxf(tm, sc[e]);
                tm = xor32_max(tm);
                const float mn = fmaxf(m, tm); const float ms = (mn > NEG) ? mn : 0.f;
                const float alpha = fexp2((m - ms) * AL2E); float ps = 0.f;
#pragma unroll
                for (int e = 0; e < 16; ++e) { sc[e] = fexp2((sc[e] - ms) * AL2E); ps += sc[e]; }
                lsum = lsum * alpha + ps; m = mn;
                if (__any(alpha != 1.0f)) {
#pragma unroll
                    for (int e = 0; e < 16; ++e) { o0[e] *= alpha; o1[e] *= alpha; }
                }
                pv32(tb, kh, r32, h, sc, o0, o1);
            }
        });
        }
        const float Lw = xor32_sum(lsum); const float gw = g2 / fmaxf(Lw, 1e-30f);
        const float gc = g0 * inv_c;
#pragma unroll
        for (int e = 0; e < 16; ++e) { oc0[e] = gc * oc0[e] + gw * o0[e]; oc1[e] = gc * oc1[e] + gw * o1[e]; }
        bf16_t* op = oatt + trow * 1024 + (hkv * 4 + gq) * 64;
#pragma unroll
        for (int g4 = 0; g4 < 4; ++g4) { const int d = 8 * g4 + 4 * h; u32x2 w0, w1;
            w0.x = pk2(oc0[4 * g4], oc0[4 * g4 + 1]); w0.y = pk2(oc0[4 * g4 + 2], oc0[4 * g4 + 3]); w1.x = pk2(oc1[4 * g4], oc1[4 * g4 + 1]); w1.y = pk2(oc1[4 * g4 + 2], oc1[4 * g4 + 3]);
            *(u32x2*)(op + d) = w0; *(u32x2*)(op + 32 + d) = w1; }
    }
    const int cur = qb; const bool dense = (cur + 1 <= 16);
    float mf = NEG, lf = 0.f;
    {
        const int nfb = dense ? (cur + 1) : 3;
        TileSrc ts{kfs + (size_t)bh * 64 * SEQ, 4096, 0, vts + (size_t)bh * 64 * SEQ, 4096, 0};
#pragma unroll
        for (int e = 0; e < 16; ++e) { oc0[e] = 0.f; oc1[e] = 0.f; }
        auto dense_fn = [&](int i, const LAS unsigned char* tb) {
            const int j = dense ? i : (i == 0 ? 0 : cur - 2 + i);
#pragma unroll
            for (int kh = 0; kh < 2; ++kh) {
                const int k0 = 64 * j + 32 * kh;
                if (k0 > 64 * qb + 32 * qh + 31) continue;
                f32x16 sc = qk32(tb, kh, r32, h, qf);
                float tm = NEG;
                if (k0 + 31 > 64 * qb + 32 * qh) {
#pragma unroll
                    for (int e = 0; e < 16; ++e) { const int key = k0 + (e & 3) + 8 * (e >> 2) + 4 * h; sc[e] = (key <= t) ? sc[e] : NEG; }
                }
#pragma unroll
                for (int e = 0; e < 16; ++e) tm = fmaxf(tm, sc[e]);
                tm = xor32_max(tm);
                const float mn = fmaxf(mf, tm); const float ms = (mn > NEG) ? mn : 0.f;
                const float alpha = fexp2((mf - ms) * AL2E); float ps = 0.f;
#pragma unroll
                for (int e = 0; e < 16; ++e) { sc[e] = fexp2((sc[e] - ms) * AL2E); ps += sc[e]; }
                lf = lf * alpha + ps; mf = mn;
                if (__any(alpha != 1.0f)) {
#pragma unroll
                    for (int e = 0; e < 16; ++e) { oc0[e] *= alpha; oc1[e] *= alpha; }
                }
                pv32(tb, kh, r32, h, sc, oc0, oc1);
            }
        };
        auto dense_map = [&](int i) -> int { return dense ? i : (i == 0 ? 0 : cur - 2 + i); };
        kv_pipeline<true, decltype(dense_fn)&, decltype(dense_map), true>(F, F.lds + LDS_RA, ts, nfb, dense_fn, dense_map);
        lf = xor32_sum(lf);
#pragma unroll
        for (int g4 = 0; g4 < 4; ++g4) { *(f32x4*)(park + 4 * g4) = (f32x4){oc0[4 * g4], oc0[4 * g4 + 1], oc0[4 * g4 + 2], oc0[4 * g4 + 3]}; *(f32x4*)(park + 16 + 4 * g4) = (f32x4){oc1[4 * g4], oc1[4 * g4 + 1], oc1[4 * g4 + 2], oc1[4 * g4 + 3]}; }
    }
    {
        const int c16 = lane & 15, kq = lane >> 4, hd = c16 & 3, qs = c16 >> 2;
        LAS unsigned char* QT = F.lds + LDS_QT; LAS unsigned char* QL = F.lds + LDS_QL + w * 64; LAS int* MREF = (LAS int*)(F.lds + LDS_MREF); LAS unsigned* LS = (LAS unsigned*)(F.lds + LDS_LS);
        LAS int* OS = (LAS int*)(F.lds + LDS_RB);
        LAS int* QCNT = (LAS int*)(F.lds + LDS_QCNT); LAS int* FLAGW = (LAS int*)(F.lds + LDS_QCNT + 12);
        bool exact = false;
        const int nsp = dense ? 0 : (cur - 2);
        if (nsp > 0) {
        { const int row = F.tid >> 1, half = F.tid & 1, q = row >> 2, hh = row & 3;
          const bf16_t* src = proj + (size_t)(b * SEQ + 64 * qb + q) * PW + C_Q + (hkv * 4 + hh) * 64 + 32 * half;
          const u32x4 v0 = *(const u32x4*)src, v1 = *(const u32x4*)(src + 8), v2 = *(const u32x4*)(src + 16), v3 = *(const u32x4*)(src + 24);
          LAS u32x4* d = (LAS u32x4*)(QT + row * QT_ROW + 64 * half); d[0] = v0; d[1] = v1; d[2] = v2; d[3] = v3; }
        for (int i = F.tid; i < 64 * OS_QS; i += 512) OS[i] = 0;
        if (F.tid < 256) LS[F.tid] = 0u;
        if (h == 0) MREF[ql * 4 + gq] = __float_as_int(mf);
        if (F.tid < 2) QCNT[F.tid] = 0;
        if (F.tid == 2) FLAGW[0] = 0;
        __syncthreads();
        const bf16_t* Ksb = kfs + (size_t)bh * 64 * SEQ + lane * 8;
        const bf16_t* Vsb = vts + (size_t)bh * 64 * SEQ + lane * 8;
        auto ticket = [&](LAS int* cnt) -> int { int tk = 0; if (lane == 0) tk = __hip_atomic_fetch_add(cnt, 1, __ATOMIC_RELAXED, __HIP_MEMORY_SCOPE_WORKGROUP); return __builtin_amdgcn_readfirstlane(tk); };
        auto load_k = [&](int j, bf16x8 (&kf)[4][2]) {
#pragma unroll
            for (int rt = 0; rt < 4; ++rt)
#pragma unroll
                for (int ks = 0; ks < 2; ++ks) kf[rt][ks] = *(const bf16x8*)(Ksb + (size_t)j * 4096 + 512 * (2 * rt + ks)); };
        auto load_v = [&](int j, bf16x8 (&vf)[4][2]) {
#pragma unroll
            for (int dt = 0; dt < 4; ++dt)
#pragma unroll
                for (int sp = 0; sp < 2; ++sp) vf[dt][sp] = *(const bf16x8*)(Vsb + (size_t)j * 4096 + 512 * (2 * dt + sp)); };
        auto make_list = [&](int j, int& nj) -> int {
            const unsigned byte = WM[(lane >> 3) * 256 + j]; const bool act = (byte >> (lane & 7)) & 1u;
            const unsigned long long bal = __ballot(act); nj = __popcll(bal);
            const int rank = __builtin_amdgcn_mbcnt_hi((unsigned)(bal >> 32), __builtin_amdgcn_mbcnt_lo((unsigned)bal, 0u));
            if (act) QL[rank] = (unsigned char)lane;
            asm volatile("s_waitcnt lgkmcnt(0)" ::: "memory");
            return (nj + 3) >> 2; };
        auto col_query = [&](int tl, int nj, bool& valid) -> int { const int idx = 4 * tl + qs; valid = idx < nj; return (int)QL[valid ? idx : 0]; };
        auto scores = [&](const bf16x8 (&kf)[4][2], int q, bool valid, f32x4 (&st)[4]) {
            const LAS unsigned char* qp = QT + (q * 4 + hd) * QT_ROW + 16 * kq;
            const bf16x8 q0 = *(const LAS bf16x8*)qp, q1 = *(const LAS bf16x8*)(qp + 64);
#pragma unroll
            for (int rt = 0; rt < 4; ++rt) { st[rt] = (f32x4){0.f, 0.f, 0.f, 0.f}; st[rt] = MFMA16(kf[rt][0], q0, st[rt]); st[rt] = MFMA16(kf[rt][1], q1, st[rt]); }
            if (!valid) {
#pragma unroll
                for (int rt = 0; rt < 4; ++rt) st[rt] = (f32x4){NEG, NEG, NEG, NEG};
            } };
        auto run_pass2 = [&](const bool FAST) {
            bf16x8 kf[4][2], kn[4][2], vf[4][2], vn[4][2];
            int t0 = ticket(QCNT + 1), t1;
            { const int j0 = t0 < nsp ? t0 : nsp - 1; load_k(1 + j0, kn); load_v(1 + j0, vn); }
            while (t0 < nsp) {
                asm volatile("s_waitcnt vmcnt(0)" ::: "memory");
#pragma unroll
                for (int rt = 0; rt < 4; ++rt)
#pragma unroll
                    for (int ks = 0; ks < 2; ++ks) { kf[rt][ks] = kn[rt][ks]; vf[rt][ks] = vn[rt][ks]; }
#pragma unroll
                for (int rt = 0; rt < 4; ++rt)
#pragma unroll
                    for (int ks = 0; ks < 2; ++ks) { asm volatile("" : "+v"(kf[rt][ks])); asm volatile("" : "+v"(vf[rt][ks])); }
                t1 = ticket(QCNT + 1);
                { const int j1 = t1 < nsp ? t1 : nsp - 1; load_k(1 + j1, kn); load_v(1 + j1, vn); }
                int nj; const int ntl = make_list(1 + t0, nj);
                for (int tl = 0; tl < ntl; ++tl) {
                    bool valid; const int q = col_query(tl, nj, valid);
                    f32x4 st[4]; scores(kf, q, valid, st);
                    float mr;
                    if (FAST) mr = __int_as_float(MREF[q * 4 + hd]);
                    else { const int key = MREF[q * 4 + hd]; const int ib = key >= 0 ? key : (key ^ 0x7fffffff); mr = __int_as_float(ib); mr = (mr > NEG) ? mr : 0.f; }
                    float ps = 0.f; mr -= os_e2;
#pragma unroll
                    for (int rt = 0; rt < 4; ++rt)
#pragma unroll
                        for (int e = 0; e < 4; ++e) { st[rt][e] = fexp2((st[rt][e] - mr) * AL2E); ps += st[rt][e]; }
                    ps = xor32_sum(xor16_sum(ps));
                    if (FAST) { if (ps > 218.0f * os_scale) FLAGW[0] = 1; }
                    f32x4 o[4];
#pragma unroll
                    for (int dt = 0; dt < 4; ++dt) o[dt] = (f32x4){0.f, 0.f, 0.f, 0.f};
#pragma unroll
                    for (int sp = 0; sp < 2; ++sp) {
                        u32x4 pw; pw.x = pk2(st[2 * sp][0], st[2 * sp][1]); pw.y = pk2(st[2 * sp][2], st[2 * sp][3]); pw.z = pk2(st[2 * sp + 1][0], st[2 * sp + 1][1]); pw.w = pk2(st[2 * sp + 1][2], st[2 * sp + 1][3]);
                        const bf16x8 pb = __builtin_bit_cast(bf16x8, pw);
#pragma unroll
                        for (int dt = 0; dt < 4; ++dt) o[dt] = MFMA16(vf[dt][sp], pb, o[dt]);
                    }
                    if (valid) {
                        LAS int* op = OS + q * OS_QS + hd * OS_HS + 4 * kq;
#pragma unroll
                        for (int dt = 0; dt < 4; ++dt)
#pragma unroll
                            for (int e = 0; e < 4; ++e) __hip_atomic_fetch_add(op + 16 * dt + e, (int)o[dt][e], __ATOMIC_RELAXED, __HIP_MEMORY_SCOPE_WORKGROUP);
                        if (kq == 0) __hip_atomic_fetch_add(LS + q * 4 + hd, (unsigned)(ps * ls_scale + 0.5f), __ATOMIC_RELAXED, __HIP_MEMORY_SCOPE_WORKGROUP);
                    }
                }
                t0 = t1;
            }
            asm volatile("s_waitcnt vmcnt(0)" ::: "memory");
        };
        for (int rep2_ = 0; rep2_ < REP_B3; ++rep2_) {
            if (rep2_ > 0) { __syncthreads(); if (F.tid == 0) QCNT[1] = 0; __syncthreads(); }
            run_pass2(true);
        }
        __syncthreads();
        exact = (FLAGW[0] != 0) || (REP_B2 > 1);
        if (exact) {
            __syncthreads();
            for (int i = F.tid; i < 64 * OS_QS; i += 512) OS[i] = 0;
            if (F.tid < 256) { MREF[F.tid] = (int)0x80000000; LS[F.tid] = 0u; }
            if (F.tid < 2) QCNT[F.tid] = 0;
            __syncthreads();
            {
                bf16x8 kf[4][2], kn[4][2], kn2[4][2];
                int t0 = ticket(QCNT), t1 = ticket(QCNT), t2;
                if (t0 < nsp) load_k(1 + t0, kf);
                if (t1 < nsp) load_k(1 + t1, kn);
                while (t0 < nsp) {
                    t2 = ticket(QCNT);
                    if (t2 < nsp) load_k(1 + t2, kn2);
                    int nj; const int ntl = make_list(1 + t0, nj);
                    for (int tl = 0; tl < ntl; ++tl) {
                        bool valid; const int q = col_query(tl, nj, valid);
                        f32x4 st[4]; scores(kf, q, valid, st);
                        float bm = NEG;
#pragma unroll
                        for (int rt = 0; rt < 4; ++rt)
#pragma unroll
                            for (int e = 0; e < 4; ++e) bm = fmaxf(bm, st[rt][e]);
                        bm = xor32_max(xor16_max(bm));
                        if (valid && kq == 0) { const int ib = __float_as_int(bm); const int key = ib >= 0 ? ib : (ib ^ 0x7fffffff);
                            __hip_atomic_fetch_max(MREF + q * 4 + hd, key, __ATOMIC_RELAXED, __HIP_MEMORY_SCOPE_WORKGROUP); }
                    }
#pragma unroll
                    for (int rt = 0; rt < 4; ++rt)
#pragma unroll
                        for (int ks = 0; ks < 2; ++ks) { kf[rt][ks] = kn[rt][ks]; kn[rt][ks] = kn2[rt][ks]; }
                    t0 = t1; t1 = t2;
                }
            }
            __syncthreads();
            run_pass2(false);
            __syncthreads();
        }
        }
        {
            float ms_ = NEG, ls_ = 0.f;
            if (nsp > 0) { const int key = MREF[ql * 4 + gq]; const int ib = key >= 0 ? key : (key ^ 0x7fffffff); const float m0 = exact ? __int_as_float(ib) : mf;
                if ((!exact || key != (int)0x80000000) && m0 > NEG) { ms_ = m0; ls_ = (float)LS[ql * 4 + gq] * (1.0f / 1048576.0f); } }
            const float Mx = fmaxf(mf, ms_);
            const float wf = fexp2((mf - Mx) * AL2E), ws_ = (ms_ > NEG) ? fexp2((ms_ - Mx) * AL2E) : 0.f;
            const float Lt = lf * wf + ls_ * ws_;
            const float g1 = sigmoidf_(bf2f(grow[1])) / fmaxf(Lt, 1e-30f);
            const float cf = g1 * wf, cs = g1 * ws_ * os_inv;
            const LAS int* ap = OS + ql * OS_QS + gq * OS_HS; float osq = 0.f;
            bf16_t* op = oatt + trow * 1024 + (hkv * 4 + gq) * 64;
#pragma unroll
            for (int g4 = 0; g4 < 4; ++g4) { const int d = 8 * g4 + 4 * h;
                const u32x2 p0 = *(const u32x2*)(op + d), p1 = *(const u32x2*)(op + 32 + d);
                const f32x4 f0 = *(const f32x4*)(park + 4 * g4), f1 = *(const f32x4*)(park + 16 + 4 * g4);
                float s0[4], s1[4];
#pragma unroll
                for (int e = 0; e < 4; ++e) { s0[e] = (nsp > 0) ? (float)ap[d + e] : 0.f; s1[e] = (nsp > 0) ? (float)ap[32 + d + e] : 0.f; }
                u32x2 w0, w1;
                w0.x = pk2(bflo(p0.x) + cf * f0[0] + cs * s0[0], bfhi(p0.x) + cf * f0[1] + cs * s0[1]); w0.y = pk2(bflo(p0.y) + cf * f0[2] + cs * s0[2], bfhi(p0.y) + cf * f0[3] + cs * s0[3]);
                w1.x = pk2(bflo(p1.x) + cf * f1[0] + cs * s1[0], bfhi(p1.x) + cf * f1[1] + cs * s1[1]); w1.y = pk2(bflo(p1.y) + cf * f1[2] + cs * s1[2], bfhi(p1.y) + cf * f1[3] + cs * s1[3]);
                *(u32x2*)(op + d) = w0; *(u32x2*)(op + 32 + d) = w1;
                osq += (bflo(w0.x) * bflo(w0.x) + bfhi(w0.x) * bfhi(w0.x)) + (bflo(w0.y) * bflo(w0.y) + bfhi(w0.y) * bfhi(w0.y)) + (bflo(w1.x) * bflo(w1.x) + bfhi(w1.x) * bfhi(w1.x)) + (bflo(w1.y) * bflo(w1.y) + bfhi(w1.y) * bfhi(w1.y)); }
            (void)__hip_atomic_fetch_add(sst + trow * 2, (unsigned long long)(osq * 16777216.f), __ATOMIC_RELAXED, __HIP_MEMORY_SCOPE_AGENT);
        }
    }
    __syncthreads();
}

DI void attn_phase(Frame& F, const bf16_t* proj, const bf16_t* kcb, const bf16_t* vctb, const bf16_t* vts, const bf16_t* vtw, bf16_t* oatt, const unsigned* vmax_word, float* park, unsigned* qctr, const bf16_t* kfs, unsigned long long* sst) {
    const float vmaxf = fmaxf(__uint_as_float(__hip_atomic_load(vmax_word, __ATOMIC_RELAXED, __HIP_MEMORY_SCOPE_AGENT)), 1e-20f);
    int e2 = (int)floorf(log2f(2.0e9f / (1100.0f * 55.0f * vmaxf)));
    e2 = e2 > 100 ? 100 : (e2 < -100 ? -100 : e2);
    const float os_scale = exp2f((float)e2), os_inv = exp2f((float)-e2);
    LAS int* QW = (LAS int*)(F.lds + LDS_QCNT + 8);
    int xq; { unsigned xx; asm volatile("s_getreg_b32 %0, hwreg(20, 0, 4)" : "=s"(xx)); xq = (int)(xx & 7u); }
    for (int tries = 0; tries < 8; ) {
        __syncthreads();
        if (F.tid == 0) QW[0] = (int)__hip_atomic_fetch_add(qctr + xq, 1u, __ATOMIC_RELAXED, __HIP_MEMORY_SCOPE_AGENT);
        __syncthreads();
        const int k = __builtin_amdgcn_readfirstlane(QW[0]);
        if (k >= 192) { xq = (xq + 1) & 7; ++tries; continue; }
        int bh, qb;
        if (xq < 6) { bh = xq; qb = 4 * (63 - k / 3) + (2 - k % 3); }
        else { bh = 3 * (xq - 6) + (k >> 6); qb = 4 * (63 - (k & 63)) + 3; }
        attn_unit(F, proj, kcb, vctb, vts, vtw, oatt, bh, qb, os_scale, os_inv, (float)e2, park + (size_t)F.bid * 16384 + (size_t)F.tid * 32, kfs, sst);
    }
    __syncthreads();
}


#define XB_TMO      128
#define XB_XCNT(j)  (256  + 64 * (j))
#define XB_XSUB(j)  (1280 + 64 * (j))
#define XB_XGEN(j)  (2304 + 64 * (j))
#define XB_TOP      3328
#define XB_TOPGEN   3392
#define XCD_BAR_WORDS 3456
#define XB_SPIN_CAP (1u << 22)
DI unsigned xb_ld(unsigned* p)              { return __hip_atomic_load(p, __ATOMIC_RELAXED, __HIP_MEMORY_SCOPE_AGENT); }
DI unsigned xb_add(unsigned* p, unsigned v) { return __hip_atomic_fetch_add(p, v, __ATOMIC_RELAXED, __HIP_MEMORY_SCOPE_AGENT); }
DI unsigned xb_xcc_id() { unsigned x; asm volatile("s_getreg_b32 %0, hwreg(20, 0, 4)" : "=s"(x)); return x & 0xFu; }
#define XB_SPIN(cond, bar) do { unsigned _sp = 0; while (cond) { __builtin_amdgcn_s_sleep(1); \
    if ((++_sp & 255u) == 0u) { if (xb_ld(&(bar)[XB_TMO])) break; if (_sp > XB_SPIN_CAP) { atomicAdd(&(bar)[XB_TMO], 1u); break; } } } } while (0)
DI void xcd_barrier_complete(unsigned* bar, unsigned x, unsigned& nloc, unsigned& nx) {
    const unsigned G = gridDim.x * gridDim.y * gridDim.z;
    unsigned sum, cnt, mine, sp = 0u;
    for (;;) {
        sum = 0u; cnt = 0u; mine = 0u;
#pragma unroll
        for (unsigned j = 0; j < 16; ++j) { const unsigned c = xb_ld(&bar[XB_XCNT(j)]); sum += c; cnt += (c > 0u) ? 1u : 0u; mine = (j == x) ? c : mine; }
        if (sum == G) break;
        __builtin_amdgcn_s_sleep(1);
        if ((++sp & 255u) == 0u) { if (xb_ld(&bar[XB_TMO])) break; if (sp > XB_SPIN_CAP) { atomicAdd(&bar[XB_TMO], 1u); break; } }
    }
    nloc = mine > 0u ? mine : 1u; nx = cnt > 0u ? cnt : 1u;
}
DI void xcd_barrier(unsigned* bar, volatile LAS unsigned* st, int tid) {
    asm volatile("s_waitcnt vmcnt(0)" ::: "memory");
    __syncthreads();
    if (tid == 0) {
        const unsigned x = xb_xcc_id();
        __builtin_amdgcn_s_waitcnt(0);
        unsigned nloc = st[0], nx = st[1];
        if (nloc == 0u) { xcd_barrier_complete(bar, x, nloc, nx); st[0] = nloc; st[1] = nx; }
        const unsigned old = xb_add(&bar[XB_XSUB(x)], 1u);
        const unsigned gen = old / nloc;
        if (old + 1u == (gen + 1u) * nloc) {
            __builtin_amdgcn_fence(__ATOMIC_RELEASE, "agent");
            asm volatile("s_waitcnt vmcnt(0)" ::: "memory");
            const unsigned og = xb_add(&bar[XB_TOP], 1u);
            const unsigned tg = og / nx;
            if (og + 1u == (tg + 1u) * nx) xb_add(&bar[XB_TOPGEN], 1u);
            else XB_SPIN(xb_ld(&bar[XB_TOPGEN]) == tg, bar);
            __builtin_amdgcn_fence(__ATOMIC_ACQUIRE, "agent");
            xb_add(&bar[XB_XGEN(x)], 1u);
            asm volatile("s_waitcnt vmcnt(0)" ::: "memory");
        } else {
            XB_SPIN(xb_ld(&bar[XB_XGEN(x)]) == gen, bar);
            __builtin_amdgcn_fence(__ATOMIC_ACQUIRE, "agent");
            asm volatile("s_waitcnt vmcnt(0)" ::: "memory");
        }
    }
    __syncthreads();
}

#define REFRESH() do { int w_ = wave0, b_ = blockIdx.x, g_ = gridDim.x; asm volatile("" : "+s"(w_), "+s"(b_), "+s"(g_)); \
    int l_; asm volatile("v_mbcnt_lo_u32_b32 %0, -1, 0\n\tv_mbcnt_hi_u32_b32 %0, -1, %0" : "=v"(l_)); \
    F.lane = l_; F.wave = w_; F.tid = w_ * 64 + l_; F.bid = b_; F.G = g_; F.gw = b_ * 8 + w_; F.ngw = g_ * 8; } while (0)
#define XBAR() xcd_barrier((unsigned*)(F.wsp() + WS_CTL), (volatile LAS unsigned*)(F.lds + LDS_PT + 232), F.tid)
#if REP_SYNC > 1
#define GSYNC() do { XBAR(); XBAR(); REFRESH(); } while (0)
#else
#define GSYNC() do { REFRESH(); XBAR(); REFRESH(); } while (0)
#endif
#define WSP(off) (F.wsp() + (off))
#define WL(off) (F.wsp() + WS_W + (size_t)l * WL_STRIDE + (off))
#define MSL(off) (F.wsp() + WS_MISC + (size_t)l * MS_L + (off))
#define CTL(off) (F.wsp() + WS_CTL + CT_BASE + (size_t)l * CT_L + (off))
__global__ void __launch_bounds__(512, 2) mk_fwd(Params p) {
    extern __shared__ __attribute__((aligned(16))) unsigned char lds_raw[];
    cg::grid_group grid = cg::this_grid();
    Frame F;
    F.lds = (LAS unsigned char*)lds_raw; F.pt = (LAS const unsigned long long*)(F.lds + LDS_PT);
    const int wave0 = __builtin_amdgcn_readfirstlane((int)threadIdx.x >> 6);
    REFRESH();
    {
        LAS unsigned long long* ptw = (LAS unsigned long long*)(F.lds + LDS_PT);
        if (F.tid < 26) ptw[F.tid] = (unsigned long long)p.in[F.tid];
        if (F.tid == 26) ptw[26] = (unsigned long long)p.out;
        if (F.tid == 27) ptw[27] = (unsigned long long)p.ws;
        if (F.tid == 28) ptw[29] = 0ull;
        if (F.tid == 0) (void)xb_add((unsigned*)p.ws + XB_XCNT(xb_xcc_id()), 1u);
    }
    __syncthreads();

    PH(2, convert_rows_stats(F, F.in(0), (bf16_t*)WSP(WS_ACT), (unsigned long long*)WSP(WS_SSX)); REFRESH(););
    { unsigned long long* z = (unsigned long long*)WSP(WS_SSX) + (size_t)NT * 2; for (int i = F.bid * 512 + F.tid; i < (NL - 1) * NT * 2; i += F.G * 512) z[i] = 0ull; }
    { unsigned long long* z = (unsigned long long*)WSP(WS_SST); for (int i = F.bid * 512 + F.tid; i < NL * NT * 2; i += F.G * 512) z[i] = 0ull; }
    PH(0, prologue_a(F, 0, F.gw, F.ngw); REFRESH(););
    if (F.G == 0x7fffffff) grid.sync();
    GSYNC();
    PH(1, prologue_b(F); REFRESH(););
    if (F.G != 256) { prologue_a(F, 1, F.gw, F.ngw); __syncthreads(); REFRESH(); }
    else if (F.bid >= 128) { prologue_a(F, 1, (F.bid - 128) * 8 + F.wave, 1024); __syncthreads(); REFRESH(); }

#if STAGE >= 2
#pragma unroll 1
    for (int l = 0; l < NL; ++l) {
        REFRESH();
        { pg8::APlain g{(l == 0) ? (const char*)WSP(WS_ACT) : (const char*)F.out(), (const char*)WL(WO_WIN), 1024}; pg8::StaticOrder S; S.init(NT / 256, PW / 256, F.G, F.bid);
          pg8::EpiBf16 E{(bf16_t*)WSP(WS_PROJ), PW, (const unsigned long long*)WSP(WS_SSX) + (size_t)l * NT * 2}; pg8::gemm_phase<pg8::EpiBf16, pg8::APlain, true>(F.lds, g, S, E, F.tid); }
#if REP_INPROJ > 1
        REFRESH();
        { pg8::APlain g{(l == 0) ? (const char*)WSP(WS_ACT) : (const char*)F.out(), (const char*)WL(WO_WIN), 1024}; pg8::StaticOrder S; S.init(NT / 256, PW / 256, F.G, F.bid);
          pg8::EpiBf16 E{(bf16_t*)WSP(WS_PROJ), PW, (const unsigned long long*)WSP(WS_SSX) + (size_t)l * NT * 2}; pg8::gemm_phase<pg8::EpiBf16, pg8::APlain, true>(F.lds, g, S, E, F.tid); }
#endif
        GSYNC();
#define LOCAL_HANDOFF() do { asm volatile("s_waitcnt vmcnt(0)" ::: "memory"); __syncthreads(); if (F.tid == 0) { __builtin_amdgcn_fence(__ATOMIC_ACQUIRE, "agent"); asm volatile("s_waitcnt vmcnt(0)" ::: "memory"); } __syncthreads(); } while (0)
        if (F.G == 256) {
            if (F.bid < 48) {
                REFRESH();
                { pg8::ACompress g{(const char*)WSP(WS_PROJ), (const char*)WL(WO_W1)}; pg8::StaticOrder S; S.init_run(F.bid, 0, 1);
                  pg8::EpiCmpHid E{(bf16_t*)WSP(WS_HIDC), (const float*)CTL(CT_CB1)}; pg8::gemm_phase<pg8::EpiCmpHid, pg8::ACompress, true>(F.lds, g, S, E, F.tid); }
                REFRESH(); LOCAL_HANDOFF(); REFRESH();
                { const int pm = F.bid, it = (pm / 24) * 192 + (pm % 24) * 8 + F.wave;
                  compress2_phase(F, (const bf16_t*)WSP(WS_HIDC), (const bf16_t*)CTL(CT_W2T), F.in(7) + (size_t)l * 2 * 64, (bf16_t*)WSP(WS_KC), (bf16_t*)WSP(WS_VCT), it, it + 1, 1); }
            } else if (F.bid < 80) {
                REFRESH();
                { pg8::ASsm1 g{(const char*)WSP(WS_UC), (const char*)WL(WO_SS1)}; pg8::StaticOrder S; S.init_run((F.bid - 48) * 4, 1, 4);
                  pg8::EpiSsm1 E{(float*)WSP(WS_YI), (float*)WSP(WS_HL)}; pg8::gemm_phase<pg8::EpiSsm1, pg8::ASsm1, true>(F.lds, g, S, E, F.tid); }
                REFRESH(); LOCAL_HANDOFF(); REFRESH();
                ssm_carry_phase(F, (const float*)WSP(WS_HL), (const f32x2*)CTL(CT_AB16), (const f32x2*)CTL(CT_AB1K), (bf16_t*)WSP(WS_HIN), F.bid - 48, F.bid - 47, 1);
            } else {
                REFRESH();
                vtranspose_phase(F, (const bf16_t*)WSP(WS_PROJ), (bf16_t*)WSP(WS_VTS), (bf16_t*)WSP(WS_VTW), (bf16_t*)WSP(WS_KFS), (unsigned*)WSP(WS_CTL) + 3584 + l, 80);
                __syncthreads(); REFRESH();
                { pg8::ASsm1 g{(const char*)WSP(WS_UC), (const char*)WL(WO_SS1)}; pg8::StaticOrder S; S.init(128, 1, 176, F.bid - 80);
                  pg8::EpiSsm1 E{(float*)WSP(WS_YI), (float*)WSP(WS_HL)}; pg8::gemm_phase<pg8::EpiSsm1, pg8::ASsm1, true>(F.lds, g, S, E, F.tid); }
            }
            GSYNC();
        } else {
        PH(3, REFRESH(); vtranspose_phase(F, (const bf16_t*)WSP(WS_PROJ), (bf16_t*)WSP(WS_VTS), (bf16_t*)WSP(WS_VTW), (bf16_t*)WSP(WS_KFS), (unsigned*)WSP(WS_CTL) + 3584 + l, 48);
        __syncthreads(); REFRESH(););
        PH(4, REFRESH();
        { pg8::ACompress g{(const char*)WSP(WS_PROJ), (const char*)WL(WO_W1)}; pg8::StaticOrder S; S.init(48, 1, F.G, F.bid);
          pg8::EpiCmpHid E{(bf16_t*)WSP(WS_HIDC), (const float*)CTL(CT_CB1)}; pg8::gemm_phase<pg8::EpiCmpHid, pg8::ACompress, true>(F.lds, g, S, E, F.tid); });
        PH(5, REFRESH();
        { pg8::ASsm1 g{(const char*)WSP(WS_UC), (const char*)WL(WO_SS1)}; pg8::StaticOrder S; S.init(128, 2, F.G, F.bid);
          pg8::EpiSsm1 E{(float*)WSP(WS_YI), (float*)WSP(WS_HL)}; pg8::gemm_phase<pg8::EpiSsm1, pg8::ASsm1, true>(F.lds, g, S, E, F.tid); });
        GSYNC();
        PH(6, compress2_phase(F, (const bf16_t*)WSP(WS_HIDC), (const bf16_t*)CTL(CT_W2T), F.in(7) + (size_t)l * 2 * 64, (bf16_t*)WSP(WS_KC), (bf16_t*)WSP(WS_VCT), F.gw, 2 * 192, F.ngw);
        __syncthreads(); REFRESH(););
        PH(7, ssm_carry_phase(F, (const float*)WSP(WS_HL), (const f32x2*)CTL(CT_AB16), (const f32x2*)CTL(CT_AB1K), (bf16_t*)WSP(WS_HIN), F.bid, 32, F.G); REFRESH(););
        GSYNC();
        }
        PH(8,         REFRESH();
        { pg8::ASsm2 g{(const char*)WSP(WS_HIN), (const char*)WL(WO_SS2)}; pg8::StaticOrder S; S.init(128, 1, F.G, F.bid);
          pg8::EpiSsm2 E{(const float*)WSP(WS_YI), (const bf16_t*)WSP(WS_PROJ), F.in(15) + (size_t)l * 256, (bf16_t*)WSP(WS_YS2)}; pg8::gemm_phase<pg8::EpiSsm2, pg8::ASsm2, true>(F.lds, g, S, E, F.tid); });
#if STAGE >= 3
        REFRESH();
        attn_phase(F, (const bf16_t*)WSP(WS_PROJ), (const bf16_t*)WSP(WS_KC), (const bf16_t*)WSP(WS_VCT), (const bf16_t*)WSP(WS_VTS), (const bf16_t*)WSP(WS_VTW), (bf16_t*)WSP(WS_OATT), (const unsigned*)WSP(WS_CTL) + 3584 + l, (float*)WSP(WS_PARK), (unsigned*)WSP(WS_CTL) + 3600 + 16 * l, (const bf16_t*)WSP(WS_KFS), (unsigned long long*)WSP(WS_SST) + (size_t)l * NT * 2);
#if REP_ATTN > 1
        REFRESH();
        attn_phase(F, (const bf16_t*)WSP(WS_PROJ), (const bf16_t*)WSP(WS_KC), (const bf16_t*)WSP(WS_VCT), (const bf16_t*)WSP(WS_VTS), (const bf16_t*)WSP(WS_VTW), (bf16_t*)WSP(WS_OATT), (const unsigned*)WSP(WS_CTL) + 3584 + l, (float*)WSP(WS_PARK), (unsigned*)WSP(WS_CTL) + 3600 + 16 * l, (const bf16_t*)WSP(WS_KFS), (unsigned long long*)WSP(WS_SST) + (size_t)l * NT * 2);
#endif
#else
        { unsigned* oz = (unsigned*)WSP(WS_OATT); for (size_t i = (size_t)F.bid * 512 + F.tid; i < (size_t)NT * 768 / 2; i += (size_t)F.G * 512) oz[i] = 0u; }
#endif
        GSYNC();
        PH(9,         REFRESH();
        { pg8::APlain g{(const char*)WSP(WS_YS2), (const char*)MSL(MS_WGLU), 256}; pg8::StaticOrder S; S.init(NT / 256, 2, F.G, F.bid);
          pg8::EpiGlu E{(bf16_t*)WSP(WS_OATT), F.in(17) + (size_t)l * 512, (unsigned long long*)WSP(WS_SST) + (size_t)l * NT * 2}; pg8::gemm_phase<pg8::EpiGlu, pg8::APlain, true>(F.lds, g, S, E, F.tid); });
        GSYNC();
        REFRESH();
        { pg8::APlain g{(const char*)WSP(WS_OATT), (const char*)WL(WO_WOUT), 1024}; pg8::StaticOrder S; S.init(NT / 256, 4, F.G, F.bid);
          pg8::EpiResB<true, 0> E{(l == 0) ? F.in(0) : (const float*)nullptr, (const bf16_t*)F.out(), (bf16_t*)F.out(), (const unsigned long long*)WSP(WS_SST) + (size_t)l * NT * 2, (unsigned long long*)nullptr}; pg8::gemm_phase<pg8::EpiResB<true, 0>, pg8::APlain, true>(F.lds, g, S, E, F.tid); }
        GSYNC();
#if STAGE >= 4
        PH(11, rmsnorm_rows_xb<1>(F, (const bf16_t*)F.out(), F.in(21) + (size_t)l * DM, WSP(WS_ACT)); REFRESH(););
        GSYNC();
        REFRESH();
        { pg8::APlain g{(const char*)WSP(WS_ACT), (const char*)WL(WO_WGU), 512, 0x7c7c7c7c, 0x7c7c7c7c}; pg8::StaticOrder S; S.init(NT / 256, 22, F.G, F.bid);
          pg8::EpiSwiglu8 E{(unsigned char*)WSP(WS_PROJ), 0.015625f * FP8FIX}; pg8::gemm_phase<pg8::EpiSwiglu8, pg8::APlain, true, true>(F.lds, g, S, E, F.tid); }
        GSYNC();
        REFRESH();
        { pg8::APlain g{(const char*)WSP(WS_PROJ), (const char*)WL(WO_WD), DFF / 2, 0x7b7b7b7b, 0x7b7b7b7b}; pg8::StaticOrder S; S.init(NT / 256, 4, F.G, F.bid);
          pg8::EpiResB<false, 8> E{(const float*)nullptr, (const bf16_t*)F.out(), (l == NL - 1) ? (bf16_t*)WSP(WS_XLAST) : (bf16_t*)F.out(), (const unsigned long long*)nullptr, (l == NL - 1) ? (unsigned long long*)nullptr : (unsigned long long*)WSP(WS_SSX) + (size_t)(l + 1) * NT * 2}; pg8::gemm_phase<pg8::EpiResB<false, 8>, pg8::APlain, true, true>(F.lds, g, S, E, F.tid); }
        GSYNC();
#endif
#if STAGE < 5
        break;
#endif
    }
    rmsnorm_rows_xb<2>(F, (const bf16_t*)WSP(WS_XLAST), F.in(25), F.out());
#else
    {
        const float* x0 = F.in(0); const float* fg = F.in(25); float* X = F.out();
        for (int m = F.gw; m < NT; m += F.ngw) {
            const f32x4* xr = (const f32x4*)(x0 + (size_t)m * DM) + F.lane; f32x4 v[4]; float s = 0.f;
#pragma unroll
            for (int j = 0; j < 4; ++j) { v[j] = xr[64 * j]; s += (v[j].x * v[j].x + v[j].y * v[j].y) + (v[j].z * v[j].z + v[j].w * v[j].w); }
            const float rstd = rsqrtf(wave_sum(s) * (1.f / DM) + 1e-6f);
            f32x4* o = (f32x4*)(X + (size_t)m * DM) + F.lane;
#pragma unroll
            for (int j = 0; j < 4; ++j) o[64 * j] = v[j] * rstd * ((const f32x4*)fg)[64 * j + F.lane];
        }
    }
#endif
}

extern "C" void kernel_launch(void* const* d_in, const int* in_sizes, int n_in, void* d_out, int out_size, void* d_ws, size_t ws_size, hipStream_t stream) {
    static int grid_blocks = 0;
    if (grid_blocks == 0) {
        if (n_in != 26 || ws_size < WS_END) { fprintf(stderr, "kernel_launch: unexpected n_in %d or ws_size %zu (< %zu)\n", n_in, ws_size, (size_t)WS_END); grid_blocks = -1; return; }
        int dev = 0, cus = 0, per_cu = 0;
        hipGetDevice(&dev);
        hipDeviceGetAttribute(&cus, hipDeviceAttributeMultiprocessorCount, dev);
        hipFuncSetAttribute((const void*)mk_fwd, hipFuncAttributeMaxDynamicSharedMemorySize, LDS_BYTES);
        hipOccupancyMaxActiveBlocksPerMultiprocessor(&per_cu, (const void*)mk_fwd, 512, LDS_BYTES);
        if (per_cu < 1) { fprintf(stderr, "kernel_launch: occupancy query says %d blocks per CU\n", per_cu); per_cu = 1; }
        grid_blocks = cus;
        (void)hipGetLastError();
    }
    if (grid_blocks < 0) return;
    if (hipMemsetAsync((char*)d_ws + WS_CTL, 0, 16384, stream) != hipSuccess) { fprintf(stderr, "kernel_launch: memset of the barrier words failed\n"); return; }
    Params p{};
    for (int i = 0; i < 26; ++i) p.in[i] = (const float*)d_in[i];
    p.out = (float*)d_out; p.ws = (unsigned char*)d_ws;
    void* args[] = {&p};
    hipError_t e = hipLaunchCooperativeKernel((const void*)mk_fwd, dim3(grid_blocks), dim3(512), args, LDS_BYTES, stream);
    if (e != hipSuccess) fprintf(stderr, "cooperative launch failed: %s (grid %d)\n", hipGetErrorString(e), grid_blocks);
}
```

```cpp
#include <hip/hip_runtime.h>
#include <hip/hip_cooperative_groups.h>
#include <cstdio>
#include <cstdint>
namespace cg = cooperative_groups;

#ifndef STAGE
#define STAGE 99
#endif
#ifndef REP_ATTN
#define REP_ATTN 1
#endif
#ifndef REP_B1
#define REP_B1 1
#endif
#ifndef REP_B2
#define REP_B2 1
#endif
#ifndef REP_B3
#define REP_B3 1
#endif
#ifndef REP_TK
#define REP_TK 1
#endif
#ifndef FP8FIX
#define FP8FIX 1.0f
#endif
#ifndef PROBE_DUP
#define PROBE_DUP 0
#endif
#define PH(bit, ...) do { __VA_ARGS__ if (PROBE_DUP & (1 << (bit))) { __VA_ARGS__ } } while (0)
#ifndef FORCE_REDO
#define FORCE_REDO 0
#endif
#ifndef REP_GU
#define REP_GU 1
#endif
#ifndef REP_INPROJ
#define REP_INPROJ 1
#endif
#ifndef REP_SYNC
#define REP_SYNC 1
#endif

#define DI __device__ __forceinline__
#define LAS __attribute__((address_space(3)))
typedef unsigned short bf16_t;
typedef short bf16x8 __attribute__((ext_vector_type(8)));
typedef short s16x4 __attribute__((ext_vector_type(4)));
typedef float f32x4 __attribute__((ext_vector_type(4)));
typedef float f32x2 __attribute__((ext_vector_type(2)));
typedef float f32x16 __attribute__((ext_vector_type(16)));
typedef unsigned u32x4 __attribute__((ext_vector_type(4)));
typedef unsigned u32x2 __attribute__((ext_vector_type(2)));
typedef __bf16 bf2_t __attribute__((ext_vector_type(2)));
typedef int i32x8 __attribute__((ext_vector_type(8)));
typedef int i32x4 __attribute__((ext_vector_type(4)));

DI float clamp8(float v) { return fminf(fmaxf(v, -440.f), 440.f); }
DI unsigned pk4_fp8(float a, float b, float c, float d) { int w = 0; w = __builtin_amdgcn_cvt_pk_fp8_f32(clamp8(a), clamp8(b), w, false); w = __builtin_amdgcn_cvt_pk_fp8_f32(clamp8(c), clamp8(d), w, true); return (unsigned)w; }
DI unsigned pk2(float lo, float hi) { f32x2 v = {lo, hi}; return __builtin_bit_cast(unsigned, __builtin_convertvector(v, bf2_t)); }
DI bf16_t f2bf(float f) { return (bf16_t)(pk2(f, 0.f) & 0xffffu); }
DI float bf2f(bf16_t u) { return __uint_as_float((unsigned)u << 16); }
DI float bflo(unsigned w) { return __uint_as_float(w << 16); }
DI float bfhi(unsigned w) { return __uint_as_float(w & 0xffff0000u); }
DI float fexp2(float x) { return __builtin_amdgcn_exp2f(x); }
DI float sigmoidf_(float x) { return __builtin_amdgcn_rcpf(1.0f + __builtin_amdgcn_exp2f(-1.4426950408889634f * x)); }
DI float gelu_tanh(float x) { const float y = 0.7978845608028654f * (x + 0.044715f * x * x * x); return x * __builtin_amdgcn_rcpf(1.0f + __builtin_amdgcn_exp2f(-2.8853900817779268f * y)); }
template <int CTRL> DI float dppf(float v) { return __builtin_bit_cast(float, __builtin_amdgcn_update_dpp(0, __builtin_bit_cast(int, v), CTRL, 0xF, 0xF, false)); }
struct F2 { float lo, hi; };
DI F2 halves32(float v) { const auto r = __builtin_amdgcn_permlane32_swap(__float_as_uint(v), __float_as_uint(v), false, false); return {__uint_as_float(r[0]), __uint_as_float(r[1])}; }
DI F2 rows16(float v) { const auto r = __builtin_amdgcn_permlane16_swap(__float_as_uint(v), __float_as_uint(v), false, false); return {__uint_as_float(r[0]), __uint_as_float(r[1])}; }
DI float xor32_sum(float v) { const F2 p = halves32(v); return p.lo + p.hi; }
DI float xor32_max(float v) { const F2 p = halves32(v); return fmaxf(p.lo, p.hi); }
DI float xor16_sum(float v) { const F2 p = rows16(v); return p.lo + p.hi; }
DI float xor16_max(float v) { const F2 p = rows16(v); return fmaxf(p.lo, p.hi); }
DI float wave_sum(float v) {
    v += dppf<0xB1>(v); v += dppf<0x4E>(v); v += dppf<0x141>(v); v += dppf<0x140>(v);
    return xor32_sum(xor16_sum(v));
}

DI unsigned wave_max_u32(unsigned v) {
    v = max(v, (unsigned)__builtin_amdgcn_update_dpp(0, (int)v, 0xB1, 0xF, 0xF, false));
    v = max(v, (unsigned)__builtin_amdgcn_update_dpp(0, (int)v, 0x4E, 0xF, 0xF, false));
    v = max(v, (unsigned)__builtin_amdgcn_update_dpp(0, (int)v, 0x141, 0xF, 0xF, false));
    v = max(v, (unsigned)__builtin_amdgcn_update_dpp(0, (int)v, 0x140, 0xF, 0xF, false));
    const unsigned a = __builtin_amdgcn_readlane(v, 0), b = __builtin_amdgcn_readlane(v, 16), c = __builtin_amdgcn_readlane(v, 32), d = __builtin_amdgcn_readlane(v, 48);
    return max(max(a, b), max(c, d));
}

constexpr int NB = 2, SEQ = 16384, DM = 1024, NT = NB * SEQ, NL = 2;
constexpr int PW = 2304;
constexpr int C_Q = 0, C_KC = 768, C_VC = 960, C_KS = 1152, C_VS = 1344, C_KW = 1536, C_VW = 1728, C_U = 1920, C_G = 2176;
constexpr int DFF = 2816;
constexpr float L2E = 1.4426950408889634f;

constexpr size_t MiB = 1u << 20;
constexpr size_t WS_CTL = 0;
constexpr size_t WS_W = 1 * MiB;
constexpr size_t WL_STRIDE = 32 * MiB;
constexpr size_t WO_WIN = 0;
constexpr size_t WO_WOUT = 5 * MiB;
constexpr size_t WO_WGU = 7 * MiB;
constexpr size_t WO_WD = 18 * MiB;
constexpr size_t WO_W1 = 24 * MiB;
constexpr size_t WO_SS1 = 26 * MiB;
constexpr size_t WO_SS2 = 30 * MiB;
constexpr size_t CT_L = 256 * 1024;
constexpr size_t CT_BASE = 64 * 1024;
constexpr size_t CT_AB16 = 0;
constexpr size_t CT_AB1K = 8 * 1024;
constexpr size_t CT_CB1 = 16 * 1024;
constexpr size_t CT_W2T = 20 * 1024;
constexpr size_t CT_WGLU = 84 * 1024;
constexpr size_t WS_ACT = WS_W + 2 * WL_STRIDE;
constexpr size_t WS_PROJ = WS_ACT + 64 * MiB;
constexpr size_t WS_OATT = WS_PROJ + 176 * MiB;
constexpr size_t WS_OSSM = WS_OATT + 48 * MiB;
constexpr size_t WS_YS2 = WS_OSSM + 16 * MiB;
constexpr size_t WS_YI = WS_ACT;
constexpr size_t WS_HL = WS_YS2 + 16 * MiB;
constexpr size_t WS_HIN = WS_HL + 16 * MiB;
constexpr size_t WS_VTS = WS_HIN + 16 * MiB;
constexpr size_t WS_VTW = WS_VTS + 12 * MiB;
constexpr size_t WS_KC = WS_VTW + 12 * MiB;
constexpr size_t WS_VCT = WS_KC + 1 * MiB;
constexpr size_t WS_HIDC = WS_VCT + 1 * MiB;
constexpr size_t WS_MISC = WS_HIDC + 6 * MiB;
constexpr size_t WS_PARK = WS_MISC + 4 * MiB;
constexpr size_t WS_KFS = WS_PARK + 16 * MiB;
constexpr size_t WS_SST = WS_KFS + 12 * MiB;
constexpr size_t WS_SSX = WS_SST + 1 * MiB;
constexpr size_t WS_UC = WS_SSX + 1 * MiB;
constexpr size_t WS_END = WS_UC + 16 * MiB;
constexpr size_t WS_XLAST = WS_PROJ + 96 * MiB;
constexpr size_t MS_L = 2 * MiB;
constexpr size_t MS_MTAB = 0;
constexpr size_t MS_CBP = 256 * 1024;
constexpr size_t MS_WGLU = 512 * 1024;
constexpr size_t MS_BBAR = 1024 * 1024;
constexpr size_t MS_FTAB = 1024 * 1024 + 128 * 1024;

constexpr int LDS_BYTES = 143360;

struct Params { const float* in[26]; float* out; unsigned char* ws; };

namespace pg8 {
constexpr int BM = 256, BK = 64, HALF = 128, HTB = HALF * BK * 2, STAGE_BYTES = 8 * HTB, NXCD = 8, WGM = 8;
__host__ __device__ __forceinline__ int lds_byte(int r, int c) { const int st = (r >> 4) * 2 + (c >> 5), rr = r & 15, cc = c & 31, ob = rr * 64 + cc * 2; return st * 1024 + (ob ^ (((ob >> 9) & 1) << 5)); }
__host__ __device__ __forceinline__ void stage_rc(int b, int& R, int& C) { const int st = b / 1024, sb = b % 1024, swz = sb ^ (((sb >> 9) & 1) << 5); R = (st >> 1) * 16 + swz / 64; C = (st & 1) * 32 + (swz % 64) / 2; }
__host__ __device__ __forceinline__ int perm32(int rho) { const int n = rho >> 4, i = rho & 15; return 8 * (i >> 2) + 4 * n + (i & 3); }
struct Unit { int pm, pn, part; };
constexpr int ROWTAB_OFF = STAGE_BYTES;
struct StaticOrder {
    int nM, nN, nwg, G, c, lmode = 0, lbase = 0, lpn = 0, lcount = 0;
    __device__ void init(int nM_, int nN_, int G_, int c_) { nM = nM_; nN = nN_; nwg = nM * nN; G = G_; c = c_; lmode = 0; }
    __device__ void init_run(int base, int pn, int count) { lmode = 1; lbase = base; lpn = pn; lcount = count; nM = 0; nN = 0; nwg = 0; G = 1; c = 0; }
    __device__ bool next(int i, Unit& u) const {
        if (lmode == 1) { if (i >= lcount) return false; u.pm = lbase + i; u.pn = lpn; return true; }
        const long L = (long)i * G + c; if (L >= nwg) return false;
        int wgid = (int)L; { const int q = nwg / NXCD, r = nwg % NXCD, xcd = wgid % NXCD, off = wgid / NXCD; wgid = (xcd < r ? xcd * (q + 1) : r * (q + 1) + (xcd - r) * q) + off; }
        const int nig = WGM * nN, gid = wgid / nig, fm = gid * WGM, gsz = (nM - fm) < WGM ? (nM - fm) : WGM;
        u.pm = fm + ((wgid % nig) % gsz); u.pn = (wgid % nig) / gsz; return true;
    }
};

template <class Epi, class Addr, bool ALIGN_EPI, bool FP8 = false>
__device__ __forceinline__ void gemm_phase(LAS unsigned char* lds, const Addr& g, const StaticOrder& S, const Epi& E, int tid) {
    asm volatile("" : "+v"(tid));
    const int wid = __builtin_amdgcn_readfirstlane(tid >> 6), lane = tid & 63, wr = wid >> 2, wc = wid & 3, fr = lane & 15, fq = lane >> 4;
    const int K = g.K(), nt0 = K / BK;
    unsigned voffA[2], voffB[2];
#pragma unroll
    for (int i = 0; i < 2; ++i) { int R, C; stage_rc(tid * 16 + i * 8192, R, C); const int Rb = Epi::PERM ? ((R & ~31) + perm32(R & 31)) : R;
        voffA[i] = (unsigned)R * g.a_row_bytes() + g.a_col_off(C); voffB[i] = (unsigned)(Rb * K + C) * 2u; }
    const size_t kstepA = g.a_kstep(), kstepB = (size_t)(BK * 2);
    const size_t hstepA = (size_t)HALF * g.a_row_bytes(), hstepB = (size_t)HALF * K * 2;
    const unsigned ldsw = (unsigned)wid * 1024u;
    const int aoff = lds_byte(wr * 64 + fr, fq * 8), boff = lds_byte(wc * 32 + fr, fq * 8);
#define PG8_SA(b, h) (((b) * 2 + (h)) * HTB)
#define PG8_SB(b, h) ((4 + (b) * 2 + (h)) * HTB)
#define PG8_STAGE(bufoff, gbase, voff) do { _Pragma("unroll") for (int _i = 0; _i < 2; ++_i) \
        __builtin_amdgcn_global_load_lds((const unsigned*)((const char*)(gbase) + (voff)[_i]), (LAS unsigned*)(lds + (bufoff) + ldsw + _i * 8192), 16, 0, 0); } while (0)
#define PG8_LDA(dst, b, h) do { _Pragma("unroll") for (int m = 0; m < 4; ++m) _Pragma("unroll") for (int k = 0; k < 2; ++k) dst[m][k] = *(const LAS bf16x8*)(lds + PG8_SA(b, h) + aoff + m * 2048 + k * 1024); } while (0)
#define PG8_LDB(dst, b, h) do { _Pragma("unroll") for (int n = 0; n < 2; ++n) _Pragma("unroll") for (int k = 0; k < 2; ++k) dst[n][k] = *(const LAS bf16x8*)(lds + PG8_SB(b, h) + boff + n * 2048 + k * 1024); } while (0)
#define PG8_CAT(x, y) __builtin_bit_cast(i32x8, __builtin_shufflevector((x), (y), 0, 1, 2, 3, 4, 5, 6, 7, 8, 9, 10, 11, 12, 13, 14, 15))
#define PG8_MMA(ai, bj, At, Bt) do { __builtin_amdgcn_s_setprio(1); _Pragma("unroll") for (int m = 0; m < 4; ++m) _Pragma("unroll") for (int n = 0; n < 2; ++n) { \
        if constexpr (FP8) { const i32x8 bw_ = PG8_CAT(Bt[n][0], Bt[n][1]), aw_ = PG8_CAT(At[m][0], At[m][1]); \
            asm volatile("v_mfma_f32_16x16x128_f8f6f4 %0, %1, %2, %0" : "+v"(acc[ai][bj][m][n]) : "v"(bw_), "v"(aw_));   } \
        else { _Pragma("unroll") for (int k = 0; k < 2; ++k) acc[ai][bj][m][n] = __builtin_amdgcn_mfma_f32_16x16x32_bf16(Bt[n][k], At[m][k], acc[ai][bj][m][n], 0, 0, 0); } } \
        __builtin_amdgcn_s_setprio(0); } while (0)
#define PG8_WAIT_V(n) asm volatile("s_waitcnt vmcnt(" #n ")" ::: "memory")
#define PG8_WAIT_L(n) asm volatile("s_waitcnt lgkmcnt(" #n ")" ::: "memory")
#define PG8_BAR __builtin_amdgcn_s_barrier()
#define PG8_SCHED __builtin_amdgcn_sched_barrier(0)
    Unit cur, nxt; int ui = 0;
    constexpr bool SPLIT = Epi::MID_T > 0;
    auto get_unit = [&](int i, Unit& u) -> bool { if constexpr (SPLIT) { const bool ok = S.next(i >> 1, u); u.part = i & 1; return ok; } else { const bool ok = S.next(i, u); u.part = 0; return ok; } };
    auto part_off = [&](const Unit& u) -> size_t { if constexpr (SPLIT) return (size_t)u.part * (Epi::MID_T * BK * 2); else return 0; };
    if (!get_unit(0, cur)) return;
    f32x4 acc[2][2][4][2];
#pragma unroll
    for (int a = 0; a < 2; ++a)
#pragma unroll
        for (int b = 0; b < 2; ++b)
#pragma unroll
            for (int m = 0; m < 4; ++m)
#pragma unroll
                for (int n = 0; n < 2; ++n) acc[a][b][m][n] = (f32x4){0.f, 0.f, 0.f, 0.f};
    bf16x8 At[4][2], B0[2][2], B1[2][2];
    const char* cA = g.a_base(cur) + part_off(cur); const char* cB = g.b_base(cur) + part_off(cur);
    PG8_STAGE(PG8_SB(0, 0), cB, voffB); PG8_STAGE(PG8_SB(0, 1), cB + hstepB, voffB); PG8_STAGE(PG8_SA(0, 0), cA, voffA); PG8_STAGE(PG8_SA(0, 1), cA + hstepA, voffA);
    if (wr == 1) PG8_BAR;
    PG8_WAIT_V(2); PG8_BAR;
    PG8_STAGE(PG8_SB(1, 0), cB + kstepB, voffB); PG8_STAGE(PG8_SA(1, 0), cA + kstepA, voffA); PG8_STAGE(PG8_SB(1, 1), cB + hstepB + kstepB, voffB);
    PG8_WAIT_V(6); PG8_BAR;
    for (;;) {
        const bool has_next = get_unit(ui + 1, nxt);
        const char* nA = has_next ? g.a_base(nxt) + part_off(nxt) : cA; const char* nB = has_next ? g.b_base(nxt) + part_off(nxt) : cB;
        int nt = nt0; if constexpr (SPLIT) nt = cur.part ? nt0 - Epi::MID_T : Epi::MID_T;
        for (int t = 0; t < nt; t += 2) {
            const bool last = (t == nt - 2);
            if constexpr (Epi::ROWTAB) {
                if (t == 0 && wid < 4 && cur.part == 0) {
                    int l_; asm volatile("v_mbcnt_lo_u32_b32 %0, -1, 0\n\tv_mbcnt_hi_u32_b32 %0, -1, %0" : "=v"(l_));
                    __builtin_amdgcn_global_load_lds((const unsigned*)(E.rowtab + ((size_t)cur.pm * BM + wid * 64 + l_) * 2), (LAS unsigned*)(lds + ROWTAB_OFF + ((SPLIT ? (ui >> 1) : ui) & 1) * 4096 + wid * 1024), 16, 0, 0); } }
            const char* a1 = cA + (size_t)(t + 1) * kstepA;
            const char* a2 = last ? nA : cA + (size_t)(t + 2) * kstepA; const char* b2 = last ? nB : cB + (size_t)(t + 2) * kstepB;
            const char* a3 = a2 + kstepA; const char* b3 = b2 + kstepB;
            PG8_LDB(B0, 0, 0); PG8_LDB(B1, 0, 1); PG8_SCHED; PG8_LDA(At, 0, 0); PG8_STAGE(PG8_SA(1, 1), a1 + hstepA, voffA);
            PG8_WAIT_V(8); PG8_WAIT_L(0); PG8_BAR; PG8_MMA(0, 0, At, B0); PG8_MMA(0, 1, At, B1); PG8_BAR; PG8_SCHED;
            PG8_LDA(At, 0, 1); PG8_STAGE(PG8_SB(0, 0), b2, voffB); PG8_STAGE(PG8_SB(0, 1), b2 + hstepB, voffB); PG8_STAGE(PG8_SA(0, 0), a2, voffA);
            PG8_WAIT_V(8); PG8_WAIT_L(0); PG8_BAR; PG8_MMA(1, 0, At, B0); PG8_MMA(1, 1, At, B1); PG8_BAR; PG8_SCHED;
            PG8_LDB(B0, 1, 0); PG8_LDB(B1, 1, 1); PG8_SCHED; PG8_LDA(At, 1, 0); PG8_STAGE(PG8_SA(0, 1), a2 + hstepA, voffA);
            PG8_WAIT_V(8); PG8_WAIT_L(0); PG8_BAR; PG8_MMA(0, 0, At, B0); PG8_MMA(0, 1, At, B1); PG8_BAR; PG8_SCHED;
            PG8_LDA(At, 1, 1); PG8_STAGE(PG8_SB(1, 0), b3, voffB); PG8_STAGE(PG8_SB(1, 1), b3 + hstepB, voffB); PG8_STAGE(PG8_SA(1, 0), a3, voffA);
            PG8_WAIT_V(8); PG8_WAIT_L(0); PG8_BAR; PG8_MMA(1, 0, At, B0); PG8_MMA(1, 1, At, B1); PG8_BAR; PG8_SCHED;
        }
        if constexpr (ALIGN_EPI) { if (wr == 0) PG8_BAR; }
        if constexpr (FP8) asm volatile("s_nop 15\n\ts_nop 15" ::: "memory");
        { int le_; asm volatile("v_mbcnt_lo_u32_b32 %0, -1, 0\n\tv_mbcnt_hi_u32_b32 %0, -1, %0" : "=v"(le_)); const int fr_e = le_ & 15, fq_e = le_ >> 4;
          if constexpr (Epi::ROWTAB) {
              const LAS unsigned long long* tab = (const LAS unsigned long long*)(lds + ROWTAB_OFF + ((SPLIT ? (ui >> 1) : ui) & 1) * 4096);
              if (SPLIT && cur.part == 0) {
                  const LAS unsigned long long* tb = tab + (wr * 64 + fr_e) * 2;
#pragma unroll
                  for (int a = 0; a < 2; ++a)
#pragma unroll
                      for (int m = 0; m < 4; ++m) { const float ratio = Epi::row_ratio(tb[(a * HALF + m * 16) * 2], tb[(a * HALF + m * 16) * 2 + 1]);
#pragma unroll
                          for (int b = 0; b < 2; ++b)
#pragma unroll
                              for (int n = 0; n < 2; ++n) acc[a][b][m][n] = acc[a][b][m][n] * ratio; }
              } else E(acc, cur, wr, wc, fr_e, fq_e, tab);
          } else E(acc, cur, wr, wc, fr_e, fq_e); }
        if (!has_next) break;
        if (!SPLIT || cur.part != 0) {
#pragma unroll
        for (int a = 0; a < 2; ++a)
#pragma unroll
            for (int b = 0; b < 2; ++b)
#pragma unroll
                for (int m = 0; m < 4; ++m)
#pragma unroll
                    for (int n = 0; n < 2; ++n) acc[a][b][m][n] = (f32x4){0.f, 0.f, 0.f, 0.f};
        }
        cur = nxt; cA = nA; cB = nB; ++ui;
        if constexpr (ALIGN_EPI) { if (wr == 1) PG8_BAR; }
    }
    PG8_WAIT_V(0);
    if constexpr (!ALIGN_EPI) { if (wr == 0) PG8_BAR; }
    PG8_BAR;
#undef PG8_SA
#undef PG8_SB
#undef PG8_STAGE
#undef PG8_LDA
#undef PG8_LDB
#undef PG8_MMA
#undef PG8_CAT
#undef PG8_WAIT_V
#undef PG8_WAIT_L
#undef PG8_BAR
#undef PG8_SCHED
}

struct APlain {
    const char* A; const char* Bt; int k; int sw = 0x7f7f7f7f, sa = 0x7f7f7f7f;
    DI int scale_w() const { return sw; } DI int scale_a() const { return sa; }
    DI int K() const { return k; }
    DI unsigned a_row_bytes() const { return (unsigned)k * 2u; }
    DI unsigned a_kstep() const { return 128u; }
    DI unsigned a_col_off(int C) const { return (unsigned)C * 2u; }
    DI const char* a_base(const Unit& u) const { return A + (size_t)u.pm * 256 * k * 2; }
    DI const char* b_base(const Unit& u) const { return Bt + (size_t)u.pn * 256 * k * 2; }
};
struct ACompress {
    const char* proj; const char* w1t;
    DI int scale_w() const { return 0x7f7f7f7f; } DI int scale_a() const { return 0x7f7f7f7f; }
    DI int K() const { return 2048; }
    DI unsigned a_row_bytes() const { return 16u * PW * 2u; }
    DI unsigned a_kstep() const { return (unsigned)PW * 2u; }
    DI unsigned a_col_off(int C) const { return (unsigned)C * 2u; }
    DI const char* a_base(const Unit& u) const { const int kv = u.pm / 24, r = u.pm % 24, bh = r >> 2, qt = r & 3, b = bh / 3, h = bh % 3;
        return proj + ((size_t)(b * SEQ + 4096 * qt) * PW + (kv ? C_VC : C_KC) + h * 64) * 2; }
    DI const char* b_base(const Unit& u) const { return w1t + (size_t)(u.pm / 24) * 256 * 2048 * 2; }
};
struct ASsm1 {
    const char* uc; const char* ss1;
    DI int scale_w() const { return 0x7f7f7f7f; } DI int scale_a() const { return 0x7f7f7f7f; }
    DI int K() const { return 256; }
    DI unsigned a_row_bytes() const { return 512u; }
    DI unsigned a_kstep() const { return 128u; }
    DI unsigned a_col_off(int C) const { return (unsigned)C * 2u; }
    DI const char* a_base(const Unit& u) const { const int bg = u.pm >> 2, qt = u.pm & 3; return uc + ((size_t)bg * SEQ + 4096 * qt) * 32; }
    DI const char* b_base(const Unit& u) const { const int gi = (u.pm >> 2) & 15; return ss1 + ((size_t)gi * 512 + (size_t)u.pn * 256) * 256 * 2; }
};
struct ASsm2 {
    const char* hin; const char* ss2;
    DI int scale_w() const { return 0x7f7f7f7f; } DI int scale_a() const { return 0x7f7f7f7f; }
    DI int K() const { return 256; }
    DI unsigned a_row_bytes() const { return 512u; }
    DI unsigned a_kstep() const { return 128u; }
    DI unsigned a_col_off(int C) const { return (unsigned)C * 2u; }
    DI const char* a_base(const Unit& u) const { return hin + (size_t)u.pm * 256 * 512; }
    DI const char* b_base(const Unit& u) const { const int gi = (u.pm >> 2) & 15; return ss2 + (size_t)gi * 256 * 256 * 2; }
};

struct EpiBf16 {
    static constexpr bool PERM = true; static constexpr bool ROWTAB = true; static constexpr int MID_T = -1;
    bf16_t* O; int ldc; const unsigned long long* rowtab;
    static DI float row_ratio(unsigned long long, unsigned long long) { return 1.f; }
    DI void operator()(const f32x4 (&acc)[2][2][4][2], const Unit& u, int wr, int wc, int fr, int fq, const LAS unsigned long long* tab) const {
        const int row0 = u.pm * BM + wr * 64 + fr, col0 = u.pn * BM + wc * 32 + 8 * fq;
        const int ubj = (u.pn == C_U / 256) ? 1 : ((u.pn == C_U / 256 + 1) ? 0 : -1);
#pragma unroll
        for (int ai = 0; ai < 2; ++ai)
#pragma unroll
            for (int m = 0; m < 4; ++m) { bf16_t* rowp = O + (size_t)(row0 + ai * HALF + m * 16) * ldc + col0;
                const float sc = rsqrtf((float)tab[(wr * 64 + fr + ai * HALF + m * 16) * 2] * (1.f / (1048576.f * DM)) + 1e-6f);
#pragma unroll
                for (int bj = 0; bj < 2; ++bj) { const f32x4 v0 = acc[ai][bj][m][0] * sc, v1 = acc[ai][bj][m][1] * sc;
                    u32x4 w; w.x = pk2(v0[0], v0[1]); w.y = pk2(v0[2], v0[3]); w.z = pk2(v1[0], v1[1]); w.w = pk2(v1[2], v1[3]);
                    *(u32x4*)(rowp + bj * HALF) = w;
                    if (bj == ubj) { const int row = row0 + ai * HALF + m * 16, ucol = col0 + bj * HALF - C_U;
                        bf16_t* uc = (bf16_t*)((unsigned char*)O + (WS_UC - WS_PROJ));
                        *(u32x4*)(uc + (((size_t)((row >> 14) * 16 + (ucol >> 4)) * SEQ + (row & (SEQ - 1))) * 16 + (ucol & 15))) = w; } } }
    }
};
struct EpiCmpHid {
    static constexpr bool PERM = true; static constexpr bool ROWTAB = false; static constexpr int MID_T = -1;
    bf16_t* O; const float* cb1;
    DI void operator()(const f32x4 (&acc)[2][2][4][2], const Unit& u, int wr, int wc, int fr, int fq) const {
        const int row0 = u.pm * BM + wr * 64 + fr, col0 = wc * 32 + 8 * fq; const float* bb = cb1 + (u.pm / 24) * 256;
        f32x4 bv[2][2];
#pragma unroll
        for (int bj = 0; bj < 2; ++bj)
#pragma unroll
            for (int n = 0; n < 2; ++n) bv[bj][n] = *(const f32x4*)(bb + col0 + bj * HALF + 4 * n);
#pragma unroll
        for (int ai = 0; ai < 2; ++ai)
#pragma unroll
            for (int m = 0; m < 4; ++m) { bf16_t* rowp = O + (size_t)(row0 + ai * HALF + m * 16) * 256 + col0;
#pragma unroll
                for (int bj = 0; bj < 2; ++bj) { f32x4 v0 = acc[ai][bj][m][0] + bv[bj][0], v1 = acc[ai][bj][m][1] + bv[bj][1];
#pragma unroll
                    for (int e = 0; e < 4; ++e) { v0[e] = gelu_tanh(v0[e]); v1[e] = gelu_tanh(v1[e]); }
                    u32x4 w; w.x = pk2(v0[0], v0[1]); w.y = pk2(v0[2], v0[3]); w.z = pk2(v1[0], v1[1]); w.w = pk2(v1[2], v1[3]);
                    *(u32x4*)(rowp + bj * HALF) = w; } }
    }
};
struct EpiSsm1 {
    static constexpr bool PERM = false; static constexpr bool ROWTAB = false; static constexpr int MID_T = -1;
    float* YI; float* HL;
    DI void operator()(const f32x4 (&acc)[2][2][4][2], const Unit& u, int wr, int wc, int fr, int fq) const {
        const int row0 = u.pm * BM + wr * 64 + fr, col0 = wc * 32 + 4 * fq;
#pragma unroll
        for (int ai = 0; ai < 2; ++ai)
#pragma unroll
            for (int m = 0; m < 4; ++m) { const size_t row = (size_t)(row0 + ai * HALF + m * 16);
                if (u.pn == 0) {
#pragma unroll
                    for (int bj = 0; bj < 2; ++bj)
#pragma unroll
                        for (int n = 0; n < 2; ++n) *(f32x4*)(YI + row * 256 + col0 + bj * HALF + n * 16) = acc[ai][bj][m][n];
                } else {
#pragma unroll
                    for (int n = 0; n < 2; ++n) *(f32x4*)(HL + row * 128 + col0 + n * 16) = acc[ai][0][m][n];
                } }
    }
};
struct EpiSsm2 {
    static constexpr bool PERM = false; static constexpr bool ROWTAB = false; static constexpr int MID_T = -1;
    const float* YI; const bf16_t* proj; const float* dskip; bf16_t* YS2;
    DI void operator()(const f32x4 (&acc)[2][2][4][2], const Unit& u, int wr, int wc, int fr, int fq) const {
        const int row0 = u.pm * BM + wr * 64 + fr, col0 = wc * 32 + 4 * fq;
        const int bg = u.pm >> 2, b = bg >> 4, gi = bg & 15;
        const f32x4 dsk = *(const f32x4*)(dskip + gi * 16 + 4 * fq);
#pragma unroll
        for (int ai = 0; ai < 2; ++ai)
#pragma unroll
            for (int m = 0; m < 4; ++m) { const int row = row0 + ai * HALF + m * 16; const int chunk = row & 1023;
#pragma unroll
                for (int bj = 0; bj < 2; ++bj)
#pragma unroll
                    for (int n = 0; n < 2; ++n) { const int col = col0 + bj * HALF + n * 16, tau = col >> 4;
                        const size_t tok = (size_t)b * SEQ + chunk * 16 + tau;
                        const f32x4 yi = *(const f32x4*)(YI + (size_t)row * 256 + col);
                        const u32x2 uw = *(const u32x2*)(proj + tok * PW + C_U + gi * 16 + 4 * fq);
                        f32x4 y = acc[ai][bj][m][n] + yi;
                        y[0] += dsk[0] * bflo(uw.x); y[1] += dsk[1] * bfhi(uw.x); y[2] += dsk[2] * bflo(uw.y); y[3] += dsk[3] * bfhi(uw.y);
                        u32x2 w; w.x = pk2(gelu_tanh(y[0]), gelu_tanh(y[1])); w.y = pk2(gelu_tanh(y[2]), gelu_tanh(y[3]));
                        *(u32x2*)(YS2 + tok * 256 + gi * 16 + 4 * fq) = w; } }
    }
};
struct EpiGlu {
    static constexpr bool PERM = true; static constexpr bool ROWTAB = false; static constexpr int MID_T = -1;
    bf16_t* O; const float* bglu; unsigned long long* sst;
    DI void operator()(const f32x4 (&acc)[2][2][4][2], const Unit& u, int wr, int wc, int fr, int fq) const {
        const int row0 = u.pm * BM + wr * 64 + fr, col0 = u.pn * HALF + wc * 32 + 8 * fq;
        f32x4 bvv[2], bgg[2];
#pragma unroll
        for (int n = 0; n < 2; ++n) { bvv[n] = *(const f32x4*)(bglu + col0 + 4 * n); bgg[n] = *(const f32x4*)(bglu + 256 + col0 + 4 * n); }
#pragma unroll
        for (int ai = 0; ai < 2; ++ai)
#pragma unroll
            for (int m = 0; m < 4; ++m) { const int row = row0 + ai * HALF + m * 16; bf16_t* rowp = O + (size_t)row * 1024 + 768 + col0;
                f32x4 o[2];
#pragma unroll
                for (int n = 0; n < 2; ++n) { const f32x4 v = acc[ai][0][m][n] + bvv[n], gt = acc[ai][1][m][n] + bgg[n];
#pragma unroll
                    for (int e = 0; e < 4; ++e) o[n][e] = v[e] * sigmoidf_(gt[e]); }
                u32x4 w; w.x = pk2(o[0][0], o[0][1]); w.y = pk2(o[0][2], o[0][3]); w.z = pk2(o[1][0], o[1][1]); w.w = pk2(o[1][2], o[1][3]);
                *(u32x4*)rowp = w;
                const f32x4 q = o[0] * o[0] + o[1] * o[1]; const float t = xor32_sum(xor16_sum((q[0] + q[1]) + (q[2] + q[3])));
                if (fq == 0) (void)__hip_atomic_fetch_add(sst + (size_t)row * 2 + 1, (unsigned long long)(t * 16777216.f), __ATOMIC_RELAXED, __HIP_MEMORY_SCOPE_AGENT); }
    }
};
struct EpiSwiglu8 {
    static constexpr bool PERM = true; static constexpr bool ROWTAB = false; static constexpr int MID_T = -1;
    unsigned char* O; float asc;
    DI void operator()(const f32x4 (&acc)[2][2][4][2], const Unit& u, int wr, int wc, int fr, int fq) const {
        const int row0 = u.pm * BM + wr * 64 + fr, col0 = u.pn * HALF + wc * 32 + 8 * fq;
#pragma unroll
        for (int ai = 0; ai < 2; ++ai)
#pragma unroll
            for (int m = 0; m < 4; ++m) { unsigned char* rowp = O + (size_t)(row0 + ai * HALF + m * 16) * DFF + col0;
                f32x4 o[2];
#pragma unroll
                for (int n = 0; n < 2; ++n) { const f32x4 gt = acc[ai][0][m][n] * asc, up = acc[ai][1][m][n] * asc;
#pragma unroll
                    for (int e = 0; e < 4; ++e) o[n][e] = 4.0f * gt[e] * sigmoidf_(gt[e]) * up[e]; }
                u32x2 w; w.x = pk4_fp8(o[0][0], o[0][1], o[0][2], o[0][3]); w.y = pk4_fp8(o[1][0], o[1][1], o[1][2], o[1][3]);
                *(u32x2*)rowp = w; }
    }
};
struct EpiSwiglu {
    static constexpr bool PERM = true; static constexpr bool ROWTAB = false; static constexpr int MID_T = -1;
    bf16_t* O;
    DI void operator()(const f32x4 (&acc)[2][2][4][2], const Unit& u, int wr, int wc, int fr, int fq) const {
        const int row0 = u.pm * BM + wr * 64 + fr, col0 = u.pn * HALF + wc * 32 + 8 * fq;
#pragma unroll
        for (int ai = 0; ai < 2; ++ai)
#pragma unroll
            for (int m = 0; m < 4; ++m) { bf16_t* rowp = O + (size_t)(row0 + ai * HALF + m * 16) * DFF + col0;
                f32x4 o[2];
#pragma unroll
                for (int n = 0; n < 2; ++n) { const f32x4 gt = acc[ai][0][m][n], up = acc[ai][1][m][n];
#pragma unroll
                    for (int e = 0; e < 4; ++e) o[n][e] = gt[e] * sigmoidf_(gt[e]) * up[e]; }
                u32x4 w; w.x = pk2(o[0][0], o[0][1]); w.y = pk2(o[0][2], o[0][3]); w.z = pk2(o[1][0], o[1][1]); w.w = pk2(o[1][2], o[1][3]);
                *(u32x4*)rowp = w; }
    }
};
struct EpiResF32 {
    static constexpr bool PERM = false; static constexpr bool ROWTAB = false; static constexpr int MID_T = -1;
    const float* base; float* out; float asc = 1.0f;
    DI void operator()(const f32x4 (&acc)[2][2][4][2], const Unit& u, int wr, int wc, int fr, int fq) const {
        const int row0 = u.pm * BM + wr * 64 + fr, col0 = u.pn * BM + wc * 32 + 4 * fq;
#pragma unroll
        for (int ai = 0; ai < 2; ++ai)
#pragma unroll
            for (int m = 0; m < 4; ++m) { const size_t off = (size_t)(row0 + ai * HALF + m * 16) * DM + col0;
#pragma unroll
                for (int bj = 0; bj < 2; ++bj)
#pragma unroll
                    for (int n = 0; n < 2; ++n) { const f32x4 bs = *(const f32x4*)(base + off + bj * HALF + n * 16);
                        *(f32x4*)(out + off + bj * HALF + n * 16) = bs + acc[ai][bj][m][n] * asc; } }
    }
};
template <bool MID, int ASC_EXP>
struct EpiResB {
    static constexpr bool PERM = true; static constexpr bool ROWTAB = MID; static constexpr int MID_T = MID ? 12 : -1;
    static constexpr float asc = 1.0f / (float)(1 << ASC_EXP);
    const float* basef; const bf16_t* baseb; bf16_t* out; const unsigned long long* rowtab; unsigned long long* ssx;
    static DI float rstd_a(unsigned long long v) { return rsqrtf((float)v * (1.f / (16777216.f * 768.f)) + 1e-6f); }
    static DI float rstd_s(unsigned long long v) { return rsqrtf((float)v * (1.f / (16777216.f * 256.f)) + 1e-6f); }
    static DI float row_ratio(unsigned long long a, unsigned long long s_) { return rstd_a(a) / rstd_s(s_); }
    template <bool F32B>
    DI void run(const f32x4 (&acc)[2][2][4][2], const Unit& u, int wr, int wc, int fr, int fq, const LAS unsigned long long* tab) const {
        const int row0 = u.pm * BM + wr * 64 + fr, col0 = u.pn * BM + wc * 32 + 8 * fq;
#pragma unroll
        for (int ai = 0; ai < 2; ++ai)
#pragma unroll
            for (int m = 0; m < 4; ++m) { const int row = row0 + ai * HALF + m * 16; const size_t off = (size_t)row * DM + col0; float sq = 0.f;
                float sc = asc; if constexpr (MID) sc = asc * rstd_s(tab[(wr * 64 + fr + ai * HALF + m * 16) * 2 + 1]);
#pragma unroll
                for (int bj = 0; bj < 2; ++bj) { f32x4 b0, b1;
                    if constexpr (F32B) { b0 = *(const f32x4*)(basef + off + bj * HALF); b1 = *(const f32x4*)(basef + off + bj * HALF + 4); }
                    else { const u32x4 b = *(const u32x4*)(baseb + off + bj * HALF); b0 = f32x4{bflo(b.x), bfhi(b.x), bflo(b.y), bfhi(b.y)}; b1 = f32x4{bflo(b.z), bfhi(b.z), bflo(b.w), bfhi(b.w)}; }
                    const f32x4 v0 = b0 + acc[ai][bj][m][0] * sc, v1 = b1 + acc[ai][bj][m][1] * sc;
                    u32x4 w; w.x = pk2(v0[0], v0[1]); w.y = pk2(v0[2], v0[3]); w.z = pk2(v1[0], v1[1]); w.w = pk2(v1[2], v1[3]);
                    *(u32x4*)(out + off + bj * HALF) = w;
                    if constexpr (!MID) { const f32x4 q = v0 * v0 + v1 * v1; sq += (q[0] + q[1]) + (q[2] + q[3]); } }
                if constexpr (!MID) { if (ssx != nullptr) { const float t = xor32_sum(xor16_sum(sq));
                    if (fq == 0) (void)__hip_atomic_fetch_add(ssx + (size_t)row * 2, (unsigned long long)(t * 1048576.f), __ATOMIC_RELAXED, __HIP_MEMORY_SCOPE_AGENT); } } }
    }
    DI void operator()(const f32x4 (&acc)[2][2][4][2], const Unit& u, int wr, int wc, int fr, int fq, const LAS unsigned long long* tab = nullptr) const {
        if (basef != nullptr) run<true>(acc, u, wr, wc, fr, fq, tab); else run<false>(acc, u, wr, wc, fr, fq, tab);
    }
};
}

struct Frame {
    LAS unsigned char* lds;
    LAS const unsigned long long* pt;
    int tid, lane, wave, G, gw, ngw, bid;
    DI const float* in(int i) const { const unsigned long long v = pt[i]; const unsigned lo = __builtin_amdgcn_readfirstlane((unsigned)v), hi = __builtin_amdgcn_readfirstlane((unsigned)(v >> 32));
        return (const float*)(const __attribute__((address_space(1))) float*)(((unsigned long long)hi << 32) | lo); }
    DI float* out() const { return (float*)in(26); }
    DI unsigned char* wsp() const { return (unsigned char*)in(27); }
};
constexpr int LDS_PT = LDS_BYTES - 256;

DI void transpose_item(const float* W, int K, int ldw, int nvalid, bf16_t* WT, int drow0, LAS float* scr, int k0, int n0, float scale, int lane, const float* gam64 = nullptr) {
    if (n0 + 32 <= nvalid) {
        const int n4 = (lane & 7) * 4; f32x4 v[8];
#pragma unroll
        for (int i = 0; i < 8; ++i) v[i] = *(const f32x4*)(W + (size_t)(k0 + 8 * i + (lane >> 3)) * ldw + n0 + n4);
        if (gam64 != nullptr) {
#pragma unroll
            for (int i = 0; i < 8; ++i) v[i] = v[i] * gam64[8 * i + (lane >> 3)];
        }
#pragma unroll
        for (int i = 0; i < 8; ++i) { LAS float* s = scr + (8 * i + (lane >> 3)) * 33 + n4; s[0] = v[i].x * scale; s[1] = v[i].y * scale; s[2] = v[i].z * scale; s[3] = v[i].w * scale; }
    } else {
    const int nn = n0 + (lane & 31); const bool ok = nn < nvalid;
#pragma unroll 8
    for (int i = 0; i < 32; ++i) { const int kk = 2 * i + (lane >> 5); scr[kk * 33 + (lane & 31)] = ok ? W[(size_t)(k0 + kk) * ldw + nn] * scale : 0.f; }
    }
    asm volatile("s_waitcnt lgkmcnt(0)" ::: "memory");
    const int c = lane & 7;
#pragma unroll
    for (int j = 0; j < 4; ++j) { const int n = (lane >> 3) + 8 * j; const LAS float* s = scr + (8 * c) * 33 + n;
        u32x4 o; o.x = pk2(s[0 * 33], s[1 * 33]); o.y = pk2(s[2 * 33], s[3 * 33]); o.z = pk2(s[4 * 33], s[5 * 33]); o.w = pk2(s[6 * 33], s[7 * 33]);
        *(u32x4*)(WT + (size_t)(drow0 + n) * K + k0 + 8 * c) = o; }
    asm volatile("s_waitcnt lgkmcnt(0)" ::: "memory");
}

DI void transpose_item_fp8(const float* W, int K, int ldw, unsigned char* WT, int drow0, LAS float* scr, int k0, int n0, float scale, int lane) {
    const int n4 = (lane & 7) * 4; f32x4 v[8];
#pragma unroll
    for (int i = 0; i < 8; ++i) v[i] = *(const f32x4*)(W + (size_t)(k0 + 8 * i + (lane >> 3)) * ldw + n0 + n4);
#pragma unroll
    for (int i = 0; i < 8; ++i) { LAS float* s = scr + (8 * i + (lane >> 3)) * 33 + n4; s[0] = v[i].x * scale; s[1] = v[i].y * scale; s[2] = v[i].z * scale; s[3] = v[i].w * scale; }
    asm volatile("s_waitcnt lgkmcnt(0)" ::: "memory");
    const int c = lane & 7;
#pragma unroll
    for (int j = 0; j < 4; ++j) { const int n = (lane >> 3) + 8 * j; const LAS float* s = scr + (8 * c) * 33 + n;
        u32x2 o; o.x = pk4_fp8(s[0 * 33], s[1 * 33], s[2 * 33], s[3 * 33]); o.y = pk4_fp8(s[4 * 33], s[5 * 33], s[6 * 33], s[7 * 33]);
        *(u32x2*)(WT + (size_t)(drow0 + n) * K + k0 + 8 * c) = o; }
    asm volatile("s_waitcnt lgkmcnt(0)" ::: "memory");
}

DI int win_dest_row(int n) {
    if (n < 1920) return n;
    if (n < 1956) return C_G + (n - 1920);
    return C_U + (n - 1956);
}

DI void prologue_a(Frame& F, int mode, int gw0, int ngw0) {
    LAS float* scr = (LAS float*)(F.lds + F.wave * 16640);
    constexpr int I_WIN = 16 * 72, I_WOUT = 16 * 32, I_WG = 16 * 88, I_WD = 44 * 32, I_W1 = 2 * 32 * 8, I_WGLU = 4 * 16, I_W2 = 2 * 4 * 2, I_CB = 64, I_M = 1024, I_TAB = 16;
    constexpr int PER_L = I_WIN + I_WOUT + 2 * I_WG + I_WD + I_W1 + I_WGLU + I_W2 + I_CB + I_M + I_TAB;
    const int lane = F.lane;
    constexpr int A1 = I_WIN, A3E = I_WIN + I_WOUT + 2 * I_WG + I_WD, A4E = A3E + I_W1, A5E = A4E + I_WGLU;
    for (int it = gw0; it < NL * PER_L; it += ngw0) {
        const int l = it / PER_L; int r = it % PER_L;
        { const bool late = (r >= A1 && r < A3E) || (r >= A4E && r < A5E) || (l > 0 && (r < A1 || (r >= A3E && r < A4E)));
          if (late != (mode == 1)) continue; }
        unsigned char* wl = F.wsp() + WS_W + (size_t)l * WL_STRIDE;
        unsigned char* ms = F.wsp() + WS_MISC + (size_t)l * MS_L;
        unsigned char* ct = F.wsp() + WS_CTL + CT_BASE + (size_t)l * CT_L;
        if (r < I_WIN) {
            const int kb = r / 72, nb = r % 72, k0 = 64 * kb, n0 = 32 * nb;
            const float* W = F.in(2) + (size_t)l * 1024 * 2212;
            bf16_t* WT = (bf16_t*)(wl + WO_WIN);
            const float* gam = F.in(1) + (size_t)l * DM + k0;
            if (n0 + 32 <= 1920) { transpose_item(W, 1024, 2212, 2212, WT, n0, scr, k0, n0, n0 < 768 ? 0.125f * L2E : 1.0f, lane, gam); }
            else {
                const int d = n0 + (lane & 31);
                int srcn = -1;
                if (d < 1920) srcn = d; else if (d >= C_U && d < C_U + 256) srcn = 1956 + (d - C_U); else if (d >= C_G && d < C_G + 36) srcn = 1920 + (d - C_G);
#pragma unroll 8
                for (int i = 0; i < 32; ++i) { const int kk = 2 * i + (lane >> 5); scr[kk * 33 + (lane & 31)] = srcn >= 0 ? W[(size_t)(k0 + kk) * 2212 + srcn] * gam[kk] : 0.f; }
                asm volatile("s_waitcnt lgkmcnt(0)" ::: "memory");
                const int c = lane & 7;
#pragma unroll
                for (int j = 0; j < 4; ++j) { const int n = (lane >> 3) + 8 * j; const LAS float* s = scr + (8 * c) * 33 + n;
                    u32x4 o; o.x = pk2(s[0 * 33], s[1 * 33]); o.y = pk2(s[2 * 33], s[3 * 33]); o.z = pk2(s[4 * 33], s[5 * 33]); o.w = pk2(s[6 * 33], s[7 * 33]);
                    *(u32x4*)(WT + (size_t)(n0 + n) * 1024 + k0 + 8 * c) = o; }
                asm volatile("s_waitcnt lgkmcnt(0)" ::: "memory");
            }
            continue; }
        r -= I_WIN;
        if (r < I_WOUT) { const int kb = r / 32, nb = r % 32;
            transpose_item(F.in(20) + (size_t)l * 1024 * 1024, 1024, 1024, 1024, (bf16_t*)(wl + WO_WOUT), 32 * nb, scr, 64 * kb, 32 * nb, 1.f, lane, kb < 12 ? F.in(18) + (size_t)l * 768 + 64 * kb : F.in(19) + (size_t)l * 256 + 64 * (kb - 12)); continue; }
        r -= I_WOUT;
        if (r < 2 * I_WG) { const int up = r / I_WG; const int rr = r % I_WG; const int kb = rr / 88, nb = rr % 88, n0 = 32 * nb;
            const int drow = (n0 / 128) * 256 + up * 128 + (n0 % 128);
            transpose_item_fp8(F.in(up ? 23 : 22) + (size_t)l * 1024 * DFF, 1024, DFF, (unsigned char*)(wl + WO_WGU), drow, scr, 64 * kb, n0, 64.f, lane); continue; }
        r -= 2 * I_WG;
        if (r < I_WD) { const int kb = r / 32, nb = r % 32; transpose_item_fp8(F.in(24) + (size_t)l * DFF * 1024, DFF, 1024, (unsigned char*)(wl + WO_WD), 32 * nb, scr, 64 * kb, 32 * nb, 64.f, lane); continue; }
        r -= I_WD;
        if (r < I_W1) { const int kv = r / 256; const int rr = r % 256; const int kb = rr / 8, nb = rr % 8;
            transpose_item(F.in(4) + ((size_t)l * 2 + kv) * 2048 * 256, 2048, 256, 256, (bf16_t*)(wl + WO_W1) + (size_t)kv * 256 * 2048, 32 * nb, scr, 64 * kb, 32 * nb, 1.f, lane); continue; }
        r -= I_W1;
        if (r < I_WGLU) { const int kb = r / 16, nb = r % 16, n0 = 32 * nb; const int gate = n0 >= 256, nn = n0 & 255;
            const int drow = (nn / 128) * 256 + gate * 128 + (nn % 128);
            transpose_item(F.in(16) + (size_t)l * 256 * 512, 256, 512, 512, (bf16_t*)(ms + MS_WGLU), drow, scr, 64 * kb, n0, 1.f, lane); continue; }
        r -= I_WGLU;
        if (r < I_W2) { const int kv = r / 8; const int rr = r % 8; const int kb = rr / 2, nb = rr % 2;
            transpose_item(F.in(6) + ((size_t)l * 2 + kv) * 256 * 64, 256, 64, 64, (bf16_t*)(ct + CT_W2T) + (size_t)kv * 64 * 256, 32 * nb, scr, 64 * kb, 32 * nb, 1.f, lane); continue; }
        r -= I_W2;
        if (r < I_CB) {
            const int kv = r / 32, ch = r % 32; const float* pe = F.in(3) + ((size_t)l * 2 + kv) * 2048; const float* w1 = F.in(4) + ((size_t)l * 2 + kv) * 2048 * 256;
            f32x4 s = {0.f, 0.f, 0.f, 0.f};
#pragma unroll 8
            for (int i = 0; i < 64; ++i) { const int k = 64 * ch + i; const float pv = pe[k]; const f32x4 w = *(const f32x4*)(w1 + (size_t)k * 256 + 4 * lane); s += w * pv; }
            *(f32x4*)((float*)(ms + MS_CBP) + ((size_t)kv * 32 + ch) * 256 + 4 * lane) = s; continue; }
        r -= I_CB;
        if (r < I_M) {
            const int e0 = r * 64; const int gi = e0 >> 12, dl = (e0 >> 8) & 15, cp0 = (e0 >> 4) & 15, n = lane;
            const float dt = __expf(F.in(8)[l * 16 + gi]);
            const float ar = F.in(9)[((size_t)l * 16 + gi) * 64 + n], ai = F.in(10)[((size_t)l * 16 + gi) * 64 + n];
            const float x = dt * ar, y = dt * ai; const float sy = __sinf(y), cy = __cosf(y), sh = __sinf(0.5f * y);
            const float em1 = (fabsf(x) < 0.25f) ? x * (1.f + x * (0.5f + x * (0.16666667f + x * (0.041666668f + x * 0.0083333338f)))) : expm1f(x);
            const float nr = em1 * cy - 2.f * sh * sh; const float abi = (em1 + 1.f) * sy;
            const float den = ar * ar + ai * ai;
            const float fr_ = (nr * ar + abi * ai) / den, fi_ = (abi * ar - nr * ai) / den;
            const float mg = __expf((float)dl * x); const float pr = mg * __cosf((float)dl * y), pi = mg * __sinf((float)dl * y);
            const f32x4* bre = (const f32x4*)(F.in(11) + (((size_t)l * 16 + gi) * 64 + n) * 16); const f32x4* bim = (const f32x4*)(F.in(12) + (((size_t)l * 16 + gi) * 64 + n) * 16);
            float zr[16], zi[16];
#pragma unroll
            for (int q4 = 0; q4 < 4; ++q4) { const f32x4 br = bre[q4], bi = bim[q4];
#pragma unroll
                for (int j = 0; j < 4; ++j) { const float bbr = fr_ * br[j] - fi_ * bi[j], bbi = fr_ * bi[j] + fi_ * br[j]; zr[4 * q4 + j] = pr * bbr - pi * bbi; zi[4 * q4 + j] = pr * bbi + pi * bbr; } }
#pragma unroll
            for (int cc = 0; cc < 4; ++cc) { const int cp = cp0 + cc;
                const float cr = F.in(13)[(((size_t)l * 16 + gi) * 16 + cp) * 64 + n], ci = F.in(14)[(((size_t)l * 16 + gi) * 16 + cp) * 64 + n];
#pragma unroll
                for (int c = 0; c < 16; ++c) scr[n * 65 + cc * 16 + c] = cr * zr[c] - ci * zi[c]; }
            asm volatile("s_waitcnt lgkmcnt(0)" ::: "memory");
            float mine = 0.f;
#pragma unroll 8
            for (int nn = 0; nn < 64; ++nn) mine += scr[nn * 65 + lane];
            ((float*)(ms + MS_MTAB))[e0 + lane] = mine;
            asm volatile("s_waitcnt lgkmcnt(0)" ::: "memory"); continue; }
        r -= I_M;
        {
            const int e = r * 64 + lane; const int gi = e >> 6, n = e & 63;
            const float dt = __expf(F.in(8)[l * 16 + gi]);
            const float ar = F.in(9)[((size_t)l * 16 + gi) * 64 + n], ai = F.in(10)[((size_t)l * 16 + gi) * 64 + n];
            const float x = dt * ar, y = dt * ai; float sy, cy; sy = __sinf(y); cy = __cosf(y); const float sh = __sinf(0.5f * y);
            const float em1 = (fabsf(x) < 0.25f) ? x * (1.f + x * (0.5f + x * (0.16666667f + x * (0.041666668f + x * 0.0083333338f)))) : expm1f(x); const float nr = em1 * cy - 2.f * sh * sh; const float abi = (em1 + 1.f) * sy;
            const float den = ar * ar + ai * ai;
            const float fr_ = (nr * ar + abi * ai) / den, fi_ = (abi * ar - nr * ai) / den;
            float s16, c16; s16 = __sinf(16.f * y); c16 = __cosf(16.f * y); const float m16 = __expf(16.f * x);
            ((f32x2*)(ct + CT_AB16))[e] = (f32x2){m16 * c16, m16 * s16};
            float s1k, c1k; s1k = __sinf(512.f * y); c1k = __cosf(512.f * y); const float m1k = __expf(512.f * x);
            ((f32x2*)(ct + CT_AB1K))[e] = (f32x2){m1k * c1k, m1k * s1k};
            const float* bre = F.in(11) + (((size_t)l * 16 + gi) * 64 + n) * 16; const float* bim = F.in(12) + (((size_t)l * 16 + gi) * 64 + n) * 16;
            f32x2* bb = (f32x2*)(ms + MS_BBAR) + (size_t)e * 16;
#pragma unroll
            for (int c = 0; c < 16; ++c) { const float br = bre[c], bi = bim[c]; bb[c] = (f32x2){fr_ * br - fi_ * bi, fr_ * bi + fi_ * br}; }
        }
    }
}

DI void prologue_b(Frame& F) {
    const int gt = F.gw * 64 + F.lane, ngt = F.ngw * 64;
    for (int l = 0; l < NL; ++l) {
        unsigned char* wl = F.wsp() + WS_W + (size_t)l * WL_STRIDE;
        unsigned char* ms = F.wsp() + WS_MISC + (size_t)l * MS_L;
        unsigned char* ct = F.wsp() + WS_CTL + CT_BASE + (size_t)l * CT_L;
        const float* MT = (const float*)(ms + MS_MTAB);
        const f32x2* BB = (const f32x2*)(ms + MS_BBAR);
        const float dtl_base = 0.f; (void)dtl_base;
        for (int e = gt; e < 16 * 512 * 256; e += ngt) {
            const int gi = e >> 17, n = (e >> 8) & 511, k = e & 255; float v = 0.f;
            if (n < 256) { const int tp = n >> 4, cp = n & 15, ta = k >> 4, c = k & 15; if (tp >= ta) v = MT[((gi * 16 + (tp - ta)) * 16 + cp) * 16 + c]; }
            else if (n < 384) { const int s = (n - 256) & 63, part = (n - 256) >> 6, ta = k >> 4, c = k & 15;
                const float dt = __expf(F.in(8)[l * 16 + gi]);
                const float ar = F.in(9)[((size_t)l * 16 + gi) * 64 + s], ai = F.in(10)[((size_t)l * 16 + gi) * 64 + s];
                const float pw = (float)(15 - ta); float sp, cpw; sp = __sinf(pw * dt * ai); cpw = __cosf(pw * dt * ai); const float mg = __expf(pw * dt * ar);
                const float pr = mg * cpw, pi = mg * sp; const f32x2 b = BB[((size_t)gi * 64 + s) * 16 + c];
                v = part ? (pr * b.y + pi * b.x) : (pr * b.x - pi * b.y); }
            ((bf16_t*)(wl + WO_SS1))[e] = f2bf(v);
        }
        for (int e = gt; e < 16 * 256 * 256; e += ngt) {
            const int gi = e >> 16, n = (e >> 8) & 255, k = e & 255; float v = 0.f;
            if (k < 128) { const int s = k & 63, part = k >> 6, ta = n >> 4, c = n & 15;
                const float dt = __expf(F.in(8)[l * 16 + gi]);
                const float ar = F.in(9)[((size_t)l * 16 + gi) * 64 + s], ai = F.in(10)[((size_t)l * 16 + gi) * 64 + s];
                const float pw = (float)(ta + 1); float sp, cpw; sp = __sinf(pw * dt * ai); cpw = __cosf(pw * dt * ai); const float mg = __expf(pw * dt * ar);
                const float pr = mg * cpw, pi = mg * sp;
                const float cr = F.in(13)[(((size_t)l * 16 + gi) * 16 + c) * 64 + s], ci = F.in(14)[(((size_t)l * 16 + gi) * 16 + c) * 64 + s];
                v = part ? -(cr * pi + ci * pr) : (cr * pr - ci * pi); }
            ((bf16_t*)(wl + WO_SS2))[e] = f2bf(v);
        }
        for (int e = gt; e < 512; e += ngt) { const int kv = e >> 8, n = e & 255; float s = F.in(5)[((size_t)l * 2 + kv) * 256 + n];
            const float* pp = (const float*)(ms + MS_CBP) + (size_t)kv * 32 * 256 + n;
            for (int ch = 0; ch < 32; ++ch) s += pp[ch * 256];
            ((float*)(ct + CT_CB1))[e] = s; }
    }
}

DI void convert_rows_stats(Frame& F, const float* x, bf16_t* o, unsigned long long* ssx) {
    for (int m = F.gw; m < NT; m += F.ngw) {
        const f32x4* xr = (const f32x4*)(x + (size_t)m * DM) + F.lane; f32x4 v[4]; float s = 0.f;
#pragma unroll
        for (int j = 0; j < 4; ++j) { v[j] = xr[64 * j]; s += (v[j].x * v[j].x + v[j].y * v[j].y) + (v[j].z * v[j].z + v[j].w * v[j].w); }
        u32x2* o8 = (u32x2*)(o + (size_t)m * DM) + F.lane;
#pragma unroll
        for (int j = 0; j < 4; ++j) { u32x2 w; w.x = pk2(v[j].x, v[j].y); w.y = pk2(v[j].z, v[j].w); o8[64 * j] = w; }
        s = wave_sum(s);
        if (F.lane == 0) ssx[(size_t)m * 2] = (unsigned long long)(s * 1048576.f);
    }
}
DI void rmsnorm_rows_bf16(Frame& F, const float* x, const float* g, bf16_t* o) {
    const f32x4* gp = (const f32x4*)g + F.lane; f32x4 gv[4];
#pragma unroll
    for (int j = 0; j < 4; ++j) gv[j] = gp[64 * j];
    for (int m = F.gw; m < NT; m += F.ngw) {
        const f32x4* xr = (const f32x4*)(x + (size_t)m * DM) + F.lane; f32x4 v[4]; float s = 0.f;
#pragma unroll
        for (int j = 0; j < 4; ++j) { v[j] = xr[64 * j]; s += (v[j].x * v[j].x + v[j].y * v[j].y) + (v[j].z * v[j].z + v[j].w * v[j].w); }
        const float rstd = rsqrtf(wave_sum(s) * (1.f / DM) + 1e-6f);
        u32x2* o8 = (u32x2*)(o + (size_t)m * DM) + F.lane;
#pragma unroll
        for (int j = 0; j < 4; ++j) { u32x2 w; w.x = pk2(v[j].x * rstd * gv[j].x, v[j].y * rstd * gv[j].y); w.y = pk2(v[j].z * rstd * gv[j].z, v[j].w * rstd * gv[j].w); o8[64 * j] = w; }
    }
}
DI void rmsnorm_rows_fp8(Frame& F, const float* x, const float* g, unsigned char* o) {
    const f32x4* gp = (const f32x4*)g + F.lane; f32x4 gv[4];
#pragma unroll
    for (int j = 0; j < 4; ++j) gv[j] = gp[64 * j];
    for (int m = F.gw; m < NT; m += F.ngw) {
        const f32x4* xr = (const f32x4*)(x + (size_t)m * DM) + F.lane; f32x4 v[4]; float s = 0.f;
#pragma unroll
        for (int j = 0; j < 4; ++j) { v[j] = xr[64 * j]; s += (v[j].x * v[j].x + v[j].y * v[j].y) + (v[j].z * v[j].z + v[j].w * v[j].w); }
        const float rstd = rsqrtf(wave_sum(s) * (1.f / DM) + 1e-6f);
        unsigned* o4 = (unsigned*)(o + (size_t)m * DM) + F.lane;
#pragma unroll
        for (int j = 0; j < 4; ++j) o4[64 * j] = pk4_fp8(v[j].x * rstd * gv[j].x, v[j].y * rstd * gv[j].y, v[j].z * rstd * gv[j].z, v[j].w * rstd * gv[j].w);
    }
}
DI void rmsnorm_rows_f32_inplace(Frame& F, float* x, const float* g) {
    const f32x4* gp = (const f32x4*)g + F.lane; f32x4 gv[4];
#pragma unroll
    for (int j = 0; j < 4; ++j) gv[j] = gp[64 * j];
    for (int m = F.gw; m < NT; m += F.ngw) {
        f32x4* xr = (f32x4*)(x + (size_t)m * DM) + F.lane; f32x4 v[4]; float s = 0.f;
#pragma unroll
        for (int j = 0; j < 4; ++j) { v[j] = xr[64 * j]; s += (v[j].x * v[j].x + v[j].y * v[j].y) + (v[j].z * v[j].z + v[j].w * v[j].w); }
        const float rstd = rsqrtf(wave_sum(s) * (1.f / DM) + 1e-6f);
#pragma unroll
        for (int j = 0; j < 4; ++j) xr[64 * j] = v[j] * rstd * gv[j];
    }
}
template <int OUT>
DI void rmsnorm_rows_xb(Frame& F, const bf16_t* x, const float* g, void* o) {
    const f32x4* gp = (const f32x4*)g + 2 * F.lane; f32x4 gv[2][2];
#pragma unroll
    for (int j = 0; j < 2; ++j) { gv[j][0] = gp[128 * j]; gv[j][1] = gp[128 * j + 1]; }
    for (int m = 2 * F.gw; m < NT; m += 2 * F.ngw) {
        u32x4 w[2][2];
#pragma unroll
        for (int r = 0; r < 2; ++r)
#pragma unroll
            for (int j = 0; j < 2; ++j) w[r][j] = ((const u32x4*)(x + (size_t)(m + r) * DM) + F.lane)[64 * j];
#pragma unroll
        for (int r = 0; r < 2; ++r) {
            f32x4 v[2][2]; float s = 0.f;
#pragma unroll
            for (int j = 0; j < 2; ++j) { const u32x4 q = w[r][j];
                v[j][0] = f32x4{bflo(q.x), bfhi(q.x), bflo(q.y), bfhi(q.y)}; v[j][1] = f32x4{bflo(q.z), bfhi(q.z), bflo(q.w), bfhi(q.w)};
                const f32x4 a = v[j][0] * v[j][0] + v[j][1] * v[j][1]; s += (a.x + a.y) + (a.z + a.w); }
            const float rstd = rsqrtf(wave_sum(s) * (1.f / DM) + 1e-6f);
#pragma unroll
            for (int j = 0; j < 2; ++j) { const f32x4 y0 = v[j][0] * rstd * gv[j][0], y1 = v[j][1] * rstd * gv[j][1];
                if constexpr (OUT == 0) { u32x4 t; t.x = pk2(y0.x, y0.y); t.y = pk2(y0.z, y0.w); t.z = pk2(y1.x, y1.y); t.w = pk2(y1.z, y1.w);
                    ((u32x4*)((bf16_t*)o + (size_t)(m + r) * DM) + F.lane)[64 * j] = t; }
                else if constexpr (OUT == 1) { u32x2 t; t.x = pk4_fp8(y0.x, y0.y, y0.z, y0.w); t.y = pk4_fp8(y1.x, y1.y, y1.z, y1.w);
                    ((u32x2*)((unsigned char*)o + (size_t)(m + r) * DM) + F.lane)[64 * j] = t; }
                else { f32x4* op = (f32x4*)((float*)o + (size_t)(m + r) * DM) + 2 * F.lane + 128 * j; op[0] = y0; op[1] = y1; } }
        }
    }
}
DI void mix_norm_rows(Frame& F, const bf16_t* oatt, const bf16_t* ossm, const float* gatt, const float* gssm, bf16_t* mixed) {
    for (int m = F.gw; m < NT; m += F.ngw) {
        const u32x2* ar = (const u32x2*)(oatt + (size_t)m * 768) + F.lane;
        float a[12]; float s = 0.f;
#pragma unroll
        for (int j = 0; j < 3; ++j) { const u32x2 w = ar[64 * j]; a[4 * j] = bflo(w.x); a[4 * j + 1] = bfhi(w.x); a[4 * j + 2] = bflo(w.y); a[4 * j + 3] = bfhi(w.y); }
#pragma unroll
        for (int j = 0; j < 12; ++j) s += a[j] * a[j];
        const float ra = rsqrtf(wave_sum(s) * (1.f / 768.f) + 1e-6f);
        const u32x2 sw = ((const u32x2*)(ossm + (size_t)m * 256))[F.lane];
        float b[4] = {bflo(sw.x), bfhi(sw.x), bflo(sw.y), bfhi(sw.y)};
        const float rs = rsqrtf(wave_sum(b[0] * b[0] + b[1] * b[1] + b[2] * b[2] + b[3] * b[3]) * (1.f / 256.f) + 1e-6f);
        u32x2* o8 = (u32x2*)(mixed + (size_t)m * DM);
#pragma unroll
        for (int j = 0; j < 3; ++j) { const f32x4 gv = ((const f32x4*)gatt)[64 * j + F.lane];
            u32x2 w; w.x = pk2(a[4 * j] * ra * gv.x, a[4 * j + 1] * ra * gv.y); w.y = pk2(a[4 * j + 2] * ra * gv.z, a[4 * j + 3] * ra * gv.w); o8[64 * j + F.lane] = w; }
        { const f32x4 gv = ((const f32x4*)gssm)[F.lane]; u32x2 w; w.x = pk2(b[0] * rs * gv.x, b[1] * rs * gv.y); w.y = pk2(b[2] * rs * gv.z, b[3] * rs * gv.w); o8[192 + F.lane] = w; }
    }
}

#define KPERM(rt, r) (32 * ((rt) >> 1) + 8 * ((r) >> 2) + 4 * ((rt) & 1) + ((r) & 3))
DI void vtranspose_phase(Frame& F, const bf16_t* proj, bf16_t* vts, bf16_t* vtw, bf16_t* kfs, unsigned* vmax_word, int cu0) {
    LAS bf16_t* scr = (LAS bf16_t*)(F.lds + F.wave * 8704);
    unsigned vm = 0u;
    const bool split = F.G > 96;
    if (split && F.bid < cu0) return;
    const int gw0 = split ? F.gw - cu0 * 8 : F.gw, ngw0 = split ? F.ngw - cu0 * 8 : F.ngw;
    const int c16 = F.lane & 15, kq = F.lane >> 4;
    for (int it = gw0; it < 3 * 6 * 256; it += ngw0) {
        const int which = it / 1536, r = it % 1536, bh = r >> 8, tt = r & 255, b = bh / 3, h = bh % 3;
        const bf16_t* src = proj + ((size_t)(b * SEQ + 64 * tt)) * PW + (which == 0 ? C_VS : (which == 1 ? C_VW : C_KS)) + h * 64;
        bf16_t* dst = (which == 0 ? vts : (which == 1 ? vtw : kfs)) + (size_t)bh * 64 * SEQ + (size_t)tt * 4096;
#pragma unroll
        for (int i = 0; i < 8; ++i) { const int tk = i * 8 + (F.lane >> 3), d8 = F.lane & 7; const u32x4 w = *(const u32x4*)(src + (size_t)tk * PW + 8 * d8);
            if (which == 0) { vm = max(vm, max(max(w.x & 0x7fff0000u, (w.x << 16) & 0x7fff0000u), max(w.y & 0x7fff0000u, (w.y << 16) & 0x7fff0000u)));
                              vm = max(vm, max(max(w.z & 0x7fff0000u, (w.z << 16) & 0x7fff0000u), max(w.w & 0x7fff0000u, (w.w << 16) & 0x7fff0000u))); }
            LAS bf16_t* sp = scr + tk * 66 + 8 * d8; ((LAS unsigned*)sp)[0] = w.x; ((LAS unsigned*)sp)[1] = w.y; ((LAS unsigned*)sp)[2] = w.z; ((LAS unsigned*)sp)[3] = w.w; }
        asm volatile("s_waitcnt lgkmcnt(0)" ::: "memory");
        if (which == 1) {
#pragma unroll
            for (int i = 0; i < 8; ++i) { const int d = i * 8 + (F.lane >> 3), t8 = F.lane & 7; unsigned short e[8];
#pragma unroll
                for (int j = 0; j < 8; ++j) e[j] = scr[(8 * t8 + j) * 66 + d];
                u32x4 w; w.x = e[0] | ((unsigned)e[1] << 16); w.y = e[2] | ((unsigned)e[3] << 16); w.z = e[4] | ((unsigned)e[5] << 16); w.w = e[6] | ((unsigned)e[7] << 16);
                *(u32x4*)(dst + (size_t)d * 64 + 8 * t8) = w; }
        } else if (which == 0) {
#pragma unroll
            for (int I = 0; I < 8; ++I) { const int dt = I >> 1, sp = I & 1; unsigned short e[8];
#pragma unroll
                for (int j = 0; j < 8; ++j) e[j] = scr[(32 * sp + 8 * kq + j) * 66 + 16 * dt + c16];
                u32x4 w; w.x = e[0] | ((unsigned)e[1] << 16); w.y = e[2] | ((unsigned)e[3] << 16); w.z = e[4] | ((unsigned)e[5] << 16); w.w = e[6] | ((unsigned)e[7] << 16);
                *(u32x4*)(dst + (I * 64 + F.lane) * 8) = w; }
        } else {
#pragma unroll
            for (int I = 0; I < 8; ++I) { const int rt = I >> 1, ks = I & 1; const LAS bf16_t* sp = scr + KPERM(rt, c16) * 66 + 32 * ks + 8 * kq;
                u32x4 w; w.x = ((const LAS unsigned*)sp)[0]; w.y = ((const LAS unsigned*)sp)[1]; w.z = ((const LAS unsigned*)sp)[2]; w.w = ((const LAS unsigned*)sp)[3];
                *(u32x4*)(dst + (I * 64 + F.lane) * 8) = w; }
        }
        asm volatile("s_waitcnt lgkmcnt(0)" ::: "memory");
    }
    vm = wave_max_u32(vm);
    if (F.lane == 0 && vm != 0u) __hip_atomic_fetch_max(vmax_word, vm, __ATOMIC_RELAXED, __HIP_MEMORY_SCOPE_AGENT);
}

#define MFMA32(a, b, c) __builtin_amdgcn_mfma_f32_32x32x16_bf16((a), (b), (c), 0, 0, 0)
#define MFMA16(a, b, c) __builtin_amdgcn_mfma_f32_16x16x32_bf16((a), (b), (c), 0, 0, 0)

DI void compress2_phase(Frame& F, const bf16_t* hidc, const bf16_t* w2t, const float* b2  , bf16_t* kc, bf16_t* vct, int it0, int it_end, int it_step) {
    const int r = F.lane & 31, h = F.lane >> 5;
    for (int it = it0; it < it_end; it += it_step) {
        const int kv = it / 192, rb = it % 192; const int R0 = kv * 6144 + rb * 32;
        f32x16 acc0, acc1;
#pragma unroll
        for (int i = 0; i < 16; ++i) { acc0[i] = 0.f; acc1[i] = 0.f; }
        const bf16_t* ap = hidc + (size_t)(R0 + r) * 256 + 8 * h; const bf16_t* bp = w2t + (size_t)kv * 64 * 256 + (size_t)r * 256 + 8 * h;
#pragma unroll 4
        for (int ks = 0; ks < 16; ++ks) { const bf16x8 a = *(const bf16x8*)(ap + 16 * ks); const bf16x8 b0 = *(const bf16x8*)(bp + 16 * ks), b1 = *(const bf16x8*)(bp + 32 * 256 + 16 * ks);
            acc0 = MFMA32(a, b0, acc0); acc1 = MFMA32(a, b1, acc1); }
        const int bh = rb >> 5, i0 = (rb & 31) * 32;
        const float bb0 = b2[kv * 64 + r], bb1 = b2[kv * 64 + 32 + r];
        if (kv == 0) {
#pragma unroll
            for (int i = 0; i < 16; ++i) { const int row = i0 + (i & 3) + 8 * (i >> 2) + 4 * h; bf16_t* o = kc + ((size_t)bh * 1024 + row) * 64;
                const bool junk = (row == 1023);
                o[r] = junk ? (bf16_t)0 : f2bf(acc0[i] + bb0); o[32 + r] = junk ? (bf16_t)0 : f2bf(acc1[i] + bb1); }
        } else {
#pragma unroll
            for (int g4 = 0; g4 < 4; ++g4) { const int row = i0 + 8 * g4 + 4 * h;
                u32x2 w0, w1; w0.x = pk2(acc0[4 * g4] + bb0, acc0[4 * g4 + 1] + bb0); w0.y = pk2(acc0[4 * g4 + 2] + bb0, acc0[4 * g4 + 3] + bb0);
                w1.x = pk2(acc1[4 * g4] + bb1, acc1[4 * g4 + 1] + bb1); w1.y = pk2(acc1[4 * g4 + 2] + bb1, acc1[4 * g4 + 3] + bb1);
                if (row == 1020) { w0.y &= 0x0000ffffu; w1.y &= 0x0000ffffu; }
                bf16_t* vt = vct + (size_t)bh * 64 * 1024 + (size_t)(row >> 6) * 4096 + (row & 63);
                *(u32x2*)(vt + r * 64) = w0; *(u32x2*)(vt + (32 + r) * 64) = w1; }
        }
    }
}

DI void ssm_carry_phase(Frame& F, const float* hl, const f32x2* ab16, const f32x2* ab512, bf16_t* hin, int bg0, int bg_end, int bg_step) {
    LAS f32x2* E = (LAS f32x2*)F.lds;
    const int s = F.lane;
    for (int bg = bg0; bg < bg_end; bg += bg_step) {
        const int gi = bg & 15; const f32x2 a16 = ab16[gi * 64 + s], a5 = ab512[gi * 64 + s];
        const float* hp = hl + (size_t)bg * 1024 * 128 + s;
        float hr[4], hi[4];
#pragma unroll
        for (int j = 0; j < 4; ++j) { hr[j] = 0.f; hi[j] = 0.f; }
#pragma unroll 4
        for (int c = 0; c < 32; ++c) {
#pragma unroll
            for (int j = 0; j < 4; ++j) { const float* q = hp + (size_t)((4 * F.wave + j) * 32 + c) * 128; const float lr = q[0], li = q[64];
                const float nr = a16.x * hr[j] - a16.y * hi[j] + lr, ni = a16.x * hi[j] + a16.y * hr[j] + li; hr[j] = nr; hi[j] = ni; } }
#pragma unroll
        for (int j = 0; j < 4; ++j) E[(4 * F.wave + j) * 64 + s] = (f32x2){hr[j], hi[j]};
        __syncthreads();
        { float pr = 0.f, pi = 0.f;
          for (int k = 0; k < 4 * F.wave; ++k) { const f32x2 e = E[k * 64 + s]; const float nr = a5.x * pr - a5.y * pi + e.x, ni = a5.x * pi + a5.y * pr + e.y; pr = nr; pi = ni; }
#pragma unroll
          for (int j = 0; j < 4; ++j) { hr[j] = pr; hi[j] = pi; const f32x2 e = E[(4 * F.wave + j) * 64 + s]; const float nr = a5.x * pr - a5.y * pi + e.x, ni = a5.x * pi + a5.y * pr + e.y; pr = nr; pi = ni; } }
#pragma unroll 4
        for (int c = 0; c < 32; ++c) {
#pragma unroll
            for (int j = 0; j < 4; ++j) { const int ch = (4 * F.wave + j) * 32 + c; const float* q = hp + (size_t)ch * 128; const float lr = q[0], li = q[64];
                bf16_t* o = hin + ((size_t)bg * 1024 + ch) * 256; o[s] = f2bf(hr[j]); o[64 + s] = f2bf(hi[j]); ((unsigned*)(o + 128))[s] = 0u;
                const float nr = a16.x * hr[j] - a16.y * hi[j] + lr, ni = a16.x * hi[j] + a16.y * hr[j] + li; hr[j] = nr; hi[j] = ni; } }
        __syncthreads();
    }
}

constexpr float AL2E = 1.0f;
constexpr int IMP_STRIDE = 257;
constexpr int OS_QS = 261, OS_HS = 65;
constexpr int LDS_RA = 0, LDS_RB = 64 * IMP_STRIDE * 4, LDS_WM = LDS_RB + 64 * OS_QS * 4;
constexpr int QT_ROW = 144, LDS_QT = LDS_RA, LDS_QL = LDS_QT + 256 * QT_ROW, LDS_MREF = LDS_QL + 512, LDS_LS = LDS_MREF + 1024;
constexpr int LDS_QCNT = LDS_WM + 2048;
static_assert(LDS_LS + 1024 <= LDS_RB && LDS_QCNT + 20 <= LDS_BYTES - 256, "LDS map");
constexpr int TROW = 144, TILE_V = 64 * TROW, TILE_BYTES = 2 * 64 * TROW;

struct TileSrc { const bf16_t* k; long kstep, kstride; const bf16_t* v; long vstep, vstride; };

constexpr int PD = 1;
struct IdMap { DI int operator()(int i) const { return i; } };
template <bool WITH_V, class Compute, class Map = IdMap, bool FRAG = false>
DI void kv_pipeline(Frame& F, LAS unsigned char* sb, const TileSrc& ts, int n, Compute&& compute, Map tmap = Map()) {
    if (n <= 0) return;
    const int row = F.tid >> 3, ch = F.tid & 7, nl = n - 1;
    const bf16_t* kp = FRAG ? ts.k + F.tid * 8 : ts.k + (long)row * ts.kstride + ch * 8; const bf16_t* vp = FRAG ? ts.v + F.tid * 8 : ts.v + (long)row * ts.vstride + ch * 8;
    LAS unsigned char* wk = sb + row * TROW + ch * 16; int vdel = TILE_V;
    if (FRAG) { const int I = F.tid >> 6, l_ = F.tid & 63, c16_ = l_ & 15, kq_ = l_ >> 4;
        const int kofs = KPERM(I >> 1, c16_) * TROW + (32 * (I & 1) + 8 * kq_) * 2, vofs = TILE_V + (16 * (I >> 1) + c16_) * TROW + (32 * (I & 1) + 8 * kq_) * 2;
        wk = sb + kofs; vdel = vofs - kofs; }
    u32x4 kr[PD], vr[PD];
#pragma unroll
    for (int u = 0; u < PD; ++u) { const int t = tmap(u < nl ? u : nl); kr[u] = *(const u32x4*)(kp + (long)t * ts.kstep); vr[u] = WITH_V ? *(const u32x4*)(vp + (long)t * ts.vstep) : (u32x4){0u, 0u, 0u, 0u}; }
    *(LAS u32x4*)wk = kr[0]; if (WITH_V) *(LAS u32x4*)(wk + vdel) = vr[0];
    { const int t = tmap(PD < nl ? PD : nl); kr[0] = *(const u32x4*)(kp + (long)t * ts.kstep); if (WITH_V) vr[0] = *(const u32x4*)(vp + (long)t * ts.vstep); }
    __syncthreads();
    for (int i0 = 0; i0 < n; i0 += PD) {
#pragma unroll
        for (int u = 0; u < PD; ++u) {
            const int i = i0 + u; const int s1 = (u + 1) % PD;
            { LAS unsigned char* w1 = wk + ((i + 1) & 1) * TILE_BYTES; *(LAS u32x4*)w1 = kr[s1]; if (WITH_V) *(LAS u32x4*)(w1 + vdel) = vr[s1]; }
            { const int t = tmap((i + 1 + PD) < nl ? (i + 1 + PD) : nl); kr[s1] = *(const u32x4*)(kp + (long)t * ts.kstep); if (WITH_V) vr[s1] = *(const u32x4*)(vp + (long)t * ts.vstep); }
            if (i < n) compute(i, sb + (i & 1) * TILE_BYTES);
            __syncthreads();
        }
    }
}

DI f32x16 qk32(const LAS unsigned char* tb, int kh, int r32, int h, const bf16x8 (&qf)[4]) {
    f32x16 sc;
#pragma unroll
    for (int i = 0; i < 16; ++i) sc[i] = 0.f;
    const LAS unsigned char* kp = tb + (32 * kh + r32) * TROW + 16 * h;
#pragma unroll
    for (int s = 0; s < 4; ++s) { const bf16x8 a = *(const LAS bf16x8*)(kp + 32 * s); sc = MFMA32(a, qf[s], sc); }
    return sc;
}
DI void qk32x2(const LAS unsigned char* tb, int r32, int h, const bf16x8 (&qf)[4], f32x16& s0, f32x16& s1) {
#pragma unroll
    for (int i = 0; i < 16; ++i) { s0[i] = 0.f; s1[i] = 0.f; }
    const LAS unsigned char* kp = tb + r32 * TROW + 16 * h;
#pragma unroll
    for (int s = 0; s < 4; ++s) { const bf16x8 a0 = *(const LAS bf16x8*)(kp + 32 * s), a1 = *(const LAS bf16x8*)(kp + 32 * TROW + 32 * s); s0 = MFMA32(a0, qf[s], s0); s1 = MFMA32(a1, qf[s], s1); }
}
DI void pv32(const LAS unsigned char* tb, int kh, int r32, int h, const f32x16& p, f32x16& o0, f32x16& o1) {
#pragma unroll
    for (int s2 = 0; s2 < 2; ++s2) {
        u32x4 pw; pw.x = pk2(p[8 * s2], p[8 * s2 + 1]); pw.y = pk2(p[8 * s2 + 2], p[8 * s2 + 3]); pw.z = pk2(p[8 * s2 + 4], p[8 * s2 + 5]); pw.w = pk2(p[8 * s2 + 6], p[8 * s2 + 7]);
        const bf16x8 pb = __builtin_bit_cast(bf16x8, pw);
        const LAS unsigned char* vp = tb + TILE_V + r32 * TROW + (32 * kh + 16 * s2 + 4 * h) * 2;
        { const s16x4 lo = *(const LAS s16x4*)vp, hi = *(const LAS s16x4*)(vp + 16); const bf16x8 a = __builtin_shufflevector(lo, hi, 0, 1, 2, 3, 4, 5, 6, 7); o0 = MFMA32(a, pb, o0); }
        { const s16x4 lo = *(const LAS s16x4*)(vp + 32 * TROW), hi = *(const LAS s16x4*)(vp + 32 * TROW + 16); const bf16x8 a = __builtin_shufflevector(lo, hi, 0, 1, 2, 3, 4, 5, 6, 7); o1 = MFMA32(a, pb, o1); }
    }
}

DI void attn_unit(Frame& F, const bf16_t* proj, const bf16_t* kcb, const bf16_t* vctb, const bf16_t* vts, const bf16_t* vtw, bf16_t* oatt, int bh, int qb, float os_scale, float os_inv, float os_e2, float* park, const bf16_t* kfs, unsigned long long* sst) {
    const float ls_scale = 1048576.0f * os_inv;
    LAS unsigned* IMP = (LAS unsigned*)(F.lds + LDS_RA); LAS unsigned char* WM = F.lds + LDS_WM;
    const int b = bh / 3, hkv = bh % 3, lane = F.lane, w = F.wave;
    const float NEG = -__builtin_inff();
    for (int i = F.tid; i < 64 * IMP_STRIDE; i += 512) IMP[i] = 0u;
    for (int i = F.tid; i < 512; i += 512) ((LAS unsigned*)WM)[i] = 0u;
    if (F.tid == 0) ((LAS int*)(F.lds + LDS_QCNT + 16))[0] = 0;
    const int r32 = lane & 31, h = lane >> 5, gq = w & 3, qh = w >> 2;
    const int ql = 32 * qh + r32, t = 64 * qb + ql;
    const size_t trow = (size_t)(b * SEQ + t);
    const bf16_t* qrow = proj + trow * PW + C_Q + (hkv * 4 + gq) * 64;
    bf16x8 qf[4];
#pragma unroll
    for (int s = 0; s < 4; ++s) qf[s] = *(const bf16x8*)(qrow + 16 * s + 8 * h);
    const bf16_t* grow = proj + trow * PW + C_G + hkv * 12 + gq * 3;
    const float g0 = sigmoidf_(bf2f(grow[0])), g2 = sigmoidf_(bf2f(grow[2]));
    f32x16 oc0, oc1; float inv_c = 0.f;
#pragma unroll
    for (int i = 0; i < 16; ++i) { oc0[i] = 0.f; oc1[i] = 0.f; }
    {
        const int ntile = (4 * qb + 3 + 63) >> 6;
        const int vis = (t - 31) >> 4;
        const int vis_w = (64 * qb + 32 * qh + 31 - 31) >> 4;
        const int vis_min = (64 * qb + 32 * qh - 31) >> 4;
        TileSrc ts{kcb + (size_t)bh * 1024 * 64, 64 * 64, 64, vctb + (size_t)bh * 64 * 1024, 4096, 64};
        float m = NEG, lsum = 0.f;
        kv_pipeline<false>(F, F.lds + LDS_RB, ts, ntile, [&](int i, const LAS unsigned char* tb) {
            if (64 * i > vis_w) return;
            const bool two = (64 * i + 32 <= vis_w); f32x16 sq0, sq1;
            if (two) qk32x2(tb, r32, h, qf, sq0, sq1); else { sq0 = qk32(tb, 0, r32, h, qf); sq1 = sq0; }
#pragma unroll
            for (int kh = 0; kh < 2; ++kh) {
                if (kh == 1 && !two) continue;
                f32x16 sc = kh ? sq1 : sq0;
                if (64 * i + 32 * kh + 31 > vis_min) {
#pragma unroll
                    for (int e = 0; e < 16; ++e) { const int ki = 64 * i + 32 * kh + (e & 3) + 8 * (e >> 2) + 4 * h; sc[e] = (ki <= vis) ? sc[e] : NEG; }
                }
                float ps = 0.f;
#pragma unroll
                for (int e = 0; e < 16; ++e) ps += fexp2(sc[e]);
                lsum += ps;
            }
        });
        bool redo1; { const float Lq = xor32_sum(lsum); LAS int* WFLAG = (LAS int*)(F.lds + LDS_QCNT + 16);
          if (!(Lq == 0.f || (Lq > 5.4e-20f && Lq < 1.8e19f))) WFLAG[0] = 1;
          __syncthreads();
          redo1 = (WFLAG[0] != 0) || (FORCE_REDO != 0); }
        float M = 0.f, Lt = 0.f;
        if (!redo1) { Lt = xor32_sum(lsum); }
        else {
        lsum = 0.f;
        for (int rep_ = 0; rep_ < REP_B1; ++rep_)
        kv_pipeline<false>(F, F.lds + LDS_RB, ts, ntile, [&](int i, const LAS unsigned char* tb) {
            if (64 * i > vis_w) return;
            const bool two = (64 * i + 32 <= vis_w); f32x16 sq0, sq1;
            if (two) qk32x2(tb, r32, h, qf, sq0, sq1); else { sq0 = qk32(tb, 0, r32, h, qf); sq1 = sq0; }
#pragma unroll
            for (int kh = 0; kh < 2; ++kh) {
                if (kh == 1 && !two) continue;
                f32x16 sc = kh ? sq1 : sq0;
                float tm = NEG;
                if (64 * i + 32 * kh + 31 > vis_min) {
#pragma unroll
                    for (int e = 0; e < 16; ++e) { const int ki = 64 * i + 32 * kh + (e & 3) + 8 * (e >> 2) + 4 * h; sc[e] = (ki <= vis) ? sc[e] : NEG; }
                }
#pragma unroll
                for (int e = 0; e < 16; ++e) tm = fmaxf(tm, sc[e]);
                const float mn = fmaxf(m, tm);
                if (mn > NEG) { float ps = 0.f;
#pragma unroll
                    for (int e = 0; e < 16; ++e) ps += fexp2((sc[e] - mn) * AL2E);
                    lsum = lsum * fexp2((m - mn) * AL2E) + ps; m = mn; }
            }
        });
        const F2 mm = halves32(m), ll = halves32(lsum);
        M = fmaxf(mm.lo, mm.hi);
        if (M > NEG) Lt = ll.lo * fexp2((mm.lo - M) * AL2E) + ll.hi * fexp2((mm.hi - M) * AL2E); else M = 0.f;
        }
        const float inv = 1.0f / fmaxf(Lt, 1e-30f), inv24 = inv * 16777216.0f;
        inv_c = inv;
        for (int rep_ = 0; rep_ < REP_B1; ++rep_)
        kv_pipeline<true>(F, F.lds + LDS_RB, ts, ntile, [&](int i, const LAS unsigned char* tb) {
            if (64 * i > vis_w) return;
            const bool two = (64 * i + 32 <= vis_w); f32x16 sq0, sq1;
            if (two) qk32x2(tb, r32, h, qf, sq0, sq1); else { sq0 = qk32(tb, 0, r32, h, qf); sq1 = sq0; }
#pragma unroll
            for (int kh = 0; kh < 2; ++kh) {
                if (kh == 1 && !two) continue;
                f32x16 sc = kh ? sq1 : sq0;
#pragma unroll
                for (int e = 0; e < 16; ++e) sc[e] = fexp2((sc[e] - M) * AL2E);
                if (64 * i + 32 * kh + 31 > vis_min) {
#pragma unroll
                    for (int e = 0; e < 16; ++e) { const int ki = 64 * i + 32 * kh + (e & 3) + 8 * (e >> 2) + 4 * h; sc[e] = (ki <= vis) ? sc[e] : 0.f; }
                }
#pragma unroll
                for (int a = 0; a < 4; ++a) { const float G = (sc[4 * a] + sc[4 * a + 1]) + (sc[4 * a + 2] + sc[4 * a + 3]); const int j = 16 * i + 8 * kh + 2 * a + h;
                    __hip_atomic_fetch_add(IMP + ql * IMP_STRIDE + j, (unsigned)(G * inv24 + 0.5f), __ATOMIC_RELAXED, __HIP_MEMORY_SCOPE_WORKGROUP);
                    __hip_atomic_fetch_add(IMP + ql * IMP_STRIDE + j + 1, (unsigned)(sc[4 * a + 3] * inv24 + 0.5f), __ATOMIC_RELAXED, __HIP_MEMORY_SCOPE_WORKGROUP); }
                pv32(tb, kh, r32, h, sc, oc0, oc1);
            }
        });
    }
    {
        const int cur = qb; LAS unsigned char* wm = WM + w * 256;
        if (cur + 1 <= 16) { if (lane <= cur) wm[lane] = 0xff; }
        else for (int rep_ = 0; rep_ < REP_TK; ++rep_) {
            unsigned key[8][4]; unsigned selbits = 0u;
#pragma unroll
            for (int qi = 0; qi < 8; ++qi) {
#pragma unroll
                for (int i = 0; i < 4; ++i) { const int j = 4 * lane + i; const unsigned x = IMP[(8 * w + qi) * IMP_STRIDE + j]; key[qi][i] = (j >= 1 && j <= cur - 2) ? (((x + 1u) << 2) | (unsigned)(3 - i)) : 0u; }
#define CE_(a_, b_) do { const unsigned hi_ = max(key[qi][a_], key[qi][b_]), lo_ = min(key[qi][a_], key[qi][b_]); key[qi][a_] = hi_; key[qi][b_] = lo_; } while (0)
                CE_(0, 1); CE_(2, 3); CE_(0, 2); CE_(1, 3); CE_(1, 2);
#undef CE_
            }
            for (int k = 0; k < 13; ++k) {
#pragma unroll
                for (int qi = 0; qi < 8; ++qi) {
                    const unsigned hv = key[qi][0] >> 2; const unsigned Mx = wave_max_u32(hv);
                    const unsigned long long bal = __ballot(hv == Mx); const int L = __ffsll((long long)bal) - 1;
                    const unsigned hk = (unsigned)__builtin_amdgcn_readlane((int)key[qi][0], L);
                    const unsigned bit = 1u << (8 * (3 - (int)(hk & 3u)) + qi);
                    const bool win = (lane == L);
                    selbits |= win ? bit : 0u;
                    key[qi][0] = win ? key[qi][1] : key[qi][0]; key[qi][1] = win ? key[qi][2] : key[qi][1]; key[qi][2] = win ? key[qi][3] : key[qi][2]; key[qi][3] = win ? 0u : key[qi][3];
                }
            }
            unsigned mybits[4];
#pragma unroll
            for (int i = 0; i < 4; ++i) mybits[i] = (selbits >> (8 * i)) & 0xffu;
#pragma unroll
            for (int i = 0; i < 4; ++i) { const int j = 4 * lane + i; unsigned bits = mybits[i]; if (j == 0 || j == cur - 1 || j == cur) bits = 0xffu; wm[j] = (unsigned char)bits; }
        }
    }
    __syncthreads();
    {
        const int kt_lo = (qb - 8) > 0 ? (qb - 8) : 0; const int ntile = qb - kt_lo + 1;
        const int t0w = 64 * qb + 32 * qh;
        TileSrc ts{proj + ((size_t)(b * SEQ) + 64 * kt_lo) * PW + C_KW + hkv * 64, 64 * PW, PW, vtw + (size_t)bh * 64 * SEQ + (size_t)kt_lo * 4096, 4096, 64};
        float m = NEG, lsum = 0.f; f32x16 o0, o1;
#pragma unroll
        for (int i = 0; i < 16; ++i) { o0[i] = 0.f; o1[i] = 0.f; }
        kv_pipeline<true>(F, F.lds + LDS_RA, ts, ntile, [&](int i, const LAS unsigned char* tb) {
#pragma unroll
            for (int kh = 0; kh < 2; ++kh) {
                const int k0 = 64 * (kt_lo + i) + 32 * kh;
                if (k0 > t0w + 31 || k0 + 31 <= t0w - 512) continue;
                f32x16 sc = qk32(tb, kh, r32, h, qf);
                if (!(k0 + 31 <= t0w && k0 > t0w + 31 - 512)) {
#pragma unroll
                    for (int e = 0; e < 16; ++e) { const int key = k0 + (e & 3) + 8 * (e >> 2) + 4 * h; sc[e] = (key <= t && key > t - 512) ? sc[e] : NEG; }
                }
                float ps = 0.f;
#pragma unroll
                for (int e = 0; e < 16; ++e) { sc[e] = fexp2(sc[e]); ps += sc[e]; }
                lsum += ps;
                pv32(tb, kh, r32, h, sc, o0, o1);
            }
        });
        bool redo; { const float Lq = xor32_sum(lsum); LAS int* WFLAG = (LAS int*)(F.lds + LDS_QCNT + 16);
          if (!(Lq > 5.4e-20f && Lq < 1.8e19f)) WFLAG[0] = 1;
          __syncthreads();
          redo = (WFLAG[0] != 0) || (FORCE_REDO != 0); }
        if (redo) {
        lsum = 0.f;
#pragma unroll
        for (int i = 0; i < 16; ++i) { o0[i] = 0.f; o1[i] = 0.f; }
        kv_pipeline<true>(F, F.lds + LDS_RA, ts, ntile, [&](int i, const LAS unsigned char* tb) {
#pragma unroll
            for (int kh = 0; kh < 2; ++kh) {
                const int k0 = 64 * (kt_lo + i) + 32 * kh;
                if (k0 > t0w + 31 || k0 + 31 <= t0w - 512) continue;
                f32x16 sc = qk32(tb, kh, r32, h, qf);
                float tm = NEG;
                if (!(k0 + 31 <= t0w && k0 > t0w + 31 - 512)) {
#pragma unroll
                    for (int e = 0; e < 16; ++e) { const int key = k0 + (e & 3) + 8 * (e >> 2) + 4 * h; sc[e] = (key <= t && key > t - 512) ? sc[e] : NEG; }
                }
#pragma unroll
                for (int e = 0; e < 16; ++e) tm = fmaxf(tm, sc[e]);
                tm = xor32_max(tm);
                const float mn = fmaxf(m, tm); const float ms = (mn > NEG) ? mn : 0.f;
                const float alpha = fexp2((m - ms) * AL2E); float ps = 0.f;
#pragma unroll
                for (int e = 0; e < 16; ++e) { sc[e] = fexp2((sc[e] - ms) * AL2E); ps += sc[e]; }
                lsum = lsum * alpha + ps; m = mn;
                if (__any(alpha != 1.0f)) {
#pragma unroll
                    for (int e = 0; e < 16; ++e) { o0[e] *= alpha; o1[e] *= alpha; }
                }
                pv32(tb, kh, r32, h, sc, o0, o1);
            }
        });
        }
        const float Lw = xor32_sum(lsum); const float gw = g2 / fmaxf(Lw, 1e-30f);
        const float gc = g0 * inv_c;
#pragma unroll
        for (int e = 0; e < 16; ++e) { oc0[e] = gc * oc0[e] + gw * o0[e]; oc1[e] = gc * oc1[e] + gw * o1[e]; }
        bf16_t* op = oatt + trow * 1024 + (hkv * 4 + gq) * 64;
#pragma unroll
        for (int g4 = 0; g4 < 4; ++g4) { const int d = 8 * g4 + 4 * h; u32x2 w0, w1;
            w0.x = pk2(oc0[4 * g4], oc0[4 * g4 + 1]); w0.y = pk2(oc0[4 * g4 + 2], oc0[4 * g4 + 3]); w1.x = pk2(oc1[4 * g4], oc1[4 * g4 + 1]); w1.y = pk2(oc1[4 * g4 + 2], oc1[4 * g4 + 3]);
            *(u32x2*)(op + d) = w0; *(u32x2*)(op + 32 + d) = w1; }
    }
    const int cur = qb; const bool dense = (cur + 1 <= 16);
    float mf = NEG, lf = 0.f, msp = 0.f;
    {
        const int nfb = dense ? (cur + 1) : 3;
        TileSrc ts{kfs + (size_t)bh * 64 * SEQ, 4096, 0, vts + (size_t)bh * 64 * SEQ, 4096, 0};
#pragma unroll
        for (int e = 0; e < 16; ++e) { oc0[e] = 0.f; oc1[e] = 0.f; }
        auto dense_map = [&](int i) -> int { return dense ? i : (i == 0 ? 0 : cur - 2 + i); };
        auto dense_fast = [&](int i, const LAS unsigned char* tb) {
            const int j = dense ? i : (i == 0 ? 0 : cur - 2 + i);
#pragma unroll
            for (int kh = 0; kh < 2; ++kh) {
                const int k0 = 64 * j + 32 * kh;
                if (k0 > 64 * qb + 32 * qh + 31) continue;
                f32x16 sc = qk32(tb, kh, r32, h, qf);
                if (k0 + 31 > 64 * qb + 32 * qh) {
#pragma unroll
                    for (int e = 0; e < 16; ++e) { const int key = k0 + (e & 3) + 8 * (e >> 2) + 4 * h; sc[e] = (key <= t) ? sc[e] : NEG; }
                }
                float ps = 0.f;
#pragma unroll
                for (int e = 0; e < 16; ++e) { sc[e] = fexp2(sc[e]); ps += sc[e]; }
                lf += ps;
                pv32(tb, kh, r32, h, sc, oc0, oc1);
            }
        };
        kv_pipeline<true, decltype(dense_fast)&, decltype(dense_map), true>(F, F.lds + LDS_RA, ts, nfb, dense_fast, dense_map);
        bool redo2; { const float Lq = xor32_sum(lf); LAS int* WFLAG = (LAS int*)(F.lds + LDS_QCNT + 16);
          if (!(Lq > 5.4e-20f && Lq < 1.8e19f)) WFLAG[0] = 1;
          __syncthreads();
          redo2 = (WFLAG[0] != 0) || (FORCE_REDO != 0); }
        if (!redo2) { lf = xor32_sum(lf); mf = 0.f; msp = __log2f(lf) - 4.0f; }
        else {
        lf = 0.f;
#pragma unroll
        for (int e = 0; e < 16; ++e) { oc0[e] = 0.f; oc1[e] = 0.f; }
        auto dense_fn = [&](int i, const LAS unsigned char* tb) {
            const int j = dense ? i : (i == 0 ? 0 : cur - 2 + i);
#pragma unroll
            for (int kh = 0; kh < 2; ++kh) {
                const int k0 = 64 * j + 32 * kh;
                if (k0 > 64 * qb + 32 * qh + 31) continue;
                f32x16 sc = qk32(tb, kh, r32, h, qf);
                float tm = NEG;
                if (k0 + 31 > 64 * qb + 32 * qh) {
#pragma unroll
                    for (int e = 0; e < 16; ++e) { const int key = k0 + (e & 3) + 8 * (e >> 2) + 4 * h; sc[e] = (key <= t) ? sc[e] : NEG; }
                }
#pragma unroll
                for (int e = 0; e < 16; ++e) tm = fmaxf(tm, sc[e]);
                tm = xor32_max(tm);
                const float mn = fmaxf(mf, tm); const float ms = (mn > NEG) ? mn : 0.f;
                const float alpha = fexp2((mf - ms) * AL2E); float ps = 0.f;
#pragma unroll
                for (int e = 0; e < 16; ++e) { sc[e] = fexp2((sc[e] - ms) * AL2E); ps += sc[e]; }
                lf = lf * alpha + ps; mf = mn;
                if (__any(alpha != 1.0f)) {
#pragma unroll
                    for (int e = 0; e < 16; ++e) { oc0[e] *= alpha; oc1[e] *= alpha; }
                }
                pv32(tb, kh, r32, h, sc, oc0, oc1);
            }
        };
        kv_pipeline<true, decltype(dense_fn)&, decltype(dense_map), true>(F, F.lds + LDS_RA, ts, nfb, dense_fn, dense_map);
        lf = xor32_sum(lf); msp = mf;
        }
#pragma unroll
        for (int g4 = 0; g4 < 4; ++g4) { *(f32x4*)(park + 4 * g4) = (f32x4){oc0[4 * g4], oc0[4 * g4 + 1], oc0[4 * g4 + 2], oc0[4 * g4 + 3]}; *(f32x4*)(park + 16 + 4 * g4) = (f32x4){oc1[4 * g4], oc1[4 * g4 + 1], oc1[4 * g4 + 2], oc1[4 * g4 + 3]}; }
    }
    {
        const int c16 = lane & 15, kq = lane >> 4, hd = c16 & 3, qs = c16 >> 2;
        LAS unsigned char* QT = F.lds + LDS_QT; LAS unsigned char* QL = F.lds + LDS_QL + w * 64; LAS int* MREF = (LAS int*)(F.lds + LDS_MREF); LAS unsigned* LS = (LAS unsigned*)(F.lds + LDS_LS);
        LAS int* OS = (LAS int*)(F.lds + LDS_RB);
        LAS int* QCNT = (LAS int*)(F.lds + LDS_QCNT); LAS int* FLAGW = (LAS int*)(F.lds + LDS_QCNT + 12);
        bool exact = false;
        const int nsp = dense ? 0 : (cur - 2);
        if (nsp > 0) {
        { const int row = F.tid >> 1, half = F.tid & 1, q = row >> 2, hh = row & 3;
          const bf16_t* src = proj + (size_t)(b * SEQ + 64 * qb + q) * PW + C_Q + (hkv * 4 + hh) * 64 + 32 * half;
          const u32x4 v0 = *(const u32x4*)src, v1 = *(const u32x4*)(src + 8), v2 = *(const u32x4*)(src + 16), v3 = *(const u32x4*)(src + 24);
          LAS u32x4* d = (LAS u32x4*)(QT + row * QT_ROW + 64 * half); d[0] = v0; d[1] = v1; d[2] = v2; d[3] = v3; }
        for (int i = F.tid; i < 64 * OS_QS; i += 512) OS[i] = 0;
        if (F.tid < 256) LS[F.tid] = 0u;
        if (h == 0) MREF[ql * 4 + gq] = __float_as_int(msp);
        if (F.tid < 2) QCNT[F.tid] = 0;
        if (F.tid == 2) FLAGW[0] = 0;
        __syncthreads();
        const bf16_t* Ksb = kfs + (size_t)bh * 64 * SEQ + lane * 8;
        const bf16_t* Vsb = vts + (size_t)bh * 64 * SEQ + lane * 8;
        auto ticket = [&](LAS int* cnt) -> int { int tk = 0; if (lane == 0) tk = __hip_atomic_fetch_add(cnt, 1, __ATOMIC_RELAXED, __HIP_MEMORY_SCOPE_WORKGROUP); return __builtin_amdgcn_readfirstlane(tk); };
        auto load_k = [&](int j, bf16x8 (&kf)[4][2]) {
#pragma unroll
            for (int rt = 0; rt < 4; ++rt)
#pragma unroll
                for (int ks = 0; ks < 2; ++ks) kf[rt][ks] = *(const bf16x8*)(Ksb + (size_t)j * 4096 + 512 * (2 * rt + ks)); };
        auto load_v = [&](int j, bf16x8 (&vf)[4][2]) {
#pragma unroll
            for (int dt = 0; dt < 4; ++dt)
#pragma unroll
                for (int sp = 0; sp < 2; ++sp) vf[dt][sp] = *(const bf16x8*)(Vsb + (size_t)j * 4096 + 512 * (2 * dt + sp)); };
        auto make_list = [&](int j, int& nj) -> int {
            const unsigned byte = WM[(lane >> 3) * 256 + j]; const bool act = (byte >> (lane & 7)) & 1u;
            const unsigned long long bal = __ballot(act); nj = __popcll(bal);
            const int rank = __builtin_amdgcn_mbcnt_hi((unsigned)(bal >> 32), __builtin_amdgcn_mbcnt_lo((unsigned)bal, 0u));
            if (act) QL[rank] = (unsigned char)lane;
            asm volatile("s_waitcnt lgkmcnt(0)" ::: "memory");
            return (nj + 3) >> 2; };
        auto col_query = [&](int tl, int nj, bool& valid) -> int { const int idx = 4 * tl + qs; valid = idx < nj; return (int)QL[valid ? idx : 0]; };
        auto scores = [&](const bf16x8 (&kf)[4][2], int q, bool valid, f32x4 (&st)[4]) {
            const LAS unsigned char* qp = QT + (q * 4 + hd) * QT_ROW + 16 * kq;
            const bf16x8 q0 = *(const LAS bf16x8*)qp, q1 = *(const LAS bf16x8*)(qp + 64);
#pragma unroll
            for (int rt = 0; rt < 4; ++rt) { st[rt] = (f32x4){0.f, 0.f, 0.f, 0.f}; st[rt] = MFMA16(kf[rt][0], q0, st[rt]); st[rt] = MFMA16(kf[rt][1], q1, st[rt]); }
            if (!valid) {
#pragma unroll
                for (int rt = 0; rt < 4; ++rt) st[rt] = (f32x4){NEG, NEG, NEG, NEG};
            } };
        auto run_pass2 = [&](const bool FAST) {
            bf16x8 kf[4][2], kn[4][2], vf[4][2], vn[4][2];
            int t0 = ticket(QCNT + 1), t1;
            { const int j0 = t0 < nsp ? t0 : nsp - 1; load_k(1 + j0, kn); load_v(1 + j0, vn); }
            while (t0 < nsp) {
                asm volatile("s_waitcnt vmcnt(0)" ::: "memory");
#pragma unroll
                for (int rt = 0; rt < 4; ++rt)
#pragma unroll
                    for (int ks = 0; ks < 2; ++ks) { kf[rt][ks] = kn[rt][ks]; vf[rt][ks] = vn[rt][ks]; }
#pragma unroll
                for (int rt = 0; rt < 4; ++rt)
#pragma unroll
                    for (int ks = 0; ks < 2; ++ks) { asm volatile("" : "+v"(kf[rt][ks])); asm volatile("" : "+v"(vf[rt][ks])); }
                t1 = ticket(QCNT + 1);
                { const int j1 = t1 < nsp ? t1 : nsp - 1; load_k(1 + j1, kn); load_v(1 + j1, vn); }
                int nj; const int ntl = make_list(1 + t0, nj);
                for (int tl = 0; tl < ntl; ++tl) {
                    bool valid; const int q = col_query(tl, nj, valid);
                    f32x4 st[4]; scores(kf, q, valid, st);
                    float mr;
                    if (FAST) mr = __int_as_float(MREF[q * 4 + hd]);
                    else { const int key = MREF[q * 4 + hd]; const int ib = key >= 0 ? key : (key ^ 0x7fffffff); mr = __int_as_float(ib); mr = (mr > NEG) ? mr : 0.f; }
                    float ps = 0.f; mr -= os_e2;
#pragma unroll
                    for (int rt = 0; rt < 4; ++rt)
#pragma unroll
                        for (int e = 0; e < 4; ++e) { st[rt][e] = fexp2((st[rt][e] - mr) * AL2E); ps += st[rt][e]; }
                    ps = xor32_sum(xor16_sum(ps));
                    if (FAST) { if (ps > 218.0f * os_scale) FLAGW[0] = 1; }
                    f32x4 o[4];
#pragma unroll
                    for (int dt = 0; dt < 4; ++dt) o[dt] = (f32x4){0.f, 0.f, 0.f, 0.f};
#pragma unroll
                    for (int sp = 0; sp < 2; ++sp) {
                        u32x4 pw; pw.x = pk2(st[2 * sp][0], st[2 * sp][1]); pw.y = pk2(st[2 * sp][2], st[2 * sp][3]); pw.z = pk2(st[2 * sp + 1][0], st[2 * sp + 1][1]); pw.w = pk2(st[2 * sp + 1][2], st[2 * sp + 1][3]);
                        const bf16x8 pb = __builtin_bit_cast(bf16x8, pw);
#pragma unroll
                        for (int dt = 0; dt < 4; ++dt) o[dt] = MFMA16(vf[dt][sp], pb, o[dt]);
                    }
                    if (valid) {
                        LAS int* op = OS + q * OS_QS + hd * OS_HS + 4 * kq;
#pragma unroll
                        for (int dt = 0; dt < 4; ++dt)
#pragma unroll
                            for (int e = 0; e < 4; ++e) __hip_atomic_fetch_add(op + 16 * dt + e, (int)o[dt][e], __ATOMIC_RELAXED, __HIP_MEMORY_SCOPE_WORKGROUP);
                        if (kq == 0) __hip_atomic_fetch_add(LS + q * 4 + hd, (unsigned)(ps * ls_scale + 0.5f), __ATOMIC_RELAXED, __HIP_MEMORY_SCOPE_WORKGROUP);
                    }
                }
                t0 = t1;
            }
            asm volatile("s_waitcnt vmcnt(0)" ::: "memory");
        };
        for (int rep2_ = 0; rep2_ < REP_B3; ++rep2_) {
            if (rep2_ > 0) { __syncthreads(); if (F.tid == 0) QCNT[1] = 0; __syncthreads(); }
            run_pass2(true);
        }
        __syncthreads();
        exact = (FLAGW[0] != 0) || (REP_B2 > 1);
        if (exact) {
            __syncthreads();
            for (int i = F.tid; i < 64 * OS_QS; i += 512) OS[i] = 0;
            if (F.tid < 256) { MREF[F.tid] = (int)0x80000000; LS[F.tid] = 0u; }
            if (F.tid < 2) QCNT[F.tid] = 0;
            __syncthreads();
            {
                bf16x8 kf[4][2], kn[4][2], kn2[4][2];
                int t0 = ticket(QCNT), t1 = ticket(QCNT), t2;
                if (t0 < nsp) load_k(1 + t0, kf);
                if (t1 < nsp) load_k(1 + t1, kn);
                while (t0 < nsp) {
                    t2 = ticket(QCNT);
                    if (t2 < nsp) load_k(1 + t2, kn2);
                    int nj; const int ntl = make_list(1 + t0, nj);
                    for (int tl = 0; tl < ntl; ++tl) {
                        bool valid; const int q = col_query(tl, nj, valid);
                        f32x4 st[4]; scores(kf, q, valid, st);
                        float bm = NEG;
#pragma unroll
                        for (int rt = 0; rt < 4; ++rt)
#pragma unroll
                            for (int e = 0; e < 4; ++e) bm = fmaxf(bm, st[rt][e]);
                        bm = xor32_max(xor16_max(bm));
                        if (valid && kq == 0) { const int ib = __float_as_int(bm); const int key = ib >= 0 ? ib : (ib ^ 0x7fffffff);
                            __hip_atomic_fetch_max(MREF + q * 4 + hd, key, __ATOMIC_RELAXED, __HIP_MEMORY_SCOPE_WORKGROUP); }
                    }
#pragma unroll
                    for (int rt = 0; rt < 4; ++rt)
#pragma unroll
                        for (int ks = 0; ks < 2; ++ks) { kf[rt][ks] = kn[rt][ks]; kn[rt][ks] = kn2[rt][ks]; }
                    t0 = t1; t1 = t2;
                }
            }
            __syncthreads();
            run_pass2(false);
            __syncthreads();
        }
        }
        {
            float ms_ = NEG, ls_ = 0.f;
            if (nsp > 0) { const int key = MREF[ql * 4 + gq]; const int ib = key >= 0 ? key : (key ^ 0x7fffffff); const float m0 = exact ? __int_as_float(ib) : msp;
                if ((!exact || key != (int)0x80000000) && m0 > NEG) { ms_ = m0; ls_ = (float)LS[ql * 4 + gq] * (1.0f / 1048576.0f); } }
            const float Mx = fmaxf(mf, ms_);
            const float wf = fexp2((mf - Mx) * AL2E), ws_ = (ms_ > NEG) ? fexp2((ms_ - Mx) * AL2E) : 0.f;
            const float Lt = lf * wf + ls_ * ws_;
            const float g1 = sigmoidf_(bf2f(grow[1])) / fmaxf(Lt, 1e-30f);
            const float cf = g1 * wf, cs = g1 * ws_ * os_inv;
            const LAS int* ap = OS + ql * OS_QS + gq * OS_HS; float osq = 0.f;
            bf16_t* op = oatt + trow * 1024 + (hkv * 4 + gq) * 64;
#pragma unroll
            for (int g4 = 0; g4 < 4; ++g4) { const int d = 8 * g4 + 4 * h;
                const u32x2 p0 = *(const u32x2*)(op + d), p1 = *(const u32x2*)(op + 32 + d);
                const f32x4 f0 = *(const f32x4*)(park + 4 * g4), f1 = *(const f32x4*)(park + 16 + 4 * g4);
                float s0[4], s1[4];
#pragma unroll
                for (int e = 0; e < 4; ++e) { s0[e] = (nsp > 0) ? (float)ap[d + e] : 0.f; s1[e] = (nsp > 0) ? (float)ap[32 + d + e] : 0.f; }
                u32x2 w0, w1;
                w0.x = pk2(bflo(p0.x) + cf * f0[0] + cs * s0[0], bfhi(p0.x) + cf * f0[1] + cs * s0[1]); w0.y = pk2(bflo(p0.y) + cf * f0[2] + cs * s0[2], bfhi(p0.y) + cf * f0[3] + cs * s0[3]);
                w1.x = pk2(bflo(p1.x) + cf * f1[0] + cs * s1[0], bfhi(p1.x) + cf * f1[1] + cs * s1[1]); w1.y = pk2(bflo(p1.y) + cf * f1[2] + cs * s1[2], bfhi(p1.y) + cf * f1[3] + cs * s1[3]);
                *(u32x2*)(op + d) = w0; *(u32x2*)(op + 32 + d) = w1;
                osq += (bflo(w0.x) * bflo(w0.x) + bfhi(w0.x) * bfhi(w0.x)) + (bflo(w0.y) * bflo(w0.y) + bfhi(w0.y) * bfhi(w0.y)) + (bflo(w1.x) * bflo(w1.x) + bfhi(w1.x) * bfhi(w1.x)) + (bflo(w1.y) * bflo(w1.y) + bfhi(w1.y) * bfhi(w1.y)); }
            (void)__hip_atomic_fetch_add(sst + trow * 2, (unsigned long long)(osq * 16777216.f), __ATOMIC_RELAXED, __HIP_MEMORY_SCOPE_AGENT);
        }
    }
    __syncthreads();
}

DI void attn_phase(Frame& F, const bf16_t* proj, const bf16_t* kcb, const bf16_t* vctb, const bf16_t* vts, const bf16_t* vtw, bf16_t* oatt, const unsigned* vmax_word, float* park, unsigned* qctr, const bf16_t* kfs, unsigned long long* sst) {
    const float vmaxf = fmaxf(__uint_as_float(__hip_atomic_load(vmax_word, __ATOMIC_RELAXED, __HIP_MEMORY_SCOPE_AGENT)), 1e-20f);
    int e2 = (int)floorf(log2f(2.0e9f / (1100.0f * 55.0f * vmaxf)));
    e2 = e2 > 100 ? 100 : (e2 < -100 ? -100 : e2);
    const float os_scale = exp2f((float)e2), os_inv = exp2f((float)-e2);
    LAS int* QW = (LAS int*)(F.lds + LDS_QCNT + 8);
    int xq; { unsigned xx; asm volatile("s_getreg_b32 %0, hwreg(20, 0, 4)" : "=s"(xx)); xq = (int)(xx & 7u); }
    for (int tries = 0; tries < 8; ) {
        __syncthreads();
        if (F.tid == 0) QW[0] = (int)__hip_atomic_fetch_add(qctr + xq, 1u, __ATOMIC_RELAXED, __HIP_MEMORY_SCOPE_AGENT);
        __syncthreads();
        const int k = __builtin_amdgcn_readfirstlane(QW[0]);
        if (k >= 192) { xq = (xq + 1) & 7; ++tries; continue; }
        int bh, qb;
        if (xq < 6) { bh = xq; qb = 4 * (63 - k / 3) + (2 - k % 3); }
        else { bh = 3 * (xq - 6) + (k >> 6); qb = 4 * (63 - (k & 63)) + 3; }
        attn_unit(F, proj, kcb, vctb, vts, vtw, oatt, bh, qb, os_scale, os_inv, (float)e2, park + (size_t)F.bid * 16384 + (size_t)F.tid * 32, kfs, sst);
    }
    __syncthreads();
}


#define XB_TMO      128
#define XB_XCNT(j)  (256  + 64 * (j))
#define XB_XSUB(j)  (1280 + 64 * (j))
#define XB_XGEN(j)  (2304 + 64 * (j))
#define XB_TOP      3328
#define XB_TOPGEN   3392
#define XCD_BAR_WORDS 3456
#define XB_SPIN_CAP (1u << 22)
DI unsigned xb_ld(unsigned* p)              { return __hip_atomic_load(p, __ATOMIC_RELAXED, __HIP_MEMORY_SCOPE_AGENT); }
DI unsigned xb_add(unsigned* p, unsigned v) { return __hip_atomic_fetch_add(p, v, __ATOMIC_RELAXED, __HIP_MEMORY_SCOPE_AGENT); }
DI unsigned xb_xcc_id() { unsigned x; asm volatile("s_getreg_b32 %0, hwreg(20, 0, 4)" : "=s"(x)); return x & 0xFu; }
#define XB_SPIN(cond, bar) do { unsigned _sp = 0; while (cond) { __builtin_amdgcn_s_sleep(1); \
    if ((++_sp & 255u) == 0u) { if (xb_ld(&(bar)[XB_TMO])) break; if (_sp > XB_SPIN_CAP) { atomicAdd(&(bar)[XB_TMO], 1u); break; } } } } while (0)
DI void xcd_barrier_complete(unsigned* bar, unsigned x, unsigned& nloc, unsigned& nx) {
    const unsigned G = gridDim.x * gridDim.y * gridDim.z;
    unsigned sum, cnt, mine, sp = 0u;
    for (;;) {
        sum = 0u; cnt = 0u; mine = 0u;
#pragma unroll
        for (unsigned j = 0; j < 16; ++j) { const unsigned c = xb_ld(&bar[XB_XCNT(j)]); sum += c; cnt += (c > 0u) ? 1u : 0u; mine = (j == x) ? c : mine; }
        if (sum == G) break;
        __builtin_amdgcn_s_sleep(1);
        if ((++sp & 255u) == 0u) { if (xb_ld(&bar[XB_TMO])) break; if (sp > XB_SPIN_CAP) { atomicAdd(&bar[XB_TMO], 1u); break; } }
    }
    nloc = mine > 0u ? mine : 1u; nx = cnt > 0u ? cnt : 1u;
}
DI void xcd_barrier(unsigned* bar, volatile LAS unsigned* st, int tid) {
    asm volatile("s_waitcnt vmcnt(0)" ::: "memory");
    __syncthreads();
    if (tid == 0) {
        const unsigned x = xb_xcc_id();
        __builtin_amdgcn_s_waitcnt(0);
        unsigned nloc = st[0], nx = st[1];
        if (nloc == 0u) { xcd_barrier_complete(bar, x, nloc, nx); st[0] = nloc; st[1] = nx; }
        const unsigned old = xb_add(&bar[XB_XSUB(x)], 1u);
        const unsigned gen = old / nloc;
        if (old + 1u == (gen + 1u) * nloc) {
            __builtin_amdgcn_fence(__ATOMIC_RELEASE, "agent");
            asm volatile("s_waitcnt vmcnt(0)" ::: "memory");
            const unsigned og = xb_add(&bar[XB_TOP], 1u);
            const unsigned tg = og / nx;
            if (og + 1u == (tg + 1u) * nx) xb_add(&bar[XB_TOPGEN], 1u);
            else XB_SPIN(xb_ld(&bar[XB_TOPGEN]) == tg, bar);
            __builtin_amdgcn_fence(__ATOMIC_ACQUIRE, "agent");
            xb_add(&bar[XB_XGEN(x)], 1u);
            asm volatile("s_waitcnt vmcnt(0)" ::: "memory");
        } else {
            XB_SPIN(xb_ld(&bar[XB_XGEN(x)]) == gen, bar);
            __builtin_amdgcn_fence(__ATOMIC_ACQUIRE, "agent");
            asm volatile("s_waitcnt vmcnt(0)" ::: "memory");
        }
    }
    __syncthreads();
}

#define REFRESH() do { int w_ = wave0, b_ = blockIdx.x, g_ = gridDim.x; asm volatile("" : "+s"(w_), "+s"(b_), "+s"(g_)); \
    int l_; asm volatile("v_mbcnt_lo_u32_b32 %0, -1, 0\n\tv_mbcnt_hi_u32_b32 %0, -1, %0" : "=v"(l_)); \
    F.lane = l_; F.wave = w_; F.tid = w_ * 64 + l_; F.bid = b_; F.G = g_; F.gw = b_ * 8 + w_; F.ngw = g_ * 8; } while (0)
#define XBAR() xcd_barrier((unsigned*)(F.wsp() + WS_CTL), (volatile LAS unsigned*)(F.lds + LDS_PT + 232), F.tid)
#if REP_SYNC > 1
#define GSYNC() do { XBAR(); XBAR(); REFRESH(); } while (0)
#else
#define GSYNC() do { REFRESH(); XBAR(); REFRESH(); } while (0)
#endif
#define WSP(off) (F.wsp() + (off))
#define WL(off) (F.wsp() + WS_W + (size_t)l * WL_STRIDE + (off))
#define MSL(off) (F.wsp() + WS_MISC + (size_t)l * MS_L + (off))
#define CTL(off) (F.wsp() + WS_CTL + CT_BASE + (size_t)l * CT_L + (off))
__global__ void __launch_bounds__(512, 2) mk_fwd(Params p) {
    extern __shared__ __attribute__((aligned(16))) unsigned char lds_raw[];
    cg::grid_group grid = cg::this_grid();
    Frame F;
    F.lds = (LAS unsigned char*)lds_raw; F.pt = (LAS const unsigned long long*)(F.lds + LDS_PT);
    const int wave0 = __builtin_amdgcn_readfirstlane((int)threadIdx.x >> 6);
    REFRESH();
    {
        LAS unsigned long long* ptw = (LAS unsigned long long*)(F.lds + LDS_PT);
        if (F.tid < 26) ptw[F.tid] = (unsigned long long)p.in[F.tid];
        if (F.tid == 26) ptw[26] = (unsigned long long)p.out;
        if (F.tid == 27) ptw[27] = (unsigned long long)p.ws;
        if (F.tid == 28) ptw[29] = 0ull;
        if (F.tid == 0) (void)xb_add((unsigned*)p.ws + XB_XCNT(xb_xcc_id()), 1u);
    }
    __syncthreads();

    PH(2, convert_rows_stats(F, F.in(0), (bf16_t*)WSP(WS_ACT), (unsigned long long*)WSP(WS_SSX)); REFRESH(););
    { unsigned long long* z = (unsigned long long*)WSP(WS_SSX) + (size_t)NT * 2; for (int i = F.bid * 512 + F.tid; i < (NL - 1) * NT * 2; i += F.G * 512) z[i] = 0ull; }
    { unsigned long long* z = (unsigned long long*)WSP(WS_SST); for (int i = F.bid * 512 + F.tid; i < NL * NT * 2; i += F.G * 512) z[i] = 0ull; }
    PH(0, prologue_a(F, 0, F.gw, F.ngw); REFRESH(););
    if (F.G == 0x7fffffff) grid.sync();
    GSYNC();
    PH(1, prologue_b(F); REFRESH(););
    if (F.G != 256) { prologue_a(F, 1, F.gw, F.ngw); __syncthreads(); REFRESH(); }
    else if (F.bid >= 128) { prologue_a(F, 1, (F.bid - 128) * 8 + F.wave, 1024); __syncthreads(); REFRESH(); }

#if STAGE >= 2
#pragma unroll 1
    for (int l = 0; l < NL; ++l) {
        REFRESH();
        { pg8::APlain g{(l == 0) ? (const char*)WSP(WS_ACT) : (const char*)F.out(), (const char*)WL(WO_WIN), 1024}; pg8::StaticOrder S; S.init(NT / 256, PW / 256, F.G, F.bid);
          pg8::EpiBf16 E{(bf16_t*)WSP(WS_PROJ), PW, (const unsigned long long*)WSP(WS_SSX) + (size_t)l * NT * 2}; pg8::gemm_phase<pg8::EpiBf16, pg8::APlain, true>(F.lds, g, S, E, F.tid); }
#if REP_INPROJ > 1
        REFRESH();
        { pg8::APlain g{(l == 0) ? (const char*)WSP(WS_ACT) : (const char*)F.out(), (const char*)WL(WO_WIN), 1024}; pg8::StaticOrder S; S.init(NT / 256, PW / 256, F.G, F.bid);
          pg8::EpiBf16 E{(bf16_t*)WSP(WS_PROJ), PW, (const unsigned long long*)WSP(WS_SSX) + (size_t)l * NT * 2}; pg8::gemm_phase<pg8::EpiBf16, pg8::APlain, true>(F.lds, g, S, E, F.tid); }
#endif
        GSYNC();
#define LOCAL_HANDOFF() do { asm volatile("s_waitcnt vmcnt(0)" ::: "memory"); __syncthreads(); if (F.tid == 0) { __builtin_amdgcn_fence(__ATOMIC_ACQUIRE, "agent"); asm volatile("s_waitcnt vmcnt(0)" ::: "memory"); } __syncthreads(); } while (0)
        if (F.G == 256) {
            if (F.bid < 48) {
                REFRESH();
                { pg8::ACompress g{(const char*)WSP(WS_PROJ), (const char*)WL(WO_W1)}; pg8::StaticOrder S; S.init_run(F.bid, 0, 1);
                  pg8::EpiCmpHid E{(bf16_t*)WSP(WS_HIDC), (const float*)CTL(CT_CB1)}; pg8::gemm_phase<pg8::EpiCmpHid, pg8::ACompress, true>(F.lds, g, S, E, F.tid); }
                REFRESH(); LOCAL_HANDOFF(); REFRESH();
                { const int pm = F.bid, it = (pm / 24) * 192 + (pm % 24) * 8 + F.wave;
                  compress2_phase(F, (const bf16_t*)WSP(WS_HIDC), (const bf16_t*)CTL(CT_W2T), F.in(7) + (size_t)l * 2 * 64, (bf16_t*)WSP(WS_KC), (bf16_t*)WSP(WS_VCT), it, it + 1, 1); }
            } else if (F.bid < 80) {
                REFRESH();
                { pg8::ASsm1 g{(const char*)WSP(WS_UC), (const char*)WL(WO_SS1)}; pg8::StaticOrder S; S.init_run((F.bid - 48) * 4, 1, 4);
                  pg8::EpiSsm1 E{(float*)WSP(WS_YI), (float*)WSP(WS_HL)}; pg8::gemm_phase<pg8::EpiSsm1, pg8::ASsm1, true>(F.lds, g, S, E, F.tid); }
                REFRESH(); LOCAL_HANDOFF(); REFRESH();
                ssm_carry_phase(F, (const float*)WSP(WS_HL), (const f32x2*)CTL(CT_AB16), (const f32x2*)CTL(CT_AB1K), (bf16_t*)WSP(WS_HIN), F.bid - 48, F.bid - 47, 1);
            } else {
                REFRESH();
                vtranspose_phase(F, (const bf16_t*)WSP(WS_PROJ), (bf16_t*)WSP(WS_VTS), (bf16_t*)WSP(WS_VTW), (bf16_t*)WSP(WS_KFS), (unsigned*)WSP(WS_CTL) + 3584 + l, 80);
                __syncthreads(); REFRESH();
                { pg8::ASsm1 g{(const char*)WSP(WS_UC), (const char*)WL(WO_SS1)}; pg8::StaticOrder S; S.init(128, 1, 176, F.bid - 80);
                  pg8::EpiSsm1 E{(float*)WSP(WS_YI), (float*)WSP(WS_HL)}; pg8::gemm_phase<pg8::EpiSsm1, pg8::ASsm1, true>(F.lds, g, S, E, F.tid); }
            }
            GSYNC();
        } else {
        PH(3, REFRESH(); vtranspose_phase(F, (const bf16_t*)WSP(WS_PROJ), (bf16_t*)WSP(WS_VTS), (bf16_t*)WSP(WS_VTW), (bf16_t*)WSP(WS_KFS), (unsigned*)WSP(WS_CTL) + 3584 + l, 48);
        __syncthreads(); REFRESH(););
        PH(4, REFRESH();
        { pg8::ACompress g{(const char*)WSP(WS_PROJ), (const char*)WL(WO_W1)}; pg8::StaticOrder S; S.init(48, 1, F.G, F.bid);
          pg8::EpiCmpHid E{(bf16_t*)WSP(WS_HIDC), (const float*)CTL(CT_CB1)}; pg8::gemm_phase<pg8::EpiCmpHid, pg8::ACompress, true>(F.lds, g, S, E, F.tid); });
        PH(5, REFRESH();
        { pg8::ASsm1 g{(const char*)WSP(WS_UC), (const char*)WL(WO_SS1)}; pg8::StaticOrder S; S.init(128, 2, F.G, F.bid);
          pg8::EpiSsm1 E{(float*)WSP(WS_YI), (float*)WSP(WS_HL)}; pg8::gemm_phase<pg8::EpiSsm1, pg8::ASsm1, true>(F.lds, g, S, E, F.tid); });
        GSYNC();
        PH(6, compress2_phase(F, (const bf16_t*)WSP(WS_HIDC), (const bf16_t*)CTL(CT_W2T), F.in(7) + (size_t)l * 2 * 64, (bf16_t*)WSP(WS_KC), (bf16_t*)WSP(WS_VCT), F.gw, 2 * 192, F.ngw);
        __syncthreads(); REFRESH(););
        PH(7, ssm_carry_phase(F, (const float*)WSP(WS_HL), (const f32x2*)CTL(CT_AB16), (const f32x2*)CTL(CT_AB1K), (bf16_t*)WSP(WS_HIN), F.bid, 32, F.G); REFRESH(););
        GSYNC();
        }
        PH(8,         REFRESH();
        { pg8::ASsm2 g{(const char*)WSP(WS_HIN), (const char*)WL(WO_SS2)}; pg8::StaticOrder S; S.init(128, 1, F.G, F.bid);
          pg8::EpiSsm2 E{(const float*)WSP(WS_YI), (const bf16_t*)WSP(WS_PROJ), F.in(15) + (size_t)l * 256, (bf16_t*)WSP(WS_YS2)}; pg8::gemm_phase<pg8::EpiSsm2, pg8::ASsm2, true>(F.lds, g, S, E, F.tid); });
#if STAGE >= 3
        REFRESH();
        attn_phase(F, (const bf16_t*)WSP(WS_PROJ), (const bf16_t*)WSP(WS_KC), (const bf16_t*)WSP(WS_VCT), (const bf16_t*)WSP(WS_VTS), (const bf16_t*)WSP(WS_VTW), (bf16_t*)WSP(WS_OATT), (const unsigned*)WSP(WS_CTL) + 3584 + l, (float*)WSP(WS_PARK), (unsigned*)WSP(WS_CTL) + 3600 + 16 * l, (const bf16_t*)WSP(WS_KFS), (unsigned long long*)WSP(WS_SST) + (size_t)l * NT * 2);
#if REP_ATTN > 1
        REFRESH();
        attn_phase(F, (const bf16_t*)WSP(WS_PROJ), (const bf16_t*)WSP(WS_KC), (const bf16_t*)WSP(WS_VCT), (const bf16_t*)WSP(WS_VTS), (const bf16_t*)WSP(WS_VTW), (bf16_t*)WSP(WS_OATT), (const unsigned*)WSP(WS_CTL) + 3584 + l, (float*)WSP(WS_PARK), (unsigned*)WSP(WS_CTL) + 3600 + 16 * l, (const bf16_t*)WSP(WS_KFS), (unsigned long long*)WSP(WS_SST) + (size_t)l * NT * 2);
#endif
#else
        { unsigned* oz = (unsigned*)WSP(WS_OATT); for (size_t i = (size_t)F.bid * 512 + F.tid; i < (size_t)NT * 768 / 2; i += (size_t)F.G * 512) oz[i] = 0u; }
#endif
        GSYNC();
        PH(9,         REFRESH();
        { pg8::APlain g{(const char*)WSP(WS_YS2), (const char*)MSL(MS_WGLU), 256}; pg8::StaticOrder S; S.init(NT / 256, 2, F.G, F.bid);
          pg8::EpiGlu E{(bf16_t*)WSP(WS_OATT), F.in(17) + (size_t)l * 512, (unsigned long long*)WSP(WS_SST) + (size_t)l * NT * 2}; pg8::gemm_phase<pg8::EpiGlu, pg8::APlain, true>(F.lds, g, S, E, F.tid); });
        GSYNC();
        REFRESH();
        { pg8::APlain g{(const char*)WSP(WS_OATT), (const char*)WL(WO_WOUT), 1024}; pg8::StaticOrder S; S.init(NT / 256, 4, F.G, F.bid);
          pg8::EpiResB<true, 0> E{(l == 0) ? F.in(0) : (const float*)nullptr, (const bf16_t*)F.out(), (bf16_t*)F.out(), (const unsigned long long*)WSP(WS_SST) + (size_t)l * NT * 2, (unsigned long long*)nullptr}; pg8::gemm_phase<pg8::EpiResB<true, 0>, pg8::APlain, true>(F.lds, g, S, E, F.tid); }
        GSYNC();
#if STAGE >= 4
        PH(11, rmsnorm_rows_xb<1>(F, (const bf16_t*)F.out(), F.in(21) + (size_t)l * DM, WSP(WS_ACT)); REFRESH(););
        GSYNC();
        REFRESH();
        { pg8::APlain g{(const char*)WSP(WS_ACT), (const char*)WL(WO_WGU), 512, 0x7c7c7c7c, 0x7c7c7c7c}; pg8::StaticOrder S; S.init(NT / 256, 22, F.G, F.bid);
          pg8::EpiSwiglu8 E{(unsigned char*)WSP(WS_PROJ), 0.015625f * FP8FIX}; pg8::gemm_phase<pg8::EpiSwiglu8, pg8::APlain, true, true>(F.lds, g, S, E, F.tid); }
        GSYNC();
        REFRESH();
        { pg8::APlain g{(const char*)WSP(WS_PROJ), (const char*)WL(WO_WD), DFF / 2, 0x7b7b7b7b, 0x7b7b7b7b}; pg8::StaticOrder S; S.init(NT / 256, 4, F.G, F.bid);
          pg8::EpiResB<false, 8> E{(const float*)nullptr, (const bf16_t*)F.out(), (l == NL - 1) ? (bf16_t*)WSP(WS_XLAST) : (bf16_t*)F.out(), (const unsigned long long*)nullptr, (l == NL - 1) ? (unsigned long long*)nullptr : (unsigned long long*)WSP(WS_SSX) + (size_t)(l + 1) * NT * 2}; pg8::gemm_phase<pg8::EpiResB<false, 8>, pg8::APlain, true, true>(F.lds, g, S, E, F.tid); }
        GSYNC();
#endif
#if STAGE < 5
        break;
#endif
    }
    rmsnorm_rows_xb<2>(F, (const bf16_t*)WSP(WS_XLAST), F.in(25), F.out());
#else
    {
        const float* x0 = F.in(0); const float* fg = F.in(25); float* X = F.out();
        for (int m = F.gw; m < NT; m += F.ngw) {
            const f32x4* xr = (const f32x4*)(x0 + (size_t)m * DM) + F.lane; f32x4 v[4]; float s = 0.f;
#pragma unroll
            for (int j = 0; j < 4; ++j) { v[j] = xr[64 * j]; s += (v[j].x * v[j].x + v[j].y * v[j].y) + (v[j].z * v[j].z + v[j].w * v[j].w); }
            const float rstd = rsqrtf(wave_sum(s) * (1.f / DM) + 1e-6f);
            f32x4* o = (f32x4*)(X + (size_t)m * DM) + F.lane;
#pragma unroll
            for (int j = 0; j < 4; ++j) o[64 * j] = v[j] * rstd * ((const f32x4*)fg)[64 * j + F.lane];
        }
    }
#endif
}

extern "C" void kernel_launch(void* const* d_in, const int* in_sizes, int n_in, void* d_out, int out_size, void* d_ws, size_t ws_size, hipStream_t stream) {
    static int grid_blocks = 0;
    if (grid_blocks == 0) {
        if (n_in != 26 || ws_size < WS_END) { fprintf(stderr, "kernel_launch: unexpected n_in %d or ws_size %zu (< %zu)\n", n_in, ws_size, (size_t)WS_END); grid_blocks = -1; return; }
        int dev = 0, cus = 0, per_cu = 0;
        hipGetDevice(&dev);
        hipDeviceGetAttribute(&cus, hipDeviceAttributeMultiprocessorCount, dev);
        hipFuncSetAttribute((const void*)mk_fwd, hipFuncAttributeMaxDynamicSharedMemorySize, LDS_BYTES);
        hipOccupancyMaxActiveBlocksPerMultiprocessor(&per_cu, (const void*)mk_fwd, 512, LDS_BYTES);
        if (per_cu < 1) { fprintf(stderr, "kernel_launch: occupancy query says %d blocks per CU\n", per_cu); per_cu = 1; }
        grid_blocks = cus;
        (void)hipGetLastError();
    }
    if (grid_blocks < 0) return;
    if (hipMemsetAsync((char*)d_ws + WS_CTL, 0, 16384, stream) != hipSuccess) { fprintf(stderr, "kernel_launch: memset of the barrier words failed\n"); return; }
    Params p{};
    for (int i = 0; i < 26; ++i) p.in[i] = (const float*)d_in[i];
    p.out = (float*)d_out; p.ws = (unsigned char*)d_ws;
    void* args[] = {&p};
    hipError_t e = hipLaunchCooperativeKernel((const void*)mk_fwd, dim3(grid_blocks), dim3(512), args, LDS_BYTES, stream);
    if (e != hipSuccess) fprintf(stderr, "cooperative launch failed: %s (grid %d)\n", hipGetErrorString(e), grid_blocks);
}
```

```cpp
#include <hip/hip_runtime.h>
#include <hip/hip_cooperative_groups.h>
#include <cstdio>
#include <cstdint>
namespace cg = cooperative_groups;

#ifndef STAGE
#define STAGE 99
#endif
#ifndef REP_ATTN
#define REP_ATTN 1
#endif
#ifndef REP_B1
#define REP_B1 1
#endif
#ifndef REP_B2
#define REP_B2 1
#endif
#ifndef REP_B3
#define REP_B3 1
#endif
#ifndef REP_TK
#define REP_TK 1
#endif
#ifndef FP8FIX
#define FP8FIX 1.0f
#endif
#ifndef PROBE_DUP
#define PROBE_DUP 0
#endif
#define PH(bit, ...) do { __VA_ARGS__ if (PROBE_DUP & (1 << (bit))) { __VA_ARGS__ } } while (0)
#ifndef FORCE_REDO
#define FORCE_REDO 0
#endif
#ifndef REP_GU
#define REP_GU 1
#endif
#ifndef REP_INPROJ
#define REP_INPROJ 1
#endif
#ifndef REP_SYNC
#define REP_SYNC 1
#endif

#define DI __device__ __forceinline__
#define LAS __attribute__((address_space(3)))
typedef unsigned short bf16_t;
typedef short bf16x8 __attribute__((ext_vector_type(8)));
typedef short s16x4 __attribute__((ext_vector_type(4)));
typedef float f32x4 __attribute__((ext_vector_type(4)));
typedef float f32x2 __attribute__((ext_vector_type(2)));
typedef float f32x16 __attribute__((ext_vector_type(16)));
typedef unsigned u32x4 __attribute__((ext_vector_type(4)));
typedef unsigned u32x2 __attribute__((ext_vector_type(2)));
typedef __bf16 bf2_t __attribute__((ext_vector_type(2)));
typedef int i32x8 __attribute__((ext_vector_type(8)));
typedef int i32x4 __attribute__((ext_vector_type(4)));

DI float clamp8(float v) { return fminf(fmaxf(v, -440.f), 440.f); }
DI unsigned pk4_fp8(float a, float b, float c, float d) { int w = 0; w = __builtin_amdgcn_cvt_pk_fp8_f32(clamp8(a), clamp8(b), w, false); w = __builtin_amdgcn_cvt_pk_fp8_f32(clamp8(c), clamp8(d), w, true); return (unsigned)w; }
DI unsigned pk2(float lo, float hi) { f32x2 v = {lo, hi}; return __builtin_bit_cast(unsigned, __builtin_convertvector(v, bf2_t)); }
DI bf16_t f2bf(float f) { return (bf16_t)(pk2(f, 0.f) & 0xffffu); }
DI float bf2f(bf16_t u) { return __uint_as_float((unsigned)u << 16); }
DI float bflo(unsigned w) { return __uint_as_float(w << 16); }
DI float bfhi(unsigned w) { return __uint_as_float(w & 0xffff0000u); }
DI float fexp2(float x) { return __builtin_amdgcn_exp2f(x); }
DI float sigmoidf_(float x) { return __builtin_amdgcn_rcpf(1.0f + __builtin_amdgcn_exp2f(-1.4426950408889634f * x)); }
DI float gelu_tanh(float x) { const float y = 0.7978845608028654f * (x + 0.044715f * x * x * x); return x * __builtin_amdgcn_rcpf(1.0f + __builtin_amdgcn_exp2f(-2.8853900817779268f * y)); }
template <int CTRL> DI float dppf(float v) { return __builtin_bit_cast(float, __builtin_amdgcn_update_dpp(0, __builtin_bit_cast(int, v), CTRL, 0xF, 0xF, false)); }
struct F2 { float lo, hi; };
DI F2 halves32(float v) { const auto r = __builtin_amdgcn_permlane32_swap(__float_as_uint(v), __float_as_uint(v), false, false); return {__uint_as_float(r[0]), __uint_as_float(r[1])}; }
DI F2 rows16(float v) { const auto r = __builtin_amdgcn_permlane16_swap(__float_as_uint(v), __float_as_uint(v), false, false); return {__uint_as_float(r[0]), __uint_as_float(r[1])}; }
DI float xor32_sum(float v) { const F2 p = halves32(v); return p.lo + p.hi; }
DI float xor32_max(float v) { const F2 p = halves32(v); return fmaxf(p.lo, p.hi); }
DI float xor16_sum(float v) { const F2 p = rows16(v); return p.lo + p.hi; }
DI float xor16_max(float v) { const F2 p = rows16(v); return fmaxf(p.lo, p.hi); }
DI float wave_sum(float v) {
    v += dppf<0xB1>(v); v += dppf<0x4E>(v); v += dppf<0x141>(v); v += dppf<0x140>(v);
    return xor32_sum(xor16_sum(v));
}

DI unsigned wave_max_u32(unsigned v) {
    v = max(v, (unsigned)__builtin_amdgcn_update_dpp(0, (int)v, 0xB1, 0xF, 0xF, false));
    v = max(v, (unsigned)__builtin_amdgcn_update_dpp(0, (int)v, 0x4E, 0xF, 0xF, false));
    v = max(v, (unsigned)__builtin_amdgcn_update_dpp(0, (int)v, 0x141, 0xF, 0xF, false));
    v = max(v, (unsigned)__builtin_amdgcn_update_dpp(0, (int)v, 0x140, 0xF, 0xF, false));
    const unsigned a = __builtin_amdgcn_readlane(v, 0), b = __builtin_amdgcn_readlane(v, 16), c = __builtin_amdgcn_readlane(v, 32), d = __builtin_amdgcn_readlane(v, 48);
    return max(max(a, b), max(c, d));
}
#define WMAX_STEP4(ctl) "v_max_u32_dpp %0, %0, %0 " ctl "\n\tv_max_u32_dpp %1, %1, %1 " ctl "\n\tv_max_u32_dpp %2, %2, %2 " ctl "\n\tv_max_u32_dpp %3, %3, %3 " ctl "\n\t"
DI void wave_max4_lane63(unsigned& a, unsigned& b, unsigned& c, unsigned& d) {
    asm volatile("s_nop 1\n\t"
                 WMAX_STEP4("quad_perm:[1,0,3,2] row_mask:0xf bank_mask:0xf bound_ctrl:1")
                 WMAX_STEP4("quad_perm:[2,3,0,1] row_mask:0xf bank_mask:0xf bound_ctrl:1")
                 WMAX_STEP4("row_half_mirror row_mask:0xf bank_mask:0xf bound_ctrl:1")
                 WMAX_STEP4("row_mirror row_mask:0xf bank_mask:0xf bound_ctrl:1")
                 WMAX_STEP4("row_bcast:15 row_mask:0xa bank_mask:0xf")
                 WMAX_STEP4("row_bcast:31 row_mask:0xc bank_mask:0xf")
                 "s_nop 1"
                 : "+v"(a), "+v"(b), "+v"(c), "+v"(d));
}
DI unsigned wave_max_u32_b(unsigned v) {
    v = max(v, (unsigned)__builtin_amdgcn_update_dpp(0, (int)v, 0xB1, 0xF, 0xF, false));
    v = max(v, (unsigned)__builtin_amdgcn_update_dpp(0, (int)v, 0x4E, 0xF, 0xF, false));
    v = max(v, (unsigned)__builtin_amdgcn_update_dpp(0, (int)v, 0x141, 0xF, 0xF, false));
    v = max(v, (unsigned)__builtin_amdgcn_update_dpp(0, (int)v, 0x140, 0xF, 0xF, false));
    v = max(v, (unsigned)__builtin_amdgcn_update_dpp((int)v, (int)v, 0x142, 0xA, 0xF, false));
    v = max(v, (unsigned)__builtin_amdgcn_update_dpp((int)v, (int)v, 0x143, 0xC, 0xF, false));
    return (unsigned)__builtin_amdgcn_readlane((int)v, 63);
}

constexpr int NB = 2, SEQ = 16384, DM = 1024, NT = NB * SEQ, NL = 2;
constexpr int PW = 2304;
constexpr int C_Q = 0, C_KC = 768, C_VC = 960, C_KS = 1152, C_VS = 1344, C_KW = 1536, C_VW = 1728, C_U = 1920, C_G = 2176;
constexpr int DFF = 2816;
constexpr float L2E = 1.4426950408889634f;

constexpr size_t MiB = 1u << 20;
constexpr size_t WS_CTL = 0;
constexpr size_t WS_W = 1 * MiB;
constexpr size_t WL_STRIDE = 32 * MiB;
constexpr size_t WO_WIN = 0;
constexpr size_t WO_WOUT = 5 * MiB;
constexpr size_t WO_WGU = 7 * MiB;
constexpr size_t WO_WD = 18 * MiB;
constexpr size_t WO_W1 = 24 * MiB;
constexpr size_t WO_SS1 = 26 * MiB;
constexpr size_t WO_SS2 = 30 * MiB;
constexpr size_t CT_L = 256 * 1024;
constexpr size_t CT_BASE = 64 * 1024;
constexpr size_t CT_AB16 = 0;
constexpr size_t CT_AB1K = 8 * 1024;
constexpr size_t CT_CB1 = 16 * 1024;
constexpr size_t CT_W2T = 20 * 1024;
constexpr size_t CT_WGLU = 84 * 1024;
constexpr size_t WS_ACT = WS_W + 2 * WL_STRIDE;
constexpr size_t WS_PROJ = WS_ACT + 64 * MiB;
constexpr size_t WS_OATT = WS_PROJ + 176 * MiB;
constexpr size_t WS_OSSM = WS_OATT + 48 * MiB;
constexpr size_t WS_YS2 = WS_OSSM + 16 * MiB;
constexpr size_t WS_YI = WS_ACT;
constexpr size_t WS_HL = WS_YS2 + 16 * MiB;
constexpr size_t WS_HIN = WS_HL + 16 * MiB;
constexpr size_t WS_VTS = WS_HIN + 16 * MiB;
constexpr size_t WS_VTW = WS_VTS + 12 * MiB;
constexpr size_t WS_KC = WS_VTW + 12 * MiB;
constexpr size_t WS_VCT = WS_KC + 1 * MiB;
constexpr size_t WS_HIDC = WS_VCT + 1 * MiB;
constexpr size_t WS_MISC = WS_HIDC + 6 * MiB;
constexpr size_t WS_PARK = WS_MISC + 4 * MiB;
constexpr size_t WS_KFS = WS_PARK + 16 * MiB;
constexpr size_t WS_SST = WS_KFS + 12 * MiB;
constexpr size_t WS_SSX = WS_SST + 1 * MiB;
constexpr size_t WS_UC = WS_SSX + 1 * MiB;
constexpr size_t WS_END = WS_UC + 16 * MiB;
constexpr size_t WS_XLAST = WS_PROJ + 96 * MiB;
constexpr size_t MS_L = 2 * MiB;
constexpr size_t MS_MTAB = 0;
constexpr size_t MS_CBP = 256 * 1024;
constexpr size_t MS_WGLU = 512 * 1024;
constexpr size_t MS_BBAR = 1024 * 1024;
constexpr size_t MS_FTAB = 1024 * 1024 + 128 * 1024;

constexpr int LDS_BYTES = 143360;

struct Params { const float* in[26]; float* out; unsigned char* ws; };

namespace pg8 {
constexpr int BM = 256, BK = 64, HALF = 128, HTB = HALF * BK * 2, STAGE_BYTES = 8 * HTB, NXCD = 8, WGM = 8;
__host__ __device__ __forceinline__ int lds_byte(int r, int c) { const int st = (r >> 4) * 2 + (c >> 5), rr = r & 15, cc = c & 31, ob = rr * 64 + cc * 2; return st * 1024 + (ob ^ (((ob >> 9) & 1) << 5)); }
__host__ __device__ __forceinline__ void stage_rc(int b, int& R, int& C) { const int st = b / 1024, sb = b % 1024, swz = sb ^ (((sb >> 9) & 1) << 5); R = (st >> 1) * 16 + swz / 64; C = (st & 1) * 32 + (swz % 64) / 2; }
__host__ __device__ __forceinline__ int perm32(int rho) { const int n = rho >> 4, i = rho & 15; return 8 * (i >> 2) + 4 * n + (i & 3); }
struct Unit { int pm, pn, part; };
constexpr int ROWTAB_OFF = STAGE_BYTES;
struct StaticOrder {
    int nM, nN, nwg, G, c, lmode = 0, lbase = 0, lpn = 0, lcount = 0;
    __device__ void init(int nM_, int nN_, int G_, int c_) { nM = nM_; nN = nN_; nwg = nM * nN; G = G_; c = c_; lmode = 0; }
    __device__ void init_run(int base, int pn, int count) { lmode = 1; lbase = base; lpn = pn; lcount = count; nM = 0; nN = 0; nwg = 0; G = 1; c = 0; }
    __device__ bool next(int i, Unit& u) const {
        if (lmode == 1) { if (i >= lcount) return false; u.pm = lbase + i; u.pn = lpn; return true; }
        const long L = (long)i * G + c; if (L >= nwg) return false;
        int wgid = (int)L; { const int q = nwg / NXCD, r = nwg % NXCD, xcd = wgid % NXCD, off = wgid / NXCD; wgid = (xcd < r ? xcd * (q + 1) : r * (q + 1) + (xcd - r) * q) + off; }
        const int nig = WGM * nN, gid = wgid / nig, fm = gid * WGM, gsz = (nM - fm) < WGM ? (nM - fm) : WGM;
        u.pm = fm + ((wgid % nig) % gsz); u.pn = (wgid % nig) / gsz; return true;
    }
};

template <class Epi, class Addr, bool ALIGN_EPI, bool FP8 = false>
__device__ __forceinline__ void gemm_phase(LAS unsigned char* lds, const Addr& g, const StaticOrder& S, const Epi& E, int tid) {
    asm volatile("" : "+v"(tid));
    const int wid = __builtin_amdgcn_readfirstlane(tid >> 6), lane = tid & 63, wr = wid >> 2, wc = wid & 3, fr = lane & 15, fq = lane >> 4;
    const int K = g.K(), nt0 = K / BK;
    unsigned voffA[2], voffB[2];
#pragma unroll
    for (int i = 0; i < 2; ++i) { int R, C; stage_rc(tid * 16 + i * 8192, R, C); const int Rb = Epi::PERM ? ((R & ~31) + perm32(R & 31)) : R;
        voffA[i] = (unsigned)R * g.a_row_bytes() + g.a_col_off(C); voffB[i] = (unsigned)(Rb * K + C) * 2u; }
    const size_t kstepA = g.a_kstep(), kstepB = (size_t)(BK * 2);
    const size_t hstepA = (size_t)HALF * g.a_row_bytes(), hstepB = (size_t)HALF * K * 2;
    const unsigned ldsw = (unsigned)wid * 1024u;
    const int aoff = lds_byte(wr * 64 + fr, fq * 8), boff = lds_byte(wc * 32 + fr, fq * 8);
#define PG8_SA(b, h) (((b) * 2 + (h)) * HTB)
#define PG8_SB(b, h) ((4 + (b) * 2 + (h)) * HTB)
#define PG8_STAGE(bufoff, gbase, voff) do { _Pragma("unroll") for (int _i = 0; _i < 2; ++_i) \
        __builtin_amdgcn_global_load_lds((const unsigned*)((const char*)(gbase) + (voff)[_i]), (LAS unsigned*)(lds + (bufoff) + ldsw + _i * 8192), 16, 0, 0); } while (0)
#define PG8_LDA(dst, b, h) do { _Pragma("unroll") for (int m = 0; m < 4; ++m) _Pragma("unroll") for (int k = 0; k < 2; ++k) dst[m][k] = *(const LAS bf16x8*)(lds + PG8_SA(b, h) + aoff + m * 2048 + k * 1024); } while (0)
#define PG8_LDB(dst, b, h) do { _Pragma("unroll") for (int n = 0; n < 2; ++n) _Pragma("unroll") for (int k = 0; k < 2; ++k) dst[n][k] = *(const LAS bf16x8*)(lds + PG8_SB(b, h) + boff + n * 2048 + k * 1024); } while (0)
#define PG8_CAT(x, y) __builtin_bit_cast(i32x8, __builtin_shufflevector((x), (y), 0, 1, 2, 3, 4, 5, 6, 7, 8, 9, 10, 11, 12, 13, 14, 15))
#define PG8_MMA(ai, bj, At, Bt) do { __builtin_amdgcn_s_setprio(1); _Pragma("unroll") for (int m = 0; m < 4; ++m) _Pragma("unroll") for (int n = 0; n < 2; ++n) { \
        if constexpr (FP8) { const i32x8 bw_ = PG8_CAT(Bt[n][0], Bt[n][1]), aw_ = PG8_CAT(At[m][0], At[m][1]); \
            asm volatile("v_mfma_f32_16x16x128_f8f6f4 %0, %1, %2, %0" : "+v"(acc[ai][bj][m][n]) : "v"(bw_), "v"(aw_));   } \
        else { _Pragma("unroll") for (int k = 0; k < 2; ++k) acc[ai][bj][m][n] = __builtin_amdgcn_mfma_f32_16x16x32_bf16(Bt[n][k], At[m][k], acc[ai][bj][m][n], 0, 0, 0); } } \
        __builtin_amdgcn_s_setprio(0); } while (0)
#define PG8_WAIT_V(n) asm volatile("s_waitcnt vmcnt(" #n ")" ::: "memory")
#define PG8_WAIT_L(n) asm volatile("s_waitcnt lgkmcnt(" #n ")" ::: "memory")
#define PG8_BAR __builtin_amdgcn_s_barrier()
#define PG8_SCHED __builtin_amdgcn_sched_barrier(0)
    Unit cur, nxt; int ui = 0;
    constexpr bool SPLIT = Epi::MID_T > 0;
    auto get_unit = [&](int i, Unit& u) -> bool { if constexpr (SPLIT) { const bool ok = S.next(i >> 1, u); u.part = i & 1; return ok; } else { const bool ok = S.next(i, u); u.part = 0; return ok; } };
    auto part_off = [&](const Unit& u) -> size_t { if constexpr (SPLIT) return (size_t)u.part * (Epi::MID_T * BK * 2); else return 0; };
    if (!get_unit(0, cur)) return;
    f32x4 acc[2][2][4][2];
#pragma unroll
    for (int a = 0; a < 2; ++a)
#pragma unroll
        for (int b = 0; b < 2; ++b)
#pragma unroll
            for (int m = 0; m < 4; ++m)
#pragma unroll
                for (int n = 0; n < 2; ++n) acc[a][b][m][n] = (f32x4){0.f, 0.f, 0.f, 0.f};
    bf16x8 At[4][2], B0[2][2], B1[2][2];
    const char* cA = g.a_base(cur) + part_off(cur); const char* cB = g.b_base(cur) + part_off(cur);
    PG8_STAGE(PG8_SB(0, 0), cB, voffB); PG8_STAGE(PG8_SB(0, 1), cB + hstepB, voffB); PG8_STAGE(PG8_SA(0, 0), cA, voffA); PG8_STAGE(PG8_SA(0, 1), cA + hstepA, voffA);
    if (wr == 1) PG8_BAR;
    PG8_WAIT_V(2); PG8_BAR;
    PG8_STAGE(PG8_SB(1, 0), cB + kstepB, voffB); PG8_STAGE(PG8_SA(1, 0), cA + kstepA, voffA); PG8_STAGE(PG8_SB(1, 1), cB + hstepB + kstepB, voffB);
    PG8_WAIT_V(6); PG8_BAR;
    for (;;) {
        const bool has_next = get_unit(ui + 1, nxt);
        const char* nA = has_next ? g.a_base(nxt) + part_off(nxt) : cA; const char* nB = has_next ? g.b_base(nxt) + part_off(nxt) : cB;
        int nt = nt0; if constexpr (SPLIT) nt = cur.part ? nt0 - Epi::MID_T : Epi::MID_T;
        for (int t = 0; t < nt; t += 2) {
            const bool last = (t == nt - 2);
            if constexpr (Epi::ROWTAB) {
                if (t == 0 && wid < 4 && cur.part == 0) {
                    int l_; asm volatile("v_mbcnt_lo_u32_b32 %0, -1, 0\n\tv_mbcnt_hi_u32_b32 %0, -1, %0" : "=v"(l_));
                    __builtin_amdgcn_global_load_lds((const unsigned*)(E.rowtab + ((size_t)cur.pm * BM + wid * 64 + l_) * 2), (LAS unsigned*)(lds + ROWTAB_OFF + ((SPLIT ? (ui >> 1) : ui) & 1) * 4096 + wid * 1024), 16, 0, 0); } }
            const char* a1 = cA + (size_t)(t + 1) * kstepA;
            const char* a2 = last ? nA : cA + (size_t)(t + 2) * kstepA; const char* b2 = last ? nB : cB + (size_t)(t + 2) * kstepB;
            const char* a3 = a2 + kstepA; const char* b3 = b2 + kstepB;
            PG8_LDB(B0, 0, 0); PG8_LDB(B1, 0, 1); PG8_SCHED; PG8_LDA(At, 0, 0); PG8_STAGE(PG8_SA(1, 1), a1 + hstepA, voffA);
            PG8_WAIT_V(8); PG8_WAIT_L(0); PG8_BAR; PG8_MMA(0, 0, At, B0); PG8_MMA(0, 1, At, B1); PG8_BAR; PG8_SCHED;
            PG8_LDA(At, 0, 1); PG8_STAGE(PG8_SB(0, 0), b2, voffB); PG8_STAGE(PG8_SB(0, 1), b2 + hstepB, voffB); PG8_STAGE(PG8_SA(0, 0), a2, voffA);
            PG8_WAIT_V(8); PG8_WAIT_L(0); PG8_BAR; PG8_MMA(1, 0, At, B0); PG8_MMA(1, 1, At, B1); PG8_BAR; PG8_SCHED;
            PG8_LDB(B0, 1, 0); PG8_LDB(B1, 1, 1); PG8_SCHED; PG8_LDA(At, 1, 0); PG8_STAGE(PG8_SA(0, 1), a2 + hstepA, voffA);
            PG8_WAIT_V(8); PG8_WAIT_L(0); PG8_BAR; PG8_MMA(0, 0, At, B0); PG8_MMA(0, 1, At, B1); PG8_BAR; PG8_SCHED;
            PG8_LDA(At, 1, 1); PG8_STAGE(PG8_SB(1, 0), b3, voffB); PG8_STAGE(PG8_SB(1, 1), b3 + hstepB, voffB); PG8_STAGE(PG8_SA(1, 0), a3, voffA);
            PG8_WAIT_V(8); PG8_WAIT_L(0); PG8_BAR; PG8_MMA(1, 0, At, B0); PG8_MMA(1, 1, At, B1); PG8_BAR; PG8_SCHED;
        }
        if constexpr (ALIGN_EPI) { if (wr == 0) PG8_BAR; }
        if constexpr (FP8) asm volatile("s_nop 15\n\ts_nop 15" ::: "memory");
        { int le_; asm volatile("v_mbcnt_lo_u32_b32 %0, -1, 0\n\tv_mbcnt_hi_u32_b32 %0, -1, %0" : "=v"(le_)); const int fr_e = le_ & 15, fq_e = le_ >> 4;
          if constexpr (Epi::ROWTAB) {
              const LAS unsigned long long* tab = (const LAS unsigned long long*)(lds + ROWTAB_OFF + ((SPLIT ? (ui >> 1) : ui) & 1) * 4096);
              if (SPLIT && cur.part == 0) {
                  const LAS unsigned long long* tb = tab + (wr * 64 + fr_e) * 2;
#pragma unroll
                  for (int a = 0; a < 2; ++a)
#pragma unroll
                      for (int m = 0; m < 4; ++m) { const float ratio = Epi::row_ratio(tb[(a * HALF + m * 16) * 2], tb[(a * HALF + m * 16) * 2 + 1]);
#pragma unroll
                          for (int b = 0; b < 2; ++b)
#pragma unroll
                              for (int n = 0; n < 2; ++n) acc[a][b][m][n] = acc[a][b][m][n] * ratio; }
              } else E(acc, cur, wr, wc, fr_e, fq_e, tab);
          } else E(acc, cur, wr, wc, fr_e, fq_e); }
        if (!has_next) break;
        if (!SPLIT || cur.part != 0) {
#pragma unroll
        for (int a = 0; a < 2; ++a)
#pragma unroll
            for (int b = 0; b < 2; ++b)
#pragma unroll
                for (int m = 0; m < 4; ++m)
#pragma unroll
                    for (int n = 0; n < 2; ++n) acc[a][b][m][n] = (f32x4){0.f, 0.f, 0.f, 0.f};
        }
        cur = nxt; cA = nA; cB = nB; ++ui;
        if constexpr (ALIGN_EPI) { if (wr == 1) PG8_BAR; }
    }
    PG8_WAIT_V(0);
    if constexpr (!ALIGN_EPI) { if (wr == 0) PG8_BAR; }
    PG8_BAR;
#undef PG8_SA
#undef PG8_SB
#undef PG8_STAGE
#undef PG8_LDA
#undef PG8_LDB
#undef PG8_MMA
#undef PG8_CAT
#undef PG8_WAIT_V
#undef PG8_WAIT_L
#undef PG8_BAR
#undef PG8_SCHED
}

struct APlain {
    const char* A; const char* Bt; int k; int sw = 0x7f7f7f7f, sa = 0x7f7f7f7f;
    DI int scale_w() const { return sw; } DI int scale_a() const { return sa; }
    DI int K() const { return k; }
    DI unsigned a_row_bytes() const { return (unsigned)k * 2u; }
    DI unsigned a_kstep() const { return 128u; }
    DI unsigned a_col_off(int C) const { return (unsigned)C * 2u; }
    DI const char* a_base(const Unit& u) const { return A + (size_t)u.pm * 256 * k * 2; }
    DI const char* b_base(const Unit& u) const { return Bt + (size_t)u.pn * 256 * k * 2; }
};
struct ACompress {
    const char* proj; const char* w1t;
    DI int scale_w() const { return 0x7f7f7f7f; } DI int scale_a() const { return 0x7f7f7f7f; }
    DI int K() const { return 2048; }
    DI unsigned a_row_bytes() const { return 16u * PW * 2u; }
    DI unsigned a_kstep() const { return (unsigned)PW * 2u; }
    DI unsigned a_col_off(int C) const { return (unsigned)C * 2u; }
    DI const char* a_base(const Unit& u) const { const int kv = u.pm / 24, r = u.pm % 24, bh = r >> 2, qt = r & 3, b = bh / 3, h = bh % 3;
        return proj + ((size_t)(b * SEQ + 4096 * qt) * PW + (kv ? C_VC : C_KC) + h * 64) * 2; }
    DI const char* b_base(const Unit& u) const { return w1t + (size_t)(u.pm / 24) * 256 * 2048 * 2; }
};
struct ASsm1 {
    const char* uc; const char* ss1;
    DI int scale_w() const { return 0x7f7f7f7f; } DI int scale_a() const { return 0x7f7f7f7f; }
    DI int K() const { return 256; }
    DI unsigned a_row_bytes() const { return 512u; }
    DI unsigned a_kstep() const { return 128u; }
    DI unsigned a_col_off(int C) const { return (unsigned)C * 2u; }
    DI const char* a_base(const Unit& u) const { const int bg = u.pm >> 2, qt = u.pm & 3; return uc + ((size_t)bg * SEQ + 4096 * qt) * 32; }
    DI const char* b_base(const Unit& u) const { const int gi = (u.pm >> 2) & 15; return ss1 + ((size_t)gi * 512 + (size_t)u.pn * 256) * 256 * 2; }
};
struct ASsm2 {
    const char* hin; const char* ss2;
    DI int scale_w() const { return 0x7f7f7f7f; } DI int scale_a() const { return 0x7f7f7f7f; }
    DI int K() const { return 256; }
    DI unsigned a_row_bytes() const { return 512u; }
    DI unsigned a_kstep() const { return 128u; }
    DI unsigned a_col_off(int C) const { return (unsigned)C * 2u; }
    DI const char* a_base(const Unit& u) const { return hin + (size_t)u.pm * 256 * 512; }
    DI const char* b_base(const Unit& u) const { const int gi = (u.pm >> 2) & 15; return ss2 + (size_t)gi * 256 * 256 * 2; }
};

struct EpiBf16 {
    static constexpr bool PERM = true; static constexpr bool ROWTAB = true; static constexpr int MID_T = -1;
    bf16_t* O; int ldc; const unsigned long long* rowtab;
    static DI float row_ratio(unsigned long long, unsigned long long) { return 1.f; }
    DI void operator()(const f32x4 (&acc)[2][2][4][2], const Unit& u, int wr, int wc, int fr, int fq, const LAS unsigned long long* tab) const {
        const int row0 = u.pm * BM + wr * 64 + fr, col0 = u.pn * BM + wc * 32 + 8 * fq;
        const int ubj = (u.pn == C_U / 256) ? 1 : ((u.pn == C_U / 256 + 1) ? 0 : -1);
#pragma unroll
        for (int ai = 0; ai < 2; ++ai)
#pragma unroll
            for (int m = 0; m < 4; ++m) { bf16_t* rowp = O + (size_t)(row0 + ai * HALF + m * 16) * ldc + col0;
                const float sc = rsqrtf((float)tab[(wr * 64 + fr + ai * HALF + m * 16) * 2] * (1.f / (1048576.f * DM)) + 1e-6f);
#pragma unroll
                for (int bj = 0; bj < 2; ++bj) { const f32x4 v0 = acc[ai][bj][m][0] * sc, v1 = acc[ai][bj][m][1] * sc;
                    u32x4 w; w.x = pk2(v0[0], v0[1]); w.y = pk2(v0[2], v0[3]); w.z = pk2(v1[0], v1[1]); w.w = pk2(v1[2], v1[3]);
                    if (bj == ubj) { const int row = row0 + ai * HALF + m * 16, ucol = col0 + bj * HALF - C_U;
                        bf16_t* uc = (bf16_t*)((unsigned char*)O + (WS_UC - WS_PROJ));
                        *(u32x4*)(uc + (((size_t)((row >> 14) * 16 + (ucol >> 4)) * SEQ + (row & (SEQ - 1))) * 16 + (ucol & 15))) = w; }
                    else if (col0 + bj * HALF < C_G + 40) *(u32x4*)(rowp + bj * HALF) = w; } }
    }
};
struct EpiCmpHid {
    static constexpr bool PERM = true; static constexpr bool ROWTAB = false; static constexpr int MID_T = -1;
    bf16_t* O; const float* cb1;
    DI void operator()(const f32x4 (&acc)[2][2][4][2], const Unit& u, int wr, int wc, int fr, int fq) const {
        const int row0 = u.pm * BM + wr * 64 + fr, col0 = wc * 32 + 8 * fq; const float* bb = cb1 + (u.pm / 24) * 256;
        f32x4 bv[2][2];
#pragma unroll
        for (int bj = 0; bj < 2; ++bj)
#pragma unroll
            for (int n = 0; n < 2; ++n) bv[bj][n] = *(const f32x4*)(bb + col0 + bj * HALF + 4 * n);
#pragma unroll
        for (int ai = 0; ai < 2; ++ai)
#pragma unroll
            for (int m = 0; m < 4; ++m) { bf16_t* rowp = O + (size_t)(row0 + ai * HALF + m * 16) * 256 + col0;
#pragma unroll
                for (int bj = 0; bj < 2; ++bj) { f32x4 v0 = acc[ai][bj][m][0] + bv[bj][0], v1 = acc[ai][bj][m][1] + bv[bj][1];
#pragma unroll
                    for (int e = 0; e < 4; ++e) { v0[e] = gelu_tanh(v0[e]); v1[e] = gelu_tanh(v1[e]); }
                    u32x4 w; w.x = pk2(v0[0], v0[1]); w.y = pk2(v0[2], v0[3]); w.z = pk2(v1[0], v1[1]); w.w = pk2(v1[2], v1[3]);
                    *(u32x4*)(rowp + bj * HALF) = w; } }
    }
};
struct EpiSsm1 {
    static constexpr bool PERM = false; static constexpr bool ROWTAB = false; static constexpr int MID_T = -1;
    float* YI; float* HL;
    DI void operator()(const f32x4 (&acc)[2][2][4][2], const Unit& u, int wr, int wc, int fr, int fq) const {
        const int row0 = u.pm * BM + wr * 64 + fr, col0 = wc * 32 + 4 * fq;
#pragma unroll
        for (int ai = 0; ai < 2; ++ai)
#pragma unroll
            for (int m = 0; m < 4; ++m) { const size_t row = (size_t)(row0 + ai * HALF + m * 16);
                if (u.pn == 0) {
#pragma unroll
                    for (int bj = 0; bj < 2; ++bj)
#pragma unroll
                        for (int n = 0; n < 2; ++n) *(f32x4*)(YI + row * 256 + col0 + bj * HALF + n * 16) = acc[ai][bj][m][n];
                } else {
#pragma unroll
                    for (int n = 0; n < 2; ++n) *(f32x4*)(HL + row * 128 + col0 + n * 16) = acc[ai][0][m][n];
                } }
    }
};
struct EpiSsm2 {
    static constexpr bool PERM = false; static constexpr bool ROWTAB = false; static constexpr int MID_T = -1;
    const float* YI; const bf16_t* proj; const float* dskip; bf16_t* YS2;
    DI void operator()(const f32x4 (&acc)[2][2][4][2], const Unit& u, int wr, int wc, int fr, int fq) const {
        const int row0 = u.pm * BM + wr * 64 + fr, col0 = wc * 32 + 4 * fq;
        const int bg = u.pm >> 2, b = bg >> 4, gi = bg & 15;
        const f32x4 dsk = *(const f32x4*)(dskip + gi * 16 + 4 * fq);
#pragma unroll
        for (int ai = 0; ai < 2; ++ai)
#pragma unroll
            for (int m = 0; m < 4; ++m) { const int row = row0 + ai * HALF + m * 16; const int chunk = row & 1023;
#pragma unroll
                for (int bj = 0; bj < 2; ++bj)
#pragma unroll
                    for (int n = 0; n < 2; ++n) { const int col = col0 + bj * HALF + n * 16, tau = col >> 4;
                        const size_t tok = (size_t)b * SEQ + chunk * 16 + tau;
                        const f32x4 yi = *(const f32x4*)(YI + (size_t)row * 256 + col);
                        const u32x2 uw = *(const u32x2*)(proj + ((size_t)bg * SEQ * 16 + (size_t)chunk * 256 + col));
                        f32x4 y = acc[ai][bj][m][n] + yi;
                        y[0] += dsk[0] * bflo(uw.x); y[1] += dsk[1] * bfhi(uw.x); y[2] += dsk[2] * bflo(uw.y); y[3] += dsk[3] * bfhi(uw.y);
                        u32x2 w; w.x = pk2(gelu_tanh(y[0]), gelu_tanh(y[1])); w.y = pk2(gelu_tanh(y[2]), gelu_tanh(y[3]));
                        *(u32x2*)(YS2 + tok * 256 + gi * 16 + 4 * fq) = w; } }
    }
};
struct EpiGlu {
    static constexpr bool PERM = true; static constexpr bool ROWTAB = false; static constexpr int MID_T = -1;
    bf16_t* O; const float* bglu; unsigned long long* sst;
    DI void operator()(const f32x4 (&acc)[2][2][4][2], const Unit& u, int wr, int wc, int fr, int fq) const {
        const int row0 = u.pm * BM + wr * 64 + fr, col0 = u.pn * HALF + wc * 32 + 8 * fq;
        f32x4 bvv[2], bgg[2];
#pragma unroll
        for (int n = 0; n < 2; ++n) { bvv[n] = *(const f32x4*)(bglu + col0 + 4 * n); bgg[n] = *(const f32x4*)(bglu + 256 + col0 + 4 * n); }
#pragma unroll
        for (int ai = 0; ai < 2; ++ai)
#pragma unroll
            for (int m = 0; m < 4; ++m) { const int row = row0 + ai * HALF + m * 16; bf16_t* rowp = O + (size_t)row * 1024 + 768 + col0;
                f32x4 o[2];
#pragma unroll
                for (int n = 0; n < 2; ++n) { const f32x4 v = acc[ai][0][m][n] + bvv[n], gt = acc[ai][1][m][n] + bgg[n];
#pragma unroll
                    for (int e = 0; e < 4; ++e) o[n][e] = v[e] * sigmoidf_(gt[e]); }
                u32x4 w; w.x = pk2(o[0][0], o[0][1]); w.y = pk2(o[0][2], o[0][3]); w.z = pk2(o[1][0], o[1][1]); w.w = pk2(o[1][2], o[1][3]);
                *(u32x4*)rowp = w;
                const f32x4 q = o[0] * o[0] + o[1] * o[1]; const float t = xor32_sum(xor16_sum((q[0] + q[1]) + (q[2] + q[3])));
                if (fq == 0) (void)__hip_atomic_fetch_add(sst + (size_t)row * 2 + 1, (unsigned long long)(t * 16777216.f), __ATOMIC_RELAXED, __HIP_MEMORY_SCOPE_AGENT); }
    }
};
struct EpiSwiglu8 {
    static constexpr bool PERM = true; static constexpr bool ROWTAB = false; static constexpr int MID_T = -1;
    unsigned char* O; float asc;
    DI void operator()(const f32x4 (&acc)[2][2][4][2], const Unit& u, int wr, int wc, int fr, int fq) const {
        const int row0 = u.pm * BM + wr * 64 + fr, col0 = u.pn * HALF + wc * 32 + 8 * fq;
        const float c1 = -1.4426950408889634f * asc, c2 = 4.0f * asc * asc;
#pragma unroll
        for (int ai = 0; ai < 2; ++ai)
#pragma unroll
            for (int m = 0; m < 4; ++m) { unsigned char* rowp = O + (size_t)(row0 + ai * HALF + m * 16) * DFF + col0;
                f32x4 o[2];
#pragma unroll
                for (int n = 0; n < 2; ++n) { const f32x4 ga = acc[ai][0][m][n], ua = acc[ai][1][m][n];
#pragma unroll
                    for (int e = 0; e < 4; ++e) o[n][e] = (ga[e] * ua[e]) * __builtin_amdgcn_rcpf(1.0f + __builtin_amdgcn_exp2f(c1 * ga[e])) * c2; }
                u32x2 w; w.x = pk4_fp8(o[0][0], o[0][1], o[0][2], o[0][3]); w.y = pk4_fp8(o[1][0], o[1][1], o[1][2], o[1][3]);
                *(u32x2*)rowp = w; }
    }
};
struct EpiSwiglu {
    static constexpr bool PERM = true; static constexpr bool ROWTAB = false; static constexpr int MID_T = -1;
    bf16_t* O;
    DI void operator()(const f32x4 (&acc)[2][2][4][2], const Unit& u, int wr, int wc, int fr, int fq) const {
        const int row0 = u.pm * BM + wr * 64 + fr, col0 = u.pn * HALF + wc * 32 + 8 * fq;
#pragma unroll
        for (int ai = 0; ai < 2; ++ai)
#pragma unroll
            for (int m = 0; m < 4; ++m) { bf16_t* rowp = O + (size_t)(row0 + ai * HALF + m * 16) * DFF + col0;
                f32x4 o[2];
#pragma unroll
                for (int n = 0; n < 2; ++n) { const f32x4 gt = acc[ai][0][m][n], up = acc[ai][1][m][n];
#pragma unroll
                    for (int e = 0; e < 4; ++e) o[n][e] = gt[e] * sigmoidf_(gt[e]) * up[e]; }
                u32x4 w; w.x = pk2(o[0][0], o[0][1]); w.y = pk2(o[0][2], o[0][3]); w.z = pk2(o[1][0], o[1][1]); w.w = pk2(o[1][2], o[1][3]);
                *(u32x4*)rowp = w; }
    }
};
struct EpiResF32 {
    static constexpr bool PERM = false; static constexpr bool ROWTAB = false; static constexpr int MID_T = -1;
    const float* base; float* out; float asc = 1.0f;
    DI void operator()(const f32x4 (&acc)[2][2][4][2], const Unit& u, int wr, int wc, int fr, int fq) const {
        const int row0 = u.pm * BM + wr * 64 + fr, col0 = u.pn * BM + wc * 32 + 4 * fq;
#pragma unroll
        for (int ai = 0; ai < 2; ++ai)
#pragma unroll
            for (int m = 0; m < 4; ++m) { const size_t off = (size_t)(row0 + ai * HALF + m * 16) * DM + col0;
#pragma unroll
                for (int bj = 0; bj < 2; ++bj)
#pragma unroll
                    for (int n = 0; n < 2; ++n) { const f32x4 bs = *(const f32x4*)(base + off + bj * HALF + n * 16);
                        *(f32x4*)(out + off + bj * HALF + n * 16) = bs + acc[ai][bj][m][n] * asc; } }
    }
};
template <bool MID, int ASC_EXP>
struct EpiResB {
    static constexpr bool PERM = true; static constexpr bool ROWTAB = MID; static constexpr int MID_T = MID ? 12 : -1;
    static constexpr float asc = 1.0f / (float)(1 << ASC_EXP);
    const float* basef; const bf16_t* baseb; bf16_t* out; const unsigned long long* rowtab; unsigned long long* ssx;
    static DI float rstd_a(unsigned long long v) { return rsqrtf((float)v * (1.f / (16777216.f * 768.f)) + 1e-6f); }
    static DI float rstd_s(unsigned long long v) { return rsqrtf((float)v * (1.f / (16777216.f * 256.f)) + 1e-6f); }
    static DI float row_ratio(unsigned long long a, unsigned long long s_) { return rstd_a(a) / rstd_s(s_); }
    template <bool F32B>
    DI void run(const f32x4 (&acc)[2][2][4][2], const Unit& u, int wr, int wc, int fr, int fq, const LAS unsigned long long* tab) const {
        const int row0 = u.pm * BM + wr * 64 + fr, col0 = u.pn * BM + wc * 32 + 8 * fq;
#pragma unroll
        for (int ai = 0; ai < 2; ++ai)
#pragma unroll
            for (int m = 0; m < 4; ++m) { const int row = row0 + ai * HALF + m * 16; const size_t off = (size_t)row * DM + col0; float sq = 0.f;
                float sc = asc; if constexpr (MID) sc = asc * rstd_s(tab[(wr * 64 + fr + ai * HALF + m * 16) * 2 + 1]);
#pragma unroll
                for (int bj = 0; bj < 2; ++bj) { f32x4 b0, b1;
                    if constexpr (F32B) { b0 = *(const f32x4*)(basef + off + bj * HALF); b1 = *(const f32x4*)(basef + off + bj * HALF + 4); }
                    else { const u32x4 b = *(const u32x4*)(baseb + off + bj * HALF); b0 = f32x4{bflo(b.x), bfhi(b.x), bflo(b.y), bfhi(b.y)}; b1 = f32x4{bflo(b.z), bfhi(b.z), bflo(b.w), bfhi(b.w)}; }
                    const f32x4 v0 = b0 + acc[ai][bj][m][0] * sc, v1 = b1 + acc[ai][bj][m][1] * sc;
                    u32x4 w; w.x = pk2(v0[0], v0[1]); w.y = pk2(v0[2], v0[3]); w.z = pk2(v1[0], v1[1]); w.w = pk2(v1[2], v1[3]);
                    *(u32x4*)(out + off + bj * HALF) = w;
                    if constexpr (!MID) { const f32x4 q = v0 * v0 + v1 * v1; sq += (q[0] + q[1]) + (q[2] + q[3]); } }
                if constexpr (!MID) { if (ssx != nullptr) { const float t = xor32_sum(xor16_sum(sq));
                    if (fq == 0) (void)__hip_atomic_fetch_add(ssx + (size_t)row * 2, (unsigned long long)(t * 1048576.f), __ATOMIC_RELAXED, __HIP_MEMORY_SCOPE_AGENT); } } }
    }
    DI void operator()(const f32x4 (&acc)[2][2][4][2], const Unit& u, int wr, int wc, int fr, int fq, const LAS unsigned long long* tab = nullptr) const {
        if (basef != nullptr) run<true>(acc, u, wr, wc, fr, fq, tab); else run<false>(acc, u, wr, wc, fr, fq, tab);
    }
};
}

struct Frame {
    LAS unsigned char* lds;
    LAS const unsigned long long* pt;
    int tid, lane, wave, G, gw, ngw, bid;
    DI const float* in(int i) const { const unsigned long long v = pt[i]; const unsigned lo = __builtin_amdgcn_readfirstlane((unsigned)v), hi = __builtin_amdgcn_readfirstlane((unsigned)(v >> 32));
        return (const float*)(const __attribute__((address_space(1))) float*)(((unsigned long long)hi << 32) | lo); }
    DI float* out() const { return (float*)in(26); }
    DI unsigned char* wsp() const { return (unsigned char*)in(27); }
};
constexpr int LDS_PT = LDS_BYTES - 256;

DI void transpose_item(const float* W, int K, int ldw, int nvalid, bf16_t* WT, int drow0, LAS float* scr, int k0, int n0, float scale, int lane, const float* gam64 = nullptr) {
    if (n0 + 32 <= nvalid) {
        const int n4 = (lane & 7) * 4; f32x4 v[8];
#pragma unroll
        for (int i = 0; i < 8; ++i) v[i] = *(const f32x4*)(W + (size_t)(k0 + 8 * i + (lane >> 3)) * ldw + n0 + n4);
        if (gam64 != nullptr) {
#pragma unroll
            for (int i = 0; i < 8; ++i) v[i] = v[i] * gam64[8 * i + (lane >> 3)];
        }
#pragma unroll
        for (int i = 0; i < 8; ++i) { LAS float* s = scr + (8 * i + (lane >> 3)) * 33 + n4; s[0] = v[i].x * scale; s[1] = v[i].y * scale; s[2] = v[i].z * scale; s[3] = v[i].w * scale; }
    } else {
    const int nn = n0 + (lane & 31); const bool ok = nn < nvalid;
#pragma unroll 8
    for (int i = 0; i < 32; ++i) { const int kk = 2 * i + (lane >> 5); scr[kk * 33 + (lane & 31)] = ok ? W[(size_t)(k0 + kk) * ldw + nn] * scale : 0.f; }
    }
    asm volatile("s_waitcnt lgkmcnt(0)" ::: "memory");
    const int c = lane & 7;
#pragma unroll
    for (int j = 0; j < 4; ++j) { const int n = (lane >> 3) + 8 * j; const LAS float* s = scr + (8 * c) * 33 + n;
        u32x4 o; o.x = pk2(s[0 * 33], s[1 * 33]); o.y = pk2(s[2 * 33], s[3 * 33]); o.z = pk2(s[4 * 33], s[5 * 33]); o.w = pk2(s[6 * 33], s[7 * 33]);
        *(u32x4*)(WT + (size_t)(drow0 + n) * K + k0 + 8 * c) = o; }
    asm volatile("s_waitcnt lgkmcnt(0)" ::: "memory");
}

DI void transpose_item_fp8(const float* W, int K, int ldw, unsigned char* WT, int drow0, LAS float* scr, int k0, int n0, float scale, int lane) {
    const int n4 = (lane & 7) * 4; f32x4 v[8];
#pragma unroll
    for (int i = 0; i < 8; ++i) v[i] = *(const f32x4*)(W + (size_t)(k0 + 8 * i + (lane >> 3)) * ldw + n0 + n4);
#pragma unroll
    for (int i = 0; i < 8; ++i) { LAS float* s = scr + (8 * i + (lane >> 3)) * 33 + n4; s[0] = v[i].x * scale; s[1] = v[i].y * scale; s[2] = v[i].z * scale; s[3] = v[i].w * scale; }
    asm volatile("s_waitcnt lgkmcnt(0)" ::: "memory");
    const int c = lane & 7;
#pragma unroll
    for (int j = 0; j < 4; ++j) { const int n = (lane >> 3) + 8 * j; const LAS float* s = scr + (8 * c) * 33 + n;
        u32x2 o; o.x = pk4_fp8(s[0 * 33], s[1 * 33], s[2 * 33], s[3 * 33]); o.y = pk4_fp8(s[4 * 33], s[5 * 33], s[6 * 33], s[7 * 33]);
        *(u32x2*)(WT + (size_t)(drow0 + n) * K + k0 + 8 * c) = o; }
    asm volatile("s_waitcnt lgkmcnt(0)" ::: "memory");
}

DI int win_dest_row(int n) {
    if (n < 1920) return n;
    if (n < 1956) return C_G + (n - 1920);
    return C_U + (n - 1956);
}

DI void prologue_a(Frame& F, int mode, int gw0, int ngw0) {
    LAS float* scr = (LAS float*)(F.lds + F.wave * 16640);
    constexpr int I_WIN = 16 * 72, I_WOUT = 16 * 32, I_WG = 16 * 88, I_WD = 44 * 32, I_W1 = 2 * 32 * 8, I_WGLU = 4 * 16, I_W2 = 2 * 4 * 2, I_CB = 64, I_M = 1024, I_TAB = 16;
    constexpr int PER_L = I_WIN + I_WOUT + 2 * I_WG + I_WD + I_W1 + I_WGLU + I_W2 + I_CB + I_M + I_TAB;
    const int lane = F.lane;
    constexpr int A1 = I_WIN, A3E = I_WIN + I_WOUT + 2 * I_WG + I_WD, A4E = A3E + I_W1, A5E = A4E + I_WGLU;
    for (int it = gw0; it < NL * PER_L; it += ngw0) {
        const int l = it / PER_L; int r = it % PER_L;
        { const bool late = (r >= A1 && r < A3E) || (r >= A4E && r < A5E) || (l > 0 && (r < A1 || (r >= A3E && r < A4E)));
          if (late != (mode == 1)) continue; }
        unsigned char* wl = F.wsp() + WS_W + (size_t)l * WL_STRIDE;
        unsigned char* ms = F.wsp() + WS_MISC + (size_t)l * MS_L;
        unsigned char* ct = F.wsp() + WS_CTL + CT_BASE + (size_t)l * CT_L;
        if (r < I_WIN) {
            const int kb = r / 72, nb = r % 72, k0 = 64 * kb, n0 = 32 * nb;
            const float* W = F.in(2) + (size_t)l * 1024 * 2212;
            bf16_t* WT = (bf16_t*)(wl + WO_WIN);
            const float* gam = F.in(1) + (size_t)l * DM + k0;
            if (n0 + 32 <= 1920) { transpose_item(W, 1024, 2212, 2212, WT, n0, scr, k0, n0, n0 < 768 ? 0.125f * L2E : 1.0f, lane, gam); }
            else {
                const int d = n0 + (lane & 31);
                int srcn = -1;
                if (d < 1920) srcn = d; else if (d >= C_U && d < C_U + 256) srcn = 1956 + (d - C_U); else if (d >= C_G && d < C_G + 36) srcn = 1920 + (d - C_G);
#pragma unroll 8
                for (int i = 0; i < 32; ++i) { const int kk = 2 * i + (lane >> 5); scr[kk * 33 + (lane & 31)] = srcn >= 0 ? W[(size_t)(k0 + kk) * 2212 + srcn] * gam[kk] : 0.f; }
                asm volatile("s_waitcnt lgkmcnt(0)" ::: "memory");
                const int c = lane & 7;
#pragma unroll
                for (int j = 0; j < 4; ++j) { const int n = (lane >> 3) + 8 * j; const LAS float* s = scr + (8 * c) * 33 + n;
                    u32x4 o; o.x = pk2(s[0 * 33], s[1 * 33]); o.y = pk2(s[2 * 33], s[3 * 33]); o.z = pk2(s[4 * 33], s[5 * 33]); o.w = pk2(s[6 * 33], s[7 * 33]);
                    *(u32x4*)(WT + (size_t)(n0 + n) * 1024 + k0 + 8 * c) = o; }
                asm volatile("s_waitcnt lgkmcnt(0)" ::: "memory");
            }
            continue; }
        r -= I_WIN;
        if (r < I_WOUT) { const int kb = r / 32, nb = r % 32;
            transpose_item(F.in(20) + (size_t)l * 1024 * 1024, 1024, 1024, 1024, (bf16_t*)(wl + WO_WOUT), 32 * nb, scr, 64 * kb, 32 * nb, 1.f, lane, kb < 12 ? F.in(18) + (size_t)l * 768 + 64 * kb : F.in(19) + (size_t)l * 256 + 64 * (kb - 12)); continue; }
        r -= I_WOUT;
        if (r < 2 * I_WG) { const int up = r / I_WG; const int rr = r % I_WG; const int kb = rr / 88, nb = rr % 88, n0 = 32 * nb;
            const int drow = (n0 / 128) * 256 + up * 128 + (n0 % 128);
            transpose_item_fp8(F.in(up ? 23 : 22) + (size_t)l * 1024 * DFF, 1024, DFF, (unsigned char*)(wl + WO_WGU), drow, scr, 64 * kb, n0, 64.f, lane); continue; }
        r -= 2 * I_WG;
        if (r < I_WD) { const int kb = r / 32, nb = r % 32; transpose_item_fp8(F.in(24) + (size_t)l * DFF * 1024, DFF, 1024, (unsigned char*)(wl + WO_WD), 32 * nb, scr, 64 * kb, 32 * nb, 64.f, lane); continue; }
        r -= I_WD;
        if (r < I_W1) { const int kv = r / 256; const int rr = r % 256; const int kb = rr / 8, nb = rr % 8;
            transpose_item(F.in(4) + ((size_t)l * 2 + kv) * 2048 * 256, 2048, 256, 256, (bf16_t*)(wl + WO_W1) + (size_t)kv * 256 * 2048, 32 * nb, scr, 64 * kb, 32 * nb, 1.f, lane); continue; }
        r -= I_W1;
        if (r < I_WGLU) { const int kb = r / 16, nb = r % 16, n0 = 32 * nb; const int gate = n0 >= 256, nn = n0 & 255;
            const int drow = (nn / 128) * 256 + gate * 128 + (nn % 128);
            transpose_item(F.in(16) + (size_t)l * 256 * 512, 256, 512, 512, (bf16_t*)(ms + MS_WGLU), drow, scr, 64 * kb, n0, 1.f, lane); continue; }
        r -= I_WGLU;
        if (r < I_W2) { const int kv = r / 8; const int rr = r % 8; const int kb = rr / 2, nb = rr % 2;
            transpose_item(F.in(6) + ((size_t)l * 2 + kv) * 256 * 64, 256, 64, 64, (bf16_t*)(ct + CT_W2T) + (size_t)kv * 64 * 256, 32 * nb, scr, 64 * kb, 32 * nb, 1.f, lane); continue; }
        r -= I_W2;
        if (r < I_CB) {
            const int kv = r / 32, ch = r % 32; const float* pe = F.in(3) + ((size_t)l * 2 + kv) * 2048; const float* w1 = F.in(4) + ((size_t)l * 2 + kv) * 2048 * 256;
            f32x4 s = {0.f, 0.f, 0.f, 0.f};
#pragma unroll 8
            for (int i = 0; i < 64; ++i) { const int k = 64 * ch + i; const float pv = pe[k]; const f32x4 w = *(const f32x4*)(w1 + (size_t)k * 256 + 4 * lane); s += w * pv; }
            *(f32x4*)((float*)(ms + MS_CBP) + ((size_t)kv * 32 + ch) * 256 + 4 * lane) = s; continue; }
        r -= I_CB;
        if (r < I_M) {
            const int e0 = r * 64; const int gi = e0 >> 12, dl = (e0 >> 8) & 15, cp0 = (e0 >> 4) & 15, n = lane;
            const float dt = __expf(F.in(8)[l * 16 + gi]);
            const float ar = F.in(9)[((size_t)l * 16 + gi) * 64 + n], ai = F.in(10)[((size_t)l * 16 + gi) * 64 + n];
            const float x = dt * ar, y = dt * ai; const float sy = __sinf(y), cy = __cosf(y), sh = __sinf(0.5f * y);
            const float em1 = (fabsf(x) < 0.25f) ? x * (1.f + x * (0.5f + x * (0.16666667f + x * (0.041666668f + x * 0.0083333338f)))) : expm1f(x);
            const float nr = em1 * cy - 2.f * sh * sh; const float abi = (em1 + 1.f) * sy;
            const float den = ar * ar + ai * ai;
            const float fr_ = (nr * ar + abi * ai) / den, fi_ = (abi * ar - nr * ai) / den;
            const float mg = __expf((float)dl * x); const float pr = mg * __cosf((float)dl * y), pi = mg * __sinf((float)dl * y);
            const f32x4* bre = (const f32x4*)(F.in(11) + (((size_t)l * 16 + gi) * 64 + n) * 16); const f32x4* bim = (const f32x4*)(F.in(12) + (((size_t)l * 16 + gi) * 64 + n) * 16);
            float zr[16], zi[16];
#pragma unroll
            for (int q4 = 0; q4 < 4; ++q4) { const f32x4 br = bre[q4], bi = bim[q4];
#pragma unroll
                for (int j = 0; j < 4; ++j) { const float bbr = fr_ * br[j] - fi_ * bi[j], bbi = fr_ * bi[j] + fi_ * br[j]; zr[4 * q4 + j] = pr * bbr - pi * bbi; zi[4 * q4 + j] = pr * bbi + pi * bbr; } }
#pragma unroll
            for (int cc = 0; cc < 4; ++cc) { const int cp = cp0 + cc;
                const float cr = F.in(13)[(((size_t)l * 16 + gi) * 16 + cp) * 64 + n], ci = F.in(14)[(((size_t)l * 16 + gi) * 16 + cp) * 64 + n];
#pragma unroll
                for (int c = 0; c < 16; ++c) scr[n * 65 + cc * 16 + c] = cr * zr[c] - ci * zi[c]; }
            asm volatile("s_waitcnt lgkmcnt(0)" ::: "memory");
            float mine = 0.f;
#pragma unroll 8
            for (int nn = 0; nn < 64; ++nn) mine += scr[nn * 65 + lane];
            ((float*)(ms + MS_MTAB))[e0 + lane] = mine;
            asm volatile("s_waitcnt lgkmcnt(0)" ::: "memory"); continue; }
        r -= I_M;
        {
            const int e = r * 64 + lane; const int gi = e >> 6, n = e & 63;
            const float dt = __expf(F.in(8)[l * 16 + gi]);
            const float ar = F.in(9)[((size_t)l * 16 + gi) * 64 + n], ai = F.in(10)[((size_t)l * 16 + gi) * 64 + n];
            const float x = dt * ar, y = dt * ai; float sy, cy; sy = __sinf(y); cy = __cosf(y); const float sh = __sinf(0.5f * y);
            const float em1 = (fabsf(x) < 0.25f) ? x * (1.f + x * (0.5f + x * (0.16666667f + x * (0.041666668f + x * 0.0083333338f)))) : expm1f(x); const float nr = em1 * cy - 2.f * sh * sh; const float abi = (em1 + 1.f) * sy;
            const float den = ar * ar + ai * ai;
            const float fr_ = (nr * ar + abi * ai) / den, fi_ = (abi * ar - nr * ai) / den;
            float s16, c16; s16 = __sinf(16.f * y); c16 = __cosf(16.f * y); const float m16 = __expf(16.f * x);
            ((f32x2*)(ct + CT_AB16))[e] = (f32x2){m16 * c16, m16 * s16};
            float s1k, c1k; s1k = __sinf(512.f * y); c1k = __cosf(512.f * y); const float m1k = __expf(512.f * x);
            ((f32x2*)(ct + CT_AB1K))[e] = (f32x2){m1k * c1k, m1k * s1k};
            const float* bre = F.in(11) + (((size_t)l * 16 + gi) * 64 + n) * 16; const float* bim = F.in(12) + (((size_t)l * 16 + gi) * 64 + n) * 16;
            f32x2* bb = (f32x2*)(ms + MS_BBAR) + (size_t)e * 16;
#pragma unroll
            for (int c = 0; c < 16; ++c) { const float br = bre[c], bi = bim[c]; bb[c] = (f32x2){fr_ * br - fi_ * bi, fr_ * bi + fi_ * br}; }
        }
    }
}

DI void prologue_b(Frame& F) {
    const int gt = F.gw * 64 + F.lane, ngt = F.ngw * 64;
    for (int l = 0; l < NL; ++l) {
        unsigned char* wl = F.wsp() + WS_W + (size_t)l * WL_STRIDE;
        unsigned char* ms = F.wsp() + WS_MISC + (size_t)l * MS_L;
        unsigned char* ct = F.wsp() + WS_CTL + CT_BASE + (size_t)l * CT_L;
        const float* MT = (const float*)(ms + MS_MTAB);
        const f32x2* BB = (const f32x2*)(ms + MS_BBAR);
        const float dtl_base = 0.f; (void)dtl_base;
        for (int e = gt; e < 16 * 512 * 256; e += ngt) {
            const int gi = e >> 17, n = (e >> 8) & 511, k = e & 255; float v = 0.f;
            if (n < 256) { const int tp = n >> 4, cp = n & 15, ta = k >> 4, c = k & 15; if (tp >= ta) v = MT[((gi * 16 + (tp - ta)) * 16 + cp) * 16 + c]; }
            else if (n < 384) { const int s = (n - 256) & 63, part = (n - 256) >> 6, ta = k >> 4, c = k & 15;
                const float dt = __expf(F.in(8)[l * 16 + gi]);
                const float ar = F.in(9)[((size_t)l * 16 + gi) * 64 + s], ai = F.in(10)[((size_t)l * 16 + gi) * 64 + s];
                const float pw = (float)(15 - ta); float sp, cpw; sp = __sinf(pw * dt * ai); cpw = __cosf(pw * dt * ai); const float mg = __expf(pw * dt * ar);
                const float pr = mg * cpw, pi = mg * sp; const f32x2 b = BB[((size_t)gi * 64 + s) * 16 + c];
                v = part ? (pr * b.y + pi * b.x) : (pr * b.x - pi * b.y); }
            ((bf16_t*)(wl + WO_SS1))[e] = f2bf(v);
        }
        for (int e = gt; e < 16 * 256 * 256; e += ngt) {
            const int gi = e >> 16, n = (e >> 8) & 255, k = e & 255; float v = 0.f;
            if (k < 128) { const int s = k & 63, part = k >> 6, ta = n >> 4, c = n & 15;
                const float dt = __expf(F.in(8)[l * 16 + gi]);
                const float ar = F.in(9)[((size_t)l * 16 + gi) * 64 + s], ai = F.in(10)[((size_t)l * 16 + gi) * 64 + s];
                const float pw = (float)(ta + 1); float sp, cpw; sp = __sinf(pw * dt * ai); cpw = __cosf(pw * dt * ai); const float mg = __expf(pw * dt * ar);
                const float pr = mg * cpw, pi = mg * sp;
                const float cr = F.in(13)[(((size_t)l * 16 + gi) * 16 + c) * 64 + s], ci = F.in(14)[(((size_t)l * 16 + gi) * 16 + c) * 64 + s];
                v = part ? -(cr * pi + ci * pr) : (cr * pr - ci * pi); }
            ((bf16_t*)(wl + WO_SS2))[e] = f2bf(v);
        }
        for (int e = gt; e < 512; e += ngt) { const int kv = e >> 8, n = e & 255; float s = F.in(5)[((size_t)l * 2 + kv) * 256 + n];
            const float* pp = (const float*)(ms + MS_CBP) + (size_t)kv * 32 * 256 + n;
            for (int ch = 0; ch < 32; ++ch) s += pp[ch * 256];
            ((float*)(ct + CT_CB1))[e] = s; }
    }
}

DI void convert_rows_stats(Frame& F, const float* x, bf16_t* o, unsigned long long* ssx) {
    for (int m = F.gw; m < NT; m += F.ngw) {
        const f32x4* xr = (const f32x4*)(x + (size_t)m * DM) + F.lane; f32x4 v[4]; float s = 0.f;
#pragma unroll
        for (int j = 0; j < 4; ++j) { v[j] = xr[64 * j]; s += (v[j].x * v[j].x + v[j].y * v[j].y) + (v[j].z * v[j].z + v[j].w * v[j].w); }
        u32x2* o8 = (u32x2*)(o + (size_t)m * DM) + F.lane;
#pragma unroll
        for (int j = 0; j < 4; ++j) { u32x2 w; w.x = pk2(v[j].x, v[j].y); w.y = pk2(v[j].z, v[j].w); o8[64 * j] = w; }
        s = wave_sum(s);
        if (F.lane == 0) ssx[(size_t)m * 2] = (unsigned long long)(s * 1048576.f);
    }
}
DI void rmsnorm_rows_bf16(Frame& F, const float* x, const float* g, bf16_t* o) {
    const f32x4* gp = (const f32x4*)g + F.lane; f32x4 gv[4];
#pragma unroll
    for (int j = 0; j < 4; ++j) gv[j] = gp[64 * j];
    for (int m = F.gw; m < NT; m += F.ngw) {
        const f32x4* xr = (const f32x4*)(x + (size_t)m * DM) + F.lane; f32x4 v[4]; float s = 0.f;
#pragma unroll
        for (int j = 0; j < 4; ++j) { v[j] = xr[64 * j]; s += (v[j].x * v[j].x + v[j].y * v[j].y) + (v[j].z * v[j].z + v[j].w * v[j].w); }
        const float rstd = rsqrtf(wave_sum(s) * (1.f / DM) + 1e-6f);
        u32x2* o8 = (u32x2*)(o + (size_t)m * DM) + F.lane;
#pragma unroll
        for (int j = 0; j < 4; ++j) { u32x2 w; w.x = pk2(v[j].x * rstd * gv[j].x, v[j].y * rstd * gv[j].y); w.y = pk2(v[j].z * rstd * gv[j].z, v[j].w * rstd * gv[j].w); o8[64 * j] = w; }
    }
}
DI void rmsnorm_rows_fp8(Frame& F, const float* x, const float* g, unsigned char* o) {
    const f32x4* gp = (const f32x4*)g + F.lane; f32x4 gv[4];
#pragma unroll
    for (int j = 0; j < 4; ++j) gv[j] = gp[64 * j];
    for (int m = F.gw; m < NT; m += F.ngw) {
        const f32x4* xr = (const f32x4*)(x + (size_t)m * DM) + F.lane; f32x4 v[4]; float s = 0.f;
#pragma unroll
        for (int j = 0; j < 4; ++j) { v[j] = xr[64 * j]; s += (v[j].x * v[j].x + v[j].y * v[j].y) + (v[j].z * v[j].z + v[j].w * v[j].w); }
        const float rstd = rsqrtf(wave_sum(s) * (1.f / DM) + 1e-6f);
        unsigned* o4 = (unsigned*)(o + (size_t)m * DM) + F.lane;
#pragma unroll
        for (int j = 0; j < 4; ++j) o4[64 * j] = pk4_fp8(v[j].x * rstd * gv[j].x, v[j].y * rstd * gv[j].y, v[j].z * rstd * gv[j].z, v[j].w * rstd * gv[j].w);
    }
}
DI void rmsnorm_rows_f32_inplace(Frame& F, float* x, const float* g) {
    const f32x4* gp = (const f32x4*)g + F.lane; f32x4 gv[4];
#pragma unroll
    for (int j = 0; j < 4; ++j) gv[j] = gp[64 * j];
    for (int m = F.gw; m < NT; m += F.ngw) {
        f32x4* xr = (f32x4*)(x + (size_t)m * DM) + F.lane; f32x4 v[4]; float s = 0.f;
#pragma unroll
        for (int j = 0; j < 4; ++j) { v[j] = xr[64 * j]; s += (v[j].x * v[j].x + v[j].y * v[j].y) + (v[j].z * v[j].z + v[j].w * v[j].w); }
        const float rstd = rsqrtf(wave_sum(s) * (1.f / DM) + 1e-6f);
#pragma unroll
        for (int j = 0; j < 4; ++j) xr[64 * j] = v[j] * rstd * gv[j];
    }
}
template <int OUT>
DI void rmsnorm_rows_xb(Frame& F, const bf16_t* x, const float* g, void* o) {
    const f32x4* gp = (const f32x4*)g + 2 * F.lane; f32x4 gv[2][2];
#pragma unroll
    for (int j = 0; j < 2; ++j) { gv[j][0] = gp[128 * j]; gv[j][1] = gp[128 * j + 1]; }
    for (int m = 2 * F.gw; m < NT; m += 2 * F.ngw) {
        u32x4 w[2][2];
#pragma unroll
        for (int r = 0; r < 2; ++r)
#pragma unroll
            for (int j = 0; j < 2; ++j) w[r][j] = ((const u32x4*)(x + (size_t)(m + r) * DM) + F.lane)[64 * j];
#pragma unroll
        for (int r = 0; r < 2; ++r) {
            f32x4 v[2][2]; float s = 0.f;
#pragma unroll
            for (int j = 0; j < 2; ++j) { const u32x4 q = w[r][j];
                v[j][0] = f32x4{bflo(q.x), bfhi(q.x), bflo(q.y), bfhi(q.y)}; v[j][1] = f32x4{bflo(q.z), bfhi(q.z), bflo(q.w), bfhi(q.w)};
                const f32x4 a = v[j][0] * v[j][0] + v[j][1] * v[j][1]; s += (a.x + a.y) + (a.z + a.w); }
            const float rstd = rsqrtf(wave_sum(s) * (1.f / DM) + 1e-6f);
#pragma unroll
            for (int j = 0; j < 2; ++j) { const f32x4 y0 = v[j][0] * rstd * gv[j][0], y1 = v[j][1] * rstd * gv[j][1];
                if constexpr (OUT == 0) { u32x4 t; t.x = pk2(y0.x, y0.y); t.y = pk2(y0.z, y0.w); t.z = pk2(y1.x, y1.y); t.w = pk2(y1.z, y1.w);
                    ((u32x4*)((bf16_t*)o + (size_t)(m + r) * DM) + F.lane)[64 * j] = t; }
                else if constexpr (OUT == 1) { u32x2 t; t.x = pk4_fp8(y0.x, y0.y, y0.z, y0.w); t.y = pk4_fp8(y1.x, y1.y, y1.z, y1.w);
                    ((u32x2*)((unsigned char*)o + (size_t)(m + r) * DM) + F.lane)[64 * j] = t; }
                else { f32x4* op = (f32x4*)((float*)o + (size_t)(m + r) * DM) + 2 * F.lane + 128 * j; op[0] = y0; op[1] = y1; } }
        }
    }
}
DI void mix_norm_rows(Frame& F, const bf16_t* oatt, const bf16_t* ossm, const float* gatt, const float* gssm, bf16_t* mixed) {
    for (int m = F.gw; m < NT; m += F.ngw) {
        const u32x2* ar = (const u32x2*)(oatt + (size_t)m * 768) + F.lane;
        float a[12]; float s = 0.f;
#pragma unroll
        for (int j = 0; j < 3; ++j) { const u32x2 w = ar[64 * j]; a[4 * j] = bflo(w.x); a[4 * j + 1] = bfhi(w.x); a[4 * j + 2] = bflo(w.y); a[4 * j + 3] = bfhi(w.y); }
#pragma unroll
        for (int j = 0; j < 12; ++j) s += a[j] * a[j];
        const float ra = rsqrtf(wave_sum(s) * (1.f / 768.f) + 1e-6f);
        const u32x2 sw = ((const u32x2*)(ossm + (size_t)m * 256))[F.lane];
        float b[4] = {bflo(sw.x), bfhi(sw.x), bflo(sw.y), bfhi(sw.y)};
        const float rs = rsqrtf(wave_sum(b[0] * b[0] + b[1] * b[1] + b[2] * b[2] + b[3] * b[3]) * (1.f / 256.f) + 1e-6f);
        u32x2* o8 = (u32x2*)(mixed + (size_t)m * DM);
#pragma unroll
        for (int j = 0; j < 3; ++j) { const f32x4 gv = ((const f32x4*)gatt)[64 * j + F.lane];
            u32x2 w; w.x = pk2(a[4 * j] * ra * gv.x, a[4 * j + 1] * ra * gv.y); w.y = pk2(a[4 * j + 2] * ra * gv.z, a[4 * j + 3] * ra * gv.w); o8[64 * j + F.lane] = w; }
        { const f32x4 gv = ((const f32x4*)gssm)[F.lane]; u32x2 w; w.x = pk2(b[0] * rs * gv.x, b[1] * rs * gv.y); w.y = pk2(b[2] * rs * gv.z, b[3] * rs * gv.w); o8[192 + F.lane] = w; }
    }
}

#define KPERM(rt, r) (32 * ((rt) >> 1) + 8 * ((r) >> 2) + 4 * ((rt) & 1) + ((r) & 3))
DI void vtranspose_phase(Frame& F, const bf16_t* proj, bf16_t* vts, bf16_t* vtw, bf16_t* kfs, unsigned* vmax_word, int cu0) {
    LAS bf16_t* scr = (LAS bf16_t*)(F.lds + F.wave * 8704);
    unsigned vm = 0u;
    const bool split = F.G > 96;
    if (split && F.bid < cu0) return;
    const int gw0 = split ? F.gw - cu0 * 8 : F.gw, ngw0 = split ? F.ngw - cu0 * 8 : F.ngw;
    const int c16 = F.lane & 15, kq = F.lane >> 4;
    for (int it = gw0; it < 3 * 6 * 256; it += ngw0) {
        const int which = it / 1536, r = it % 1536, bh = r >> 8, tt = r & 255, b = bh / 3, h = bh % 3;
        const bf16_t* src = proj + ((size_t)(b * SEQ + 64 * tt)) * PW + (which == 0 ? C_VS : (which == 1 ? C_VW : C_KS)) + h * 64;
        bf16_t* dst = (which == 0 ? vts : (which == 1 ? vtw : kfs)) + (size_t)bh * 64 * SEQ + (size_t)tt * 4096;
#pragma unroll
        for (int i = 0; i < 8; ++i) { const int tk = i * 8 + (F.lane >> 3), d8 = F.lane & 7; const u32x4 w = *(const u32x4*)(src + (size_t)tk * PW + 8 * d8);
            if (which == 0) { vm = max(vm, max(max(w.x & 0x7fff0000u, (w.x << 16) & 0x7fff0000u), max(w.y & 0x7fff0000u, (w.y << 16) & 0x7fff0000u)));
                              vm = max(vm, max(max(w.z & 0x7fff0000u, (w.z << 16) & 0x7fff0000u), max(w.w & 0x7fff0000u, (w.w << 16) & 0x7fff0000u))); }
            LAS bf16_t* sp = scr + tk * 66 + 8 * d8; ((LAS unsigned*)sp)[0] = w.x; ((LAS unsigned*)sp)[1] = w.y; ((LAS unsigned*)sp)[2] = w.z; ((LAS unsigned*)sp)[3] = w.w; }
        asm volatile("s_waitcnt lgkmcnt(0)" ::: "memory");
        if (which == 1) {
#pragma unroll
            for (int i = 0; i < 8; ++i) { const int d = i * 8 + (F.lane >> 3), t8 = F.lane & 7; unsigned short e[8];
#pragma unroll
                for (int j = 0; j < 8; ++j) e[j] = scr[(8 * t8 + j) * 66 + d];
                u32x4 w; w.x = e[0] | ((unsigned)e[1] << 16); w.y = e[2] | ((unsigned)e[3] << 16); w.z = e[4] | ((unsigned)e[5] << 16); w.w = e[6] | ((unsigned)e[7] << 16);
                *(u32x4*)(dst + (size_t)d * 64 + 8 * t8) = w; }
        } else if (which == 0) {
#pragma unroll
            for (int I = 0; I < 8; ++I) { const int dt = I >> 1, sp = I & 1; unsigned short e[8];
#pragma unroll
                for (int j = 0; j < 8; ++j) e[j] = scr[(32 * sp + 8 * kq + j) * 66 + 16 * dt + c16];
                u32x4 w; w.x = e[0] | ((unsigned)e[1] << 16); w.y = e[2] | ((unsigned)e[3] << 16); w.z = e[4] | ((unsigned)e[5] << 16); w.w = e[6] | ((unsigned)e[7] << 16);
                *(u32x4*)(dst + (I * 64 + F.lane) * 8) = w; }
        } else {
#pragma unroll
            for (int I = 0; I < 8; ++I) { const int rt = I >> 1, ks = I & 1; const LAS bf16_t* sp = scr + KPERM(rt, c16) * 66 + 32 * ks + 8 * kq;
                u32x4 w; w.x = ((const LAS unsigned*)sp)[0]; w.y = ((const LAS unsigned*)sp)[1]; w.z = ((const LAS unsigned*)sp)[2]; w.w = ((const LAS unsigned*)sp)[3];
                *(u32x4*)(dst + (I * 64 + F.lane) * 8) = w; }
        }
        asm volatile("s_waitcnt lgkmcnt(0)" ::: "memory");
    }
    vm = wave_max_u32(vm);
    if (F.lane == 0 && vm != 0u) __hip_atomic_fetch_max(vmax_word, vm, __ATOMIC_RELAXED, __HIP_MEMORY_SCOPE_AGENT);
}

#define MFMA32(a, b, c) __builtin_amdgcn_mfma_f32_32x32x16_bf16((a), (b), (c), 0, 0, 0)
#define MFMA16(a, b, c) __builtin_amdgcn_mfma_f32_16x16x32_bf16((a), (b), (c), 0, 0, 0)

DI void compress2_phase(Frame& F, const bf16_t* hidc, const bf16_t* w2t, const float* b2  , bf16_t* kc, bf16_t* vct, int it0, int it_end, int it_step) {
    const int r = F.lane & 31, h = F.lane >> 5;
    for (int it = it0; it < it_end; it += it_step) {
        const int kv = it / 192, rb = it % 192; const int R0 = kv * 6144 + rb * 32;
        f32x16 acc0, acc1;
#pragma unroll
        for (int i = 0; i < 16; ++i) { acc0[i] = 0.f; acc1[i] = 0.f; }
        const bf16_t* ap = hidc + (size_t)(R0 + r) * 256 + 8 * h; const bf16_t* bp = w2t + (size_t)kv * 64 * 256 + (size_t)r * 256 + 8 * h;
#pragma unroll 4
        for (int ks = 0; ks < 16; ++ks) { const bf16x8 a = *(const bf16x8*)(ap + 16 * ks); const bf16x8 b0 = *(const bf16x8*)(bp + 16 * ks), b1 = *(const bf16x8*)(bp + 32 * 256 + 16 * ks);
            acc0 = MFMA32(a, b0, acc0); acc1 = MFMA32(a, b1, acc1); }
        const int bh = rb >> 5, i0 = (rb & 31) * 32;
        const float bb0 = b2[kv * 64 + r], bb1 = b2[kv * 64 + 32 + r];
        if (kv == 0) {
#pragma unroll
            for (int i = 0; i < 16; ++i) { const int row = i0 + (i & 3) + 8 * (i >> 2) + 4 * h; bf16_t* o = kc + ((size_t)bh * 1024 + row) * 64;
                const bool junk = (row == 1023);
                o[r] = junk ? (bf16_t)0 : f2bf(acc0[i] + bb0); o[32 + r] = junk ? (bf16_t)0 : f2bf(acc1[i] + bb1); }
        } else {
#pragma unroll
            for (int g4 = 0; g4 < 4; ++g4) { const int row = i0 + 8 * g4 + 4 * h;
                u32x2 w0, w1; w0.x = pk2(acc0[4 * g4] + bb0, acc0[4 * g4 + 1] + bb0); w0.y = pk2(acc0[4 * g4 + 2] + bb0, acc0[4 * g4 + 3] + bb0);
                w1.x = pk2(acc1[4 * g4] + bb1, acc1[4 * g4 + 1] + bb1); w1.y = pk2(acc1[4 * g4 + 2] + bb1, acc1[4 * g4 + 3] + bb1);
                if (row == 1020) { w0.y &= 0x0000ffffu; w1.y &= 0x0000ffffu; }
                bf16_t* vt = vct + (size_t)bh * 64 * 1024 + (size_t)(row >> 6) * 4096 + (row & 63);
                *(u32x2*)(vt + r * 64) = w0; *(u32x2*)(vt + (32 + r) * 64) = w1; }
        }
    }
}

DI void ssm_carry_phase(Frame& F, const float* hl, const f32x2* ab16, const f32x2* ab512, bf16_t* hin, int bg0, int bg_end, int bg_step) {
    LAS f32x2* E = (LAS f32x2*)F.lds;
    const int s = F.lane;
    for (int bg = bg0; bg < bg_end; bg += bg_step) {
        const int gi = bg & 15; const f32x2 a16 = ab16[gi * 64 + s], a5 = ab512[gi * 64 + s];
        const float* hp = hl + (size_t)bg * 1024 * 128 + s;
        float hr[4], hi[4];
#pragma unroll
        for (int j = 0; j < 4; ++j) { hr[j] = 0.f; hi[j] = 0.f; }
#pragma unroll 4
        for (int c = 0; c < 32; ++c) {
#pragma unroll
            for (int j = 0; j < 4; ++j) { const float* q = hp + (size_t)((4 * F.wave + j) * 32 + c) * 128; const float lr = q[0], li = q[64];
                const float nr = a16.x * hr[j] - a16.y * hi[j] + lr, ni = a16.x * hi[j] + a16.y * hr[j] + li; hr[j] = nr; hi[j] = ni; } }
#pragma unroll
        for (int j = 0; j < 4; ++j) E[(4 * F.wave + j) * 64 + s] = (f32x2){hr[j], hi[j]};
        __syncthreads();
        { float pr = 0.f, pi = 0.f;
          for (int k = 0; k < 4 * F.wave; ++k) { const f32x2 e = E[k * 64 + s]; const float nr = a5.x * pr - a5.y * pi + e.x, ni = a5.x * pi + a5.y * pr + e.y; pr = nr; pi = ni; }
#pragma unroll
          for (int j = 0; j < 4; ++j) { hr[j] = pr; hi[j] = pi; const f32x2 e = E[(4 * F.wave + j) * 64 + s]; const float nr = a5.x * pr - a5.y * pi + e.x, ni = a5.x * pi + a5.y * pr + e.y; pr = nr; pi = ni; } }
#pragma unroll 4
        for (int c = 0; c < 32; ++c) {
#pragma unroll
            for (int j = 0; j < 4; ++j) { const int ch = (4 * F.wave + j) * 32 + c; const float* q = hp + (size_t)ch * 128; const float lr = q[0], li = q[64];
                bf16_t* o = hin + ((size_t)bg * 1024 + ch) * 256; o[s] = f2bf(hr[j]); o[64 + s] = f2bf(hi[j]); ((unsigned*)(o + 128))[s] = 0u;
                const float nr = a16.x * hr[j] - a16.y * hi[j] + lr, ni = a16.x * hi[j] + a16.y * hr[j] + li; hr[j] = nr; hi[j] = ni; } }
        __syncthreads();
    }
}

constexpr float AL2E = 1.0f;
constexpr int IMP_STRIDE = 257;
constexpr int OS_QS = 261, OS_HS = 65;
constexpr int LDS_RA = 0, LDS_RB = 64 * IMP_STRIDE * 4, LDS_WM = LDS_RB + 64 * OS_QS * 4;
constexpr int QT_ROW = 144, LDS_QT = LDS_RA, LDS_QL = LDS_QT + 256 * QT_ROW, LDS_MREF = LDS_QL + 512, LDS_LS = LDS_MREF + 1024;
constexpr int LDS_QCNT = LDS_WM + 2048;
static_assert(LDS_LS + 1024 <= LDS_RB && LDS_QCNT + 20 <= LDS_BYTES - 256, "LDS map");
constexpr int TROW = 144, TILE_V = 64 * TROW, TILE_BYTES = 2 * 64 * TROW;

struct TileSrc { const bf16_t* k; long kstep, kstride; const bf16_t* v; long vstep, vstride; };

constexpr int PD = 1;
struct IdMap { DI int operator()(int i) const { return i; } };
template <bool WITH_V, class Compute, class Map = IdMap, bool FRAG = false>
DI void kv_pipeline(Frame& F, LAS unsigned char* sb, const TileSrc& ts, int n, Compute&& compute, Map tmap = Map()) {
    if (n <= 0) return;
    const int row = F.tid >> 3, ch = F.tid & 7, nl = n - 1;
    const bf16_t* kp = FRAG ? ts.k + F.tid * 8 : ts.k + (long)row * ts.kstride + ch * 8; const bf16_t* vp = FRAG ? ts.v + F.tid * 8 : ts.v + (long)row * ts.vstride + ch * 8;
    LAS unsigned char* wk = sb + row * TROW + ch * 16; int vdel = TILE_V;
    if (FRAG) { const int I = F.tid >> 6, l_ = F.tid & 63, c16_ = l_ & 15, kq_ = l_ >> 4;
        const int kofs = KPERM(I >> 1, c16_) * TROW + (32 * (I & 1) + 8 * kq_) * 2, vofs = TILE_V + (16 * (I >> 1) + c16_) * TROW + (32 * (I & 1) + 8 * kq_) * 2;
        wk = sb + kofs; vdel = vofs - kofs; }
    u32x4 kr[PD], vr[PD];
#pragma unroll
    for (int u = 0; u < PD; ++u) { const int t = tmap(u < nl ? u : nl); kr[u] = *(const u32x4*)(kp + (long)t * ts.kstep); vr[u] = WITH_V ? *(const u32x4*)(vp + (long)t * ts.vstep) : (u32x4){0u, 0u, 0u, 0u}; }
    *(LAS u32x4*)wk = kr[0]; if (WITH_V) *(LAS u32x4*)(wk + vdel) = vr[0];
    { const int t = tmap(PD < nl ? PD : nl); kr[0] = *(const u32x4*)(kp + (long)t * ts.kstep); if (WITH_V) vr[0] = *(const u32x4*)(vp + (long)t * ts.vstep); }
    __syncthreads();
    for (int i0 = 0; i0 < n; i0 += PD) {
#pragma unroll
        for (int u = 0; u < PD; ++u) {
            const int i = i0 + u; const int s1 = (u + 1) % PD;
            { LAS unsigned char* w1 = wk + ((i + 1) & 1) * TILE_BYTES; *(LAS u32x4*)w1 = kr[s1]; if (WITH_V) *(LAS u32x4*)(w1 + vdel) = vr[s1]; }
            { const int t = tmap((i + 1 + PD) < nl ? (i + 1 + PD) : nl); kr[s1] = *(const u32x4*)(kp + (long)t * ts.kstep); if (WITH_V) vr[s1] = *(const u32x4*)(vp + (long)t * ts.vstep); }
            if (i < n) compute(i, sb + (i & 1) * TILE_BYTES);
            __syncthreads();
        }
    }
}

DI f32x16 qk32(const LAS unsigned char* tb, int kh, int r32, int h, const bf16x8 (&qf)[4]) {
    f32x16 sc;
#pragma unroll
    for (int i = 0; i < 16; ++i) sc[i] = 0.f;
    const LAS unsigned char* kp = tb + (32 * kh + r32) * TROW + 16 * h;
#pragma unroll
    for (int s = 0; s < 4; ++s) { const bf16x8 a = *(const LAS bf16x8*)(kp + 32 * s); sc = MFMA32(a, qf[s], sc); }
    return sc;
}
DI void qk32x2c(const LAS unsigned char* tb, int r32, int h, const bf16x8 (&qf)[4], const f32x16& c0, f32x16& s0, f32x16& s1) {
    s0 = c0; s1 = c0;
    const LAS unsigned char* kp = tb + r32 * TROW + 16 * h;
#pragma unroll
    for (int s = 0; s < 4; ++s) { const bf16x8 a0 = *(const LAS bf16x8*)(kp + 32 * s), a1 = *(const LAS bf16x8*)(kp + 32 * TROW + 32 * s); s0 = MFMA32(a0, qf[s], s0); s1 = MFMA32(a1, qf[s], s1); }
}
DI f32x16 qk32c(const LAS unsigned char* tb, int kh, int r32, int h, const bf16x8 (&qf)[4], const f32x16& c0) {
    f32x16 sc = c0;
    const LAS unsigned char* kp = tb + (32 * kh + r32) * TROW + 16 * h;
#pragma unroll
    for (int s = 0; s < 4; ++s) { const bf16x8 a = *(const LAS bf16x8*)(kp + 32 * s); sc = MFMA32(a, qf[s], sc); }
    return sc;
}
DI void qk32x2(const LAS unsigned char* tb, int r32, int h, const bf16x8 (&qf)[4], f32x16& s0, f32x16& s1) {
#pragma unroll
    for (int i = 0; i < 16; ++i) { s0[i] = 0.f; s1[i] = 0.f; }
    const LAS unsigned char* kp = tb + r32 * TROW + 16 * h;
#pragma unroll
    for (int s = 0; s < 4; ++s) { const bf16x8 a0 = *(const LAS bf16x8*)(kp + 32 * s), a1 = *(const LAS bf16x8*)(kp + 32 * TROW + 32 * s); s0 = MFMA32(a0, qf[s], s0); s1 = MFMA32(a1, qf[s], s1); }
}
DI void pv32(const LAS unsigned char* tb, int kh, int r32, int h, const f32x16& p, f32x16& o0, f32x16& o1) {
#pragma unroll
    for (int s2 = 0; s2 < 2; ++s2) {
        u32x4 pw; pw.x = pk2(p[8 * s2], p[8 * s2 + 1]); pw.y = pk2(p[8 * s2 + 2], p[8 * s2 + 3]); pw.z = pk2(p[8 * s2 + 4], p[8 * s2 + 5]); pw.w = pk2(p[8 * s2 + 6], p[8 * s2 + 7]);
        const bf16x8 pb = __builtin_bit_cast(bf16x8, pw);
        const LAS unsigned char* vp = tb + TILE_V + r32 * TROW + (32 * kh + 16 * s2 + 4 * h) * 2;
        { const s16x4 lo = *(const LAS s16x4*)vp, hi = *(const LAS s16x4*)(vp + 16); const bf16x8 a = __builtin_shufflevector(lo, hi, 0, 1, 2, 3, 4, 5, 6, 7); o0 = MFMA32(a, pb, o0); }
        { const s16x4 lo = *(const LAS s16x4*)(vp + 32 * TROW), hi = *(const LAS s16x4*)(vp + 32 * TROW + 16); const bf16x8 a = __builtin_shufflevector(lo, hi, 0, 1, 2, 3, 4, 5, 6, 7); o1 = MFMA32(a, pb, o1); }
    }
}

DI void attn_unit(Frame& F, const bf16_t* proj, const bf16_t* kcb, const bf16_t* vctb, const bf16_t* vts, const bf16_t* vtw, bf16_t* oatt, int bh, int qb, float os_scale, float os_inv, float os_e2, float* park, const bf16_t* kfs, unsigned long long* sst) {
    const float ls_scale = 1048576.0f * os_inv;
    LAS unsigned* IMP = (LAS unsigned*)(F.lds + LDS_RA); LAS unsigned char* WM = F.lds + LDS_WM;
    const int b = bh / 3, hkv = bh % 3, lane = F.lane, w = F.wave;
    const float NEG = -__builtin_inff();
    for (int i = F.tid; i < 64 * IMP_STRIDE; i += 512) IMP[i] = 0u;
    for (int i = F.tid; i < 512; i += 512) ((LAS unsigned*)WM)[i] = 0u;
    if (F.tid == 0) ((LAS int*)(F.lds + LDS_QCNT + 16))[0] = 0;
    const int r32 = lane & 31, h = lane >> 5, gq = w & 3, qh = w >> 2;
    const int ql = 32 * qh + r32, t = 64 * qb + ql;
    const size_t trow = (size_t)(b * SEQ + t);
    const bf16_t* qrow = proj + trow * PW + C_Q + (hkv * 4 + gq) * 64;
    bf16x8 qf[4];
#pragma unroll
    for (int s = 0; s < 4; ++s) qf[s] = *(const bf16x8*)(qrow + 16 * s + 8 * h);
    const bf16_t* grow = proj + trow * PW + C_G + hkv * 12 + gq * 3;
    const float g0 = sigmoidf_(bf2f(grow[0])), g2 = sigmoidf_(bf2f(grow[2]));
    f32x16 oc0, oc1; float inv_c = 0.f;
#pragma unroll
    for (int i = 0; i < 16; ++i) { oc0[i] = 0.f; oc1[i] = 0.f; }
    {
        const int ntile = (4 * qb + 3 + 63) >> 6;
        const int vis = (t - 31) >> 4;
        const int vis_w = (64 * qb + 32 * qh + 31 - 31) >> 4;
        const int vis_min = (64 * qb + 32 * qh - 31) >> 4;
        TileSrc ts{kcb + (size_t)bh * 1024 * 64, 64 * 64, 64, vctb + (size_t)bh * 64 * 1024, 4096, 64};
        float m = NEG, lsum = 0.f;
        kv_pipeline<false>(F, F.lds + LDS_RB, ts, ntile, [&](int i, const LAS unsigned char* tb) {
            if (64 * i > vis_w) return;
            const bool two = (64 * i + 32 <= vis_w); f32x16 sq0, sq1;
            if (two) qk32x2(tb, r32, h, qf, sq0, sq1); else { sq0 = qk32(tb, 0, r32, h, qf); sq1 = sq0; }
#pragma unroll
            for (int kh = 0; kh < 2; ++kh) {
                if (kh == 1 && !two) continue;
                f32x16 sc = kh ? sq1 : sq0;
                if (64 * i + 32 * kh + 31 > vis_min) {
#pragma unroll
                    for (int e = 0; e < 16; ++e) { const int ki = 64 * i + 32 * kh + (e & 3) + 8 * (e >> 2) + 4 * h; sc[e] = (ki <= vis) ? sc[e] : NEG; }
                }
                float ps = 0.f;
#pragma unroll
                for (int e = 0; e < 16; ++e) ps += fexp2(sc[e]);
                lsum += ps;
            }
        });
        bool redo1; { const float Lq = xor32_sum(lsum); LAS int* WFLAG = (LAS int*)(F.lds + LDS_QCNT + 16);
          if (!(Lq == 0.f || (Lq > 5.4e-20f && Lq < 1.8e19f))) WFLAG[0] = 1;
          __syncthreads();
          redo1 = (WFLAG[0] != 0) || (FORCE_REDO != 0); }
        float M = 0.f, Lt = 0.f;
        if (!redo1) { Lt = xor32_sum(lsum); }
        else {
        lsum = 0.f;
        for (int rep_ = 0; rep_ < REP_B1; ++rep_)
        kv_pipeline<false>(F, F.lds + LDS_RB, ts, ntile, [&](int i, const LAS unsigned char* tb) {
            if (64 * i > vis_w) return;
            const bool two = (64 * i + 32 <= vis_w); f32x16 sq0, sq1;
            if (two) qk32x2(tb, r32, h, qf, sq0, sq1); else { sq0 = qk32(tb, 0, r32, h, qf); sq1 = sq0; }
#pragma unroll
            for (int kh = 0; kh < 2; ++kh) {
                if (kh == 1 && !two) continue;
                f32x16 sc = kh ? sq1 : sq0;
                float tm = NEG;
                if (64 * i + 32 * kh + 31 > vis_min) {
#pragma unroll
                    for (int e = 0; e < 16; ++e) { const int ki = 64 * i + 32 * kh + (e & 3) + 8 * (e >> 2) + 4 * h; sc[e] = (ki <= vis) ? sc[e] : NEG; }
                }
#pragma unroll
                for (int e = 0; e < 16; ++e) tm = fmaxf(tm, sc[e]);
                const float mn = fmaxf(m, tm);
                if (mn > NEG) { float ps = 0.f;
#pragma unroll
                    for (int e = 0; e < 16; ++e) ps += fexp2((sc[e] - mn) * AL2E);
                    lsum = lsum * fexp2((m - mn) * AL2E) + ps; m = mn; }
            }
        });
        const F2 mm = halves32(m), ll = halves32(lsum);
        M = fmaxf(mm.lo, mm.hi);
        if (M > NEG) Lt = ll.lo * fexp2((mm.lo - M) * AL2E) + ll.hi * fexp2((mm.hi - M) * AL2E); else M = 0.f;
        }
        inv_c = 1.0f / 16777216.0f;
        const float cMs = 24.0f - __log2f(fmaxf(Lt, 1e-30f)) - M;
        f32x16 cM;
#pragma unroll
        for (int e = 0; e < 16; ++e) cM[e] = cMs;
        for (int rep_ = 0; rep_ < REP_B1; ++rep_)
        kv_pipeline<true>(F, F.lds + LDS_RB, ts, ntile, [&](int i, const LAS unsigned char* tb) {
            if (64 * i > vis_w) return;
            const bool two = (64 * i + 32 <= vis_w); f32x16 sq0, sq1;
            if (two) qk32x2c(tb, r32, h, qf, cM, sq0, sq1); else { sq0 = qk32c(tb, 0, r32, h, qf, cM); sq1 = sq0; }
#pragma unroll
            for (int kh = 0; kh < 2; ++kh) {
                if (kh == 1 && !two) continue;
                f32x16 sc = kh ? sq1 : sq0;
#pragma unroll
                for (int e = 0; e < 16; ++e) sc[e] = fexp2(sc[e]);
                if (64 * i + 32 * kh + 31 > vis_min) {
#pragma unroll
                    for (int e = 0; e < 16; ++e) { const int ki = 64 * i + 32 * kh + (e & 3) + 8 * (e >> 2) + 4 * h; sc[e] = (ki <= vis) ? sc[e] : 0.f; }
                }
#pragma unroll
                for (int a = 0; a < 4; ++a) { const float G = (sc[4 * a] + sc[4 * a + 1]) + (sc[4 * a + 2] + sc[4 * a + 3]); const int j = 16 * i + 8 * kh + 2 * a + h;
                    __hip_atomic_fetch_add(IMP + ql * IMP_STRIDE + j, (unsigned)G, __ATOMIC_RELAXED, __HIP_MEMORY_SCOPE_WORKGROUP);
                    __hip_atomic_fetch_add(IMP + ql * IMP_STRIDE + j + 1, (unsigned)sc[4 * a + 3], __ATOMIC_RELAXED, __HIP_MEMORY_SCOPE_WORKGROUP); }
                pv32(tb, kh, r32, h, sc, oc0, oc1);
            }
        });
    }
    {
        const int cur = qb; LAS unsigned char* wm = WM + w * 256;
        if (cur + 1 <= 16) { if (lane <= cur) wm[lane] = 0xff; }
        else for (int rep_ = 0; rep_ < REP_TK; ++rep_) {
            unsigned key[8][4]; unsigned selbits = 0u;
#pragma unroll
            for (int qi = 0; qi < 8; ++qi) {
#pragma unroll
                for (int i = 0; i < 4; ++i) { const int j = 4 * lane + i; const unsigned x = IMP[(8 * w + qi) * IMP_STRIDE + j]; key[qi][i] = (j >= 1 && j <= cur - 2) ? (((x + 1u) << 2) | (unsigned)(3 - i)) : 0u; }
#define CE_(a_, b_) do { const unsigned hi_ = max(key[qi][a_], key[qi][b_]), lo_ = min(key[qi][a_], key[qi][b_]); key[qi][a_] = hi_; key[qi][b_] = lo_; } while (0)
                CE_(0, 1); CE_(2, 3); CE_(0, 2); CE_(1, 3); CE_(1, 2);
#undef CE_
            }
            for (int k = 0; k < 13; ++k) {
                unsigned hvs[8], rd[8];
#pragma unroll
                for (int qi = 0; qi < 8; ++qi) { hvs[qi] = key[qi][0] >> 2; rd[qi] = hvs[qi]; }
                wave_max4_lane63(rd[0], rd[1], rd[2], rd[3]); wave_max4_lane63(rd[4], rd[5], rd[6], rd[7]);
#pragma unroll
                for (int qi = 0; qi < 8; ++qi) {
                    const unsigned hv = hvs[qi]; const unsigned Mx = (unsigned)__builtin_amdgcn_readlane((int)rd[qi], 63);
                    const unsigned long long bal = __ballot(hv == Mx); const int L = __ffsll((long long)bal) - 1;
                    const unsigned bit = 1u << (8 * (3 - (int)(key[qi][0] & 3u)) + qi);
                    const bool win = (lane == L);
                    selbits |= win ? bit : 0u;
                    key[qi][0] = win ? key[qi][1] : key[qi][0]; key[qi][1] = win ? key[qi][2] : key[qi][1]; key[qi][2] = win ? key[qi][3] : key[qi][2]; key[qi][3] = win ? 0u : key[qi][3];
                }
            }
            unsigned mybits[4];
#pragma unroll
            for (int i = 0; i < 4; ++i) mybits[i] = (selbits >> (8 * i)) & 0xffu;
#pragma unroll
            for (int i = 0; i < 4; ++i) { const int j = 4 * lane + i; unsigned bits = mybits[i]; if (j == 0 || j == cur - 1 || j == cur) bits = 0xffu; wm[j] = (unsigned char)bits; }
        }
    }
    __syncthreads();
    {
        const int kt_lo = (qb - 8) > 0 ? (qb - 8) : 0; const int ntile = qb - kt_lo + 1;
        const int t0w = 64 * qb + 32 * qh;
        TileSrc ts{proj + ((size_t)(b * SEQ) + 64 * kt_lo) * PW + C_KW + hkv * 64, 64 * PW, PW, vtw + (size_t)bh * 64 * SEQ + (size_t)kt_lo * 4096, 4096, 64};
        float m = NEG, lsum = 0.f; f32x16 o0, o1;
#pragma unroll
        for (int i = 0; i < 16; ++i) { o0[i] = 0.f; o1[i] = 0.f; }
        kv_pipeline<true>(F, F.lds + LDS_RA, ts, ntile, [&](int i, const LAS unsigned char* tb) {
#pragma unroll
            for (int kh = 0; kh < 2; ++kh) {
                const int k0 = 64 * (kt_lo + i) + 32 * kh;
                if (k0 > t0w + 31 || k0 + 31 <= t0w - 512) continue;
                f32x16 sc = qk32(tb, kh, r32, h, qf);
                if (!(k0 + 31 <= t0w && k0 > t0w + 31 - 512)) {
#pragma unroll
                    for (int e = 0; e < 16; ++e) { const int key = k0 + (e & 3) + 8 * (e >> 2) + 4 * h; sc[e] = (key <= t && key > t - 512) ? sc[e] : NEG; }
                }
                float ps = 0.f;
#pragma unroll
                for (int e = 0; e < 16; ++e) { sc[e] = fexp2(sc[e]); ps += sc[e]; }
                lsum += ps;
                pv32(tb, kh, r32, h, sc, o0, o1);
            }
        });
        bool redo; { const float Lq = xor32_sum(lsum); LAS int* WFLAG = (LAS int*)(F.lds + LDS_QCNT + 16);
          if (!(Lq > 5.4e-20f && Lq < 1.8e19f)) WFLAG[0] = 1;
          __syncthreads();
          redo = (WFLAG[0] != 0) || (FORCE_REDO != 0); }
        if (redo) {
        lsum = 0.f;
#pragma unroll
        for (int i = 0; i < 16; ++i) { o0[i] = 0.f; o1[i] = 0.f; }
        kv_pipeline<true>(F, F.lds + LDS_RA, ts, ntile, [&](int i, const LAS unsigned char* tb) {
#pragma unroll
            for (int kh = 0; kh < 2; ++kh) {
                const int k0 = 64 * (kt_lo + i) + 32 * kh;
                if (k0 > t0w + 31 || k0 + 31 <= t0w - 512) continue;
                f32x16 sc = qk32(tb, kh, r32, h, qf);
                float tm = NEG;
                if (!(k0 + 31 <= t0w && k0 > t0w + 31 - 512)) {
#pragma unroll
                    for (int e = 0; e < 16; ++e) { const int key = k0 + (e & 3) + 8 * (e >> 2) + 4 * h; sc[e] = (key <= t && key > t - 512) ? sc[e] : NEG; }
                }
#pragma unroll
                for (int e = 0; e < 16; ++e) tm = fmaxf(tm, sc[e]);
                tm = xor32_max(tm);
                const float mn = fmaxf(m, tm); const float ms = (mn > NEG) ? mn : 0.f;
                const float alpha = fexp2((m - ms) * AL2E); float ps = 0.f;
#pragma unroll
                for (int e = 0; e < 16; ++e) { sc[e] = fexp2((sc[e] - ms) * AL2E); ps += sc[e]; }
                lsum = lsum * alpha + ps; m = mn;
                if (__any(alpha != 1.0f)) {
#pragma unroll
                    for (int e = 0; e < 16; ++e) { o0[e] *= alpha; o1[e] *= alpha; }
                }
                pv32(tb, kh, r32, h, sc, o0, o1);
            }
        });
        }
        const float Lw = xor32_sum(lsum); const float gw = g2 / fmaxf(Lw, 1e-30f);
        const float gc = g0 * inv_c;
#pragma unroll
        for (int e = 0; e < 16; ++e) { oc0[e] = gc * oc0[e] + gw * o0[e]; oc1[e] = gc * oc1[e] + gw * o1[e]; }
        bf16_t* op = oatt + trow * 1024 + (hkv * 4 + gq) * 64;
#pragma unroll
        for (int g4 = 0; g4 < 4; ++g4) { const int d = 8 * g4 + 4 * h; u32x2 w0, w1;
            w0.x = pk2(oc0[4 * g4], oc0[4 * g4 + 1]); w0.y = pk2(oc0[4 * g4 + 2], oc0[4 * g4 + 3]); w1.x = pk2(oc1[4 * g4], oc1[4 * g4 + 1]); w1.y = pk2(oc1[4 * g4 + 2], oc1[4 * g4 + 3]);
            *(u32x2*)(op + d) = w0; *(u32x2*)(op + 32 + d) = w1; }
    }
    const int cur = qb; const bool dense = (cur + 1 <= 16);
    float mf = NEG, lf = 0.f, msp = 0.f;
    {
        const int nfb = dense ? (cur + 1) : 3;
        TileSrc ts{kfs + (size_t)bh * 64 * SEQ, 4096, 0, vts + (size_t)bh * 64 * SEQ, 4096, 0};
#pragma unroll
        for (int e = 0; e < 16; ++e) { oc0[e] = 0.f; oc1[e] = 0.f; }
        auto dense_map = [&](int i) -> int { return dense ? i : (i == 0 ? 0 : cur - 2 + i); };
        auto dense_fast = [&](int i, const LAS unsigned char* tb) {
            const int j = dense ? i : (i == 0 ? 0 : cur - 2 + i);
#pragma unroll
            for (int kh = 0; kh < 2; ++kh) {
                const int k0 = 64 * j + 32 * kh;
                if (k0 > 64 * qb + 32 * qh + 31) continue;
                f32x16 sc = qk32(tb, kh, r32, h, qf);
                if (k0 + 31 > 64 * qb + 32 * qh) {
#pragma unroll
                    for (int e = 0; e < 16; ++e) { const int key = k0 + (e & 3) + 8 * (e >> 2) + 4 * h; sc[e] = (key <= t) ? sc[e] : NEG; }
                }
                float ps = 0.f;
#pragma unroll
                for (int e = 0; e < 16; ++e) { sc[e] = fexp2(sc[e]); ps += sc[e]; }
                lf += ps;
                pv32(tb, kh, r32, h, sc, oc0, oc1);
            }
        };
        kv_pipeline<true, decltype(dense_fast)&, decltype(dense_map), true>(F, F.lds + LDS_RA, ts, nfb, dense_fast, dense_map);
        bool redo2; { const float Lq = xor32_sum(lf); LAS int* WFLAG = (LAS int*)(F.lds + LDS_QCNT + 16);
          if (!(Lq > 5.4e-20f && Lq < 1.8e19f)) WFLAG[0] = 1;
          __syncthreads();
          redo2 = (WFLAG[0] != 0) || (FORCE_REDO != 0); }
        if (!redo2) { lf = xor32_sum(lf); mf = 0.f; msp = __log2f(lf) - 4.0f; }
        else {
        lf = 0.f;
#pragma unroll
        for (int e = 0; e < 16; ++e) { oc0[e] = 0.f; oc1[e] = 0.f; }
        auto dense_fn = [&](int i, const LAS unsigned char* tb) {
            const int j = dense ? i : (i == 0 ? 0 : cur - 2 + i);
#pragma unroll
            for (int kh = 0; kh < 2; ++kh) {
                const int k0 = 64 * j + 32 * kh;
                if (k0 > 64 * qb + 32 * qh + 31) continue;
                f32x16 sc = qk32(tb, kh, r32, h, qf);
                float tm = NEG;
                if (k0 + 31 > 64 * qb + 32 * qh) {
#pragma unroll
                    for (int e = 0; e < 16; ++e) { const int key = k0 + (e & 3) + 8 * (e >> 2) + 4 * h; sc[e] = (key <= t) ? sc[e] : NEG; }
                }
#pragma unroll
                for (int e = 0; e < 16; ++e) tm = fmaxf(tm, sc[e]);
                tm = xor32_max(tm);
                const float mn = fmaxf(mf, tm); const float ms = (mn > NEG) ? mn : 0.f;
                const float alpha = fexp2((mf - ms) * AL2E); float ps = 0.f;
#pragma unroll
                for (int e = 0; e < 16; ++e) { sc[e] = fexp2((sc[e] - ms) * AL2E); ps += sc[e]; }
                lf = lf * alpha + ps; mf = mn;
                if (__any(alpha != 1.0f)) {
#pragma unroll
                    for (int e = 0; e < 16; ++e) { oc0[e] *= alpha; oc1[e] *= alpha; }
                }
                pv32(tb, kh, r32, h, sc, oc0, oc1);
            }
        };
        kv_pipeline<true, decltype(dense_fn)&, decltype(dense_map), true>(F, F.lds + LDS_RA, ts, nfb, dense_fn, dense_map);
        lf = xor32_sum(lf); msp = mf;
        }
#pragma unroll
        for (int g4 = 0; g4 < 4; ++g4) { *(f32x4*)(park + 4 * g4) = (f32x4){oc0[4 * g4], oc0[4 * g4 + 1], oc0[4 * g4 + 2], oc0[4 * g4 + 3]}; *(f32x4*)(park + 16 + 4 * g4) = (f32x4){oc1[4 * g4], oc1[4 * g4 + 1], oc1[4 * g4 + 2], oc1[4 * g4 + 3]}; }
    }
    {
        const int c16 = lane & 15, kq = lane >> 4, hd = c16 & 3, qs = c16 >> 2;
        LAS unsigned char* QT = F.lds + LDS_QT; LAS unsigned char* QL = F.lds + LDS_QL + w * 64; LAS int* MREF = (LAS int*)(F.lds + LDS_MREF); LAS unsigned* LS = (LAS unsigned*)(F.lds + LDS_LS);
        LAS int* OS = (LAS int*)(F.lds + LDS_RB);
        LAS int* QCNT = (LAS int*)(F.lds + LDS_QCNT); LAS int* FLAGW = (LAS int*)(F.lds + LDS_QCNT + 12);
        bool exact = false;
        const int nsp = dense ? 0 : (cur - 2);
        if (nsp > 0) {
        { const int row = F.tid >> 1, half = F.tid & 1, q = row >> 2, hh = row & 3;
          const bf16_t* src = proj + (size_t)(b * SEQ + 64 * qb + q) * PW + C_Q + (hkv * 4 + hh) * 64 + 32 * half;
          const u32x4 v0 = *(const u32x4*)src, v1 = *(const u32x4*)(src + 8), v2 = *(const u32x4*)(src + 16), v3 = *(const u32x4*)(src + 24);
          LAS u32x4* d = (LAS u32x4*)(QT + row * QT_ROW + 64 * half); d[0] = v0; d[1] = v1; d[2] = v2; d[3] = v3; }
        for (int i = F.tid; i < 64 * OS_QS; i += 512) OS[i] = 0;
        if (F.tid < 256) LS[F.tid] = 0u;
        if (h == 0) MREF[ql * 4 + gq] = __float_as_int(msp);
        if (F.tid < 2) QCNT[F.tid] = 0;
        if (F.tid == 2) FLAGW[0] = 0;
        __syncthreads();
        const bf16_t* Ksb = kfs + (size_t)bh * 64 * SEQ + lane * 8;
        const bf16_t* Vsb = vts + (size_t)bh * 64 * SEQ + lane * 8;
        auto ticket = [&](LAS int* cnt) -> int { int tk = 0; if (lane == 0) tk = __hip_atomic_fetch_add(cnt, 1, __ATOMIC_RELAXED, __HIP_MEMORY_SCOPE_WORKGROUP); return __builtin_amdgcn_readfirstlane(tk); };
        auto load_k = [&](int j, bf16x8 (&kf)[4][2]) {
#pragma unroll
            for (int rt = 0; rt < 4; ++rt)
#pragma unroll
                for (int ks = 0; ks < 2; ++ks) kf[rt][ks] = *(const bf16x8*)(Ksb + (size_t)j * 4096 + 512 * (2 * rt + ks)); };
        auto load_v = [&](int j, bf16x8 (&vf)[4][2]) {
#pragma unroll
            for (int dt = 0; dt < 4; ++dt)
#pragma unroll
                for (int sp = 0; sp < 2; ++sp) vf[dt][sp] = *(const bf16x8*)(Vsb + (size_t)j * 4096 + 512 * (2 * dt + sp)); };
        auto make_list = [&](int j, int& nj) -> int {
            const unsigned byte = WM[(lane >> 3) * 256 + j]; const bool act = (byte >> (lane & 7)) & 1u;
            const unsigned long long bal = __ballot(act); nj = __popcll(bal);
            const int rank = __builtin_amdgcn_mbcnt_hi((unsigned)(bal >> 32), __builtin_amdgcn_mbcnt_lo((unsigned)bal, 0u));
            if (act) QL[rank] = (unsigned char)lane;
            asm volatile("s_waitcnt lgkmcnt(0)" ::: "memory");
            return (nj + 3) >> 2; };
        auto col_query = [&](int tl, int nj, bool& valid) -> int { const int idx = 4 * tl + qs; valid = idx < nj; return (int)QL[valid ? idx : 0]; };
        auto scores = [&](const bf16x8 (&kf)[4][2], int q, const f32x4 c0, f32x4 (&st)[4]) {
            const LAS unsigned char* qp = QT + (q * 4 + hd) * QT_ROW + 16 * kq;
            const bf16x8 q0 = *(const LAS bf16x8*)qp, q1 = *(const LAS bf16x8*)(qp + 64);
#pragma unroll
            for (int rt = 0; rt < 4; ++rt) { st[rt] = MFMA16(kf[rt][0], q0, c0); st[rt] = MFMA16(kf[rt][1], q1, st[rt]); } };
        auto run_pass2 = [&](const bool FAST) {
            bf16x8 ka[4][2], va[4][2], kb[4][2], vb[4][2]; float psmax = 0.f;
            auto do_block = [&](const bf16x8 (&kf)[4][2], const bf16x8 (&vf)[4][2], const int t0) {
                int nj; const int ntl = make_list(1 + t0, nj);
                for (int tl = 0; tl < ntl; ++tl) {
                    bool valid; const int q = col_query(tl, nj, valid);
                    float mr;
                    if (FAST) mr = __int_as_float(MREF[q * 4 + hd]);
                    else { const int key = MREF[q * 4 + hd]; const int ib = key >= 0 ? key : (key ^ 0x7fffffff); mr = __int_as_float(ib); mr = (mr > NEG) ? mr : 0.f; }
                    float ps = 0.f; mr = os_e2 - mr;
                    f32x4 st[4]; scores(kf, q, (f32x4){mr, mr, mr, mr}, st);
#pragma unroll
                    for (int rt = 0; rt < 4; ++rt)
#pragma unroll
                        for (int e = 0; e < 4; ++e) { st[rt][e] = fexp2(st[rt][e]); ps += st[rt][e]; }
                    ps = xor32_sum(xor16_sum(ps));
                    psmax = fmaxf(psmax, ps);
                    f32x4 o[4];
#pragma unroll
                    for (int dt = 0; dt < 4; ++dt) o[dt] = (f32x4){0.f, 0.f, 0.f, 0.f};
#pragma unroll
                    for (int sp = 0; sp < 2; ++sp) {
                        u32x4 pw; pw.x = pk2(st[2 * sp][0], st[2 * sp][1]); pw.y = pk2(st[2 * sp][2], st[2 * sp][3]); pw.z = pk2(st[2 * sp + 1][0], st[2 * sp + 1][1]); pw.w = pk2(st[2 * sp + 1][2], st[2 * sp + 1][3]);
                        const bf16x8 pb = __builtin_bit_cast(bf16x8, pw);
#pragma unroll
                        for (int dt = 0; dt < 4; ++dt) o[dt] = MFMA16(vf[dt][sp], pb, o[dt]);
                    }
                    if (valid) {
                        LAS int* op = OS + q * OS_QS + hd * OS_HS + 4 * kq;
#pragma unroll
                        for (int dt = 0; dt < 4; ++dt)
#pragma unroll
                            for (int e = 0; e < 4; ++e) __hip_atomic_fetch_add(op + 16 * dt + e, (int)o[dt][e], __ATOMIC_RELAXED, __HIP_MEMORY_SCOPE_WORKGROUP);
                        if (kq == 0) __hip_atomic_fetch_add(LS + q * 4 + hd, (unsigned)(ps * ls_scale + 0.5f), __ATOMIC_RELAXED, __HIP_MEMORY_SCOPE_WORKGROUP);
                    }
                }
            };
            int t0 = ticket(QCNT + 1), t1;
            { const int j0 = t0 < nsp ? t0 : nsp - 1; load_k(1 + j0, ka); load_v(1 + j0, va); }
            for (;;) {
                if (t0 >= nsp) break;
                asm volatile("s_waitcnt vmcnt(0)" ::: "memory");
                t1 = ticket(QCNT + 1);
                { const int j1 = t1 < nsp ? t1 : nsp - 1; load_k(1 + j1, kb); load_v(1 + j1, vb); }
                do_block(ka, va, t0);
                if (t1 >= nsp) break;
                asm volatile("s_waitcnt vmcnt(0)" ::: "memory");
                t0 = ticket(QCNT + 1);
                { const int j0 = t0 < nsp ? t0 : nsp - 1; load_k(1 + j0, ka); load_v(1 + j0, va); }
                do_block(kb, vb, t1);
            }
            asm volatile("s_waitcnt vmcnt(0)" ::: "memory");
            if (FAST) { if (psmax > 218.0f * os_scale) FLAGW[0] = 1; }
        };
        for (int rep2_ = 0; rep2_ < REP_B3; ++rep2_) {
            if (rep2_ > 0) { __syncthreads(); if (F.tid == 0) QCNT[1] = 0; __syncthreads(); }
            run_pass2(true);
        }
        __syncthreads();
        exact = (FLAGW[0] != 0) || (REP_B2 > 1);
        if (exact) {
            __syncthreads();
            for (int i = F.tid; i < 64 * OS_QS; i += 512) OS[i] = 0;
            if (F.tid < 256) { MREF[F.tid] = (int)0x80000000; LS[F.tid] = 0u; }
            if (F.tid < 2) QCNT[F.tid] = 0;
            __syncthreads();
            {
                bf16x8 kf[4][2], kn[4][2], kn2[4][2];
                int t0 = ticket(QCNT), t1 = ticket(QCNT), t2;
                if (t0 < nsp) load_k(1 + t0, kf);
                if (t1 < nsp) load_k(1 + t1, kn);
                while (t0 < nsp) {
                    t2 = ticket(QCNT);
                    if (t2 < nsp) load_k(1 + t2, kn2);
                    int nj; const int ntl = make_list(1 + t0, nj);
                    for (int tl = 0; tl < ntl; ++tl) {
                        bool valid; const int q = col_query(tl, nj, valid);
                        f32x4 st[4]; scores(kf, q, (f32x4){0.f, 0.f, 0.f, 0.f}, st);
                        float bm = NEG;
#pragma unroll
                        for (int rt = 0; rt < 4; ++rt)
#pragma unroll
                            for (int e = 0; e < 4; ++e) bm = fmaxf(bm, st[rt][e]);
                        bm = xor32_max(xor16_max(bm));
                        if (valid && kq == 0) { const int ib = __float_as_int(bm); const int key = ib >= 0 ? ib : (ib ^ 0x7fffffff);
                            __hip_atomic_fetch_max(MREF + q * 4 + hd, key, __ATOMIC_RELAXED, __HIP_MEMORY_SCOPE_WORKGROUP); }
                    }
#pragma unroll
                    for (int rt = 0; rt < 4; ++rt)
#pragma unroll
                        for (int ks = 0; ks < 2; ++ks) { kf[rt][ks] = kn[rt][ks]; kn[rt][ks] = kn2[rt][ks]; }
                    t0 = t1; t1 = t2;
                }
            }
            __syncthreads();
            run_pass2(false);
            __syncthreads();
        }
        }
        {
            float ms_ = NEG, ls_ = 0.f;
            if (nsp > 0) { const int key = MREF[ql * 4 + gq]; const int ib = key >= 0 ? key : (key ^ 0x7fffffff); const float m0 = exact ? __int_as_float(ib) : msp;
                if ((!exact || key != (int)0x80000000) && m0 > NEG) { ms_ = m0; ls_ = (float)LS[ql * 4 + gq] * (1.0f / 1048576.0f); } }
            const float Mx = fmaxf(mf, ms_);
            const float wf = fexp2((mf - Mx) * AL2E), ws_ = (ms_ > NEG) ? fexp2((ms_ - Mx) * AL2E) : 0.f;
            const float Lt = lf * wf + ls_ * ws_;
            const float g1 = sigmoidf_(bf2f(grow[1])) / fmaxf(Lt, 1e-30f);
            const float cf = g1 * wf, cs = g1 * ws_ * os_inv;
            const LAS int* ap = OS + ql * OS_QS + gq * OS_HS; float osq = 0.f;
            bf16_t* op = oatt + trow * 1024 + (hkv * 4 + gq) * 64;
#pragma unroll
            for (int g4 = 0; g4 < 4; ++g4) { const int d = 8 * g4 + 4 * h;
                const u32x2 p0 = *(const u32x2*)(op + d), p1 = *(const u32x2*)(op + 32 + d);
                const f32x4 f0 = *(const f32x4*)(park + 4 * g4), f1 = *(const f32x4*)(park + 16 + 4 * g4);
                float s0[4], s1[4];
#pragma unroll
                for (int e = 0; e < 4; ++e) { s0[e] = (nsp > 0) ? (float)ap[d + e] : 0.f; s1[e] = (nsp > 0) ? (float)ap[32 + d + e] : 0.f; }
                u32x2 w0, w1;
                w0.x = pk2(bflo(p0.x) + cf * f0[0] + cs * s0[0], bfhi(p0.x) + cf * f0[1] + cs * s0[1]); w0.y = pk2(bflo(p0.y) + cf * f0[2] + cs * s0[2], bfhi(p0.y) + cf * f0[3] + cs * s0[3]);
                w1.x = pk2(bflo(p1.x) + cf * f1[0] + cs * s1[0], bfhi(p1.x) + cf * f1[1] + cs * s1[1]); w1.y = pk2(bflo(p1.y) + cf * f1[2] + cs * s1[2], bfhi(p1.y) + cf * f1[3] + cs * s1[3]);
                *(u32x2*)(op + d) = w0; *(u32x2*)(op + 32 + d) = w1;
                osq += (bflo(w0.x) * bflo(w0.x) + bfhi(w0.x) * bfhi(w0.x)) + (bflo(w0.y) * bflo(w0.y) + bfhi(w0.y) * bfhi(w0.y)) + (bflo(w1.x) * bflo(w1.x) + bfhi(w1.x) * bfhi(w1.x)) + (bflo(w1.y) * bflo(w1.y) + bfhi(w1.y) * bfhi(w1.y)); }
            (void)__hip_atomic_fetch_add(sst + trow * 2, (unsigned long long)(osq * 16777216.f), __ATOMIC_RELAXED, __HIP_MEMORY_SCOPE_AGENT);
        }
    }
    __syncthreads();
}

DI void attn_phase(Frame& F, const bf16_t* proj, const bf16_t* kcb, const bf16_t* vctb, const bf16_t* vts, const bf16_t* vtw, bf16_t* oatt, const unsigned* vmax_word, float* park, unsigned* qctr, const bf16_t* kfs, unsigned long long* sst) {
    const float vmaxf = fmaxf(__uint_as_float(__hip_atomic_load(vmax_word, __ATOMIC_RELAXED, __HIP_MEMORY_SCOPE_AGENT)), 1e-20f);
    int e2 = (int)floorf(log2f(2.0e9f / (1100.0f * 55.0f * vmaxf)));
    e2 = e2 > 100 ? 100 : (e2 < -100 ? -100 : e2);
    const float os_scale = exp2f((float)e2), os_inv = exp2f((float)-e2);
    LAS int* QW = (LAS int*)(F.lds + LDS_QCNT + 8);
    int xq; { unsigned xx; asm volatile("s_getreg_b32 %0, hwreg(20, 0, 4)" : "=s"(xx)); xq = (int)(xx & 7u); }
    int kpre = -1;
    for (int tries = 0; tries < 8; ) {
        int k;
        if (kpre >= 0) { k = kpre; kpre = -1; }
        else { __syncthreads();
            if (F.tid == 0) QW[0] = (int)__hip_atomic_fetch_add(qctr + xq, 1u, __ATOMIC_RELAXED, __HIP_MEMORY_SCOPE_AGENT);
            __syncthreads();
            k = __builtin_amdgcn_readfirstlane(QW[0]); }
        if (k >= 192) { xq = (xq + 1) & 7; ++tries; continue; }
        const bool pre = k < 150;
        int raw = 0; if (pre && F.tid == 0) raw = (int)__hip_atomic_fetch_add(qctr + xq, 1u, __ATOMIC_RELAXED, __HIP_MEMORY_SCOPE_AGENT);
        int bh, qb;
        if (xq < 6) { bh = xq; qb = 4 * (63 - k / 3) + (2 - k % 3); }
        else { bh = 3 * (xq - 6) + (k >> 6); qb = 4 * (63 - (k & 63)) + 3; }
        attn_unit(F, proj, kcb, vctb, vts, vtw, oatt, bh, qb, os_scale, os_inv, (float)e2, park + (size_t)F.bid * 16384 + (size_t)F.tid * 32, kfs, sst);
        if (pre) { __syncthreads(); if (F.tid == 0) QW[0] = raw; __syncthreads(); kpre = __builtin_amdgcn_readfirstlane(QW[0]); }
    }
    __syncthreads();
}


#define XB_TMO      128
#define XB_XCNT(j)  (256  + 64 * (j))
#define XB_XSUB(j)  (1280 + 64 * (j))
#define XB_XGEN(j)  (2304 + 64 * (j))
#define XB_TOP      3328
#define XB_TOPGEN   3392
#define XCD_BAR_WORDS 3456
#define XB_SPIN_CAP (1u << 22)
DI unsigned xb_ld(unsigned* p)              { return __hip_atomic_load(p, __ATOMIC_RELAXED, __HIP_MEMORY_SCOPE_AGENT); }
DI unsigned xb_add(unsigned* p, unsigned v) { return __hip_atomic_fetch_add(p, v, __ATOMIC_RELAXED, __HIP_MEMORY_SCOPE_AGENT); }
DI unsigned xb_xcc_id() { unsigned x; asm volatile("s_getreg_b32 %0, hwreg(20, 0, 4)" : "=s"(x)); return x & 0xFu; }
#define XB_SPIN(cond, bar) do { unsigned _sp = 0; while (cond) { __builtin_amdgcn_s_sleep(1); \
    if ((++_sp & 255u) == 0u) { if (xb_ld(&(bar)[XB_TMO])) break; if (_sp > XB_SPIN_CAP) { atomicAdd(&(bar)[XB_TMO], 1u); break; } } } } while (0)
DI void xcd_barrier_complete(unsigned* bar, unsigned x, unsigned& nloc, unsigned& nx) {
    const unsigned G = gridDim.x * gridDim.y * gridDim.z;
    unsigned sum, cnt, mine, sp = 0u;
    for (;;) {
        sum = 0u; cnt = 0u; mine = 0u;
#pragma unroll
        for (unsigned j = 0; j < 16; ++j) { const unsigned c = xb_ld(&bar[XB_XCNT(j)]); sum += c; cnt += (c > 0u) ? 1u : 0u; mine = (j == x) ? c : mine; }
        if (sum == G) break;
        __builtin_amdgcn_s_sleep(1);
        if ((++sp & 255u) == 0u) { if (xb_ld(&bar[XB_TMO])) break; if (sp > XB_SPIN_CAP) { atomicAdd(&bar[XB_TMO], 1u); break; } }
    }
    nloc = mine > 0u ? mine : 1u; nx = cnt > 0u ? cnt : 1u;
}
DI void xcd_barrier(unsigned* bar, volatile LAS unsigned* st, int tid) {
    asm volatile("s_waitcnt vmcnt(0)" ::: "memory");
    __syncthreads();
    if (tid == 0) {
        const unsigned x = xb_xcc_id();
        __builtin_amdgcn_s_waitcnt(0);
        unsigned nloc = st[0], nx = st[1];
        if (nloc == 0u) { xcd_barrier_complete(bar, x, nloc, nx); st[0] = nloc; st[1] = nx; }
        const unsigned old = xb_add(&bar[XB_XSUB(x)], 1u);
        const unsigned gen = old / nloc;
        if (old + 1u == (gen + 1u) * nloc) {
            __builtin_amdgcn_fence(__ATOMIC_RELEASE, "agent");
            asm volatile("s_waitcnt vmcnt(0)" ::: "memory");
            const unsigned og = xb_add(&bar[XB_TOP], 1u);
            const unsigned tg = og / nx;
            if (og + 1u == (tg + 1u) * nx) xb_add(&bar[XB_TOPGEN], 1u);
            else XB_SPIN(xb_ld(&bar[XB_TOPGEN]) == tg, bar);
            __builtin_amdgcn_fence(__ATOMIC_ACQUIRE, "agent");
            xb_add(&bar[XB_XGEN(x)], 1u);
            asm volatile("s_waitcnt vmcnt(0)" ::: "memory");
        } else {
            XB_SPIN(xb_ld(&bar[XB_XGEN(x)]) == gen, bar);
            __builtin_amdgcn_fence(__ATOMIC_ACQUIRE, "agent");
            asm volatile("s_waitcnt vmcnt(0)" ::: "memory");
        }
    }
    __syncthreads();
}

#define REFRESH() do { int w_ = wave0, b_ = blockIdx.x, g_ = gridDim.x; asm volatile("" : "+s"(w_), "+s"(b_), "+s"(g_)); \
    int l_; asm volatile("v_mbcnt_lo_u32_b32 %0, -1, 0\n\tv_mbcnt_hi_u32_b32 %0, -1, %0" : "=v"(l_)); \
    F.lane = l_; F.wave = w_; F.tid = w_ * 64 + l_; F.bid = b_; F.G = g_; F.gw = b_ * 8 + w_; F.ngw = g_ * 8; } while (0)
#define XBAR() xcd_barrier((unsigned*)(F.wsp() + WS_CTL), (volatile LAS unsigned*)(F.lds + LDS_PT + 232), F.tid)
#if REP_SYNC > 1
#define GSYNC() do { XBAR(); XBAR(); REFRESH(); } while (0)
#else
#define GSYNC() do { REFRESH(); XBAR(); REFRESH(); } while (0)
#endif
#define WSP(off) (F.wsp() + (off))
#define WL(off) (F.wsp() + WS_W + (size_t)l * WL_STRIDE + (off))
#define MSL(off) (F.wsp() + WS_MISC + (size_t)l * MS_L + (off))
#define CTL(off) (F.wsp() + WS_CTL + CT_BASE + (size_t)l * CT_L + (off))
__global__ void __launch_bounds__(512, 2) mk_fwd(Params p) {
    extern __shared__ __attribute__((aligned(16))) unsigned char lds_raw[];
    cg::grid_group grid = cg::this_grid();
    Frame F;
    F.lds = (LAS unsigned char*)lds_raw; F.pt = (LAS const unsigned long long*)(F.lds + LDS_PT);
    const int wave0 = __builtin_amdgcn_readfirstlane((int)threadIdx.x >> 6);
    REFRESH();
    {
        LAS unsigned long long* ptw = (LAS unsigned long long*)(F.lds + LDS_PT);
        if (F.tid < 26) ptw[F.tid] = (unsigned long long)p.in[F.tid];
        if (F.tid == 26) ptw[26] = (unsigned long long)p.out;
        if (F.tid == 27) ptw[27] = (unsigned long long)p.ws;
        if (F.tid == 28) ptw[29] = 0ull;
        if (F.tid == 0) (void)xb_add((unsigned*)p.ws + XB_XCNT(xb_xcc_id()), 1u);
    }
    __syncthreads();

    PH(2, convert_rows_stats(F, F.in(0), (bf16_t*)WSP(WS_ACT), (unsigned long long*)WSP(WS_SSX)); REFRESH(););
    { unsigned long long* z = (unsigned long long*)WSP(WS_SSX) + (size_t)NT * 2; for (int i = F.bid * 512 + F.tid; i < (NL - 1) * NT * 2; i += F.G * 512) z[i] = 0ull; }
    { unsigned long long* z = (unsigned long long*)WSP(WS_SST); for (int i = F.bid * 512 + F.tid; i < NL * NT * 2; i += F.G * 512) z[i] = 0ull; }
    PH(0, prologue_a(F, 0, F.gw, F.ngw); REFRESH(););
    if (F.G == 0x7fffffff) grid.sync();
    GSYNC();
    PH(1, prologue_b(F); REFRESH(););
    if (F.G != 256) { prologue_a(F, 1, F.gw, F.ngw); __syncthreads(); REFRESH(); }
    else if (F.bid >= 128) { prologue_a(F, 1, (F.bid - 128) * 8 + F.wave, 1024); __syncthreads(); REFRESH(); }

#if STAGE >= 2
#pragma unroll 1
    for (int l = 0; l < NL; ++l) {
        REFRESH();
        { pg8::APlain g{(l == 0) ? (const char*)WSP(WS_ACT) : (const char*)F.out(), (const char*)WL(WO_WIN), 1024}; pg8::StaticOrder S; S.init(NT / 256, PW / 256, F.G, F.bid);
          pg8::EpiBf16 E{(bf16_t*)WSP(WS_PROJ), PW, (const unsigned long long*)WSP(WS_SSX) + (size_t)l * NT * 2}; pg8::gemm_phase<pg8::EpiBf16, pg8::APlain, true>(F.lds, g, S, E, F.tid); }
#if REP_INPROJ > 1
        REFRESH();
        { pg8::APlain g{(l == 0) ? (const char*)WSP(WS_ACT) : (const char*)F.out(), (const char*)WL(WO_WIN), 1024}; pg8::StaticOrder S; S.init(NT / 256, PW / 256, F.G, F.bid);
          pg8::EpiBf16 E{(bf16_t*)WSP(WS_PROJ), PW, (const unsigned long long*)WSP(WS_SSX) + (size_t)l * NT * 2}; pg8::gemm_phase<pg8::EpiBf16, pg8::APlain, true>(F.lds, g, S, E, F.tid); }
#endif
        GSYNC();
#define LOCAL_HANDOFF() do { asm volatile("s_waitcnt vmcnt(0)" ::: "memory"); __syncthreads(); if (F.tid == 0) { __builtin_amdgcn_fence(__ATOMIC_ACQUIRE, "agent"); asm volatile("s_waitcnt vmcnt(0)" ::: "memory"); } __syncthreads(); } while (0)
        if (F.G == 256) {
            if (F.bid < 48) {
                REFRESH();
                { pg8::ACompress g{(const char*)WSP(WS_PROJ), (const char*)WL(WO_W1)}; pg8::StaticOrder S; S.init_run(F.bid, 0, 1);
                  pg8::EpiCmpHid E{(bf16_t*)WSP(WS_HIDC), (const float*)CTL(CT_CB1)}; pg8::gemm_phase<pg8::EpiCmpHid, pg8::ACompress, true>(F.lds, g, S, E, F.tid); }
                REFRESH(); LOCAL_HANDOFF(); REFRESH();
                { const int pm = F.bid, it = (pm / 24) * 192 + (pm % 24) * 8 + F.wave;
                  compress2_phase(F, (const bf16_t*)WSP(WS_HIDC), (const bf16_t*)CTL(CT_W2T), F.in(7) + (size_t)l * 2 * 64, (bf16_t*)WSP(WS_KC), (bf16_t*)WSP(WS_VCT), it, it + 1, 1); }
            } else if (F.bid < 80) {
                REFRESH();
                { pg8::ASsm1 g{(const char*)WSP(WS_UC), (const char*)WL(WO_SS1)}; pg8::StaticOrder S; S.init_run((F.bid - 48) * 4, 1, 4);
                  pg8::EpiSsm1 E{(float*)WSP(WS_YI), (float*)WSP(WS_HL)}; pg8::gemm_phase<pg8::EpiSsm1, pg8::ASsm1, true>(F.lds, g, S, E, F.tid); }
                REFRESH(); LOCAL_HANDOFF(); REFRESH();
                ssm_carry_phase(F, (const float*)WSP(WS_HL), (const f32x2*)CTL(CT_AB16), (const f32x2*)CTL(CT_AB1K), (bf16_t*)WSP(WS_HIN), F.bid - 48, F.bid - 47, 1);
            } else {
                REFRESH();
                vtranspose_phase(F, (const bf16_t*)WSP(WS_PROJ), (bf16_t*)WSP(WS_VTS), (bf16_t*)WSP(WS_VTW), (bf16_t*)WSP(WS_KFS), (unsigned*)WSP(WS_CTL) + 3584 + l, 80);
                __syncthreads(); REFRESH();
                { pg8::ASsm1 g{(const char*)WSP(WS_UC), (const char*)WL(WO_SS1)}; pg8::StaticOrder S; S.init(128, 1, 176, F.bid - 80);
                  pg8::EpiSsm1 E{(float*)WSP(WS_YI), (float*)WSP(WS_HL)}; pg8::gemm_phase<pg8::EpiSsm1, pg8::ASsm1, true>(F.lds, g, S, E, F.tid); }
            }
            GSYNC();
        } else {
        PH(3, REFRESH(); vtranspose_phase(F, (const bf16_t*)WSP(WS_PROJ), (bf16_t*)WSP(WS_VTS), (bf16_t*)WSP(WS_VTW), (bf16_t*)WSP(WS_KFS), (unsigned*)WSP(WS_CTL) + 3584 + l, 48);
        __syncthreads(); REFRESH(););
        PH(4, REFRESH();
        { pg8::ACompress g{(const char*)WSP(WS_PROJ), (const char*)WL(WO_W1)}; pg8::StaticOrder S; S.init(48, 1, F.G, F.bid);
          pg8::EpiCmpHid E{(bf16_t*)WSP(WS_HIDC), (const float*)CTL(CT_CB1)}; pg8::gemm_phase<pg8::EpiCmpHid, pg8::ACompress, true>(F.lds, g, S, E, F.tid); });
        PH(5, REFRESH();
        { pg8::ASsm1 g{(const char*)WSP(WS_UC), (const char*)WL(WO_SS1)}; pg8::StaticOrder S; S.init(128, 2, F.G, F.bid);
          pg8::EpiSsm1 E{(float*)WSP(WS_YI), (float*)WSP(WS_HL)}; pg8::gemm_phase<pg8::EpiSsm1, pg8::ASsm1, true>(F.lds, g, S, E, F.tid); });
        GSYNC();
        PH(6, compress2_phase(F, (const bf16_t*)WSP(WS_HIDC), (const bf16_t*)CTL(CT_W2T), F.in(7) + (size_t)l * 2 * 64, (bf16_t*)WSP(WS_KC), (bf16_t*)WSP(WS_VCT), F.gw, 2 * 192, F.ngw);
        __syncthreads(); REFRESH(););
        PH(7, ssm_carry_phase(F, (const float*)WSP(WS_HL), (const f32x2*)CTL(CT_AB16), (const f32x2*)CTL(CT_AB1K), (bf16_t*)WSP(WS_HIN), F.bid, 32, F.G); REFRESH(););
        GSYNC();
        }
        PH(8,         REFRESH();
        { pg8::ASsm2 g{(const char*)WSP(WS_HIN), (const char*)WL(WO_SS2)}; pg8::StaticOrder S; S.init(128, 1, F.G, F.bid);
          pg8::EpiSsm2 E{(const float*)WSP(WS_YI), (const bf16_t*)WSP(WS_UC), F.in(15) + (size_t)l * 256, (bf16_t*)WSP(WS_YS2)}; pg8::gemm_phase<pg8::EpiSsm2, pg8::ASsm2, true>(F.lds, g, S, E, F.tid); });
#if STAGE >= 3
        REFRESH();
        attn_phase(F, (const bf16_t*)WSP(WS_PROJ), (const bf16_t*)WSP(WS_KC), (const bf16_t*)WSP(WS_VCT), (const bf16_t*)WSP(WS_VTS), (const bf16_t*)WSP(WS_VTW), (bf16_t*)WSP(WS_OATT), (const unsigned*)WSP(WS_CTL) + 3584 + l, (float*)WSP(WS_PARK), (unsigned*)WSP(WS_CTL) + 3600 + 16 * l, (const bf16_t*)WSP(WS_KFS), (unsigned long long*)WSP(WS_SST) + (size_t)l * NT * 2);
#if REP_ATTN > 1
        REFRESH();
        attn_phase(F, (const bf16_t*)WSP(WS_PROJ), (const bf16_t*)WSP(WS_KC), (const bf16_t*)WSP(WS_VCT), (const bf16_t*)WSP(WS_VTS), (const bf16_t*)WSP(WS_VTW), (bf16_t*)WSP(WS_OATT), (const unsigned*)WSP(WS_CTL) + 3584 + l, (float*)WSP(WS_PARK), (unsigned*)WSP(WS_CTL) + 3600 + 16 * l, (const bf16_t*)WSP(WS_KFS), (unsigned long long*)WSP(WS_SST) + (size_t)l * NT * 2);
#endif
#else
        { unsigned* oz = (unsigned*)WSP(WS_OATT); for (size_t i = (size_t)F.bid * 512 + F.tid; i < (size_t)NT * 768 / 2; i += (size_t)F.G * 512) oz[i] = 0u; }
#endif
        GSYNC();
        PH(9,         REFRESH();
        { pg8::APlain g{(const char*)WSP(WS_YS2), (const char*)MSL(MS_WGLU), 256}; pg8::StaticOrder S; S.init(NT / 256, 2, F.G, F.bid);
          pg8::EpiGlu E{(bf16_t*)WSP(WS_OATT), F.in(17) + (size_t)l * 512, (unsigned long long*)WSP(WS_SST) + (size_t)l * NT * 2}; pg8::gemm_phase<pg8::EpiGlu, pg8::APlain, true>(F.lds, g, S, E, F.tid); });
        GSYNC();
        REFRESH();
        { pg8::APlain g{(const char*)WSP(WS_OATT), (const char*)WL(WO_WOUT), 1024}; pg8::StaticOrder S; S.init(NT / 256, 4, F.G, F.bid);
          pg8::EpiResB<true, 0> E{(l == 0) ? F.in(0) : (const float*)nullptr, (const bf16_t*)F.out(), (bf16_t*)F.out(), (const unsigned long long*)WSP(WS_SST) + (size_t)l * NT * 2, (unsigned long long*)nullptr}; pg8::gemm_phase<pg8::EpiResB<true, 0>, pg8::APlain, true>(F.lds, g, S, E, F.tid); }
        GSYNC();
#if STAGE >= 4
        PH(11, rmsnorm_rows_xb<1>(F, (const bf16_t*)F.out(), F.in(21) + (size_t)l * DM, WSP(WS_ACT)); REFRESH(););
        GSYNC();
        REFRESH();
        { pg8::APlain g{(const char*)WSP(WS_ACT), (const char*)WL(WO_WGU), 512, 0x7c7c7c7c, 0x7c7c7c7c}; pg8::StaticOrder S; S.init(NT / 256, 22, F.G, F.bid);
          pg8::EpiSwiglu8 E{(unsigned char*)WSP(WS_PROJ), 0.015625f * FP8FIX}; pg8::gemm_phase<pg8::EpiSwiglu8, pg8::APlain, true, true>(F.lds, g, S, E, F.tid); }
        GSYNC();
        REFRESH();
        { pg8::APlain g{(const char*)WSP(WS_PROJ), (const char*)WL(WO_WD), DFF / 2, 0x7b7b7b7b, 0x7b7b7b7b}; pg8::StaticOrder S; S.init(NT / 256, 4, F.G, F.bid);
          pg8::EpiResB<false, 8> E{(const float*)nullptr, (const bf16_t*)F.out(), (l == NL - 1) ? (bf16_t*)WSP(WS_XLAST) : (bf16_t*)F.out(), (const unsigned long long*)nullptr, (l == NL - 1) ? (unsigned long long*)nullptr : (unsigned long long*)WSP(WS_SSX) + (size_t)(l + 1) * NT * 2}; pg8::gemm_phase<pg8::EpiResB<false, 8>, pg8::APlain, true, true>(F.lds, g, S, E, F.tid); }
        GSYNC();
#endif
#if STAGE < 5
        break;
#endif
    }
    rmsnorm_rows_xb<2>(F, (const bf16_t*)WSP(WS_XLAST), F.in(25), F.out());
#else
    {
        const float* x0 = F.in(0); const float* fg = F.in(25); float* X = F.out();
        for (int m = F.gw; m < NT; m += F.ngw) {
            const f32x4* xr = (const f32x4*)(x0 + (size_t)m * DM) + F.lane; f32x4 v[4]; float s = 0.f;
#pragma unroll
            for (int j = 0; j < 4; ++j) { v[j] = xr[64 * j]; s += (v[j].x * v[j].x + v[j].y * v[j].y) + (v[j].z * v[j].z + v[j].w * v[j].w); }
            const float rstd = rsqrtf(wave_sum(s) * (1.f / DM) + 1e-6f);
            f32x4* o = (f32x4*)(X + (size_t)m * DM) + F.lane;
#pragma unroll
            for (int j = 0; j < 4; ++j) o[64 * j] = v[j] * rstd * ((const f32x4*)fg)[64 * j + F.lane];
        }
    }
#endif
}

extern "C" void kernel_launch(void* const* d_in, const int* in_sizes, int n_in, void* d_out, int out_size, void* d_ws, size_t ws_size, hipStream_t stream) {
    static int grid_blocks = 0;
    if (grid_blocks == 0) {
        if (n_in != 26 || ws_size < WS_END) { fprintf(stderr, "kernel_launch: unexpected n_in %d or ws_size %zu (< %zu)\n", n_in, ws_size, (size_t)WS_END); grid_blocks = -1; return; }
        int dev = 0, cus = 0, per_cu = 0;
        hipGetDevice(&dev);
        hipDeviceGetAttribute(&cus, hipDeviceAttributeMultiprocessorCount, dev);
        hipFuncSetAttribute((const void*)mk_fwd, hipFuncAttributeMaxDynamicSharedMemorySize, LDS_BYTES);
        hipOccupancyMaxActiveBlocksPerMultiprocessor(&per_cu, (const void*)mk_fwd, 512, LDS_BYTES);
        if (per_cu < 1) { fprintf(stderr, "kernel_launch: occupancy query says %d blocks per CU\n", per_cu); per_cu = 1; }
        grid_blocks = cus;
        (void)hipGetLastError();
    }
    if (grid_blocks < 0) return;
    if (hipMemsetAsync((char*)d_ws + WS_CTL, 0, 16384, stream) != hipSuccess) { fprintf(stderr, "kernel_launch: memset of the barrier words failed\n"); return; }
    Params p{};
    for (int i = 0; i < 26; ++i) p.in[i] = (const float*)d_in[i];
    p.out = (float*)d_out; p.ws = (unsigned char*)d_ws;
    void* args[] = {&p};
    hipError_t e = hipLaunchCooperativeKernel((const void*)mk_fwd, dim3(grid_blocks), dim3(512), args, LDS_BYTES, stream);
    if (e != hipSuccess) fprintf(stderr, "cooperative launch failed: %s (grid %d)\n", hipGetErrorString(e), grid_blocks);
}
```
